# Optimizing an MI355X kernel written in HIP

```python
import numpy as np
import jax
import jax.numpy as jnp
from jax import lax

D_MODEL = 1024
BATCH = 4
SEQ = 8192
DEPTH = 4

D_MIX = D_MODEL
BLK = 128
LN_EPS = 1e-5
NORM_EPS = 1e-6
DEEPNORM_ALPHA = (2 * DEPTH) ** 0.25
DEEPNORM_BETA = (8 * DEPTH) ** -0.25

RET_HEADS = 4
RET_DK = 32
RET_DV = 64
RET_W = RET_HEADS * RET_DV
RET_THETA = 10000.0
DIL_HEADS = 4
DIL_DH = 64
DIL_W = DIL_HEADS * DIL_DH
DIL_PATTERNS = ((128, 1), (512, 4), (2048, 16))
ROPE_THETA = 500000.0
ROPE_ROT_DIM = DIL_DH // 4
RWKV_HEADS = 4
RWKV_DH = 64
RWKV_W = RWKV_HEADS * RWKV_DH
DECAY_LORA = 64
AAA_LORA = 64
MV_LORA = 32
GATE_LORA = 128
RWKV_GN_EPS = 64e-5
MLA_HEADS = 4
MLA_NOPE = 64
MLA_ROPE = 32
MLA_DV = 64
MLA_W = MLA_HEADS * MLA_DV
Q_LORA = 256
KV_LORA = 128
MLA_THETA = 10000.0
N_EXPERTS = 32
TOP_K = 4
D_FF_EXPERT = D_MODEL
SWIGLU_LIMIT = 7.0
SWIGLU_ALPHA = 1.702
MOE_BLK = 256

RET_SPLITS = (RET_HEADS * RET_DK, RET_HEADS * RET_DK, RET_W, RET_W)
DIL_SPLITS = (DIL_W, DIL_W, DIL_W)
RWKV_SPLITS = (RWKV_W, RWKV_W, RWKV_W, DECAY_LORA, AAA_LORA, GATE_LORA)
MLA_SPLITS = (Q_LORA, KV_LORA, MLA_ROPE)
A_END = sum(RET_SPLITS)
B_END = A_END + sum(DIL_SPLITS)
C_END = B_END + sum(RWKV_SPLITS)
N_IN = C_END + sum(MLA_SPLITS)
RWKV_SHIFT_W = sum(RWKV_SPLITS)

kernel_name = "hybrid_parallel_heads_moe_trunk"

F32 = jnp.float32


def split_cols(p, sizes):
    idx = np.cumsum(sizes)[:-1].tolist()
    return jnp.split(p, idx, axis=-1)


def layer_norm(x, g, b, eps=LN_EPS):
    xf = x.astype(F32)
    mu = jnp.mean(xf, -1, keepdims=True)
    var = jnp.mean(jnp.square(xf - mu), -1, keepdims=True)
    return ((xf - mu) * lax.rsqrt(var + eps) * g.astype(F32) + b.astype(F32)).astype(x.dtype)


def rms_norm(x, g, eps=NORM_EPS):
    xf = x.astype(F32)
    return (xf * lax.rsqrt(jnp.mean(xf * xf, -1, keepdims=True) + eps) * g.astype(F32)).astype(x.dtype)


def rope_table(n_pos, rot_dim, theta):
    inv_freq = 1.0 / (theta ** (jnp.arange(0, rot_dim, 2, dtype=F32) / rot_dim))
    ang = jnp.arange(n_pos, dtype=F32)[:, None] * inv_freq[None, :]
    return jnp.cos(ang), jnp.sin(ang)


def apply_rope(x, cs):
    cos = cs[0][None, :, None, :]
    sin = cs[1][None, :, None, :]
    x1, x2 = jnp.split(x.astype(F32), 2, axis=-1)
    return jnp.concatenate([x1 * cos - x2 * sin, x1 * sin + x2 * cos], -1).astype(x.dtype)


def apply_partial_rope(x, cs, rot_dim):
    return jnp.concatenate([apply_rope(x[..., :rot_dim], cs), x[..., rot_dim:]], -1)


def retention_mixer(q, k, v, g, norm_g, cs):
    B_, S_, _ = q.shape
    n_ch = S_ // BLK
    q = apply_rope(q.reshape(B_, S_, RET_HEADS, RET_DK), cs)
    k = apply_rope(k.reshape(B_, S_, RET_HEADS, RET_DK), cs) * (RET_DK ** -0.5)
    v = v.reshape(B_, S_, RET_HEADS, RET_DV)
    log_gamma = jnp.log(1.0 - 2.0 ** (-5.0 - jnp.arange(RET_HEADS, dtype=F32)))
    idx = jnp.arange(BLK, dtype=F32)
    dist = idx[:, None] - idx[None, :]
    inner_decay = jnp.where(dist >= 0, jnp.exp(jnp.maximum(dist, 0.0)[None] * log_gamma[:, None, None]), 0.0)
    qc = q.reshape(B_, n_ch, BLK, RET_HEADS, RET_DK)
    kc = k.reshape(B_, n_ch, BLK, RET_HEADS, RET_DK)
    vc = v.reshape(B_, n_ch, BLK, RET_HEADS, RET_DV)
    scores = jnp.einsum('bnihd,bnjhd->bnhij', qc, kc) * inner_decay
    o_inner = jnp.einsum('bnhij,bnjhe->bnihe', scores, vc)
    zeta = jnp.exp((BLK - 1 - idx)[None, :] * log_gamma[:, None])
    kv_chunk = jnp.einsum('bnjhd,hj,bnjhe->nbhde', kc, zeta, vc)
    chunk_decay = jnp.exp(BLK * log_gamma)[None, :, None, None]

    def step(state, kv):
        return chunk_decay * state + kv, state

    _, states = lax.scan(step, jnp.zeros_like(kv_chunk[0]), kv_chunk)
    xi = jnp.exp((idx + 1.0)[None, :] * log_gamma[:, None])
    o_cross = jnp.einsum('bnihd,nbhde,hi->bnihe', qc, states, xi)
    o = (o_inner + o_cross).reshape(B_, S_, RET_HEADS, RET_DV)
    o = rms_norm(o, norm_g.reshape(RET_HEADS, RET_DV))
    return (jax.nn.silu(g.astype(F32)) * o.reshape(B_, S_, RET_W)).astype(q.dtype)


def banded_block_attention(q, k, v, n_back):
    G, L, H, dh = q.shape
    nb = L // BLK
    qb = q.reshape(G, nb, BLK, H, dh)

    def with_prev(t):
        t = t.reshape(G, nb, BLK, H, dh)
        prev = jnp.concatenate([jnp.zeros_like(t[:, :1]), t[:, :-1]], axis=1)
        return jnp.concatenate([prev, t], axis=2)

    kk = with_prev(k)
    vv = with_prev(v)
    s = jnp.einsum('gnihd,gnjhd->gnhij', qb, kk).astype(F32) * (dh ** -0.5)
    qpos = BLK + jnp.arange(BLK)
    kpos = jnp.arange(2 * BLK)
    dist = qpos[:, None] - kpos[None, :]
    band = (dist >= 0) & (dist <= n_back)
    first = band & (kpos[None, :] >= BLK)
    mask = jnp.where((jnp.arange(nb) == 0)[:, None, None], first[None], band[None])
    s = jnp.where(mask[None, :, None], s, -jnp.inf)
    lse = jax.nn.logsumexp(s, axis=-1)
    p = jnp.exp(s - lse[..., None])
    o = jnp.einsum('gnhij,gnjhd->gnihd', p.astype(v.dtype), vv)
    return o.reshape(G, L, H, dh), jnp.swapaxes(lse, 2, 3).reshape(G, L, H)


def dilated_mixer(q, k, v, norm_g, cs):
    B_, S_, _ = q.shape
    shp = (B_, S_, DIL_HEADS, DIL_DH)
    q = apply_partial_rope(q.reshape(shp), cs, ROPE_ROT_DIM)
    k = apply_partial_rope(k.reshape(shp), cs, ROPE_ROT_DIM)
    v = v.reshape(shp)
    outs, lses = [], []
    for window, dil in DIL_PATTERNS:
        span = dil * BLK
        s_pad = -(-S_ // span) * span
        m = s_pad // dil

        def to_residues(t):
            t = jnp.pad(t, ((0, 0), (0, s_pad - S_), (0, 0), (0, 0)))
            return t.reshape(B_, m, dil, DIL_HEADS, DIL_DH).transpose(0, 2, 1, 3, 4).reshape(B_ * dil, m, DIL_HEADS, DIL_DH)

        o, lse = banded_block_attention(to_residues(q), to_residues(k), to_residues(v), window // dil)
        o = o.reshape(B_, dil, m, DIL_HEADS, DIL_DH).transpose(0, 2, 1, 3, 4).reshape(B_, s_pad, DIL_HEADS, DIL_DH)[:, :S_]
        lse = lse.reshape(B_, dil, m, DIL_HEADS).transpose(0, 2, 1, 3).reshape(B_, s_pad, DIL_HEADS)[:, :S_]
        outs.append(o)
        lses.append(lse)
    wts = jax.nn.softmax(jnp.stack(lses), axis=0)
    o = jnp.einsum('pbsh,pbshd->bshd', wts, jnp.stack(outs).astype(F32))
    return rms_norm(o.reshape(B_, S_, DIL_W), norm_g).astype(q.dtype)


def token_shift(p, mu):
    prev = jnp.pad(p, ((0, 0), (1, 0), (0, 0)))[:, :-1]
    return p + (prev - p) * mu


def l2_normalize(x, eps=1e-12):
    xf = x.astype(F32)
    return xf / jnp.maximum(jnp.sqrt(jnp.sum(xf * xf, -1, keepdims=True)), eps)


def rwkv7_scan(r, w, k, v, a, b):
    B_, S_, H, N = r.shape

    def step(state, inp):
        r_t, w_t, k_t, v_t, a_t, b_t = inp
        sa = jnp.einsum('bhij,bhj->bhi', state, a_t)
        state = state * w_t[:, :, None, :] + sa[..., None] * b_t[:, :, None, :] + v_t[..., None] * k_t[:, :, None, :]
        return state, jnp.einsum('bhij,bhj->bhi', state, r_t)

    xs = (jnp.moveaxis(r, 1, 0), jnp.moveaxis(w, 1, 0), jnp.moveaxis(k, 1, 0),
          jnp.moveaxis(v, 1, 0), jnp.moveaxis(a, 1, 0), jnp.moveaxis(b, 1, 0))
    _, y = lax.scan(step, jnp.zeros((B_, H, N, N), F32), xs)
    return jnp.moveaxis(y, 0, 1)


def rwkv7_mixer(r, k, v, wd, ad, gd, w0, w_up, a0, a_up, g_up, k_k, k_a, r_k, ln_g, ln_b):
    B_, S_, _ = r.shape
    hs = (B_, S_, RWKV_HEADS, RWKV_DH)
    w = -jax.nn.softplus(-(w0 + jnp.tanh(wd) @ w_up)) - 0.5
    decay = jnp.exp(-jnp.exp(w.astype(F32)))
    a = jax.nn.sigmoid((a0 + ad @ a_up).astype(F32))
    g = (jax.nn.sigmoid(gd) @ g_up).astype(F32)
    kk = l2_normalize((k * k_k).reshape(hs))
    k = k.astype(F32) * (1.0 + (a - 1.0) * k_a.astype(F32))
    rf = r.astype(F32).reshape(hs)
    kf = k.reshape(hs)
    vf = v.astype(F32).reshape(hs)
    y = rwkv7_scan(rf, decay.reshape(hs), kf, vf, -kk, kk * a.reshape(hs))
    y = layer_norm(y, ln_g.reshape(RWKV_HEADS, RWKV_DH), ln_b.reshape(RWKV_HEADS, RWKV_DH), RWKV_GN_EPS)
    y = y + jnp.sum(rf * kf * r_k.astype(F32), -1, keepdims=True) * vf
    return (y.reshape(B_, S_, RWKV_W) * g).astype(r.dtype)


def causal_block_attention(q, k, v, scale):
    B_, S_, H, dq = q.shape
    nb = S_ // BLK
    qb = jnp.moveaxis(q.reshape(B_, nb, BLK, H, dq), 1, 0)
    kpos = jnp.arange(S_)

    def one_block(args):
        q_blk, blk = args
        s = jnp.einsum('bqhd,bkhd->bhqk', q_blk, k).astype(F32) * scale
        qpos = blk * BLK + jnp.arange(BLK)
        s = jnp.where(kpos[None, :] <= qpos[:, None], s, -jnp.inf)
        p = jax.nn.softmax(s, axis=-1)
        return jnp.einsum('bhqk,bkhd->bqhd', p.astype(v.dtype), v)

    o = lax.map(one_block, (qb, jnp.arange(nb)))
    return jnp.moveaxis(o, 0, 1).reshape(B_, S_, H, v.shape[-1])


def mla_mixer(c_q, c_kv, k_rope, q_norm_g, w_q_up, kv_norm_g, w_kv_up, out_norm_g, cs):
    B_, S_, _ = c_q.shape
    q = (rms_norm(c_q, q_norm_g) @ w_q_up).reshape(B_, S_, MLA_HEADS, MLA_NOPE + MLA_ROPE)
    kv = (rms_norm(c_kv, kv_norm_g) @ w_kv_up).reshape(B_, S_, MLA_HEADS, MLA_NOPE + MLA_DV)
    q = jnp.concatenate([q[..., :MLA_NOPE], apply_rope(q[..., MLA_NOPE:], cs)], -1)
    k_pe = apply_rope(k_rope[:, :, None, :], cs)
    k = jnp.concatenate([kv[..., :MLA_NOPE], jnp.broadcast_to(k_pe, (B_, S_, MLA_HEADS, MLA_ROPE))], -1)
    v = kv[..., MLA_NOPE:]
    o = causal_block_attention(q, k, v, (MLA_NOPE + MLA_ROPE) ** -0.5)
    return rms_norm(o.reshape(B_, S_, MLA_W), out_norm_g)


def moe_ffn(h, w_router, b_router, w_gu, b_gu, w_dn, b_dn):
    B_, S_, D = h.shape
    n_tok = B_ * S_
    t = h.reshape(n_tok, D)
    logits = (t @ w_router + b_router).astype(F32)
    top_val, top_idx = lax.top_k(logits, TOP_K)
    gate = jax.nn.softmax(top_val, axis=-1)
    n_assign = n_tok * TOP_K
    e_flat = top_idx.reshape(-1).astype(jnp.int32)
    tok_flat = jnp.repeat(jnp.arange(n_tok, dtype=jnp.int32), TOP_K)
    g_flat = gate.reshape(-1)
    order = jnp.argsort(e_flat)
    e_sorted = e_flat[order]
    counts = jnp.bincount(e_flat, length=N_EXPERTS).astype(jnp.int32)
    padded = (counts + MOE_BLK - 1) // MOE_BLK * MOE_BLK
    start = jnp.cumsum(counts) - counts
    pend = jnp.cumsum(padded)
    pstart = pend - padded
    dest = pstart[e_sorted] + (jnp.arange(n_assign, dtype=jnp.int32) - start[e_sorted])
    n_rows = (n_assign + N_EXPERTS * (MOE_BLK - 1) + MOE_BLK - 1) // MOE_BLK * MOE_BLK
    n_blocks = n_rows // MOE_BLK
    row_tok = jnp.full((n_rows,), n_tok, jnp.int32).at[dest].set(tok_flat[order])
    row_gate = jnp.zeros((n_rows,), F32).at[dest].set(g_flat[order])
    block_e = jnp.minimum(jnp.searchsorted(pend, jnp.arange(n_blocks, dtype=jnp.int32) * MOE_BLK, side='right'), N_EXPERTS - 1)
    t_pad = jnp.concatenate([t, jnp.zeros((1, D), t.dtype)], axis=0)

    def expert_block(args):
        toks, e = args
        xb = t_pad[toks]
        gu = xb @ w_gu[e] + b_gu[e]
        x_glu = jnp.minimum(gu[:, 0::2], SWIGLU_LIMIT)
        x_lin = jnp.clip(gu[:, 1::2], -SWIGLU_LIMIT, SWIGLU_LIMIT)
        act = x_glu * jax.nn.sigmoid(SWIGLU_ALPHA * x_glu) * (x_lin + 1.0)
        return act @ w_dn[e] + b_dn[e]

    yb = lax.map(expert_block, (row_tok.reshape(n_blocks, MOE_BLK), block_e))
    y = jax.ops.segment_sum(yb.reshape(n_rows, D).astype(F32) * row_gate[:, None], row_tok, num_segments=n_tok + 1)[:n_tok]
    return y.reshape(B_, S_, D).astype(h.dtype)


def setup_inputs(seed: int = 0) -> dict:
    key = jax.random.key(seed)
    keys = jax.random.split(key, 40)
    it = iter(range(40))

    def nk():
        return keys[next(it)]

    def nrm(shape, scale):
        return jax.random.normal(nk(), shape, jnp.float32) * scale

    def unif(shape, lo, hi):
        return jax.random.uniform(nk(), shape, jnp.float32, lo, hi)

    def gain(shape):
        return 1.0 + nrm(shape, 0.02)

    L = DEPTH
    Lv = DEPTH - 1
    return {
        "x": nrm((BATCH, SEQ, D_MODEL), 1.0),
        "w_in": nrm((L, D_MODEL, N_IN), D_MODEL ** -0.5),
        "w_out": nrm((L, D_MIX, D_MODEL), D_MIX ** -0.5 * DEEPNORM_BETA),
        "ret_norm_g": gain((L, RET_W)),
        "dil_norm_g": gain((L, DIL_W)),
        "rwkv_mu": unif((L, RWKV_SHIFT_W), 0.0, 1.0),
        "rwkv_w0": unif((L, RWKV_W), -6.0, -0.5),
        "rwkv_w_up": nrm((L, DECAY_LORA, RWKV_W), 0.1),
        "rwkv_a0": nrm((L, RWKV_W), 0.2),
        "rwkv_a_up": nrm((L, AAA_LORA, RWKV_W), 0.5 * AAA_LORA ** -0.5),
        "rwkv_g_up": nrm((L, GATE_LORA, RWKV_W), GATE_LORA ** -0.5),
        "rwkv_k_k": 0.85 + nrm((L, RWKV_W), 0.02),
        "rwkv_k_a": gain((L, RWKV_W)),
        "rwkv_r_k": nrm((L, RWKV_HEADS, RWKV_DH), 0.1),
        "rwkv_ln_g": gain((L, RWKV_W)),
        "rwkv_ln_b": nrm((L, RWKV_W), 0.02),
        "rwkv_vres_down": nrm((Lv, D_MODEL, MV_LORA), D_MODEL ** -0.5),
        "rwkv_vres_mu": unif((Lv, MV_LORA), 0.0, 1.0),
        "rwkv_v0": 0.5 + nrm((Lv, RWKV_W), 0.1),
        "rwkv_v_up": nrm((Lv, MV_LORA, RWKV_W), 0.5 * MV_LORA ** -0.5),
        "mla_q_norm_g": gain((L, Q_LORA)),
        "mla_w_q_up": nrm((L, Q_LORA, MLA_HEADS * (MLA_NOPE + MLA_ROPE)), Q_LORA ** -0.5),
        "mla_kv_norm_g": gain((L, KV_LORA)),
        "mla_w_kv_up": nrm((L, KV_LORA, MLA_HEADS * (MLA_NOPE + MLA_DV)), KV_LORA ** -0.5),
        "mla_out_norm_g": gain((L, MLA_W)),
        "ln1_g": gain((L, D_MODEL)),
        "ln1_b": nrm((L, D_MODEL), 0.02),
        "router_w": nrm((L, D_MODEL, N_EXPERTS), D_MODEL ** -0.5),
        "router_b": nrm((L, N_EXPERTS), 0.01),
        "exp_w_gu": nrm((L, N_EXPERTS, D_MODEL, 2 * D_FF_EXPERT), D_MODEL ** -0.5),
        "exp_b_gu": nrm((L, N_EXPERTS, 2 * D_FF_EXPERT), 0.02),
        "exp_w_dn": nrm((L, N_EXPERTS, D_FF_EXPERT, D_MODEL), D_FF_EXPERT ** -0.5 * DEEPNORM_BETA),
        "exp_b_dn": nrm((L, N_EXPERTS, D_MODEL), 0.02),
        "ln2_g": gain((L, D_MODEL)),
        "ln2_b": nrm((L, D_MODEL), 0.02),
    }


def reference(x, w_in, w_out, ret_norm_g, dil_norm_g, rwkv_mu, rwkv_w0, rwkv_w_up, rwkv_a0, rwkv_a_up,
              rwkv_g_up, rwkv_k_k, rwkv_k_a, rwkv_r_k, rwkv_ln_g, rwkv_ln_b, rwkv_vres_down, rwkv_vres_mu,
              rwkv_v0, rwkv_v_up, mla_q_norm_g, mla_w_q_up, mla_kv_norm_g, mla_w_kv_up, mla_out_norm_g,
              ln1_g, ln1_b, router_w, router_b, exp_w_gu, exp_b_gu, exp_w_dn, exp_b_dn, ln2_g, ln2_b):
    S_ = x.shape[1]
    ret_cs = rope_table(S_, RET_DK, RET_THETA)
    dil_cs = rope_table(S_, ROPE_ROT_DIM, ROPE_THETA)
    mla_cs = rope_table(S_, MLA_ROPE, MLA_THETA)
    v_first = None
    for l in range(DEPTH):
        if l == 0:
            p = x @ w_in[l]
        else:
            p = x @ jnp.concatenate([w_in[l], rwkv_vres_down[l - 1]], axis=1)

        a_q, a_k, a_v, a_g = split_cols(p[..., :A_END], RET_SPLITS)
        o_a = retention_mixer(a_q, a_k, a_v, a_g, ret_norm_g[l], ret_cs)

        b_q, b_k, b_v = split_cols(p[..., A_END:B_END], DIL_SPLITS)
        o_b = dilated_mixer(b_q, b_k, b_v, dil_norm_g[l], dil_cs)

        c_r, c_k, c_v, c_wd, c_ad, c_gd = split_cols(token_shift(p[..., B_END:C_END], rwkv_mu[l]), RWKV_SPLITS)
        if l == 0:
            v_first = c_v
        else:
            vd = token_shift(p[..., N_IN:], rwkv_vres_mu[l - 1])
            c_v = c_v + (v_first - c_v) * jax.nn.sigmoid(rwkv_v0[l - 1] + vd @ rwkv_v_up[l - 1])
        o_c = rwkv7_mixer(c_r, c_k, c_v, c_wd, c_ad, c_gd, rwkv_w0[l], rwkv_w_up[l], rwkv_a0[l], rwkv_a_up[l],
                          rwkv_g_up[l], rwkv_k_k[l], rwkv_k_a[l], rwkv_r_k[l], rwkv_ln_g[l], rwkv_ln_b[l])

        d_cq, d_ckv, d_kr = split_cols(p[..., C_END:N_IN], MLA_SPLITS)
        o_d = mla_mixer(d_cq, d_ckv, d_kr, mla_q_norm_g[l], mla_w_q_up[l], mla_kv_norm_g[l], mla_w_kv_up[l],
                        mla_out_norm_g[l], mla_cs)

        mix = jnp.concatenate([o_a, o_b, o_c, o_d], axis=-1).astype(x.dtype) @ w_out[l]
        x = layer_norm(DEEPNORM_ALPHA * x + mix, ln1_g[l], ln1_b[l])
        ffn = moe_ffn(x, router_w[l], router_b[l], exp_w_gu[l], exp_b_gu[l], exp_w_dn[l], exp_b_dn[l])
        x = layer_norm(DEEPNORM_ALPHA * x + ffn, ln2_g[l], ln2_b[l])
    return x
```

```cpp
#include <hip/hip_runtime.h>
#include <stdint.h>
#include <string.h>
#include <stdio.h>

typedef unsigned short bf16_t;
typedef short bf16x8 __attribute__((ext_vector_type(8)));
typedef float f32x4 __attribute__((ext_vector_type(4)));
typedef unsigned u32x4 __attribute__((ext_vector_type(4)));

constexpr int NT = 32768, SEQ = 8192, NBATCH = 4, DM = 1024, NIN = 2976, NINP = 3072, DEPTH = 4, NE = 32, TOPK = 4;
constexpr int BLK = 128, NCH = SEQ / BLK;
constexpr float ALPHA = 1.6817928305074292f;
constexpr int PC_RQ = 0, PC_RK = 128, PC_RV = 256, PC_RG = 512, PC_DQ = 768, PC_DK = 1024, PC_DV = 1280;
constexpr int PC_C = 1536, PC_CR = 1536, PC_CK = 1792, PC_CV = 2048, PC_CWD = 2304, PC_CAD = 2368, PC_CGD = 2432;
constexpr int PC_MQ = 2560, PC_MKV = 2816, PC_MKR = 2944, PC_VRES = 2976;
constexpr int MOE_TM = 128;
constexpr int MOE_MAXROWS = NT * TOPK + NE * MOE_TM;
constexpr int NTHREADS = 512;
constexpr int LDS_BYTES = 147456;

__device__ __forceinline__ bf16_t f2bf(float f) { unsigned u = __float_as_uint(f); u += 0x7fffu + ((u >> 16) & 1u); return (bf16_t)(u >> 16); }
__device__ __forceinline__ float bf2f(bf16_t h) { return __uint_as_float(((unsigned)h) << 16); }
__device__ __forceinline__ float wave_sum(float v) { for (int o = 32; o; o >>= 1) v += __shfl_xor(v, o); return v; }
__device__ __forceinline__ float grp16_sum(float v) { for (int o = 8; o; o >>= 1) v += __shfl_xor(v, o); return v; }
__device__ __forceinline__ float sigmoidf_(float x) { return 1.0f / (1.0f + __expf(-x)); }

struct Params {
    const float *x, *w_in, *w_out, *ret_norm_g, *dil_norm_g, *rwkv_mu, *rwkv_w0, *rwkv_w_up, *rwkv_a0, *rwkv_a_up, *rwkv_g_up, *rwkv_k_k, *rwkv_k_a,
        *rwkv_r_k, *rwkv_ln_g, *rwkv_ln_b, *vres_down, *vres_mu, *rwkv_v0, *rwkv_v_up, *mla_q_norm_g, *mla_w_q_up, *mla_kv_norm_g, *mla_w_kv_up,
        *mla_out_norm_g, *ln1_g, *ln1_b, *router_w, *router_b, *w_gu, *b_gu, *w_dn, *b_dn, *ln2_g, *ln2_b;
    float* out;
    unsigned* bar; int* cnt;
    float *tab_ret, *tab_dil, *tab_mla;
    bf16_t *win_t, *wout_t, *wgu_t, *wdn_t, *wq_t, *wkv_t;
    float* xf; bf16_t* xb; bf16_t* pbuf; bf16_t* mixcat; float* y1; bf16_t* x1b;
    float *rq, *rk, *rkv, *rstate;
    float *dq, *dk, *dob;
    float *sr, *sw, *sk, *sv, *sa, *sb, *sg, *sy, *vfirst;
    float *rsq, *rskv, *kpe, *qu, *kvu, *mo;
    int *rowtok, *toke, *tokpos; float* rowgate; bf16_t *act, *yb;
};

template <class F>
__device__ __forceinline__ void tr_tile(F f, bf16_t* dst, int ldd, int k0, int n0, float* tile) {
    const int tid = threadIdx.x;
#pragma unroll
    for (int i = 0; i < 8; ++i) { const int e = tid + i * NTHREADS, kk = e >> 6, nn = e & 63; tile[kk * 65 + nn] = f(k0 + kk, n0 + nn); }
    __syncthreads();
#pragma unroll
    for (int i = 0; i < 8; ++i) { const int e = tid + i * NTHREADS, nn = e >> 6, kk = e & 63; dst[(size_t)(n0 + nn) * ldd + k0 + kk] = f2bf(tile[kk * 65 + nn]); }
    __syncthreads();
}

__device__ void ph_prologue(const Params& p, char* lds) {
    float* tile = (float*)lds;
    const int nb = gridDim.x, bid = blockIdx.x, tid = threadIdx.x;
    for (int t = bid; t < DEPTH * NE * 16 * 32; t += nb) {
        const int le = t >> 9, r = t & 511, tk = r >> 5, tn = r & 31;
        const float* src = p.w_gu + (size_t)le * 1024 * 2048;
        tr_tile([&](int k, int n) { return src[(size_t)k * 2048 + n]; }, p.wgu_t + (size_t)le * 2048 * 1024, 1024, tk * 64, tn * 64, tile);
    }
    for (int t = bid; t < DEPTH * NE * 16 * 16; t += nb) {
        const int le = t >> 8, r = t & 255, tk = r >> 4, tn = r & 15;
        const float* src = p.w_dn + (size_t)le * 1024 * 1024;
        tr_tile([&](int k, int n) { return src[(size_t)k * 1024 + n]; }, p.wdn_t + (size_t)le * 1024 * 1024, 1024, tk * 64, tn * 64, tile);
    }
    for (int t = bid; t < DEPTH * 16 * 48; t += nb) {
        const int l = t / (16 * 48), r = t % (16 * 48), tk = r / 48, tn = r % 48;
        const float* src = p.w_in + (size_t)l * 1024 * NIN;
        const float* vr = p.vres_down + (size_t)(l > 0 ? l - 1 : 0) * 1024 * 32;
        tr_tile([&](int k, int n) { return n < NIN ? src[(size_t)k * NIN + n] : ((n < NIN + 32 && l > 0) ? vr[k * 32 + (n - NIN)] : 0.0f); },
                p.win_t + (size_t)l * NINP * 1024, 1024, tk * 64, tn * 64, tile);
    }
    for (int t = bid; t < DEPTH * 16 * 16; t += nb) {
        const int l = t >> 8, r = t & 255, tk = r >> 4, tn = r & 15;
        const float* src = p.w_out + (size_t)l * 1024 * 1024;
        tr_tile([&](int k, int n) { return src[(size_t)k * 1024 + n]; }, p.wout_t + (size_t)l * 1024 * 1024, 1024, tk * 64, tn * 64, tile);
    }
    for (int t = bid; t < DEPTH * 4 * 6; t += nb) {
        const int l = t / 24, r = t % 24, tk = r / 6, tn = r % 6;
        const float* src = p.mla_w_q_up + (size_t)l * 256 * 384; const float* g = p.mla_q_norm_g + l * 256;
        tr_tile([&](int k, int n) { return src[k * 384 + n] * g[k]; }, p.wq_t + (size_t)l * 384 * 256, 256, tk * 64, tn * 64, tile);
    }
    for (int t = bid; t < DEPTH * 2 * 8; t += nb) {
        const int l = t / 16, r = t % 16, tk = r / 8, tn = r % 8;
        const float* src = p.mla_w_kv_up + (size_t)l * 128 * 512; const float* g = p.mla_kv_norm_g + l * 128;
        tr_tile([&](int k, int n) { return src[k * 512 + n] * g[k]; }, p.wkv_t + (size_t)l * 512 * 128, 128, tk * 64, tn * 64, tile);
    }
    for (int i = bid * NTHREADS + tid; i < SEQ * 40; i += nb * NTHREADS) {
        const int pos = i / 40, j = i % 40;
        double theta, rot; int f; float* dst;
        if (j < 16) { theta = 10000.0; rot = 32.0; f = j; dst = p.tab_ret + ((size_t)pos * 16 + f) * 2; }
        else if (j < 24) { theta = 500000.0; rot = 16.0; f = j - 16; dst = p.tab_dil + ((size_t)pos * 8 + f) * 2; }
        else { theta = 10000.0; rot = 32.0; f = j - 24; dst = p.tab_mla + ((size_t)pos * 16 + f) * 2; }
        const double inv = 1.0 / pow(theta, (2.0 * f) / rot), ang = (double)pos * inv;
        dst[0] = (float)cos(ang); dst[1] = (float)sin(ang);
    }
    for (size_t i = (size_t)bid * NTHREADS + tid; i < (size_t)NT * DM / 4; i += (size_t)nb * NTHREADS) {
        const float4 v = ((const float4*)p.x)[i];
        ushort4 o; o.x = f2bf(v.x); o.y = f2bf(v.y); o.z = f2bf(v.z); o.w = f2bf(v.w);
        ((ushort4*)p.xb)[i] = o;
    }
    if (bid == 0 && tid < DEPTH * NE) p.cnt[tid] = 0;
}

template <class Epi>
__device__ __forceinline__ void gemm_tile128(const bf16_t* __restrict__ A, int lda, const int* __restrict__ rowidx, int nvalid,
                                             const bf16_t* __restrict__ Bt, int ldb, int K, char* lds, Epi epi) {
    constexpr int LDT = 72;
    bf16_t* As = (bf16_t*)lds; bf16_t* Bs = As + 128 * LDT;
    const int tid = threadIdx.x, lane = tid & 63, wid = tid >> 6, wm = wid >> 2, wn = wid & 3, fr = lane & 15, fq = lane >> 4;
    const bf16_t* ap[2]; const bf16_t* bp[2]; int so[2];
#pragma unroll
    for (int i = 0; i < 2; ++i) {
        const int c = tid + i * NTHREADS, row = c >> 3, kc = c & 7;
        int ar = row; if (rowidx) ar = (row < nvalid) ? rowidx[row] : rowidx[0];
        ap[i] = A + (size_t)ar * lda + kc * 8; bp[i] = Bt + (size_t)row * ldb + kc * 8; so[i] = row * LDT + kc * 8;
    }
    f32x4 acc[4][2];
#pragma unroll
    for (int mi = 0; mi < 4; ++mi)
#pragma unroll
        for (int ni = 0; ni < 2; ++ni) acc[mi][ni] = (f32x4){0.f, 0.f, 0.f, 0.f};
    u32x4 ra0, ra1, rb0, rb1;
    ra0 = *(const u32x4*)(ap[0]); ra1 = *(const u32x4*)(ap[1]); rb0 = *(const u32x4*)(bp[0]); rb1 = *(const u32x4*)(bp[1]);
    const int nk = K >> 6;
    for (int kt = 0; kt < nk; ++kt) {
        __syncthreads();
        *(u32x4*)(As + so[0]) = ra0; *(u32x4*)(As + so[1]) = ra1; *(u32x4*)(Bs + so[0]) = rb0; *(u32x4*)(Bs + so[1]) = rb1;
        __syncthreads();
        if (kt + 1 < nk) {
            const int ko = (kt + 1) * 64;
            ra0 = *(const u32x4*)(ap[0] + ko); ra1 = *(const u32x4*)(ap[1] + ko); rb0 = *(const u32x4*)(bp[0] + ko); rb1 = *(const u32x4*)(bp[1] + ko);
        }
#pragma unroll
        for (int kk = 0; kk < 2; ++kk) {
            bf16x8 af[4], bfr[2];
#pragma unroll
            for (int mi = 0; mi < 4; ++mi) af[mi] = *(const bf16x8*)(As + (wm * 64 + mi * 16 + fr) * LDT + kk * 32 + fq * 8);
#pragma unroll
            for (int ni = 0; ni < 2; ++ni) bfr[ni] = *(const bf16x8*)(Bs + (wn * 32 + ni * 16 + fr) * LDT + kk * 32 + fq * 8);
#pragma unroll
            for (int mi = 0; mi < 4; ++mi)
#pragma unroll
                for (int ni = 0; ni < 2; ++ni) acc[mi][ni] = __builtin_amdgcn_mfma_f32_16x16x32_bf16(bfr[ni], af[mi], acc[mi][ni], 0, 0, 0);
        }
    }
#pragma unroll
    for (int mi = 0; mi < 4; ++mi)
#pragma unroll
        for (int ni = 0; ni < 2; ++ni) epi(wm * 64 + mi * 16 + fr, wn * 32 + ni * 16 + fq * 4, acc[mi][ni]);
    __syncthreads();
}

__device__ void ph_inproj(const Params& p, int l, char* lds) {
    const bf16_t* Bt = p.win_t + (size_t)l * NINP * 1024;
    const int ntn = NINP / 128, nunits = (NT / 128) * ntn;
    for (int u = blockIdx.x; u < nunits; u += gridDim.x) {
        const int mt = u / ntn, nt = u % ntn;
        bf16_t* out = p.pbuf + (size_t)mt * 128 * NINP + nt * 128;
        gemm_tile128(p.xb + (size_t)mt * 128 * 1024, 1024, nullptr, 128, Bt + (size_t)nt * 128 * 1024, 1024, 1024, lds,
                     [=](int r, int c, f32x4 v) mutable { ushort4 o; o.x = f2bf(v[0]); o.y = f2bf(v[1]); o.z = f2bf(v[2]); o.w = f2bf(v[3]); *(ushort4*)(out + (size_t)r * NINP + c) = o; });
    }
}

__device__ void ph_rope_prep(const Params& p, int l) {
    const int lane = threadIdx.x & 63, gw = blockIdx.x * (NTHREADS / 64) + (threadIdx.x >> 6), nw = gridDim.x * (NTHREADS / 64);
    for (int t = gw; t < NT; t += nw) {
        const int pos = t % SEQ;
        const bf16_t* pr = p.pbuf + (size_t)t * NINP;
        {
            const int h = lane >> 4, i = lane & 15;
            const float c = p.tab_ret[(pos * 16 + i) * 2], s = p.tab_ret[(pos * 16 + i) * 2 + 1];
            float x1 = bf2f(pr[PC_RQ + h * 32 + i]), x2 = bf2f(pr[PC_RQ + h * 32 + 16 + i]);
            p.rq[(size_t)t * 128 + h * 32 + i] = x1 * c - x2 * s; p.rq[(size_t)t * 128 + h * 32 + 16 + i] = x1 * s + x2 * c;
            x1 = bf2f(pr[PC_RK + h * 32 + i]); x2 = bf2f(pr[PC_RK + h * 32 + 16 + i]);
            const float sc = 0.17677669529663687f;
            p.rk[(size_t)t * 128 + h * 32 + i] = (x1 * c - x2 * s) * sc; p.rk[(size_t)t * 128 + h * 32 + 16 + i] = (x1 * s + x2 * c) * sc;
        }
        {
            for (int e = lane; e < 256; e += 64) {
                const int h = e >> 6, d = e & 63;
                float qv, kv;
                if (d < 16) {
                    const int i = d & 7; const float c = p.tab_dil[(pos * 8 + i) * 2], s = p.tab_dil[(pos * 8 + i) * 2 + 1];
                    const float q1 = bf2f(pr[PC_DQ + h * 64 + i]), q2 = bf2f(pr[PC_DQ + h * 64 + 8 + i]);
                    const float k1 = bf2f(pr[PC_DK + h * 64 + i]), k2 = bf2f(pr[PC_DK + h * 64 + 8 + i]);
                    if (d < 8) { qv = q1 * c - q2 * s; kv = k1 * c - k2 * s; } else { qv = q1 * s + q2 * c; kv = k1 * s + k2 * c; }
                } else { qv = bf2f(pr[PC_DQ + e]); kv = bf2f(pr[PC_DK + e]); }
                p.dq[(size_t)t * 256 + e] = qv * 0.125f; p.dk[(size_t)t * 256 + e] = kv;
            }
        }
        {
            float ss = 0.f;
            for (int e = lane; e < 256; e += 64) { const float v = bf2f(pr[PC_MQ + e]); ss += v * v; }
            ss = wave_sum(ss);
            float s2 = 0.f;
            for (int e = lane; e < 128; e += 64) { const float v = bf2f(pr[PC_MKV + e]); s2 += v * v; }
            s2 = wave_sum(s2);
            if (lane == 0) { p.rsq[t] = rsqrtf(ss * (1.0f / 256.0f) + 1e-6f); p.rskv[t] = rsqrtf(s2 * (1.0f / 128.0f) + 1e-6f); }
            if (lane < 16) {
                const float c = p.tab_mla[(pos * 16 + lane) * 2], s = p.tab_mla[(pos * 16 + lane) * 2 + 1];
                const float x1 = bf2f(pr[PC_MKR + lane]), x2 = bf2f(pr[PC_MKR + 16 + lane]);
                p.kpe[(size_t)t * 32 + lane] = x1 * c - x2 * s; p.kpe[(size_t)t * 32 + 16 + lane] = x1 * s + x2 * c;
            }
        }
    }
}

__device__ __forceinline__ float ret_log_gamma(int h) { return logf(1.0f - exp2f(-5.0f - (float)h)); }

__device__ void ph_ret_kv(const Params& p, int l) {
    const size_t total = (size_t)NBATCH * NCH * 4 * 32 * 64;
    for (size_t i = (size_t)blockIdx.x * NTHREADS + threadIdx.x; i < total; i += (size_t)gridDim.x * NTHREADS) {
        const int e = i & 63, d = (i >> 6) & 31, h = (i >> 11) & 3, n = (i >> 13) & 63, b = (int)(i >> 19);
        const float lg = ret_log_gamma(h);
        const int t0 = b * SEQ + n * BLK;
        float acc = 0.f;
        for (int j = 0; j < BLK; ++j) {
            const float z = __expf((float)(BLK - 1 - j) * lg);
            acc += p.rk[(size_t)(t0 + j) * 128 + h * 32 + d] * z * bf2f(p.pbuf[(size_t)(t0 + j) * NINP + PC_RV + h * 64 + e]);
        }
        p.rkv[i] = acc;
    }
}
__device__ void ph_ret_scan(const Params& p, int l) {
    const int i = blockIdx.x * NTHREADS + threadIdx.x;
    if (i < NBATCH * 4 * 32 * 64) {
        const int e = i & 63, d = (i >> 6) & 31, h = (i >> 11) & 3, b = i >> 13;
        const float cd = __expf((float)BLK * ret_log_gamma(h));
        float s = 0.f;
        for (int n = 0; n < NCH; ++n) {
            const size_t idx = ((((size_t)b * NCH + n) * 4 + h) * 32 + d) * 64 + e;
            p.rstate[idx] = s; s = cd * s + p.rkv[idx];
        }
    }
}
__device__ void ph_ret_out(const Params& p, int l) {
    const int lane = threadIdx.x & 63;
    const int nwv = gridDim.x * (NTHREADS / 64);
    for (int w = blockIdx.x * (NTHREADS / 64) + (threadIdx.x >> 6); w < NT / 64 * 4; w += nwv) {
        const int h = w & 3, tb = (w >> 2) * 64, t = tb + lane, b = t / SEQ, pos = t % SEQ, n = pos / BLK, i = pos % BLK, c0 = tb - (tb % BLK);
        const float lg = ret_log_gamma(h);
        float q[32], o[64];
#pragma unroll
        for (int d = 0; d < 32; ++d) q[d] = p.rq[(size_t)t * 128 + h * 32 + d];
#pragma unroll
        for (int e = 0; e < 64; ++e) o[e] = 0.f;
        const int jmax = (tb % BLK) + 63;
        for (int j = 0; j <= jmax; ++j) {
            const float* kj = p.rk + (size_t)(c0 + j) * 128 + h * 32;
            float s = 0.f;
#pragma unroll
            for (int d = 0; d < 32; ++d) s += q[d] * kj[d];
            s = (j <= i) ? s * __expf((float)(i - j) * lg) : 0.f;
            const bf16_t* vj = p.pbuf + (size_t)(c0 + j) * NINP + PC_RV + h * 64;
#pragma unroll
            for (int e = 0; e < 64; ++e) o[e] += s * bf2f(vj[e]);
        }
        const float xi = __expf((float)(i + 1) * lg);
        const float* st = p.rstate + (((size_t)b * NCH + n) * 4 + h) * 32 * 64;
        for (int d = 0; d < 32; ++d) {
            const float qd = q[d] * xi;
#pragma unroll
            for (int e = 0; e < 64; ++e) o[e] += qd * st[d * 64 + e];
        }
        float ss = 0.f;
#pragma unroll
        for (int e = 0; e < 64; ++e) ss += o[e] * o[e];
        const float rs = rsqrtf(ss * (1.0f / 64.0f) + 1e-6f);
        const float* ng = p.ret_norm_g + l * 256 + h * 64;
        const bf16_t* gp = p.pbuf + (size_t)t * NINP + PC_RG + h * 64;
        bf16_t* outp = p.mixcat + (size_t)t * 1024 + h * 64;
#pragma unroll
        for (int e = 0; e < 64; ++e) { const float g = bf2f(gp[e]); outp[e] = f2bf(g * sigmoidf_(g) * (o[e] * rs * ng[e])); }
    }
}

__device__ void ph_dil_attn(const Params& p, int l) {
    const size_t total = (size_t)NT * 4;
    for (size_t idx = (size_t)blockIdx.x * NTHREADS + threadIdx.x; idx < total; idx += (size_t)gridDim.x * NTHREADS) {
        const int h = (int)(idx / NT), t = (int)(idx % NT), pos = t % SEQ;
        float q[64], o[64];
#pragma unroll
        for (int d = 0; d < 64; ++d) { q[d] = p.dq[(size_t)t * 256 + h * 64 + d]; o[d] = 0.f; }
        float m = -1e30f, lsum = 0.f;
        for (int pat = 0; pat < 3; ++pat) {
            const int dil = pat == 0 ? 1 : (pat == 1 ? 4 : 16);
            for (int j = 0; j <= 128; ++j) {
                const int kp = pos - j * dil;
                if (kp < 0) break;
                const size_t kt = (size_t)(t - j * dil);
                const float4* kr = (const float4*)(p.dk + kt * 256 + h * 64);
                float s = 0.f;
#pragma unroll
                for (int d4 = 0; d4 < 16; ++d4) { const float4 kv = kr[d4]; s += q[d4 * 4] * kv.x + q[d4 * 4 + 1] * kv.y + q[d4 * 4 + 2] * kv.z + q[d4 * 4 + 3] * kv.w; }
                const float mn = fmaxf(m, s), c = __expf(m - mn), pe = __expf(s - mn);
                lsum = lsum * c + pe; m = mn;
                const bf16_t* vr = p.pbuf + kt * NINP + PC_DV + h * 64;
#pragma unroll
                for (int d = 0; d < 64; ++d) o[d] = o[d] * c + pe * bf2f(vr[d]);
            }
        }
        const float inv = 1.0f / lsum;
#pragma unroll
        for (int d = 0; d < 64; ++d) p.dob[(size_t)t * 256 + h * 64 + d] = o[d] * inv;
    }
}

__device__ void ph_rwkv_prep(const Params& p, int l, char* lds) {
    float* lw = (float*)lds;
    float* la = lw + 16 * 64;
    float* lg = la + 16 * 64;
    float* lv = lg + 16 * 128;
    const int tid = threadIdx.x, c = tid & 255, half = tid >> 8;
    const float* mu = p.rwkv_mu + l * 1024;
    const float* w_up = p.rwkv_w_up + (size_t)l * 64 * 256; const float* a_up = p.rwkv_a_up + (size_t)l * 64 * 256; const float* g_up = p.rwkv_g_up + (size_t)l * 128 * 256;
    const float* v_up = p.rwkv_v_up + (size_t)(l > 0 ? l - 1 : 0) * 32 * 256;
    const float* vmu = p.vres_mu + (l > 0 ? l - 1 : 0) * 32;
    for (int tb = blockIdx.x * 16; tb < NT; tb += gridDim.x * 16) {
        __syncthreads();
        for (int e = tid; e < 16 * 288; e += NTHREADS) {
            const int tt = e / 288, j = e % 288, t = tb + tt;
            const bool first = (t % SEQ) == 0;
            const bf16_t* pr = p.pbuf + (size_t)t * NINP;
            int col; float m;
            if (j < 256) { col = PC_CWD + j; m = mu[768 + j]; } else { col = PC_VRES + (j - 256); m = vmu[j - 256]; }
            const float cur = bf2f(pr[col]), prev = first ? 0.f : bf2f(pr[col - NINP]);
            const float xs = cur + (prev - cur) * m;
            if (j < 64) lw[tt * 64 + j] = tanhf(xs);
            else if (j < 128) la[tt * 64 + (j - 64)] = xs;
            else if (j < 256) lg[tt * 128 + (j - 128)] = sigmoidf_(xs);
            else lv[tt * 32 + (j - 256)] = xs;
        }
        __syncthreads();
        float aw[8], aa[8], ag[8], av[8];
#pragma unroll
        for (int i = 0; i < 8; ++i) { aw[i] = 0.f; aa[i] = 0.f; ag[i] = 0.f; av[i] = 0.f; }
        for (int m = 0; m < 64; ++m) {
            const float ww = w_up[m * 256 + c], wa = a_up[m * 256 + c];
#pragma unroll
            for (int i = 0; i < 8; ++i) { aw[i] += lw[(half * 8 + i) * 64 + m] * ww; aa[i] += la[(half * 8 + i) * 64 + m] * wa; }
        }
        for (int m = 0; m < 128; ++m) {
            const float wg = g_up[m * 256 + c];
#pragma unroll
            for (int i = 0; i < 8; ++i) ag[i] += lg[(half * 8 + i) * 128 + m] * wg;
        }
        if (l > 0) for (int m = 0; m < 32; ++m) {
            const float wv = v_up[m * 256 + c];
#pragma unroll
            for (int i = 0; i < 8; ++i) av[i] += lv[(half * 8 + i) * 32 + m] * wv;
        }
        const float w0 = p.rwkv_w0[l * 256 + c], a0 = p.rwkv_a0[l * 256 + c], kkc = p.rwkv_k_k[l * 256 + c], kac = p.rwkv_k_a[l * 256 + c];
        const float v0 = p.rwkv_v0[(l > 0 ? l - 1 : 0) * 256 + c];
        const float mr = mu[c], mk = mu[256 + c], mv = mu[512 + c];
#pragma unroll
        for (int i = 0; i < 8; ++i) {
            const int t = tb + half * 8 + i; const bool first = (t % SEQ) == 0;
            const bf16_t* pr = p.pbuf + (size_t)t * NINP;
            float r = bf2f(pr[PC_CR + c]), k = bf2f(pr[PC_CK + c]), v = bf2f(pr[PC_CV + c]);
            const float rp = first ? 0.f : bf2f(pr[PC_CR + c - NINP]), kp = first ? 0.f : bf2f(pr[PC_CK + c - NINP]), vp = first ? 0.f : bf2f(pr[PC_CV + c - NINP]);
            r = r + (rp - r) * mr; k = k + (kp - k) * mk; v = v + (vp - v) * mv;
            const float wpre = w0 + aw[i];
            const float sp = (-wpre > 20.f) ? -wpre : log1pf(__expf(-wpre));
            const float w = -sp - 0.5f;
            const float decay = __expf(-__expf(w));
            const float a = sigmoidf_(a0 + aa[i]);
            const float kkr = k * kkc;
            const float ss = wave_sum(kkr * kkr);
            const float kk = kkr / fmaxf(sqrtf(ss), 1e-12f);
            const float k2 = k * (1.0f + (a - 1.0f) * kac);
            const size_t o = (size_t)t * 256 + c;
            if (l == 0) p.vfirst[o] = v;
            else v = v + (p.vfirst[o] - v) * sigmoidf_(v0 + av[i]);
            p.sr[o] = r; p.sw[o] = decay; p.sk[o] = k2; p.sv[o] = v; p.sa[o] = -kk; p.sb[o] = kk * a; p.sg[o] = ag[i];
        }
    }
}

__device__ void ph_rwkv_scan(const Params& p, int l) {
    const int lane = threadIdx.x & 63, wv = threadIdx.x >> 6;
    const int nwaves = NBATCH * 4 * 16;
    for (int u = blockIdx.x + wv * gridDim.x; u < nwaves; u += gridDim.x * (NTHREADS / 64)) {
        const int bh = u >> 4, b = bh >> 2, h = bh & 3, i0 = (u & 15) * 4, rr = lane >> 4, c4 = (lane & 15) * 4;
        float s0 = 0.f, s1 = 0.f, s2 = 0.f, s3 = 0.f;
        const size_t base = (size_t)b * SEQ * 256 + h * 64;
        float4 ca[4], cw[4], cb[4], ck[4], cr[4]; float cv[4];
        float4 na[4], nw_[4], nb_[4], nk[4], nr[4]; float nv[4];
#pragma unroll
        for (int i = 0; i < 4; ++i) {
            const size_t o = base + (size_t)i * 256;
            ca[i] = *(const float4*)(p.sa + o + c4); cw[i] = *(const float4*)(p.sw + o + c4); cb[i] = *(const float4*)(p.sb + o + c4);
            ck[i] = *(const float4*)(p.sk + o + c4); cr[i] = *(const float4*)(p.sr + o + c4); cv[i] = p.sv[o + i0 + rr];
        }
        for (int t = 0; t < SEQ; t += 4) {
            if (t + 4 < SEQ) {
#pragma unroll
                for (int i = 0; i < 4; ++i) {
                    const size_t o = base + (size_t)(t + 4 + i) * 256;
                    na[i] = *(const float4*)(p.sa + o + c4); nw_[i] = *(const float4*)(p.sw + o + c4); nb_[i] = *(const float4*)(p.sb + o + c4);
                    nk[i] = *(const float4*)(p.sk + o + c4); nr[i] = *(const float4*)(p.sr + o + c4); nv[i] = p.sv[o + i0 + rr];
                }
            }
#pragma unroll
            for (int i = 0; i < 4; ++i) {
                const float4 a = ca[i], w = cw[i], bb = cb[i], k = ck[i], r = cr[i]; const float v = cv[i];
                float sa = s0 * a.x + s1 * a.y + s2 * a.z + s3 * a.w;
                sa = grp16_sum(sa);
                s0 = s0 * w.x + sa * bb.x + v * k.x; s1 = s1 * w.y + sa * bb.y + v * k.y; s2 = s2 * w.z + sa * bb.z + v * k.z; s3 = s3 * w.w + sa * bb.w + v * k.w;
                float y = s0 * r.x + s1 * r.y + s2 * r.z + s3 * r.w;
                y = grp16_sum(y);
                if ((lane & 15) == 0) p.sy[base + (size_t)(t + i) * 256 + i0 + rr] = y;
            }
#pragma unroll
            for (int i = 0; i < 4; ++i) { ca[i] = na[i]; cw[i] = nw_[i]; cb[i] = nb_[i]; ck[i] = nk[i]; cr[i] = nr[i]; cv[i] = nv[i]; }
        }
    }
}

__device__ void ph_mla_up(const Params& p, int l, char* lds) {
    const int nq = (NT / 128) * 3, nkv = (NT / 128) * 4;
    for (int u = blockIdx.x; u < nq + nkv; u += gridDim.x) {
        if (u < nq) {
            const int mt = u / 3, nt = u % 3;
            float* out = p.qu + (size_t)mt * 128 * 384 + nt * 128; const float* rs = p.rsq + mt * 128;
            gemm_tile128(p.pbuf + (size_t)mt * 128 * NINP + PC_MQ, NINP, nullptr, 128, p.wq_t + ((size_t)l * 384 + nt * 128) * 256, 256, 256, lds,
                         [=](int r, int c, f32x4 v) mutable { const float s = rs[r]; *(f32x4*)(out + (size_t)r * 384 + c) = v * s; });
        } else {
            const int uu = u - nq, mt = uu / 4, nt = uu % 4;
            float* out = p.kvu + (size_t)mt * 128 * 512 + nt * 128; const float* rs = p.rskv + mt * 128;
            gemm_tile128(p.pbuf + (size_t)mt * 128 * NINP + PC_MKV, NINP, nullptr, 128, p.wkv_t + ((size_t)l * 512 + nt * 128) * 128, 128, 128, lds,
                         [=](int r, int c, f32x4 v) mutable { const float s = rs[r]; *(f32x4*)(out + (size_t)r * 512 + c) = v * s; });
        }
    }
}

__device__ void ph_mla_attn(const Params& p, int l, char* lds) {
    float* Ks = (float*)lds;
    float* Vs = Ks + 128 * 96;
    const int tid = threadIdx.x, part = tid & 1, qi = tid >> 1;
    const float scale = 0.10206207261596575f;
    for (int it = blockIdx.x; it < 16 * 32; it += gridDim.x) {
        const int bh = it & 15, qb0 = it >> 4, qb = (qb0 < 16) ? qb0 : (47 - qb0);
        const int b = bh >> 2, h = bh & 3, q0 = qb * 256, t = b * SEQ + q0 + qi, pos = q0 + qi;
        float q[48], o[32];
        {
            const float* qp = p.qu + (size_t)t * 384 + h * 96;
#pragma unroll
            for (int i = 0; i < 48; ++i) q[i] = qp[part * 48 + i] * scale;
            if (part == 1) {
#pragma unroll
                for (int j = 0; j < 16; ++j) {
                    const float c = p.tab_mla[(pos * 16 + j) * 2], s = p.tab_mla[(pos * 16 + j) * 2 + 1], x1 = qp[64 + j], x2 = qp[80 + j];
                    q[16 + j] = (x1 * c - x2 * s) * scale; q[32 + j] = (x1 * s + x2 * c) * scale;
                }
            }
        }
#pragma unroll
        for (int e = 0; e < 32; ++e) o[e] = 0.f;
        float m = -1e30f, lsum = 0.f;
        const int nkt = (q0 + 256) / 128;
        for (int kt = 0; kt < nkt; ++kt) {
            __syncthreads();
            const int kb = b * SEQ + kt * 128;
            for (int e = tid; e < 128 * 24; e += NTHREADS) {
                const int j = e / 24, c4 = e % 24;
                float4 v;
                if (c4 < 16) v = *(const float4*)(p.kvu + (size_t)(kb + j) * 512 + h * 128 + c4 * 4);
                else v = *(const float4*)(p.kpe + (size_t)(kb + j) * 32 + (c4 - 16) * 4);
                *(float4*)(Ks + j * 96 + c4 * 4) = v;
            }
            for (int e = tid; e < 128 * 16; e += NTHREADS) {
                const int j = e >> 4, c4 = e & 15;
                *(float4*)(Vs + j * 64 + c4 * 4) = *(const float4*)(p.kvu + (size_t)(kb + j) * 512 + h * 128 + 64 + c4 * 4);
            }
            __syncthreads();
            const int kbase = kt * 128;
            for (int j8 = 0; j8 < 128; j8 += 8) {
                float s[8];
#pragma unroll
                for (int jj = 0; jj < 8; ++jj) {
                    const float4* kr = (const float4*)(Ks + (j8 + jj) * 96 + part * 48);
                    float a = 0.f;
#pragma unroll
                    for (int d4 = 0; d4 < 12; ++d4) { const float4 kv = kr[d4]; a += q[d4 * 4] * kv.x + q[d4 * 4 + 1] * kv.y + q[d4 * 4 + 2] * kv.z + q[d4 * 4 + 3] * kv.w; }
                    a += __shfl_xor(a, 1);
                    s[jj] = (kbase + j8 + jj <= pos) ? a : -1e30f;
                }
                float mn = m;
#pragma unroll
                for (int jj = 0; jj < 8; ++jj) mn = fmaxf(mn, s[jj]);
                const float c = __expf(m - mn); m = mn; lsum *= c;
#pragma unroll
                for (int e = 0; e < 32; ++e) o[e] *= c;
#pragma unroll
                for (int jj = 0; jj < 8; ++jj) {
                    const float pe = (s[jj] > -1e29f) ? __expf(s[jj] - mn) : 0.f;
                    lsum += pe;
                    const float4* vr = (const float4*)(Vs + (j8 + jj) * 64 + part * 32);
#pragma unroll
                    for (int e4 = 0; e4 < 8; ++e4) { const float4 vv = vr[e4]; o[e4 * 4] += pe * vv.x; o[e4 * 4 + 1] += pe * vv.y; o[e4 * 4 + 2] += pe * vv.z; o[e4 * 4 + 3] += pe * vv.w; }
                }
            }
        }
        const float inv = 1.0f / lsum;
        float* op = p.mo + (size_t)t * 256 + h * 64 + part * 32;
#pragma unroll
        for (int e = 0; e < 32; ++e) op[e] = o[e] * inv;
        __syncthreads();
    }
}

__device__ void ph_finalize_mix(const Params& p, int l) {
    const int lane = threadIdx.x & 63, gw = blockIdx.x * (NTHREADS / 64) + (threadIdx.x >> 6), nw = gridDim.x * (NTHREADS / 64);
    const int c = lane * 4, h = lane >> 4;
    for (int t = gw; t < NT; t += nw) {
        bf16_t* outp = p.mixcat + (size_t)t * 1024;
        {
            const float4 v = *(const float4*)(p.dob + (size_t)t * 256 + c);
            const float ss = wave_sum(v.x * v.x + v.y * v.y + v.z * v.z + v.w * v.w);
            const float rs = rsqrtf(ss * (1.0f / 256.0f) + 1e-6f);
            const float4 g = *(const float4*)(p.dil_norm_g + l * 256 + c);
            ushort4 o; o.x = f2bf(v.x * rs * g.x); o.y = f2bf(v.y * rs * g.y); o.z = f2bf(v.z * rs * g.z); o.w = f2bf(v.w * rs * g.w);
            *(ushort4*)(outp + 256 + c) = o;
        }
        {
            const size_t o4 = (size_t)t * 256 + c;
            const float4 y = *(const float4*)(p.sy + o4), r = *(const float4*)(p.sr + o4), k = *(const float4*)(p.sk + o4), v = *(const float4*)(p.sv + o4), g = *(const float4*)(p.sg + o4);
            const float mean = grp16_sum(y.x + y.y + y.z + y.w) * (1.0f / 64.0f);
            const float dx = y.x - mean, dy = y.y - mean, dz = y.z - mean, dw = y.w - mean;
            const float var = grp16_sum(dx * dx + dy * dy + dz * dz + dw * dw) * (1.0f / 64.0f);
            const float rs = rsqrtf(var + 64e-5f);
            const float4 lg = *(const float4*)(p.rwkv_ln_g + l * 256 + c), lb = *(const float4*)(p.rwkv_ln_b + l * 256 + c), rk = *(const float4*)(p.rwkv_r_k + l * 256 + c);
            const float bonus = grp16_sum(r.x * k.x * rk.x + r.y * k.y * rk.y + r.z * k.z * rk.z + r.w * k.w * rk.w);
            ushort4 o;
            o.x = f2bf((dx * rs * lg.x + lb.x + bonus * v.x) * g.x); o.y = f2bf((dy * rs * lg.y + lb.y + bonus * v.y) * g.y);
            o.z = f2bf((dz * rs * lg.z + lb.z + bonus * v.z) * g.z); o.w = f2bf((dw * rs * lg.w + lb.w + bonus * v.w) * g.w);
            *(ushort4*)(outp + 512 + c) = o;
        }
        {
            const float4 v = *(const float4*)(p.mo + (size_t)t * 256 + c);
            const float ss = wave_sum(v.x * v.x + v.y * v.y + v.z * v.z + v.w * v.w);
            const float rs = rsqrtf(ss * (1.0f / 256.0f) + 1e-6f);
            const float4 g = *(const float4*)(p.mla_out_norm_g + l * 256 + c);
            ushort4 o; o.x = f2bf(v.x * rs * g.x); o.y = f2bf(v.y * rs * g.y); o.z = f2bf(v.z * rs * g.z); o.w = f2bf(v.w * rs * g.w);
            *(ushort4*)(outp + 768 + c) = o;
        }
    }
    (void)h;
}

__device__ void ph_outproj(const Params& p, int l, char* lds) {
    const float* xin = (l == 0) ? p.x : p.xf;
    const bf16_t* Bt = p.wout_t + (size_t)l * 1024 * 1024;
    for (int u = blockIdx.x; u < (NT / 128) * 8; u += gridDim.x) {
        const int mt = u >> 3, nt = u & 7;
        const size_t o0 = (size_t)mt * 128 * 1024 + nt * 128;
        gemm_tile128(p.mixcat + (size_t)mt * 128 * 1024, 1024, nullptr, 128, Bt + (size_t)nt * 128 * 1024, 1024, 1024, lds,
                     [=](int r, int c, f32x4 v) mutable { const size_t o = o0 + (size_t)r * 1024 + c; const f32x4 xv = *(const f32x4*)(xin + o); *(f32x4*)(p.y1 + o) = xv * ALPHA + v; });
    }
}

__device__ void ph_ln1_router(const Params& p, int l, char* lds) {
    int* hist = (int*)lds;
    int* base = hist + 32;
    int* le = base + 32;
    float* lgt = (float*)(le + 512);
    int* lrank = (int*)(lgt + 512);
    const int tid = threadIdx.x, lane = tid & 63, wv = tid >> 6;
    const float* g1 = p.ln1_g + l * 1024; const float* b1 = p.ln1_b + l * 1024;
    const float* rw = p.router_w + (size_t)l * 1024 * 32; const float* rb = p.router_b + l * 32;
    for (int tb = blockIdx.x * 128; tb < NT; tb += gridDim.x * 128) {
        __syncthreads();
        if (tid < 32) hist[tid] = 0;
        __syncthreads();
        for (int tt = wv; tt < 128; tt += 8) {
            const int t = tb + tt;
            float4 y[4]; float s = 0.f;
#pragma unroll
            for (int m = 0; m < 4; ++m) { y[m] = *(const float4*)(p.y1 + (size_t)t * 1024 + m * 256 + lane * 4); s += y[m].x + y[m].y + y[m].z + y[m].w; }
            const float mean = wave_sum(s) * (1.0f / 1024.0f);
            float q = 0.f;
#pragma unroll
            for (int m = 0; m < 4; ++m) { y[m].x -= mean; y[m].y -= mean; y[m].z -= mean; y[m].w -= mean; q += y[m].x * y[m].x + y[m].y * y[m].y + y[m].z * y[m].z + y[m].w * y[m].w; }
            const float rs = rsqrtf(wave_sum(q) * (1.0f / 1024.0f) + 1e-5f);
            float lg[32];
#pragma unroll
            for (int e = 0; e < 32; ++e) lg[e] = 0.f;
#pragma unroll 1
            for (int m = 0; m < 4; ++m) {
                const int c = m * 256 + lane * 4;
                const float4 g = *(const float4*)(g1 + c), bb = *(const float4*)(b1 + c);
                const float4 yv = *(const float4*)(p.y1 + (size_t)t * 1024 + c);
                float4 xv; xv.x = (yv.x - mean) * rs * g.x + bb.x; xv.y = (yv.y - mean) * rs * g.y + bb.y; xv.z = (yv.z - mean) * rs * g.z + bb.z; xv.w = (yv.w - mean) * rs * g.w + bb.w;
                *(float4*)(p.y1 + (size_t)t * 1024 + c) = xv;
                ushort4 ob; ob.x = f2bf(xv.x); ob.y = f2bf(xv.y); ob.z = f2bf(xv.z); ob.w = f2bf(xv.w);
                *(ushort4*)(p.x1b + (size_t)t * 1024 + c) = ob;
                const float xs[4] = {xv.x, xv.y, xv.z, xv.w};
#pragma unroll
                for (int i = 0; i < 4; ++i) {
                    const float4* wr = (const float4*)(rw + (size_t)(c + i) * 32);
#pragma unroll
                    for (int e4 = 0; e4 < 8; ++e4) { const float4 w = wr[e4]; lg[e4 * 4] += xs[i] * w.x; lg[e4 * 4 + 1] += xs[i] * w.y; lg[e4 * 4 + 2] += xs[i] * w.z; lg[e4 * 4 + 3] += xs[i] * w.w; }
                }
            }
#pragma unroll
            for (int e = 0; e < 32; ++e) lg[e] = wave_sum(lg[e]) + rb[e];
            int idx[4]; float val[4];
#pragma unroll
            for (int k = 0; k < 4; ++k) {
                float bv = -3.0e38f; int bi = 0;
#pragma unroll
                for (int e = 0; e < 32; ++e) { if (lg[e] > bv) { bv = lg[e]; bi = e; } }
                idx[k] = bi; val[k] = bv;
#pragma unroll
                for (int e = 0; e < 32; ++e) if (e == bi) lg[e] = -3.0e38f;
            }
            const float e1 = __expf(val[1] - val[0]), e2 = __expf(val[2] - val[0]), e3 = __expf(val[3] - val[0]);
            const float inv = 1.0f / (1.0f + e1 + e2 + e3);
            const float gt[4] = {inv, e1 * inv, e2 * inv, e3 * inv};
            if (lane < 4) {
                int ee = idx[0]; float gg = gt[0];
                if (lane == 1) { ee = idx[1]; gg = gt[1]; } else if (lane == 2) { ee = idx[2]; gg = gt[2]; } else if (lane == 3) { ee = idx[3]; gg = gt[3]; }
                le[tt * 4 + lane] = ee; lgt[tt * 4 + lane] = gg;
                lrank[tt * 4 + lane] = atomicAdd(&hist[ee], 1);
            }
        }
        __syncthreads();
        if (tid < 32) base[tid] = atomicAdd(&p.cnt[l * NE + tid], hist[tid]);
        __syncthreads();
        {
            const int tt = tid >> 2, t = tb + tt, e = le[tid], pos = base[e] + lrank[tid];
            p.toke[(size_t)t * 4 + (tid & 3)] = e; p.tokpos[(size_t)t * 4 + (tid & 3)] = pos;
            p.rowtok[(size_t)e * NT + pos] = t; p.rowgate[(size_t)e * NT + pos] = lgt[tid];
        }
    }
}

__device__ __forceinline__ void moe_tile_prefix(const Params& p, int l, int* tb  ) {
    __syncthreads();
    if (threadIdx.x == 0) { int a = 0; for (int e = 0; e < NE; ++e) { tb[e] = a; a += (p.cnt[l * NE + e] + MOE_TM - 1) / MOE_TM; } tb[NE] = a; }
    __syncthreads();
}
__device__ void ph_moe_gu(const Params& p, int l, char* lds) {
    int* tb = (int*)(lds + 40960);
    moe_tile_prefix(p, l, tb);
    const int ntile = tb[NE], nunits = ntile * 16;
    for (int u = blockIdx.x; u < nunits; u += gridDim.x) {
        const int mtg = u >> 4, nt = u & 15;
        int e = 0; while (tb[e + 1] <= mtg) ++e;
        const int mt = mtg - tb[e], cnt = p.cnt[l * NE + e], nvalid = min(MOE_TM, cnt - mt * MOE_TM);
        const float* bias = p.b_gu + ((size_t)l * NE + e) * 2048 + nt * 128;
        bf16_t* out = p.act + (size_t)mtg * MOE_TM * 1024 + nt * 64;
        gemm_tile128(p.x1b, 1024, p.rowtok + (size_t)e * NT + mt * MOE_TM, nvalid, p.wgu_t + (((size_t)l * NE + e) * 2048 + nt * 128) * 1024, 1024, 1024, lds,
                     [=](int r, int c, f32x4 v) mutable {
                         const f32x4 bv = *(const f32x4*)(bias + c); v = v + bv;
                         const float g0 = fminf(v[0], 7.0f), l0 = fminf(fmaxf(v[1], -7.0f), 7.0f), g1 = fminf(v[2], 7.0f), l1 = fminf(fmaxf(v[3], -7.0f), 7.0f);
                         const float a0 = g0 * sigmoidf_(1.702f * g0) * (l0 + 1.0f), a1 = g1 * sigmoidf_(1.702f * g1) * (l1 + 1.0f);
                         ushort2 o; o.x = f2bf(a0); o.y = f2bf(a1); *(ushort2*)(out + (size_t)r * 1024 + (c >> 1)) = o; });
    }
}
__device__ void ph_moe_dn(const Params& p, int l, char* lds) {
    int* tb = (int*)(lds + 40960);
    moe_tile_prefix(p, l, tb);
    const int ntile = tb[NE], nunits = ntile * 8;
    for (int u = blockIdx.x; u < nunits; u += gridDim.x) {
        const int mtg = u >> 3, nt = u & 7;
        int e = 0; while (tb[e + 1] <= mtg) ++e;
        const int mt = mtg - tb[e], cnt = p.cnt[l * NE + e], nvalid = min(MOE_TM, cnt - mt * MOE_TM);
        const float* bias = p.b_dn + ((size_t)l * NE + e) * 1024 + nt * 128;
        const float* gate = p.rowgate + (size_t)e * NT + mt * MOE_TM;
        bf16_t* out = p.yb + (size_t)mtg * MOE_TM * 1024 + nt * 128;
        gemm_tile128(p.act + (size_t)mtg * MOE_TM * 1024, 1024, nullptr, 128, p.wdn_t + (((size_t)l * NE + e) * 1024 + nt * 128) * 1024, 1024, 1024, lds,
                     [=](int r, int c, f32x4 v) mutable {
                         const float g = (r < nvalid) ? gate[r] : 0.f;
                         const f32x4 bv = *(const f32x4*)(bias + c); v = (v + bv) * g;
                         ushort4 o; o.x = f2bf(v[0]); o.y = f2bf(v[1]); o.z = f2bf(v[2]); o.w = f2bf(v[3]); *(ushort4*)(out + (size_t)r * 1024 + c) = o; });
    }
}
__device__ void ph_combine_ln2(const Params& p, int l, char* lds) {
    int* tb = (int*)(lds + 40960);
    moe_tile_prefix(p, l, tb);
    const int lane = threadIdx.x & 63, gw = blockIdx.x * (NTHREADS / 64) + (threadIdx.x >> 6), nw = gridDim.x * (NTHREADS / 64);
    const float* g2 = p.ln2_g + l * 1024; const float* b2 = p.ln2_b + l * 1024;
    float* dstf = (l == DEPTH - 1) ? p.out : p.xf;
    for (int t = gw; t < NT; t += nw) {
        size_t rows[4];
#pragma unroll
        for (int k = 0; k < 4; ++k) { const int e = p.toke[(size_t)t * 4 + k], pos = p.tokpos[(size_t)t * 4 + k]; rows[k] = (size_t)tb[e] * MOE_TM + pos; }
        float4 y[4]; float s = 0.f;
#pragma unroll
        for (int m = 0; m < 4; ++m) {
            const int c = m * 256 + lane * 4;
            float4 v = *(const float4*)(p.y1 + (size_t)t * 1024 + c);
            v.x *= ALPHA; v.y *= ALPHA; v.z *= ALPHA; v.w *= ALPHA;
#pragma unroll
            for (int k = 0; k < 4; ++k) { const ushort4 yb = *(const ushort4*)(p.yb + rows[k] * 1024 + c); v.x += bf2f(yb.x); v.y += bf2f(yb.y); v.z += bf2f(yb.z); v.w += bf2f(yb.w); }
            y[m] = v; s += v.x + v.y + v.z + v.w;
        }
        const float mean = wave_sum(s) * (1.0f / 1024.0f);
        float q = 0.f;
#pragma unroll
        for (int m = 0; m < 4; ++m) { y[m].x -= mean; y[m].y -= mean; y[m].z -= mean; y[m].w -= mean; q += y[m].x * y[m].x + y[m].y * y[m].y + y[m].z * y[m].z + y[m].w * y[m].w; }
        const float rs = rsqrtf(wave_sum(q) * (1.0f / 1024.0f) + 1e-5f);
#pragma unroll
        for (int m = 0; m < 4; ++m) {
            const int c = m * 256 + lane * 4;
            const float4 g = *(const float4*)(g2 + c), bb = *(const float4*)(b2 + c);
            float4 xv; xv.x = y[m].x * rs * g.x + bb.x; xv.y = y[m].y * rs * g.y + bb.y; xv.z = y[m].z * rs * g.z + bb.z; xv.w = y[m].w * rs * g.w + bb.w;
            *(float4*)(dstf + (size_t)t * 1024 + c) = xv;
            ushort4 ob; ob.x = f2bf(xv.x); ob.y = f2bf(xv.y); ob.z = f2bf(xv.z); ob.w = f2bf(xv.w);
            *(ushort4*)(p.xb + (size_t)t * 1024 + c) = ob;
        }
    }
}

constexpr int PH_PRO = 0, PH_INPROJ = 1, PH_PREP = 2, PH_RETKV = 3, PH_RETSCAN = 4, PH_RETOUT = 5, PH_DIL = 6, PH_RWKVPREP = 7, PH_RWKVSCAN = 8, PH_MLAUP = 9,
              PH_MLAATTN = 10, PH_FINAL = 11, PH_OUTPROJ = 12, PH_LN1 = 13, PH_GU = 14, PH_DN = 15, PH_LN2 = 16;

template <int ph>
__global__ void __launch_bounds__(NTHREADS, 2) mega(Params p, int l) {
    extern __shared__ __attribute__((aligned(16))) char lds[];
    if (ph == PH_PRO) ph_prologue(p, lds);
    if (ph == PH_INPROJ) ph_inproj(p, l, lds);
    if (ph == PH_PREP) ph_rope_prep(p, l);
    if (ph == PH_RETKV) ph_ret_kv(p, l);
    if (ph == PH_RETSCAN) ph_ret_scan(p, l);
    if (ph == PH_RETOUT) ph_ret_out(p, l);
    if (ph == PH_DIL) ph_dil_attn(p, l);
    if (ph == PH_RWKVPREP) ph_rwkv_prep(p, l, lds);
    if (ph == PH_RWKVSCAN) ph_rwkv_scan(p, l);
    if (ph == PH_MLAUP) ph_mla_up(p, l, lds);
    if (ph == PH_MLAATTN) ph_mla_attn(p, l, lds);
    if (ph == PH_FINAL) ph_finalize_mix(p, l);
    if (ph == PH_OUTPROJ) ph_outproj(p, l, lds);
    if (ph == PH_LN1) ph_ln1_router(p, l, lds);
    if (ph == PH_GU) ph_moe_gu(p, l, lds);
    if (ph == PH_DN) ph_moe_dn(p, l, lds);
    if (ph == PH_LN2) ph_combine_ln2(p, l, lds);
}
template <int PH> static void launch_ph(const Params& p, int l, hipStream_t stream) {
    static bool attr_set = false;
    if (!attr_set) { (void)hipFuncSetAttribute((const void*)mega<PH>, hipFuncAttributeMaxDynamicSharedMemorySize, LDS_BYTES); attr_set = true; }
    hipLaunchKernelGGL(mega<PH>, dim3(256), dim3(NTHREADS), LDS_BYTES, stream, p, l);
}
template <int PH> static void launch_layer(const Params& p, int l, hipStream_t stream) {
    launch_ph<PH>(p, l, stream);
    if constexpr (PH < PH_LN2) launch_layer<PH + 1>(p, l, stream);
}

struct Carver { char* base; size_t off; template <class T> T* take(size_t n) { T* r = (T*)(base + off); off += ((n * sizeof(T) + 255) / 256) * 256; return r; } };

extern "C" void kernel_launch(void* const* d_in, const int* in_sizes, int n_in, void* d_out, int out_size, void* d_ws, size_t ws_size, hipStream_t stream) {
    Params p; memset(&p, 0, sizeof(p));
    const float** ip = (const float**)&p;
    for (int i = 0; i < 35; ++i) ip[i] = (const float*)d_in[i];
    p.out = (float*)d_out;
    Carver c{(char*)d_ws, 0};
    p.bar = c.take<unsigned>(4096); p.cnt = c.take<int>(DEPTH * NE);
    p.tab_ret = c.take<float>((size_t)SEQ * 32); p.tab_dil = c.take<float>((size_t)SEQ * 16); p.tab_mla = c.take<float>((size_t)SEQ * 32);
    p.win_t = c.take<bf16_t>((size_t)DEPTH * NINP * 1024); p.wout_t = c.take<bf16_t>((size_t)DEPTH * 1024 * 1024);
    p.wgu_t = c.take<bf16_t>((size_t)DEPTH * NE * 2048 * 1024); p.wdn_t = c.take<bf16_t>((size_t)DEPTH * NE * 1024 * 1024);
    p.wq_t = c.take<bf16_t>((size_t)DEPTH * 384 * 256); p.wkv_t = c.take<bf16_t>((size_t)DEPTH * 512 * 128);
    p.xf = c.take<float>((size_t)NT * DM); p.xb = c.take<bf16_t>((size_t)NT * DM); p.pbuf = c.take<bf16_t>((size_t)NT * NINP);
    p.mixcat = c.take<bf16_t>((size_t)NT * DM); p.y1 = c.take<float>((size_t)NT * DM); p.x1b = c.take<bf16_t>((size_t)NT * DM);
    p.rq = c.take<float>((size_t)NT * 128); p.rk = c.take<float>((size_t)NT * 128);
    p.rkv = c.take<float>((size_t)NBATCH * NCH * 4 * 32 * 64); p.rstate = c.take<float>((size_t)NBATCH * NCH * 4 * 32 * 64);
    p.dq = c.take<float>((size_t)NT * 256); p.dk = c.take<float>((size_t)NT * 256); p.dob = c.take<float>((size_t)NT * 256);
    p.sr = c.take<float>((size_t)NT * 256); p.sw = c.take<float>((size_t)NT * 256); p.sk = c.take<float>((size_t)NT * 256); p.sv = c.take<float>((size_t)NT * 256);
    p.sa = c.take<float>((size_t)NT * 256); p.sb = c.take<float>((size_t)NT * 256); p.sg = c.take<float>((size_t)NT * 256); p.sy = c.take<float>((size_t)NT * 256);
    p.vfirst = c.take<float>((size_t)NT * 256);
    p.rsq = c.take<float>(NT); p.rskv = c.take<float>(NT); p.kpe = c.take<float>((size_t)NT * 32);
    p.qu = c.take<float>((size_t)NT * 384); p.kvu = c.take<float>((size_t)NT * 512); p.mo = c.take<float>((size_t)NT * 256);
    p.rowtok = c.take<int>((size_t)NE * NT); p.toke = c.take<int>((size_t)NT * 4); p.tokpos = c.take<int>((size_t)NT * 4); p.rowgate = c.take<float>((size_t)NE * NT);
    p.act = c.take<bf16_t>((size_t)MOE_MAXROWS * 1024); p.yb = c.take<bf16_t>((size_t)MOE_MAXROWS * 1024);
    if (c.off > ws_size) { fprintf(stderr, "workspace too small: need %zu have %zu\n", c.off, ws_size); return; }

    launch_ph<PH_PRO>(p, 0, stream);
    for (int l = 0; l < DEPTH; ++l) launch_layer<PH_INPROJ>(p, l, stream);
}
```

```cpp
#include <hip/hip_runtime.h>
#include <stdint.h>
#include <string.h>
#include <stdio.h>

typedef unsigned short bf16_t;
typedef short bf16x8 __attribute__((ext_vector_type(8)));
typedef float f32x4 __attribute__((ext_vector_type(4)));
typedef unsigned u32x4 __attribute__((ext_vector_type(4)));

constexpr int NT = 32768, SEQ = 8192, NBATCH = 4, DM = 1024, NIN = 2976, NINP = 3072, DEPTH = 4, NE = 32, TOPK = 4;
constexpr int BLK = 128, NCH = SEQ / BLK;
constexpr float ALPHA = 1.6817928305074292f;
constexpr int PC_RQ = 0, PC_RK = 128, PC_RV = 256, PC_RG = 512, PC_DQ = 768, PC_DK = 1024, PC_DV = 1280;
constexpr int PC_C = 1536, PC_CR = 1536, PC_CK = 1792, PC_CV = 2048, PC_CWD = 2304, PC_CAD = 2368, PC_CGD = 2432;
constexpr int PC_MQ = 2560, PC_MKV = 2816, PC_MKR = 2944, PC_VRES = 2976;
constexpr int MOE_TM = 128;
constexpr int MOE_MAXROWS = NT * TOPK + NE * MOE_TM;
constexpr int NTHREADS = 512;
constexpr int LDS_BYTES = 147456;

__device__ __forceinline__ bf16_t f2bf(float f) { unsigned u = __float_as_uint(f); u += 0x7fffu + ((u >> 16) & 1u); return (bf16_t)(u >> 16); }
__device__ __forceinline__ float bf2f(bf16_t h) { return __uint_as_float(((unsigned)h) << 16); }
__device__ __forceinline__ float wave_sum(float v) { for (int o = 32; o; o >>= 1) v += __shfl_xor(v, o); return v; }
__device__ __forceinline__ float grp16_sum(float v) { for (int o = 8; o; o >>= 1) v += __shfl_xor(v, o); return v; }
__device__ __forceinline__ float sigmoidf_(float x) { return 1.0f / (1.0f + __expf(-x)); }

#define XB_TMO      128
#define XB_XCNT(j)  (256  + 64 * (j))
#define XB_XSUB(j)  (1280 + 64 * (j))
#define XB_XGEN(j)  (2304 + 64 * (j))
#define XB_TOP      3328
#define XB_TOPGEN   3392
#define XCD_BAR_WORDS 3456
#define XB_SPIN_CAP (1u << 22)
#define LAS __attribute__((address_space(3)))
__device__ __forceinline__ unsigned xb_ld(unsigned* p)              { return __hip_atomic_load(p, __ATOMIC_RELAXED, __HIP_MEMORY_SCOPE_AGENT); }
__device__ __forceinline__ unsigned xb_add(unsigned* p, unsigned v) { return __hip_atomic_fetch_add(p, v, __ATOMIC_RELAXED, __HIP_MEMORY_SCOPE_AGENT); }
__device__ __forceinline__ unsigned xb_xcc_id() { return (unsigned)__builtin_amdgcn_s_getreg((3 << 11) | 20) & 0xFu; }
#define XB_SPIN(cond, bar) do { unsigned _sp = 0; while (cond) { __builtin_amdgcn_s_sleep(1); \
    if ((++_sp & 255u) == 0u) { if (xb_ld(&(bar)[XB_TMO])) break; if (_sp > XB_SPIN_CAP) { atomicAdd(&(bar)[XB_TMO], 1u); break; } } } } while (0)
struct XcdBarrier { unsigned* bar; unsigned x; volatile LAS unsigned* st; };
__device__ __forceinline__ XcdBarrier xcd_barrier_post(unsigned* bar, volatile LAS unsigned* st) {
    XcdBarrier b; b.bar = bar; b.x = xb_xcc_id(); b.st = st;
    if (threadIdx.x == 0) (void)xb_add(&bar[XB_XCNT(b.x)], 1u);
    return b;
}
__device__ __forceinline__ void xcd_barrier_complete(unsigned* bar, unsigned x, unsigned& nloc, unsigned& nx) {
    const unsigned G = gridDim.x * gridDim.y * gridDim.z;
    unsigned sum, cnt, mine, sp = 0u;
    for (;;) {
        sum = 0u; cnt = 0u; mine = 0u;
#pragma unroll
        for (unsigned j = 0; j < 16; ++j) { const unsigned c = xb_ld(&bar[XB_XCNT(j)]); sum += c; cnt += (c > 0u) ? 1u : 0u; mine = (j == x) ? c : mine; }
        if (sum == G) break;
        __builtin_amdgcn_s_sleep(1);
        if ((++sp & 255u) == 0u) { if (xb_ld(&bar[XB_TMO])) break; if (sp > XB_SPIN_CAP) { atomicAdd(&bar[XB_TMO], 1u); break; } }
    }
    nloc = mine > 0u ? mine : 1u; nx = cnt > 0u ? cnt : 1u;
}
__device__ __forceinline__ void xcd_barrier(const XcdBarrier& b) {
    asm volatile("s_waitcnt vmcnt(0)" ::: "memory");
    __syncthreads();
    if (threadIdx.x == 0) {
        unsigned* bar = b.bar;
        __builtin_amdgcn_s_waitcnt(0);
        unsigned nloc = b.st[0], nx = b.st[1];
        if (nloc == 0u) { xcd_barrier_complete(bar, b.x, nloc, nx); b.st[0] = nloc; b.st[1] = nx; }
        const unsigned old = xb_add(&bar[XB_XSUB(b.x)], 1u);
        const unsigned gen = old / nloc;
        if (old + 1u == (gen + 1u) * nloc) {
            __builtin_amdgcn_fence(__ATOMIC_RELEASE, "agent");
            asm volatile("s_waitcnt vmcnt(0)" ::: "memory");
            const unsigned og = xb_add(&bar[XB_TOP], 1u);
            const unsigned tg = og / nx;
            if (og + 1u == (tg + 1u) * nx) xb_add(&bar[XB_TOPGEN], 1u);
            else XB_SPIN(xb_ld(&bar[XB_TOPGEN]) == tg, bar);
            __builtin_amdgcn_fence(__ATOMIC_ACQUIRE, "agent");
            xb_add(&bar[XB_XGEN(b.x)], 1u);
            asm volatile("s_waitcnt vmcnt(0)" ::: "memory");
        } else {
            XB_SPIN(xb_ld(&bar[XB_XGEN(b.x)]) == gen, bar);
            __builtin_amdgcn_fence(__ATOMIC_ACQUIRE, "agent");
            asm volatile("s_waitcnt vmcnt(0)" ::: "memory");
        }
    }
    __syncthreads();
}

struct Params {
    const float *x, *w_in, *w_out, *ret_norm_g, *dil_norm_g, *rwkv_mu, *rwkv_w0, *rwkv_w_up, *rwkv_a0, *rwkv_a_up, *rwkv_g_up, *rwkv_k_k, *rwkv_k_a,
        *rwkv_r_k, *rwkv_ln_g, *rwkv_ln_b, *vres_down, *vres_mu, *rwkv_v0, *rwkv_v_up, *mla_q_norm_g, *mla_w_q_up, *mla_kv_norm_g, *mla_w_kv_up,
        *mla_out_norm_g, *ln1_g, *ln1_b, *router_w, *router_b, *w_gu, *b_gu, *w_dn, *b_dn, *ln2_g, *ln2_b;
    float* out;
    unsigned* bar; int* cnt;
    float *tab_ret, *tab_dil, *tab_mla;
    bf16_t *win_t, *wout_t, *wgu_t, *wdn_t, *wq_t, *wkv_t;
    float* xf; bf16_t* xb; bf16_t* pbuf; bf16_t* mixcat; float* y1; bf16_t* x1b;
    float *rq, *rk, *rkv, *rstate;
    float *dq, *dk, *dob;
    float *sr, *sw, *sk, *sv, *sa, *sb, *sg, *sy, *vfirst;
    float *rsq, *rskv, *kpe, *qu, *kvu, *mo;
    int *rowtok, *toke, *tokpos; float* rowgate; bf16_t *act, *yb;
};

__device__ __forceinline__ int opq_tid() { int t = threadIdx.x; asm volatile("" : "+v"(t)); return t; }
__device__ __forceinline__ int opq_bid() { int b = blockIdx.x; asm volatile("" : "+s"(b)); return b; }
template <class F>
__device__ __forceinline__ void tr_tile(F f, bf16_t* dst, int ldd, int k0, int n0, float* tile, const int TID) {
    const int tid = TID;
#pragma unroll
    for (int i = 0; i < 8; ++i) { const int e = tid + i * NTHREADS, kk = e >> 6, nn = e & 63; tile[kk * 65 + nn] = f(k0 + kk, n0 + nn); }
    __syncthreads();
#pragma unroll
    for (int i = 0; i < 8; ++i) { const int e = tid + i * NTHREADS, nn = e >> 6, kk = e & 63; dst[(size_t)(n0 + nn) * ldd + k0 + kk] = f2bf(tile[kk * 65 + nn]); }
    __syncthreads();
}

__device__ void ph_prologue(const Params& p, char* lds) {
    const int TID = opq_tid(), BID = opq_bid(); (void)TID; (void)BID;
    float* tile = (float*)lds;
    const int nb = gridDim.x, bid = BID, tid = TID;
    for (int t = bid; t < DEPTH * NE * 16 * 32; t += nb) {
        const int le = t >> 9, r = t & 511, tk = r >> 5, tn = r & 31;
        const float* src = p.w_gu + (size_t)le * 1024 * 2048;
        tr_tile([&](int k, int n) { return src[(size_t)k * 2048 + n]; }, p.wgu_t + (size_t)le * 2048 * 1024, 1024, tk * 64, tn * 64, tile, TID);
    }
    for (int t = bid; t < DEPTH * NE * 16 * 16; t += nb) {
        const int le = t >> 8, r = t & 255, tk = r >> 4, tn = r & 15;
        const float* src = p.w_dn + (size_t)le * 1024 * 1024;
        tr_tile([&](int k, int n) { return src[(size_t)k * 1024 + n]; }, p.wdn_t + (size_t)le * 1024 * 1024, 1024, tk * 64, tn * 64, tile, TID);
    }
    for (int t = bid; t < DEPTH * 16 * 48; t += nb) {
        const int l = t / (16 * 48), r = t % (16 * 48), tk = r / 48, tn = r % 48;
        const float* src = p.w_in + (size_t)l * 1024 * NIN;
        const float* vr = p.vres_down + (size_t)(l > 0 ? l - 1 : 0) * 1024 * 32;
        tr_tile([&](int k, int n) { return n < NIN ? src[(size_t)k * NIN + n] : ((n < NIN + 32 && l > 0) ? vr[k * 32 + (n - NIN)] : 0.0f); },
                p.win_t + (size_t)l * NINP * 1024, 1024, tk * 64, tn * 64, tile, TID);
    }
    for (int t = bid; t < DEPTH * 16 * 16; t += nb) {
        const int l = t >> 8, r = t & 255, tk = r >> 4, tn = r & 15;
        const float* src = p.w_out + (size_t)l * 1024 * 1024;
        tr_tile([&](int k, int n) { return src[(size_t)k * 1024 + n]; }, p.wout_t + (size_t)l * 1024 * 1024, 1024, tk * 64, tn * 64, tile, TID);
    }
    for (int t = bid; t < DEPTH * 4 * 6; t += nb) {
        const int l = t / 24, r = t % 24, tk = r / 6, tn = r % 6;
        const float* src = p.mla_w_q_up + (size_t)l * 256 * 384; const float* g = p.mla_q_norm_g + l * 256;
        tr_tile([&](int k, int n) { return src[k * 384 + n] * g[k]; }, p.wq_t + (size_t)l * 384 * 256, 256, tk * 64, tn * 64, tile, TID);
    }
    for (int t = bid; t < DEPTH * 2 * 8; t += nb) {
        const int l = t / 16, r = t % 16, tk = r / 8, tn = r % 8;
        const float* src = p.mla_w_kv_up + (size_t)l * 128 * 512; const float* g = p.mla_kv_norm_g + l * 128;
        tr_tile([&](int k, int n) { return src[k * 512 + n] * g[k]; }, p.wkv_t + (size_t)l * 512 * 128, 128, tk * 64, tn * 64, tile, TID);
    }
    for (int i = bid * NTHREADS + tid; i < SEQ * 40; i += nb * NTHREADS) {
        const int pos = i / 40, j = i % 40;
        double theta, rot; int f; float* dst;
        if (j < 16) { theta = 10000.0; rot = 32.0; f = j; dst = p.tab_ret + ((size_t)pos * 16 + f) * 2; }
        else if (j < 24) { theta = 500000.0; rot = 16.0; f = j - 16; dst = p.tab_dil + ((size_t)pos * 8 + f) * 2; }
        else { theta = 10000.0; rot = 32.0; f = j - 24; dst = p.tab_mla + ((size_t)pos * 16 + f) * 2; }
        const double inv = 1.0 / pow(theta, (2.0 * f) / rot), ang = (double)pos * inv;
        dst[0] = (float)cos(ang); dst[1] = (float)sin(ang);
    }
    for (size_t i = (size_t)bid * NTHREADS + tid; i < (size_t)NT * DM / 4; i += (size_t)nb * NTHREADS) {
        const float4 v = ((const float4*)p.x)[i];
        ushort4 o; o.x = f2bf(v.x); o.y = f2bf(v.y); o.z = f2bf(v.z); o.w = f2bf(v.w);
        ((ushort4*)p.xb)[i] = o;
    }
    if (bid == 0 && tid < DEPTH * NE) p.cnt[tid] = 0;
}

template <class Epi>
__device__ __forceinline__ void gemm_tile128(const bf16_t* __restrict__ A, int lda, const int* __restrict__ rowidx, int nvalid,
                                             const bf16_t* __restrict__ Bt, int ldb, int K, char* lds, const int TID, Epi epi) {
    constexpr int LDT = 72;
    bf16_t* As = (bf16_t*)lds; bf16_t* Bs = As + 128 * LDT;
    const int tid = TID, lane = tid & 63, wid = tid >> 6, wm = wid >> 2, wn = wid & 3, fr = lane & 15, fq = lane >> 4;
    const bf16_t* ap[2]; const bf16_t* bp[2]; int so[2];
#pragma unroll
    for (int i = 0; i < 2; ++i) {
        const int c = tid + i * NTHREADS, row = c >> 3, kc = c & 7;
        int ar = row; if (rowidx) ar = (row < nvalid) ? rowidx[row] : rowidx[0];
        ap[i] = A + (size_t)ar * lda + kc * 8; bp[i] = Bt + (size_t)row * ldb + kc * 8; so[i] = row * LDT + kc * 8;
    }
    f32x4 acc[4][2];
#pragma unroll
    for (int mi = 0; mi < 4; ++mi)
#pragma unroll
        for (int ni = 0; ni < 2; ++ni) acc[mi][ni] = (f32x4){0.f, 0.f, 0.f, 0.f};
    u32x4 ra0, ra1, rb0, rb1;
    ra0 = *(const u32x4*)(ap[0]); ra1 = *(const u32x4*)(ap[1]); rb0 = *(const u32x4*)(bp[0]); rb1 = *(const u32x4*)(bp[1]);
    const int nk = K >> 6;
    for (int kt = 0; kt < nk; ++kt) {
        __syncthreads();
        *(u32x4*)(As + so[0]) = ra0; *(u32x4*)(As + so[1]) = ra1; *(u32x4*)(Bs + so[0]) = rb0; *(u32x4*)(Bs + so[1]) = rb1;
        __syncthreads();
        if (kt + 1 < nk) {
            const int ko = (kt + 1) * 64;
            ra0 = *(const u32x4*)(ap[0] + ko); ra1 = *(const u32x4*)(ap[1] + ko); rb0 = *(const u32x4*)(bp[0] + ko); rb1 = *(const u32x4*)(bp[1] + ko);
        }
#pragma unroll
        for (int kk = 0; kk < 2; ++kk) {
            bf16x8 af[4], bfr[2];
#pragma unroll
            for (int mi = 0; mi < 4; ++mi) af[mi] = *(const bf16x8*)(As + (wm * 64 + mi * 16 + fr) * LDT + kk * 32 + fq * 8);
#pragma unroll
            for (int ni = 0; ni < 2; ++ni) bfr[ni] = *(const bf16x8*)(Bs + (wn * 32 + ni * 16 + fr) * LDT + kk * 32 + fq * 8);
#pragma unroll
            for (int mi = 0; mi < 4; ++mi)
#pragma unroll
                for (int ni = 0; ni < 2; ++ni) acc[mi][ni] = __builtin_amdgcn_mfma_f32_16x16x32_bf16(bfr[ni], af[mi], acc[mi][ni], 0, 0, 0);
        }
    }
#pragma unroll
    for (int mi = 0; mi < 4; ++mi)
#pragma unroll
        for (int ni = 0; ni < 2; ++ni) epi(wm * 64 + mi * 16 + fr, wn * 32 + ni * 16 + fq * 4, acc[mi][ni]);
    __syncthreads();
}

__device__ void ph_inproj(const Params& p, int l, char* lds) {
    const int TID = opq_tid(), BID = opq_bid(); (void)TID; (void)BID;
    const bf16_t* Bt = p.win_t + (size_t)l * NINP * 1024;
    const int ntn = NINP / 128, nunits = (NT / 128) * ntn;
    for (int u = BID; u < nunits; u += gridDim.x) {
        const int mt = u / ntn, nt = u % ntn;
        bf16_t* out = p.pbuf + (size_t)mt * 128 * NINP + nt * 128;
        gemm_tile128(p.xb + (size_t)mt * 128 * 1024, 1024, nullptr, 128, Bt + (size_t)nt * 128 * 1024, 1024, 1024, lds, TID,
                     [=](int r, int c, f32x4 v) mutable { ushort4 o; o.x = f2bf(v[0]); o.y = f2bf(v[1]); o.z = f2bf(v[2]); o.w = f2bf(v[3]); *(ushort4*)(out + (size_t)r * NINP + c) = o; });
    }
}

__device__ void ph_rope_prep(const Params& p, int l) {
    const int TID = opq_tid(), BID = opq_bid(); (void)TID; (void)BID;
    const int lane = TID & 63, gw = BID * (NTHREADS / 64) + (TID >> 6), nw = gridDim.x * (NTHREADS / 64);
    for (int t = gw; t < NT; t += nw) {
        const int pos = t % SEQ;
        const bf16_t* pr = p.pbuf + (size_t)t * NINP;
        {
            const int h = lane >> 4, i = lane & 15;
            const float c = p.tab_ret[(pos * 16 + i) * 2], s = p.tab_ret[(pos * 16 + i) * 2 + 1];
            float x1 = bf2f(pr[PC_RQ + h * 32 + i]), x2 = bf2f(pr[PC_RQ + h * 32 + 16 + i]);
            p.rq[(size_t)t * 128 + h * 32 + i] = x1 * c - x2 * s; p.rq[(size_t)t * 128 + h * 32 + 16 + i] = x1 * s + x2 * c;
            x1 = bf2f(pr[PC_RK + h * 32 + i]); x2 = bf2f(pr[PC_RK + h * 32 + 16 + i]);
            const float sc = 0.17677669529663687f;
            p.rk[(size_t)t * 128 + h * 32 + i] = (x1 * c - x2 * s) * sc; p.rk[(size_t)t * 128 + h * 32 + 16 + i] = (x1 * s + x2 * c) * sc;
        }
        {
            for (int e = lane; e < 256; e += 64) {
                const int h = e >> 6, d = e & 63;
                float qv, kv;
                if (d < 16) {
                    const int i = d & 7; const float c = p.tab_dil[(pos * 8 + i) * 2], s = p.tab_dil[(pos * 8 + i) * 2 + 1];
                    const float q1 = bf2f(pr[PC_DQ + h * 64 + i]), q2 = bf2f(pr[PC_DQ + h * 64 + 8 + i]);
                    const float k1 = bf2f(pr[PC_DK + h * 64 + i]), k2 = bf2f(pr[PC_DK + h * 64 + 8 + i]);
                    if (d < 8) { qv = q1 * c - q2 * s; kv = k1 * c - k2 * s; } else { qv = q1 * s + q2 * c; kv = k1 * s + k2 * c; }
                } else { qv = bf2f(pr[PC_DQ + e]); kv = bf2f(pr[PC_DK + e]); }
                p.dq[(size_t)t * 256 + e] = qv * 0.125f; p.dk[(size_t)t * 256 + e] = kv;
            }
        }
        {
            float ss = 0.f;
            for (int e = lane; e < 256; e += 64) { const float v = bf2f(pr[PC_MQ + e]); ss += v * v; }
            ss = wave_sum(ss);
            float s2 = 0.f;
            for (int e = lane; e < 128; e += 64) { const float v = bf2f(pr[PC_MKV + e]); s2 += v * v; }
            s2 = wave_sum(s2);
            if (lane == 0) { p.rsq[t] = rsqrtf(ss * (1.0f / 256.0f) + 1e-6f); p.rskv[t] = rsqrtf(s2 * (1.0f / 128.0f) + 1e-6f); }
            if (lane < 16) {
                const float c = p.tab_mla[(pos * 16 + lane) * 2], s = p.tab_mla[(pos * 16 + lane) * 2 + 1];
                const float x1 = bf2f(pr[PC_MKR + lane]), x2 = bf2f(pr[PC_MKR + 16 + lane]);
                p.kpe[(size_t)t * 32 + lane] = x1 * c - x2 * s; p.kpe[(size_t)t * 32 + 16 + lane] = x1 * s + x2 * c;
            }
        }
    }
}

__device__ __forceinline__ float ret_log_gamma(int h) { return logf(1.0f - exp2f(-5.0f - (float)h)); }

__device__ void ph_ret_kv(const Params& p, int l) {
    const int TID = opq_tid(), BID = opq_bid(); (void)TID; (void)BID;
    const size_t total = (size_t)NBATCH * NCH * 4 * 32 * 64;
    for (size_t i = (size_t)BID * NTHREADS + TID; i < total; i += (size_t)gridDim.x * NTHREADS) {
        const int e = i & 63, d = (i >> 6) & 31, h = (i >> 11) & 3, n = (i >> 13) & 63, b = (int)(i >> 19);
        const float lg = ret_log_gamma(h);
        const int t0 = b * SEQ + n * BLK;
        float acc = 0.f;
        for (int j = 0; j < BLK; ++j) {
            const float z = __expf((float)(BLK - 1 - j) * lg);
            acc += p.rk[(size_t)(t0 + j) * 128 + h * 32 + d] * z * bf2f(p.pbuf[(size_t)(t0 + j) * NINP + PC_RV + h * 64 + e]);
        }
        p.rkv[i] = acc;
    }
}
__device__ void ph_ret_scan(const Params& p, int l) {
    const int TID = opq_tid(), BID = opq_bid(); (void)TID; (void)BID;
    const int i = BID * NTHREADS + TID;
    if (i < NBATCH * 4 * 32 * 64) {
        const int e = i & 63, d = (i >> 6) & 31, h = (i >> 11) & 3, b = i >> 13;
        const float cd = __expf((float)BLK * ret_log_gamma(h));
        float s = 0.f;
        for (int n = 0; n < NCH; ++n) {
            const size_t idx = ((((size_t)b * NCH + n) * 4 + h) * 32 + d) * 64 + e;
            p.rstate[idx] = s; s = cd * s + p.rkv[idx];
        }
    }
}
__device__ void ph_ret_out(const Params& p, int l) {
    const int TID = opq_tid(), BID = opq_bid(); (void)TID; (void)BID;
    const int lane = TID & 63;
    const int nwv = gridDim.x * (NTHREADS / 64);
    for (int w = BID * (NTHREADS / 64) + (TID >> 6); w < NT / 64 * 4; w += nwv) {
        const int h = w & 3, tb = (w >> 2) * 64, t = tb + lane, b = t / SEQ, pos = t % SEQ, n = pos / BLK, i = pos % BLK, c0 = tb - (tb % BLK);
        const float lg = ret_log_gamma(h);
        float q[32], o[64];
#pragma unroll
        for (int d = 0; d < 32; ++d) q[d] = p.rq[(size_t)t * 128 + h * 32 + d];
#pragma unroll
        for (int e = 0; e < 64; ++e) o[e] = 0.f;
        const int jmax = (tb % BLK) + 63;
        for (int j = 0; j <= jmax; ++j) {
            const float* kj = p.rk + (size_t)(c0 + j) * 128 + h * 32;
            float s = 0.f;
#pragma unroll
            for (int d = 0; d < 32; ++d) s += q[d] * kj[d];
            s = (j <= i) ? s * __expf((float)(i - j) * lg) : 0.f;
            const bf16_t* vj = p.pbuf + (size_t)(c0 + j) * NINP + PC_RV + h * 64;
#pragma unroll
            for (int e = 0; e < 64; ++e) o[e] += s * bf2f(vj[e]);
        }
        const float xi = __expf((float)(i + 1) * lg);
        const float* st = p.rstate + (((size_t)b * NCH + n) * 4 + h) * 32 * 64;
        for (int d = 0; d < 32; ++d) {
            const float qd = q[d] * xi;
#pragma unroll
            for (int e = 0; e < 64; ++e) o[e] += qd * st[d * 64 + e];
        }
        float ss = 0.f;
#pragma unroll
        for (int e = 0; e < 64; ++e) ss += o[e] * o[e];
        const float rs = rsqrtf(ss * (1.0f / 64.0f) + 1e-6f);
        const float* ng = p.ret_norm_g + l * 256 + h * 64;
        const bf16_t* gp = p.pbuf + (size_t)t * NINP + PC_RG + h * 64;
        bf16_t* outp = p.mixcat + (size_t)t * 1024 + h * 64;
#pragma unroll
        for (int e = 0; e < 64; ++e) { const float g = bf2f(gp[e]); outp[e] = f2bf(g * sigmoidf_(g) * (o[e] * rs * ng[e])); }
    }
}

__device__ void ph_dil_attn(const Params& p, int l) {
    const int TID = opq_tid(), BID = opq_bid(); (void)TID; (void)BID;
    const size_t total = (size_t)NT * 4;
    for (size_t idx = (size_t)BID * NTHREADS + TID; idx < total; idx += (size_t)gridDim.x * NTHREADS) {
        const int h = (int)(idx / NT), t = (int)(idx % NT), pos = t % SEQ;
        float q[64], o[64];
#pragma unroll
        for (int d = 0; d < 64; ++d) { q[d] = p.dq[(size_t)t * 256 + h * 64 + d]; o[d] = 0.f; }
        float m = -1e30f, lsum = 0.f;
        for (int pat = 0; pat < 3; ++pat) {
            const int dil = pat == 0 ? 1 : (pat == 1 ? 4 : 16);
            for (int j = 0; j <= 128; ++j) {
                const int kp = pos - j * dil;
                if (kp < 0) break;
                const size_t kt = (size_t)(t - j * dil);
                const float4* kr = (const float4*)(p.dk + kt * 256 + h * 64);
                float s = 0.f;
#pragma unroll
                for (int d4 = 0; d4 < 16; ++d4) { const float4 kv = kr[d4]; s += q[d4 * 4] * kv.x + q[d4 * 4 + 1] * kv.y + q[d4 * 4 + 2] * kv.z + q[d4 * 4 + 3] * kv.w; }
                const float mn = fmaxf(m, s), c = __expf(m - mn), pe = __expf(s - mn);
                lsum = lsum * c + pe; m = mn;
                const bf16_t* vr = p.pbuf + kt * NINP + PC_DV + h * 64;
#pragma unroll
                for (int d = 0; d < 64; ++d) o[d] = o[d] * c + pe * bf2f(vr[d]);
            }
        }
        const float inv = 1.0f / lsum;
#pragma unroll
        for (int d = 0; d < 64; ++d) p.dob[(size_t)t * 256 + h * 64 + d] = o[d] * inv;
    }
}

__device__ void ph_rwkv_prep(const Params& p, int l, char* lds) {
    const int TID = opq_tid(), BID = opq_bid(); (void)TID; (void)BID;
    float* lw = (float*)lds;
    float* la = lw + 16 * 64;
    float* lg = la + 16 * 64;
    float* lv = lg + 16 * 128;
    const int tid = TID, c = tid & 255, half = tid >> 8;
    const float* mu = p.rwkv_mu + l * 1024;
    const float* w_up = p.rwkv_w_up + (size_t)l * 64 * 256; const float* a_up = p.rwkv_a_up + (size_t)l * 64 * 256; const float* g_up = p.rwkv_g_up + (size_t)l * 128 * 256;
    const float* v_up = p.rwkv_v_up + (size_t)(l > 0 ? l - 1 : 0) * 32 * 256;
    const float* vmu = p.vres_mu + (l > 0 ? l - 1 : 0) * 32;
    for (int tb = BID * 16; tb < NT; tb += gridDim.x * 16) {
        __syncthreads();
        for (int e = tid; e < 16 * 288; e += NTHREADS) {
            const int tt = e / 288, j = e % 288, t = tb + tt;
            const bool first = (t % SEQ) == 0;
            const bf16_t* pr = p.pbuf + (size_t)t * NINP;
            int col; float m;
            if (j < 256) { col = PC_CWD + j; m = mu[768 + j]; } else { col = PC_VRES + (j - 256); m = vmu[j - 256]; }
            const float cur = bf2f(pr[col]), prev = first ? 0.f : bf2f(pr[col - NINP]);
            const float xs = cur + (prev - cur) * m;
            if (j < 64) lw[tt * 64 + j] = tanhf(xs);
            else if (j < 128) la[tt * 64 + (j - 64)] = xs;
            else if (j < 256) lg[tt * 128 + (j - 128)] = sigmoidf_(xs);
            else lv[tt * 32 + (j - 256)] = xs;
        }
        __syncthreads();
        float aw[8], aa[8], ag[8], av[8];
#pragma unroll
        for (int i = 0; i < 8; ++i) { aw[i] = 0.f; aa[i] = 0.f; ag[i] = 0.f; av[i] = 0.f; }
        for (int m = 0; m < 64; ++m) {
            const float ww = w_up[m * 256 + c], wa = a_up[m * 256 + c];
#pragma unroll
            for (int i = 0; i < 8; ++i) { aw[i] += lw[(half * 8 + i) * 64 + m] * ww; aa[i] += la[(half * 8 + i) * 64 + m] * wa; }
        }
        for (int m = 0; m < 128; ++m) {
            const float wg = g_up[m * 256 + c];
#pragma unroll
            for (int i = 0; i < 8; ++i) ag[i] += lg[(half * 8 + i) * 128 + m] * wg;
        }
        if (l > 0) for (int m = 0; m < 32; ++m) {
            const float wv = v_up[m * 256 + c];
#pragma unroll
            for (int i = 0; i < 8; ++i) av[i] += lv[(half * 8 + i) * 32 + m] * wv;
        }
        const float w0 = p.rwkv_w0[l * 256 + c], a0 = p.rwkv_a0[l * 256 + c], kkc = p.rwkv_k_k[l * 256 + c], kac = p.rwkv_k_a[l * 256 + c];
        const float v0 = p.rwkv_v0[(l > 0 ? l - 1 : 0) * 256 + c];
        const float mr = mu[c], mk = mu[256 + c], mv = mu[512 + c];
#pragma unroll
        for (int i = 0; i < 8; ++i) {
            const int t = tb + half * 8 + i; const bool first = (t % SEQ) == 0;
            const bf16_t* pr = p.pbuf + (size_t)t * NINP;
            float r = bf2f(pr[PC_CR + c]), k = bf2f(pr[PC_CK + c]), v = bf2f(pr[PC_CV + c]);
            const float rp = first ? 0.f : bf2f(pr[PC_CR + c - NINP]), kp = first ? 0.f : bf2f(pr[PC_CK + c - NINP]), vp = first ? 0.f : bf2f(pr[PC_CV + c - NINP]);
            r = r + (rp - r) * mr; k = k + (kp - k) * mk; v = v + (vp - v) * mv;
            const float wpre = w0 + aw[i];
            const float sp = (-wpre > 20.f) ? -wpre : log1pf(__expf(-wpre));
            const float w = -sp - 0.5f;
            const float decay = __expf(-__expf(w));
            const float a = sigmoidf_(a0 + aa[i]);
            const float kkr = k * kkc;
            const float ss = wave_sum(kkr * kkr);
            const float kk = kkr / fmaxf(sqrtf(ss), 1e-12f);
            const float k2 = k * (1.0f + (a - 1.0f) * kac);
            const size_t o = (size_t)t * 256 + c;
            if (l == 0) p.vfirst[o] = v;
            else v = v + (p.vfirst[o] - v) * sigmoidf_(v0 + av[i]);
            p.sr[o] = r; p.sw[o] = decay; p.sk[o] = k2; p.sv[o] = v; p.sa[o] = -kk; p.sb[o] = kk * a; p.sg[o] = ag[i];
        }
    }
}

__device__ void ph_rwkv_scan(const Params& p, int l) {
    const int TID = opq_tid(), BID = opq_bid(); (void)TID; (void)BID;
    const int lane = TID & 63, wv = TID >> 6;
    const int nwaves = NBATCH * 4 * 16;
    for (int u = BID + wv * gridDim.x; u < nwaves; u += gridDim.x * (NTHREADS / 64)) {
        const int bh = u >> 4, b = bh >> 2, h = bh & 3, i0 = (u & 15) * 4, rr = lane >> 4, c4 = (lane & 15) * 4;
        float s0 = 0.f, s1 = 0.f, s2 = 0.f, s3 = 0.f;
        const size_t base = (size_t)b * SEQ * 256 + h * 64;
        float4 ca[4], cw[4], cb[4], ck[4], cr[4]; float cv[4];
        float4 na[4], nw_[4], nb_[4], nk[4], nr[4]; float nv[4];
#pragma unroll
        for (int i = 0; i < 4; ++i) {
            const size_t o = base + (size_t)i * 256;
            ca[i] = *(const float4*)(p.sa + o + c4); cw[i] = *(const float4*)(p.sw + o + c4); cb[i] = *(const float4*)(p.sb + o + c4);
            ck[i] = *(const float4*)(p.sk + o + c4); cr[i] = *(const float4*)(p.sr + o + c4); cv[i] = p.sv[o + i0 + rr];
        }
        for (int t = 0; t < SEQ; t += 4) {
            if (t + 4 < SEQ) {
#pragma unroll
                for (int i = 0; i < 4; ++i) {
                    const size_t o = base + (size_t)(t + 4 + i) * 256;
                    na[i] = *(const float4*)(p.sa + o + c4); nw_[i] = *(const float4*)(p.sw + o + c4); nb_[i] = *(const float4*)(p.sb + o + c4);
                    nk[i] = *(const float4*)(p.sk + o + c4); nr[i] = *(const float4*)(p.sr + o + c4); nv[i] = p.sv[o + i0 + rr];
                }
            }
#pragma unroll
            for (int i = 0; i < 4; ++i) {
                const float4 a = ca[i], w = cw[i], bb = cb[i], k = ck[i], r = cr[i]; const float v = cv[i];
                float sa = s0 * a.x + s1 * a.y + s2 * a.z + s3 * a.w;
                sa = grp16_sum(sa);
                s0 = s0 * w.x + sa * bb.x + v * k.x; s1 = s1 * w.y + sa * bb.y + v * k.y; s2 = s2 * w.z + sa * bb.z + v * k.z; s3 = s3 * w.w + sa * bb.w + v * k.w;
                float y = s0 * r.x + s1 * r.y + s2 * r.z + s3 * r.w;
                y = grp16_sum(y);
                if ((lane & 15) == 0) p.sy[base + (size_t)(t + i) * 256 + i0 + rr] = y;
            }
#pragma unroll
            for (int i = 0; i < 4; ++i) { ca[i] = na[i]; cw[i] = nw_[i]; cb[i] = nb_[i]; ck[i] = nk[i]; cr[i] = nr[i]; cv[i] = nv[i]; }
        }
    }
}

__device__ void ph_mla_up(const Params& p, int l, char* lds) {
    const int TID = opq_tid(), BID = opq_bid(); (void)TID; (void)BID;
    const int nq = (NT / 128) * 3, nkv = (NT / 128) * 4;
    for (int u = BID; u < nq + nkv; u += gridDim.x) {
        if (u < nq) {
            const int mt = u / 3, nt = u % 3;
            float* out = p.qu + (size_t)mt * 128 * 384 + nt * 128; const float* rs = p.rsq + mt * 128;
            gemm_tile128(p.pbuf + (size_t)mt * 128 * NINP + PC_MQ, NINP, nullptr, 128, p.wq_t + ((size_t)l * 384 + nt * 128) * 256, 256, 256, lds, TID,
                         [=](int r, int c, f32x4 v) mutable { const float s = rs[r]; *(f32x4*)(out + (size_t)r * 384 + c) = v * s; });
        } else {
            const int uu = u - nq, mt = uu / 4, nt = uu % 4;
            float* out = p.kvu + (size_t)mt * 128 * 512 + nt * 128; const float* rs = p.rskv + mt * 128;
            gemm_tile128(p.pbuf + (size_t)mt * 128 * NINP + PC_MKV, NINP, nullptr, 128, p.wkv_t + ((size_t)l * 512 + nt * 128) * 128, 128, 128, lds, TID,
                         [=](int r, int c, f32x4 v) mutable { const float s = rs[r]; *(f32x4*)(out + (size_t)r * 512 + c) = v * s; });
        }
    }
}

__device__ void ph_mla_attn(const Params& p, int l, char* lds) {
    const int TID = opq_tid(), BID = opq_bid(); (void)TID; (void)BID;
    float* Ks = (float*)lds;
    float* Vs = Ks + 128 * 96;
    const int tid = TID, part = tid & 1, qi = tid >> 1;
    const float scale = 0.10206207261596575f;
    for (int it = BID; it < 16 * 32; it += gridDim.x) {
        const int bh = it & 15, qb0 = it >> 4, qb = (qb0 < 16) ? qb0 : (47 - qb0);
        const int b = bh >> 2, h = bh & 3, q0 = qb * 256, t = b * SEQ + q0 + qi, pos = q0 + qi;
        float q[48], o[32];
        {
            const float* qp = p.qu + (size_t)t * 384 + h * 96;
#pragma unroll
            for (int i = 0; i < 48; ++i) q[i] = qp[part * 48 + i] * scale;
            if (part == 1) {
#pragma unroll
                for (int j = 0; j < 16; ++j) {
                    const float c = p.tab_mla[(pos * 16 + j) * 2], s = p.tab_mla[(pos * 16 + j) * 2 + 1], x1 = qp[64 + j], x2 = qp[80 + j];
                    q[16 + j] = (x1 * c - x2 * s) * scale; q[32 + j] = (x1 * s + x2 * c) * scale;
                }
            }
        }
#pragma unroll
        for (int e = 0; e < 32; ++e) o[e] = 0.f;
        float m = -1e30f, lsum = 0.f;
        const int nkt = (q0 + 256) / 128;
        for (int kt = 0; kt < nkt; ++kt) {
            __syncthreads();
            const int kb = b * SEQ + kt * 128;
            for (int e = tid; e < 128 * 24; e += NTHREADS) {
                const int j = e / 24, c4 = e % 24;
                float4 v;
                if (c4 < 16) v = *(const float4*)(p.kvu + (size_t)(kb + j) * 512 + h * 128 + c4 * 4);
                else v = *(const float4*)(p.kpe + (size_t)(kb + j) * 32 + (c4 - 16) * 4);
                *(float4*)(Ks + j * 96 + c4 * 4) = v;
            }
            for (int e = tid; e < 128 * 16; e += NTHREADS) {
                const int j = e >> 4, c4 = e & 15;
                *(float4*)(Vs + j * 64 + c4 * 4) = *(const float4*)(p.kvu + (size_t)(kb + j) * 512 + h * 128 + 64 + c4 * 4);
            }
            __syncthreads();
            const int kbase = kt * 128;
            for (int j8 = 0; j8 < 128; j8 += 8) {
                float s[8];
#pragma unroll
                for (int jj = 0; jj < 8; ++jj) {
                    const float4* kr = (const float4*)(Ks + (j8 + jj) * 96 + part * 48);
                    float a = 0.f;
#pragma unroll
                    for (int d4 = 0; d4 < 12; ++d4) { const float4 kv = kr[d4]; a += q[d4 * 4] * kv.x + q[d4 * 4 + 1] * kv.y + q[d4 * 4 + 2] * kv.z + q[d4 * 4 + 3] * kv.w; }
                    a += __shfl_xor(a, 1);
                    s[jj] = (kbase + j8 + jj <= pos) ? a : -1e30f;
                }
                float mn = m;
#pragma unroll
                for (int jj = 0; jj < 8; ++jj) mn = fmaxf(mn, s[jj]);
                const float c = __expf(m - mn); m = mn; lsum *= c;
#pragma unroll
                for (int e = 0; e < 32; ++e) o[e] *= c;
#pragma unroll
                for (int jj = 0; jj < 8; ++jj) {
                    const float pe = (s[jj] > -1e29f) ? __expf(s[jj] - mn) : 0.f;
                    lsum += pe;
                    const float4* vr = (const float4*)(Vs + (j8 + jj) * 64 + part * 32);
#pragma unroll
                    for (int e4 = 0; e4 < 8; ++e4) { const float4 vv = vr[e4]; o[e4 * 4] += pe * vv.x; o[e4 * 4 + 1] += pe * vv.y; o[e4 * 4 + 2] += pe * vv.z; o[e4 * 4 + 3] += pe * vv.w; }
                }
            }
        }
        const float inv = 1.0f / lsum;
        float* op = p.mo + (size_t)t * 256 + h * 64 + part * 32;
#pragma unroll
        for (int e = 0; e < 32; ++e) op[e] = o[e] * inv;
        __syncthreads();
    }
}

__device__ void ph_finalize_mix(const Params& p, int l) {
    const int TID = opq_tid(), BID = opq_bid(); (void)TID; (void)BID;
    const int lane = TID & 63, gw = BID * (NTHREADS / 64) + (TID >> 6), nw = gridDim.x * (NTHREADS / 64);
    const int c = lane * 4, h = lane >> 4;
    for (int t = gw; t < NT; t += nw) {
        bf16_t* outp = p.mixcat + (size_t)t * 1024;
        {
            const float4 v = *(const float4*)(p.dob + (size_t)t * 256 + c);
            const float ss = wave_sum(v.x * v.x + v.y * v.y + v.z * v.z + v.w * v.w);
            const float rs = rsqrtf(ss * (1.0f / 256.0f) + 1e-6f);
            const float4 g = *(const float4*)(p.dil_norm_g + l * 256 + c);
            ushort4 o; o.x = f2bf(v.x * rs * g.x); o.y = f2bf(v.y * rs * g.y); o.z = f2bf(v.z * rs * g.z); o.w = f2bf(v.w * rs * g.w);
            *(ushort4*)(outp + 256 + c) = o;
        }
        {
            const size_t o4 = (size_t)t * 256 + c;
            const float4 y = *(const float4*)(p.sy + o4), r = *(const float4*)(p.sr + o4), k = *(const float4*)(p.sk + o4), v = *(const float4*)(p.sv + o4), g = *(const float4*)(p.sg + o4);
            const float mean = grp16_sum(y.x + y.y + y.z + y.w) * (1.0f / 64.0f);
            const float dx = y.x - mean, dy = y.y - mean, dz = y.z - mean, dw = y.w - mean;
            const float var = grp16_sum(dx * dx + dy * dy + dz * dz + dw * dw) * (1.0f / 64.0f);
            const float rs = rsqrtf(var + 64e-5f);
            const float4 lg = *(const float4*)(p.rwkv_ln_g + l * 256 + c), lb = *(const float4*)(p.rwkv_ln_b + l * 256 + c), rk = *(const float4*)(p.rwkv_r_k + l * 256 + c);
            const float bonus = grp16_sum(r.x * k.x * rk.x + r.y * k.y * rk.y + r.z * k.z * rk.z + r.w * k.w * rk.w);
            ushort4 o;
            o.x = f2bf((dx * rs * lg.x + lb.x + bonus * v.x) * g.x); o.y = f2bf((dy * rs * lg.y + lb.y + bonus * v.y) * g.y);
            o.z = f2bf((dz * rs * lg.z + lb.z + bonus * v.z) * g.z); o.w = f2bf((dw * rs * lg.w + lb.w + bonus * v.w) * g.w);
            *(ushort4*)(outp + 512 + c) = o;
        }
        {
            const float4 v = *(const float4*)(p.mo + (size_t)t * 256 + c);
            const float ss = wave_sum(v.x * v.x + v.y * v.y + v.z * v.z + v.w * v.w);
            const float rs = rsqrtf(ss * (1.0f / 256.0f) + 1e-6f);
            const float4 g = *(const float4*)(p.mla_out_norm_g + l * 256 + c);
            ushort4 o; o.x = f2bf(v.x * rs * g.x); o.y = f2bf(v.y * rs * g.y); o.z = f2bf(v.z * rs * g.z); o.w = f2bf(v.w * rs * g.w);
            *(ushort4*)(outp + 768 + c) = o;
        }
    }
    (void)h;
}

__device__ void ph_outproj(const Params& p, int l, char* lds) {
    const int TID = opq_tid(), BID = opq_bid(); (void)TID; (void)BID;
    const float* xin = (l == 0) ? p.x : p.xf;
    const bf16_t* Bt = p.wout_t + (size_t)l * 1024 * 1024;
    for (int u = BID; u < (NT / 128) * 8; u += gridDim.x) {
        const int mt = u >> 3, nt = u & 7;
        const size_t o0 = (size_t)mt * 128 * 1024 + nt * 128;
        gemm_tile128(p.mixcat + (size_t)mt * 128 * 1024, 1024, nullptr, 128, Bt + (size_t)nt * 128 * 1024, 1024, 1024, lds, TID,
                     [=](int r, int c, f32x4 v) mutable { const size_t o = o0 + (size_t)r * 1024 + c; const f32x4 xv = *(const f32x4*)(xin + o); *(f32x4*)(p.y1 + o) = xv * ALPHA + v; });
    }
}

__device__ void ph_ln1_router(const Params& p, int l, char* lds) {
    const int TID = opq_tid(), BID = opq_bid(); (void)TID; (void)BID;
    int* hist = (int*)lds;
    int* base = hist + 32;
    int* le = base + 32;
    float* lgt = (float*)(le + 512);
    int* lrank = (int*)(lgt + 512);
    const int tid = TID, lane = tid & 63, wv = tid >> 6;
    const float* g1 = p.ln1_g + l * 1024; const float* b1 = p.ln1_b + l * 1024;
    const float* rw = p.router_w + (size_t)l * 1024 * 32; const float* rb = p.router_b + l * 32;
    for (int tb = BID * 128; tb < NT; tb += gridDim.x * 128) {
        __syncthreads();
        if (tid < 32) hist[tid] = 0;
        __syncthreads();
        for (int tt = wv; tt < 128; tt += 8) {
            const int t = tb + tt;
            float4 y[4]; float s = 0.f;
#pragma unroll
            for (int m = 0; m < 4; ++m) { y[m] = *(const float4*)(p.y1 + (size_t)t * 1024 + m * 256 + lane * 4); s += y[m].x + y[m].y + y[m].z + y[m].w; }
            const float mean = wave_sum(s) * (1.0f / 1024.0f);
            float q = 0.f;
#pragma unroll
            for (int m = 0; m < 4; ++m) { y[m].x -= mean; y[m].y -= mean; y[m].z -= mean; y[m].w -= mean; q += y[m].x * y[m].x + y[m].y * y[m].y + y[m].z * y[m].z + y[m].w * y[m].w; }
            const float rs = rsqrtf(wave_sum(q) * (1.0f / 1024.0f) + 1e-5f);
            float lg[32];
#pragma unroll
            for (int e = 0; e < 32; ++e) lg[e] = 0.f;
#pragma unroll 1
            for (int m = 0; m < 4; ++m) {
                const int c = m * 256 + lane * 4;
                const float4 g = *(const float4*)(g1 + c), bb = *(const float4*)(b1 + c);
                const float4 yv = *(const float4*)(p.y1 + (size_t)t * 1024 + c);
                float4 xv; xv.x = (yv.x - mean) * rs * g.x + bb.x; xv.y = (yv.y - mean) * rs * g.y + bb.y; xv.z = (yv.z - mean) * rs * g.z + bb.z; xv.w = (yv.w - mean) * rs * g.w + bb.w;
                *(float4*)(p.y1 + (size_t)t * 1024 + c) = xv;
                ushort4 ob; ob.x = f2bf(xv.x); ob.y = f2bf(xv.y); ob.z = f2bf(xv.z); ob.w = f2bf(xv.w);
                *(ushort4*)(p.x1b + (size_t)t * 1024 + c) = ob;
                const float xs[4] = {xv.x, xv.y, xv.z, xv.w};
#pragma unroll
                for (int i = 0; i < 4; ++i) {
                    const float4* wr = (const float4*)(rw + (size_t)(c + i) * 32);
#pragma unroll
                    for (int e4 = 0; e4 < 8; ++e4) { const float4 w = wr[e4]; lg[e4 * 4] += xs[i] * w.x; lg[e4 * 4 + 1] += xs[i] * w.y; lg[e4 * 4 + 2] += xs[i] * w.z; lg[e4 * 4 + 3] += xs[i] * w.w; }
                }
            }
#pragma unroll
            for (int e = 0; e < 32; ++e) lg[e] = wave_sum(lg[e]) + rb[e];
            int idx[4]; float val[4];
#pragma unroll
            for (int k = 0; k < 4; ++k) {
                float bv = -3.0e38f; int bi = 0;
#pragma unroll
                for (int e = 0; e < 32; ++e) { if (lg[e] > bv) { bv = lg[e]; bi = e; } }
                idx[k] = bi; val[k] = bv;
#pragma unroll
                for (int e = 0; e < 32; ++e) if (e == bi) lg[e] = -3.0e38f;
            }
            const float e1 = __expf(val[1] - val[0]), e2 = __expf(val[2] - val[0]), e3 = __expf(val[3] - val[0]);
            const float inv = 1.0f / (1.0f + e1 + e2 + e3);
            const float gt[4] = {inv, e1 * inv, e2 * inv, e3 * inv};
            if (lane < 4) {
                int ee = idx[0]; float gg = gt[0];
                if (lane == 1) { ee = idx[1]; gg = gt[1]; } else if (lane == 2) { ee = idx[2]; gg = gt[2]; } else if (lane == 3) { ee = idx[3]; gg = gt[3]; }
                le[tt * 4 + lane] = ee; lgt[tt * 4 + lane] = gg;
                lrank[tt * 4 + lane] = atomicAdd(&hist[ee], 1);
            }
        }
        __syncthreads();
        if (tid < 32) base[tid] = atomicAdd(&p.cnt[l * NE + tid], hist[tid]);
        __syncthreads();
        {
            const int tt = tid >> 2, t = tb + tt, e = le[tid], pos = base[e] + lrank[tid];
            p.toke[(size_t)t * 4 + (tid & 3)] = e; p.tokpos[(size_t)t * 4 + (tid & 3)] = pos;
            p.rowtok[(size_t)e * NT + pos] = t; p.rowgate[(size_t)e * NT + pos] = lgt[tid];
        }
    }
}

__device__ __forceinline__ void moe_tile_prefix(const Params& p, int l, int* tb  , const int TID) {
    __syncthreads();
    if (TID == 0) { int a = 0; for (int e = 0; e < NE; ++e) { tb[e] = a; a += (p.cnt[l * NE + e] + MOE_TM - 1) / MOE_TM; } tb[NE] = a; }
    __syncthreads();
}
__device__ void ph_moe_gu(const Params& p, int l, char* lds) {
    const int TID = opq_tid(), BID = opq_bid(); (void)TID; (void)BID;
    int* tb = (int*)(lds + 40960);
    moe_tile_prefix(p, l, tb, TID);
    const int ntile = tb[NE], nunits = ntile * 16;
    for (int u = BID; u < nunits; u += gridDim.x) {
        const int mtg = u >> 4, nt = u & 15;
        int e = 0; while (tb[e + 1] <= mtg) ++e;
        const int mt = mtg - tb[e], cnt = p.cnt[l * NE + e], nvalid = min(MOE_TM, cnt - mt * MOE_TM);
        const float* bias = p.b_gu + ((size_t)l * NE + e) * 2048 + nt * 128;
        bf16_t* out = p.act + (size_t)mtg * MOE_TM * 1024 + nt * 64;
        gemm_tile128(p.x1b, 1024, p.rowtok + (size_t)e * NT + mt * MOE_TM, nvalid, p.wgu_t + (((size_t)l * NE + e) * 2048 + nt * 128) * 1024, 1024, 1024, lds, TID,
                     [=](int r, int c, f32x4 v) mutable {
                         const f32x4 bv = *(const f32x4*)(bias + c); v = v + bv;
                         const float g0 = fminf(v[0], 7.0f), l0 = fminf(fmaxf(v[1], -7.0f), 7.0f), g1 = fminf(v[2], 7.0f), l1 = fminf(fmaxf(v[3], -7.0f), 7.0f);
                         const float a0 = g0 * sigmoidf_(1.702f * g0) * (l0 + 1.0f), a1 = g1 * sigmoidf_(1.702f * g1) * (l1 + 1.0f);
                         ushort2 o; o.x = f2bf(a0); o.y = f2bf(a1); *(ushort2*)(out + (size_t)r * 1024 + (c >> 1)) = o; });
    }
}
__device__ void ph_moe_dn(const Params& p, int l, char* lds) {
    const int TID = opq_tid(), BID = opq_bid(); (void)TID; (void)BID;
    int* tb = (int*)(lds + 40960);
    moe_tile_prefix(p, l, tb, TID);
    const int ntile = tb[NE], nunits = ntile * 8;
    for (int u = BID; u < nunits; u += gridDim.x) {
        const int mtg = u >> 3, nt = u & 7;
        int e = 0; while (tb[e + 1] <= mtg) ++e;
        const int mt = mtg - tb[e], cnt = p.cnt[l * NE + e], nvalid = min(MOE_TM, cnt - mt * MOE_TM);
        const float* bias = p.b_dn + ((size_t)l * NE + e) * 1024 + nt * 128;
        const float* gate = p.rowgate + (size_t)e * NT + mt * MOE_TM;
        bf16_t* out = p.yb + (size_t)mtg * MOE_TM * 1024 + nt * 128;
        gemm_tile128(p.act + (size_t)mtg * MOE_TM * 1024, 1024, nullptr, 128, p.wdn_t + (((size_t)l * NE + e) * 1024 + nt * 128) * 1024, 1024, 1024, lds, TID,
                     [=](int r, int c, f32x4 v) mutable {
                         const float g = (r < nvalid) ? gate[r] : 0.f;
                         const f32x4 bv = *(const f32x4*)(bias + c); v = (v + bv) * g;
                         ushort4 o; o.x = f2bf(v[0]); o.y = f2bf(v[1]); o.z = f2bf(v[2]); o.w = f2bf(v[3]); *(ushort4*)(out + (size_t)r * 1024 + c) = o; });
    }
}
__device__ void ph_combine_ln2(const Params& p, int l, char* lds) {
    const int TID = opq_tid(), BID = opq_bid(); (void)TID; (void)BID;
    int* tb = (int*)(lds + 40960);
    moe_tile_prefix(p, l, tb, TID);
    const int lane = TID & 63, gw = BID * (NTHREADS / 64) + (TID >> 6), nw = gridDim.x * (NTHREADS / 64);
    const float* g2 = p.ln2_g + l * 1024; const float* b2 = p.ln2_b + l * 1024;
    float* dstf = (l == DEPTH - 1) ? p.out : p.xf;
    for (int t = gw; t < NT; t += nw) {
        size_t rows[4];
#pragma unroll
        for (int k = 0; k < 4; ++k) { const int e = p.toke[(size_t)t * 4 + k], pos = p.tokpos[(size_t)t * 4 + k]; rows[k] = (size_t)tb[e] * MOE_TM + pos; }
        float4 y[4]; float s = 0.f;
#pragma unroll
        for (int m = 0; m < 4; ++m) {
            const int c = m * 256 + lane * 4;
            float4 v = *(const float4*)(p.y1 + (size_t)t * 1024 + c);
            v.x *= ALPHA; v.y *= ALPHA; v.z *= ALPHA; v.w *= ALPHA;
#pragma unroll
            for (int k = 0; k < 4; ++k) { const ushort4 yb = *(const ushort4*)(p.yb + rows[k] * 1024 + c); v.x += bf2f(yb.x); v.y += bf2f(yb.y); v.z += bf2f(yb.z); v.w += bf2f(yb.w); }
            y[m] = v; s += v.x + v.y + v.z + v.w;
        }
        const float mean = wave_sum(s) * (1.0f / 1024.0f);
        float q = 0.f;
#pragma unroll
        for (int m = 0; m < 4; ++m) { y[m].x -= mean; y[m].y -= mean; y[m].z -= mean; y[m].w -= mean; q += y[m].x * y[m].x + y[m].y * y[m].y + y[m].z * y[m].z + y[m].w * y[m].w; }
        const float rs = rsqrtf(wave_sum(q) * (1.0f / 1024.0f) + 1e-5f);
#pragma unroll
        for (int m = 0; m < 4; ++m) {
            const int c = m * 256 + lane * 4;
            const float4 g = *(const float4*)(g2 + c), bb = *(const float4*)(b2 + c);
            float4 xv; xv.x = y[m].x * rs * g.x + bb.x; xv.y = y[m].y * rs * g.y + bb.y; xv.z = y[m].z * rs * g.z + bb.z; xv.w = y[m].w * rs * g.w + bb.w;
            *(float4*)(dstf + (size_t)t * 1024 + c) = xv;
            ushort4 ob; ob.x = f2bf(xv.x); ob.y = f2bf(xv.y); ob.z = f2bf(xv.z); ob.w = f2bf(xv.w);
            *(ushort4*)(p.xb + (size_t)t * 1024 + c) = ob;
        }
    }
}

constexpr int PH_PRO = 0, PH_INPROJ = 1, PH_PREP = 2, PH_RETKV = 3, PH_RETSCAN = 4, PH_RETOUT = 5, PH_DIL = 6, PH_RWKVPREP = 7, PH_RWKVSCAN = 8, PH_MLAUP = 9,
              PH_MLAATTN = 10, PH_FINAL = 11, PH_OUTPROJ = 12, PH_LN1 = 13, PH_GU = 14, PH_DN = 15, PH_LN2 = 16;

template <int ph>
__global__ void __launch_bounds__(NTHREADS, 2) mega(Params p, int l) {
    extern __shared__ __attribute__((aligned(16))) char lds[];
    if (ph == PH_PRO) ph_prologue(p, lds);
    if (ph == PH_INPROJ) ph_inproj(p, l, lds);
    if (ph == PH_PREP) ph_rope_prep(p, l);
    if (ph == PH_RETKV) ph_ret_kv(p, l);
    if (ph == PH_RETSCAN) ph_ret_scan(p, l);
    if (ph == PH_RETOUT) ph_ret_out(p, l);
    if (ph == PH_DIL) ph_dil_attn(p, l);
    if (ph == PH_RWKVPREP) ph_rwkv_prep(p, l, lds);
    if (ph == PH_RWKVSCAN) ph_rwkv_scan(p, l);
    if (ph == PH_MLAUP) ph_mla_up(p, l, lds);
    if (ph == PH_MLAATTN) ph_mla_attn(p, l, lds);
    if (ph == PH_FINAL) ph_finalize_mix(p, l);
    if (ph == PH_OUTPROJ) ph_outproj(p, l, lds);
    if (ph == PH_LN1) ph_ln1_router(p, l, lds);
    if (ph == PH_GU) ph_moe_gu(p, l, lds);
    if (ph == PH_DN) ph_moe_dn(p, l, lds);
    if (ph == PH_LN2) ph_combine_ln2(p, l, lds);
}
template <int PH> static void launch_ph(const Params& p, int l, hipStream_t stream) {
    static bool attr_set = false;
    if (!attr_set) { (void)hipFuncSetAttribute((const void*)mega<PH>, hipFuncAttributeMaxDynamicSharedMemorySize, LDS_BYTES); attr_set = true; }
    hipLaunchKernelGGL(mega<PH>, dim3(256), dim3(NTHREADS), LDS_BYTES, stream, p, l);
}
template <int PH> static void launch_layer(const Params& p, int l, hipStream_t stream) {
    launch_ph<PH>(p, l, stream);
    if constexpr (PH < PH_LN2) launch_layer<PH + 1>(p, l, stream);
}

__global__ void __launch_bounds__(NTHREADS, 2) mega_fused(Params p) {
    extern __shared__ __attribute__((aligned(16))) char lds[];
    volatile LAS unsigned* xbw = (volatile LAS unsigned*)(lds + LDS_BYTES - 16);
    if (threadIdx.x == 0) { xbw[0] = 0u; xbw[1] = 0u; xbw[2] = 0u; xbw[3] = 0u; }
    __syncthreads();
    XcdBarrier bar = xcd_barrier_post(p.bar, xbw);
    ph_prologue(p, lds);
    xcd_barrier(bar);
    for (int l = 0; l < DEPTH; ++l) {
        ph_inproj(p, l, lds);
        xcd_barrier(bar);
        ph_rope_prep(p, l);
        xcd_barrier(bar);
        ph_ret_kv(p, l); ph_rwkv_prep(p, l, lds); ph_mla_up(p, l, lds); ph_dil_attn(p, l);
        xcd_barrier(bar);
        ph_ret_scan(p, l); ph_mla_attn(p, l, lds); ph_rwkv_scan(p, l);
        xcd_barrier(bar);
        ph_ret_out(p, l); ph_finalize_mix(p, l);
        xcd_barrier(bar);
        ph_outproj(p, l, lds);
        xcd_barrier(bar);
        ph_ln1_router(p, l, lds);
        xcd_barrier(bar);
        ph_moe_gu(p, l, lds);
        xcd_barrier(bar);
        ph_moe_dn(p, l, lds);
        xcd_barrier(bar);
        ph_combine_ln2(p, l, lds);
        xcd_barrier(bar);
    }
}

struct Carver { char* base; size_t off; template <class T> T* take(size_t n) { T* r = (T*)(base + off); off += ((n * sizeof(T) + 255) / 256) * 256; return r; } };

extern "C" void kernel_launch(void* const* d_in, const int* in_sizes, int n_in, void* d_out, int out_size, void* d_ws, size_t ws_size, hipStream_t stream) {
    Params p; memset(&p, 0, sizeof(p));
    const float** ip = (const float**)&p;
    for (int i = 0; i < 35; ++i) ip[i] = (const float*)d_in[i];
    p.out = (float*)d_out;
    Carver c{(char*)d_ws, 0};
    p.bar = c.take<unsigned>(4096); p.cnt = c.take<int>(DEPTH * NE);
    p.tab_ret = c.take<float>((size_t)SEQ * 32); p.tab_dil = c.take<float>((size_t)SEQ * 16); p.tab_mla = c.take<float>((size_t)SEQ * 32);
    p.win_t = c.take<bf16_t>((size_t)DEPTH * NINP * 1024); p.wout_t = c.take<bf16_t>((size_t)DEPTH * 1024 * 1024);
    p.wgu_t = c.take<bf16_t>((size_t)DEPTH * NE * 2048 * 1024); p.wdn_t = c.take<bf16_t>((size_t)DEPTH * NE * 1024 * 1024);
    p.wq_t = c.take<bf16_t>((size_t)DEPTH * 384 * 256); p.wkv_t = c.take<bf16_t>((size_t)DEPTH * 512 * 128);
    p.xf = c.take<float>((size_t)NT * DM); p.xb = c.take<bf16_t>((size_t)NT * DM); p.pbuf = c.take<bf16_t>((size_t)NT * NINP);
    p.mixcat = c.take<bf16_t>((size_t)NT * DM); p.y1 = c.take<float>((size_t)NT * DM); p.x1b = c.take<bf16_t>((size_t)NT * DM);
    p.rq = c.take<float>((size_t)NT * 128); p.rk = c.take<float>((size_t)NT * 128);
    p.rkv = c.take<float>((size_t)NBATCH * NCH * 4 * 32 * 64); p.rstate = c.take<float>((size_t)NBATCH * NCH * 4 * 32 * 64);
    p.dq = c.take<float>((size_t)NT * 256); p.dk = c.take<float>((size_t)NT * 256); p.dob = c.take<float>((size_t)NT * 256);
    p.sr = c.take<float>((size_t)NT * 256); p.sw = c.take<float>((size_t)NT * 256); p.sk = c.take<float>((size_t)NT * 256); p.sv = c.take<float>((size_t)NT * 256);
    p.sa = c.take<float>((size_t)NT * 256); p.sb = c.take<float>((size_t)NT * 256); p.sg = c.take<float>((size_t)NT * 256); p.sy = c.take<float>((size_t)NT * 256);
    p.vfirst = c.take<float>((size_t)NT * 256);
    p.rsq = c.take<float>(NT); p.rskv = c.take<float>(NT); p.kpe = c.take<float>((size_t)NT * 32);
    p.qu = c.take<float>((size_t)NT * 384); p.kvu = c.take<float>((size_t)NT * 512); p.mo = c.take<float>((size_t)NT * 256);
    p.rowtok = c.take<int>((size_t)NE * NT); p.toke = c.take<int>((size_t)NT * 4); p.tokpos = c.take<int>((size_t)NT * 4); p.rowgate = c.take<float>((size_t)NE * NT);
    p.act = c.take<bf16_t>((size_t)MOE_MAXROWS * 1024); p.yb = c.take<bf16_t>((size_t)MOE_MAXROWS * 1024);
    if (c.off > ws_size) { fprintf(stderr, "workspace too small: need %zu have %zu\n", c.off, ws_size); return; }

#ifdef MULTI_LAUNCH
    launch_ph<PH_PRO>(p, 0, stream);
    for (int l = 0; l < DEPTH; ++l) launch_layer<PH_INPROJ>(p, l, stream);
#else
    static int grid = 0;
    if (!grid) {
        (void)hipFuncSetAttribute((const void*)mega_fused, hipFuncAttributeMaxDynamicSharedMemorySize, LDS_BYTES);
        int dev = 0, cus = 0, per_cu = 0;
        (void)hipGetDevice(&dev);
        (void)hipDeviceGetAttribute(&cus, hipDeviceAttributeMultiprocessorCount, dev);
        (void)hipOccupancyMaxActiveBlocksPerMultiprocessor(&per_cu, mega_fused, NTHREADS, LDS_BYTES);
        if (cus <= 0) cus = 256;
        grid = cus * (per_cu < 1 ? 1 : 1);
    }
    (void)hipMemsetAsync(p.bar, 0, XCD_BAR_WORDS * sizeof(unsigned), stream);
    hipLaunchKernelGGL(mega_fused, dim3(grid), dim3(NTHREADS), LDS_BYTES, stream, p);
#endif
}
```

```cpp
#include <hip/hip_runtime.h>
#include <stdint.h>
#include <string.h>
#include <stdio.h>

typedef unsigned short bf16_t;
typedef short bf16x8 __attribute__((ext_vector_type(8)));
typedef float f32x4 __attribute__((ext_vector_type(4)));
typedef unsigned u32x4 __attribute__((ext_vector_type(4)));
typedef float f32x16 __attribute__((ext_vector_type(16)));
typedef short s16x4 __attribute__((ext_vector_type(4)));
typedef float f32x2_t __attribute__((ext_vector_type(2)));
typedef __bf16 bf16x2_t __attribute__((ext_vector_type(2)));

constexpr int NT = 32768, SEQ = 8192, NBATCH = 4, DM = 1024, NIN = 2976, NINP = 3072, DEPTH = 4, NE = 32, TOPK = 4;
constexpr int BLK = 128, NCH = SEQ / BLK;
constexpr float ALPHA = 1.6817928305074292f;
constexpr int PC_RQ = 0, PC_RK = 128, PC_RV = 256, PC_RG = 512, PC_DQ = 768, PC_DK = 1024, PC_DV = 1280;
constexpr int PC_C = 1536, PC_CR = 1536, PC_CK = 1792, PC_CV = 2048, PC_CWD = 2304, PC_CAD = 2368, PC_CGD = 2432;
constexpr int PC_MQ = 2560, PC_MKV = 2816, PC_MKR = 2944, PC_VRES = 2976;
constexpr int MOE_TM = 256;
constexpr int MOE_MAXROWS = NT * TOPK + NE * MOE_TM;
constexpr int NTHREADS = 512;
constexpr int LDS_BYTES = 147456;

__device__ __forceinline__ bf16_t f2bf(float f) { unsigned u = __float_as_uint(f); u += 0x7fffu + ((u >> 16) & 1u); return (bf16_t)(u >> 16); }
__device__ __forceinline__ unsigned cvtpk(float lo, float hi) { f32x2_t v = {lo, hi}; bf16x2_t b = __builtin_convertvector(v, bf16x2_t); return __builtin_bit_cast(unsigned, b); }
__device__ __forceinline__ float xhalf_max(float v) { auto rr = __builtin_amdgcn_permlane32_swap(__float_as_uint(v), __float_as_uint(v), false, false); return fmaxf(__uint_as_float(rr[0]), __uint_as_float(rr[1])); }
__device__ __forceinline__ float xhalf_sum(float v) { auto rr = __builtin_amdgcn_permlane32_swap(__float_as_uint(v), __float_as_uint(v), false, false); return __uint_as_float(rr[0]) + __uint_as_float(rr[1]); }
__device__ __forceinline__ float bf2f(bf16_t h) { return __uint_as_float(((unsigned)h) << 16); }
template <int CTRL> __device__ __forceinline__ float dpp_f(float v) { return __int_as_float(__builtin_amdgcn_update_dpp(0, __float_as_int(v), CTRL, 0xF, 0xF, true)); }
__device__ __forceinline__ float grp16_sum(float v) {
    v += dpp_f<0x128>(v); v += dpp_f<0x124>(v); v += dpp_f<0x122>(v); v += dpp_f<0x121>(v); return v; }
__device__ __forceinline__ float wave_sum(float v) {
    v = grp16_sum(v);
    const int i = __float_as_int(v);
    return (__int_as_float(__builtin_amdgcn_readlane(i, 0)) + __int_as_float(__builtin_amdgcn_readlane(i, 16))) +
           (__int_as_float(__builtin_amdgcn_readlane(i, 32)) + __int_as_float(__builtin_amdgcn_readlane(i, 48))); }
__device__ __forceinline__ float sigmoidf_(float x) { return 1.0f / (1.0f + __expf(-x)); }

#define XB_TMO      128
#define XB_XCNT(j)  (256  + 64 * (j))
#define XB_XSUB(j)  (1280 + 64 * (j))
#define XB_XGEN(j)  (2304 + 64 * (j))
#define XB_TOP      3328
#define XB_TOPGEN   3392
#define XCD_BAR_WORDS 3456
#define XB_SPIN_CAP (1u << 22)
#define LAS __attribute__((address_space(3)))
__device__ __forceinline__ unsigned xb_ld(unsigned* p)              { return __hip_atomic_load(p, __ATOMIC_RELAXED, __HIP_MEMORY_SCOPE_AGENT); }
__device__ __forceinline__ unsigned xb_add(unsigned* p, unsigned v) { return __hip_atomic_fetch_add(p, v, __ATOMIC_RELAXED, __HIP_MEMORY_SCOPE_AGENT); }
__device__ __forceinline__ unsigned xb_xcc_id() { return (unsigned)__builtin_amdgcn_s_getreg((3 << 11) | 20) & 0xFu; }
#define XB_SPIN(cond, bar) do { unsigned _sp = 0; while (cond) { __builtin_amdgcn_s_sleep(1); \
    if ((++_sp & 255u) == 0u) { if (xb_ld(&(bar)[XB_TMO])) break; if (_sp > XB_SPIN_CAP) { atomicAdd(&(bar)[XB_TMO], 1u); break; } } } } while (0)
struct XcdBarrier { unsigned* bar; unsigned x; volatile LAS unsigned* st; };
__device__ __forceinline__ XcdBarrier xcd_barrier_post(unsigned* bar, volatile LAS unsigned* st) {
    XcdBarrier b; b.bar = bar; b.x = xb_xcc_id(); b.st = st;
    if (threadIdx.x == 0) (void)xb_add(&bar[XB_XCNT(b.x)], 1u);
    return b;
}
__device__ __forceinline__ void xcd_barrier_complete(unsigned* bar, unsigned x, unsigned& nloc, unsigned& nx) {
    const unsigned G = gridDim.x * gridDim.y * gridDim.z;
    unsigned sum, cnt, mine, sp = 0u;
    for (;;) {
        sum = 0u; cnt = 0u; mine = 0u;
#pragma unroll
        for (unsigned j = 0; j < 16; ++j) { const unsigned c = xb_ld(&bar[XB_XCNT(j)]); sum += c; cnt += (c > 0u) ? 1u : 0u; mine = (j == x) ? c : mine; }
        if (sum == G) break;
        __builtin_amdgcn_s_sleep(1);
        if ((++sp & 255u) == 0u) { if (xb_ld(&bar[XB_TMO])) break; if (sp > XB_SPIN_CAP) { atomicAdd(&bar[XB_TMO], 1u); break; } }
    }
    nloc = mine > 0u ? mine : 1u; nx = cnt > 0u ? cnt : 1u;
}
__device__ __forceinline__ void xcd_barrier(const XcdBarrier& b, const int tid0) {
    asm volatile("s_waitcnt vmcnt(0)" ::: "memory");
    __syncthreads();
    if (tid0 == 0) {
        unsigned* bar = b.bar;
        __builtin_amdgcn_s_waitcnt(0);
        unsigned nloc = b.st[0], nx = b.st[1];
        if (nloc == 0u) { xcd_barrier_complete(bar, b.x, nloc, nx); b.st[0] = nloc; b.st[1] = nx; }
        const unsigned old = xb_add(&bar[XB_XSUB(b.x)], 1u);
        const unsigned gen = old / nloc;
        if (old + 1u == (gen + 1u) * nloc) {
            __builtin_amdgcn_fence(__ATOMIC_RELEASE, "agent");
            asm volatile("s_waitcnt vmcnt(0)" ::: "memory");
            const unsigned og = xb_add(&bar[XB_TOP], 1u);
            const unsigned tg = og / nx;
            if (og + 1u == (tg + 1u) * nx) xb_add(&bar[XB_TOPGEN], 1u);
            else XB_SPIN(xb_ld(&bar[XB_TOPGEN]) == tg, bar);
            __builtin_amdgcn_fence(__ATOMIC_ACQUIRE, "agent");
            xb_add(&bar[XB_XGEN(b.x)], 1u);
            asm volatile("s_waitcnt vmcnt(0)" ::: "memory");
        } else {
            XB_SPIN(xb_ld(&bar[XB_XGEN(b.x)]) == gen, bar);
            __builtin_amdgcn_fence(__ATOMIC_ACQUIRE, "agent");
            asm volatile("s_waitcnt vmcnt(0)" ::: "memory");
        }
    }
    __syncthreads();
}

struct Params {
    const float *x, *w_in, *w_out, *ret_norm_g, *dil_norm_g, *rwkv_mu, *rwkv_w0, *rwkv_w_up, *rwkv_a0, *rwkv_a_up, *rwkv_g_up, *rwkv_k_k, *rwkv_k_a,
        *rwkv_r_k, *rwkv_ln_g, *rwkv_ln_b, *vres_down, *vres_mu, *rwkv_v0, *rwkv_v_up, *mla_q_norm_g, *mla_w_q_up, *mla_kv_norm_g, *mla_w_kv_up,
        *mla_out_norm_g, *ln1_g, *ln1_b, *router_w, *router_b, *w_gu, *b_gu, *w_dn, *b_dn, *ln2_g, *ln2_b;
    float* out;
    unsigned* bar; int* cnt;
    float *tab_ret, *tab_dil, *tab_mla;
    bf16_t *win_t, *wout_t, *wgu_t, *wdn_t, *wq_t, *wkv_t;
    float* xf; bf16_t* xb; bf16_t* pbuf; bf16_t* mixcat; float* y1; bf16_t* x1b;
    float *rq, *rk, *rkv, *rstate;
    float *dq, *dk, *dob, *dlse;
    float *sr, *sw, *sk, *sv, *sa, *sb, *sg, *sy, *vfirst;
    float *rsq, *rskv, *kpe, *qu, *kvu, *mo;
    bf16_t *mq, *mk, *mv;
    int *rowtok, *toke, *tokpos; float* rowgate; bf16_t *act, *yb;
};

__device__ __forceinline__ int opq_tid(int wbase) { unsigned z = 0u; asm volatile("" : "+s"(z)); int t = wbase | (int)__builtin_amdgcn_mbcnt_hi(~0u, __builtin_amdgcn_mbcnt_lo(~0u, z)); asm volatile("" : "+v"(t)); return t; }
__device__ __forceinline__ int opq_bid() { int b = blockIdx.x; asm volatile("" : "+s"(b)); return b; }
typedef const __attribute__((address_space(4))) Params* KPtr;
typedef const __attribute__((address_space(4))) Params& KRef;
__device__ __forceinline__ KPtr kp_launder(KPtr k) {
    const unsigned long long v = (unsigned long long)k;
    unsigned lo = (unsigned)v, hi = (unsigned)(v >> 32);
    asm volatile("" : "+s"(lo), "+s"(hi));
    return (KPtr)(((unsigned long long)hi << 32) | lo);
}
#define PH_HEADV (void)kp_in; const Params& p = pkv; const int TID = opq_tid(wbase_in), BID = opq_bid(); (void)TID; (void)BID;
#define PH_HEAD (void)pkv; KPtr kp_ = kp_launder(kp_in); KRef p = *kp_; const int TID = opq_tid(wbase_in), BID = opq_bid(); (void)TID; (void)BID;
template <class F>
__device__ __forceinline__ void tr_tile(F f, bf16_t* dst, int ldd, int k0, int n0, float* tile, const int TID) {
    const int tid = TID;
#pragma unroll
    for (int i = 0; i < 8; ++i) { const int e = tid + i * NTHREADS, kk = e >> 6, nn = e & 63; tile[kk * 65 + nn] = f(k0 + kk, n0 + nn); }
    __syncthreads();
#pragma unroll
    for (int i = 0; i < 8; ++i) { const int e = tid + i * NTHREADS, nn = e >> 6, kk = e & 63; dst[(size_t)(n0 + nn) * ldd + k0 + kk] = f2bf(tile[kk * 65 + nn]); }
    __syncthreads();
}

__device__ void ph_prologue(const Params& pkv, KPtr kp_in, int wbase_in, char* lds) {
    PH_HEAD
    float* tile = (float*)lds;
    const int nb = gridDim.x, bid = BID, tid = TID;
    for (int t = bid; t < DEPTH * NE * 16 * 32; t += nb) {
        const int le = t >> 9, r = t & 511, tk = r >> 5, tn = r & 31;
        const float* src = p.w_gu + (size_t)le * 1024 * 2048;
        tr_tile([&](int k, int n) { return src[(size_t)k * 2048 + n]; }, p.wgu_t + (size_t)le * 2048 * 1024, 1024, tk * 64, tn * 64, tile, TID);
    }
    for (int t = bid; t < DEPTH * NE * 16 * 16; t += nb) {
        const int le = t >> 8, r = t & 255, tk = r >> 4, tn = r & 15;
        const float* src = p.w_dn + (size_t)le * 1024 * 1024;
        tr_tile([&](int k, int n) { return src[(size_t)k * 1024 + n]; }, p.wdn_t + (size_t)le * 1024 * 1024, 1024, tk * 64, tn * 64, tile, TID);
    }
    for (int t = bid; t < DEPTH * 16 * 48; t += nb) {
        const int l = t / (16 * 48), r = t % (16 * 48), tk = r / 48, tn = r % 48;
        const float* src = p.w_in + (size_t)l * 1024 * NIN;
        const float* vr = p.vres_down + (size_t)(l > 0 ? l - 1 : 0) * 1024 * 32;
        tr_tile([&](int k, int n) { return n < NIN ? src[(size_t)k * NIN + n] : ((n < NIN + 32 && l > 0) ? vr[k * 32 + (n - NIN)] : 0.0f); },
                p.win_t + (size_t)l * NINP * 1024, 1024, tk * 64, tn * 64, tile, TID);
    }
    for (int t = bid; t < DEPTH * 16 * 16; t += nb) {
        const int l = t >> 8, r = t & 255, tk = r >> 4, tn = r & 15;
        const float* src = p.w_out + (size_t)l * 1024 * 1024;
        tr_tile([&](int k, int n) { return src[(size_t)k * 1024 + n]; }, p.wout_t + (size_t)l * 1024 * 1024, 1024, tk * 64, tn * 64, tile, TID);
    }
    for (int t = bid; t < DEPTH * 4 * 6; t += nb) {
        const int l = t / 24, r = t % 24, tk = r / 6, tn = r % 6;
        const float* src = p.mla_w_q_up + (size_t)l * 256 * 384; const float* g = p.mla_q_norm_g + l * 256;
        tr_tile([&](int k, int n) { return src[k * 384 + n] * g[k]; }, p.wq_t + (size_t)l * 384 * 256, 256, tk * 64, tn * 64, tile, TID);
    }
    for (int t = bid; t < DEPTH * 2 * 8; t += nb) {
        const int l = t / 16, r = t % 16, tk = r / 8, tn = r % 8;
        const float* src = p.mla_w_kv_up + (size_t)l * 128 * 512; const float* g = p.mla_kv_norm_g + l * 128;
        tr_tile([&](int k, int n) { return src[k * 512 + n] * g[k]; }, p.wkv_t + (size_t)l * 512 * 128, 128, tk * 64, tn * 64, tile, TID);
    }
    for (int i = bid * NTHREADS + tid; i < SEQ * 40; i += nb * NTHREADS) {
        const int pos = i / 40, j = i % 40;
        double theta, rot; int f; float* dst;
        if (j < 16) { theta = 10000.0; rot = 32.0; f = j; dst = p.tab_ret + ((size_t)pos * 16 + f) * 2; }
        else if (j < 24) { theta = 500000.0; rot = 16.0; f = j - 16; dst = p.tab_dil + ((size_t)pos * 8 + f) * 2; }
        else { theta = 10000.0; rot = 32.0; f = j - 24; dst = p.tab_mla + ((size_t)pos * 16 + f) * 2; }
        const double inv = 1.0 / pow(theta, (2.0 * f) / rot), ang = (double)pos * inv;
        dst[0] = (float)cos(ang); dst[1] = (float)sin(ang);
    }
    for (size_t i = (size_t)bid * NTHREADS + tid; i < (size_t)NT * DM / 4; i += (size_t)nb * NTHREADS) {
        const float4 v = ((const float4*)p.x)[i];
        ushort4 o; o.x = f2bf(v.x); o.y = f2bf(v.y); o.z = f2bf(v.z); o.w = f2bf(v.w);
        ((ushort4*)p.xb)[i] = o;
    }
    if (bid == 0 && tid < DEPTH * NE) p.cnt[tid] = 0;
}

template <class Epi>
__device__ __forceinline__ void gemm_tile128(const bf16_t* __restrict__ A, int lda, const int* __restrict__ rowidx, int nvalid,
                                             const bf16_t* __restrict__ Bt, int ldb, int K, char* lds, const int TID, Epi epi) {
    constexpr int LDT = 72;
    bf16_t* As = (bf16_t*)lds; bf16_t* Bs = As + 128 * LDT;
    const int tid = TID, lane = tid & 63, wid = tid >> 6, wm = wid >> 2, wn = wid & 3, fr = lane & 15, fq = lane >> 4;
    const bf16_t* ap[2]; const bf16_t* bp[2]; int so[2];
#pragma unroll
    for (int i = 0; i < 2; ++i) {
        const int c = tid + i * NTHREADS, row = c >> 3, kc = c & 7;
        int ar = row; if (rowidx) ar = (row < nvalid) ? rowidx[row] : rowidx[0];
        ap[i] = A + (size_t)ar * lda + kc * 8; bp[i] = Bt + (size_t)row * ldb + kc * 8; so[i] = row * LDT + kc * 8;
    }
    f32x4 acc[4][2];
#pragma unroll
    for (int mi = 0; mi < 4; ++mi)
#pragma unroll
        for (int ni = 0; ni < 2; ++ni) acc[mi][ni] = (f32x4){0.f, 0.f, 0.f, 0.f};
    u32x4 ra0, ra1, rb0, rb1;
    ra0 = *(const u32x4*)(ap[0]); ra1 = *(const u32x4*)(ap[1]); rb0 = *(const u32x4*)(bp[0]); rb1 = *(const u32x4*)(bp[1]);
    const int nk = K >> 6;
    for (int kt = 0; kt < nk; ++kt) {
        __syncthreads();
        *(u32x4*)(As + so[0]) = ra0; *(u32x4*)(As + so[1]) = ra1; *(u32x4*)(Bs + so[0]) = rb0; *(u32x4*)(Bs + so[1]) = rb1;
        __syncthreads();
        if (kt + 1 < nk) {
            const int ko = (kt + 1) * 64;
            ra0 = *(const u32x4*)(ap[0] + ko); ra1 = *(const u32x4*)(ap[1] + ko); rb0 = *(const u32x4*)(bp[0] + ko); rb1 = *(const u32x4*)(bp[1] + ko);
        }
#pragma unroll
        for (int kk = 0; kk < 2; ++kk) {
            bf16x8 af[4], bfr[2];
#pragma unroll
            for (int mi = 0; mi < 4; ++mi) af[mi] = *(const bf16x8*)(As + (wm * 64 + mi * 16 + fr) * LDT + kk * 32 + fq * 8);
#pragma unroll
            for (int ni = 0; ni < 2; ++ni) bfr[ni] = *(const bf16x8*)(Bs + (wn * 32 + ni * 16 + fr) * LDT + kk * 32 + fq * 8);
#pragma unroll
            for (int mi = 0; mi < 4; ++mi)
#pragma unroll
                for (int ni = 0; ni < 2; ++ni) acc[mi][ni] = __builtin_amdgcn_mfma_f32_16x16x32_bf16(bfr[ni], af[mi], acc[mi][ni], 0, 0, 0);
        }
    }
#pragma unroll
    for (int mi = 0; mi < 4; ++mi)
#pragma unroll
        for (int ni = 0; ni < 2; ++ni) epi(wm * 64 + mi * 16 + fr, wn * 32 + ni * 16 + fq * 4, acc[mi][ni]);
    __syncthreads();
}

__device__ __forceinline__ int g8_lds_byte(int r, int c) { const int st = (r >> 4) * 2 + (c >> 5), rr = r & 15, cc = c & 31, ob = rr * 64 + cc * 2; return st * 1024 + (ob ^ (((ob >> 9) & 1) << 5)); }
__device__ __forceinline__ void g8_stage_rc(int b, int& R, int& C) { const int st = b / 1024, sb = b % 1024, swz = sb ^ (((sb >> 9) & 1) << 5); R = (st >> 1) * 16 + swz / 64; C = (st & 1) * 32 + (swz % 64) / 2; }
template <class Epi>
__device__ __forceinline__ void gemm_tile256(const bf16_t* __restrict__ A, int lda, const int* __restrict__ rowidx, int nvalid,
                                             const bf16_t* __restrict__ Bt, int ldb, int K, char* lds, const int TID, Epi epi) {
    constexpr int G_HT = 128 * 64;
    bf16_t* shm = (bf16_t*)lds;
#define G8_SA(b, h) (shm + ((b) * 2 + (h)) * G_HT)
#define G8_SB(b, h) (shm + (4 + (b) * 2 + (h)) * G_HT)
#define G8_SPTR(dst, src) do { unsigned long long _v = (unsigned long long)(src); unsigned _lo = (unsigned)_v, _hi = (unsigned)(_v >> 32); asm volatile("" : "+s"(_lo), "+s"(_hi)); \
        dst = (const char*)(((unsigned long long)_hi << 32) | _lo); } while (0)
#define G8_STAGE(P, BASE, OFF, kt) do { const char* _sb; G8_SPTR(_sb, (const char*)(BASE) + (size_t)(kt) * 128); _Pragma("unroll") for (int _i = 0; _i < 2; ++_i) { \
        __builtin_amdgcn_global_load_lds((const unsigned*)(_sb + (size_t)(OFF)[_i]), (unsigned*)((char*)(P) + tz * 16 + _i * 8192), 16, 0, 0); } } while (0)
#define G8_LDA(dst, b, h) _Pragma("unroll") for (int m = 0; m < 4; ++m) _Pragma("unroll") for (int k = 0; k < 2; ++k) \
        dst[m][k] = *reinterpret_cast<const bf16x8*>((char*)G8_SA(b, h) + g8_lds_byte(wr * 64 + m * 16 + fr, k * 32 + fq * 8))
#define G8_LDB(dst, b, h) _Pragma("unroll") for (int n = 0; n < 2; ++n) _Pragma("unroll") for (int k = 0; k < 2; ++k) \
        dst[n][k] = *reinterpret_cast<const bf16x8*>((char*)G8_SB(b, h) + g8_lds_byte(wc * 32 + n * 16 + fr, k * 32 + fq * 8))
#define G8_MMA(ai, bj, At_, Bt_) do { __builtin_amdgcn_s_setprio(1); \
        _Pragma("unroll") for (int m = 0; m < 4; ++m) _Pragma("unroll") for (int n = 0; n < 2; ++n) _Pragma("unroll") for (int k = 0; k < 2; ++k) \
            acc[ai][bj][m][n] = __builtin_amdgcn_mfma_f32_16x16x32_bf16(Bt_[n][k], At_[m][k], acc[ai][bj][m][n], 0, 0, 0); \
        __builtin_amdgcn_s_setprio(0); } while (0)
#define G8_WAIT_V(n) asm volatile("s_waitcnt vmcnt(" #n ")" ::: "memory")
#define G8_WAIT_L(n) asm volatile("s_waitcnt lgkmcnt(" #n ")" ::: "memory")
#define G8_BAR __builtin_amdgcn_s_barrier()
#define G8_SCHED __builtin_amdgcn_sched_barrier(0)
    int tz = opq_tid(TID);
    int wid = tz >> 6, lane = tz & 63, wr = wid >> 2, wc = wid & 3, fr = lane & 15, fq = lane >> 4;
    unsigned aoff0[2], aoff1[2], boff0[2];
#pragma unroll
    for (int i = 0; i < 2; ++i) {
        int r, c; g8_stage_rc(tz * 16 + i * 8192, r, c);
        int r0 = r, r1 = 128 + r;
        if (rowidx) { r0 = (r0 < nvalid) ? rowidx[r0] : rowidx[0]; r1 = (r1 < nvalid) ? rowidx[r1] : rowidx[0]; }
        aoff0[i] = (unsigned)(r0 * lda + c) * 2u; aoff1[i] = (unsigned)(r1 * lda + c) * 2u;
        boff0[i] = (unsigned)(r * ldb + c) * 2u;
    }
    const bf16_t* Bt1 = Bt + (size_t)128 * ldb;
    f32x4 acc[2][2][4][2];
#pragma unroll
    for (int a = 0; a < 2; ++a)
#pragma unroll
        for (int b = 0; b < 2; ++b)
#pragma unroll
            for (int m = 0; m < 4; ++m)
#pragma unroll
                for (int n = 0; n < 2; ++n) acc[a][b][m][n] = (f32x4){0.f, 0.f, 0.f, 0.f};
    bf16x8 At[4][2], B0[2][2], B1[2][2];
    const int nt = K / 64;
    G8_STAGE(G8_SB(0, 0), Bt, boff0, 0); G8_STAGE(G8_SA(0, 0), A, aoff0, 0);
    G8_STAGE(G8_SB(0, 1), Bt1, boff0, 0); G8_STAGE(G8_SA(0, 1), A, aoff1, 0);
    if (wr == 1) G8_BAR;
    G8_WAIT_V(4); G8_BAR;
    G8_STAGE(G8_SB(1, 0), Bt, boff0, 1); G8_STAGE(G8_SA(1, 0), A, aoff0, 1); G8_STAGE(G8_SB(1, 1), Bt1, boff0, 1);
    G8_WAIT_V(6); G8_BAR;
    for (int t = 0; t < nt - 2; t += 2) {
        G8_LDB(B0, 0, 0); G8_SCHED; G8_LDA(At, 0, 0); G8_STAGE(G8_SA(1, 1), A, aoff1, t + 1);
        G8_WAIT_L(8); G8_BAR; G8_WAIT_L(0); G8_MMA(0, 0, At, B0); G8_BAR; G8_SCHED;
        G8_LDB(B1, 0, 1); G8_STAGE(G8_SB(0, 0), Bt, boff0, t + 2);
        G8_BAR; G8_WAIT_L(0); G8_MMA(0, 1, At, B1); G8_BAR;
        G8_LDA(At, 0, 1); G8_STAGE(G8_SA(0, 0), A, aoff0, t + 2);
        G8_BAR; G8_WAIT_L(0); G8_MMA(1, 0, At, B0); G8_BAR; G8_SCHED;
        G8_STAGE(G8_SB(0, 1), Bt1, boff0, t + 2);
        G8_WAIT_V(6); G8_BAR; G8_MMA(1, 1, At, B1); G8_BAR;
        G8_LDB(B0, 1, 0); G8_SCHED; G8_LDA(At, 1, 0); G8_STAGE(G8_SA(0, 1), A, aoff1, t + 2);
        G8_WAIT_L(8); G8_BAR; G8_WAIT_L(0); G8_MMA(0, 0, At, B0); G8_BAR; G8_SCHED;
        G8_LDB(B1, 1, 1); G8_STAGE(G8_SB(1, 0), Bt, boff0, t + 3);
        G8_BAR; G8_WAIT_L(0); G8_MMA(0, 1, At, B1); G8_BAR;
        G8_LDA(At, 1, 1); G8_STAGE(G8_SA(1, 0), A, aoff0, t + 3);
        G8_BAR; G8_WAIT_L(0); G8_MMA(1, 0, At, B0); G8_BAR; G8_SCHED;
        G8_STAGE(G8_SB(1, 1), Bt1, boff0, t + 3);
        G8_WAIT_V(6); G8_BAR; G8_MMA(1, 1, At, B1); G8_BAR;
    }
    { G8_LDB(B0, 0, 0); G8_WAIT_V(0); G8_LDA(At, 0, 0); G8_STAGE(G8_SA(1, 1), A, aoff1, nt - 1);
      G8_BAR; G8_WAIT_L(0); G8_MMA(0, 0, At, B0); G8_BAR;
      G8_LDB(B1, 0, 1); G8_BAR; G8_WAIT_L(0); G8_MMA(0, 1, At, B1); G8_BAR;
      G8_LDA(At, 0, 1); G8_WAIT_V(4); G8_BAR; G8_WAIT_L(0); G8_MMA(1, 0, At, B0); G8_MMA(1, 1, At, B1); G8_BAR; }
    { G8_LDB(B0, 1, 0); G8_LDA(At, 1, 0); G8_WAIT_V(2); G8_BAR; G8_WAIT_L(0); G8_MMA(0, 0, At, B0); G8_BAR;
      G8_LDB(B1, 1, 1); G8_WAIT_V(0); G8_BAR; G8_WAIT_L(0); G8_MMA(0, 1, At, B1); G8_BAR;
      G8_LDA(At, 1, 1); G8_BAR; G8_WAIT_L(0); G8_MMA(1, 0, At, B0); G8_MMA(1, 1, At, B1); G8_BAR; }
    if (wr == 0) G8_BAR;
    asm volatile("" : "+v"(tz)); wid = tz >> 6; lane = tz & 63; wr = wid >> 2; wc = wid & 3; fr = lane & 15; fq = lane >> 4;
#pragma unroll
    for (int ai = 0; ai < 2; ++ai)
#pragma unroll
        for (int m = 0; m < 4; ++m)
#pragma unroll
            for (int bj = 0; bj < 2; ++bj)
#pragma unroll
                for (int n = 0; n < 2; ++n) epi(ai * 128 + wr * 64 + m * 16 + fr, bj * 128 + wc * 32 + n * 16 + fq * 4, acc[ai][bj][m][n]);
    __syncthreads();
}

__device__ void ph_inproj(const Params& pkv, KPtr kp_in, int wbase_in, int l, char* lds) {
    PH_HEAD
    const bf16_t* Bt = p.win_t + (size_t)l * NINP * 1024;
    const int ntn = NINP / 256, nunits = (NT / 256) * ntn;
    for (int u = BID; u < nunits; u += gridDim.x) {
        const int mt = u / ntn, nt = u % ntn;
        bf16_t* out = p.pbuf + (size_t)mt * 256 * NINP + nt * 256;
        gemm_tile256(p.xb + (size_t)mt * 256 * 1024, 1024, nullptr, 256, Bt + (size_t)nt * 256 * 1024, 1024, 1024, lds, wbase_in,
                     [=](int r, int c, f32x4 v) mutable { ushort4 o; o.x = f2bf(v[0]); o.y = f2bf(v[1]); o.z = f2bf(v[2]); o.w = f2bf(v[3]); *(ushort4*)(out + (size_t)r * NINP + c) = o; });
    }
}

__device__ void ph_rope_prep(const Params& pkv, KPtr kp_in, int wbase_in, int l) {
    PH_HEAD
    const int lane = TID & 63, gw = BID * (NTHREADS / 64) + (TID >> 6), nw = gridDim.x * (NTHREADS / 64);
    for (int t = gw; t < NT; t += nw) {
        const int pos = t % SEQ;
        const bf16_t* pr = p.pbuf + (size_t)t * NINP;
        {
            const int h = lane >> 4, i = lane & 15;
            const float c = p.tab_ret[(pos * 16 + i) * 2], s = p.tab_ret[(pos * 16 + i) * 2 + 1];
            float x1 = bf2f(pr[PC_RQ + h * 32 + i]), x2 = bf2f(pr[PC_RQ + h * 32 + 16 + i]);
            p.rq[(size_t)t * 128 + h * 32 + i] = x1 * c - x2 * s; p.rq[(size_t)t * 128 + h * 32 + 16 + i] = x1 * s + x2 * c;
            x1 = bf2f(pr[PC_RK + h * 32 + i]); x2 = bf2f(pr[PC_RK + h * 32 + 16 + i]);
            const float sc = 0.17677669529663687f;
            p.rk[(size_t)t * 128 + h * 32 + i] = (x1 * c - x2 * s) * sc; p.rk[(size_t)t * 128 + h * 32 + 16 + i] = (x1 * s + x2 * c) * sc;
        }
        {
            for (int e = lane; e < 256; e += 64) {
                const int h = e >> 6, d = e & 63;
                float qv, kv;
                if (d < 16) {
                    const int i = d & 7; const float c = p.tab_dil[(pos * 8 + i) * 2], s = p.tab_dil[(pos * 8 + i) * 2 + 1];
                    const float q1 = bf2f(pr[PC_DQ + h * 64 + i]), q2 = bf2f(pr[PC_DQ + h * 64 + 8 + i]);
                    const float k1 = bf2f(pr[PC_DK + h * 64 + i]), k2 = bf2f(pr[PC_DK + h * 64 + 8 + i]);
                    if (d < 8) { qv = q1 * c - q2 * s; kv = k1 * c - k2 * s; } else { qv = q1 * s + q2 * c; kv = k1 * s + k2 * c; }
                } else { qv = bf2f(pr[PC_DQ + e]); kv = bf2f(pr[PC_DK + e]); }
                ((bf16_t*)p.dq)[(size_t)t * 256 + e] = f2bf(qv * (0.125f * 1.4426950408889634f)); ((bf16_t*)p.dk)[(size_t)t * 256 + e] = f2bf(kv);
            }
        }
        {
            float ss = 0.f;
            for (int e = lane; e < 256; e += 64) { const float v = bf2f(pr[PC_MQ + e]); ss += v * v; }
            ss = wave_sum(ss);
            float s2 = 0.f;
            for (int e = lane; e < 128; e += 64) { const float v = bf2f(pr[PC_MKV + e]); s2 += v * v; }
            s2 = wave_sum(s2);
            if (lane == 0) { p.rsq[t] = rsqrtf(ss * (1.0f / 256.0f) + 1e-6f); p.rskv[t] = rsqrtf(s2 * (1.0f / 128.0f) + 1e-6f); }
            if (lane < 16) {
                const float c = p.tab_mla[(pos * 16 + lane) * 2], s = p.tab_mla[(pos * 16 + lane) * 2 + 1];
                const float x1 = bf2f(pr[PC_MKR + lane]), x2 = bf2f(pr[PC_MKR + 16 + lane]);
                p.kpe[(size_t)t * 32 + lane] = x1 * c - x2 * s; p.kpe[(size_t)t * 32 + 16 + lane] = x1 * s + x2 * c;
            }
        }
    }
}

__device__ __forceinline__ float ret_log_gamma(int h) { return logf(1.0f - exp2f(-5.0f - (float)h)); }

__device__ void ph_ret_kv(const Params& pkv, KPtr kp_in, int wbase_in, int l) {
    PH_HEAD
    const size_t total = (size_t)NBATCH * NCH * 4 * 32 * 64;
    for (size_t i = (size_t)BID * NTHREADS + TID; i < total; i += (size_t)gridDim.x * NTHREADS) {
        const int e = i & 63, d = (i >> 6) & 31, h = (i >> 11) & 3, n = (i >> 13) & 63, b = (int)(i >> 19);
        const float lg = ret_log_gamma(h);
        const int t0 = b * SEQ + n * BLK;
        float acc = 0.f;
        for (int j = 0; j < BLK; ++j) {
            const float z = __expf((float)(BLK - 1 - j) * lg);
            acc += p.rk[(size_t)(t0 + j) * 128 + h * 32 + d] * z * bf2f(p.pbuf[(size_t)(t0 + j) * NINP + PC_RV + h * 64 + e]);
        }
        p.rkv[i] = acc;
    }
}
__device__ void ph_ret_scan(const Params& pkv, KPtr kp_in, int wbase_in, int l) {
    PH_HEAD
    const int i = BID * NTHREADS + TID;
    if (i < NBATCH * 4 * 32 * 64) {
        const int e = i & 63, d = (i >> 6) & 31, h = (i >> 11) & 3, b = i >> 13;
        const float cd = __expf((float)BLK * ret_log_gamma(h));
        float s = 0.f;
        for (int n = 0; n < NCH; ++n) {
            const size_t idx = ((((size_t)b * NCH + n) * 4 + h) * 32 + d) * 64 + e;
            p.rstate[idx] = s; s = cd * s + p.rkv[idx];
        }
    }
}
__device__ void ph_ret_out(const Params& pkv, KPtr kp_in, int wbase_in, int l) {
    PH_HEAD
    const int lane = TID & 63;
    const int nwv = gridDim.x * (NTHREADS / 64);
    for (int w = BID * (NTHREADS / 64) + (TID >> 6); w < NT / 64 * 4; w += nwv) {
        const int h = w & 3, tb = (w >> 2) * 64, t = tb + lane, b = t / SEQ, pos = t % SEQ, n = pos / BLK, i = pos % BLK, c0 = tb - (tb % BLK);
        const float lg = ret_log_gamma(h);
        float q[32], o[64];
#pragma unroll
        for (int d = 0; d < 32; ++d) q[d] = p.rq[(size_t)t * 128 + h * 32 + d];
#pragma unroll
        for (int e = 0; e < 64; ++e) o[e] = 0.f;
        const int jmax = (tb % BLK) + 63;
        for (int j = 0; j <= jmax; ++j) {
            const float* kj = p.rk + (size_t)(c0 + j) * 128 + h * 32;
            float s = 0.f;
#pragma unroll
            for (int d = 0; d < 32; ++d) s += q[d] * kj[d];
            s = (j <= i) ? s * __expf((float)(i - j) * lg) : 0.f;
            const bf16_t* vj = p.pbuf + (size_t)(c0 + j) * NINP + PC_RV + h * 64;
#pragma unroll
            for (int e = 0; e < 64; ++e) o[e] += s * bf2f(vj[e]);
        }
        const float xi = __expf((float)(i + 1) * lg);
        const float* st = p.rstate + (((size_t)b * NCH + n) * 4 + h) * 32 * 64;
        for (int d = 0; d < 32; ++d) {
            const float qd = q[d] * xi;
#pragma unroll
            for (int e = 0; e < 64; ++e) o[e] += qd * st[d * 64 + e];
        }
        float ss = 0.f;
#pragma unroll
        for (int e = 0; e < 64; ++e) ss += o[e] * o[e];
        const float rs = rsqrtf(ss * (1.0f / 64.0f) + 1e-6f);
        const float* ng = p.ret_norm_g + l * 256 + h * 64;
        const bf16_t* gp = p.pbuf + (size_t)t * NINP + PC_RG + h * 64;
        bf16_t* outp = p.mixcat + (size_t)t * 1024 + h * 64;
#pragma unroll
        for (int e = 0; e < 64; ++e) { const float g = bf2f(gp[e]); outp[e] = f2bf(g * sigmoidf_(g) * (o[e] * rs * ng[e])); }
    }
}

__device__ void ph_dil_attn(const Params& pkv, KPtr kp_in, int wbase_in, int l, char* lds) {
    PH_HEAD
    constexpr int KSTR = 72, VSTR = 68;
    bf16_t* Ks = (bf16_t*)lds;
    bf16_t* Vt = Ks + 64 * KSTR;
    const int tid = TID, lane = tid & 63, wv = tid >> 6, r = lane & 31, h = lane >> 5;
    for (int it = BID; it < 16 * 96; it += gridDim.x) {
        const int bh = it & 15, u = it >> 4;
        const int b = bh >> 2, hd = bh & 3;
        int pat, dil, rr, m0;
        if (u < 32) { pat = 0; dil = 1; rr = 0; m0 = u * 256; }
        else if (u < 64) { pat = 1; dil = 4; rr = (u - 32) >> 3; m0 = ((u - 32) & 7) * 256; }
        else { pat = 2; dil = 16; rr = (u - 64) >> 1; m0 = ((u - 64) & 1) * 256; }
        const int qmin = m0 + 32 * wv, qmax = qmin + 31, myq = qmin + r;
        const size_t tok0 = (size_t)b * SEQ + rr;
        bf16x8 qf[4];
        {
            const bf16_t* qrow = (const bf16_t*)p.dq + (tok0 + (size_t)dil * myq) * 256 + hd * 64 + 8 * h;
#pragma unroll
            for (int s = 0; s < 4; ++s) qf[s] = *(const bf16x8*)(qrow + 16 * s);
        }
        f32x16 o0, o1;
#pragma unroll
        for (int i = 0; i < 16; ++i) { o0[i] = 0.f; o1[i] = 0.f; }
        float m = -1e30f, lsum = 0.f;
        const int kk = tid >> 3, kc = tid & 7, vk = tid & 63, vc = tid >> 6;
        const bf16_t* kbase = (const bf16_t*)p.dk + hd * 64 + kc * 8;
        const bf16_t* vbase = p.pbuf + PC_DV + hd * 64 + vc * 8;
        const int j0 = (m0 == 0) ? 2 : 0;
        u32x4 rk, rv;
        {
            const int kb = m0 - 128 + 64 * j0;
            rk = *(const u32x4*)(kbase + (tok0 + (size_t)dil * (kb + kk)) * 256);
            rv = *(const u32x4*)(vbase + (tok0 + (size_t)dil * (kb + vk)) * NINP);
        }
        for (int j = j0; j < 6; ++j) {
            __syncthreads();
            *(u32x4*)(Ks + kk * KSTR + kc * 8) = rk;
            {
                const unsigned w0 = rv[0], w1 = rv[1], w2 = rv[2], w3 = rv[3];
                bf16_t* vd = Vt + (vc * 8) * VSTR + vk;
                vd[0] = (bf16_t)(w0 & 0xffff); vd[VSTR] = (bf16_t)(w0 >> 16); vd[2 * VSTR] = (bf16_t)(w1 & 0xffff); vd[3 * VSTR] = (bf16_t)(w1 >> 16);
                vd[4 * VSTR] = (bf16_t)(w2 & 0xffff); vd[5 * VSTR] = (bf16_t)(w2 >> 16); vd[6 * VSTR] = (bf16_t)(w3 & 0xffff); vd[7 * VSTR] = (bf16_t)(w3 >> 16);
            }
            __syncthreads();
            const int kb = m0 - 128 + 64 * j;
            if (j + 1 < 6) {
                const int kn = kb + 64;
                rk = *(const u32x4*)(kbase + (tok0 + (size_t)dil * (kn + kk)) * 256);
                rv = *(const u32x4*)(vbase + (tok0 + (size_t)dil * (kn + vk)) * NINP);
            }
            const bool need0 = (kb <= qmax) && (kb + 31 >= qmin - 128);
            const bool need1 = (kb + 32 <= qmax) && (kb + 63 >= qmin - 128);
            if (need0 || need1) {
                f32x16 s0, s1;
#pragma unroll
                for (int i = 0; i < 16; ++i) { s0[i] = -3e38f; s1[i] = -3e38f; }
                if (need0) {
#pragma unroll
                    for (int i = 0; i < 16; ++i) s0[i] = 0.f;
#pragma unroll
                    for (int s = 0; s < 4; ++s) { const bf16x8 kf = *(const bf16x8*)(Ks + r * KSTR + 16 * s + 8 * h); s0 = __builtin_amdgcn_mfma_f32_32x32x16_bf16(kf, qf[s], s0, 0, 0, 0); }
                    if (!((kb + 31 <= qmin) && (kb >= qmax - 128))) {
#pragma unroll
                        for (int i = 0; i < 16; ++i) { const int key = kb + (i & 3) + 8 * (i >> 2) + 4 * h; if (key > myq || key < myq - 128) s0[i] = -3e38f; }
                    }
                }
                if (need1) {
#pragma unroll
                    for (int i = 0; i < 16; ++i) s1[i] = 0.f;
#pragma unroll
                    for (int s = 0; s < 4; ++s) { const bf16x8 kf = *(const bf16x8*)(Ks + (32 + r) * KSTR + 16 * s + 8 * h); s1 = __builtin_amdgcn_mfma_f32_32x32x16_bf16(kf, qf[s], s1, 0, 0, 0); }
                    if (!((kb + 63 <= qmin) && (kb + 32 >= qmax - 128))) {
#pragma unroll
                        for (int i = 0; i < 16; ++i) { const int key = kb + 32 + (i & 3) + 8 * (i >> 2) + 4 * h; if (key > myq || key < myq - 128) s1[i] = -3e38f; }
                    }
                }
                float mx = s0[0];
#pragma unroll
                for (int i = 1; i < 16; ++i) mx = fmaxf(mx, s0[i]);
#pragma unroll
                for (int i = 0; i < 16; ++i) mx = fmaxf(mx, s1[i]);
                mx = xhalf_max(mx);
                const float mn = fmaxf(m, mx), alpha = __builtin_amdgcn_exp2f(m - mn);
                m = mn;
                float ps = 0.f;
                if (need0) {
#pragma unroll
                    for (int i = 0; i < 16; ++i) { s0[i] = __builtin_amdgcn_exp2f(s0[i] - mn); ps += s0[i]; }
                }
                if (need1) {
#pragma unroll
                    for (int i = 0; i < 16; ++i) { s1[i] = __builtin_amdgcn_exp2f(s1[i] - mn); ps += s1[i]; }
                }
                lsum = lsum * alpha + ps;
                if (!__all(alpha == 1.0f)) {
#pragma unroll
                    for (int i = 0; i < 16; ++i) { o0[i] *= alpha; o1[i] *= alpha; }
                }
                if (need0) {
#pragma unroll
                    for (int s = 0; s < 2; ++s) {
                        u32x4 pw; pw[0] = cvtpk(s0[8 * s], s0[8 * s + 1]); pw[1] = cvtpk(s0[8 * s + 2], s0[8 * s + 3]); pw[2] = cvtpk(s0[8 * s + 4], s0[8 * s + 5]); pw[3] = cvtpk(s0[8 * s + 6], s0[8 * s + 7]);
                        const bf16x8 pf = __builtin_bit_cast(bf16x8, pw);
                        const bf16_t* va = Vt + r * VSTR + 16 * s + 4 * h;
                        const s16x4 a0 = *(const s16x4*)(va), a1 = *(const s16x4*)(va + 8), b0 = *(const s16x4*)(va + 32 * VSTR), b1 = *(const s16x4*)(va + 32 * VSTR + 8);
                        o0 = __builtin_amdgcn_mfma_f32_32x32x16_bf16(__builtin_shufflevector(a0, a1, 0, 1, 2, 3, 4, 5, 6, 7), pf, o0, 0, 0, 0);
                        o1 = __builtin_amdgcn_mfma_f32_32x32x16_bf16(__builtin_shufflevector(b0, b1, 0, 1, 2, 3, 4, 5, 6, 7), pf, o1, 0, 0, 0);
                    }
                }
                if (need1) {
#pragma unroll
                    for (int s = 0; s < 2; ++s) {
                        u32x4 pw; pw[0] = cvtpk(s1[8 * s], s1[8 * s + 1]); pw[1] = cvtpk(s1[8 * s + 2], s1[8 * s + 3]); pw[2] = cvtpk(s1[8 * s + 4], s1[8 * s + 5]); pw[3] = cvtpk(s1[8 * s + 6], s1[8 * s + 7]);
                        const bf16x8 pf = __builtin_bit_cast(bf16x8, pw);
                        const bf16_t* va = Vt + r * VSTR + 32 + 16 * s + 4 * h;
                        const s16x4 a0 = *(const s16x4*)(va), a1 = *(const s16x4*)(va + 8), b0 = *(const s16x4*)(va + 32 * VSTR), b1 = *(const s16x4*)(va + 32 * VSTR + 8);
                        o0 = __builtin_amdgcn_mfma_f32_32x32x16_bf16(__builtin_shufflevector(a0, a1, 0, 1, 2, 3, 4, 5, 6, 7), pf, o0, 0, 0, 0);
                        o1 = __builtin_amdgcn_mfma_f32_32x32x16_bf16(__builtin_shufflevector(b0, b1, 0, 1, 2, 3, 4, 5, 6, 7), pf, o1, 0, 0, 0);
                    }
                }
            }
        }
        const float lt = xhalf_sum(lsum), inv = 1.0f / lt;
        const size_t tq = tok0 + (size_t)dil * myq;
        float* op = p.dob + ((size_t)pat * NT + tq) * 256 + hd * 64 + 4 * h;
#pragma unroll
        for (int g = 0; g < 4; ++g) {
            *(f32x4*)(op + 8 * g) = (f32x4){o0[4 * g] * inv, o0[4 * g + 1] * inv, o0[4 * g + 2] * inv, o0[4 * g + 3] * inv};
            *(f32x4*)(op + 32 + 8 * g) = (f32x4){o1[4 * g] * inv, o1[4 * g + 1] * inv, o1[4 * g + 2] * inv, o1[4 * g + 3] * inv};
        }
        if (h == 0) p.dlse[((size_t)pat * NT + tq) * 4 + hd] = m + __builtin_amdgcn_logf(lt);
        __syncthreads();
    }
}

__device__ void ph_rwkv_prep(const Params& pkv, KPtr kp_in, int wbase_in, int l, char* lds) {
    PH_HEAD
    float* lw = (float*)lds;
    float* la = lw + 16 * 64;
    float* lg = la + 16 * 64;
    float* lv = lg + 16 * 128;
    const int tid = TID, c = tid & 255, half = tid >> 8;
    const float* mu = p.rwkv_mu + l * 1024;
    const float* w_up = p.rwkv_w_up + (size_t)l * 64 * 256; const float* a_up = p.rwkv_a_up + (size_t)l * 64 * 256; const float* g_up = p.rwkv_g_up + (size_t)l * 128 * 256;
    const float* v_up = p.rwkv_v_up + (size_t)(l > 0 ? l - 1 : 0) * 32 * 256;
    const float* vmu = p.vres_mu + (l > 0 ? l - 1 : 0) * 32;
    for (int tb = BID * 16; tb < NT; tb += gridDim.x * 16) {
        __syncthreads();
        for (int e = tid; e < 16 * 288; e += NTHREADS) {
            const int tt = e / 288, j = e % 288, t = tb + tt;
            const bool first = (t % SEQ) == 0;
            const bf16_t* pr = p.pbuf + (size_t)t * NINP;
            int col; float m;
            if (j < 256) { col = PC_CWD + j; m = mu[768 + j]; } else { col = PC_VRES + (j - 256); m = vmu[j - 256]; }
            const float cur = bf2f(pr[col]), prev = first ? 0.f : bf2f(pr[col - NINP]);
            const float xs = cur + (prev - cur) * m;
            if (j < 64) lw[tt * 64 + j] = tanhf(xs);
            else if (j < 128) la[tt * 64 + (j - 64)] = xs;
            else if (j < 256) lg[tt * 128 + (j - 128)] = sigmoidf_(xs);
            else lv[tt * 32 + (j - 256)] = xs;
        }
        __syncthreads();
        float aw[8], aa[8], ag[8], av[8];
#pragma unroll
        for (int i = 0; i < 8; ++i) { aw[i] = 0.f; aa[i] = 0.f; ag[i] = 0.f; av[i] = 0.f; }
        for (int m = 0; m < 64; ++m) {
            const float ww = w_up[m * 256 + c], wa = a_up[m * 256 + c];
#pragma unroll
            for (int i = 0; i < 8; ++i) { aw[i] += lw[(half * 8 + i) * 64 + m] * ww; aa[i] += la[(half * 8 + i) * 64 + m] * wa; }
        }
        for (int m = 0; m < 128; ++m) {
            const float wg = g_up[m * 256 + c];
#pragma unroll
            for (int i = 0; i < 8; ++i) ag[i] += lg[(half * 8 + i) * 128 + m] * wg;
        }
        if (l > 0) for (int m = 0; m < 32; ++m) {
            const float wv = v_up[m * 256 + c];
#pragma unroll
            for (int i = 0; i < 8; ++i) av[i] += lv[(half * 8 + i) * 32 + m] * wv;
        }
        const float w0 = p.rwkv_w0[l * 256 + c], a0 = p.rwkv_a0[l * 256 + c], kkc = p.rwkv_k_k[l * 256 + c], kac = p.rwkv_k_a[l * 256 + c];
        const float v0 = p.rwkv_v0[(l > 0 ? l - 1 : 0) * 256 + c];
        const float mr = mu[c], mk = mu[256 + c], mv = mu[512 + c];
#pragma unroll
        for (int i = 0; i < 8; ++i) {
            const int t = tb + half * 8 + i; const bool first = (t % SEQ) == 0;
            const bf16_t* pr = p.pbuf + (size_t)t * NINP;
            float r = bf2f(pr[PC_CR + c]), k = bf2f(pr[PC_CK + c]), v = bf2f(pr[PC_CV + c]);
            const float rp = first ? 0.f : bf2f(pr[PC_CR + c - NINP]), kp = first ? 0.f : bf2f(pr[PC_CK + c - NINP]), vp = first ? 0.f : bf2f(pr[PC_CV + c - NINP]);
            r = r + (rp - r) * mr; k = k + (kp - k) * mk; v = v + (vp - v) * mv;
            const float wpre = w0 + aw[i];
            const float sp = (-wpre > 20.f) ? -wpre : log1pf(__expf(-wpre));
            const float w = -sp - 0.5f;
            const float decay = __expf(-__expf(w));
            const float a = sigmoidf_(a0 + aa[i]);
            const float kkr = k * kkc;
            const float ss = wave_sum(kkr * kkr);
            const float kk = kkr / fmaxf(sqrtf(ss), 1e-12f);
            const float k2 = k * (1.0f + (a - 1.0f) * kac);
            const size_t o = (size_t)t * 256 + c;
            if (l == 0) p.vfirst[o] = v;
            else v = v + (p.vfirst[o] - v) * sigmoidf_(v0 + av[i]);
            p.sr[o] = r; p.sw[o] = decay; p.sk[o] = k2; p.sv[o] = v; p.sa[o] = -kk; p.sb[o] = kk * a; p.sg[o] = ag[i];
        }
    }
}

__device__ void ph_rwkv_scan(const Params& pkv, KPtr kp_in, int wbase_in, int l) {
    PH_HEAD
    const int lane = TID & 63, wv = TID >> 6;
    const int nwaves = NBATCH * 4 * 16;
    for (int u = BID + wv * gridDim.x; u < nwaves; u += gridDim.x * (NTHREADS / 64)) {
        const int bh = u >> 4, b = bh >> 2, h = bh & 3, i0 = (u & 15) * 4, rr = lane >> 4, c4 = (lane & 15) * 4;
        float s0 = 0.f, s1 = 0.f, s2 = 0.f, s3 = 0.f;
        const size_t base = (size_t)b * SEQ * 256 + h * 64;
        float4 ca[4], cw[4], cb[4], ck[4], cr[4]; float cv[4];
        float4 na[4], nw_[4], nb_[4], nk[4], nr[4]; float nv[4];
#pragma unroll
        for (int i = 0; i < 4; ++i) {
            const size_t o = base + (size_t)i * 256;
            ca[i] = *(const float4*)(p.sa + o + c4); cw[i] = *(const float4*)(p.sw + o + c4); cb[i] = *(const float4*)(p.sb + o + c4);
            ck[i] = *(const float4*)(p.sk + o + c4); cr[i] = *(const float4*)(p.sr + o + c4); cv[i] = p.sv[o + i0 + rr];
        }
        for (int t = 0; t < SEQ; t += 4) {
            if (t + 4 < SEQ) {
#pragma unroll
                for (int i = 0; i < 4; ++i) {
                    const size_t o = base + (size_t)(t + 4 + i) * 256;
                    na[i] = *(const float4*)(p.sa + o + c4); nw_[i] = *(const float4*)(p.sw + o + c4); nb_[i] = *(const float4*)(p.sb + o + c4);
                    nk[i] = *(const float4*)(p.sk + o + c4); nr[i] = *(const float4*)(p.sr + o + c4); nv[i] = p.sv[o + i0 + rr];
                }
            }
#pragma unroll
            for (int i = 0; i < 4; ++i) {
                const float4 a = ca[i], w = cw[i], bb = cb[i], k = ck[i], r = cr[i]; const float v = cv[i];
                float sa = s0 * a.x + s1 * a.y + s2 * a.z + s3 * a.w;
                sa = grp16_sum(sa);
                s0 = s0 * w.x + sa * bb.x + v * k.x; s1 = s1 * w.y + sa * bb.y + v * k.y; s2 = s2 * w.z + sa * bb.z + v * k.z; s3 = s3 * w.w + sa * bb.w + v * k.w;
                float y = s0 * r.x + s1 * r.y + s2 * r.z + s3 * r.w;
                y = grp16_sum(y);
                if ((lane & 15) == 0) p.sy[base + (size_t)(t + i) * 256 + i0 + rr] = y;
            }
#pragma unroll
            for (int i = 0; i < 4; ++i) { ca[i] = na[i]; cw[i] = nw_[i]; cb[i] = nb_[i]; ck[i] = nk[i]; cr[i] = nr[i]; cv[i] = nv[i]; }
        }
    }
}

__device__ void ph_mla_up(const Params& pkv, KPtr kp_in, int wbase_in, int l, char* lds) {
    PH_HEAD
    const int nq = (NT / 128) * 3, nkv = (NT / 128) * 4;
    for (int u = BID; u < nq + nkv; u += gridDim.x) {
        if (u < nq) {
            const int mt = u / 3, nt = u % 3;
            float* out = p.qu + (size_t)mt * 128 * 384 + nt * 128; const float* rs = p.rsq + mt * 128;
            gemm_tile128(p.pbuf + (size_t)mt * 128 * NINP + PC_MQ, NINP, nullptr, 128, p.wq_t + ((size_t)l * 384 + nt * 128) * 256, 256, 256, lds, TID,
                         [=](int r, int c, f32x4 v) mutable { const float s = rs[r]; *(f32x4*)(out + (size_t)r * 384 + c) = v * s; });
        } else {
            const int uu = u - nq, mt = uu / 4, nt = uu % 4;
            float* out = p.kvu + (size_t)mt * 128 * 512 + nt * 128; const float* rs = p.rskv + mt * 128;
            gemm_tile128(p.pbuf + (size_t)mt * 128 * NINP + PC_MKV, NINP, nullptr, 128, p.wkv_t + ((size_t)l * 512 + nt * 128) * 128, 128, 128, lds, TID,
                         [=](int r, int c, f32x4 v) mutable { const float s = rs[r]; *(f32x4*)(out + (size_t)r * 512 + c) = v * s; });
        }
    }
}

__device__ void ph_mla_pack(const Params& pkv, KPtr kp_in, int wbase_in, int l) {
    PH_HEAD
    const int lane = TID & 63, gw = BID * (NTHREADS / 64) + (TID >> 6), nw = gridDim.x * (NTHREADS / 64);
    const float SC = 0.10206207261596575f * 1.4426950408889634f;
    for (int t = gw; t < NT; t += nw) {
        const int pos = t % SEQ;
        const float* qp = p.qu + (size_t)t * 384; const float* kvp = p.kvu + (size_t)t * 512; const float* kp2 = p.kpe + (size_t)t * 32;
        bf16_t* mq = p.mq + (size_t)t * 384; bf16_t* mk = p.mk + (size_t)t * 384; bf16_t* mv = p.mv + (size_t)t * 256;
        for (int e = lane; e < 384; e += 64) {
            const int hd = e / 96, d = e % 96;
            float qv, kv;
            if (d < 64) { qv = qp[e]; kv = kvp[hd * 128 + d]; }
            else {
                const int i = (d - 64) & 15; const float c = p.tab_mla[(pos * 16 + i) * 2], sn = p.tab_mla[(pos * 16 + i) * 2 + 1];
                const float x1 = qp[hd * 96 + 64 + i], x2 = qp[hd * 96 + 80 + i];
                qv = (d < 80) ? (x1 * c - x2 * sn) : (x1 * sn + x2 * c);
                kv = kp2[d - 64];
            }
            mq[e] = f2bf(qv * SC); mk[e] = f2bf(kv);
        }
        for (int e = lane; e < 256; e += 64) mv[e] = f2bf(kvp[(e >> 6) * 128 + 64 + (e & 63)]);
    }
}

__device__ void ph_mla_attn(const Params& pkv, KPtr kp_in, int wbase_in, int l, char* lds) {
    PH_HEAD
    constexpr int KSTR = 104, VSTR = 68;
    bf16_t* Ks = (bf16_t*)lds;
    bf16_t* Vt = Ks + 64 * KSTR;
    const int tid = TID, lane = tid & 63, wv = tid >> 6, r = lane & 31, h = lane >> 5;
    for (int it = BID; it < 16 * 32; it += gridDim.x) {
        const int bh = it & 15, j0 = it >> 4, qb = (j0 < 16) ? j0 : (47 - j0);
        const int b = bh >> 2, hd = bh & 3, q0 = qb * 256;
        const int qmin = q0 + 32 * wv, qmax = qmin + 31, myq = qmin + r;
        bf16x8 qf[6];
        {
            const bf16_t* qrow = p.mq + ((size_t)(b * SEQ + myq) * 4 + hd) * 96 + 8 * h;
#pragma unroll
            for (int s = 0; s < 6; ++s) qf[s] = *(const bf16x8*)(qrow + 16 * s);
        }
        f32x16 o0, o1;
#pragma unroll
        for (int i = 0; i < 16; ++i) { o0[i] = 0.f; o1[i] = 0.f; }
        float m = -1e30f, lsum = 0.f;
        const int nkt = (q0 + 256) / 64;
        const int kk0 = tid / 12, kc0 = tid % 12, kk1 = (tid + 512) / 12, kc1 = (tid + 512) % 12;
        const int vk = tid & 63, vc = tid >> 6;
        const bf16_t* kbase = p.mk + ((size_t)b * SEQ * 4 + hd) * 96;
        const bf16_t* vbase = p.mv + ((size_t)b * SEQ * 4 + hd) * 64;
        u32x4 rk0, rk1, rv;
        rk0 = *(const u32x4*)(kbase + (size_t)kk0 * 384 + kc0 * 8);
        rk1 = (tid < 256) ? *(const u32x4*)(kbase + (size_t)kk1 * 384 + kc1 * 8) : (u32x4){0u, 0u, 0u, 0u};
        rv = *(const u32x4*)(vbase + (size_t)vk * 256 + vc * 8);
        for (int kt = 0; kt < nkt; ++kt) {
            __syncthreads();
            *(u32x4*)(Ks + kk0 * KSTR + kc0 * 8) = rk0;
            if (tid < 256) *(u32x4*)(Ks + kk1 * KSTR + kc1 * 8) = rk1;
            {
                const unsigned w0 = rv[0], w1 = rv[1], w2 = rv[2], w3 = rv[3];
                bf16_t* vd = Vt + (vc * 8) * VSTR + vk;
                vd[0] = (bf16_t)(w0 & 0xffff); vd[VSTR] = (bf16_t)(w0 >> 16); vd[2 * VSTR] = (bf16_t)(w1 & 0xffff); vd[3 * VSTR] = (bf16_t)(w1 >> 16);
                vd[4 * VSTR] = (bf16_t)(w2 & 0xffff); vd[5 * VSTR] = (bf16_t)(w2 >> 16); vd[6 * VSTR] = (bf16_t)(w3 & 0xffff); vd[7 * VSTR] = (bf16_t)(w3 >> 16);
            }
            __syncthreads();
            if (kt + 1 < nkt) {
                const size_t ko = (size_t)(kt + 1) * 64;
                rk0 = *(const u32x4*)(kbase + (ko + kk0) * 384 + kc0 * 8);
                if (tid < 256) rk1 = *(const u32x4*)(kbase + (ko + kk1) * 384 + kc1 * 8);
                rv = *(const u32x4*)(vbase + (ko + vk) * 256 + vc * 8);
            }
            const int kb = kt * 64;
            if (kb <= qmax) {
                const bool need1 = (kb + 32 <= qmax);
                f32x16 s0, s1;
#pragma unroll
                for (int i = 0; i < 16; ++i) { s0[i] = 0.f; s1[i] = -1e30f; }
#pragma unroll
                for (int s = 0; s < 6; ++s) { const bf16x8 kf = *(const bf16x8*)(Ks + r * KSTR + 16 * s + 8 * h); s0 = __builtin_amdgcn_mfma_f32_32x32x16_bf16(kf, qf[s], s0, 0, 0, 0); }
                if (need1) {
#pragma unroll
                    for (int i = 0; i < 16; ++i) s1[i] = 0.f;
#pragma unroll
                    for (int s = 0; s < 6; ++s) { const bf16x8 kf = *(const bf16x8*)(Ks + (32 + r) * KSTR + 16 * s + 8 * h); s1 = __builtin_amdgcn_mfma_f32_32x32x16_bf16(kf, qf[s], s1, 0, 0, 0); }
                }
                if (kb + 63 > qmin) {
#pragma unroll
                    for (int i = 0; i < 16; ++i) {
                        const int key = kb + (i & 3) + 8 * (i >> 2) + 4 * h;
                        if (key > myq) s0[i] = -1e30f;
                        if (key + 32 > myq) s1[i] = -1e30f;
                    }
                }
                float mx = s0[0];
#pragma unroll
                for (int i = 1; i < 16; ++i) mx = fmaxf(mx, s0[i]);
#pragma unroll
                for (int i = 0; i < 16; ++i) mx = fmaxf(mx, s1[i]);
                mx = xhalf_max(mx);
                const float mn = fmaxf(m, mx), alpha = __builtin_amdgcn_exp2f(m - mn);
                m = mn;
                float ps = 0.f;
#pragma unroll
                for (int i = 0; i < 16; ++i) { s0[i] = __builtin_amdgcn_exp2f(s0[i] - mn); ps += s0[i]; }
                if (need1) {
#pragma unroll
                    for (int i = 0; i < 16; ++i) { s1[i] = __builtin_amdgcn_exp2f(s1[i] - mn); ps += s1[i]; }
                }
                lsum = lsum * alpha + ps;
                if (!__all(alpha == 1.0f)) {
#pragma unroll
                    for (int i = 0; i < 16; ++i) { o0[i] *= alpha; o1[i] *= alpha; }
                }
#pragma unroll
                for (int s = 0; s < 2; ++s) {
                    u32x4 pw; pw[0] = cvtpk(s0[8 * s], s0[8 * s + 1]); pw[1] = cvtpk(s0[8 * s + 2], s0[8 * s + 3]); pw[2] = cvtpk(s0[8 * s + 4], s0[8 * s + 5]); pw[3] = cvtpk(s0[8 * s + 6], s0[8 * s + 7]);
                    const bf16x8 pf = __builtin_bit_cast(bf16x8, pw);
                    const bf16_t* va = Vt + r * VSTR + 16 * s + 4 * h;
                    const s16x4 a0 = *(const s16x4*)(va), a1 = *(const s16x4*)(va + 8), b0 = *(const s16x4*)(va + 32 * VSTR), b1 = *(const s16x4*)(va + 32 * VSTR + 8);
                    o0 = __builtin_amdgcn_mfma_f32_32x32x16_bf16(__builtin_shufflevector(a0, a1, 0, 1, 2, 3, 4, 5, 6, 7), pf, o0, 0, 0, 0);
                    o1 = __builtin_amdgcn_mfma_f32_32x32x16_bf16(__builtin_shufflevector(b0, b1, 0, 1, 2, 3, 4, 5, 6, 7), pf, o1, 0, 0, 0);
                }
                if (need1) {
#pragma unroll
                    for (int s = 0; s < 2; ++s) {
                        u32x4 pw; pw[0] = cvtpk(s1[8 * s], s1[8 * s + 1]); pw[1] = cvtpk(s1[8 * s + 2], s1[8 * s + 3]); pw[2] = cvtpk(s1[8 * s + 4], s1[8 * s + 5]); pw[3] = cvtpk(s1[8 * s + 6], s1[8 * s + 7]);
                        const bf16x8 pf = __builtin_bit_cast(bf16x8, pw);
                        const bf16_t* va = Vt + r * VSTR + 32 + 16 * s + 4 * h;
                        const s16x4 a0 = *(const s16x4*)(va), a1 = *(const s16x4*)(va + 8), b0 = *(const s16x4*)(va + 32 * VSTR), b1 = *(const s16x4*)(va + 32 * VSTR + 8);
                        o0 = __builtin_amdgcn_mfma_f32_32x32x16_bf16(__builtin_shufflevector(a0, a1, 0, 1, 2, 3, 4, 5, 6, 7), pf, o0, 0, 0, 0);
                        o1 = __builtin_amdgcn_mfma_f32_32x32x16_bf16(__builtin_shufflevector(b0, b1, 0, 1, 2, 3, 4, 5, 6, 7), pf, o1, 0, 0, 0);
                    }
                }
            }
        }
        const float inv = 1.0f / xhalf_sum(lsum);
        float* op = p.mo + (size_t)(b * SEQ + myq) * 256 + hd * 64 + 4 * h;
#pragma unroll
        for (int g = 0; g < 4; ++g) {
            *(f32x4*)(op + 8 * g) = (f32x4){o0[4 * g] * inv, o0[4 * g + 1] * inv, o0[4 * g + 2] * inv, o0[4 * g + 3] * inv};
            *(f32x4*)(op + 32 + 8 * g) = (f32x4){o1[4 * g] * inv, o1[4 * g + 1] * inv, o1[4 * g + 2] * inv, o1[4 * g + 3] * inv};
        }
        __syncthreads();
    }
}

__device__ void ph_finalize_mix(const Params& pkv, KPtr kp_in, int wbase_in, int l) {
    PH_HEAD
    const int lane = TID & 63, gw = BID * (NTHREADS / 64) + (TID >> 6), nw = gridDim.x * (NTHREADS / 64);
    const int c = lane * 4, h = lane >> 4;
    for (int t = gw; t < NT; t += nw) {
        bf16_t* outp = p.mixcat + (size_t)t * 1024;
        {
            const float l0 = p.dlse[((size_t)0 * NT + t) * 4 + h], l1 = p.dlse[((size_t)1 * NT + t) * 4 + h], l2 = p.dlse[((size_t)2 * NT + t) * 4 + h];
            const float lm = fmaxf(l0, fmaxf(l1, l2));
            float w0 = __builtin_amdgcn_exp2f(l0 - lm), w1 = __builtin_amdgcn_exp2f(l1 - lm), w2 = __builtin_amdgcn_exp2f(l2 - lm);
            const float wi = 1.0f / (w0 + w1 + w2); w0 *= wi; w1 *= wi; w2 *= wi;
            const float4 v0 = *(const float4*)(p.dob + ((size_t)0 * NT + t) * 256 + c), v1 = *(const float4*)(p.dob + ((size_t)1 * NT + t) * 256 + c), v2 = *(const float4*)(p.dob + ((size_t)2 * NT + t) * 256 + c);
            float4 v; v.x = w0 * v0.x + w1 * v1.x + w2 * v2.x; v.y = w0 * v0.y + w1 * v1.y + w2 * v2.y; v.z = w0 * v0.z + w1 * v1.z + w2 * v2.z; v.w = w0 * v0.w + w1 * v1.w + w2 * v2.w;
            const float ss = wave_sum(v.x * v.x + v.y * v.y + v.z * v.z + v.w * v.w);
            const float rs = rsqrtf(ss * (1.0f / 256.0f) + 1e-6f);
            const float4 g = *(const float4*)(p.dil_norm_g + l * 256 + c);
            ushort4 o; o.x = f2bf(v.x * rs * g.x); o.y = f2bf(v.y * rs * g.y); o.z = f2bf(v.z * rs * g.z); o.w = f2bf(v.w * rs * g.w);
            *(ushort4*)(outp + 256 + c) = o;
        }
        {
            const size_t o4 = (size_t)t * 256 + c;
            const float4 y = *(const float4*)(p.sy + o4), r = *(const float4*)(p.sr + o4), k = *(const float4*)(p.sk + o4), v = *(const float4*)(p.sv + o4), g = *(const float4*)(p.sg + o4);
            const float mean = grp16_sum(y.x + y.y + y.z + y.w) * (1.0f / 64.0f);
            const float dx = y.x - mean, dy = y.y - mean, dz = y.z - mean, dw = y.w - mean;
            const float var = grp16_sum(dx * dx + dy * dy + dz * dz + dw * dw) * (1.0f / 64.0f);
            const float rs = rsqrtf(var + 64e-5f);
            const float4 lg = *(const float4*)(p.rwkv_ln_g + l * 256 + c), lb = *(const float4*)(p.rwkv_ln_b + l * 256 + c), rk = *(const float4*)(p.rwkv_r_k + l * 256 + c);
            const float bonus = grp16_sum(r.x * k.x * rk.x + r.y * k.y * rk.y + r.z * k.z * rk.z + r.w * k.w * rk.w);
            ushort4 o;
            o.x = f2bf((dx * rs * lg.x + lb.x + bonus * v.x) * g.x); o.y = f2bf((dy * rs * lg.y + lb.y + bonus * v.y) * g.y);
            o.z = f2bf((dz * rs * lg.z + lb.z + bonus * v.z) * g.z); o.w = f2bf((dw * rs * lg.w + lb.w + bonus * v.w) * g.w);
            *(ushort4*)(outp + 512 + c) = o;
        }
        {
            const float4 v = *(const float4*)(p.mo + (size_t)t * 256 + c);
            const float ss = wave_sum(v.x * v.x + v.y * v.y + v.z * v.z + v.w * v.w);
            const float rs = rsqrtf(ss * (1.0f / 256.0f) + 1e-6f);
            const float4 g = *(const float4*)(p.mla_out_norm_g + l * 256 + c);
            ushort4 o; o.x = f2bf(v.x * rs * g.x); o.y = f2bf(v.y * rs * g.y); o.z = f2bf(v.z * rs * g.z); o.w = f2bf(v.w * rs * g.w);
            *(ushort4*)(outp + 768 + c) = o;
        }
    }
    (void)h;
}

__device__ void ph_outproj(const Params& pkv, KPtr kp_in, int wbase_in, int l, char* lds) {
    PH_HEAD
    const float* xin = (l == 0) ? p.x : p.xf; float* y1 = p.y1;
    const bf16_t* Bt = p.wout_t + (size_t)l * 1024 * 1024;
    for (int u = BID; u < (NT / 256) * 4; u += gridDim.x) {
        const int mt = u >> 2, nt = u & 3;
        const size_t o0 = (size_t)mt * 256 * 1024 + nt * 256;
        gemm_tile256(p.mixcat + (size_t)mt * 256 * 1024, 1024, nullptr, 256, Bt + (size_t)nt * 256 * 1024, 1024, 1024, lds, wbase_in,
                     [=](int r, int c, f32x4 v) mutable { const size_t o = o0 + (size_t)r * 1024 + c; const f32x4 xv = *(const f32x4*)(xin + o); *(f32x4*)(y1 + o) = xv * ALPHA + v; });
    }
}

__device__ void ph_ln1_router(const Params& pkv, KPtr kp_in, int wbase_in, int l, char* lds) {
    PH_HEAD
    int* hist = (int*)lds;
    int* base = hist + 32;
    int* le = base + 32;
    float* lgt = (float*)(le + 512);
    int* lrank = (int*)(lgt + 512);
    const int tid = TID, lane = tid & 63, wv = tid >> 6;
    const float* g1 = p.ln1_g + l * 1024; const float* b1 = p.ln1_b + l * 1024;
    const float* rw = p.router_w + (size_t)l * 1024 * 32; const float* rb = p.router_b + l * 32;
    for (int tb = BID * 128; tb < NT; tb += gridDim.x * 128) {
        __syncthreads();
        if (tid < 32) hist[tid] = 0;
        __syncthreads();
        for (int tt = wv; tt < 128; tt += 8) {
            const int t = tb + tt;
            float4 y[4]; float s = 0.f;
#pragma unroll
            for (int m = 0; m < 4; ++m) { y[m] = *(const float4*)(p.y1 + (size_t)t * 1024 + m * 256 + lane * 4); s += y[m].x + y[m].y + y[m].z + y[m].w; }
            const float mean = wave_sum(s) * (1.0f / 1024.0f);
            float q = 0.f;
#pragma unroll
            for (int m = 0; m < 4; ++m) { y[m].x -= mean; y[m].y -= mean; y[m].z -= mean; y[m].w -= mean; q += y[m].x * y[m].x + y[m].y * y[m].y + y[m].z * y[m].z + y[m].w * y[m].w; }
            const float rs = rsqrtf(wave_sum(q) * (1.0f / 1024.0f) + 1e-5f);
            float lg[32];
#pragma unroll
            for (int e = 0; e < 32; ++e) lg[e] = 0.f;
#pragma unroll 1
            for (int m = 0; m < 4; ++m) {
                const int c = m * 256 + lane * 4;
                const float4 g = *(const float4*)(g1 + c), bb = *(const float4*)(b1 + c);
                const float4 yv = *(const float4*)(p.y1 + (size_t)t * 1024 + c);
                float4 xv; xv.x = (yv.x - mean) * rs * g.x + bb.x; xv.y = (yv.y - mean) * rs * g.y + bb.y; xv.z = (yv.z - mean) * rs * g.z + bb.z; xv.w = (yv.w - mean) * rs * g.w + bb.w;
                *(float4*)(p.y1 + (size_t)t * 1024 + c) = xv;
                ushort4 ob; ob.x = f2bf(xv.x); ob.y = f2bf(xv.y); ob.z = f2bf(xv.z); ob.w = f2bf(xv.w);
                *(ushort4*)(p.x1b + (size_t)t * 1024 + c) = ob;
                const float xs[4] = {xv.x, xv.y, xv.z, xv.w};
#pragma unroll
                for (int i = 0; i < 4; ++i) {
                    const float4* wr = (const float4*)(rw + (size_t)(c + i) * 32);
#pragma unroll
                    for (int e4 = 0; e4 < 8; ++e4) { const float4 w = wr[e4]; lg[e4 * 4] += xs[i] * w.x; lg[e4 * 4 + 1] += xs[i] * w.y; lg[e4 * 4 + 2] += xs[i] * w.z; lg[e4 * 4 + 3] += xs[i] * w.w; }
                }
            }
#pragma unroll
            for (int e = 0; e < 32; ++e) lg[e] = wave_sum(lg[e]) + rb[e];
            int idx[4]; float val[4];
#pragma unroll
            for (int k = 0; k < 4; ++k) {
                float bv = -3.0e38f; int bi = 0;
#pragma unroll
                for (int e = 0; e < 32; ++e) { if (lg[e] > bv) { bv = lg[e]; bi = e; } }
                idx[k] = bi; val[k] = bv;
#pragma unroll
                for (int e = 0; e < 32; ++e) if (e == bi) lg[e] = -3.0e38f;
            }
            const float e1 = __expf(val[1] - val[0]), e2 = __expf(val[2] - val[0]), e3 = __expf(val[3] - val[0]);
            const float inv = 1.0f / (1.0f + e1 + e2 + e3);
            const float gt[4] = {inv, e1 * inv, e2 * inv, e3 * inv};
            if (lane < 4) {
                int ee = idx[0]; float gg = gt[0];
                if (lane == 1) { ee = idx[1]; gg = gt[1]; } else if (lane == 2) { ee = idx[2]; gg = gt[2]; } else if (lane == 3) { ee = idx[3]; gg = gt[3]; }
                le[tt * 4 + lane] = ee; lgt[tt * 4 + lane] = gg;
                lrank[tt * 4 + lane] = atomicAdd(&hist[ee], 1);
            }
        }
        __syncthreads();
        if (tid < 32) base[tid] = atomicAdd(&p.cnt[l * NE + tid], hist[tid]);
        __syncthreads();
        {
            const int tt = tid >> 2, t = tb + tt, e = le[tid], pos = base[e] + lrank[tid];
            p.toke[(size_t)t * 4 + (tid & 3)] = e; p.tokpos[(size_t)t * 4 + (tid & 3)] = pos;
            p.rowtok[(size_t)e * NT + pos] = t; p.rowgate[(size_t)e * NT + pos] = lgt[tid];
        }
    }
}

__device__ __forceinline__ void moe_tile_prefix(KRef p, int l, int* tb  , const int TID) {
    __syncthreads();
    if (TID == 0) { int a = 0; for (int e = 0; e < NE; ++e) { tb[e] = a; a += (p.cnt[l * NE + e] + MOE_TM - 1) / MOE_TM; } tb[NE] = a; }
    __syncthreads();
}
__device__ void ph_moe_gu(const Params& pkv, KPtr kp_in, int wbase_in, int l, char* lds) {
    PH_HEAD
    int* tb = (int*)(lds + 132096);
    moe_tile_prefix(p, l, tb, TID);
    const int ntile = __builtin_amdgcn_readfirstlane(tb[NE]), nunits = ntile * 8;
    for (int u = BID; u < nunits; u += gridDim.x) {
        const int mtg = u >> 3, nt = u & 7;
        int e = 0; while (tb[e + 1] <= mtg) ++e;
        e = __builtin_amdgcn_readfirstlane(e);
        const int mt = __builtin_amdgcn_readfirstlane(mtg - tb[e]), cnt = __builtin_amdgcn_readfirstlane(p.cnt[l * NE + e]), nvalid = min(MOE_TM, cnt - mt * MOE_TM);
        const float* bias = p.b_gu + ((size_t)l * NE + e) * 2048 + nt * 256;
        bf16_t* out = p.act + (size_t)mtg * MOE_TM * 1024 + nt * 128;
        gemm_tile256(p.x1b, 1024, p.rowtok + (size_t)e * NT + mt * MOE_TM, nvalid, p.wgu_t + (((size_t)l * NE + e) * 2048 + nt * 256) * 1024, 1024, 1024, lds, wbase_in,
                     [=](int r, int c, f32x4 v) mutable {
                         const f32x4 bv = *(const f32x4*)(bias + c); v = v + bv;
                         const float g0 = fminf(v[0], 7.0f), l0 = fminf(fmaxf(v[1], -7.0f), 7.0f), g1 = fminf(v[2], 7.0f), l1 = fminf(fmaxf(v[3], -7.0f), 7.0f);
                         const float a0 = g0 * sigmoidf_(1.702f * g0) * (l0 + 1.0f), a1 = g1 * sigmoidf_(1.702f * g1) * (l1 + 1.0f);
                         ushort2 o; o.x = f2bf(a0); o.y = f2bf(a1); *(ushort2*)(out + (size_t)r * 1024 + (c >> 1)) = o; });
    }
}
__device__ void ph_moe_dn(const Params& pkv, KPtr kp_in, int wbase_in, int l, char* lds) {
    PH_HEAD
    int* tb = (int*)(lds + 132096);
    moe_tile_prefix(p, l, tb, TID);
    const int ntile = __builtin_amdgcn_readfirstlane(tb[NE]), nunits = ntile * 4;
    for (int u = BID; u < nunits; u += gridDim.x) {
        const int mtg = u >> 2, nt = u & 3;
        int e = 0; while (tb[e + 1] <= mtg) ++e;
        e = __builtin_amdgcn_readfirstlane(e);
        const int mt = __builtin_amdgcn_readfirstlane(mtg - tb[e]), cnt = __builtin_amdgcn_readfirstlane(p.cnt[l * NE + e]), nvalid = min(MOE_TM, cnt - mt * MOE_TM);
        const float* bias = p.b_dn + ((size_t)l * NE + e) * 1024 + nt * 256;
        const float* gate = p.rowgate + (size_t)e * NT + mt * MOE_TM;
        bf16_t* out = p.yb + (size_t)mtg * MOE_TM * 1024 + nt * 256;
        gemm_tile256(p.act + (size_t)mtg * MOE_TM * 1024, 1024, nullptr, 256, p.wdn_t + (((size_t)l * NE + e) * 1024 + nt * 256) * 1024, 1024, 1024, lds, wbase_in,
                     [=](int r, int c, f32x4 v) mutable {
                         const float g = (r < nvalid) ? gate[r] : 0.f;
                         const f32x4 bv = *(const f32x4*)(bias + c); v = (v + bv) * g;
                         ushort4 o; o.x = f2bf(v[0]); o.y = f2bf(v[1]); o.z = f2bf(v[2]); o.w = f2bf(v[3]); *(ushort4*)(out + (size_t)r * 1024 + c) = o; });
    }
}
__device__ void ph_combine_ln2(const Params& pkv, KPtr kp_in, int wbase_in, int l, char* lds) {
    PH_HEAD
    int* tb = (int*)(lds + 132096);
    moe_tile_prefix(p, l, tb, TID);
    const int lane = TID & 63, gw = BID * (NTHREADS / 64) + (TID >> 6), nw = gridDim.x * (NTHREADS / 64);
    const float* g2 = p.ln2_g + l * 1024; const float* b2 = p.ln2_b + l * 1024;
    float* dstf = (l == DEPTH - 1) ? p.out : p.xf;
    for (int t = gw; t < NT; t += nw) {
        size_t rows[4];
#pragma unroll
        for (int k = 0; k < 4; ++k) { const int e = p.toke[(size_t)t * 4 + k], pos = p.tokpos[(size_t)t * 4 + k]; rows[k] = (size_t)tb[e] * MOE_TM + pos; }
        float4 y[4]; float s = 0.f;
#pragma unroll
        for (int m = 0; m < 4; ++m) {
            const int c = m * 256 + lane * 4;
            float4 v = *(const float4*)(p.y1 + (size_t)t * 1024 + c);
            v.x *= ALPHA; v.y *= ALPHA; v.z *= ALPHA; v.w *= ALPHA;
#pragma unroll
            for (int k = 0; k < 4; ++k) { const ushort4 yb = *(const ushort4*)(p.yb + rows[k] * 1024 + c); v.x += bf2f(yb.x); v.y += bf2f(yb.y); v.z += bf2f(yb.z); v.w += bf2f(yb.w); }
            y[m] = v; s += v.x + v.y + v.z + v.w;
        }
        const float mean = wave_sum(s) * (1.0f / 1024.0f);
        float q = 0.f;
#pragma unroll
        for (int m = 0; m < 4; ++m) { y[m].x -= mean; y[m].y -= mean; y[m].z -= mean; y[m].w -= mean; q += y[m].x * y[m].x + y[m].y * y[m].y + y[m].z * y[m].z + y[m].w * y[m].w; }
        const float rs = rsqrtf(wave_sum(q) * (1.0f / 1024.0f) + 1e-5f);
#pragma unroll
        for (int m = 0; m < 4; ++m) {
            const int c = m * 256 + lane * 4;
            const float4 g = *(const float4*)(g2 + c), bb = *(const float4*)(b2 + c);
            float4 xv; xv.x = y[m].x * rs * g.x + bb.x; xv.y = y[m].y * rs * g.y + bb.y; xv.z = y[m].z * rs * g.z + bb.z; xv.w = y[m].w * rs * g.w + bb.w;
            *(float4*)(dstf + (size_t)t * 1024 + c) = xv;
            ushort4 ob; ob.x = f2bf(xv.x); ob.y = f2bf(xv.y); ob.z = f2bf(xv.z); ob.w = f2bf(xv.w);
            *(ushort4*)(p.xb + (size_t)t * 1024 + c) = ob;
        }
    }
}

constexpr int PH_PRO = 0, PH_INPROJ = 1, PH_PREP = 2, PH_RETKV = 3, PH_RETSCAN = 4, PH_RETOUT = 5, PH_DIL = 6, PH_RWKVPREP = 7, PH_RWKVSCAN = 8, PH_MLAUP = 9,
              PH_MLAATTN = 10, PH_FINAL = 11, PH_OUTPROJ = 12, PH_LN1 = 13, PH_GU = 14, PH_DN = 15, PH_LN2 = 16;

#ifdef MULTI_LAUNCH
template <int ph>
__global__ void __launch_bounds__(NTHREADS, 2) mega(Params pk, int l) {
    extern __shared__ __attribute__((aligned(16))) char lds[];
    KPtr kp = (KPtr)__builtin_amdgcn_kernarg_segment_ptr();
    const int wbase = __builtin_amdgcn_readfirstlane(threadIdx.x) & ~63;
    if (ph == PH_PRO) ph_prologue(pk, kp, wbase, lds);
    if (ph == PH_INPROJ) ph_inproj(pk, kp, wbase, l, lds);
    if (ph == PH_PREP) ph_rope_prep(pk, kp, wbase, l);
    if (ph == PH_RETKV) ph_ret_kv(pk, kp, wbase, l);
    if (ph == PH_RETSCAN) ph_ret_scan(pk, kp, wbase, l);
    if (ph == PH_RETOUT) ph_ret_out(pk, kp, wbase, l);
    if (ph == PH_DIL) ph_dil_attn(pk, kp, wbase, l, lds);
    if (ph == PH_RWKVPREP) ph_rwkv_prep(pk, kp, wbase, l, lds);
    if (ph == PH_RWKVSCAN) ph_rwkv_scan(pk, kp, wbase, l);
    if (ph == PH_MLAUP) ph_mla_up(pk, kp, wbase, l, lds);
    if (ph == PH_MLAATTN) ph_mla_attn(pk, kp, wbase, l, lds);
    if (ph == PH_FINAL) ph_finalize_mix(pk, kp, wbase, l);
    if (ph == PH_OUTPROJ) ph_outproj(pk, kp, wbase, l, lds);
    if (ph == PH_LN1) ph_ln1_router(pk, kp, wbase, l, lds);
    if (ph == PH_GU) ph_moe_gu(pk, kp, wbase, l, lds);
    if (ph == PH_DN) ph_moe_dn(pk, kp, wbase, l, lds);
    if (ph == PH_LN2) ph_combine_ln2(pk, kp, wbase, l, lds);
}
template <int PH> static void launch_ph(const Params& p, int l, hipStream_t stream) {
    static bool attr_set = false;
    if (!attr_set) { (void)hipFuncSetAttribute((const void*)mega<PH>, hipFuncAttributeMaxDynamicSharedMemorySize, LDS_BYTES); attr_set = true; }
    hipLaunchKernelGGL(mega<PH>, dim3(256), dim3(NTHREADS), LDS_BYTES, stream, p, l);
}
template <int PH> static void launch_layer(const Params& p, int l, hipStream_t stream) {
    launch_ph<PH>(p, l, stream);
    if constexpr (PH < PH_LN2) launch_layer<PH + 1>(p, l, stream);
}

#else
__device__ __forceinline__ void grid_sync(KPtr kp_in, int wbase_in, char* lds) {
    KPtr kp_ = kp_launder(kp_in);
    XcdBarrier b; b.bar = kp_->bar; b.x = xb_xcc_id(); b.st = (volatile LAS unsigned*)(lds + LDS_BYTES - 16);
    xcd_barrier(b, opq_tid(wbase_in));
}
__global__ void __launch_bounds__(NTHREADS, 2) mega_fused(Params pk) {
    extern __shared__ __attribute__((aligned(16))) char lds[];
    KPtr kp = (KPtr)__builtin_amdgcn_kernarg_segment_ptr();
    const int wbase = __builtin_amdgcn_readfirstlane(threadIdx.x) & ~63;
    volatile LAS unsigned* xbw = (volatile LAS unsigned*)(lds + LDS_BYTES - 16);
    if (threadIdx.x == 0) { xbw[0] = 0u; xbw[1] = 0u; xbw[2] = 0u; xbw[3] = 0u; }
    __syncthreads();
    (void)xcd_barrier_post(pk.bar, xbw);
    ph_prologue(pk, kp, wbase, lds);
    grid_sync(kp, wbase, lds);
    for (int l = 0; l < DEPTH; ++l) {
        ph_inproj(pk, kp, wbase, l, lds);
        grid_sync(kp, wbase, lds);
        ph_rope_prep(pk, kp, wbase, l);
        grid_sync(kp, wbase, lds);
        ph_ret_kv(pk, kp, wbase, l); ph_rwkv_prep(pk, kp, wbase, l, lds); ph_mla_up(pk, kp, wbase, l, lds); ph_dil_attn(pk, kp, wbase, l, lds);
        grid_sync(kp, wbase, lds);
        ph_mla_pack(pk, kp, wbase, l); ph_ret_scan(pk, kp, wbase, l);
        grid_sync(kp, wbase, lds);
        ph_mla_attn(pk, kp, wbase, l, lds); ph_rwkv_scan(pk, kp, wbase, l);
        grid_sync(kp, wbase, lds);
        ph_ret_out(pk, kp, wbase, l); ph_finalize_mix(pk, kp, wbase, l);
        grid_sync(kp, wbase, lds);
        ph_outproj(pk, kp, wbase, l, lds);
        grid_sync(kp, wbase, lds);
        ph_ln1_router(pk, kp, wbase, l, lds);
        grid_sync(kp, wbase, lds);
        ph_moe_gu(pk, kp, wbase, l, lds);
        grid_sync(kp, wbase, lds);
        ph_moe_dn(pk, kp, wbase, l, lds);
        grid_sync(kp, wbase, lds);
        ph_combine_ln2(pk, kp, wbase, l, lds);
        grid_sync(kp, wbase, lds);
    }
}

#endif
struct Carver { char* base; size_t off; template <class T> T* take(size_t n) { T* r = (T*)(base + off); off += ((n * sizeof(T) + 255) / 256) * 256; return r; } };

extern "C" void kernel_launch(void* const* d_in, const int* in_sizes, int n_in, void* d_out, int out_size, void* d_ws, size_t ws_size, hipStream_t stream) {
    Params p; memset(&p, 0, sizeof(p));
    const float** ip = (const float**)&p;
    for (int i = 0; i < 35; ++i) ip[i] = (const float*)d_in[i];
    p.out = (float*)d_out;
    Carver c{(char*)d_ws, 0};
    p.bar = c.take<unsigned>(4096); p.cnt = c.take<int>(DEPTH * NE);
    p.tab_ret = c.take<float>((size_t)SEQ * 32); p.tab_dil = c.take<float>((size_t)SEQ * 16); p.tab_mla = c.take<float>((size_t)SEQ * 32);
    p.win_t = c.take<bf16_t>((size_t)DEPTH * NINP * 1024); p.wout_t = c.take<bf16_t>((size_t)DEPTH * 1024 * 1024);
    p.wgu_t = c.take<bf16_t>((size_t)DEPTH * NE * 2048 * 1024); p.wdn_t = c.take<bf16_t>((size_t)DEPTH * NE * 1024 * 1024);
    p.wq_t = c.take<bf16_t>((size_t)DEPTH * 384 * 256); p.wkv_t = c.take<bf16_t>((size_t)DEPTH * 512 * 128);
    p.xf = c.take<float>((size_t)NT * DM); p.xb = c.take<bf16_t>((size_t)NT * DM); p.pbuf = c.take<bf16_t>((size_t)NT * NINP);
    p.mixcat = c.take<bf16_t>((size_t)NT * DM); p.y1 = c.take<float>((size_t)NT * DM); p.x1b = c.take<bf16_t>((size_t)NT * DM);
    p.rq = c.take<float>((size_t)NT * 128); p.rk = c.take<float>((size_t)NT * 128);
    p.rkv = c.take<float>((size_t)NBATCH * NCH * 4 * 32 * 64); p.rstate = c.take<float>((size_t)NBATCH * NCH * 4 * 32 * 64);
    p.dq = c.take<float>((size_t)NT * 256); p.dk = c.take<float>((size_t)NT * 256); p.dob = c.take<float>((size_t)3 * NT * 256); p.dlse = c.take<float>((size_t)3 * NT * 4);
    p.sr = c.take<float>((size_t)NT * 256); p.sw = c.take<float>((size_t)NT * 256); p.sk = c.take<float>((size_t)NT * 256); p.sv = c.take<float>((size_t)NT * 256);
    p.sa = c.take<float>((size_t)NT * 256); p.sb = c.take<float>((size_t)NT * 256); p.sg = c.take<float>((size_t)NT * 256); p.sy = c.take<float>((size_t)NT * 256);
    p.vfirst = c.take<float>((size_t)NT * 256);
    p.rsq = c.take<float>(NT); p.rskv = c.take<float>(NT); p.kpe = c.take<float>((size_t)NT * 32);
    p.qu = c.take<float>((size_t)NT * 384); p.kvu = c.take<float>((size_t)NT * 512); p.mo = c.take<float>((size_t)NT * 256);
    p.mq = c.take<bf16_t>((size_t)NT * 384); p.mk = c.take<bf16_t>((size_t)NT * 384); p.mv = c.take<bf16_t>((size_t)NT * 256);
    p.rowtok = c.take<int>((size_t)NE * NT); p.toke = c.take<int>((size_t)NT * 4); p.tokpos = c.take<int>((size_t)NT * 4); p.rowgate = c.take<float>((size_t)NE * NT);
    p.act = c.take<bf16_t>((size_t)MOE_MAXROWS * 1024); p.yb = c.take<bf16_t>((size_t)MOE_MAXROWS * 1024);
    if (c.off > ws_size) { fprintf(stderr, "workspace too small: need %zu have %zu\n", c.off, ws_size); return; }

#ifdef MULTI_LAUNCH
    launch_ph<PH_PRO>(p, 0, stream);
    for (int l = 0; l < DEPTH; ++l) launch_layer<PH_INPROJ>(p, l, stream);
#else
    static int grid = 0;
    if (!grid) {
        (void)hipFuncSetAttribute((const void*)mega_fused, hipFuncAttributeMaxDynamicSharedMemorySize, LDS_BYTES);
        int dev = 0, cus = 0, per_cu = 0;
        (void)hipGetDevice(&dev);
        (void)hipDeviceGetAttribute(&cus, hipDeviceAttributeMultiprocessorCount, dev);
        (void)hipOccupancyMaxActiveBlocksPerMultiprocessor(&per_cu, mega_fused, NTHREADS, LDS_BYTES);
        if (cus <= 0) cus = 256;
        grid = cus * (per_cu < 1 ? 1 : 1);
    }
    (void)hipMemsetAsync(p.bar, 0, XCD_BAR_WORDS * sizeof(unsigned), stream);
    hipLaunchKernelGGL(mega_fused, dim3(grid), dim3(NTHREADS), LDS_BYTES, stream, p);
#endif
}
```

```cpp
#include <hip/hip_runtime.h>
#include <stdint.h>
#include <string.h>
#include <stdio.h>

typedef unsigned short bf16_t;
typedef short bf16x8 __attribute__((ext_vector_type(8)));
typedef float f32x4 __attribute__((ext_vector_type(4)));
typedef unsigned u32x4 __attribute__((ext_vector_type(4)));
typedef float f32x16 __attribute__((ext_vector_type(16)));
typedef short s16x4 __attribute__((ext_vector_type(4)));
typedef float f32x2_t __attribute__((ext_vector_type(2)));
typedef __bf16 bf16x2_t __attribute__((ext_vector_type(2)));

constexpr int NT = 32768, SEQ = 8192, NBATCH = 4, DM = 1024, NIN = 2976, NINP = 3072, DEPTH = 4, NE = 32, TOPK = 4;
constexpr int BLK = 128, NCH = SEQ / BLK;
constexpr float ALPHA = 1.6817928305074292f;
constexpr int PC_RQ = 0, PC_RK = 128, PC_RV = 256, PC_RG = 512, PC_DQ = 768, PC_DK = 1024, PC_DV = 1280;
constexpr int PC_C = 1536, PC_CR = 1536, PC_CK = 1792, PC_CV = 2048, PC_CWD = 2304, PC_CAD = 2368, PC_CGD = 2432;
constexpr int PC_MQ = 2560, PC_MKV = 2816, PC_MKR = 2944, PC_VRES = 2976;
constexpr int MOE_TM = 256;
constexpr int MOE_MAXROWS = NT * TOPK + NE * MOE_TM;
constexpr int NTHREADS = 512;
constexpr int LDS_BYTES = 147456;

__device__ __forceinline__ bf16_t f2bf(float f) { unsigned u = __float_as_uint(f); u += 0x7fffu + ((u >> 16) & 1u); return (bf16_t)(u >> 16); }
__device__ __forceinline__ unsigned cvtpk(float lo, float hi) { f32x2_t v = {lo, hi}; bf16x2_t b = __builtin_convertvector(v, bf16x2_t); return __builtin_bit_cast(unsigned, b); }
__device__ __forceinline__ float xhalf_max(float v) { auto rr = __builtin_amdgcn_permlane32_swap(__float_as_uint(v), __float_as_uint(v), false, false); return fmaxf(__uint_as_float(rr[0]), __uint_as_float(rr[1])); }
__device__ __forceinline__ float xhalf_sum(float v) { auto rr = __builtin_amdgcn_permlane32_swap(__float_as_uint(v), __float_as_uint(v), false, false); return __uint_as_float(rr[0]) + __uint_as_float(rr[1]); }
__device__ __forceinline__ float bf2f(bf16_t h) { return __uint_as_float(((unsigned)h) << 16); }
template <int CTRL> __device__ __forceinline__ float dpp_f(float v) { return __int_as_float(__builtin_amdgcn_update_dpp(0, __float_as_int(v), CTRL, 0xF, 0xF, true)); }
__device__ __forceinline__ float grp16_sum(float v) {
    v += dpp_f<0x128>(v); v += dpp_f<0x124>(v); v += dpp_f<0x122>(v); v += dpp_f<0x121>(v); return v; }
__device__ __forceinline__ float wave_sum(float v) {
    v = grp16_sum(v);
    const int i = __float_as_int(v);
    return (__int_as_float(__builtin_amdgcn_readlane(i, 0)) + __int_as_float(__builtin_amdgcn_readlane(i, 16))) +
           (__int_as_float(__builtin_amdgcn_readlane(i, 32)) + __int_as_float(__builtin_amdgcn_readlane(i, 48))); }
__device__ __forceinline__ float sigmoidf_(float x) { return 1.0f / (1.0f + __expf(-x)); }

#define XB_TMO      128
#define XB_XCNT(j)  (256  + 64 * (j))
#define XB_XSUB(j)  (1280 + 64 * (j))
#define XB_XGEN(j)  (2304 + 64 * (j))
#define XB_TOP      3328
#define XB_TOPGEN   3392
#define XCD_BAR_WORDS 3456
#define XB_SPIN_CAP (1u << 22)
#define LAS __attribute__((address_space(3)))
__device__ __forceinline__ unsigned xb_ld(unsigned* p)              { return __hip_atomic_load(p, __ATOMIC_RELAXED, __HIP_MEMORY_SCOPE_AGENT); }
__device__ __forceinline__ unsigned xb_add(unsigned* p, unsigned v) { return __hip_atomic_fetch_add(p, v, __ATOMIC_RELAXED, __HIP_MEMORY_SCOPE_AGENT); }
__device__ __forceinline__ unsigned xb_xcc_id() { return (unsigned)__builtin_amdgcn_s_getreg((3 << 11) | 20) & 0xFu; }
#define XB_SPIN(cond, bar) do { unsigned _sp = 0; while (cond) { __builtin_amdgcn_s_sleep(1); \
    if ((++_sp & 255u) == 0u) { if (xb_ld(&(bar)[XB_TMO])) break; if (_sp > XB_SPIN_CAP) { atomicAdd(&(bar)[XB_TMO], 1u); break; } } } } while (0)
struct XcdBarrier { unsigned* bar; unsigned x; volatile LAS unsigned* st; };
__device__ __forceinline__ XcdBarrier xcd_barrier_post(unsigned* bar, volatile LAS unsigned* st) {
    XcdBarrier b; b.bar = bar; b.x = xb_xcc_id(); b.st = st;
    if (threadIdx.x == 0) (void)xb_add(&bar[XB_XCNT(b.x)], 1u);
    return b;
}
__device__ __forceinline__ void xcd_barrier_complete(unsigned* bar, unsigned x, unsigned& nloc, unsigned& nx) {
    const unsigned G = gridDim.x * gridDim.y * gridDim.z;
    unsigned sum, cnt, mine, sp = 0u;
    for (;;) {
        sum = 0u; cnt = 0u; mine = 0u;
#pragma unroll
        for (unsigned j = 0; j < 16; ++j) { const unsigned c = xb_ld(&bar[XB_XCNT(j)]); sum += c; cnt += (c > 0u) ? 1u : 0u; mine = (j == x) ? c : mine; }
        if (sum == G) break;
        __builtin_amdgcn_s_sleep(1);
        if ((++sp & 255u) == 0u) { if (xb_ld(&bar[XB_TMO])) break; if (sp > XB_SPIN_CAP) { atomicAdd(&bar[XB_TMO], 1u); break; } }
    }
    nloc = mine > 0u ? mine : 1u; nx = cnt > 0u ? cnt : 1u;
}
__device__ __forceinline__ void xcd_barrier(const XcdBarrier& b, const int tid0) {
    asm volatile("s_waitcnt vmcnt(0)" ::: "memory");
    __syncthreads();
    if (tid0 == 0) {
        unsigned* bar = b.bar;
        __builtin_amdgcn_s_waitcnt(0);
        unsigned nloc = b.st[0], nx = b.st[1];
        if (nloc == 0u) { xcd_barrier_complete(bar, b.x, nloc, nx); b.st[0] = nloc; b.st[1] = nx; }
        const unsigned old = xb_add(&bar[XB_XSUB(b.x)], 1u);
        const unsigned gen = old / nloc;
        if (old + 1u == (gen + 1u) * nloc) {
            __builtin_amdgcn_fence(__ATOMIC_RELEASE, "agent");
            asm volatile("s_waitcnt vmcnt(0)" ::: "memory");
            const unsigned og = xb_add(&bar[XB_TOP], 1u);
            const unsigned tg = og / nx;
            if (og + 1u == (tg + 1u) * nx) xb_add(&bar[XB_TOPGEN], 1u);
            else XB_SPIN(xb_ld(&bar[XB_TOPGEN]) == tg, bar);
            __builtin_amdgcn_fence(__ATOMIC_ACQUIRE, "agent");
            xb_add(&bar[XB_XGEN(b.x)], 1u);
            asm volatile("s_waitcnt vmcnt(0)" ::: "memory");
        } else {
            XB_SPIN(xb_ld(&bar[XB_XGEN(b.x)]) == gen, bar);
            __builtin_amdgcn_fence(__ATOMIC_ACQUIRE, "agent");
            asm volatile("s_waitcnt vmcnt(0)" ::: "memory");
        }
    }
    __syncthreads();
}

struct Params {
    const float *x, *w_in, *w_out, *ret_norm_g, *dil_norm_g, *rwkv_mu, *rwkv_w0, *rwkv_w_up, *rwkv_a0, *rwkv_a_up, *rwkv_g_up, *rwkv_k_k, *rwkv_k_a,
        *rwkv_r_k, *rwkv_ln_g, *rwkv_ln_b, *vres_down, *vres_mu, *rwkv_v0, *rwkv_v_up, *mla_q_norm_g, *mla_w_q_up, *mla_kv_norm_g, *mla_w_kv_up,
        *mla_out_norm_g, *ln1_g, *ln1_b, *router_w, *router_b, *w_gu, *b_gu, *w_dn, *b_dn, *ln2_g, *ln2_b;
    float* out;
    unsigned* bar; int* cnt; int* wq;
    float *tab_ret, *tab_dil, *tab_mla;
    bf16_t *win_t, *wout_t, *wgu_t, *wdn_t, *wq_t, *wkv_t;
    float* xf; bf16_t* xb; bf16_t* pbuf; bf16_t* mixcat; float* y1; bf16_t* x1b;
    float *rq, *rk, *rkv, *rstate;
    float *dq, *dk, *dob, *dlse;
    float *sr, *sw, *sk, *sv, *sa, *sb, *sg, *sy, *vfirst;
    float *rsq, *rskv, *kpe, *qu, *kvu, *mo;
    bf16_t *mq, *mk, *mv;
    int *rowtok, *toke, *tokpos; float* rowgate; bf16_t *act, *yb;
};

__device__ __forceinline__ int opq_tid(int wbase) { unsigned z = 0u; asm volatile("" : "+s"(z)); int t = wbase | (int)__builtin_amdgcn_mbcnt_hi(~0u, __builtin_amdgcn_mbcnt_lo(~0u, z)); asm volatile("" : "+v"(t)); return t; }
__device__ __forceinline__ int opq_bid() { int b = blockIdx.x; asm volatile("" : "+s"(b)); return b; }
typedef const __attribute__((address_space(4))) Params* KPtr;
typedef const __attribute__((address_space(4))) Params& KRef;
__device__ __forceinline__ KPtr kp_launder(KPtr k) {
    const unsigned long long v = (unsigned long long)k;
    unsigned lo = (unsigned)v, hi = (unsigned)(v >> 32);
    asm volatile("" : "+s"(lo), "+s"(hi));
    return (KPtr)(((unsigned long long)hi << 32) | lo);
}
#define PH_HEADV (void)kp_in; const Params& p = pkv; const int TID = opq_tid(wbase_in), BID = opq_bid(); (void)TID; (void)BID;
#define PH_HEAD (void)pkv; KPtr kp_ = kp_launder(kp_in); KRef p = *kp_; const int TID = opq_tid(wbase_in), BID = opq_bid(); (void)TID; (void)BID;
template <class F>
__device__ __forceinline__ void tr_tile(F f, bf16_t* dst, int ldd, int k0, int n0, float* tile, const int TID) {
    const int tid = TID;
#pragma unroll
    for (int i = 0; i < 8; ++i) { const int e = tid + i * NTHREADS, kk = e >> 6, nn = e & 63; tile[kk * 65 + nn] = f(k0 + kk, n0 + nn); }
    __syncthreads();
#pragma unroll
    for (int i = 0; i < 8; ++i) { const int e = tid + i * NTHREADS, nn = e >> 6, kk = e & 63; dst[(size_t)(n0 + nn) * ldd + k0 + kk] = f2bf(tile[kk * 65 + nn]); }
    __syncthreads();
}

__device__ __forceinline__ void ph_prologue(const Params& pkv, KPtr kp_in, int wbase_in, char* lds) {
    PH_HEAD
    float* tile = (float*)lds;
    const int nb = gridDim.x, bid = BID, tid = TID;
    for (int t = bid; t < DEPTH * NE * 16 * 32; t += nb) {
        const int le = t >> 9, r = t & 511, tk = r >> 5, tn = r & 31;
        const float* src = p.w_gu + (size_t)le * 1024 * 2048;
        tr_tile([&](int k, int n) { return src[(size_t)k * 2048 + n]; }, p.wgu_t + (size_t)le * 2048 * 1024, 1024, tk * 64, tn * 64, tile, TID);
    }
    for (int t = bid; t < DEPTH * NE * 16 * 16; t += nb) {
        const int le = t >> 8, r = t & 255, tk = r >> 4, tn = r & 15;
        const float* src = p.w_dn + (size_t)le * 1024 * 1024;
        tr_tile([&](int k, int n) { return src[(size_t)k * 1024 + n]; }, p.wdn_t + (size_t)le * 1024 * 1024, 1024, tk * 64, tn * 64, tile, TID);
    }
    for (int t = bid; t < DEPTH * 16 * 48; t += nb) {
        const int l = t / (16 * 48), r = t % (16 * 48), tk = r / 48, tn = r % 48;
        const float* src = p.w_in + (size_t)l * 1024 * NIN;
        const float* vr = p.vres_down + (size_t)(l > 0 ? l - 1 : 0) * 1024 * 32;
        tr_tile([&](int k, int n) { return n < NIN ? src[(size_t)k * NIN + n] : ((n < NIN + 32 && l > 0) ? vr[k * 32 + (n - NIN)] : 0.0f); },
                p.win_t + (size_t)l * NINP * 1024, 1024, tk * 64, tn * 64, tile, TID);
    }
    for (int t = bid; t < DEPTH * 16 * 16; t += nb) {
        const int l = t >> 8, r = t & 255, tk = r >> 4, tn = r & 15;
        const float* src = p.w_out + (size_t)l * 1024 * 1024;
        tr_tile([&](int k, int n) { return src[(size_t)k * 1024 + n]; }, p.wout_t + (size_t)l * 1024 * 1024, 1024, tk * 64, tn * 64, tile, TID);
    }
    for (int t = bid; t < DEPTH * 4 * 6; t += nb) {
        const int l = t / 24, r = t % 24, tk = r / 6, tn = r % 6;
        const float* src = p.mla_w_q_up + (size_t)l * 256 * 384; const float* g = p.mla_q_norm_g + l * 256;
        tr_tile([&](int k, int n) { return src[k * 384 + n] * g[k]; }, p.wq_t + (size_t)l * 384 * 256, 256, tk * 64, tn * 64, tile, TID);
    }
    for (int t = bid; t < DEPTH * 2 * 8; t += nb) {
        const int l = t / 16, r = t % 16, tk = r / 8, tn = r % 8;
        const float* src = p.mla_w_kv_up + (size_t)l * 128 * 512; const float* g = p.mla_kv_norm_g + l * 128;
        tr_tile([&](int k, int n) { return src[k * 512 + n] * g[k]; }, p.wkv_t + (size_t)l * 512 * 128, 128, tk * 64, tn * 64, tile, TID);
    }
    for (int i = bid * NTHREADS + tid; i < SEQ * 40; i += nb * NTHREADS) {
        const int pos = i / 40, j = i % 40;
        double theta, rot; int f; float* dst;
        if (j < 16) { theta = 10000.0; rot = 32.0; f = j; dst = p.tab_ret + ((size_t)pos * 16 + f) * 2; }
        else if (j < 24) { theta = 500000.0; rot = 16.0; f = j - 16; dst = p.tab_dil + ((size_t)pos * 8 + f) * 2; }
        else { theta = 10000.0; rot = 32.0; f = j - 24; dst = p.tab_mla + ((size_t)pos * 16 + f) * 2; }
        const double inv = 1.0 / pow(theta, (2.0 * f) / rot), ang = (double)pos * inv;
        dst[0] = (float)cos(ang); dst[1] = (float)sin(ang);
    }
    for (size_t i = (size_t)bid * NTHREADS + tid; i < (size_t)NT * DM / 4; i += (size_t)nb * NTHREADS) {
        const float4 v = ((const float4*)p.x)[i];
        ushort4 o; o.x = f2bf(v.x); o.y = f2bf(v.y); o.z = f2bf(v.z); o.w = f2bf(v.w);
        ((ushort4*)p.xb)[i] = o;
    }
    if (bid == 0 && tid < DEPTH * NE) p.cnt[tid] = 0;
    if (bid == 0 && tid < DEPTH * 16) p.wq[tid] = 0;
}

template <class Epi>
__device__ __forceinline__ void gemm_tile128(const bf16_t* __restrict__ A, int lda, const int* __restrict__ rowidx, int nvalid,
                                             const bf16_t* __restrict__ Bt, int ldb, int K, char* lds, const int TID, Epi epi) {
    constexpr int LDT = 72;
    bf16_t* As = (bf16_t*)lds; bf16_t* Bs = As + 128 * LDT;
    const int tid = TID, lane = tid & 63, wid = tid >> 6, wm = wid >> 2, wn = wid & 3, fr = lane & 15, fq = lane >> 4;
    const bf16_t* ap[2]; const bf16_t* bp[2]; int so[2];
#pragma unroll
    for (int i = 0; i < 2; ++i) {
        const int c = tid + i * NTHREADS, row = c >> 3, kc = c & 7;
        int ar = row; if (rowidx) ar = (row < nvalid) ? rowidx[row] : rowidx[0];
        ap[i] = A + (size_t)ar * lda + kc * 8; bp[i] = Bt + (size_t)row * ldb + kc * 8; so[i] = row * LDT + kc * 8;
    }
    f32x4 acc[4][2];
#pragma unroll
    for (int mi = 0; mi < 4; ++mi)
#pragma unroll
        for (int ni = 0; ni < 2; ++ni) acc[mi][ni] = (f32x4){0.f, 0.f, 0.f, 0.f};
    u32x4 ra0, ra1, rb0, rb1;
    ra0 = *(const u32x4*)(ap[0]); ra1 = *(const u32x4*)(ap[1]); rb0 = *(const u32x4*)(bp[0]); rb1 = *(const u32x4*)(bp[1]);
    const int nk = K >> 6;
    for (int kt = 0; kt < nk; ++kt) {
        __syncthreads();
        *(u32x4*)(As + so[0]) = ra0; *(u32x4*)(As + so[1]) = ra1; *(u32x4*)(Bs + so[0]) = rb0; *(u32x4*)(Bs + so[1]) = rb1;
        __syncthreads();
        if (kt + 1 < nk) {
            const int ko = (kt + 1) * 64;
            ra0 = *(const u32x4*)(ap[0] + ko); ra1 = *(const u32x4*)(ap[1] + ko); rb0 = *(const u32x4*)(bp[0] + ko); rb1 = *(const u32x4*)(bp[1] + ko);
        }
#pragma unroll
        for (int kk = 0; kk < 2; ++kk) {
            bf16x8 af[4], bfr[2];
#pragma unroll
            for (int mi = 0; mi < 4; ++mi) af[mi] = *(const bf16x8*)(As + (wm * 64 + mi * 16 + fr) * LDT + kk * 32 + fq * 8);
#pragma unroll
            for (int ni = 0; ni < 2; ++ni) bfr[ni] = *(const bf16x8*)(Bs + (wn * 32 + ni * 16 + fr) * LDT + kk * 32 + fq * 8);
#pragma unroll
            for (int mi = 0; mi < 4; ++mi)
#pragma unroll
                for (int ni = 0; ni < 2; ++ni) acc[mi][ni] = __builtin_amdgcn_mfma_f32_16x16x32_bf16(bfr[ni], af[mi], acc[mi][ni], 0, 0, 0);
        }
    }
#pragma unroll
    for (int mi = 0; mi < 4; ++mi)
#pragma unroll
        for (int ni = 0; ni < 2; ++ni) epi(wm * 64 + mi * 16 + fr, wn * 32 + ni * 16 + fq * 4, acc[mi][ni]);
    __syncthreads();
}

__device__ __forceinline__ int g8_lds_byte(int r, int c) { const int st = (r >> 4) * 2 + (c >> 5), rr = r & 15, cc = c & 31, ob = rr * 64 + cc * 2; return st * 1024 + (ob ^ (((ob >> 9) & 1) << 5)); }
__device__ __forceinline__ void g8_stage_rc(int b, int& R, int& C) { const int st = b / 1024, sb = b % 1024, swz = sb ^ (((sb >> 9) & 1) << 5); R = (st >> 1) * 16 + swz / 64; C = (st & 1) * 32 + (swz % 64) / 2; }
template <class Epi>
__device__ __forceinline__ void gemm_tile256(const bf16_t* __restrict__ A, int lda, const int* __restrict__ rowidx, int nvalid,
                                             const bf16_t* __restrict__ Bt, int ldb, int K, char* lds, const int TID, Epi epi) {
    constexpr int G_HT = 128 * 64;
    bf16_t* shm = (bf16_t*)lds;
#define G8_SA(b, h) (shm + ((b) * 2 + (h)) * G_HT)
#define G8_SB(b, h) (shm + (4 + (b) * 2 + (h)) * G_HT)
#define G8_SPTR(dst, src) do { unsigned long long _v = (unsigned long long)(src); unsigned _lo = (unsigned)_v, _hi = (unsigned)(_v >> 32); asm volatile("" : "+s"(_lo), "+s"(_hi)); \
        dst = (const char*)(((unsigned long long)_hi << 32) | _lo); } while (0)
#define G8_STAGE(P, BASE, OFF, kt) do { const char* _sb; G8_SPTR(_sb, (const char*)(BASE) + (size_t)(kt) * 128); _Pragma("unroll") for (int _i = 0; _i < 2; ++_i) { \
        __builtin_amdgcn_global_load_lds((const unsigned*)(_sb + (size_t)(OFF)[_i]), (unsigned*)((char*)(P) + tz * 16 + _i * 8192), 16, 0, 0); } } while (0)
#define G8_LDA(dst, b, h) _Pragma("unroll") for (int m = 0; m < 4; ++m) _Pragma("unroll") for (int k = 0; k < 2; ++k) \
        dst[m][k] = *reinterpret_cast<const bf16x8*>((char*)G8_SA(b, h) + g8_lds_byte(wr * 64 + m * 16 + fr, k * 32 + fq * 8))
#define G8_LDB(dst, b, h) _Pragma("unroll") for (int n = 0; n < 2; ++n) _Pragma("unroll") for (int k = 0; k < 2; ++k) \
        dst[n][k] = *reinterpret_cast<const bf16x8*>((char*)G8_SB(b, h) + g8_lds_byte(wc * 32 + n * 16 + fr, k * 32 + fq * 8))
#define G8_MMA(ai, bj, At_, Bt_) do { __builtin_amdgcn_s_setprio(1); \
        _Pragma("unroll") for (int m = 0; m < 4; ++m) _Pragma("unroll") for (int n = 0; n < 2; ++n) _Pragma("unroll") for (int k = 0; k < 2; ++k) \
            acc[ai][bj][m][n] = __builtin_amdgcn_mfma_f32_16x16x32_bf16(Bt_[n][k], At_[m][k], acc[ai][bj][m][n], 0, 0, 0); \
        __builtin_amdgcn_s_setprio(0); } while (0)
#define G8_WAIT_V(n) asm volatile("s_waitcnt vmcnt(" #n ")" ::: "memory")
#define G8_WAIT_L(n) asm volatile("s_waitcnt lgkmcnt(" #n ")" ::: "memory")
#define G8_BAR __builtin_amdgcn_s_barrier()
#define G8_SCHED __builtin_amdgcn_sched_barrier(0)
    int tz = opq_tid(TID);
    int wid = tz >> 6, lane = tz & 63, wr = wid >> 2, wc = wid & 3, fr = lane & 15, fq = lane >> 4;
    unsigned aoff0[2], aoff1[2], boff0[2];
#pragma unroll
    for (int i = 0; i < 2; ++i) {
        int r, c; g8_stage_rc(tz * 16 + i * 8192, r, c);
        int r0 = r, r1 = 128 + r;
        if (rowidx) { r0 = (r0 < nvalid) ? rowidx[r0] : rowidx[0]; r1 = (r1 < nvalid) ? rowidx[r1] : rowidx[0]; }
        aoff0[i] = (unsigned)(r0 * lda + c) * 2u; aoff1[i] = (unsigned)(r1 * lda + c) * 2u;
        boff0[i] = (unsigned)(r * ldb + c) * 2u;
    }
    const bf16_t* Bt1 = Bt + (size_t)128 * ldb;
    f32x4 acc[2][2][4][2];
#pragma unroll
    for (int a = 0; a < 2; ++a)
#pragma unroll
        for (int b = 0; b < 2; ++b)
#pragma unroll
            for (int m = 0; m < 4; ++m)
#pragma unroll
                for (int n = 0; n < 2; ++n) acc[a][b][m][n] = (f32x4){0.f, 0.f, 0.f, 0.f};
    bf16x8 At[4][2], B0[2][2], B1[2][2];
    const int nt = K / 64;
    G8_STAGE(G8_SB(0, 0), Bt, boff0, 0); G8_STAGE(G8_SA(0, 0), A, aoff0, 0);
    G8_STAGE(G8_SB(0, 1), Bt1, boff0, 0); G8_STAGE(G8_SA(0, 1), A, aoff1, 0);
    if (wr == 1) G8_BAR;
    G8_WAIT_V(4); G8_BAR;
    G8_STAGE(G8_SB(1, 0), Bt, boff0, 1); G8_STAGE(G8_SA(1, 0), A, aoff0, 1); G8_STAGE(G8_SB(1, 1), Bt1, boff0, 1);
    G8_WAIT_V(6); G8_BAR;
    for (int t = 0; t < nt - 2; t += 2) {
        G8_LDB(B0, 0, 0); G8_SCHED; G8_LDA(At, 0, 0); G8_STAGE(G8_SA(1, 1), A, aoff1, t + 1);
        G8_WAIT_L(8); G8_BAR; G8_WAIT_L(0); G8_MMA(0, 0, At, B0); G8_BAR; G8_SCHED;
        G8_LDB(B1, 0, 1); G8_STAGE(G8_SB(0, 0), Bt, boff0, t + 2);
        G8_BAR; G8_WAIT_L(0); G8_MMA(0, 1, At, B1); G8_BAR;
        G8_LDA(At, 0, 1); G8_STAGE(G8_SA(0, 0), A, aoff0, t + 2);
        G8_BAR; G8_WAIT_L(0); G8_MMA(1, 0, At, B0); G8_BAR; G8_SCHED;
        G8_STAGE(G8_SB(0, 1), Bt1, boff0, t + 2);
        G8_WAIT_V(6); G8_BAR; G8_MMA(1, 1, At, B1); G8_BAR;
        G8_LDB(B0, 1, 0); G8_SCHED; G8_LDA(At, 1, 0); G8_STAGE(G8_SA(0, 1), A, aoff1, t + 2);
        G8_WAIT_L(8); G8_BAR; G8_WAIT_L(0); G8_MMA(0, 0, At, B0); G8_BAR; G8_SCHED;
        G8_LDB(B1, 1, 1); G8_STAGE(G8_SB(1, 0), Bt, boff0, t + 3);
        G8_BAR; G8_WAIT_L(0); G8_MMA(0, 1, At, B1); G8_BAR;
        G8_LDA(At, 1, 1); G8_STAGE(G8_SA(1, 0), A, aoff0, t + 3);
        G8_BAR; G8_WAIT_L(0); G8_MMA(1, 0, At, B0); G8_BAR; G8_SCHED;
        G8_STAGE(G8_SB(1, 1), Bt1, boff0, t + 3);
        G8_WAIT_V(6); G8_BAR; G8_MMA(1, 1, At, B1); G8_BAR;
    }
    { G8_LDB(B0, 0, 0); G8_WAIT_V(0); G8_LDA(At, 0, 0); G8_STAGE(G8_SA(1, 1), A, aoff1, nt - 1);
      G8_BAR; G8_WAIT_L(0); G8_MMA(0, 0, At, B0); G8_BAR;
      G8_LDB(B1, 0, 1); G8_BAR; G8_WAIT_L(0); G8_MMA(0, 1, At, B1); G8_BAR;
      G8_LDA(At, 0, 1); G8_WAIT_V(4); G8_BAR; G8_WAIT_L(0); G8_MMA(1, 0, At, B0); G8_MMA(1, 1, At, B1); G8_BAR; }
    { G8_LDB(B0, 1, 0); G8_LDA(At, 1, 0); G8_WAIT_V(2); G8_BAR; G8_WAIT_L(0); G8_MMA(0, 0, At, B0); G8_BAR;
      G8_LDB(B1, 1, 1); G8_WAIT_V(0); G8_BAR; G8_WAIT_L(0); G8_MMA(0, 1, At, B1); G8_BAR;
      G8_LDA(At, 1, 1); G8_BAR; G8_WAIT_L(0); G8_MMA(1, 0, At, B0); G8_MMA(1, 1, At, B1); G8_BAR; }
    if (wr == 0) G8_BAR;
    asm volatile("" : "+v"(tz)); wid = tz >> 6; lane = tz & 63; wr = wid >> 2; wc = wid & 3; fr = lane & 15; fq = lane >> 4;
#pragma unroll
    for (int ai = 0; ai < 2; ++ai)
#pragma unroll
        for (int m = 0; m < 4; ++m)
#pragma unroll
            for (int bj = 0; bj < 2; ++bj)
#pragma unroll
                for (int n = 0; n < 2; ++n) epi(ai * 128 + wr * 64 + m * 16 + fr, bj * 128 + wc * 32 + n * 16 + fq * 4, acc[ai][bj][m][n]);
    __syncthreads();
}

__device__ __forceinline__ void ph_inproj(const Params& pkv, KPtr kp_in, int wbase_in, int l, char* lds) {
    PH_HEAD
    const bf16_t* Bt = p.win_t + (size_t)l * NINP * 1024;
    const int ntn = NINP / 256, nunits = (NT / 256) * ntn;
    for (int u = BID; u < nunits; u += gridDim.x) {
        const int mt = u / ntn, nt = u % ntn;
        bf16_t* out = p.pbuf + (size_t)mt * 256 * NINP + nt * 256;
        gemm_tile256(p.xb + (size_t)mt * 256 * 1024, 1024, nullptr, 256, Bt + (size_t)nt * 256 * 1024, 1024, 1024, lds, wbase_in,
                     [=](int r, int c, f32x4 v) mutable { ushort4 o; o.x = f2bf(v[0]); o.y = f2bf(v[1]); o.z = f2bf(v[2]); o.w = f2bf(v[3]); *(ushort4*)(out + (size_t)r * NINP + c) = o; });
    }
}

__device__ __forceinline__ void ph_rope_prep(const Params& pkv, KPtr kp_in, int wbase_in, int l) {
    PH_HEAD
    const int lane = TID & 63, gw = BID * (NTHREADS / 64) + (TID >> 6), nw = gridDim.x * (NTHREADS / 64);
    for (int t = gw; t < NT; t += nw) {
        const int pos = t % SEQ;
        const bf16_t* pr = p.pbuf + (size_t)t * NINP;
        {
            const int h = lane >> 4, i = lane & 15;
            const float c = p.tab_ret[(pos * 16 + i) * 2], s = p.tab_ret[(pos * 16 + i) * 2 + 1];
            float x1 = bf2f(pr[PC_RQ + h * 32 + i]), x2 = bf2f(pr[PC_RQ + h * 32 + 16 + i]);
            p.rq[(size_t)t * 128 + h * 32 + i] = x1 * c - x2 * s; p.rq[(size_t)t * 128 + h * 32 + 16 + i] = x1 * s + x2 * c;
            x1 = bf2f(pr[PC_RK + h * 32 + i]); x2 = bf2f(pr[PC_RK + h * 32 + 16 + i]);
            const float sc = 0.17677669529663687f;
            p.rk[(size_t)t * 128 + h * 32 + i] = (x1 * c - x2 * s) * sc; p.rk[(size_t)t * 128 + h * 32 + 16 + i] = (x1 * s + x2 * c) * sc;
        }
        {
            for (int e = lane; e < 256; e += 64) {
                const int h = e >> 6, d = e & 63;
                float qv, kv;
                if (d < 16) {
                    const int i = d & 7; const float c = p.tab_dil[(pos * 8 + i) * 2], s = p.tab_dil[(pos * 8 + i) * 2 + 1];
                    const float q1 = bf2f(pr[PC_DQ + h * 64 + i]), q2 = bf2f(pr[PC_DQ + h * 64 + 8 + i]);
                    const float k1 = bf2f(pr[PC_DK + h * 64 + i]), k2 = bf2f(pr[PC_DK + h * 64 + 8 + i]);
                    if (d < 8) { qv = q1 * c - q2 * s; kv = k1 * c - k2 * s; } else { qv = q1 * s + q2 * c; kv = k1 * s + k2 * c; }
                } else { qv = bf2f(pr[PC_DQ + e]); kv = bf2f(pr[PC_DK + e]); }
                ((bf16_t*)p.dq)[(size_t)t * 256 + e] = f2bf(qv * (0.125f * 1.4426950408889634f)); ((bf16_t*)p.dk)[(size_t)t * 256 + e] = f2bf(kv);
            }
        }
        {
            float ss = 0.f;
            for (int e = lane; e < 256; e += 64) { const float v = bf2f(pr[PC_MQ + e]); ss += v * v; }
            ss = wave_sum(ss);
            float s2 = 0.f;
            for (int e = lane; e < 128; e += 64) { const float v = bf2f(pr[PC_MKV + e]); s2 += v * v; }
            s2 = wave_sum(s2);
            if (lane == 0) { p.rsq[t] = rsqrtf(ss * (1.0f / 256.0f) + 1e-6f); p.rskv[t] = rsqrtf(s2 * (1.0f / 128.0f) + 1e-6f); }
            if (lane < 16) {
                const float c = p.tab_mla[(pos * 16 + lane) * 2], s = p.tab_mla[(pos * 16 + lane) * 2 + 1];
                const float x1 = bf2f(pr[PC_MKR + lane]), x2 = bf2f(pr[PC_MKR + 16 + lane]);
                p.kpe[(size_t)t * 32 + lane] = x1 * c - x2 * s; p.kpe[(size_t)t * 32 + 16 + lane] = x1 * s + x2 * c;
            }
        }
    }
}

__device__ __forceinline__ float ret_log_gamma(int h) { return logf(1.0f - exp2f(-5.0f - (float)h)); }

__device__ __forceinline__ void ph_ret_kv(const Params& pkv, KPtr kp_in, int wbase_in, int l, char* lds) {
    PH_HEAD
    float* kz = (float*)lds;
    float* vs = kz + 128 * 32;
    const int tid = TID;
    for (int u = BID; u < NBATCH * NCH * 4; u += gridDim.x) {
        const int h = u & 3, n = (u >> 2) & 63, b = u >> 8;
        const float lg = ret_log_gamma(h);
        const int t0 = b * SEQ + n * BLK;
        __syncthreads();
        for (int e = tid; e < 128 * 32; e += NTHREADS) { const int j = e >> 5, d = e & 31; kz[e] = p.rk[(size_t)(t0 + j) * 128 + h * 32 + d] * __expf((float)(BLK - 1 - j) * lg); }
        for (int e = tid; e < 128 * 64; e += NTHREADS) { const int j = e >> 6, c = e & 63; vs[e] = bf2f(p.pbuf[(size_t)(t0 + j) * NINP + PC_RV + h * 64 + c]); }
        __syncthreads();
        const int e = tid & 63, d0 = (tid >> 6) * 4;
        float a0 = 0.f, a1 = 0.f, a2 = 0.f, a3 = 0.f;
#pragma unroll 8
        for (int j = 0; j < BLK; ++j) {
            const float vv = vs[j * 64 + e]; const float4 kk = *(const float4*)(kz + j * 32 + d0);
            a0 += kk.x * vv; a1 += kk.y * vv; a2 += kk.z * vv; a3 += kk.w * vv;
        }
        float* out = p.rkv + (size_t)u * 2048;
        out[(d0 + 0) * 64 + e] = a0; out[(d0 + 1) * 64 + e] = a1; out[(d0 + 2) * 64 + e] = a2; out[(d0 + 3) * 64 + e] = a3;
    }
}
__device__ __forceinline__ void ph_ret_scan(const Params& pkv, KPtr kp_in, int wbase_in, int l) {
    PH_HEAD
    const int i = BID * NTHREADS + TID;
    if (i < NBATCH * 4 * 32 * 64) {
        const int e = i & 63, d = (i >> 6) & 31, h = (i >> 11) & 3, b = i >> 13;
        const float cd = __expf((float)BLK * ret_log_gamma(h));
        float s = 0.f;
        for (int n = 0; n < NCH; ++n) {
            const size_t idx = ((((size_t)b * NCH + n) * 4 + h) * 32 + d) * 64 + e;
            p.rstate[idx] = s; s = cd * s + p.rkv[idx];
        }
    }
}
__device__ __forceinline__ void ph_ret_out(const Params& pkv, KPtr kp_in, int wbase_in, int l) {
    PH_HEAD
    const int lane = TID & 63;
    const int nwv = gridDim.x * (NTHREADS / 64);
    for (int w = BID * (NTHREADS / 64) + (TID >> 6); w < NT / 64 * 4; w += nwv) {
        const int h = w & 3, tb = (w >> 2) * 64, t = tb + lane, b = t / SEQ, pos = t % SEQ, n = pos / BLK, i = pos % BLK, c0 = tb - (tb % BLK);
        const float lg = ret_log_gamma(h);
        float q[32], o[64];
#pragma unroll
        for (int d = 0; d < 32; ++d) q[d] = p.rq[(size_t)t * 128 + h * 32 + d];
#pragma unroll
        for (int e = 0; e < 64; ++e) o[e] = 0.f;
        const int jmax = (tb % BLK) + 63;
        for (int j = 0; j <= jmax; ++j) {
            const float* kj = p.rk + (size_t)(c0 + j) * 128 + h * 32;
            float s = 0.f;
#pragma unroll
            for (int d = 0; d < 32; ++d) s += q[d] * kj[d];
            s = (j <= i) ? s * __expf((float)(i - j) * lg) : 0.f;
            const bf16_t* vj = p.pbuf + (size_t)(c0 + j) * NINP + PC_RV + h * 64;
#pragma unroll
            for (int e = 0; e < 64; ++e) o[e] += s * bf2f(vj[e]);
        }
        const float xi = __expf((float)(i + 1) * lg);
        const float* st = p.rstate + (((size_t)b * NCH + n) * 4 + h) * 32 * 64;
        for (int d = 0; d < 32; ++d) {
            const float qd = q[d] * xi;
#pragma unroll
            for (int e = 0; e < 64; ++e) o[e] += qd * st[d * 64 + e];
        }
        float ss = 0.f;
#pragma unroll
        for (int e = 0; e < 64; ++e) ss += o[e] * o[e];
        const float rs = rsqrtf(ss * (1.0f / 64.0f) + 1e-6f);
        const float* ng = p.ret_norm_g + l * 256 + h * 64;
        const bf16_t* gp = p.pbuf + (size_t)t * NINP + PC_RG + h * 64;
        bf16_t* outp = p.mixcat + (size_t)t * 1024 + h * 64;
#pragma unroll
        for (int e = 0; e < 64; ++e) { const float g = bf2f(gp[e]); outp[e] = f2bf(g * sigmoidf_(g) * (o[e] * rs * ng[e])); }
    }
}

__device__ __forceinline__ void ph_dil_attn(const Params& pkv, KPtr kp_in, int wbase_in, int l, char* lds) {
    PH_HEAD
    constexpr int KSTR = 72, VSTR = 68;
    bf16_t* Ks = (bf16_t*)lds;
    bf16_t* Vt = Ks + 64 * KSTR;
    const int tid = TID, lane = tid & 63, wv = tid >> 6, r = lane & 31, h = lane >> 5;
    for (int it = BID; it < 16 * 96; it += gridDim.x) {
        const int bh = it & 15, u = it >> 4;
        const int b = bh >> 2, hd = bh & 3;
        int pat, dil, rr, m0;
        if (u < 32) { pat = 0; dil = 1; rr = 0; m0 = u * 256; }
        else if (u < 64) { pat = 1; dil = 4; rr = (u - 32) >> 3; m0 = ((u - 32) & 7) * 256; }
        else { pat = 2; dil = 16; rr = (u - 64) >> 1; m0 = ((u - 64) & 1) * 256; }
        const int qmin = m0 + 32 * wv, qmax = qmin + 31, myq = qmin + r;
        const size_t tok0 = (size_t)b * SEQ + rr;
        bf16x8 qf[4];
        {
            const bf16_t* qrow = (const bf16_t*)p.dq + (tok0 + (size_t)dil * myq) * 256 + hd * 64 + 8 * h;
#pragma unroll
            for (int s = 0; s < 4; ++s) qf[s] = *(const bf16x8*)(qrow + 16 * s);
        }
        f32x16 o0, o1;
#pragma unroll
        for (int i = 0; i < 16; ++i) { o0[i] = 0.f; o1[i] = 0.f; }
        float m = -1e30f, lsum = 0.f;
        const int kk = tid >> 3, kc = tid & 7, vk = tid & 63, vc = tid >> 6;
        const bf16_t* kbase = (const bf16_t*)p.dk + hd * 64 + kc * 8;
        const bf16_t* vbase = p.pbuf + PC_DV + hd * 64 + vc * 8;
        const int j0 = (m0 == 0) ? 2 : 0;
        u32x4 rk, rv;
        {
            const int kb = m0 - 128 + 64 * j0;
            rk = *(const u32x4*)(kbase + (tok0 + (size_t)dil * (kb + kk)) * 256);
            rv = *(const u32x4*)(vbase + (tok0 + (size_t)dil * (kb + vk)) * NINP);
        }
        for (int j = j0; j < 6; ++j) {
            __syncthreads();
            *(u32x4*)(Ks + kk * KSTR + kc * 8) = rk;
            {
                const unsigned w0 = rv[0], w1 = rv[1], w2 = rv[2], w3 = rv[3];
                bf16_t* vd = Vt + (vc * 8) * VSTR + vk;
                vd[0] = (bf16_t)(w0 & 0xffff); vd[VSTR] = (bf16_t)(w0 >> 16); vd[2 * VSTR] = (bf16_t)(w1 & 0xffff); vd[3 * VSTR] = (bf16_t)(w1 >> 16);
                vd[4 * VSTR] = (bf16_t)(w2 & 0xffff); vd[5 * VSTR] = (bf16_t)(w2 >> 16); vd[6 * VSTR] = (bf16_t)(w3 & 0xffff); vd[7 * VSTR] = (bf16_t)(w3 >> 16);
            }
            __syncthreads();
            const int kb = m0 - 128 + 64 * j;
            if (j + 1 < 6) {
                const int kn = kb + 64;
                rk = *(const u32x4*)(kbase + (tok0 + (size_t)dil * (kn + kk)) * 256);
                rv = *(const u32x4*)(vbase + (tok0 + (size_t)dil * (kn + vk)) * NINP);
            }
            const bool need0 = (kb <= qmax) && (kb + 31 >= qmin - 128);
            const bool need1 = (kb + 32 <= qmax) && (kb + 63 >= qmin - 128);
            if (need0 || need1) {
                f32x16 s0, s1;
#pragma unroll
                for (int i = 0; i < 16; ++i) { s0[i] = -3e38f; s1[i] = -3e38f; }
                if (need0) {
#pragma unroll
                    for (int i = 0; i < 16; ++i) s0[i] = 0.f;
#pragma unroll
                    for (int s = 0; s < 4; ++s) { const bf16x8 kf = *(const bf16x8*)(Ks + r * KSTR + 16 * s + 8 * h); s0 = __builtin_amdgcn_mfma_f32_32x32x16_bf16(kf, qf[s], s0, 0, 0, 0); }
                    if (!((kb + 31 <= qmin) && (kb >= qmax - 128))) {
#pragma unroll
                        for (int i = 0; i < 16; ++i) { const int key = kb + (i & 3) + 8 * (i >> 2) + 4 * h; if (key > myq || key < myq - 128) s0[i] = -3e38f; }
                    }
                }
                if (need1) {
#pragma unroll
                    for (int i = 0; i < 16; ++i) s1[i] = 0.f;
#pragma unroll
                    for (int s = 0; s < 4; ++s) { const bf16x8 kf = *(const bf16x8*)(Ks + (32 + r) * KSTR + 16 * s + 8 * h); s1 = __builtin_amdgcn_mfma_f32_32x32x16_bf16(kf, qf[s], s1, 0, 0, 0); }
                    if (!((kb + 63 <= qmin) && (kb + 32 >= qmax - 128))) {
#pragma unroll
                        for (int i = 0; i < 16; ++i) { const int key = kb + 32 + (i & 3) + 8 * (i >> 2) + 4 * h; if (key > myq || key < myq - 128) s1[i] = -3e38f; }
                    }
                }
                float mx = s0[0];
#pragma unroll
                for (int i = 1; i < 16; ++i) mx = fmaxf(mx, s0[i]);
#pragma unroll
                for (int i = 0; i < 16; ++i) mx = fmaxf(mx, s1[i]);
                mx = xhalf_max(mx);
                const float mn = fmaxf(m, mx), alpha = __builtin_amdgcn_exp2f(m - mn);
                m = mn;
                float ps = 0.f;
                if (need0) {
#pragma unroll
                    for (int i = 0; i < 16; ++i) { s0[i] = __builtin_amdgcn_exp2f(s0[i] - mn); ps += s0[i]; }
                }
                if (need1) {
#pragma unroll
                    for (int i = 0; i < 16; ++i) { s1[i] = __builtin_amdgcn_exp2f(s1[i] - mn); ps += s1[i]; }
                }
                lsum = lsum * alpha + ps;
                if (!__all(alpha == 1.0f)) {
#pragma unroll
                    for (int i = 0; i < 16; ++i) { o0[i] *= alpha; o1[i] *= alpha; }
                }
                if (need0) {
#pragma unroll
                    for (int s = 0; s < 2; ++s) {
                        u32x4 pw; pw[0] = cvtpk(s0[8 * s], s0[8 * s + 1]); pw[1] = cvtpk(s0[8 * s + 2], s0[8 * s + 3]); pw[2] = cvtpk(s0[8 * s + 4], s0[8 * s + 5]); pw[3] = cvtpk(s0[8 * s + 6], s0[8 * s + 7]);
                        const bf16x8 pf = __builtin_bit_cast(bf16x8, pw);
                        const bf16_t* va = Vt + r * VSTR + 16 * s + 4 * h;
                        const s16x4 a0 = *(const s16x4*)(va), a1 = *(const s16x4*)(va + 8), b0 = *(const s16x4*)(va + 32 * VSTR), b1 = *(const s16x4*)(va + 32 * VSTR + 8);
                        o0 = __builtin_amdgcn_mfma_f32_32x32x16_bf16(__builtin_shufflevector(a0, a1, 0, 1, 2, 3, 4, 5, 6, 7), pf, o0, 0, 0, 0);
                        o1 = __builtin_amdgcn_mfma_f32_32x32x16_bf16(__builtin_shufflevector(b0, b1, 0, 1, 2, 3, 4, 5, 6, 7), pf, o1, 0, 0, 0);
                    }
                }
                if (need1) {
#pragma unroll
                    for (int s = 0; s < 2; ++s) {
                        u32x4 pw; pw[0] = cvtpk(s1[8 * s], s1[8 * s + 1]); pw[1] = cvtpk(s1[8 * s + 2], s1[8 * s + 3]); pw[2] = cvtpk(s1[8 * s + 4], s1[8 * s + 5]); pw[3] = cvtpk(s1[8 * s + 6], s1[8 * s + 7]);
                        const bf16x8 pf = __builtin_bit_cast(bf16x8, pw);
                        const bf16_t* va = Vt + r * VSTR + 32 + 16 * s + 4 * h;
                        const s16x4 a0 = *(const s16x4*)(va), a1 = *(const s16x4*)(va + 8), b0 = *(const s16x4*)(va + 32 * VSTR), b1 = *(const s16x4*)(va + 32 * VSTR + 8);
                        o0 = __builtin_amdgcn_mfma_f32_32x32x16_bf16(__builtin_shufflevector(a0, a1, 0, 1, 2, 3, 4, 5, 6, 7), pf, o0, 0, 0, 0);
                        o1 = __builtin_amdgcn_mfma_f32_32x32x16_bf16(__builtin_shufflevector(b0, b1, 0, 1, 2, 3, 4, 5, 6, 7), pf, o1, 0, 0, 0);
                    }
                }
            }
        }
        const float lt = xhalf_sum(lsum), inv = 1.0f / lt;
        const size_t tq = tok0 + (size_t)dil * myq;
        float* op = p.dob + ((size_t)pat * NT + tq) * 256 + hd * 64 + 4 * h;
#pragma unroll
        for (int g = 0; g < 4; ++g) {
            *(f32x4*)(op + 8 * g) = (f32x4){o0[4 * g] * inv, o0[4 * g + 1] * inv, o0[4 * g + 2] * inv, o0[4 * g + 3] * inv};
            *(f32x4*)(op + 32 + 8 * g) = (f32x4){o1[4 * g] * inv, o1[4 * g + 1] * inv, o1[4 * g + 2] * inv, o1[4 * g + 3] * inv};
        }
        if (h == 0) p.dlse[((size_t)pat * NT + tq) * 4 + hd] = m + __builtin_amdgcn_logf(lt);
        __syncthreads();
    }
}

__device__ __forceinline__ void ph_rwkv_prep(const Params& pkv, KPtr kp_in, int wbase_in, int l, char* lds) {
    PH_HEAD
    float* lw = (float*)lds;
    float* la = lw + 16 * 64;
    float* lg = la + 16 * 64;
    float* lv = lg + 16 * 128;
    const int tid = TID, c = tid & 255, half = tid >> 8;
    const float* mu = p.rwkv_mu + l * 1024;
    const float* w_up = p.rwkv_w_up + (size_t)l * 64 * 256; const float* a_up = p.rwkv_a_up + (size_t)l * 64 * 256; const float* g_up = p.rwkv_g_up + (size_t)l * 128 * 256;
    const float* v_up = p.rwkv_v_up + (size_t)(l > 0 ? l - 1 : 0) * 32 * 256;
    const float* vmu = p.vres_mu + (l > 0 ? l - 1 : 0) * 32;
    for (int tb = BID * 16; tb < NT; tb += gridDim.x * 16) {
        __syncthreads();
        for (int e = tid; e < 16 * 288; e += NTHREADS) {
            const int tt = e / 288, j = e % 288, t = tb + tt;
            const bool first = (t % SEQ) == 0;
            const bf16_t* pr = p.pbuf + (size_t)t * NINP;
            int col; float m;
            if (j < 256) { col = PC_CWD + j; m = mu[768 + j]; } else { col = PC_VRES + (j - 256); m = vmu[j - 256]; }
            const float cur = bf2f(pr[col]), prev = first ? 0.f : bf2f(pr[col - NINP]);
            const float xs = cur + (prev - cur) * m;
            if (j < 64) lw[tt * 64 + j] = tanhf(xs);
            else if (j < 128) la[tt * 64 + (j - 64)] = xs;
            else if (j < 256) lg[tt * 128 + (j - 128)] = sigmoidf_(xs);
            else lv[tt * 32 + (j - 256)] = xs;
        }
        __syncthreads();
        float aw[8], aa[8], ag[8], av[8];
#pragma unroll
        for (int i = 0; i < 8; ++i) { aw[i] = 0.f; aa[i] = 0.f; ag[i] = 0.f; av[i] = 0.f; }
        for (int m = 0; m < 64; ++m) {
            const float ww = w_up[m * 256 + c], wa = a_up[m * 256 + c];
#pragma unroll
            for (int i = 0; i < 8; ++i) { aw[i] += lw[(half * 8 + i) * 64 + m] * ww; aa[i] += la[(half * 8 + i) * 64 + m] * wa; }
        }
        for (int m = 0; m < 128; ++m) {
            const float wg = g_up[m * 256 + c];
#pragma unroll
            for (int i = 0; i < 8; ++i) ag[i] += lg[(half * 8 + i) * 128 + m] * wg;
        }
        if (l > 0) for (int m = 0; m < 32; ++m) {
            const float wv = v_up[m * 256 + c];
#pragma unroll
            for (int i = 0; i < 8; ++i) av[i] += lv[(half * 8 + i) * 32 + m] * wv;
        }
        const float w0 = p.rwkv_w0[l * 256 + c], a0 = p.rwkv_a0[l * 256 + c], kkc = p.rwkv_k_k[l * 256 + c], kac = p.rwkv_k_a[l * 256 + c];
        const float v0 = p.rwkv_v0[(l > 0 ? l - 1 : 0) * 256 + c];
        const float mr = mu[c], mk = mu[256 + c], mv = mu[512 + c];
#pragma unroll
        for (int i = 0; i < 8; ++i) {
            const int t = tb + half * 8 + i; const bool first = (t % SEQ) == 0;
            const bf16_t* pr = p.pbuf + (size_t)t * NINP;
            float r = bf2f(pr[PC_CR + c]), k = bf2f(pr[PC_CK + c]), v = bf2f(pr[PC_CV + c]);
            const float rp = first ? 0.f : bf2f(pr[PC_CR + c - NINP]), kp = first ? 0.f : bf2f(pr[PC_CK + c - NINP]), vp = first ? 0.f : bf2f(pr[PC_CV + c - NINP]);
            r = r + (rp - r) * mr; k = k + (kp - k) * mk; v = v + (vp - v) * mv;
            const float wpre = w0 + aw[i];
            const float sp = (-wpre > 20.f) ? -wpre : log1pf(__expf(-wpre));
            const float w = -sp - 0.5f;
            const float decay = __expf(-__expf(w));
            const float a = sigmoidf_(a0 + aa[i]);
            const float kkr = k * kkc;
            const float ss = wave_sum(kkr * kkr);
            const float kk = kkr / fmaxf(sqrtf(ss), 1e-12f);
            const float k2 = k * (1.0f + (a - 1.0f) * kac);
            const size_t o = (size_t)t * 256 + c;
            if (l == 0) p.vfirst[o] = v;
            else v = v + (p.vfirst[o] - v) * sigmoidf_(v0 + av[i]);
            p.sr[o] = r; p.sw[o] = decay; p.sk[o] = k2; p.sv[o] = v; p.sa[o] = -kk; p.sb[o] = kk * a; p.sg[o] = ag[i];
        }
    }
}

#define PIN(x) asm volatile("" : "+v"(x))
constexpr int SCAN_BLOCKS = 64, SCAN_CH = 32, SCAN_STEP_F = 336;
__device__ __forceinline__ void ph_rwkv_scan(const Params& pkv, KPtr kp_in, int wbase_in, int l, char* lds) {
    PH_HEAD
    if (BID >= SCAN_BLOCKS) return;
    float* buf = (float*)lds;
    float* ybuf = buf + 2 * SCAN_CH * SCAN_STEP_F;
    const int tid = TID, lane = tid & 63, wv = tid >> 6;
    const int bh = BID >> 2, b = bh >> 2, hd = bh & 3, ibase = (BID & 3) * 16;
    const size_t tokbase = (size_t)b * SEQ;
    if (wv >= 4) {
        const int lt = tid - 256, lw = wv - 4;
        const int ar = lane >> 4, col4 = lane & 15, l2 = lane < 19 ? lane : 19;
        const float* base1 = ((ar == 0) ? p.sa : (ar == 1) ? p.sw : (ar == 2) ? p.sb : p.sk) + tokbase * 256 + hd * 64 + col4 * 4;
        const float* base2 = ((l2 < 16) ? (p.sr + hd * 64 + l2 * 4) : (p.sv + hd * 64 + ibase + (l2 - 16) * 4)) + tokbase * 256;
        const int d1 = lane * 4, d2 = 256 + l2 * 4;
        f32x4 a1[8], a2[8], b1[8], b2[8];
#define SCAN_ISSUE(c, r1, r2) do { _Pragma("unroll") for (int i = 0; i < 8; ++i) { const size_t so = (size_t)((c) * SCAN_CH + lw + 4 * i) * 256; r1[i] = *(const f32x4*)(base1 + so); r2[i] = *(const f32x4*)(base2 + so); } } while (0)
#define SCAN_COMMIT(c, r1, r2) do { float* dst_ = buf + (size_t)((c) & 1) * SCAN_CH * SCAN_STEP_F; _Pragma("unroll") for (int i = 0; i < 8; ++i) { float* ds_ = dst_ + (lw + 4 * i) * SCAN_STEP_F; *(f32x4*)(ds_ + d1) = r1[i]; *(f32x4*)(ds_ + d2) = r2[i]; } } while (0)
        auto yflush = [&](int c) {
            const float* yb = ybuf + (size_t)(c & 1) * SCAN_CH * 64;
#pragma unroll
            for (int i = 0; i < 2; ++i) {
                const int st = (lt >> 4) + 16 * i, rw = lt & 15;
                const f32x4 q = *(const f32x4*)(yb + st * 64 + rw * 4);
                p.sy[(tokbase + (size_t)c * SCAN_CH + st) * 256 + hd * 64 + ibase + rw] = (q[0] + q[1]) + (q[2] + q[3]);
            }
        };
        constexpr int NC = SEQ / SCAN_CH;
        SCAN_ISSUE(0, a1, a2); SCAN_COMMIT(0, a1, a2); SCAN_ISSUE(1, b1, b2); SCAN_ISSUE(2, a1, a2);
        __syncthreads();
        for (int c = 0; c < NC; c += 2) {
            SCAN_COMMIT(c + 1, b1, b2); if (c + 3 < NC) SCAN_ISSUE(c + 3, b1, b2);
            if (c > 0) yflush(c - 1);
            __syncthreads();
            if (c + 2 < NC) { SCAN_COMMIT(c + 2, a1, a2); } if (c + 4 < NC) SCAN_ISSUE(c + 4, a1, a2);
            yflush(c);
            __syncthreads();
        }
        yflush(NC - 1);
    } else {
        const int rr = lane >> 4, c4 = (lane & 15) * 4;
        float s0 = 0.f, s1 = 0.f, s2 = 0.f, s3 = 0.f;
        float* ypart = ybuf + wv * 16 + rr * 4 + (lane & 3);
        __syncthreads();
        for (int c = 0; c < SEQ / SCAN_CH; ++c) {
            const float* cb = buf + (size_t)(c & 1) * SCAN_CH * SCAN_STEP_F;
            float* yp = ypart + (size_t)(c & 1) * SCAN_CH * 64;
            f32x4 a = *(const f32x4*)(cb + c4), w = *(const f32x4*)(cb + 64 + c4), bb = *(const f32x4*)(cb + 128 + c4), k = *(const f32x4*)(cb + 192 + c4), r = *(const f32x4*)(cb + 256 + c4);
            float v = cb[320 + wv * 4 + rr];
#pragma unroll 4
            for (int st = 0; st < SCAN_CH; ++st) {
                const float* nb = cb + (st + 1 < SCAN_CH ? st + 1 : st) * SCAN_STEP_F;
                const f32x4 na = *(const f32x4*)(nb + c4), nw = *(const f32x4*)(nb + 64 + c4), nbb = *(const f32x4*)(nb + 128 + c4), nk = *(const f32x4*)(nb + 192 + c4), nr = *(const f32x4*)(nb + 256 + c4);
                const float nv = nb[320 + wv * 4 + rr];
                float p0 = s0 * a[0], p1 = s2 * a[2];
                PIN(p0); PIN(p1);
                p0 = __builtin_fmaf(s1, a[1], p0); p1 = __builtin_fmaf(s3, a[3], p1);
                PIN(p0); PIN(p1);
                const float sa = grp16_sum(p0 + p1);
                float t0 = k[0] * v, t1 = k[1] * v, t2 = k[2] * v, t3 = k[3] * v;
                PIN(t0); PIN(t1); PIN(t2); PIN(t3);
                t0 = __builtin_fmaf(s0, w[0], t0); t1 = __builtin_fmaf(s1, w[1], t1); t2 = __builtin_fmaf(s2, w[2], t2); t3 = __builtin_fmaf(s3, w[3], t3);
                PIN(t0); PIN(t1); PIN(t2); PIN(t3);
                s0 = __builtin_fmaf(bb[0], sa, t0); s1 = __builtin_fmaf(bb[1], sa, t1); s2 = __builtin_fmaf(bb[2], sa, t2); s3 = __builtin_fmaf(bb[3], sa, t3);
                PIN(s0); PIN(s1); PIN(s2); PIN(s3);
                float q0 = s0 * r[0], q1 = s2 * r[2];
                PIN(q0); PIN(q1);
                q0 = __builtin_fmaf(s1, r[1], q0); q1 = __builtin_fmaf(s3, r[3], q1);
                PIN(q0); PIN(q1);
                float y = q0 + q1;
                y += dpp_f<0x128>(y); y += dpp_f<0x124>(y);
                yp[st * 64] = y;
                a = na; w = nw; bb = nbb; k = nk; r = nr; v = nv;
                __builtin_amdgcn_sched_barrier(0);
            }
            __syncthreads();
        }
    }
}

__device__ __forceinline__ void ph_mla_up(const Params& pkv, KPtr kp_in, int wbase_in, int l, char* lds) {
    PH_HEAD
    const int nq = (NT / 128) * 3, nkv = (NT / 128) * 4;
    for (int u = BID; u < nq + nkv; u += gridDim.x) {
        if (u < nq) {
            const int mt = u / 3, nt = u % 3;
            float* out = p.qu + (size_t)mt * 128 * 384 + nt * 128; const float* rs = p.rsq + mt * 128;
            gemm_tile128(p.pbuf + (size_t)mt * 128 * NINP + PC_MQ, NINP, nullptr, 128, p.wq_t + ((size_t)l * 384 + nt * 128) * 256, 256, 256, lds, TID,
                         [=](int r, int c, f32x4 v) mutable { const float s = rs[r]; *(f32x4*)(out + (size_t)r * 384 + c) = v * s; });
        } else {
            const int uu = u - nq, mt = uu / 4, nt = uu % 4;
            float* out = p.kvu + (size_t)mt * 128 * 512 + nt * 128; const float* rs = p.rskv + mt * 128;
            gemm_tile128(p.pbuf + (size_t)mt * 128 * NINP + PC_MKV, NINP, nullptr, 128, p.wkv_t + ((size_t)l * 512 + nt * 128) * 128, 128, 128, lds, TID,
                         [=](int r, int c, f32x4 v) mutable { const float s = rs[r]; *(f32x4*)(out + (size_t)r * 512 + c) = v * s; });
        }
    }
}

__device__ __forceinline__ void ph_mla_pack(const Params& pkv, KPtr kp_in, int wbase_in, int l) {
    PH_HEAD
    const int lane = TID & 63, gw = BID * (NTHREADS / 64) + (TID >> 6), nw = gridDim.x * (NTHREADS / 64);
    const float SC = 0.10206207261596575f * 1.4426950408889634f;
    for (int t = gw; t < NT; t += nw) {
        const int pos = t % SEQ;
        const float* qp = p.qu + (size_t)t * 384; const float* kvp = p.kvu + (size_t)t * 512; const float* kp2 = p.kpe + (size_t)t * 32;
        bf16_t* mq = p.mq + (size_t)t * 384; bf16_t* mk = p.mk + (size_t)t * 384; bf16_t* mv = p.mv + (size_t)t * 256;
        for (int e = lane; e < 384; e += 64) {
            const int hd = e / 96, d = e % 96;
            float qv, kv;
            if (d < 64) { qv = qp[e]; kv = kvp[hd * 128 + d]; }
            else {
                const int i = (d - 64) & 15; const float c = p.tab_mla[(pos * 16 + i) * 2], sn = p.tab_mla[(pos * 16 + i) * 2 + 1];
                const float x1 = qp[hd * 96 + 64 + i], x2 = qp[hd * 96 + 80 + i];
                qv = (d < 80) ? (x1 * c - x2 * sn) : (x1 * sn + x2 * c);
                kv = kp2[d - 64];
            }
            mq[e] = f2bf(qv * SC); mk[e] = f2bf(kv);
        }
        for (int e = lane; e < 256; e += 64) mv[e] = f2bf(kvp[(e >> 6) * 128 + 64 + (e & 63)]);
    }
}

__device__ __forceinline__ void ph_mla_attn(const Params& pkv, KPtr kp_in, int wbase_in, int l, char* lds) {
    PH_HEAD
    constexpr int KSTR = 104, VSTR = 68;
    bf16_t* Ks = (bf16_t*)lds;
    bf16_t* Vt = Ks + 64 * KSTR;
    const int tid = TID, lane = tid & 63, wv = tid >> 6, r = lane & 31, h = lane >> 5;
    int* wq = p.wq + l * 16;
    volatile int* wslot = (volatile int*)(lds + 24576);
    for (;;) {
        __syncthreads();
        if (tid == 0) *wslot = atomicAdd(wq, 1);
        __syncthreads();
        const int it = __builtin_amdgcn_readfirstlane(*wslot);
        if (it >= 16 * 32) break;
        const int bh = it & 15, qb = 31 - (it >> 4);
        const int b = bh >> 2, hd = bh & 3, q0 = qb * 256;
        const int qmin = q0 + 32 * wv, qmax = qmin + 31, myq = qmin + r;
        bf16x8 qf[6];
        {
            const bf16_t* qrow = p.mq + ((size_t)(b * SEQ + myq) * 4 + hd) * 96 + 8 * h;
#pragma unroll
            for (int s = 0; s < 6; ++s) qf[s] = *(const bf16x8*)(qrow + 16 * s);
        }
        f32x16 o0, o1;
#pragma unroll
        for (int i = 0; i < 16; ++i) { o0[i] = 0.f; o1[i] = 0.f; }
        float m = -1e30f, lsum = 0.f;
        const int nkt = (q0 + 256) / 64;
        const int kk0 = tid / 12, kc0 = tid % 12, kk1 = (tid + 512) / 12, kc1 = (tid + 512) % 12;
        const int vk = tid & 63, vc = tid >> 6;
        const bf16_t* kbase = p.mk + ((size_t)b * SEQ * 4 + hd) * 96;
        const bf16_t* vbase = p.mv + ((size_t)b * SEQ * 4 + hd) * 64;
        u32x4 rk0, rk1, rv;
        rk0 = *(const u32x4*)(kbase + (size_t)kk0 * 384 + kc0 * 8);
        rk1 = (tid < 256) ? *(const u32x4*)(kbase + (size_t)kk1 * 384 + kc1 * 8) : (u32x4){0u, 0u, 0u, 0u};
        rv = *(const u32x4*)(vbase + (size_t)vk * 256 + vc * 8);
        for (int kt = 0; kt < nkt; ++kt) {
            __syncthreads();
            *(u32x4*)(Ks + kk0 * KSTR + kc0 * 8) = rk0;
            if (tid < 256) *(u32x4*)(Ks + kk1 * KSTR + kc1 * 8) = rk1;
            {
                const unsigned w0 = rv[0], w1 = rv[1], w2 = rv[2], w3 = rv[3];
                bf16_t* vd = Vt + (vc * 8) * VSTR + vk;
                vd[0] = (bf16_t)(w0 & 0xffff); vd[VSTR] = (bf16_t)(w0 >> 16); vd[2 * VSTR] = (bf16_t)(w1 & 0xffff); vd[3 * VSTR] = (bf16_t)(w1 >> 16);
                vd[4 * VSTR] = (bf16_t)(w2 & 0xffff); vd[5 * VSTR] = (bf16_t)(w2 >> 16); vd[6 * VSTR] = (bf16_t)(w3 & 0xffff); vd[7 * VSTR] = (bf16_t)(w3 >> 16);
            }
            __syncthreads();
            if (kt + 1 < nkt) {
                const size_t ko = (size_t)(kt + 1) * 64;
                rk0 = *(const u32x4*)(kbase + (ko + kk0) * 384 + kc0 * 8);
                if (tid < 256) rk1 = *(const u32x4*)(kbase + (ko + kk1) * 384 + kc1 * 8);
                rv = *(const u32x4*)(vbase + (ko + vk) * 256 + vc * 8);
            }
            const int kb = kt * 64;
            if (kb <= qmax) {
                const bool need1 = (kb + 32 <= qmax);
                f32x16 s0, s1;
#pragma unroll
                for (int i = 0; i < 16; ++i) { s0[i] = 0.f; s1[i] = -1e30f; }
#pragma unroll
                for (int s = 0; s < 6; ++s) { const bf16x8 kf = *(const bf16x8*)(Ks + r * KSTR + 16 * s + 8 * h); s0 = __builtin_amdgcn_mfma_f32_32x32x16_bf16(kf, qf[s], s0, 0, 0, 0); }
                if (need1) {
#pragma unroll
                    for (int i = 0; i < 16; ++i) s1[i] = 0.f;
#pragma unroll
                    for (int s = 0; s < 6; ++s) { const bf16x8 kf = *(const bf16x8*)(Ks + (32 + r) * KSTR + 16 * s + 8 * h); s1 = __builtin_amdgcn_mfma_f32_32x32x16_bf16(kf, qf[s], s1, 0, 0, 0); }
                }
                if (kb + 63 > qmin) {
#pragma unroll
                    for (int i = 0; i < 16; ++i) {
                        const int key = kb + (i & 3) + 8 * (i >> 2) + 4 * h;
                        if (key > myq) s0[i] = -1e30f;
                        if (key + 32 > myq) s1[i] = -1e30f;
                    }
                }
                float mx = s0[0];
#pragma unroll
                for (int i = 1; i < 16; ++i) mx = fmaxf(mx, s0[i]);
#pragma unroll
                for (int i = 0; i < 16; ++i) mx = fmaxf(mx, s1[i]);
                mx = xhalf_max(mx);
                const float mn = fmaxf(m, mx), alpha = __builtin_amdgcn_exp2f(m - mn);
                m = mn;
                float ps = 0.f;
#pragma unroll
                for (int i = 0; i < 16; ++i) { s0[i] = __builtin_amdgcn_exp2f(s0[i] - mn); ps += s0[i]; }
                if (need1) {
#pragma unroll
                    for (int i = 0; i < 16; ++i) { s1[i] = __builtin_amdgcn_exp2f(s1[i] - mn); ps += s1[i]; }
                }
                lsum = lsum * alpha + ps;
                if (!__all(alpha == 1.0f)) {
#pragma unroll
                    for (int i = 0; i < 16; ++i) { o0[i] *= alpha; o1[i] *= alpha; }
                }
#pragma unroll
                for (int s = 0; s < 2; ++s) {
                    u32x4 pw; pw[0] = cvtpk(s0[8 * s], s0[8 * s + 1]); pw[1] = cvtpk(s0[8 * s + 2], s0[8 * s + 3]); pw[2] = cvtpk(s0[8 * s + 4], s0[8 * s + 5]); pw[3] = cvtpk(s0[8 * s + 6], s0[8 * s + 7]);
                    const bf16x8 pf = __builtin_bit_cast(bf16x8, pw);
                    const bf16_t* va = Vt + r * VSTR + 16 * s + 4 * h;
                    const s16x4 a0 = *(const s16x4*)(va), a1 = *(const s16x4*)(va + 8), b0 = *(const s16x4*)(va + 32 * VSTR), b1 = *(const s16x4*)(va + 32 * VSTR + 8);
                    o0 = __builtin_amdgcn_mfma_f32_32x32x16_bf16(__builtin_shufflevector(a0, a1, 0, 1, 2, 3, 4, 5, 6, 7), pf, o0, 0, 0, 0);
                    o1 = __builtin_amdgcn_mfma_f32_32x32x16_bf16(__builtin_shufflevector(b0, b1, 0, 1, 2, 3, 4, 5, 6, 7), pf, o1, 0, 0, 0);
                }
                if (need1) {
#pragma unroll
                    for (int s = 0; s < 2; ++s) {
                        u32x4 pw; pw[0] = cvtpk(s1[8 * s], s1[8 * s + 1]); pw[1] = cvtpk(s1[8 * s + 2], s1[8 * s + 3]); pw[2] = cvtpk(s1[8 * s + 4], s1[8 * s + 5]); pw[3] = cvtpk(s1[8 * s + 6], s1[8 * s + 7]);
                        const bf16x8 pf = __builtin_bit_cast(bf16x8, pw);
                        const bf16_t* va = Vt + r * VSTR + 32 + 16 * s + 4 * h;
                        const s16x4 a0 = *(const s16x4*)(va), a1 = *(const s16x4*)(va + 8), b0 = *(const s16x4*)(va + 32 * VSTR), b1 = *(const s16x4*)(va + 32 * VSTR + 8);
                        o0 = __builtin_amdgcn_mfma_f32_32x32x16_bf16(__builtin_shufflevector(a0, a1, 0, 1, 2, 3, 4, 5, 6, 7), pf, o0, 0, 0, 0);
                        o1 = __builtin_amdgcn_mfma_f32_32x32x16_bf16(__builtin_shufflevector(b0, b1, 0, 1, 2, 3, 4, 5, 6, 7), pf, o1, 0, 0, 0);
                    }
                }
            }
        }
        const float inv = 1.0f / xhalf_sum(lsum);
        float* op = p.mo + (size_t)(b * SEQ + myq) * 256 + hd * 64 + 4 * h;
#pragma unroll
        for (int g = 0; g < 4; ++g) {
            *(f32x4*)(op + 8 * g) = (f32x4){o0[4 * g] * inv, o0[4 * g + 1] * inv, o0[4 * g + 2] * inv, o0[4 * g + 3] * inv};
            *(f32x4*)(op + 32 + 8 * g) = (f32x4){o1[4 * g] * inv, o1[4 * g + 1] * inv, o1[4 * g + 2] * inv, o1[4 * g + 3] * inv};
        }
        __syncthreads();
    }
}

__device__ __forceinline__ void ph_finalize_mix(const Params& pkv, KPtr kp_in, int wbase_in, int l) {
    PH_HEAD
    const int lane = TID & 63, gw = BID * (NTHREADS / 64) + (TID >> 6), nw = gridDim.x * (NTHREADS / 64);
    const int c = lane * 4, h = lane >> 4;
    for (int t = gw; t < NT; t += nw) {
        bf16_t* outp = p.mixcat + (size_t)t * 1024;
        {
            const float l0 = p.dlse[((size_t)0 * NT + t) * 4 + h], l1 = p.dlse[((size_t)1 * NT + t) * 4 + h], l2 = p.dlse[((size_t)2 * NT + t) * 4 + h];
            const float lm = fmaxf(l0, fmaxf(l1, l2));
            float w0 = __builtin_amdgcn_exp2f(l0 - lm), w1 = __builtin_amdgcn_exp2f(l1 - lm), w2 = __builtin_amdgcn_exp2f(l2 - lm);
            const float wi = 1.0f / (w0 + w1 + w2); w0 *= wi; w1 *= wi; w2 *= wi;
            const float4 v0 = *(const float4*)(p.dob + ((size_t)0 * NT + t) * 256 + c), v1 = *(const float4*)(p.dob + ((size_t)1 * NT + t) * 256 + c), v2 = *(const float4*)(p.dob + ((size_t)2 * NT + t) * 256 + c);
            float4 v; v.x = w0 * v0.x + w1 * v1.x + w2 * v2.x; v.y = w0 * v0.y + w1 * v1.y + w2 * v2.y; v.z = w0 * v0.z + w1 * v1.z + w2 * v2.z; v.w = w0 * v0.w + w1 * v1.w + w2 * v2.w;
            const float ss = wave_sum(v.x * v.x + v.y * v.y + v.z * v.z + v.w * v.w);
            const float rs = rsqrtf(ss * (1.0f / 256.0f) + 1e-6f);
            const float4 g = *(const float4*)(p.dil_norm_g + l * 256 + c);
            ushort4 o; o.x = f2bf(v.x * rs * g.x); o.y = f2bf(v.y * rs * g.y); o.z = f2bf(v.z * rs * g.z); o.w = f2bf(v.w * rs * g.w);
            *(ushort4*)(outp + 256 + c) = o;
        }
        {
            const size_t o4 = (size_t)t * 256 + c;
            const float4 y = *(const float4*)(p.sy + o4), r = *(const float4*)(p.sr + o4), k = *(const float4*)(p.sk + o4), v = *(const float4*)(p.sv + o4), g = *(const float4*)(p.sg + o4);
            const float mean = grp16_sum(y.x + y.y + y.z + y.w) * (1.0f / 64.0f);
            const float dx = y.x - mean, dy = y.y - mean, dz = y.z - mean, dw = y.w - mean;
            const float var = grp16_sum(dx * dx + dy * dy + dz * dz + dw * dw) * (1.0f / 64.0f);
            const float rs = rsqrtf(var + 64e-5f);
            const float4 lg = *(const float4*)(p.rwkv_ln_g + l * 256 + c), lb = *(const float4*)(p.rwkv_ln_b + l * 256 + c), rk = *(const float4*)(p.rwkv_r_k + l * 256 + c);
            const float bonus = grp16_sum(r.x * k.x * rk.x + r.y * k.y * rk.y + r.z * k.z * rk.z + r.w * k.w * rk.w);
            ushort4 o;
            o.x = f2bf((dx * rs * lg.x + lb.x + bonus * v.x) * g.x); o.y = f2bf((dy * rs * lg.y + lb.y + bonus * v.y) * g.y);
            o.z = f2bf((dz * rs * lg.z + lb.z + bonus * v.z) * g.z); o.w = f2bf((dw * rs * lg.w + lb.w + bonus * v.w) * g.w);
            *(ushort4*)(outp + 512 + c) = o;
        }
        {
            const float4 v = *(const float4*)(p.mo + (size_t)t * 256 + c);
            const float ss = wave_sum(v.x * v.x + v.y * v.y + v.z * v.z + v.w * v.w);
            const float rs = rsqrtf(ss * (1.0f / 256.0f) + 1e-6f);
            const float4 g = *(const float4*)(p.mla_out_norm_g + l * 256 + c);
            ushort4 o; o.x = f2bf(v.x * rs * g.x); o.y = f2bf(v.y * rs * g.y); o.z = f2bf(v.z * rs * g.z); o.w = f2bf(v.w * rs * g.w);
            *(ushort4*)(outp + 768 + c) = o;
        }
    }
    (void)h;
}

__device__ __forceinline__ void ph_outproj(const Params& pkv, KPtr kp_in, int wbase_in, int l, char* lds) {
    PH_HEAD
    const float* xin = (l == 0) ? p.x : p.xf; float* y1 = p.y1;
    const bf16_t* Bt = p.wout_t + (size_t)l * 1024 * 1024;
    for (int u = BID; u < (NT / 256) * 4; u += gridDim.x) {
        const int mt = u >> 2, nt = u & 3;
        const size_t o0 = (size_t)mt * 256 * 1024 + nt * 256;
        gemm_tile256(p.mixcat + (size_t)mt * 256 * 1024, 1024, nullptr, 256, Bt + (size_t)nt * 256 * 1024, 1024, 1024, lds, wbase_in,
                     [=](int r, int c, f32x4 v) mutable { const size_t o = o0 + (size_t)r * 1024 + c; const f32x4 xv = *(const f32x4*)(xin + o); *(f32x4*)(y1 + o) = xv * ALPHA + v; });
    }
}

__device__ __forceinline__ void ph_ln1_router(const Params& pkv, KPtr kp_in, int wbase_in, int l, char* lds) {
    PH_HEAD
    int* hist = (int*)lds;
    int* base = hist + 32;
    int* le = base + 32;
    float* lgt = (float*)(le + 512);
    int* lrank = (int*)(lgt + 512);
    const int tid = TID, lane = tid & 63, wv = tid >> 6;
    const float* g1 = p.ln1_g + l * 1024; const float* b1 = p.ln1_b + l * 1024;
    const float* rw = p.router_w + (size_t)l * 1024 * 32; const float* rb = p.router_b + l * 32;
    for (int tb = BID * 128; tb < NT; tb += gridDim.x * 128) {
        __syncthreads();
        if (tid < 32) hist[tid] = 0;
        __syncthreads();
        for (int tt = wv; tt < 128; tt += 8) {
            const int t = tb + tt;
            float4 y[4]; float s = 0.f;
#pragma unroll
            for (int m = 0; m < 4; ++m) { y[m] = *(const float4*)(p.y1 + (size_t)t * 1024 + m * 256 + lane * 4); s += y[m].x + y[m].y + y[m].z + y[m].w; }
            const float mean = wave_sum(s) * (1.0f / 1024.0f);
            float q = 0.f;
#pragma unroll
            for (int m = 0; m < 4; ++m) { y[m].x -= mean; y[m].y -= mean; y[m].z -= mean; y[m].w -= mean; q += y[m].x * y[m].x + y[m].y * y[m].y + y[m].z * y[m].z + y[m].w * y[m].w; }
            const float rs = rsqrtf(wave_sum(q) * (1.0f / 1024.0f) + 1e-5f);
            float lg[32];
#pragma unroll
            for (int e = 0; e < 32; ++e) lg[e] = 0.f;
#pragma unroll 1
            for (int m = 0; m < 4; ++m) {
                const int c = m * 256 + lane * 4;
                const float4 g = *(const float4*)(g1 + c), bb = *(const float4*)(b1 + c);
                const float4 yv = *(const float4*)(p.y1 + (size_t)t * 1024 + c);
                float4 xv; xv.x = (yv.x - mean) * rs * g.x + bb.x; xv.y = (yv.y - mean) * rs * g.y + bb.y; xv.z = (yv.z - mean) * rs * g.z + bb.z; xv.w = (yv.w - mean) * rs * g.w + bb.w;
                *(float4*)(p.y1 + (size_t)t * 1024 + c) = xv;
                ushort4 ob; ob.x = f2bf(xv.x); ob.y = f2bf(xv.y); ob.z = f2bf(xv.z); ob.w = f2bf(xv.w);
                *(ushort4*)(p.x1b + (size_t)t * 1024 + c) = ob;
                const float xs[4] = {xv.x, xv.y, xv.z, xv.w};
#pragma unroll
                for (int i = 0; i < 4; ++i) {
                    const float4* wr = (const float4*)(rw + (size_t)(c + i) * 32);
#pragma unroll
                    for (int e4 = 0; e4 < 8; ++e4) { const float4 w = wr[e4]; lg[e4 * 4] += xs[i] * w.x; lg[e4 * 4 + 1] += xs[i] * w.y; lg[e4 * 4 + 2] += xs[i] * w.z; lg[e4 * 4 + 3] += xs[i] * w.w; }
                }
            }
#pragma unroll
            for (int e = 0; e < 32; ++e) lg[e] = wave_sum(lg[e]) + rb[e];
            int idx[4]; float val[4];
#pragma unroll
            for (int k = 0; k < 4; ++k) {
                float bv = -3.0e38f; int bi = 0;
#pragma unroll
                for (int e = 0; e < 32; ++e) { if (lg[e] > bv) { bv = lg[e]; bi = e; } }
                idx[k] = bi; val[k] = bv;
#pragma unroll
                for (int e = 0; e < 32; ++e) if (e == bi) lg[e] = -3.0e38f;
            }
            const float e1 = __expf(val[1] - val[0]), e2 = __expf(val[2] - val[0]), e3 = __expf(val[3] - val[0]);
            const float inv = 1.0f / (1.0f + e1 + e2 + e3);
            const float gt[4] = {inv, e1 * inv, e2 * inv, e3 * inv};
            if (lane < 4) {
                int ee = idx[0]; float gg = gt[0];
                if (lane == 1) { ee = idx[1]; gg = gt[1]; } else if (lane == 2) { ee = idx[2]; gg = gt[2]; } else if (lane == 3) { ee = idx[3]; gg = gt[3]; }
                le[tt * 4 + lane] = ee; lgt[tt * 4 + lane] = gg;
                lrank[tt * 4 + lane] = atomicAdd(&hist[ee], 1);
            }
        }
        __syncthreads();
        if (tid < 32) base[tid] = atomicAdd(&p.cnt[l * NE + tid], hist[tid]);
        __syncthreads();
        {
            const int tt = tid >> 2, t = tb + tt, e = le[tid], pos = base[e] + lrank[tid];
            p.toke[(size_t)t * 4 + (tid & 3)] = e; p.tokpos[(size_t)t * 4 + (tid & 3)] = pos;
            p.rowtok[(size_t)e * NT + pos] = t; p.rowgate[(size_t)e * NT + pos] = lgt[tid];
        }
    }
}

__device__ __forceinline__ void moe_tile_prefix(KRef p, int l, int* tb  , const int TID) {
    __syncthreads();
    if (TID == 0) { int a = 0; for (int e = 0; e < NE; ++e) { tb[e] = a; a += (p.cnt[l * NE + e] + MOE_TM - 1) / MOE_TM; } tb[NE] = a; }
    __syncthreads();
}
__device__ __forceinline__ void ph_moe_gu(const Params& pkv, KPtr kp_in, int wbase_in, int l, char* lds) {
    PH_HEAD
    int* tb = (int*)(lds + 132096);
    moe_tile_prefix(p, l, tb, TID);
    const int ntile = __builtin_amdgcn_readfirstlane(tb[NE]), nunits = ntile * 8;
    for (int u = BID; u < nunits; u += gridDim.x) {
        const int mtg = u >> 3, nt = u & 7;
        int e = 0; while (tb[e + 1] <= mtg) ++e;
        e = __builtin_amdgcn_readfirstlane(e);
        const int mt = __builtin_amdgcn_readfirstlane(mtg - tb[e]), cnt = __builtin_amdgcn_readfirstlane(p.cnt[l * NE + e]), nvalid = min(MOE_TM, cnt - mt * MOE_TM);
        const float* bias = p.b_gu + ((size_t)l * NE + e) * 2048 + nt * 256;
        bf16_t* out = p.act + (size_t)mtg * MOE_TM * 1024 + nt * 128;
        gemm_tile256(p.x1b, 1024, p.rowtok + (size_t)e * NT + mt * MOE_TM, nvalid, p.wgu_t + (((size_t)l * NE + e) * 2048 + nt * 256) * 1024, 1024, 1024, lds, wbase_in,
                     [=](int r, int c, f32x4 v) mutable {
                         const f32x4 bv = *(const f32x4*)(bias + c); v = v + bv;
                         const float g0 = fminf(v[0], 7.0f), l0 = fminf(fmaxf(v[1], -7.0f), 7.0f), g1 = fminf(v[2], 7.0f), l1 = fminf(fmaxf(v[3], -7.0f), 7.0f);
                         const float a0 = g0 * sigmoidf_(1.702f * g0) * (l0 + 1.0f), a1 = g1 * sigmoidf_(1.702f * g1) * (l1 + 1.0f);
                         ushort2 o; o.x = f2bf(a0); o.y = f2bf(a1); *(ushort2*)(out + (size_t)r * 1024 + (c >> 1)) = o; });
    }
}
__device__ __forceinline__ void ph_moe_dn(const Params& pkv, KPtr kp_in, int wbase_in, int l, char* lds) {
    PH_HEAD
    int* tb = (int*)(lds + 132096);
    moe_tile_prefix(p, l, tb, TID);
    const int ntile = __builtin_amdgcn_readfirstlane(tb[NE]), nunits = ntile * 4;
    for (int u = BID; u < nunits; u += gridDim.x) {
        const int mtg = u >> 2, nt = u & 3;
        int e = 0; while (tb[e + 1] <= mtg) ++e;
        e = __builtin_amdgcn_readfirstlane(e);
        const int mt = __builtin_amdgcn_readfirstlane(mtg - tb[e]), cnt = __builtin_amdgcn_readfirstlane(p.cnt[l * NE + e]), nvalid = min(MOE_TM, cnt - mt * MOE_TM);
        const float* bias = p.b_dn + ((size_t)l * NE + e) * 1024 + nt * 256;
        const float* gate = p.rowgate + (size_t)e * NT + mt * MOE_TM;
        bf16_t* out = p.yb + (size_t)mtg * MOE_TM * 1024 + nt * 256;
        gemm_tile256(p.act + (size_t)mtg * MOE_TM * 1024, 1024, nullptr, 256, p.wdn_t + (((size_t)l * NE + e) * 1024 + nt * 256) * 1024, 1024, 1024, lds, wbase_in,
                     [=](int r, int c, f32x4 v) mutable {
                         const float g = (r < nvalid) ? gate[r] : 0.f;
                         const f32x4 bv = *(const f32x4*)(bias + c); v = (v + bv) * g;
                         ushort4 o; o.x = f2bf(v[0]); o.y = f2bf(v[1]); o.z = f2bf(v[2]); o.w = f2bf(v[3]); *(ushort4*)(out + (size_t)r * 1024 + c) = o; });
    }
}
__device__ __forceinline__ void ph_combine_ln2(const Params& pkv, KPtr kp_in, int wbase_in, int l, char* lds) {
    PH_HEAD
    int* tb = (int*)(lds + 132096);
    moe_tile_prefix(p, l, tb, TID);
    const int lane = TID & 63, gw = BID * (NTHREADS / 64) + (TID >> 6), nw = gridDim.x * (NTHREADS / 64);
    const float* g2 = p.ln2_g + l * 1024; const float* b2 = p.ln2_b + l * 1024;
    float* dstf = (l == DEPTH - 1) ? p.out : p.xf;
    for (int t = gw; t < NT; t += nw) {
        size_t rows[4];
#pragma unroll
        for (int k = 0; k < 4; ++k) { const int e = p.toke[(size_t)t * 4 + k], pos = p.tokpos[(size_t)t * 4 + k]; rows[k] = (size_t)tb[e] * MOE_TM + pos; }
        float4 y[4]; float s = 0.f;
#pragma unroll
        for (int m = 0; m < 4; ++m) {
            const int c = m * 256 + lane * 4;
            float4 v = *(const float4*)(p.y1 + (size_t)t * 1024 + c);
            v.x *= ALPHA; v.y *= ALPHA; v.z *= ALPHA; v.w *= ALPHA;
#pragma unroll
            for (int k = 0; k < 4; ++k) { const ushort4 yb = *(const ushort4*)(p.yb + rows[k] * 1024 + c); v.x += bf2f(yb.x); v.y += bf2f(yb.y); v.z += bf2f(yb.z); v.w += bf2f(yb.w); }
            y[m] = v; s += v.x + v.y + v.z + v.w;
        }
        const float mean = wave_sum(s) * (1.0f / 1024.0f);
        float q = 0.f;
#pragma unroll
        for (int m = 0; m < 4; ++m) { y[m].x -= mean; y[m].y -= mean; y[m].z -= mean; y[m].w -= mean; q += y[m].x * y[m].x + y[m].y * y[m].y + y[m].z * y[m].z + y[m].w * y[m].w; }
        const float rs = rsqrtf(wave_sum(q) * (1.0f / 1024.0f) + 1e-5f);
#pragma unroll
        for (int m = 0; m < 4; ++m) {
            const int c = m * 256 + lane * 4;
            const float4 g = *(const float4*)(g2 + c), bb = *(const float4*)(b2 + c);
            float4 xv; xv.x = y[m].x * rs * g.x + bb.x; xv.y = y[m].y * rs * g.y + bb.y; xv.z = y[m].z * rs * g.z + bb.z; xv.w = y[m].w * rs * g.w + bb.w;
            *(float4*)(dstf + (size_t)t * 1024 + c) = xv;
            ushort4 ob; ob.x = f2bf(xv.x); ob.y = f2bf(xv.y); ob.z = f2bf(xv.z); ob.w = f2bf(xv.w);
            *(ushort4*)(p.xb + (size_t)t * 1024 + c) = ob;
        }
    }
}

constexpr int PH_PRO = 0, PH_INPROJ = 1, PH_PREP = 2, PH_RETKV = 3, PH_RETSCAN = 4, PH_RETOUT = 5, PH_DIL = 6, PH_RWKVPREP = 7, PH_RWKVSCAN = 8, PH_MLAUP = 9,
              PH_MLAATTN = 10, PH_FINAL = 11, PH_OUTPROJ = 12, PH_LN1 = 13, PH_GU = 14, PH_DN = 15, PH_LN2 = 16;

#ifdef MULTI_LAUNCH
template <int ph>
__global__ void __launch_bounds__(NTHREADS, 2) mega(Params pk, int l) {
    extern __shared__ __attribute__((aligned(16))) char lds[];
    KPtr kp = (KPtr)__builtin_amdgcn_kernarg_segment_ptr();
    const int wbase = __builtin_amdgcn_readfirstlane(threadIdx.x) & ~63;
    if (ph == PH_PRO) ph_prologue(pk, kp, wbase, lds);
    if (ph == PH_INPROJ) ph_inproj(pk, kp, wbase, l, lds);
    if (ph == PH_PREP) ph_rope_prep(pk, kp, wbase, l);
    if (ph == PH_RETKV) ph_ret_kv(pk, kp, wbase, l, lds);
    if (ph == PH_RETSCAN) ph_ret_scan(pk, kp, wbase, l);
    if (ph == PH_RETOUT) ph_ret_out(pk, kp, wbase, l);
    if (ph == PH_DIL) ph_dil_attn(pk, kp, wbase, l, lds);
    if (ph == PH_RWKVPREP) ph_rwkv_prep(pk, kp, wbase, l, lds);
    if (ph == PH_RWKVSCAN) ph_rwkv_scan(pk, kp, wbase, l, lds);
    if (ph == PH_MLAUP) ph_mla_up(pk, kp, wbase, l, lds);
    if (ph == PH_MLAATTN) ph_mla_attn(pk, kp, wbase, l, lds);
    if (ph == PH_FINAL) ph_finalize_mix(pk, kp, wbase, l);
    if (ph == PH_OUTPROJ) ph_outproj(pk, kp, wbase, l, lds);
    if (ph == PH_LN1) ph_ln1_router(pk, kp, wbase, l, lds);
    if (ph == PH_GU) ph_moe_gu(pk, kp, wbase, l, lds);
    if (ph == PH_DN) ph_moe_dn(pk, kp, wbase, l, lds);
    if (ph == PH_LN2) ph_combine_ln2(pk, kp, wbase, l, lds);
}
template <int PH> static void launch_ph(const Params& p, int l, hipStream_t stream) {
    static bool attr_set = false;
    if (!attr_set) { (void)hipFuncSetAttribute((const void*)mega<PH>, hipFuncAttributeMaxDynamicSharedMemorySize, LDS_BYTES); attr_set = true; }
    hipLaunchKernelGGL(mega<PH>, dim3(256), dim3(NTHREADS), LDS_BYTES, stream, p, l);
}
template <int PH> static void launch_layer(const Params& p, int l, hipStream_t stream) {
    launch_ph<PH>(p, l, stream);
    if constexpr (PH < PH_LN2) launch_layer<PH + 1>(p, l, stream);
}

#else
__device__ __forceinline__ void grid_sync(KPtr kp_in, int wbase_in, char* lds) {
    KPtr kp_ = kp_launder(kp_in);
    XcdBarrier b; b.bar = kp_->bar; b.x = xb_xcc_id(); b.st = (volatile LAS unsigned*)(lds + LDS_BYTES - 16);
    xcd_barrier(b, opq_tid(wbase_in));
}
#ifndef PROBE_ID
#define PROBE_ID -1
#endif
#define RUN(ID, call) do { int reps_ = 1; if (PROBE_ID == (ID)) { reps_ = 2; asm volatile("" : "+s"(reps_)); } for (int r_ = 0; r_ < reps_; ++r_) { call; } } while (0)
__global__ void __launch_bounds__(NTHREADS, 2) mega_fused(Params pk) {
    extern __shared__ __attribute__((aligned(16))) char lds[];
    KPtr kp = (KPtr)__builtin_amdgcn_kernarg_segment_ptr();
    const int wbase = __builtin_amdgcn_readfirstlane(threadIdx.x) & ~63;
    volatile LAS unsigned* xbw = (volatile LAS unsigned*)(lds + LDS_BYTES - 16);
    if (threadIdx.x == 0) { xbw[0] = 0u; xbw[1] = 0u; xbw[2] = 0u; xbw[3] = 0u; }
    __syncthreads();
    (void)xcd_barrier_post(pk.bar, xbw);
    RUN(0, ph_prologue(pk, kp, wbase, lds));
    grid_sync(kp, wbase, lds);
    for (int l = 0; l < DEPTH; ++l) {
        RUN(1, ph_inproj(pk, kp, wbase, l, lds));
        grid_sync(kp, wbase, lds);
        RUN(2, ph_rope_prep(pk, kp, wbase, l));
        grid_sync(kp, wbase, lds);
        RUN(3, ph_ret_kv(pk, kp, wbase, l, lds)); RUN(4, ph_rwkv_prep(pk, kp, wbase, l, lds)); RUN(5, ph_mla_up(pk, kp, wbase, l, lds)); RUN(6, ph_dil_attn(pk, kp, wbase, l, lds));
        grid_sync(kp, wbase, lds);
        RUN(7, ph_mla_pack(pk, kp, wbase, l)); RUN(8, ph_ret_scan(pk, kp, wbase, l));
        grid_sync(kp, wbase, lds);
        RUN(10, ph_rwkv_scan(pk, kp, wbase, l, lds)); RUN(9, ph_mla_attn(pk, kp, wbase, l, lds));
        grid_sync(kp, wbase, lds);
        RUN(11, ph_ret_out(pk, kp, wbase, l)); RUN(12, ph_finalize_mix(pk, kp, wbase, l));
        grid_sync(kp, wbase, lds);
        RUN(13, ph_outproj(pk, kp, wbase, l, lds));
        grid_sync(kp, wbase, lds);
        ph_ln1_router(pk, kp, wbase, l, lds);
        grid_sync(kp, wbase, lds);
        RUN(14, ph_moe_gu(pk, kp, wbase, l, lds));
        grid_sync(kp, wbase, lds);
        RUN(15, ph_moe_dn(pk, kp, wbase, l, lds));
        grid_sync(kp, wbase, lds);
        RUN(16, ph_combine_ln2(pk, kp, wbase, l, lds));
        grid_sync(kp, wbase, lds);
    }
}
#endif
struct Carver { char* base; size_t off; template <class T> T* take(size_t n) { T* r = (T*)(base + off); off += ((n * sizeof(T) + 255) / 256) * 256; return r; } };

extern "C" void kernel_launch(void* const* d_in, const int* in_sizes, int n_in, void* d_out, int out_size, void* d_ws, size_t ws_size, hipStream_t stream) {
    Params p; memset(&p, 0, sizeof(p));
    const float** ip = (const float**)&p;
    for (int i = 0; i < 35; ++i) ip[i] = (const float*)d_in[i];
    p.out = (float*)d_out;
    Carver c{(char*)d_ws, 0};
    p.bar = c.take<unsigned>(4096); p.cnt = c.take<int>(DEPTH * NE); p.wq = c.take<int>(DEPTH * 16);
    p.tab_ret = c.take<float>((size_t)SEQ * 32); p.tab_dil = c.take<float>((size_t)SEQ * 16); p.tab_mla = c.take<float>((size_t)SEQ * 32);
    p.win_t = c.take<bf16_t>((size_t)DEPTH * NINP * 1024); p.wout_t = c.take<bf16_t>((size_t)DEPTH * 1024 * 1024);
    p.wgu_t = c.take<bf16_t>((size_t)DEPTH * NE * 2048 * 1024); p.wdn_t = c.take<bf16_t>((size_t)DEPTH * NE * 1024 * 1024);
    p.wq_t = c.take<bf16_t>((size_t)DEPTH * 384 * 256); p.wkv_t = c.take<bf16_t>((size_t)DEPTH * 512 * 128);
    p.xf = c.take<float>((size_t)NT * DM); p.xb = c.take<bf16_t>((size_t)NT * DM); p.pbuf = c.take<bf16_t>((size_t)NT * NINP);
    p.mixcat = c.take<bf16_t>((size_t)NT * DM); p.y1 = c.take<float>((size_t)NT * DM); p.x1b = c.take<bf16_t>((size_t)NT * DM);
    p.rq = c.take<float>((size_t)NT * 128); p.rk = c.take<float>((size_t)NT * 128);
    p.rkv = c.take<float>((size_t)NBATCH * NCH * 4 * 32 * 64); p.rstate = c.take<float>((size_t)NBATCH * NCH * 4 * 32 * 64);
    p.dq = c.take<float>((size_t)NT * 256); p.dk = c.take<float>((size_t)NT * 256); p.dob = c.take<float>((size_t)3 * NT * 256); p.dlse = c.take<float>((size_t)3 * NT * 4);
    p.sr = c.take<float>((size_t)NT * 256); p.sw = c.take<float>((size_t)NT * 256); p.sk = c.take<float>((size_t)NT * 256); p.sv = c.take<float>((size_t)NT * 256);
    p.sa = c.take<float>((size_t)NT * 256); p.sb = c.take<float>((size_t)NT * 256); p.sg = c.take<float>((size_t)NT * 256); p.sy = c.take<float>((size_t)NT * 256);
    p.vfirst = c.take<float>((size_t)NT * 256);
    p.rsq = c.take<float>(NT); p.rskv = c.take<float>(NT); p.kpe = c.take<float>((size_t)NT * 32);
    p.qu = c.take<float>((size_t)NT * 384); p.kvu = c.take<float>((size_t)NT * 512); p.mo = c.take<float>((size_t)NT * 256);
    p.mq = c.take<bf16_t>((size_t)NT * 384); p.mk = c.take<bf16_t>((size_t)NT * 384); p.mv = c.take<bf16_t>((size_t)NT * 256);
    p.rowtok = c.take<int>((size_t)NE * NT); p.toke = c.take<int>((size_t)NT * 4); p.tokpos = c.take<int>((size_t)NT * 4); p.rowgate = c.take<float>((size_t)NE * NT);
    p.act = c.take<bf16_t>((size_t)MOE_MAXROWS * 1024); p.yb = c.take<bf16_t>((size_t)MOE_MAXROWS * 1024);
    if (c.off > ws_size) { fprintf(stderr, "workspace too small: need %zu have %zu\n", c.off, ws_size); return; }

#ifdef MULTI_LAUNCH
    launch_ph<PH_PRO>(p, 0, stream);
    for (int l = 0; l < DEPTH; ++l) launch_layer<PH_INPROJ>(p, l, stream);
#else
    static int grid = 0;
    if (!grid) {
        (void)hipFuncSetAttribute((const void*)mega_fused, hipFuncAttributeMaxDynamicSharedMemorySize, LDS_BYTES);
        int dev = 0, cus = 0, per_cu = 0;
        (void)hipGetDevice(&dev);
        (void)hipDeviceGetAttribute(&cus, hipDeviceAttributeMultiprocessorCount, dev);
        (void)hipOccupancyMaxActiveBlocksPerMultiprocessor(&per_cu, mega_fused, NTHREADS, LDS_BYTES);
        if (cus <= 0) cus = 256;
        grid = cus * (per_cu < 1 ? 1 : 1);
    }
    (void)hipMemsetAsync(p.bar, 0, XCD_BAR_WORDS * sizeof(unsigned), stream);
    hipLaunchKernelGGL(mega_fused, dim3(grid), dim3(NTHREADS), LDS_BYTES, stream, p);
#endif
}
```

```cpp
#include <hip/hip_runtime.h>
#include <stdint.h>
#include <string.h>
#include <stdio.h>

typedef unsigned short bf16_t;
typedef short bf16x8 __attribute__((ext_vector_type(8)));
typedef float f32x4 __attribute__((ext_vector_type(4)));
typedef unsigned u32x4 __attribute__((ext_vector_type(4)));
typedef float f32x16 __attribute__((ext_vector_type(16)));
typedef short s16x4 __attribute__((ext_vector_type(4)));
typedef float f32x2_t __attribute__((ext_vector_type(2)));
typedef __bf16 bf16x2_t __attribute__((ext_vector_type(2)));

constexpr int NT = 32768, SEQ = 8192, NBATCH = 4, DM = 1024, NIN = 2976, NINP = 3072, DEPTH = 4, NE = 32, TOPK = 4;
constexpr int BLK = 128, NCH = SEQ / BLK;
constexpr float ALPHA = 1.6817928305074292f;
constexpr int PC_RQ = 0, PC_RK = 128, PC_RV = 256, PC_RG = 512, PC_DQ = 768, PC_DK = 1024, PC_DV = 1280;
constexpr int PC_C = 1536, PC_CR = 1536, PC_CK = 1792, PC_CV = 2048, PC_CWD = 2304, PC_CAD = 2368, PC_CGD = 2432;
constexpr int PC_MQ = 2560, PC_MKV = 2816, PC_MKR = 2944, PC_VRES = 2976;
constexpr int MOE_TM = 256;
constexpr int MOE_MAXROWS = NT * TOPK + NE * MOE_TM;
constexpr int NTHREADS = 512;
constexpr int LDS_BYTES = 147456;

__device__ __forceinline__ bf16_t f2bf(float f) { unsigned u = __float_as_uint(f); u += 0x7fffu + ((u >> 16) & 1u); return (bf16_t)(u >> 16); }
__device__ __forceinline__ unsigned cvtpk(float lo, float hi) { f32x2_t v = {lo, hi}; bf16x2_t b = __builtin_convertvector(v, bf16x2_t); return __builtin_bit_cast(unsigned, b); }
__device__ __forceinline__ float xhalf_max(float v) { auto rr = __builtin_amdgcn_permlane32_swap(__float_as_uint(v), __float_as_uint(v), false, false); return fmaxf(__uint_as_float(rr[0]), __uint_as_float(rr[1])); }
__device__ __forceinline__ float xhalf_sum(float v) { auto rr = __builtin_amdgcn_permlane32_swap(__float_as_uint(v), __float_as_uint(v), false, false); return __uint_as_float(rr[0]) + __uint_as_float(rr[1]); }
__device__ __forceinline__ float bf2f(bf16_t h) { return __uint_as_float(((unsigned)h) << 16); }
template <int CTRL> __device__ __forceinline__ float dpp_f(float v) { return __int_as_float(__builtin_amdgcn_update_dpp(0, __float_as_int(v), CTRL, 0xF, 0xF, true)); }
__device__ __forceinline__ float grp16_sum(float v) {
    v += dpp_f<0x128>(v); v += dpp_f<0x124>(v); v += dpp_f<0x122>(v); v += dpp_f<0x121>(v); return v; }
__device__ __forceinline__ float wave_sum(float v) {
    v = grp16_sum(v);
    const int i = __float_as_int(v);
    return (__int_as_float(__builtin_amdgcn_readlane(i, 0)) + __int_as_float(__builtin_amdgcn_readlane(i, 16))) +
           (__int_as_float(__builtin_amdgcn_readlane(i, 32)) + __int_as_float(__builtin_amdgcn_readlane(i, 48))); }
__device__ __forceinline__ float sigmoidf_(float x) { return 1.0f / (1.0f + __expf(-x)); }

#define XB_TMO      128
#define XB_XCNT(j)  (256  + 64 * (j))
#define XB_XSUB(j)  (1280 + 64 * (j))
#define XB_XGEN(j)  (2304 + 64 * (j))
#define XB_TOP      3328
#define XB_TOPGEN   3392
#define XCD_BAR_WORDS 3456
#define XB_SPIN_CAP (1u << 22)
#define LAS __attribute__((address_space(3)))
__device__ __forceinline__ unsigned xb_ld(unsigned* p)              { return __hip_atomic_load(p, __ATOMIC_RELAXED, __HIP_MEMORY_SCOPE_AGENT); }
__device__ __forceinline__ unsigned xb_add(unsigned* p, unsigned v) { return __hip_atomic_fetch_add(p, v, __ATOMIC_RELAXED, __HIP_MEMORY_SCOPE_AGENT); }
__device__ __forceinline__ unsigned xb_xcc_id() { return (unsigned)__builtin_amdgcn_s_getreg((3 << 11) | 20) & 0xFu; }
#define XB_SPIN(cond, bar) do { unsigned _sp = 0; while (cond) { __builtin_amdgcn_s_sleep(1); \
    if ((++_sp & 255u) == 0u) { if (xb_ld(&(bar)[XB_TMO])) break; if (_sp > XB_SPIN_CAP) { atomicAdd(&(bar)[XB_TMO], 1u); break; } } } } while (0)
struct XcdBarrier { unsigned* bar; unsigned x; volatile LAS unsigned* st; };
__device__ __forceinline__ XcdBarrier xcd_barrier_post(unsigned* bar, volatile LAS unsigned* st) {
    XcdBarrier b; b.bar = bar; b.x = xb_xcc_id(); b.st = st;
    if (threadIdx.x == 0) (void)xb_add(&bar[XB_XCNT(b.x)], 1u);
    return b;
}
__device__ __forceinline__ void xcd_barrier_complete(unsigned* bar, unsigned x, unsigned& nloc, unsigned& nx) {
    const unsigned G = gridDim.x * gridDim.y * gridDim.z;
    unsigned sum, cnt, mine, sp = 0u;
    for (;;) {
        sum = 0u; cnt = 0u; mine = 0u;
#pragma unroll
        for (unsigned j = 0; j < 16; ++j) { const unsigned c = xb_ld(&bar[XB_XCNT(j)]); sum += c; cnt += (c > 0u) ? 1u : 0u; mine = (j == x) ? c : mine; }
        if (sum == G) break;
        __builtin_amdgcn_s_sleep(1);
        if ((++sp & 255u) == 0u) { if (xb_ld(&bar[XB_TMO])) break; if (sp > XB_SPIN_CAP) { atomicAdd(&bar[XB_TMO], 1u); break; } }
    }
    nloc = mine > 0u ? mine : 1u; nx = cnt > 0u ? cnt : 1u;
}
__device__ __forceinline__ void xcd_barrier(const XcdBarrier& b, const int tid0) {
    asm volatile("s_waitcnt vmcnt(0)" ::: "memory");
    __syncthreads();
    if (tid0 == 0) {
        unsigned* bar = b.bar;
        __builtin_amdgcn_s_waitcnt(0);
        unsigned nloc = b.st[0], nx = b.st[1];
        if (nloc == 0u) { xcd_barrier_complete(bar, b.x, nloc, nx); b.st[0] = nloc; b.st[1] = nx; }
        const unsigned old = xb_add(&bar[XB_XSUB(b.x)], 1u);
        const unsigned gen = old / nloc;
        if (old + 1u == (gen + 1u) * nloc) {
            __builtin_amdgcn_fence(__ATOMIC_RELEASE, "agent");
            asm volatile("s_waitcnt vmcnt(0)" ::: "memory");
            const unsigned og = xb_add(&bar[XB_TOP], 1u);
            const unsigned tg = og / nx;
            if (og + 1u == (tg + 1u) * nx) xb_add(&bar[XB_TOPGEN], 1u);
            else XB_SPIN(xb_ld(&bar[XB_TOPGEN]) == tg, bar);
            __builtin_amdgcn_fence(__ATOMIC_ACQUIRE, "agent");
            xb_add(&bar[XB_XGEN(b.x)], 1u);
            asm volatile("s_waitcnt vmcnt(0)" ::: "memory");
        } else {
            XB_SPIN(xb_ld(&bar[XB_XGEN(b.x)]) == gen, bar);
            __builtin_amdgcn_fence(__ATOMIC_ACQUIRE, "agent");
            asm volatile("s_waitcnt vmcnt(0)" ::: "memory");
        }
    }
    __syncthreads();
}

struct Params {
    const float *x, *w_in, *w_out, *ret_norm_g, *dil_norm_g, *rwkv_mu, *rwkv_w0, *rwkv_w_up, *rwkv_a0, *rwkv_a_up, *rwkv_g_up, *rwkv_k_k, *rwkv_k_a,
        *rwkv_r_k, *rwkv_ln_g, *rwkv_ln_b, *vres_down, *vres_mu, *rwkv_v0, *rwkv_v_up, *mla_q_norm_g, *mla_w_q_up, *mla_kv_norm_g, *mla_w_kv_up,
        *mla_out_norm_g, *ln1_g, *ln1_b, *router_w, *router_b, *w_gu, *b_gu, *w_dn, *b_dn, *ln2_g, *ln2_b;
    float* out;
    unsigned* bar; int* cnt; int* wq;
    float *tab_ret, *tab_dil, *tab_mla;
    bf16_t *win_t, *wout_t, *wgu_t, *wdn_t, *wq_t, *wkv_t, *wupt, *aupt, *gupt, *vupt;
    float* xf; bf16_t* xb; bf16_t* pbuf; bf16_t* mixcat; float* y1; bf16_t* x1b;
    float *rq, *rk, *rkv, *rstate;
    float *dq, *dk, *dob, *dlse;
    float *sr, *sw, *sk, *sv, *sa, *sb, *sg, *sy, *vfirst;
    float *c_p, *c_q, *c_rh, *c_y1;
    float *rsq, *rskv, *kpe, *qu, *kvu, *mo;
    bf16_t *mq, *mk, *mv;
    int *rowtok, *toke, *tokpos; float* rowgate; bf16_t *act, *yb;
};

__device__ __forceinline__ int opq_tid(int wbase) { unsigned z = 0u; asm volatile("" : "+s"(z)); int t = wbase | (int)__builtin_amdgcn_mbcnt_hi(~0u, __builtin_amdgcn_mbcnt_lo(~0u, z)); asm volatile("" : "+v"(t)); return t; }
__device__ __forceinline__ int opq_bid() { int b = blockIdx.x; asm volatile("" : "+s"(b)); return b; }
typedef const __attribute__((address_space(4))) Params* KPtr;
typedef const __attribute__((address_space(4))) Params& KRef;
__device__ __forceinline__ KPtr kp_launder(KPtr k) {
    const unsigned long long v = (unsigned long long)k;
    unsigned lo = (unsigned)v, hi = (unsigned)(v >> 32);
    asm volatile("" : "+s"(lo), "+s"(hi));
    return (KPtr)(((unsigned long long)hi << 32) | lo);
}
#define PH_HEADV (void)kp_in; const Params& p = pkv; const int TID = opq_tid(wbase_in), BID = opq_bid(); (void)TID; (void)BID;
#define PH_HEAD (void)pkv; KPtr kp_ = kp_launder(kp_in); KRef p = *kp_; const int TID = opq_tid(wbase_in), BID = opq_bid(); (void)TID; (void)BID;
template <class F>
__device__ __forceinline__ void tr_tile(F f, bf16_t* dst, int ldd, int k0, int n0, float* tile, const int TID) {
    const int tid = TID;
#pragma unroll
    for (int i = 0; i < 8; ++i) { const int e = tid + i * NTHREADS, kk = e >> 6, nn = e & 63; tile[kk * 65 + nn] = f(k0 + kk, n0 + nn); }
    __syncthreads();
#pragma unroll
    for (int i = 0; i < 8; ++i) { const int e = tid + i * NTHREADS, nn = e >> 6, kk = e & 63; dst[(size_t)(n0 + nn) * ldd + k0 + kk] = f2bf(tile[kk * 65 + nn]); }
    __syncthreads();
}

__device__ __forceinline__ void ph_prologue(const Params& pkv, KPtr kp_in, int wbase_in, char* lds) {
    PH_HEAD
    float* tile = (float*)lds;
    const int nb = gridDim.x, bid = BID, tid = TID;
    for (int t = bid; t < DEPTH * NE * 16 * 32; t += nb) {
        const int le = t >> 9, r = t & 511, tk = r >> 5, tn = r & 31;
        const float* src = p.w_gu + (size_t)le * 1024 * 2048;
        tr_tile([&](int k, int n) { return src[(size_t)k * 2048 + n]; }, p.wgu_t + (size_t)le * 2048 * 1024, 1024, tk * 64, tn * 64, tile, TID);
    }
    for (int t = bid; t < DEPTH * NE * 16 * 16; t += nb) {
        const int le = t >> 8, r = t & 255, tk = r >> 4, tn = r & 15;
        const float* src = p.w_dn + (size_t)le * 1024 * 1024;
        tr_tile([&](int k, int n) { return src[(size_t)k * 1024 + n]; }, p.wdn_t + (size_t)le * 1024 * 1024, 1024, tk * 64, tn * 64, tile, TID);
    }
    for (int t = bid; t < DEPTH * 16 * 48; t += nb) {
        const int l = t / (16 * 48), r = t % (16 * 48), tk = r / 48, tn = r % 48;
        const float* src = p.w_in + (size_t)l * 1024 * NIN;
        const float* vr = p.vres_down + (size_t)(l > 0 ? l - 1 : 0) * 1024 * 32;
        tr_tile([&](int k, int n) { return n < NIN ? src[(size_t)k * NIN + n] : ((n < NIN + 32 && l > 0) ? vr[k * 32 + (n - NIN)] : 0.0f); },
                p.win_t + (size_t)l * NINP * 1024, 1024, tk * 64, tn * 64, tile, TID);
    }
    for (int t = bid; t < DEPTH * 16 * 16; t += nb) {
        const int l = t >> 8, r = t & 255, tk = r >> 4, tn = r & 15;
        const float* src = p.w_out + (size_t)l * 1024 * 1024;
        tr_tile([&](int k, int n) { return src[(size_t)k * 1024 + n]; }, p.wout_t + (size_t)l * 1024 * 1024, 1024, tk * 64, tn * 64, tile, TID);
    }
    for (int t = bid; t < DEPTH * 4 * 6; t += nb) {
        const int l = t / 24, r = t % 24, tk = r / 6, tn = r % 6;
        const float* src = p.mla_w_q_up + (size_t)l * 256 * 384; const float* g = p.mla_q_norm_g + l * 256;
        tr_tile([&](int k, int n) { return src[k * 384 + n] * g[k]; }, p.wq_t + (size_t)l * 384 * 256, 256, tk * 64, tn * 64, tile, TID);
    }
    for (int t = bid; t < DEPTH * 2 * 8; t += nb) {
        const int l = t / 16, r = t % 16, tk = r / 8, tn = r % 8;
        const float* src = p.mla_w_kv_up + (size_t)l * 128 * 512; const float* g = p.mla_kv_norm_g + l * 128;
        tr_tile([&](int k, int n) { return src[k * 512 + n] * g[k]; }, p.wkv_t + (size_t)l * 512 * 128, 128, tk * 64, tn * 64, tile, TID);
    }
    for (int i = bid * NTHREADS + tid; i < DEPTH * 256 * 64; i += nb * NTHREADS) {
        const int l = i / (256 * 64), r = i % (256 * 64), n = r / 64, k = r % 64;
        p.wupt[i] = f2bf(p.rwkv_w_up[((size_t)l * 64 + k) * 256 + n]); p.aupt[i] = f2bf(p.rwkv_a_up[((size_t)l * 64 + k) * 256 + n]);
    }
    for (int i = bid * NTHREADS + tid; i < DEPTH * 256 * 128; i += nb * NTHREADS) {
        const int l = i / (256 * 128), r = i % (256 * 128), n = r / 128, k = r % 128;
        p.gupt[i] = f2bf(p.rwkv_g_up[((size_t)l * 128 + k) * 256 + n]);
    }
    for (int i = bid * NTHREADS + tid; i < (DEPTH - 1) * 256 * 32; i += nb * NTHREADS) {
        const int l = i / (256 * 32), r = i % (256 * 32), n = r / 32, k = r % 32;
        p.vupt[i] = f2bf(p.rwkv_v_up[((size_t)l * 32 + k) * 256 + n]);
    }
    for (int i = bid * NTHREADS + tid; i < SEQ * 40; i += nb * NTHREADS) {
        const int pos = i / 40, j = i % 40;
        double theta, rot; int f; float* dst;
        if (j < 16) { theta = 10000.0; rot = 32.0; f = j; dst = p.tab_ret + ((size_t)pos * 16 + f) * 2; }
        else if (j < 24) { theta = 500000.0; rot = 16.0; f = j - 16; dst = p.tab_dil + ((size_t)pos * 8 + f) * 2; }
        else { theta = 10000.0; rot = 32.0; f = j - 24; dst = p.tab_mla + ((size_t)pos * 16 + f) * 2; }
        const double inv = 1.0 / pow(theta, (2.0 * f) / rot), ang = (double)pos * inv;
        dst[0] = (float)cos(ang); dst[1] = (float)sin(ang);
    }
    for (size_t i = (size_t)bid * NTHREADS + tid; i < (size_t)NT * DM / 4; i += (size_t)nb * NTHREADS) {
        const float4 v = ((const float4*)p.x)[i];
        ushort4 o; o.x = f2bf(v.x); o.y = f2bf(v.y); o.z = f2bf(v.z); o.w = f2bf(v.w);
        ((ushort4*)p.xb)[i] = o;
    }
    if (bid == 0 && tid < DEPTH * NE) p.cnt[tid] = 0;
    if (bid == 0 && tid < DEPTH * 16) p.wq[tid] = 0;
}

template <class Epi>
__device__ __forceinline__ void gemm_tile128(const bf16_t* __restrict__ A, int lda, const int* __restrict__ rowidx, int nvalid,
                                             const bf16_t* __restrict__ Bt, int ldb, int K, char* lds, const int TID, Epi epi) {
    constexpr int LDT = 72;
    bf16_t* As = (bf16_t*)lds; bf16_t* Bs = As + 128 * LDT;
    const int tid = TID, lane = tid & 63, wid = tid >> 6, wm = wid >> 2, wn = wid & 3, fr = lane & 15, fq = lane >> 4;
    const bf16_t* ap[2]; const bf16_t* bp[2]; int so[2];
#pragma unroll
    for (int i = 0; i < 2; ++i) {
        const int c = tid + i * NTHREADS, row = c >> 3, kc = c & 7;
        int ar = row; if (rowidx) ar = (row < nvalid) ? rowidx[row] : rowidx[0];
        ap[i] = A + (size_t)ar * lda + kc * 8; bp[i] = Bt + (size_t)row * ldb + kc * 8; so[i] = row * LDT + kc * 8;
    }
    f32x4 acc[4][2];
#pragma unroll
    for (int mi = 0; mi < 4; ++mi)
#pragma unroll
        for (int ni = 0; ni < 2; ++ni) acc[mi][ni] = (f32x4){0.f, 0.f, 0.f, 0.f};
    u32x4 ra0, ra1, rb0, rb1;
    ra0 = *(const u32x4*)(ap[0]); ra1 = *(const u32x4*)(ap[1]); rb0 = *(const u32x4*)(bp[0]); rb1 = *(const u32x4*)(bp[1]);
    const int nk = K >> 6;
    for (int kt = 0; kt < nk; ++kt) {
        __syncthreads();
        *(u32x4*)(As + so[0]) = ra0; *(u32x4*)(As + so[1]) = ra1; *(u32x4*)(Bs + so[0]) = rb0; *(u32x4*)(Bs + so[1]) = rb1;
        __syncthreads();
        if (kt + 1 < nk) {
            const int ko = (kt + 1) * 64;
            ra0 = *(const u32x4*)(ap[0] + ko); ra1 = *(const u32x4*)(ap[1] + ko); rb0 = *(const u32x4*)(bp[0] + ko); rb1 = *(const u32x4*)(bp[1] + ko);
        }
#pragma unroll
        for (int kk = 0; kk < 2; ++kk) {
            bf16x8 af[4], bfr[2];
#pragma unroll
            for (int mi = 0; mi < 4; ++mi) af[mi] = *(const bf16x8*)(As + (wm * 64 + mi * 16 + fr) * LDT + kk * 32 + fq * 8);
#pragma unroll
            for (int ni = 0; ni < 2; ++ni) bfr[ni] = *(const bf16x8*)(Bs + (wn * 32 + ni * 16 + fr) * LDT + kk * 32 + fq * 8);
#pragma unroll
            for (int mi = 0; mi < 4; ++mi)
#pragma unroll
                for (int ni = 0; ni < 2; ++ni) acc[mi][ni] = __builtin_amdgcn_mfma_f32_16x16x32_bf16(bfr[ni], af[mi], acc[mi][ni], 0, 0, 0);
        }
    }
#pragma unroll
    for (int mi = 0; mi < 4; ++mi)
#pragma unroll
        for (int ni = 0; ni < 2; ++ni) epi(wm * 64 + mi * 16 + fr, wn * 32 + ni * 16 + fq * 4, acc[mi][ni]);
    __syncthreads();
}

__device__ __forceinline__ int g8_lds_byte(int r, int c) { const int st = (r >> 4) * 2 + (c >> 5), rr = r & 15, cc = c & 31, ob = rr * 64 + cc * 2; return st * 1024 + (ob ^ (((ob >> 9) & 1) << 5)); }
__device__ __forceinline__ void g8_stage_rc(int b, int& R, int& C) { const int st = b / 1024, sb = b % 1024, swz = sb ^ (((sb >> 9) & 1) << 5); R = (st >> 1) * 16 + swz / 64; C = (st & 1) * 32 + (swz % 64) / 2; }
struct G8Next { const bf16_t* A; const int* rowidx; const bf16_t* Bt; int nvalid; int valid; };
template <class Epi>
__device__ __forceinline__ void gemm_tile256(const bf16_t* __restrict__ A, int lda, const int* __restrict__ rowidx, int nvalid,
                                             const bf16_t* __restrict__ Bt, int ldb, int K, char* lds, const int TID, const bool pre_issued, const G8Next nx, Epi epi) {
    constexpr int G_HT = 128 * 64;
    bf16_t* shm = (bf16_t*)lds;
    int* icache = (int*)(lds + 133120);
#define G8_SA(b, h) (shm + ((b) * 2 + (h)) * G_HT)
#define G8_SB(b, h) (shm + (4 + (b) * 2 + (h)) * G_HT)
#define G8_SPTR(dst, src) do { unsigned long long _v = (unsigned long long)(src); unsigned _lo = (unsigned)_v, _hi = (unsigned)(_v >> 32); asm volatile("" : "+s"(_lo), "+s"(_hi)); \
        dst = (const char*)(((unsigned long long)_hi << 32) | _lo); } while (0)
#define G8_STAGE(P, BASE, OFF, kt) do { const char* _sb; G8_SPTR(_sb, (const char*)(BASE) + (size_t)(kt) * 128); _Pragma("unroll") for (int _i = 0; _i < 2; ++_i) { \
        __builtin_amdgcn_global_load_lds((const unsigned*)(_sb + (size_t)(OFF)[_i]), (unsigned*)((char*)(P) + tz * 16 + _i * 8192), 16, 0, 0); } } while (0)
#define G8_LDA(dst, b, h) _Pragma("unroll") for (int m = 0; m < 4; ++m) _Pragma("unroll") for (int k = 0; k < 2; ++k) \
        dst[m][k] = *reinterpret_cast<const bf16x8*>((char*)G8_SA(b, h) + g8_lds_byte(wr * 64 + m * 16 + fr, k * 32 + fq * 8))
#define G8_LDB(dst, b, h) _Pragma("unroll") for (int n = 0; n < 2; ++n) _Pragma("unroll") for (int k = 0; k < 2; ++k) \
        dst[n][k] = *reinterpret_cast<const bf16x8*>((char*)G8_SB(b, h) + g8_lds_byte(wc * 32 + n * 16 + fr, k * 32 + fq * 8))
#define G8_MMA(ai, bj, At_, Bt_) do { __builtin_amdgcn_s_setprio(1); \
        _Pragma("unroll") for (int m = 0; m < 4; ++m) _Pragma("unroll") for (int n = 0; n < 2; ++n) _Pragma("unroll") for (int k = 0; k < 2; ++k) \
            acc[ai][bj][m][n] = __builtin_amdgcn_mfma_f32_16x16x32_bf16(Bt_[n][k], At_[m][k], acc[ai][bj][m][n], 0, 0, 0); \
        __builtin_amdgcn_s_setprio(0); } while (0)
#define G8_WAIT_V(n) asm volatile("s_waitcnt vmcnt(" #n ")" ::: "memory")
#define G8_WAIT_L(n) asm volatile("s_waitcnt lgkmcnt(" #n ")" ::: "memory")
#define G8_BAR __builtin_amdgcn_s_barrier()
#define G8_SCHED __builtin_amdgcn_sched_barrier(0)
    int tz = opq_tid(TID);
    int wid = tz >> 6, lane = tz & 63, wr = wid >> 2, wc = wid & 3, fr = lane & 15, fq = lane >> 4;
    unsigned aoff0[2], aoff1[2], boff0[2];
#pragma unroll
    for (int i = 0; i < 2; ++i) {
        int r, c; g8_stage_rc(tz * 16 + i * 8192, r, c);
        int r0 = r, r1 = 128 + r;
        if (rowidx) {
            if (pre_issued) { r0 = icache[r0]; r1 = icache[r1]; }
            else { r0 = (r0 < nvalid) ? rowidx[r0] : rowidx[0]; r1 = (r1 < nvalid) ? rowidx[r1] : rowidx[0]; }
        }
        aoff0[i] = (unsigned)(r0 * lda + c) * 2u; aoff1[i] = (unsigned)(r1 * lda + c) * 2u;
        boff0[i] = (unsigned)(r * ldb + c) * 2u;
    }
    const bf16_t* Bt1 = Bt + (size_t)128 * ldb;
    int nidx = 0;
    if (nx.valid && nx.rowidx && tz < 256) nidx = nx.rowidx[(tz < nx.nvalid) ? tz : 0];
    f32x4 acc[2][2][4][2];
#pragma unroll
    for (int a = 0; a < 2; ++a)
#pragma unroll
        for (int b = 0; b < 2; ++b)
#pragma unroll
            for (int m = 0; m < 4; ++m)
#pragma unroll
                for (int n = 0; n < 2; ++n) acc[a][b][m][n] = (f32x4){0.f, 0.f, 0.f, 0.f};
    bf16x8 At[4][2], B0[2][2], B1[2][2];
    const int nt = K / 64;
    if (!pre_issued) {
        G8_STAGE(G8_SB(0, 0), Bt, boff0, 0); G8_STAGE(G8_SA(0, 0), A, aoff0, 0);
        G8_STAGE(G8_SB(0, 1), Bt1, boff0, 0); G8_STAGE(G8_SA(0, 1), A, aoff1, 0);
    }
    if (wr == 1) G8_BAR;
    G8_WAIT_V(4); G8_BAR;
    G8_STAGE(G8_SB(1, 0), Bt, boff0, 1); G8_STAGE(G8_SA(1, 0), A, aoff0, 1); G8_STAGE(G8_SB(1, 1), Bt1, boff0, 1);
    G8_WAIT_V(6); G8_BAR;
    for (int t = 0; t < nt - 2; t += 2) {
        G8_LDB(B0, 0, 0); G8_SCHED; G8_LDA(At, 0, 0); G8_STAGE(G8_SA(1, 1), A, aoff1, t + 1);
        G8_WAIT_L(8); G8_BAR; G8_WAIT_L(0); G8_MMA(0, 0, At, B0); G8_BAR; G8_SCHED;
        G8_LDB(B1, 0, 1); G8_STAGE(G8_SB(0, 0), Bt, boff0, t + 2);
        G8_BAR; G8_WAIT_L(0); G8_MMA(0, 1, At, B1); G8_BAR;
        G8_LDA(At, 0, 1); G8_STAGE(G8_SA(0, 0), A, aoff0, t + 2);
        G8_BAR; G8_WAIT_L(0); G8_MMA(1, 0, At, B0); G8_BAR; G8_SCHED;
        G8_STAGE(G8_SB(0, 1), Bt1, boff0, t + 2);
        G8_WAIT_V(6); G8_BAR; G8_MMA(1, 1, At, B1); G8_BAR;
        G8_LDB(B0, 1, 0); G8_SCHED; G8_LDA(At, 1, 0); G8_STAGE(G8_SA(0, 1), A, aoff1, t + 2);
        G8_WAIT_L(8); G8_BAR; G8_WAIT_L(0); G8_MMA(0, 0, At, B0); G8_BAR; G8_SCHED;
        G8_LDB(B1, 1, 1); G8_STAGE(G8_SB(1, 0), Bt, boff0, t + 3);
        G8_BAR; G8_WAIT_L(0); G8_MMA(0, 1, At, B1); G8_BAR;
        G8_LDA(At, 1, 1); G8_STAGE(G8_SA(1, 0), A, aoff0, t + 3);
        G8_BAR; G8_WAIT_L(0); G8_MMA(1, 0, At, B0); G8_BAR; G8_SCHED;
        G8_STAGE(G8_SB(1, 1), Bt1, boff0, t + 3);
        G8_WAIT_V(6); G8_BAR; G8_MMA(1, 1, At, B1); G8_BAR;
    }
    { G8_LDB(B0, 0, 0); G8_WAIT_V(0); G8_LDA(At, 0, 0); G8_STAGE(G8_SA(1, 1), A, aoff1, nt - 1);
      G8_BAR; G8_WAIT_L(0); G8_MMA(0, 0, At, B0); G8_BAR;
      G8_LDB(B1, 0, 1); G8_BAR; G8_WAIT_L(0); G8_MMA(0, 1, At, B1); G8_BAR;
      G8_LDA(At, 0, 1); G8_WAIT_V(4); G8_BAR; G8_WAIT_L(0); G8_MMA(1, 0, At, B0); G8_MMA(1, 1, At, B1); G8_BAR; }
    { G8_LDB(B0, 1, 0); G8_LDA(At, 1, 0); G8_WAIT_V(2); G8_BAR; G8_WAIT_L(0); G8_MMA(0, 0, At, B0); G8_BAR;
      G8_LDB(B1, 1, 1); G8_WAIT_V(0); G8_BAR; G8_WAIT_L(0); G8_MMA(0, 1, At, B1); G8_BAR;
      G8_LDA(At, 1, 1); G8_BAR; G8_WAIT_L(0); G8_MMA(1, 0, At, B0); G8_MMA(1, 1, At, B1); G8_BAR; }
    if (wr == 0) G8_BAR;
    asm volatile("" : "+v"(tz)); wid = tz >> 6; lane = tz & 63; wr = wid >> 2; wc = wid & 3; fr = lane & 15; fq = lane >> 4;
    if (nx.valid) {
        if (nx.rowidx) { if (tz < 256) icache[tz] = nidx; G8_WAIT_L(0); G8_BAR; }
        unsigned na0[2], na1[2], nb0[2];
#pragma unroll
        for (int i = 0; i < 2; ++i) {
            int r, c; g8_stage_rc(tz * 16 + i * 8192, r, c);
            int r0 = r, r1 = 128 + r;
            if (nx.rowidx) { r0 = icache[r0]; r1 = icache[r1]; }
            na0[i] = (unsigned)(r0 * lda + c) * 2u; na1[i] = (unsigned)(r1 * lda + c) * 2u; nb0[i] = (unsigned)(r * ldb + c) * 2u;
        }
        const bf16_t* nBt1 = nx.Bt + (size_t)128 * ldb;
        G8_STAGE(G8_SB(0, 0), nx.Bt, nb0, 0); G8_STAGE(G8_SA(0, 0), nx.A, na0, 0);
        G8_STAGE(G8_SB(0, 1), nBt1, nb0, 0); G8_STAGE(G8_SA(0, 1), nx.A, na1, 0);
    }
#pragma unroll
    for (int ai = 0; ai < 2; ++ai)
#pragma unroll
        for (int m = 0; m < 4; ++m)
#pragma unroll
            for (int bj = 0; bj < 2; ++bj)
#pragma unroll
                for (int n = 0; n < 2; ++n) epi(ai * 128 + wr * 64 + m * 16 + fr, bj * 128 + wc * 32 + n * 16 + fq * 4, acc[ai][bj][m][n]);
    __syncthreads();
}

__device__ __forceinline__ void ph_inproj(const Params& pkv, KPtr kp_in, int wbase_in, int l, char* lds) {
    PH_HEAD
    const bf16_t* Bt = p.win_t + (size_t)l * NINP * 1024;
    const int ntn = NINP / 256, nunits = (NT / 256) * ntn;
    bool pre = false;
    for (int u = BID; u < nunits; u += gridDim.x) {
        const int mt = u / ntn, nt = u % ntn, un = u + gridDim.x, mt2 = un / ntn, nt2 = un % ntn;
        G8Next nx; nx.valid = 0; nx.rowidx = nullptr; nx.nvalid = 256; nx.A = p.xb + (size_t)mt2 * 256 * 1024; nx.Bt = Bt + (size_t)nt2 * 256 * 1024;
        bf16_t* out = p.pbuf + (size_t)mt * 256 * NINP + nt * 256;
        gemm_tile256(p.xb + (size_t)mt * 256 * 1024, 1024, nullptr, 256, Bt + (size_t)nt * 256 * 1024, 1024, 1024, lds, wbase_in, pre, nx,
                     [=](int r, int c, f32x4 v) mutable { uint2 o; o.x = cvtpk(v[0], v[1]); o.y = cvtpk(v[2], v[3]); *(uint2*)(out + (size_t)r * NINP + c) = o; });
        pre = nx.valid != 0;
    }
}

__device__ __forceinline__ void ph_rope_prep(const Params& pkv, KPtr kp_in, int wbase_in, int l) {
    PH_HEAD
    const int lane = TID & 63, gw = BID * (NTHREADS / 64) + (TID >> 6), nw = gridDim.x * (NTHREADS / 64);
    for (int t = gw; t < NT; t += nw) {
        const int pos = t % SEQ;
        const bf16_t* pr = p.pbuf + (size_t)t * NINP;
        {
            const int h = lane >> 4, i = lane & 15;
            const float c = p.tab_ret[(pos * 16 + i) * 2], s = p.tab_ret[(pos * 16 + i) * 2 + 1];
            float x1 = bf2f(pr[PC_RQ + h * 32 + i]), x2 = bf2f(pr[PC_RQ + h * 32 + 16 + i]);
            ((bf16_t*)p.rq)[(size_t)t * 128 + h * 32 + i] = f2bf(x1 * c - x2 * s); ((bf16_t*)p.rq)[(size_t)t * 128 + h * 32 + 16 + i] = f2bf(x1 * s + x2 * c);
            x1 = bf2f(pr[PC_RK + h * 32 + i]); x2 = bf2f(pr[PC_RK + h * 32 + 16 + i]);
            const float sc = 0.17677669529663687f;
            ((bf16_t*)p.rk)[(size_t)t * 128 + h * 32 + i] = f2bf((x1 * c - x2 * s) * sc); ((bf16_t*)p.rk)[(size_t)t * 128 + h * 32 + 16 + i] = f2bf((x1 * s + x2 * c) * sc);
        }
        {
            for (int e = lane; e < 256; e += 64) {
                const int h = e >> 6, d = e & 63;
                float qv, kv;
                if (d < 16) {
                    const int i = d & 7; const float c = p.tab_dil[(pos * 8 + i) * 2], s = p.tab_dil[(pos * 8 + i) * 2 + 1];
                    const float q1 = bf2f(pr[PC_DQ + h * 64 + i]), q2 = bf2f(pr[PC_DQ + h * 64 + 8 + i]);
                    const float k1 = bf2f(pr[PC_DK + h * 64 + i]), k2 = bf2f(pr[PC_DK + h * 64 + 8 + i]);
                    if (d < 8) { qv = q1 * c - q2 * s; kv = k1 * c - k2 * s; } else { qv = q1 * s + q2 * c; kv = k1 * s + k2 * c; }
                } else { qv = bf2f(pr[PC_DQ + e]); kv = bf2f(pr[PC_DK + e]); }
                ((bf16_t*)p.dq)[(size_t)t * 256 + e] = f2bf(qv * (0.125f * 1.4426950408889634f)); ((bf16_t*)p.dk)[(size_t)t * 256 + e] = f2bf(kv);
            }
        }
        {
            float ss = 0.f;
            for (int e = lane; e < 256; e += 64) { const float v = bf2f(pr[PC_MQ + e]); ss += v * v; }
            ss = wave_sum(ss);
            float s2 = 0.f;
            for (int e = lane; e < 128; e += 64) { const float v = bf2f(pr[PC_MKV + e]); s2 += v * v; }
            s2 = wave_sum(s2);
            if (lane == 0) { p.rsq[t] = rsqrtf(ss * (1.0f / 256.0f) + 1e-6f); p.rskv[t] = rsqrtf(s2 * (1.0f / 128.0f) + 1e-6f); }
            if (lane < 16) {
                const float c = p.tab_mla[(pos * 16 + lane) * 2], s = p.tab_mla[(pos * 16 + lane) * 2 + 1];
                const float x1 = bf2f(pr[PC_MKR + lane]), x2 = bf2f(pr[PC_MKR + 16 + lane]);
                p.kpe[(size_t)t * 32 + lane] = x1 * c - x2 * s; p.kpe[(size_t)t * 32 + 16 + lane] = x1 * s + x2 * c;
            }
        }
    }
}

__device__ __forceinline__ float ret_log_gamma(int h) { return logf(1.0f - exp2f(-5.0f - (float)h)); }

__device__ __forceinline__ void ph_ret_kv(const Params& pkv, KPtr kp_in, int wbase_in, int l, char* lds) {
    PH_HEAD
    float* kz = (float*)lds;
    float* vs = kz + 128 * 32;
    const int tid = TID;
    for (int u = BID; u < NBATCH * NCH * 4; u += gridDim.x) {
        const int h = u & 3, n = (u >> 2) & 63, b = u >> 8;
        const float lg = ret_log_gamma(h);
        const int t0 = b * SEQ + n * BLK;
        __syncthreads();
        for (int e = tid; e < 128 * 32; e += NTHREADS) { const int j = e >> 5, d = e & 31; kz[e] = bf2f(((const bf16_t*)p.rk)[(size_t)(t0 + j) * 128 + h * 32 + d]) * __expf((float)(BLK - 1 - j) * lg); }
        for (int e = tid; e < 128 * 64; e += NTHREADS) { const int j = e >> 6, c = e & 63; vs[e] = bf2f(p.pbuf[(size_t)(t0 + j) * NINP + PC_RV + h * 64 + c]); }
        __syncthreads();
        const int e = tid & 63, d0 = (tid >> 6) * 4;
        float a0 = 0.f, a1 = 0.f, a2 = 0.f, a3 = 0.f;
#pragma unroll 8
        for (int j = 0; j < BLK; ++j) {
            const float vv = vs[j * 64 + e]; const float4 kk = *(const float4*)(kz + j * 32 + d0);
            a0 += kk.x * vv; a1 += kk.y * vv; a2 += kk.z * vv; a3 += kk.w * vv;
        }
        float* out = p.rkv + (size_t)u * 2048;
        out[(d0 + 0) * 64 + e] = a0; out[(d0 + 1) * 64 + e] = a1; out[(d0 + 2) * 64 + e] = a2; out[(d0 + 3) * 64 + e] = a3;
    }
}
__device__ __forceinline__ void ph_ret_scan(const Params& pkv, KPtr kp_in, int wbase_in, int l) {
    PH_HEAD
    const int i = BID * NTHREADS + TID;
    if (i < NBATCH * 4 * 32 * 64) {
        const int e = i & 63, d = (i >> 6) & 31, h = (i >> 11) & 3, b = i >> 13;
        const float cd = __expf((float)BLK * ret_log_gamma(h));
        float s = 0.f;
        for (int n = 0; n < NCH; ++n) {
            const size_t idx = ((((size_t)b * NCH + n) * 4 + h) * 32 + d) * 64 + e;
            p.rstate[idx] = s; s = cd * s + p.rkv[idx];
        }
    }
}
__device__ __forceinline__ void ph_ret_out(const Params& pkv, KPtr kp_in, int wbase_in, int l, char* lds) {
    PH_HEAD
    constexpr int KSTR = 40, VSTR = 132, SSTR = 40, UNIT_BYTES = (128 * KSTR + 64 * VSTR + 64 * SSTR) * 2;
    const int tid = TID, lane = tid & 63, wv = tid >> 6, hb = wv >> 2, w = wv & 3, r = lane & 31, hh = lane >> 5, ht = tid & 255;
    bf16_t* Ks = (bf16_t*)(lds + hb * UNIT_BYTES);
    bf16_t* Vt = Ks + 128 * KSTR;
    bf16_t* St = Vt + 64 * VSTR;
    const bf16_t* rqb = (const bf16_t*)p.rq; const bf16_t* rkb = (const bf16_t*)p.rk;
    for (int u0 = BID * 2; u0 < NBATCH * NCH * 4; u0 += gridDim.x * 2) {
        const int u = u0 + hb, h = u & 3, n = (u >> 2) & 63, b = u >> 8;
        const int t0 = b * SEQ + n * BLK;
        const float lg2 = ret_log_gamma(h) * 1.4426950408889634f;
        __syncthreads();
#pragma unroll
        for (int i = 0; i < 2; ++i) { const int c = ht + i * 256, key = c >> 2, ch = c & 3; *(u32x4*)(Ks + key * KSTR + ch * 8) = *(const u32x4*)(rkb + (size_t)(t0 + key) * 128 + h * 32 + ch * 8); }
#pragma unroll
        for (int i = 0; i < 4; ++i) {
            const int c = ht + i * 256, key = c & 127, ch = c >> 7;
            const u32x4 rv = *(const u32x4*)(p.pbuf + (size_t)(t0 + key) * NINP + PC_RV + h * 64 + ch * 8);
            bf16_t* vd = Vt + (ch * 8) * VSTR + key;
            vd[0] = (bf16_t)(rv[0] & 0xffff); vd[VSTR] = (bf16_t)(rv[0] >> 16); vd[2 * VSTR] = (bf16_t)(rv[1] & 0xffff); vd[3 * VSTR] = (bf16_t)(rv[1] >> 16);
            vd[4 * VSTR] = (bf16_t)(rv[2] & 0xffff); vd[5 * VSTR] = (bf16_t)(rv[2] >> 16); vd[6 * VSTR] = (bf16_t)(rv[3] & 0xffff); vd[7 * VSTR] = (bf16_t)(rv[3] >> 16);
        }
        {
            const float* st = p.rstate + (size_t)u * 2048;
#pragma unroll
            for (int i = 0; i < 8; ++i) { const int c = ht + i * 256, d = c >> 6, e = c & 63; St[e * SSTR + d] = f2bf(st[c]); }
        }
        __syncthreads();
        const int iq = 32 * w + r, t = t0 + iq;
        bf16x8 qf[2];
#pragma unroll
        for (int s = 0; s < 2; ++s) qf[s] = *(const bf16x8*)(rqb + (size_t)t * 128 + h * 32 + 16 * s + 8 * hh);
        f32x16 o0, o1;
#pragma unroll
        for (int i = 0; i < 16; ++i) { o0[i] = 0.f; o1[i] = 0.f; }
#pragma unroll
        for (int s = 0; s < 2; ++s) {
            const bf16x8 sa0 = *(const bf16x8*)(St + r * SSTR + 16 * s + 8 * hh), sa1 = *(const bf16x8*)(St + (32 + r) * SSTR + 16 * s + 8 * hh);
            o0 = __builtin_amdgcn_mfma_f32_32x32x16_bf16(sa0, qf[s], o0, 0, 0, 0);
            o1 = __builtin_amdgcn_mfma_f32_32x32x16_bf16(sa1, qf[s], o1, 0, 0, 0);
        }
        {
            const float xi = __builtin_amdgcn_exp2f((float)(iq + 1) * lg2);
#pragma unroll
            for (int i = 0; i < 16; ++i) { o0[i] *= xi; o1[i] *= xi; }
        }
        float cdec[16];
#pragma unroll
        for (int i = 0; i < 16; ++i) cdec[i] = __builtin_amdgcn_exp2f(-(float)((i & 3) + 8 * (i >> 2) + 4 * hh) * lg2);
        for (int jt = 0; jt <= w; ++jt) {
            f32x16 st;
#pragma unroll
            for (int i = 0; i < 16; ++i) st[i] = 0.f;
#pragma unroll
            for (int s = 0; s < 2; ++s) { const bf16x8 kf = *(const bf16x8*)(Ks + (32 * jt + r) * KSTR + 16 * s + 8 * hh); st = __builtin_amdgcn_mfma_f32_32x32x16_bf16(kf, qf[s], st, 0, 0, 0); }
            const float al = __builtin_amdgcn_exp2f((float)(32 * (w - jt) + r) * lg2);
            if (jt == w) {
#pragma unroll
                for (int i = 0; i < 16; ++i) { const int kr = (i & 3) + 8 * (i >> 2) + 4 * hh; st[i] = (kr <= r) ? st[i] * (al * cdec[i]) : 0.f; }
            } else {
#pragma unroll
                for (int i = 0; i < 16; ++i) st[i] *= al * cdec[i];
            }
#pragma unroll
            for (int s = 0; s < 2; ++s) {
                u32x4 pw; pw[0] = cvtpk(st[8 * s], st[8 * s + 1]); pw[1] = cvtpk(st[8 * s + 2], st[8 * s + 3]); pw[2] = cvtpk(st[8 * s + 4], st[8 * s + 5]); pw[3] = cvtpk(st[8 * s + 6], st[8 * s + 7]);
                const bf16x8 pf = __builtin_bit_cast(bf16x8, pw);
                const bf16_t* va = Vt + r * VSTR + 32 * jt + 16 * s + 4 * hh;
                const s16x4 a0 = *(const s16x4*)(va), a1 = *(const s16x4*)(va + 8), b0 = *(const s16x4*)(va + 32 * VSTR), b1 = *(const s16x4*)(va + 32 * VSTR + 8);
                o0 = __builtin_amdgcn_mfma_f32_32x32x16_bf16(__builtin_shufflevector(a0, a1, 0, 1, 2, 3, 4, 5, 6, 7), pf, o0, 0, 0, 0);
                o1 = __builtin_amdgcn_mfma_f32_32x32x16_bf16(__builtin_shufflevector(b0, b1, 0, 1, 2, 3, 4, 5, 6, 7), pf, o1, 0, 0, 0);
            }
        }
        float ss = 0.f;
#pragma unroll
        for (int i = 0; i < 16; ++i) ss += o0[i] * o0[i] + o1[i] * o1[i];
        ss = xhalf_sum(ss);
        const float rs = rsqrtf(ss * (1.0f / 64.0f) + 1e-6f);
        const float* ng = p.ret_norm_g + l * 256 + h * 64 + 4 * hh;
        const bf16_t* gp = p.pbuf + (size_t)t * NINP + PC_RG + h * 64 + 4 * hh;
        bf16_t* outp = p.mixcat + (size_t)t * 1024 + h * 64 + 4 * hh;
#pragma unroll
        for (int c = 0; c < 2; ++c)
#pragma unroll
            for (int g = 0; g < 4; ++g) {
                const int eo = 32 * c + 8 * g;
                const f32x4 gn = *(const f32x4*)(ng + eo); const uint2 gu = *(const uint2*)(gp + eo);
                const float g0 = __uint_as_float(gu.x << 16), g1 = __uint_as_float(gu.x & 0xffff0000u), g2 = __uint_as_float(gu.y << 16), g3 = __uint_as_float(gu.y & 0xffff0000u);
                const float v0 = (c ? o1[4 * g] : o0[4 * g]) * rs * gn[0], v1 = (c ? o1[4 * g + 1] : o0[4 * g + 1]) * rs * gn[1], v2 = (c ? o1[4 * g + 2] : o0[4 * g + 2]) * rs * gn[2], v3 = (c ? o1[4 * g + 3] : o0[4 * g + 3]) * rs * gn[3];
                uint2 ov; ov.x = cvtpk(g0 * sigmoidf_(g0) * v0, g1 * sigmoidf_(g1) * v1); ov.y = cvtpk(g2 * sigmoidf_(g2) * v2, g3 * sigmoidf_(g3) * v3);
                *(uint2*)(outp + eo) = ov;
            }
    }
}

__device__ __forceinline__ void ph_dil_attn(const Params& pkv, KPtr kp_in, int wbase_in, int l, char* lds) {
    PH_HEAD
    constexpr int KSTR = 72, VSTR = 68;
    bf16_t* Ks = (bf16_t*)lds;
    bf16_t* Vt = Ks + 64 * KSTR;
    const int tid = TID, lane = tid & 63, wv = tid >> 6, r = lane & 31, h = lane >> 5;
    for (int it = BID; it < 16 * 96; it += gridDim.x) {
        const int bh = it & 15, u = it >> 4;
        const int b = bh >> 2, hd = bh & 3;
        int pat, dil, rr, m0;
        if (u < 32) { pat = 0; dil = 1; rr = 0; m0 = u * 256; }
        else if (u < 64) { pat = 1; dil = 4; rr = (u - 32) >> 3; m0 = ((u - 32) & 7) * 256; }
        else { pat = 2; dil = 16; rr = (u - 64) >> 1; m0 = ((u - 64) & 1) * 256; }
        const int qmin = m0 + 32 * wv, qmax = qmin + 31, myq = qmin + r;
        const size_t tok0 = (size_t)b * SEQ + rr;
        bf16x8 qf[4];
        {
            const bf16_t* qrow = (const bf16_t*)p.dq + (tok0 + (size_t)dil * myq) * 256 + hd * 64 + 8 * h;
#pragma unroll
            for (int s = 0; s < 4; ++s) qf[s] = *(const bf16x8*)(qrow + 16 * s);
        }
        f32x16 o0, o1;
#pragma unroll
        for (int i = 0; i < 16; ++i) { o0[i] = 0.f; o1[i] = 0.f; }
        float m = -1e30f, lsum = 0.f;
        const int kk = tid >> 3, kc = tid & 7, vk = tid & 63, vc = tid >> 6;
        const bf16_t* kbase = (const bf16_t*)p.dk + hd * 64 + kc * 8;
        const bf16_t* vbase = p.pbuf + PC_DV + hd * 64 + vc * 8;
        const int j0 = (m0 == 0) ? 2 : 0;
        u32x4 rk, rv;
        {
            const int kb = m0 - 128 + 64 * j0;
            rk = *(const u32x4*)(kbase + (tok0 + (size_t)dil * (kb + kk)) * 256);
            rv = *(const u32x4*)(vbase + (tok0 + (size_t)dil * (kb + vk)) * NINP);
        }
        for (int j = j0; j < 6; ++j) {
            __syncthreads();
            *(u32x4*)(Ks + kk * KSTR + kc * 8) = rk;
            {
                const unsigned w0 = rv[0], w1 = rv[1], w2 = rv[2], w3 = rv[3];
                bf16_t* vd = Vt + (vc * 8) * VSTR + vk;
                vd[0] = (bf16_t)(w0 & 0xffff); vd[VSTR] = (bf16_t)(w0 >> 16); vd[2 * VSTR] = (bf16_t)(w1 & 0xffff); vd[3 * VSTR] = (bf16_t)(w1 >> 16);
                vd[4 * VSTR] = (bf16_t)(w2 & 0xffff); vd[5 * VSTR] = (bf16_t)(w2 >> 16); vd[6 * VSTR] = (bf16_t)(w3 & 0xffff); vd[7 * VSTR] = (bf16_t)(w3 >> 16);
            }
            __syncthreads();
            const int kb = m0 - 128 + 64 * j;
            if (j + 1 < 6) {
                const int kn = kb + 64;
                rk = *(const u32x4*)(kbase + (tok0 + (size_t)dil * (kn + kk)) * 256);
                rv = *(const u32x4*)(vbase + (tok0 + (size_t)dil * (kn + vk)) * NINP);
            }
            const bool need0 = (kb <= qmax) && (kb + 31 >= qmin - 128);
            const bool need1 = (kb + 32 <= qmax) && (kb + 63 >= qmin - 128);
            if (need0 || need1) {
                f32x16 s0, s1;
#pragma unroll
                for (int i = 0; i < 16; ++i) { s0[i] = -3e38f; s1[i] = -3e38f; }
                if (need0) {
#pragma unroll
                    for (int i = 0; i < 16; ++i) s0[i] = 0.f;
#pragma unroll
                    for (int s = 0; s < 4; ++s) { const bf16x8 kf = *(const bf16x8*)(Ks + r * KSTR + 16 * s + 8 * h); s0 = __builtin_amdgcn_mfma_f32_32x32x16_bf16(kf, qf[s], s0, 0, 0, 0); }
                    if (!((kb + 31 <= qmin) && (kb >= qmax - 128))) {
#pragma unroll
                        for (int i = 0; i < 16; ++i) { const int key = kb + (i & 3) + 8 * (i >> 2) + 4 * h; if (key > myq || key < myq - 128) s0[i] = -3e38f; }
                    }
                }
                if (need1) {
#pragma unroll
                    for (int i = 0; i < 16; ++i) s1[i] = 0.f;
#pragma unroll
                    for (int s = 0; s < 4; ++s) { const bf16x8 kf = *(const bf16x8*)(Ks + (32 + r) * KSTR + 16 * s + 8 * h); s1 = __builtin_amdgcn_mfma_f32_32x32x16_bf16(kf, qf[s], s1, 0, 0, 0); }
                    if (!((kb + 63 <= qmin) && (kb + 32 >= qmax - 128))) {
#pragma unroll
                        for (int i = 0; i < 16; ++i) { const int key = kb + 32 + (i & 3) + 8 * (i >> 2) + 4 * h; if (key > myq || key < myq - 128) s1[i] = -3e38f; }
                    }
                }
                float mx = s0[0];
#pragma unroll
                for (int i = 1; i < 16; ++i) mx = fmaxf(mx, s0[i]);
#pragma unroll
                for (int i = 0; i < 16; ++i) mx = fmaxf(mx, s1[i]);
                mx = xhalf_max(mx);
                const float mn = fmaxf(m, mx), alpha = __builtin_amdgcn_exp2f(m - mn);
                m = mn;
                float ps = 0.f;
                if (need0) {
#pragma unroll
                    for (int i = 0; i < 16; ++i) { s0[i] = __builtin_amdgcn_exp2f(s0[i] - mn); ps += s0[i]; }
                }
                if (need1) {
#pragma unroll
                    for (int i = 0; i < 16; ++i) { s1[i] = __builtin_amdgcn_exp2f(s1[i] - mn); ps += s1[i]; }
                }
                lsum = lsum * alpha + ps;
                if (!__all(alpha == 1.0f)) {
#pragma unroll
                    for (int i = 0; i < 16; ++i) { o0[i] *= alpha; o1[i] *= alpha; }
                }
                if (need0) {
#pragma unroll
                    for (int s = 0; s < 2; ++s) {
                        u32x4 pw; pw[0] = cvtpk(s0[8 * s], s0[8 * s + 1]); pw[1] = cvtpk(s0[8 * s + 2], s0[8 * s + 3]); pw[2] = cvtpk(s0[8 * s + 4], s0[8 * s + 5]); pw[3] = cvtpk(s0[8 * s + 6], s0[8 * s + 7]);
                        const bf16x8 pf = __builtin_bit_cast(bf16x8, pw);
                        const bf16_t* va = Vt + r * VSTR + 16 * s + 4 * h;
                        const s16x4 a0 = *(const s16x4*)(va), a1 = *(const s16x4*)(va + 8), b0 = *(const s16x4*)(va + 32 * VSTR), b1 = *(const s16x4*)(va + 32 * VSTR + 8);
                        o0 = __builtin_amdgcn_mfma_f32_32x32x16_bf16(__builtin_shufflevector(a0, a1, 0, 1, 2, 3, 4, 5, 6, 7), pf, o0, 0, 0, 0);
                        o1 = __builtin_amdgcn_mfma_f32_32x32x16_bf16(__builtin_shufflevector(b0, b1, 0, 1, 2, 3, 4, 5, 6, 7), pf, o1, 0, 0, 0);
                    }
                }
                if (need1) {
#pragma unroll
                    for (int s = 0; s < 2; ++s) {
                        u32x4 pw; pw[0] = cvtpk(s1[8 * s], s1[8 * s + 1]); pw[1] = cvtpk(s1[8 * s + 2], s1[8 * s + 3]); pw[2] = cvtpk(s1[8 * s + 4], s1[8 * s + 5]); pw[3] = cvtpk(s1[8 * s + 6], s1[8 * s + 7]);
                        const bf16x8 pf = __builtin_bit_cast(bf16x8, pw);
                        const bf16_t* va = Vt + r * VSTR + 32 + 16 * s + 4 * h;
                        const s16x4 a0 = *(const s16x4*)(va), a1 = *(const s16x4*)(va + 8), b0 = *(const s16x4*)(va + 32 * VSTR), b1 = *(const s16x4*)(va + 32 * VSTR + 8);
                        o0 = __builtin_amdgcn_mfma_f32_32x32x16_bf16(__builtin_shufflevector(a0, a1, 0, 1, 2, 3, 4, 5, 6, 7), pf, o0, 0, 0, 0);
                        o1 = __builtin_amdgcn_mfma_f32_32x32x16_bf16(__builtin_shufflevector(b0, b1, 0, 1, 2, 3, 4, 5, 6, 7), pf, o1, 0, 0, 0);
                    }
                }
            }
        }
        const float lt = xhalf_sum(lsum), inv = 1.0f / lt;
        const size_t tq = tok0 + (size_t)dil * myq;
        float* op = p.dob + ((size_t)pat * NT + tq) * 256 + hd * 64 + 4 * h;
#pragma unroll
        for (int g = 0; g < 4; ++g) {
            *(f32x4*)(op + 8 * g) = (f32x4){o0[4 * g] * inv, o0[4 * g + 1] * inv, o0[4 * g + 2] * inv, o0[4 * g + 3] * inv};
            *(f32x4*)(op + 32 + 8 * g) = (f32x4){o1[4 * g] * inv, o1[4 * g + 1] * inv, o1[4 * g + 2] * inv, o1[4 * g + 3] * inv};
        }
        if (h == 0) p.dlse[((size_t)pat * NT + tq) * 4 + hd] = m + __builtin_amdgcn_logf(lt);
        __syncthreads();
    }
}

__device__ __forceinline__ void ph_rwkv_prep(const Params& pkv, KPtr kp_in, int wbase_in, int l, char* lds) {
    PH_HEAD
    bf16_t* Aw = (bf16_t*)lds; bf16_t* Aa = Aw + 64 * 72; bf16_t* Ag = Aa + 64 * 72; bf16_t* Av = Ag + 64 * 136; float* ssq = (float*)(Av + 64 * 40);
    const int tid = TID, lane = tid & 63, wv = tid >> 6, fr = lane & 15, fq = lane >> 4;
    const int lm = (l > 0) ? l - 1 : 0;
    const float* mu = p.rwkv_mu + l * 1024; const float* vmu = p.vres_mu + lm * 32;
    bf16x8 fw[2][2], fa[2][2], fg[2][4], fv[2];
#pragma unroll
    for (int ni = 0; ni < 2; ++ni) {
        const int n = 32 * wv + 16 * ni + fr;
#pragma unroll
        for (int ks = 0; ks < 2; ++ks) { fw[ni][ks] = *(const bf16x8*)(p.wupt + ((size_t)l * 256 + n) * 64 + 32 * ks + 8 * fq); fa[ni][ks] = *(const bf16x8*)(p.aupt + ((size_t)l * 256 + n) * 64 + 32 * ks + 8 * fq); }
#pragma unroll
        for (int ks = 0; ks < 4; ++ks) fg[ni][ks] = *(const bf16x8*)(p.gupt + ((size_t)l * 256 + n) * 128 + 32 * ks + 8 * fq);
        fv[ni] = *(const bf16x8*)(p.vupt + ((size_t)lm * 256 + n) * 32 + 8 * fq);
    }
    for (int tb = BID * 64; tb < NT; tb += gridDim.x * 64) {
        __syncthreads();
        for (int e = tid; e < 64 * 144; e += NTHREADS) {
            const int tt = e / 144, j = (e % 144) * 2, t = tb + tt;
            const bool first = (t % SEQ) == 0;
            const bf16_t* pr = p.pbuf + (size_t)t * NINP;
            int col; float m0, m1;
            if (j < 256) { col = PC_CWD + j; m0 = mu[768 + j]; m1 = mu[768 + j + 1]; } else { col = PC_VRES + (j - 256); m0 = vmu[j - 256]; m1 = vmu[j - 255]; }
            const unsigned cu = *(const unsigned*)(pr + col), pu = first ? 0u : *(const unsigned*)(pr + col - NINP);
            const float c0 = __uint_as_float(cu << 16), c1 = __uint_as_float(cu & 0xffff0000u), p0 = __uint_as_float(pu << 16), p1 = __uint_as_float(pu & 0xffff0000u);
            float x0 = c0 + (p0 - c0) * m0, x1 = c1 + (p1 - c1) * m1;
            bf16_t* dst;
            if (j < 64) { x0 = tanhf(x0); x1 = tanhf(x1); dst = Aw + tt * 72 + j; }
            else if (j < 128) { dst = Aa + tt * 72 + (j - 64); }
            else if (j < 256) { x0 = sigmoidf_(x0); x1 = sigmoidf_(x1); dst = Ag + tt * 136 + (j - 128); }
            else { dst = Av + tt * 40 + (j - 256); }
            *(unsigned*)dst = cvtpk(x0, x1);
        }
        {
            const f32x4 kkc = *(const f32x4*)(p.rwkv_k_k + l * 256 + lane * 4), mk4 = *(const f32x4*)(mu + 256 + lane * 4);
#pragma unroll
            for (int i = 0; i < 8; ++i) {
                const int tt = wv * 8 + i, t = tb + tt; const bool first = (t % SEQ) == 0;
                const bf16_t* pr = p.pbuf + (size_t)t * NINP + PC_CK + lane * 4;
                const uint2 cu = *(const uint2*)pr; const uint2 pu = first ? make_uint2(0u, 0u) : *(const uint2*)(pr - NINP);
                const float c0 = __uint_as_float(cu.x << 16), c1 = __uint_as_float(cu.x & 0xffff0000u), c2 = __uint_as_float(cu.y << 16), c3 = __uint_as_float(cu.y & 0xffff0000u);
                const float q0 = __uint_as_float(pu.x << 16), q1 = __uint_as_float(pu.x & 0xffff0000u), q2 = __uint_as_float(pu.y << 16), q3 = __uint_as_float(pu.y & 0xffff0000u);
                const float k0 = (c0 + (q0 - c0) * mk4[0]) * kkc[0], k1 = (c1 + (q1 - c1) * mk4[1]) * kkc[1], k2 = (c2 + (q2 - c2) * mk4[2]) * kkc[2], k3 = (c3 + (q3 - c3) * mk4[3]) * kkc[3];
                const float ss = grp16_sum(k0 * k0 + k1 * k1 + k2 * k2 + k3 * k3);
                if ((lane & 15) == 0) ssq[tt * 4 + (lane >> 4)] = ss;
            }
        }
        __syncthreads();
#pragma unroll 1
        for (int mt = 0; mt < 4; ++mt) {
            f32x4 cw[2], ca[2], cg[2], cv[2];
#pragma unroll
            for (int ni = 0; ni < 2; ++ni) { cw[ni] = (f32x4){0.f, 0.f, 0.f, 0.f}; ca[ni] = cw[ni]; cg[ni] = cw[ni]; cv[ni] = cw[ni]; }
            const int arow = 16 * mt + fr;
#pragma unroll
            for (int ks = 0; ks < 2; ++ks) {
                const bf16x8 xw = *(const bf16x8*)(Aw + arow * 72 + 32 * ks + 8 * fq), xa = *(const bf16x8*)(Aa + arow * 72 + 32 * ks + 8 * fq);
#pragma unroll
                for (int ni = 0; ni < 2; ++ni) { cw[ni] = __builtin_amdgcn_mfma_f32_16x16x32_bf16(fw[ni][ks], xw, cw[ni], 0, 0, 0); ca[ni] = __builtin_amdgcn_mfma_f32_16x16x32_bf16(fa[ni][ks], xa, ca[ni], 0, 0, 0); }
            }
#pragma unroll
            for (int ks = 0; ks < 4; ++ks) {
                const bf16x8 xg = *(const bf16x8*)(Ag + arow * 136 + 32 * ks + 8 * fq);
#pragma unroll
                for (int ni = 0; ni < 2; ++ni) cg[ni] = __builtin_amdgcn_mfma_f32_16x16x32_bf16(fg[ni][ks], xg, cg[ni], 0, 0, 0);
            }
            if (l > 0) {
                const bf16x8 xv = *(const bf16x8*)(Av + arow * 40 + 8 * fq);
#pragma unroll
                for (int ni = 0; ni < 2; ++ni) cv[ni] = __builtin_amdgcn_mfma_f32_16x16x32_bf16(fv[ni], xv, cv[ni], 0, 0, 0);
            }
            const int tt = 16 * mt + fr, t = tb + tt; const bool first = (t % SEQ) == 0;
            const float rn = 1.0f / fmaxf(sqrtf(ssq[tt * 4 + (wv >> 1)]), 1e-12f);
            const bf16_t* pr = p.pbuf + (size_t)t * NINP;
#pragma unroll
            for (int ni = 0; ni < 2; ++ni) {
                const int c0 = 32 * wv + 16 * ni + 4 * fq;
                const f32x4 w0 = *(const f32x4*)(p.rwkv_w0 + l * 256 + c0), a0 = *(const f32x4*)(p.rwkv_a0 + l * 256 + c0), kkc = *(const f32x4*)(p.rwkv_k_k + l * 256 + c0), kac = *(const f32x4*)(p.rwkv_k_a + l * 256 + c0);
                const f32x4 v0 = *(const f32x4*)(p.rwkv_v0 + lm * 256 + c0), mr = *(const f32x4*)(mu + c0), mk = *(const f32x4*)(mu + 256 + c0), mv = *(const f32x4*)(mu + 512 + c0);
                const uint2 ru = *(const uint2*)(pr + PC_CR + c0), ku = *(const uint2*)(pr + PC_CK + c0), vu = *(const uint2*)(pr + PC_CV + c0);
                uint2 rp = make_uint2(0u, 0u), kp2 = rp, vp = rp;
                if (!first) { rp = *(const uint2*)(pr + PC_CR + c0 - NINP); kp2 = *(const uint2*)(pr + PC_CK + c0 - NINP); vp = *(const uint2*)(pr + PC_CV + c0 - NINP); }
                const size_t o = (size_t)t * 256 + c0;
                f32x4 vf = (f32x4){0.f, 0.f, 0.f, 0.f};
                if (l > 0) vf = *(const f32x4*)(p.vfirst + o);
                f32x4 o_r, o_w, o_k, o_v, o_a, o_b;
#pragma unroll
                for (int j = 0; j < 4; ++j) {
                    const unsigned rw = (j < 2) ? ru.x : ru.y, kw = (j < 2) ? ku.x : ku.y, vw = (j < 2) ? vu.x : vu.y, rpw = (j < 2) ? rp.x : rp.y, kpw = (j < 2) ? kp2.x : kp2.y, vpw = (j < 2) ? vp.x : vp.y;
                    const float rc = (j & 1) ? __uint_as_float(rw & 0xffff0000u) : __uint_as_float(rw << 16), kc = (j & 1) ? __uint_as_float(kw & 0xffff0000u) : __uint_as_float(kw << 16), vc = (j & 1) ? __uint_as_float(vw & 0xffff0000u) : __uint_as_float(vw << 16);
                    const float rq = (j & 1) ? __uint_as_float(rpw & 0xffff0000u) : __uint_as_float(rpw << 16), kq = (j & 1) ? __uint_as_float(kpw & 0xffff0000u) : __uint_as_float(kpw << 16), vq = (j & 1) ? __uint_as_float(vpw & 0xffff0000u) : __uint_as_float(vpw << 16);
                    const float r = rc + (rq - rc) * mr[j], k = kc + (kq - kc) * mk[j];
                    float v = vc + (vq - vc) * mv[j];
                    const float wpre = w0[j] + cw[ni][j];
                    const float sp = (-wpre > 20.f) ? -wpre : log1pf(__expf(-wpre));
                    const float decay = __expf(-__expf(-sp - 0.5f));
                    const float a = sigmoidf_(a0[j] + ca[ni][j]);
                    const float kk = k * kkc[j] * rn;
                    const float k2 = k * (1.0f + (a - 1.0f) * kac[j]);
                    if (l == 0) vf[j] = v; else v = v + (vf[j] - v) * sigmoidf_(v0[j] + cv[ni][j]);
                    o_r[j] = r; o_w[j] = decay; o_k[j] = k2; o_v[j] = v; o_a[j] = -kk; o_b[j] = kk * a;
                }
                if (l == 0) *(f32x4*)(p.vfirst + o) = vf;
                *(f32x4*)(p.sr + o) = o_r; *(f32x4*)(p.sw + o) = o_w; *(f32x4*)(p.sk + o) = o_k; *(f32x4*)(p.sv + o) = o_v; *(f32x4*)(p.sa + o) = o_a; *(f32x4*)(p.sb + o) = o_b; *(f32x4*)(p.sg + o) = cg[ni];
            }
        }
    }
}

#define MF4(a, b, c) __builtin_amdgcn_mfma_f32_16x16x4f32((a), (b), (c), 0, 0, 0)
#define WSYNC() asm volatile("s_waitcnt lgkmcnt(0)" ::: "memory")
__device__ __forceinline__ f32x4 mm16(const float* A, int sam, int sak, const float* B, int sbk, int sbn, int K, f32x4 acc, int fr, int fq) {
#pragma unroll 4
    for (int kk = 0; kk < K; kk += 4) { const float a = A[fr * sam + (kk + fq) * sak]; const float b = B[(kk + fq) * sbk + fr * sbn]; acc = MF4(a, b, acc); }
    return acc;
}
constexpr int CH_T = 16, CH_N = SEQ / CH_T, CH_LD = 68, CH_WAVE_FLOATS = 6 * 16 * CH_LD + 5 * 16 * 17 + 64;
__device__ __forceinline__ void ph_rwkv_chunkpre(const Params& pkv, KPtr kp_in, int wbase_in, int l, char* lds) {
    PH_HEAD
    const int tid = TID, lane = tid & 63, wv = tid >> 6, fr = lane & 15, fq = lane >> 4;
    if (wv >= 4) return;
    float* L = (float*)lds + wv * CH_WAVE_FLOATS;
    float* At = L; float* Bt = At + 16 * CH_LD; float* Kt = Bt + 16 * CH_LD; float* Rt = Kt + 16 * CH_LD; float* Vv = Rt + 16 * CH_LD; float* W1 = Vv + 16 * CH_LD;
    float* Pst = (float*)lds + 4 * CH_WAVE_FLOATS + wv * 1024;
    float* Aab = W1 + 16 * CH_LD; float* Aak = Aab + 16 * 17; float* Arb = Aak + 16 * 17; float* Ark = Arb + 16 * 17; float* Mm = Ark + 16 * 17; float* gT = Mm + 16 * 17;
    const f32x4 z4 = (f32x4){0.f, 0.f, 0.f, 0.f};
    for (int u = BID * 4 + wv; u < 16 * CH_N; u += gridDim.x * 4) {
        const int bh = u / CH_N, c = u % CH_N, b = bh >> 2, hd = bh & 3;
        const size_t o0 = ((size_t)b * SEQ + (size_t)c * CH_T) * 256 + hd * 64 + lane;
        WSYNC();
        {
            float g = 1.0f;
#pragma unroll
            for (int t = 0; t < CH_T; ++t) {
                const size_t o = o0 + (size_t)t * 256;
                const float w = p.sw[o], a = p.sa[o], bb = p.sb[o], k = p.sk[o], r = p.sr[o], v = p.sv[o];
                const float gp = g; g *= w; const float ig = 1.0f / g;
                At[t * CH_LD + lane] = a * gp; Bt[t * CH_LD + lane] = bb * ig; Kt[t * CH_LD + lane] = k * ig; Rt[t * CH_LD + lane] = r * g; Vv[t * CH_LD + lane] = v;
            }
            gT[lane] = g;
        }
        WSYNC();
        {
            f32x4 gab = z4, gak = z4, grb = z4, grk = z4;
#pragma unroll 4
            for (int kk = 0; kk < 64; kk += 4) {
                const int o = fr * CH_LD + kk + fq;
                const float aA = At[o], aR = Rt[o], bB = Bt[o], bK = Kt[o];
                gab = MF4(aA, bB, gab); gak = MF4(aA, bK, gak); grb = MF4(aR, bB, grb); grk = MF4(aR, bK, grk);
            }
#pragma unroll
            for (int rg = 0; rg < 4; ++rg) {
                const int t = 4 * fq + rg, s = fr;
                Aab[t * 17 + s] = (s < t) ? gab[rg] : 0.f; Aak[t * 17 + s] = (s < t) ? gak[rg] : 0.f;
                Arb[t * 17 + s] = (s <= t) ? grb[rg] : 0.f; Ark[t * 17 + s] = (s <= t) ? grk[rg] : 0.f;
            }
        }
        WSYNC();
        {
            float m[16];
#pragma unroll
            for (int t = 0; t < 16; ++t) {
                float acc = (t == fr) ? 1.0f : 0.f;
#pragma unroll
                for (int s = 0; s < t; ++s) acc += Aab[t * 17 + s] * m[s];
                m[t] = acc;
            }
            if (fq == 0) {
#pragma unroll
                for (int t = 0; t < 16; ++t) Mm[t * 17 + fr] = m[t];
            }
        }
        WSYNC();
        {
            f32x4 m2 = z4, ah[4] = {z4, z4, z4, z4};
#pragma unroll
            for (int kk = 0; kk < 16; kk += 4) {
                const float a = Mm[fr * 17 + kk + fq];
                m2 = MF4(a, Aak[(kk + fq) * 17 + fr], m2);
#pragma unroll
                for (int nt = 0; nt < 4; ++nt) ah[nt] = MF4(a, At[(kk + fq) * CH_LD + 16 * nt + fr], ah[nt]);
            }
            WSYNC();
#pragma unroll
            for (int rg = 0; rg < 4; ++rg) {
                Aak[(4 * fq + rg) * 17 + fr] = m2[rg];
#pragma unroll
                for (int nt = 0; nt < 4; ++nt) At[(4 * fq + rg) * CH_LD + 16 * nt + fr] = ah[nt][rg];
            }
            WSYNC();
            f32x4 w1[4] = {z4, z4, z4, z4};
#pragma unroll
            for (int kk = 0; kk < 16; kk += 4) {
                const float a = Aak[fr * 17 + kk + fq];
#pragma unroll
                for (int nt = 0; nt < 4; ++nt) w1[nt] = MF4(a, Vv[(kk + fq) * CH_LD + 16 * nt + fr], w1[nt]);
            }
#pragma unroll
            for (int nt = 0; nt < 4; ++nt)
#pragma unroll
                for (int rg = 0; rg < 4; ++rg) W1[(4 * fq + rg) * CH_LD + 16 * nt + fr] = w1[nt][rg];
        }
        WSYNC();
        {
            float* rh = p.c_rh + (size_t)u * 1024; float* y1 = p.c_y1 + (size_t)u * 1024;
            f32x4 ar[4], yy[4];
#pragma unroll
            for (int nt = 0; nt < 4; ++nt) {
                yy[nt] = z4;
#pragma unroll
                for (int rg = 0; rg < 4; ++rg) ar[nt][rg] = Rt[(4 * fq + rg) * CH_LD + 16 * nt + fr];
            }
#pragma unroll
            for (int kk = 0; kk < 16; kk += 4) {
                const float arb = Arb[fr * 17 + kk + fq], ark = Ark[fr * 17 + kk + fq];
#pragma unroll
                for (int nt = 0; nt < 4; ++nt) {
                    const int bo = (kk + fq) * CH_LD + 16 * nt + fr;
                    ar[nt] = MF4(arb, At[bo], ar[nt]); yy[nt] = MF4(arb, W1[bo], yy[nt]); yy[nt] = MF4(ark, Vv[bo], yy[nt]);
                }
            }
#pragma unroll
            for (int nt = 0; nt < 4; ++nt)
#pragma unroll
                for (int rg = 0; rg < 4; ++rg) { rh[(4 * fq + rg) * 64 + 16 * nt + fr] = ar[nt][rg]; y1[(4 * fq + rg) * 64 + 16 * nt + fr] = yy[nt][rg]; }
        }
        {
            float* pp = p.c_p + (size_t)u * 4096; float* qq = p.c_q + (size_t)u * 4096;
#pragma unroll 1
            for (int jt = 0; jt < 4; ++jt) {
                f32x4 ap[4] = {z4, z4, z4, z4}, aq[4] = {z4, z4, z4, z4};
#pragma unroll
                for (int kk = 0; kk < 16; kk += 4) {
                    const int ao = (kk + fq) * CH_LD + 16 * jt + fr;
                    const float a_ah = At[ao], a_w1 = W1[ao], a_v = Vv[ao];
#pragma unroll
                    for (int jc = 0; jc < 4; ++jc) {
                        const int bo = (kk + fq) * CH_LD + 16 * jc + fr;
                        const float b_bt = Bt[bo], b_kt = Kt[bo];
                        ap[jc] = MF4(a_ah, b_bt, ap[jc]); aq[jc] = MF4(a_w1, b_bt, aq[jc]); aq[jc] = MF4(a_v, b_kt, aq[jc]);
                    }
                }
                WSYNC();
#pragma unroll
                for (int jc = 0; jc < 4; ++jc) {
                    const float gc = gT[16 * jc + fr];
#pragma unroll
                    for (int rg = 0; rg < 4; ++rg) {
                        const int row = 16 * jt + 4 * fq + rg, col = 16 * jc + fr;
                        Pst[(jc * 64 + 16 * rg + fr) * 4 + fq] = (ap[jc][rg] + ((row == col) ? 1.0f : 0.f)) * gc; qq[row * 64 + col] = aq[jc][rg] * gc;
                    }
                }
                WSYNC();
#pragma unroll
                for (int i = 0; i < 4; ++i) *(f32x4*)(pp + ((jt * 4 + i) * 64 + lane) * 4) = *(const f32x4*)(Pst + (i * 64 + lane) * 4);
            }
        }
    }
}

constexpr int SCANB_BLOCKS = 64;
__device__ __forceinline__ void ph_rwkv_scan(const Params& pkv, KPtr kp_in, int wbase_in, int l, char* lds) {
    PH_HEAD
    if (BID >= SCANB_BLOCKS) return;
    const int tid = TID, lane = tid & 63, wv = tid >> 6, fr = lane & 15, fq = lane >> 4, w = wv & 3;
    const int sid = BID, bh = sid >> 2, ib = sid & 3, b = bh >> 2, hd = bh & 3, ibase = ib * 16;
    float* exch = (float*)lds;
    float* ypart = (float*)lds + 4096;
    for (int i = tid; i < 8192; i += NTHREADS) ((float*)lds)[i] = 0.f;
    if (wv >= 4) {
        __syncthreads();
        for (int c = 0; c < CH_N; ++c) { __builtin_amdgcn_s_barrier(); }
        return;
    }
    f32x4 cur = (f32x4){0.f, 0.f, 0.f, 0.f};
    const size_t ubase = (size_t)bh * CH_N;
    f32x4 pa[4][4]; f32x4 qv[4], rh[4]; float y1v[4];
#define SCAN_LOAD(S, cc) do { const size_t un_ = ubase + ((cc) < CH_N ? (cc) : CH_N - 1); \
        const f32x4* pp_ = (const f32x4*)(p.c_p + un_ * 4096 + (w * 64 + lane) * 4); \
        pa[S][0] = pp_[0]; pa[S][1] = pp_[256]; pa[S][2] = pp_[512]; pa[S][3] = pp_[768]; \
        qv[S] = *(const f32x4*)(p.c_q + un_ * 4096 + (ibase + fr) * 64 + 16 * w + 4 * fq); \
        rh[S] = *(const f32x4*)(p.c_rh + un_ * 1024 + fr * 64 + 16 * w + 4 * fq); \
        y1v[S] = p.c_y1[un_ * 1024 + (4 * w + fq) * 64 + ibase + fr]; } while (0)
#define SCAN_STEP(S, cc) do { const int bufo = ((cc) & 1) * 2048; \
        float exv[16]; { const float* ex = exch + bufo; _Pragma("unroll") for (int kk = 0; kk < 16; ++kk) exv[kk] = ex[64 * kk + lane]; } \
        __builtin_amdgcn_sched_barrier(0); \
        f32x4 yp = (f32x4){0.f, 0.f, 0.f, 0.f}; \
        _Pragma("unroll") for (int rg = 0; rg < 4; ++rg) yp = MF4(rh[S][rg], cur[rg], yp); \
        asm volatile("s_waitcnt lgkmcnt(0)" ::: "memory"); __builtin_amdgcn_sched_barrier(0); \
        f32x4 acc0 = qv[S], acc1 = (f32x4){0.f, 0.f, 0.f, 0.f}; \
        _Pragma("unroll") for (int kq = 0; kq < 4; ++kq) { \
            acc0 = MF4(pa[S][kq][0], exv[4 * kq], acc0); acc1 = MF4(pa[S][kq][1], exv[4 * kq + 1], acc1); \
            acc0 = MF4(pa[S][kq][2], exv[4 * kq + 2], acc0); acc1 = MF4(pa[S][kq][3], exv[4 * kq + 3], acc1); } \
        cur = acc0 + acc1; \
        { float* yd = ypart + bufo + w * 256; _Pragma("unroll") for (int rg = 0; rg < 4; ++rg) yd[(4 * fq + rg) * 16 + fr] = yp[rg]; } \
        { float* ed = exch + (2048 - bufo) + (16 * w) * 16; _Pragma("unroll") for (int rg = 0; rg < 4; ++rg) ed[(4 * fq + rg) * 16 + fr] = cur[rg]; } \
        asm volatile("s_waitcnt lgkmcnt(0)" ::: "memory"); __builtin_amdgcn_s_barrier(); asm volatile("" ::: "memory"); \
        { const float* ys = ypart + bufo + (4 * w + fq) * 16 + fr; const float y = (ys[0] + ys[256]) + (ys[512] + ys[768]) + y1v[S]; \
          p.sy[((size_t)b * SEQ + (size_t)(cc) * CH_T + 4 * w + fq) * 256 + hd * 64 + ibase + fr] = y; } \
        SCAN_LOAD(S, (cc) + 4); } while (0)
    SCAN_LOAD(0, 0); SCAN_LOAD(1, 1); SCAN_LOAD(2, 2); SCAN_LOAD(3, 3);
    __syncthreads();
    for (int c = 0; c < CH_N; c += 4) { SCAN_STEP(0, c); SCAN_STEP(1, c + 1); SCAN_STEP(2, c + 2); SCAN_STEP(3, c + 3); }
}

__device__ __forceinline__ void ph_mla_up(const Params& pkv, KPtr kp_in, int wbase_in, int l, char* lds) {
    PH_HEAD
    const int nq = (NT / 128) * 3, nkv = (NT / 128) * 4;
    for (int u = BID; u < nq + nkv; u += gridDim.x) {
        if (u < nq) {
            const int mt = u / 3, nt = u % 3;
            float* out = p.qu + (size_t)mt * 128 * 384 + nt * 128; const float* rs = p.rsq + mt * 128;
            gemm_tile128(p.pbuf + (size_t)mt * 128 * NINP + PC_MQ, NINP, nullptr, 128, p.wq_t + ((size_t)l * 384 + nt * 128) * 256, 256, 256, lds, TID,
                         [=](int r, int c, f32x4 v) mutable { const float s = rs[r]; *(f32x4*)(out + (size_t)r * 384 + c) = v * s; });
        } else {
            const int uu = u - nq, mt = uu / 4, nt = uu % 4;
            float* out = p.kvu + (size_t)mt * 128 * 512 + nt * 128; const float* rs = p.rskv + mt * 128;
            gemm_tile128(p.pbuf + (size_t)mt * 128 * NINP + PC_MKV, NINP, nullptr, 128, p.wkv_t + ((size_t)l * 512 + nt * 128) * 128, 128, 128, lds, TID,
                         [=](int r, int c, f32x4 v) mutable { const float s = rs[r]; *(f32x4*)(out + (size_t)r * 512 + c) = v * s; });
        }
    }
}

__device__ __forceinline__ void ph_mla_pack(const Params& pkv, KPtr kp_in, int wbase_in, int l) {
    PH_HEAD
    const int lane = TID & 63, gw = BID * (NTHREADS / 64) + (TID >> 6), nw = gridDim.x * (NTHREADS / 64);
    const float SC = 0.10206207261596575f * 1.4426950408889634f;
    for (int t = gw; t < NT; t += nw) {
        const int pos = t % SEQ;
        const float* qp = p.qu + (size_t)t * 384; const float* kvp = p.kvu + (size_t)t * 512; const float* kp2 = p.kpe + (size_t)t * 32;
        bf16_t* mq = p.mq + (size_t)t * 384; bf16_t* mk = p.mk + (size_t)t * 384; bf16_t* mv = p.mv + (size_t)t * 256;
        for (int e = lane; e < 384; e += 64) {
            const int hd = e / 96, d = e % 96;
            float qv, kv;
            if (d < 64) { qv = qp[e]; kv = kvp[hd * 128 + d]; }
            else {
                const int i = (d - 64) & 15; const float c = p.tab_mla[(pos * 16 + i) * 2], sn = p.tab_mla[(pos * 16 + i) * 2 + 1];
                const float x1 = qp[hd * 96 + 64 + i], x2 = qp[hd * 96 + 80 + i];
                qv = (d < 80) ? (x1 * c - x2 * sn) : (x1 * sn + x2 * c);
                kv = kp2[d - 64];
            }
            mq[e] = f2bf(qv * SC); mk[e] = f2bf(kv);
        }
        for (int e = lane; e < 256; e += 64) mv[e] = f2bf(kvp[(e >> 6) * 128 + 64 + (e & 63)]);
    }
}

__device__ __forceinline__ void ph_mla_attn(const Params& pkv, KPtr kp_in, int wbase_in, int l, char* lds) {
    PH_HEAD
    constexpr int KSTR = 104, VSTR = 68;
    bf16_t* Ks = (bf16_t*)lds;
    bf16_t* Vt = Ks + 64 * KSTR;
    const int tid = TID, lane = tid & 63, wv = tid >> 6, r = lane & 31, h = lane >> 5;
    int* wq = p.wq + l * 16;
    volatile int* wslot = (volatile int*)(lds + 24576);
    for (;;) {
        __syncthreads();
        if (tid == 0) *wslot = atomicAdd(wq, 1);
        __syncthreads();
        const int it = __builtin_amdgcn_readfirstlane(*wslot);
        if (it >= 16 * 32) break;
        const int bh = it & 15, qb = 31 - (it >> 4);
        const int b = bh >> 2, hd = bh & 3, q0 = qb * 256;
        const int qmin = q0 + 32 * wv, qmax = qmin + 31, myq = qmin + r;
        bf16x8 qf[6];
        {
            const bf16_t* qrow = p.mq + ((size_t)(b * SEQ + myq) * 4 + hd) * 96 + 8 * h;
#pragma unroll
            for (int s = 0; s < 6; ++s) qf[s] = *(const bf16x8*)(qrow + 16 * s);
        }
        f32x16 o0, o1;
#pragma unroll
        for (int i = 0; i < 16; ++i) { o0[i] = 0.f; o1[i] = 0.f; }
        float m = -1e30f, lsum = 0.f;
        const int nkt = (q0 + 256) / 64;
        const int kk0 = tid / 12, kc0 = tid % 12, kk1 = (tid + 512) / 12, kc1 = (tid + 512) % 12;
        const int vk = tid & 63, vc = tid >> 6;
        const bf16_t* kbase = p.mk + ((size_t)b * SEQ * 4 + hd) * 96;
        const bf16_t* vbase = p.mv + ((size_t)b * SEQ * 4 + hd) * 64;
        u32x4 rk0, rk1, rv;
        rk0 = *(const u32x4*)(kbase + (size_t)kk0 * 384 + kc0 * 8);
        rk1 = (tid < 256) ? *(const u32x4*)(kbase + (size_t)kk1 * 384 + kc1 * 8) : (u32x4){0u, 0u, 0u, 0u};
        rv = *(const u32x4*)(vbase + (size_t)vk * 256 + vc * 8);
        for (int kt = 0; kt < nkt; ++kt) {
            __syncthreads();
            *(u32x4*)(Ks + kk0 * KSTR + kc0 * 8) = rk0;
            if (tid < 256) *(u32x4*)(Ks + kk1 * KSTR + kc1 * 8) = rk1;
            {
                const unsigned w0 = rv[0], w1 = rv[1], w2 = rv[2], w3 = rv[3];
                bf16_t* vd = Vt + (vc * 8) * VSTR + vk;
                vd[0] = (bf16_t)(w0 & 0xffff); vd[VSTR] = (bf16_t)(w0 >> 16); vd[2 * VSTR] = (bf16_t)(w1 & 0xffff); vd[3 * VSTR] = (bf16_t)(w1 >> 16);
                vd[4 * VSTR] = (bf16_t)(w2 & 0xffff); vd[5 * VSTR] = (bf16_t)(w2 >> 16); vd[6 * VSTR] = (bf16_t)(w3 & 0xffff); vd[7 * VSTR] = (bf16_t)(w3 >> 16);
            }
            __syncthreads();
            if (kt + 1 < nkt) {
                const size_t ko = (size_t)(kt + 1) * 64;
                rk0 = *(const u32x4*)(kbase + (ko + kk0) * 384 + kc0 * 8);
                if (tid < 256) rk1 = *(const u32x4*)(kbase + (ko + kk1) * 384 + kc1 * 8);
                rv = *(const u32x4*)(vbase + (ko + vk) * 256 + vc * 8);
            }
            const int kb = kt * 64;
            if (kb <= qmax) {
                const bool need1 = (kb + 32 <= qmax);
                f32x16 s0, s1;
#pragma unroll
                for (int i = 0; i < 16; ++i) { s0[i] = 0.f; s1[i] = -1e30f; }
#pragma unroll
                for (int s = 0; s < 6; ++s) { const bf16x8 kf = *(const bf16x8*)(Ks + r * KSTR + 16 * s + 8 * h); s0 = __builtin_amdgcn_mfma_f32_32x32x16_bf16(kf, qf[s], s0, 0, 0, 0); }
                if (need1) {
#pragma unroll
                    for (int i = 0; i < 16; ++i) s1[i] = 0.f;
#pragma unroll
                    for (int s = 0; s < 6; ++s) { const bf16x8 kf = *(const bf16x8*)(Ks + (32 + r) * KSTR + 16 * s + 8 * h); s1 = __builtin_amdgcn_mfma_f32_32x32x16_bf16(kf, qf[s], s1, 0, 0, 0); }
                }
                if (kb + 63 > qmin) {
#pragma unroll
                    for (int i = 0; i < 16; ++i) {
                        const int key = kb + (i & 3) + 8 * (i >> 2) + 4 * h;
                        if (key > myq) s0[i] = -1e30f;
                        if (key + 32 > myq) s1[i] = -1e30f;
                    }
                }
                float mx = s0[0];
#pragma unroll
                for (int i = 1; i < 16; ++i) mx = fmaxf(mx, s0[i]);
#pragma unroll
                for (int i = 0; i < 16; ++i) mx = fmaxf(mx, s1[i]);
                mx = xhalf_max(mx);
                const float mn = fmaxf(m, mx), alpha = __builtin_amdgcn_exp2f(m - mn);
                m = mn;
                float ps = 0.f;
#pragma unroll
                for (int i = 0; i < 16; ++i) { s0[i] = __builtin_amdgcn_exp2f(s0[i] - mn); ps += s0[i]; }
                if (need1) {
#pragma unroll
                    for (int i = 0; i < 16; ++i) { s1[i] = __builtin_amdgcn_exp2f(s1[i] - mn); ps += s1[i]; }
                }
                lsum = lsum * alpha + ps;
                if (!__all(alpha == 1.0f)) {
#pragma unroll
                    for (int i = 0; i < 16; ++i) { o0[i] *= alpha; o1[i] *= alpha; }
                }
#pragma unroll
                for (int s = 0; s < 2; ++s) {
                    u32x4 pw; pw[0] = cvtpk(s0[8 * s], s0[8 * s + 1]); pw[1] = cvtpk(s0[8 * s + 2], s0[8 * s + 3]); pw[2] = cvtpk(s0[8 * s + 4], s0[8 * s + 5]); pw[3] = cvtpk(s0[8 * s + 6], s0[8 * s + 7]);
                    const bf16x8 pf = __builtin_bit_cast(bf16x8, pw);
                    const bf16_t* va = Vt + r * VSTR + 16 * s + 4 * h;
                    const s16x4 a0 = *(const s16x4*)(va), a1 = *(const s16x4*)(va + 8), b0 = *(const s16x4*)(va + 32 * VSTR), b1 = *(const s16x4*)(va + 32 * VSTR + 8);
                    o0 = __builtin_amdgcn_mfma_f32_32x32x16_bf16(__builtin_shufflevector(a0, a1, 0, 1, 2, 3, 4, 5, 6, 7), pf, o0, 0, 0, 0);
                    o1 = __builtin_amdgcn_mfma_f32_32x32x16_bf16(__builtin_shufflevector(b0, b1, 0, 1, 2, 3, 4, 5, 6, 7), pf, o1, 0, 0, 0);
                }
                if (need1) {
#pragma unroll
                    for (int s = 0; s < 2; ++s) {
                        u32x4 pw; pw[0] = cvtpk(s1[8 * s], s1[8 * s + 1]); pw[1] = cvtpk(s1[8 * s + 2], s1[8 * s + 3]); pw[2] = cvtpk(s1[8 * s + 4], s1[8 * s + 5]); pw[3] = cvtpk(s1[8 * s + 6], s1[8 * s + 7]);
                        const bf16x8 pf = __builtin_bit_cast(bf16x8, pw);
                        const bf16_t* va = Vt + r * VSTR + 32 + 16 * s + 4 * h;
                        const s16x4 a0 = *(const s16x4*)(va), a1 = *(const s16x4*)(va + 8), b0 = *(const s16x4*)(va + 32 * VSTR), b1 = *(const s16x4*)(va + 32 * VSTR + 8);
                        o0 = __builtin_amdgcn_mfma_f32_32x32x16_bf16(__builtin_shufflevector(a0, a1, 0, 1, 2, 3, 4, 5, 6, 7), pf, o0, 0, 0, 0);
                        o1 = __builtin_amdgcn_mfma_f32_32x32x16_bf16(__builtin_shufflevector(b0, b1, 0, 1, 2, 3, 4, 5, 6, 7), pf, o1, 0, 0, 0);
                    }
                }
            }
        }
        const float inv = 1.0f / xhalf_sum(lsum);
        float* op = p.mo + (size_t)(b * SEQ + myq) * 256 + hd * 64 + 4 * h;
#pragma unroll
        for (int g = 0; g < 4; ++g) {
            *(f32x4*)(op + 8 * g) = (f32x4){o0[4 * g] * inv, o0[4 * g + 1] * inv, o0[4 * g + 2] * inv, o0[4 * g + 3] * inv};
            *(f32x4*)(op + 32 + 8 * g) = (f32x4){o1[4 * g] * inv, o1[4 * g + 1] * inv, o1[4 * g + 2] * inv, o1[4 * g + 3] * inv};
        }
        __syncthreads();
    }
}

__device__ __forceinline__ void ph_finalize_mix(const Params& pkv, KPtr kp_in, int wbase_in, int l) {
    PH_HEAD
    const int lane = TID & 63, gw = BID * (NTHREADS / 64) + (TID >> 6), nw = gridDim.x * (NTHREADS / 64);
    const int c = lane * 4, h = lane >> 4;
    for (int t = gw; t < NT; t += nw) {
        bf16_t* outp = p.mixcat + (size_t)t * 1024;
        {
            const float l0 = p.dlse[((size_t)0 * NT + t) * 4 + h], l1 = p.dlse[((size_t)1 * NT + t) * 4 + h], l2 = p.dlse[((size_t)2 * NT + t) * 4 + h];
            const float lm = fmaxf(l0, fmaxf(l1, l2));
            float w0 = __builtin_amdgcn_exp2f(l0 - lm), w1 = __builtin_amdgcn_exp2f(l1 - lm), w2 = __builtin_amdgcn_exp2f(l2 - lm);
            const float wi = 1.0f / (w0 + w1 + w2); w0 *= wi; w1 *= wi; w2 *= wi;
            const float4 v0 = *(const float4*)(p.dob + ((size_t)0 * NT + t) * 256 + c), v1 = *(const float4*)(p.dob + ((size_t)1 * NT + t) * 256 + c), v2 = *(const float4*)(p.dob + ((size_t)2 * NT + t) * 256 + c);
            float4 v; v.x = w0 * v0.x + w1 * v1.x + w2 * v2.x; v.y = w0 * v0.y + w1 * v1.y + w2 * v2.y; v.z = w0 * v0.z + w1 * v1.z + w2 * v2.z; v.w = w0 * v0.w + w1 * v1.w + w2 * v2.w;
            const float ss = wave_sum(v.x * v.x + v.y * v.y + v.z * v.z + v.w * v.w);
            const float rs = rsqrtf(ss * (1.0f / 256.0f) + 1e-6f);
            const float4 g = *(const float4*)(p.dil_norm_g + l * 256 + c);
            ushort4 o; o.x = f2bf(v.x * rs * g.x); o.y = f2bf(v.y * rs * g.y); o.z = f2bf(v.z * rs * g.z); o.w = f2bf(v.w * rs * g.w);
            *(ushort4*)(outp + 256 + c) = o;
        }
        {
            const size_t o4 = (size_t)t * 256 + c;
            const float4 y = *(const float4*)(p.sy + o4), r = *(const float4*)(p.sr + o4), k = *(const float4*)(p.sk + o4), v = *(const float4*)(p.sv + o4), g = *(const float4*)(p.sg + o4);
            const float mean = grp16_sum(y.x + y.y + y.z + y.w) * (1.0f / 64.0f);
            const float dx = y.x - mean, dy = y.y - mean, dz = y.z - mean, dw = y.w - mean;
            const float var = grp16_sum(dx * dx + dy * dy + dz * dz + dw * dw) * (1.0f / 64.0f);
            const float rs = rsqrtf(var + 64e-5f);
            const float4 lg = *(const float4*)(p.rwkv_ln_g + l * 256 + c), lb = *(const float4*)(p.rwkv_ln_b + l * 256 + c), rk = *(const float4*)(p.rwkv_r_k + l * 256 + c);
            const float bonus = grp16_sum(r.x * k.x * rk.x + r.y * k.y * rk.y + r.z * k.z * rk.z + r.w * k.w * rk.w);
            ushort4 o;
            o.x = f2bf((dx * rs * lg.x + lb.x + bonus * v.x) * g.x); o.y = f2bf((dy * rs * lg.y + lb.y + bonus * v.y) * g.y);
            o.z = f2bf((dz * rs * lg.z + lb.z + bonus * v.z) * g.z); o.w = f2bf((dw * rs * lg.w + lb.w + bonus * v.w) * g.w);
            *(ushort4*)(outp + 512 + c) = o;
        }
        {
            const float4 v = *(const float4*)(p.mo + (size_t)t * 256 + c);
            const float ss = wave_sum(v.x * v.x + v.y * v.y + v.z * v.z + v.w * v.w);
            const float rs = rsqrtf(ss * (1.0f / 256.0f) + 1e-6f);
            const float4 g = *(const float4*)(p.mla_out_norm_g + l * 256 + c);
            ushort4 o; o.x = f2bf(v.x * rs * g.x); o.y = f2bf(v.y * rs * g.y); o.z = f2bf(v.z * rs * g.z); o.w = f2bf(v.w * rs * g.w);
            *(ushort4*)(outp + 768 + c) = o;
        }
    }
    (void)h;
}

__device__ __forceinline__ void ph_outproj(const Params& pkv, KPtr kp_in, int wbase_in, int l, char* lds) {
    PH_HEAD
    const float* xin = (l == 0) ? p.x : p.xf; float* y1 = p.y1;
    const bf16_t* Bt = p.wout_t + (size_t)l * 1024 * 1024;
    const int nunits = (NT / 256) * 4;
    bool pre = false;
    for (int u = BID; u < nunits; u += gridDim.x) {
        const int mt = u >> 2, nt = u & 3, un = u + gridDim.x;
        G8Next nx; nx.valid = 0; nx.rowidx = nullptr; nx.nvalid = 256; nx.A = p.mixcat + (size_t)(un >> 2) * 256 * 1024; nx.Bt = Bt + (size_t)(un & 3) * 256 * 1024;
        const size_t o0 = (size_t)mt * 256 * 1024 + nt * 256;
        gemm_tile256(p.mixcat + (size_t)mt * 256 * 1024, 1024, nullptr, 256, Bt + (size_t)nt * 256 * 1024, 1024, 1024, lds, wbase_in, pre, nx,
                     [=](int r, int c, f32x4 v) mutable { const size_t o = o0 + (size_t)r * 1024 + c; const f32x4 xv = *(const f32x4*)(xin + o); *(f32x4*)(y1 + o) = xv * ALPHA + v; });
        pre = nx.valid != 0;
    }
}

__device__ __forceinline__ void ph_ln1_router(const Params& pkv, KPtr kp_in, int wbase_in, int l, char* lds) {
    PH_HEAD
    int* hist = (int*)lds;
    int* base = hist + 32;
    int* le = base + 32;
    float* lgt = (float*)(le + 512);
    int* lrank = (int*)(lgt + 512);
    const int tid = TID, lane = tid & 63, wv = tid >> 6;
    const float* g1 = p.ln1_g + l * 1024; const float* b1 = p.ln1_b + l * 1024;
    const float* rw = p.router_w + (size_t)l * 1024 * 32; const float* rb = p.router_b + l * 32;
    for (int tb = BID * 128; tb < NT; tb += gridDim.x * 128) {
        __syncthreads();
        if (tid < 32) hist[tid] = 0;
        __syncthreads();
        for (int tt = wv; tt < 128; tt += 8) {
            const int t = tb + tt;
            float4 y[4]; float s = 0.f;
#pragma unroll
            for (int m = 0; m < 4; ++m) { y[m] = *(const float4*)(p.y1 + (size_t)t * 1024 + m * 256 + lane * 4); s += y[m].x + y[m].y + y[m].z + y[m].w; }
            const float mean = wave_sum(s) * (1.0f / 1024.0f);
            float q = 0.f;
#pragma unroll
            for (int m = 0; m < 4; ++m) { y[m].x -= mean; y[m].y -= mean; y[m].z -= mean; y[m].w -= mean; q += y[m].x * y[m].x + y[m].y * y[m].y + y[m].z * y[m].z + y[m].w * y[m].w; }
            const float rs = rsqrtf(wave_sum(q) * (1.0f / 1024.0f) + 1e-5f);
            float lg[32];
#pragma unroll
            for (int e = 0; e < 32; ++e) lg[e] = 0.f;
#pragma unroll 1
            for (int m = 0; m < 4; ++m) {
                const int c = m * 256 + lane * 4;
                const float4 g = *(const float4*)(g1 + c), bb = *(const float4*)(b1 + c);
                const float4 yv = *(const float4*)(p.y1 + (size_t)t * 1024 + c);
                float4 xv; xv.x = (yv.x - mean) * rs * g.x + bb.x; xv.y = (yv.y - mean) * rs * g.y + bb.y; xv.z = (yv.z - mean) * rs * g.z + bb.z; xv.w = (yv.w - mean) * rs * g.w + bb.w;
                *(float4*)(p.y1 + (size_t)t * 1024 + c) = xv;
                ushort4 ob; ob.x = f2bf(xv.x); ob.y = f2bf(xv.y); ob.z = f2bf(xv.z); ob.w = f2bf(xv.w);
                *(ushort4*)(p.x1b + (size_t)t * 1024 + c) = ob;
                const float xs[4] = {xv.x, xv.y, xv.z, xv.w};
#pragma unroll
                for (int i = 0; i < 4; ++i) {
                    const float4* wr = (const float4*)(rw + (size_t)(c + i) * 32);
#pragma unroll
                    for (int e4 = 0; e4 < 8; ++e4) { const float4 w = wr[e4]; lg[e4 * 4] += xs[i] * w.x; lg[e4 * 4 + 1] += xs[i] * w.y; lg[e4 * 4 + 2] += xs[i] * w.z; lg[e4 * 4 + 3] += xs[i] * w.w; }
                }
            }
#pragma unroll
            for (int e = 0; e < 32; ++e) lg[e] = wave_sum(lg[e]) + rb[e];
            int idx[4]; float val[4];
#pragma unroll
            for (int k = 0; k < 4; ++k) {
                float bv = -3.0e38f; int bi = 0;
#pragma unroll
                for (int e = 0; e < 32; ++e) { if (lg[e] > bv) { bv = lg[e]; bi = e; } }
                idx[k] = bi; val[k] = bv;
#pragma unroll
                for (int e = 0; e < 32; ++e) if (e == bi) lg[e] = -3.0e38f;
            }
            const float e1 = __expf(val[1] - val[0]), e2 = __expf(val[2] - val[0]), e3 = __expf(val[3] - val[0]);
            const float inv = 1.0f / (1.0f + e1 + e2 + e3);
            const float gt[4] = {inv, e1 * inv, e2 * inv, e3 * inv};
            if (lane < 4) {
                int ee = idx[0]; float gg = gt[0];
                if (lane == 1) { ee = idx[1]; gg = gt[1]; } else if (lane == 2) { ee = idx[2]; gg = gt[2]; } else if (lane == 3) { ee = idx[3]; gg = gt[3]; }
                le[tt * 4 + lane] = ee; lgt[tt * 4 + lane] = gg;
                lrank[tt * 4 + lane] = atomicAdd(&hist[ee], 1);
            }
        }
        __syncthreads();
        if (tid < 32) base[tid] = atomicAdd(&p.cnt[l * NE + tid], hist[tid]);
        __syncthreads();
        {
            const int tt = tid >> 2, t = tb + tt, e = le[tid], pos = base[e] + lrank[tid];
            p.toke[(size_t)t * 4 + (tid & 3)] = e; p.tokpos[(size_t)t * 4 + (tid & 3)] = pos;
            p.rowtok[(size_t)e * NT + pos] = t; p.rowgate[(size_t)e * NT + pos] = lgt[tid];
        }
    }
}

__device__ __forceinline__ void moe_tile_prefix(KRef p, int l, int* tb  , const int TID) {
    __syncthreads();
    if (TID == 0) { int a = 0; for (int e = 0; e < NE; ++e) { tb[e] = a; a += (p.cnt[l * NE + e] + MOE_TM - 1) / MOE_TM; } tb[NE] = a; }
    __syncthreads();
}
struct MoeUnit { int e, mt, mtg, nt, nvalid; };
__device__ __forceinline__ MoeUnit moe_decode(const int* tb, const int* cnt, int u, int ntshift) {
    MoeUnit m; m.mtg = u >> ntshift; m.nt = u & ((1 << ntshift) - 1);
    int e = 0; while (tb[e + 1] <= m.mtg) ++e;
    m.e = __builtin_amdgcn_readfirstlane(e);
    m.mt = __builtin_amdgcn_readfirstlane(m.mtg - tb[m.e]);
    const int c = __builtin_amdgcn_readfirstlane(cnt[m.e]);
    m.nvalid = min(MOE_TM, c - m.mt * MOE_TM);
    return m;
}
__device__ __forceinline__ void ph_moe_gu(const Params& pkv, KPtr kp_in, int wbase_in, int l, char* lds) {
    PH_HEAD
    int* tb = (int*)(lds + 132096);
    moe_tile_prefix(p, l, tb, TID);
    const int ntile = __builtin_amdgcn_readfirstlane(tb[NE]), nunits = ntile * 8;
    const int* cnt = p.cnt + l * NE;
    bool pre = false;
    for (int u = BID; u < nunits; u += gridDim.x) {
        const MoeUnit m = moe_decode(tb, cnt, u, 3);
        const int un = u + gridDim.x;
        G8Next nx; nx.valid = 0; nx.A = p.x1b; nx.rowidx = nullptr; nx.Bt = nullptr; nx.nvalid = 0;
        if (nx.valid) { const MoeUnit m2 = moe_decode(tb, cnt, un, 3); nx.rowidx = p.rowtok + (size_t)m2.e * NT + m2.mt * MOE_TM; nx.nvalid = m2.nvalid; nx.Bt = p.wgu_t + (((size_t)l * NE + m2.e) * 2048 + m2.nt * 256) * 1024; }
        const float* bias = p.b_gu + ((size_t)l * NE + m.e) * 2048 + m.nt * 256;
        bf16_t* out = p.act + (size_t)m.mtg * MOE_TM * 1024 + m.nt * 128;
        gemm_tile256(p.x1b, 1024, p.rowtok + (size_t)m.e * NT + m.mt * MOE_TM, m.nvalid, p.wgu_t + (((size_t)l * NE + m.e) * 2048 + m.nt * 256) * 1024, 1024, 1024, lds, wbase_in, pre, nx,
                     [=](int r, int c, f32x4 v) mutable {
                         const f32x4 bv = *(const f32x4*)(bias + c); v = v + bv;
                         const float g0 = fminf(v[0], 7.0f), l0 = fminf(fmaxf(v[1], -7.0f), 7.0f), g1 = fminf(v[2], 7.0f), l1 = fminf(fmaxf(v[3], -7.0f), 7.0f);
                         const float a0 = g0 * sigmoidf_(1.702f * g0) * (l0 + 1.0f), a1 = g1 * sigmoidf_(1.702f * g1) * (l1 + 1.0f);
                         *(unsigned*)(out + (size_t)r * 1024 + (c >> 1)) = cvtpk(a0, a1); });
        pre = nx.valid != 0;
    }
}
__device__ __forceinline__ void ph_moe_dn(const Params& pkv, KPtr kp_in, int wbase_in, int l, char* lds) {
    PH_HEAD
    int* tb = (int*)(lds + 132096);
    moe_tile_prefix(p, l, tb, TID);
    const int ntile = __builtin_amdgcn_readfirstlane(tb[NE]), nunits = ntile * 4;
    const int* cnt = p.cnt + l * NE;
    bool pre = false;
    for (int u = BID; u < nunits; u += gridDim.x) {
        const MoeUnit m = moe_decode(tb, cnt, u, 2);
        const int un = u + gridDim.x;
        G8Next nx; nx.valid = 0; nx.A = nullptr; nx.rowidx = nullptr; nx.Bt = nullptr; nx.nvalid = 256;
        if (nx.valid) { const MoeUnit m2 = moe_decode(tb, cnt, un, 2); nx.A = p.act + (size_t)m2.mtg * MOE_TM * 1024; nx.Bt = p.wdn_t + (((size_t)l * NE + m2.e) * 1024 + m2.nt * 256) * 1024; }
        const float* bias = p.b_dn + ((size_t)l * NE + m.e) * 1024 + m.nt * 256;
        const float* gate = p.rowgate + (size_t)m.e * NT + m.mt * MOE_TM;
        bf16_t* out = p.yb + (size_t)m.mtg * MOE_TM * 1024 + m.nt * 256;
        const int nvalid = m.nvalid;
        gemm_tile256(p.act + (size_t)m.mtg * MOE_TM * 1024, 1024, nullptr, 256, p.wdn_t + (((size_t)l * NE + m.e) * 1024 + m.nt * 256) * 1024, 1024, 1024, lds, wbase_in, pre, nx,
                     [=](int r, int c, f32x4 v) mutable {
                         const float g = (r < nvalid) ? gate[r] : 0.f;
                         const f32x4 bv = *(const f32x4*)(bias + c); v = (v + bv) * g;
                         uint2 o; o.x = cvtpk(v[0], v[1]); o.y = cvtpk(v[2], v[3]); *(uint2*)(out + (size_t)r * 1024 + c) = o; });
        pre = nx.valid != 0;
    }
}
__device__ __forceinline__ void ph_combine_ln2(const Params& pkv, KPtr kp_in, int wbase_in, int l, char* lds) {
    PH_HEAD
    int* tb = (int*)(lds + 132096);
    moe_tile_prefix(p, l, tb, TID);
    const int lane = TID & 63, gw = BID * (NTHREADS / 64) + (TID >> 6), nw = gridDim.x * (NTHREADS / 64);
    const float* g2 = p.ln2_g + l * 1024; const float* b2 = p.ln2_b + l * 1024;
    float* dstf = (l == DEPTH - 1) ? p.out : p.xf;
    for (int t = gw; t < NT; t += nw) {
        size_t rows[4];
#pragma unroll
        for (int k = 0; k < 4; ++k) { const int e = p.toke[(size_t)t * 4 + k], pos = p.tokpos[(size_t)t * 4 + k]; rows[k] = (size_t)tb[e] * MOE_TM + pos; }
        float4 y[4]; float s = 0.f;
#pragma unroll
        for (int m = 0; m < 4; ++m) {
            const int c = m * 256 + lane * 4;
            float4 v = *(const float4*)(p.y1 + (size_t)t * 1024 + c);
            v.x *= ALPHA; v.y *= ALPHA; v.z *= ALPHA; v.w *= ALPHA;
#pragma unroll
            for (int k = 0; k < 4; ++k) { const ushort4 yb = *(const ushort4*)(p.yb + rows[k] * 1024 + c); v.x += bf2f(yb.x); v.y += bf2f(yb.y); v.z += bf2f(yb.z); v.w += bf2f(yb.w); }
            y[m] = v; s += v.x + v.y + v.z + v.w;
        }
        const float mean = wave_sum(s) * (1.0f / 1024.0f);
        float q = 0.f;
#pragma unroll
        for (int m = 0; m < 4; ++m) { y[m].x -= mean; y[m].y -= mean; y[m].z -= mean; y[m].w -= mean; q += y[m].x * y[m].x + y[m].y * y[m].y + y[m].z * y[m].z + y[m].w * y[m].w; }
        const float rs = rsqrtf(wave_sum(q) * (1.0f / 1024.0f) + 1e-5f);
#pragma unroll
        for (int m = 0; m < 4; ++m) {
            const int c = m * 256 + lane * 4;
            const float4 g = *(const float4*)(g2 + c), bb = *(const float4*)(b2 + c);
            float4 xv; xv.x = y[m].x * rs * g.x + bb.x; xv.y = y[m].y * rs * g.y + bb.y; xv.z = y[m].z * rs * g.z + bb.z; xv.w = y[m].w * rs * g.w + bb.w;
            *(float4*)(dstf + (size_t)t * 1024 + c) = xv;
            ushort4 ob; ob.x = f2bf(xv.x); ob.y = f2bf(xv.y); ob.z = f2bf(xv.z); ob.w = f2bf(xv.w);
            *(ushort4*)(p.xb + (size_t)t * 1024 + c) = ob;
        }
    }
}

constexpr int PH_PRO = 0, PH_INPROJ = 1, PH_PREP = 2, PH_RETKV = 3, PH_RETSCAN = 4, PH_RETOUT = 5, PH_DIL = 6, PH_RWKVPREP = 7, PH_RWKVSCAN = 8, PH_MLAUP = 9,
              PH_MLAATTN = 10, PH_FINAL = 11, PH_OUTPROJ = 12, PH_LN1 = 13, PH_GU = 14, PH_DN = 15, PH_LN2 = 16;

#ifdef MULTI_LAUNCH
template <int ph>
__global__ void __launch_bounds__(NTHREADS, 2) mega(Params pk, int l) {
    extern __shared__ __attribute__((aligned(16))) char lds[];
    KPtr kp = (KPtr)__builtin_amdgcn_kernarg_segment_ptr();
    const int wbase = __builtin_amdgcn_readfirstlane(threadIdx.x) & ~63;
    if (ph == PH_PRO) ph_prologue(pk, kp, wbase, lds);
    if (ph == PH_INPROJ) ph_inproj(pk, kp, wbase, l, lds);
    if (ph == PH_PREP) ph_rope_prep(pk, kp, wbase, l);
    if (ph == PH_RETKV) ph_ret_kv(pk, kp, wbase, l, lds);
    if (ph == PH_RETSCAN) ph_ret_scan(pk, kp, wbase, l);
    if (ph == PH_RETOUT) ph_ret_out(pk, kp, wbase, l, lds);
    if (ph == PH_DIL) ph_dil_attn(pk, kp, wbase, l, lds);
    if (ph == PH_RWKVPREP) ph_rwkv_prep(pk, kp, wbase, l, lds);
    if (ph == PH_RWKVSCAN) ph_rwkv_scan(pk, kp, wbase, l, lds);
    if (ph == PH_MLAUP) ph_mla_up(pk, kp, wbase, l, lds);
    if (ph == PH_MLAATTN) ph_mla_attn(pk, kp, wbase, l, lds);
    if (ph == PH_FINAL) ph_finalize_mix(pk, kp, wbase, l);
    if (ph == PH_OUTPROJ) ph_outproj(pk, kp, wbase, l, lds);
    if (ph == PH_LN1) ph_ln1_router(pk, kp, wbase, l, lds);
    if (ph == PH_GU) ph_moe_gu(pk, kp, wbase, l, lds);
    if (ph == PH_DN) ph_moe_dn(pk, kp, wbase, l, lds);
    if (ph == PH_LN2) ph_combine_ln2(pk, kp, wbase, l, lds);
}
template <int PH> static void launch_ph(const Params& p, int l, hipStream_t stream) {
    static bool attr_set = false;
    if (!attr_set) { (void)hipFuncSetAttribute((const void*)mega<PH>, hipFuncAttributeMaxDynamicSharedMemorySize, LDS_BYTES); attr_set = true; }
    hipLaunchKernelGGL(mega<PH>, dim3(256), dim3(NTHREADS), LDS_BYTES, stream, p, l);
}
template <int PH> static void launch_layer(const Params& p, int l, hipStream_t stream) {
    launch_ph<PH>(p, l, stream);
    if constexpr (PH < PH_LN2) launch_layer<PH + 1>(p, l, stream);
}

#else
__device__ __forceinline__ void grid_sync(KPtr kp_in, int wbase_in, char* lds) {
    KPtr kp_ = kp_launder(kp_in);
    XcdBarrier b; b.bar = kp_->bar; b.x = xb_xcc_id(); b.st = (volatile LAS unsigned*)(lds + LDS_BYTES - 16);
    xcd_barrier(b, opq_tid(wbase_in));
}
#ifndef PROBE_ID
#define PROBE_ID -1
#endif
#define RUN(ID, call) do { int reps_ = 1; if (PROBE_ID == (ID)) { reps_ = 2; asm volatile("" : "+s"(reps_)); } for (int r_ = 0; r_ < reps_; ++r_) { call; } } while (0)
__global__ void __launch_bounds__(NTHREADS, 2) mega_fused(Params pk) {
    extern __shared__ __attribute__((aligned(16))) char lds[];
    KPtr kp = (KPtr)__builtin_amdgcn_kernarg_segment_ptr();
    const int wbase = __builtin_amdgcn_readfirstlane(threadIdx.x) & ~63;
    volatile LAS unsigned* xbw = (volatile LAS unsigned*)(lds + LDS_BYTES - 16);
    if (threadIdx.x == 0) { xbw[0] = 0u; xbw[1] = 0u; xbw[2] = 0u; xbw[3] = 0u; }
    __syncthreads();
    (void)xcd_barrier_post(pk.bar, xbw);
    RUN(0, ph_prologue(pk, kp, wbase, lds));
    grid_sync(kp, wbase, lds);
    for (int l = 0; l < DEPTH; ++l) {
        RUN(1, ph_inproj(pk, kp, wbase, l, lds));
        grid_sync(kp, wbase, lds);
        RUN(2, ph_rope_prep(pk, kp, wbase, l));
        grid_sync(kp, wbase, lds);
        RUN(3, ph_ret_kv(pk, kp, wbase, l, lds)); RUN(4, ph_rwkv_prep(pk, kp, wbase, l, lds)); RUN(5, ph_mla_up(pk, kp, wbase, l, lds)); RUN(6, ph_dil_attn(pk, kp, wbase, l, lds));
        grid_sync(kp, wbase, lds);
        RUN(7, ph_mla_pack(pk, kp, wbase, l)); RUN(8, ph_ret_scan(pk, kp, wbase, l)); RUN(17, ph_rwkv_chunkpre(pk, kp, wbase, l, lds));
        grid_sync(kp, wbase, lds);
        RUN(10, ph_rwkv_scan(pk, kp, wbase, l, lds)); RUN(9, ph_mla_attn(pk, kp, wbase, l, lds));
        grid_sync(kp, wbase, lds);
        RUN(11, ph_ret_out(pk, kp, wbase, l, lds)); RUN(12, ph_finalize_mix(pk, kp, wbase, l));
        grid_sync(kp, wbase, lds);
        RUN(13, ph_outproj(pk, kp, wbase, l, lds));
        grid_sync(kp, wbase, lds);
        ph_ln1_router(pk, kp, wbase, l, lds);
        grid_sync(kp, wbase, lds);
        RUN(14, ph_moe_gu(pk, kp, wbase, l, lds));
        grid_sync(kp, wbase, lds);
        RUN(15, ph_moe_dn(pk, kp, wbase, l, lds));
        grid_sync(kp, wbase, lds);
        RUN(16, ph_combine_ln2(pk, kp, wbase, l, lds));
        grid_sync(kp, wbase, lds);
    }
}
#endif
struct Carver { char* base; size_t off; template <class T> T* take(size_t n) { T* r = (T*)(base + off); off += ((n * sizeof(T) + 255) / 256) * 256; return r; } };

extern "C" void kernel_launch(void* const* d_in, const int* in_sizes, int n_in, void* d_out, int out_size, void* d_ws, size_t ws_size, hipStream_t stream) {
    Params p; memset(&p, 0, sizeof(p));
    const float** ip = (const float**)&p;
    for (int i = 0; i < 35; ++i) ip[i] = (const float*)d_in[i];
    p.out = (float*)d_out;
    Carver c{(char*)d_ws, 0};
    p.bar = c.take<unsigned>(4096); p.cnt = c.take<int>(DEPTH * NE); p.wq = c.take<int>(DEPTH * 16);
    p.tab_ret = c.take<float>((size_t)SEQ * 32); p.tab_dil = c.take<float>((size_t)SEQ * 16); p.tab_mla = c.take<float>((size_t)SEQ * 32);
    p.win_t = c.take<bf16_t>((size_t)DEPTH * NINP * 1024); p.wout_t = c.take<bf16_t>((size_t)DEPTH * 1024 * 1024);
    p.wgu_t = c.take<bf16_t>((size_t)DEPTH * NE * 2048 * 1024); p.wdn_t = c.take<bf16_t>((size_t)DEPTH * NE * 1024 * 1024);
    p.wq_t = c.take<bf16_t>((size_t)DEPTH * 384 * 256); p.wkv_t = c.take<bf16_t>((size_t)DEPTH * 512 * 128);
    p.wupt = c.take<bf16_t>((size_t)DEPTH * 256 * 64); p.aupt = c.take<bf16_t>((size_t)DEPTH * 256 * 64); p.gupt = c.take<bf16_t>((size_t)DEPTH * 256 * 128); p.vupt = c.take<bf16_t>((size_t)DEPTH * 256 * 32);
    p.xf = c.take<float>((size_t)NT * DM); p.xb = c.take<bf16_t>((size_t)NT * DM); p.pbuf = c.take<bf16_t>((size_t)NT * NINP);
    p.mixcat = c.take<bf16_t>((size_t)NT * DM); p.y1 = c.take<float>((size_t)NT * DM); p.x1b = c.take<bf16_t>((size_t)NT * DM);
    p.rq = c.take<float>((size_t)NT * 128); p.rk = c.take<float>((size_t)NT * 128);
    p.rkv = c.take<float>((size_t)NBATCH * NCH * 4 * 32 * 64); p.rstate = c.take<float>((size_t)NBATCH * NCH * 4 * 32 * 64);
    p.dq = c.take<float>((size_t)NT * 256); p.dk = c.take<float>((size_t)NT * 256); p.dob = c.take<float>((size_t)3 * NT * 256); p.dlse = c.take<float>((size_t)3 * NT * 4);
    p.sr = c.take<float>((size_t)NT * 256); p.sw = c.take<float>((size_t)NT * 256); p.sk = c.take<float>((size_t)NT * 256); p.sv = c.take<float>((size_t)NT * 256);
    p.sa = c.take<float>((size_t)NT * 256); p.sb = c.take<float>((size_t)NT * 256); p.sg = c.take<float>((size_t)NT * 256); p.sy = c.take<float>((size_t)NT * 256);
    p.vfirst = c.take<float>((size_t)NT * 256);
    p.c_p = c.take<float>((size_t)16 * (SEQ / 16) * 4096); p.c_q = c.take<float>((size_t)16 * (SEQ / 16) * 4096); p.c_rh = c.take<float>((size_t)16 * (SEQ / 16) * 1024); p.c_y1 = c.take<float>((size_t)16 * (SEQ / 16) * 1024);
    p.rsq = c.take<float>(NT); p.rskv = c.take<float>(NT); p.kpe = c.take<float>((size_t)NT * 32);
    p.qu = c.take<float>((size_t)NT * 384); p.kvu = c.take<float>((size_t)NT * 512); p.mo = c.take<float>((size_t)NT * 256);
    p.mq = c.take<bf16_t>((size_t)NT * 384); p.mk = c.take<bf16_t>((size_t)NT * 384); p.mv = c.take<bf16_t>((size_t)NT * 256);
    p.rowtok = c.take<int>((size_t)NE * NT); p.toke = c.take<int>((size_t)NT * 4); p.tokpos = c.take<int>((size_t)NT * 4); p.rowgate = c.take<float>((size_t)NE * NT);
    p.act = c.take<bf16_t>((size_t)MOE_MAXROWS * 1024); p.yb = c.take<bf16_t>((size_t)MOE_MAXROWS * 1024);
    if (c.off > ws_size) { fprintf(stderr, "workspace too small: need %zu have %zu\n", c.off, ws_size); return; }

#ifdef MULTI_LAUNCH
    launch_ph<PH_PRO>(p, 0, stream);
    for (int l = 0; l < DEPTH; ++l) launch_layer<PH_INPROJ>(p, l, stream);
#else
    static int grid = 0;
    if (!grid) {
        (void)hipFuncSetAttribute((const void*)mega_fused, hipFuncAttributeMaxDynamicSharedMemorySize, LDS_BYTES);
        int dev = 0, cus = 0, per_cu = 0;
        (void)hipGetDevice(&dev);
        (void)hipDeviceGetAttribute(&cus, hipDeviceAttributeMultiprocessorCount, dev);
        (void)hipOccupancyMaxActiveBlocksPerMultiprocessor(&per_cu, mega_fused, NTHREADS, LDS_BYTES);
        if (cus <= 0) cus = 256;
        grid = cus * (per_cu < 1 ? 1 : 1);
    }
    (void)hipMemsetAsync(p.bar, 0, XCD_BAR_WORDS * sizeof(unsigned), stream);
    hipLaunchKernelGGL(mega_fused, dim3(grid), dim3(NTHREADS), LDS_BYTES, stream, p);
#endif
}
```

```cpp
#include <hip/hip_runtime.h>
#include <stdint.h>
#include <string.h>
#include <stdio.h>

typedef unsigned short bf16_t;
typedef short bf16x8 __attribute__((ext_vector_type(8)));
typedef float f32x4 __attribute__((ext_vector_type(4)));
typedef unsigned u32x4 __attribute__((ext_vector_type(4)));
typedef float f32x16 __attribute__((ext_vector_type(16)));
typedef short s16x4 __attribute__((ext_vector_type(4)));
typedef float f32x2_t __attribute__((ext_vector_type(2)));
typedef __bf16 bf16x2_t __attribute__((ext_vector_type(2)));

constexpr int NT = 32768, SEQ = 8192, NBATCH = 4, DM = 1024, NIN = 2976, NINP = 3072, DEPTH = 4, NE = 32, TOPK = 4;
constexpr int BLK = 128, NCH = SEQ / BLK;
constexpr float ALPHA = 1.6817928305074292f;
constexpr int PC_RQ = 0, PC_RK = 128, PC_RV = 256, PC_RG = 512, PC_DQ = 768, PC_DK = 1024, PC_DV = 1280;
constexpr int PC_C = 1536, PC_CR = 1536, PC_CK = 1792, PC_CV = 2048, PC_CWD = 2304, PC_CAD = 2368, PC_CGD = 2432;
constexpr int PC_MQ = 2560, PC_MKV = 2816, PC_MKR = 2944, PC_VRES = 2976;
constexpr int MOE_TM = 256;
constexpr int MOE_MAXROWS = NT * TOPK + NE * MOE_TM;
constexpr int NTHREADS = 512;
constexpr int LDS_BYTES = 147456;

__device__ __forceinline__ bf16_t f2bf(float f) { unsigned u = __float_as_uint(f); u += 0x7fffu + ((u >> 16) & 1u); return (bf16_t)(u >> 16); }
__device__ __forceinline__ unsigned cvtpk(float lo, float hi) { f32x2_t v = {lo, hi}; bf16x2_t b = __builtin_convertvector(v, bf16x2_t); return __builtin_bit_cast(unsigned, b); }
__device__ __forceinline__ float xhalf_max(float v) { auto rr = __builtin_amdgcn_permlane32_swap(__float_as_uint(v), __float_as_uint(v), false, false); return fmaxf(__uint_as_float(rr[0]), __uint_as_float(rr[1])); }
__device__ __forceinline__ float xhalf_sum(float v) { auto rr = __builtin_amdgcn_permlane32_swap(__float_as_uint(v), __float_as_uint(v), false, false); return __uint_as_float(rr[0]) + __uint_as_float(rr[1]); }
__device__ __forceinline__ float bf2f(bf16_t h) { return __uint_as_float(((unsigned)h) << 16); }
template <int CTRL> __device__ __forceinline__ float dpp_f(float v) { return __int_as_float(__builtin_amdgcn_update_dpp(0, __float_as_int(v), CTRL, 0xF, 0xF, true)); }
__device__ __forceinline__ float grp16_sum(float v) {
    v += dpp_f<0x128>(v); v += dpp_f<0x124>(v); v += dpp_f<0x122>(v); v += dpp_f<0x121>(v); return v; }
__device__ __forceinline__ float wave_sum(float v) {
    v = grp16_sum(v);
    const int i = __float_as_int(v);
    return (__int_as_float(__builtin_amdgcn_readlane(i, 0)) + __int_as_float(__builtin_amdgcn_readlane(i, 16))) +
           (__int_as_float(__builtin_amdgcn_readlane(i, 32)) + __int_as_float(__builtin_amdgcn_readlane(i, 48))); }
__device__ __forceinline__ float sigmoidf_(float x) { return __builtin_amdgcn_rcpf(1.0f + __builtin_amdgcn_exp2f(x * -1.4426950408889634f)); }

#define XB_TMO      128
#define XB_XCNT(j)  (256  + 64 * (j))
#define XB_XSUB(j)  (1280 + 64 * (j))
#define XB_XGEN(j)  (2304 + 64 * (j))
#define XB_TOP      3328
#define XB_TOPGEN   3392
#define XCD_BAR_WORDS 3456
#define XB_SPIN_CAP (1u << 22)
#define LAS __attribute__((address_space(3)))
__device__ __forceinline__ unsigned xb_ld(unsigned* p)              { return __hip_atomic_load(p, __ATOMIC_RELAXED, __HIP_MEMORY_SCOPE_AGENT); }
__device__ __forceinline__ unsigned xb_add(unsigned* p, unsigned v) { return __hip_atomic_fetch_add(p, v, __ATOMIC_RELAXED, __HIP_MEMORY_SCOPE_AGENT); }
__device__ __forceinline__ unsigned xb_xcc_id() { return (unsigned)__builtin_amdgcn_s_getreg((3 << 11) | 20) & 0xFu; }
#define XB_SPIN(cond, bar) do { unsigned _sp = 0; while (cond) { __builtin_amdgcn_s_sleep(1); \
    if ((++_sp & 255u) == 0u) { if (xb_ld(&(bar)[XB_TMO])) break; if (_sp > XB_SPIN_CAP) { atomicAdd(&(bar)[XB_TMO], 1u); break; } } } } while (0)
struct XcdBarrier { unsigned* bar; unsigned x; volatile LAS unsigned* st; };
__device__ __forceinline__ XcdBarrier xcd_barrier_post(unsigned* bar, volatile LAS unsigned* st) {
    XcdBarrier b; b.bar = bar; b.x = xb_xcc_id(); b.st = st;
    if (threadIdx.x == 0) (void)xb_add(&bar[XB_XCNT(b.x)], 1u);
    return b;
}
__device__ __forceinline__ void xcd_barrier_complete(unsigned* bar, unsigned x, unsigned& nloc, unsigned& nx) {
    const unsigned G = gridDim.x * gridDim.y * gridDim.z;
    unsigned sum, cnt, mine, sp = 0u;
    for (;;) {
        sum = 0u; cnt = 0u; mine = 0u;
#pragma unroll
        for (unsigned j = 0; j < 16; ++j) { const unsigned c = xb_ld(&bar[XB_XCNT(j)]); sum += c; cnt += (c > 0u) ? 1u : 0u; mine = (j == x) ? c : mine; }
        if (sum == G) break;
        __builtin_amdgcn_s_sleep(1);
        if ((++sp & 255u) == 0u) { if (xb_ld(&bar[XB_TMO])) break; if (sp > XB_SPIN_CAP) { atomicAdd(&bar[XB_TMO], 1u); break; } }
    }
    nloc = mine > 0u ? mine : 1u; nx = cnt > 0u ? cnt : 1u;
}
__device__ __forceinline__ void xcd_barrier(const XcdBarrier& b, const int tid0) {
    asm volatile("s_waitcnt vmcnt(0)" ::: "memory");
    __syncthreads();
    if (tid0 == 0) {
        unsigned* bar = b.bar;
        __builtin_amdgcn_s_waitcnt(0);
        unsigned nloc = b.st[0], nx = b.st[1];
        if (nloc == 0u) { xcd_barrier_complete(bar, b.x, nloc, nx); b.st[0] = nloc; b.st[1] = nx; }
        const unsigned old = xb_add(&bar[XB_XSUB(b.x)], 1u);
        const unsigned gen = old / nloc;
        if (old + 1u == (gen + 1u) * nloc) {
            __builtin_amdgcn_fence(__ATOMIC_RELEASE, "agent");
            asm volatile("s_waitcnt vmcnt(0)" ::: "memory");
            const unsigned og = xb_add(&bar[XB_TOP], 1u);
            const unsigned tg = og / nx;
            if (og + 1u == (tg + 1u) * nx) xb_add(&bar[XB_TOPGEN], 1u);
            else XB_SPIN(xb_ld(&bar[XB_TOPGEN]) == tg, bar);
            __builtin_amdgcn_fence(__ATOMIC_ACQUIRE, "agent");
            xb_add(&bar[XB_XGEN(b.x)], 1u);
            asm volatile("s_waitcnt vmcnt(0)" ::: "memory");
        } else {
            XB_SPIN(xb_ld(&bar[XB_XGEN(b.x)]) == gen, bar);
            __builtin_amdgcn_fence(__ATOMIC_ACQUIRE, "agent");
            asm volatile("s_waitcnt vmcnt(0)" ::: "memory");
        }
    }
    __syncthreads();
}

struct Params {
    const float *x, *w_in, *w_out, *ret_norm_g, *dil_norm_g, *rwkv_mu, *rwkv_w0, *rwkv_w_up, *rwkv_a0, *rwkv_a_up, *rwkv_g_up, *rwkv_k_k, *rwkv_k_a,
        *rwkv_r_k, *rwkv_ln_g, *rwkv_ln_b, *vres_down, *vres_mu, *rwkv_v0, *rwkv_v_up, *mla_q_norm_g, *mla_w_q_up, *mla_kv_norm_g, *mla_w_kv_up,
        *mla_out_norm_g, *ln1_g, *ln1_b, *router_w, *router_b, *w_gu, *b_gu, *w_dn, *b_dn, *ln2_g, *ln2_b;
    float* out;
    unsigned* bar; int* cnt; int* wq;
    float *tab_ret, *tab_dil, *tab_mla;
    bf16_t *win_t, *wout_t, *wgu_t, *wdn_t, *wq_t, *wkv_t, *wupt, *aupt, *gupt, *vupt;
    float* xf; bf16_t* xb; bf16_t* pbuf; bf16_t* mixcat; float* y1; bf16_t* x1b;
    float *rq, *rk, *rkv, *rstate;
    float *dq, *dk, *dob, *dlse;
    float *sr, *sw, *sk, *sv, *sa, *sb, *sg, *sy, *vfirst;
    float *c_p, *c_q, *c_rh, *c_y1;
    float *rsq, *rskv, *kpe, *qu, *kvu, *mo;
    bf16_t *mq, *mk, *mv;
    int *rowtok, *toke, *tokpos; float* rowgate; bf16_t *act, *yb;
};

__device__ __forceinline__ int opq_tid(int wbase) { unsigned z = 0u; asm volatile("" : "+s"(z)); int t = wbase | (int)__builtin_amdgcn_mbcnt_hi(~0u, __builtin_amdgcn_mbcnt_lo(~0u, z)); asm volatile("" : "+v"(t)); return t; }
__device__ __forceinline__ int opq_bid() { int b = blockIdx.x; asm volatile("" : "+s"(b)); return b; }
typedef const __attribute__((address_space(4))) Params* KPtr;
typedef const __attribute__((address_space(4))) Params& KRef;
__device__ __forceinline__ KPtr kp_launder(KPtr k) {
    const unsigned long long v = (unsigned long long)k;
    unsigned lo = (unsigned)v, hi = (unsigned)(v >> 32);
    asm volatile("" : "+s"(lo), "+s"(hi));
    return (KPtr)(((unsigned long long)hi << 32) | lo);
}
#define PH_HEADV (void)kp_in; const Params& p = pkv; const int TID = opq_tid(wbase_in), BID = opq_bid(); (void)TID; (void)BID;
#define PH_HEAD (void)pkv; KPtr kp_ = kp_launder(kp_in); KRef p = *kp_; const int TID = opq_tid(wbase_in), BID = opq_bid(); (void)TID; (void)BID;
template <class F>
__device__ __forceinline__ void tr_tile(F f, bf16_t* dst, int ldd, int k0, int n0, float* tile, const int TID) {
    const int tid = TID;
#pragma unroll
    for (int i = 0; i < 8; ++i) { const int e = tid + i * NTHREADS, kk = e >> 6, nn = e & 63; tile[kk * 65 + nn] = f(k0 + kk, n0 + nn); }
    __syncthreads();
#pragma unroll
    for (int i = 0; i < 8; ++i) { const int e = tid + i * NTHREADS, nn = e >> 6, kk = e & 63; dst[(size_t)(n0 + nn) * ldd + k0 + kk] = f2bf(tile[kk * 65 + nn]); }
    __syncthreads();
}

__device__ __forceinline__ void ph_prologue(const Params& pkv, KPtr kp_in, int wbase_in, char* lds) {
    PH_HEAD
    float* tile = (float*)lds;
    const int nb = gridDim.x, bid = BID, tid = TID;
    for (int t = bid; t < DEPTH * NE * 16 * 32; t += nb) {
        const int le = t >> 9, r = t & 511, tk = r >> 5, tn = r & 31;
        const float* src = p.w_gu + (size_t)le * 1024 * 2048;
        tr_tile([&](int k, int n) { return src[(size_t)k * 2048 + n]; }, p.wgu_t + (size_t)le * 2048 * 1024, 1024, tk * 64, tn * 64, tile, TID);
    }
    for (int t = bid; t < DEPTH * NE * 16 * 16; t += nb) {
        const int le = t >> 8, r = t & 255, tk = r >> 4, tn = r & 15;
        const float* src = p.w_dn + (size_t)le * 1024 * 1024;
        tr_tile([&](int k, int n) { return src[(size_t)k * 1024 + n]; }, p.wdn_t + (size_t)le * 1024 * 1024, 1024, tk * 64, tn * 64, tile, TID);
    }
    for (int t = bid; t < DEPTH * 16 * 48; t += nb) {
        const int l = t / (16 * 48), r = t % (16 * 48), tk = r / 48, tn = r % 48;
        const float* src = p.w_in + (size_t)l * 1024 * NIN;
        const float* vr = p.vres_down + (size_t)(l > 0 ? l - 1 : 0) * 1024 * 32;
        tr_tile([&](int k, int n) { return n < NIN ? src[(size_t)k * NIN + n] : ((n < NIN + 32 && l > 0) ? vr[k * 32 + (n - NIN)] : 0.0f); },
                p.win_t + (size_t)l * NINP * 1024, 1024, tk * 64, tn * 64, tile, TID);
    }
    for (int t = bid; t < DEPTH * 16 * 16; t += nb) {
        const int l = t >> 8, r = t & 255, tk = r >> 4, tn = r & 15;
        const float* src = p.w_out + (size_t)l * 1024 * 1024;
        tr_tile([&](int k, int n) { return src[(size_t)k * 1024 + n]; }, p.wout_t + (size_t)l * 1024 * 1024, 1024, tk * 64, tn * 64, tile, TID);
    }
    for (int t = bid; t < DEPTH * 4 * 6; t += nb) {
        const int l = t / 24, r = t % 24, tk = r / 6, tn = r % 6;
        const float* src = p.mla_w_q_up + (size_t)l * 256 * 384; const float* g = p.mla_q_norm_g + l * 256;
        tr_tile([&](int k, int n) { return src[k * 384 + n] * g[k]; }, p.wq_t + (size_t)l * 384 * 256, 256, tk * 64, tn * 64, tile, TID);
    }
    for (int t = bid; t < DEPTH * 2 * 8; t += nb) {
        const int l = t / 16, r = t % 16, tk = r / 8, tn = r % 8;
        const float* src = p.mla_w_kv_up + (size_t)l * 128 * 512; const float* g = p.mla_kv_norm_g + l * 128;
        tr_tile([&](int k, int n) { return src[k * 512 + n] * g[k]; }, p.wkv_t + (size_t)l * 512 * 128, 128, tk * 64, tn * 64, tile, TID);
    }
    for (int i = bid * NTHREADS + tid; i < DEPTH * 256 * 64; i += nb * NTHREADS) {
        const int l = i / (256 * 64), r = i % (256 * 64), n = r / 64, k = r % 64;
        p.wupt[i] = f2bf(p.rwkv_w_up[((size_t)l * 64 + k) * 256 + n]); p.aupt[i] = f2bf(p.rwkv_a_up[((size_t)l * 64 + k) * 256 + n]);
    }
    for (int i = bid * NTHREADS + tid; i < DEPTH * 256 * 128; i += nb * NTHREADS) {
        const int l = i / (256 * 128), r = i % (256 * 128), n = r / 128, k = r % 128;
        p.gupt[i] = f2bf(p.rwkv_g_up[((size_t)l * 128 + k) * 256 + n]);
    }
    for (int i = bid * NTHREADS + tid; i < (DEPTH - 1) * 256 * 32; i += nb * NTHREADS) {
        const int l = i / (256 * 32), r = i % (256 * 32), n = r / 32, k = r % 32;
        p.vupt[i] = f2bf(p.rwkv_v_up[((size_t)l * 32 + k) * 256 + n]);
    }
    for (int i = bid * NTHREADS + tid; i < SEQ * 40; i += nb * NTHREADS) {
        const int pos = i / 40, j = i % 40;
        double theta, rot; int f; float* dst;
        if (j < 16) { theta = 10000.0; rot = 32.0; f = j; dst = p.tab_ret + ((size_t)pos * 16 + f) * 2; }
        else if (j < 24) { theta = 500000.0; rot = 16.0; f = j - 16; dst = p.tab_dil + ((size_t)pos * 8 + f) * 2; }
        else { theta = 10000.0; rot = 32.0; f = j - 24; dst = p.tab_mla + ((size_t)pos * 16 + f) * 2; }
        const double inv = 1.0 / pow(theta, (2.0 * f) / rot), ang = (double)pos * inv;
        dst[0] = (float)cos(ang); dst[1] = (float)sin(ang);
    }
    for (size_t i = (size_t)bid * NTHREADS + tid; i < (size_t)NT * DM / 4; i += (size_t)nb * NTHREADS) {
        const float4 v = ((const float4*)p.x)[i];
        ushort4 o; o.x = f2bf(v.x); o.y = f2bf(v.y); o.z = f2bf(v.z); o.w = f2bf(v.w);
        ((ushort4*)p.xb)[i] = o;
    }
    if (bid == 0 && tid < DEPTH * NE) p.cnt[tid] = 0;
    if (bid == 0 && tid < DEPTH * 16) p.wq[tid] = 0;
}

template <class Epi>
__device__ __forceinline__ void gemm_tile128(const bf16_t* __restrict__ A, int lda, const int* __restrict__ rowidx, int nvalid,
                                             const bf16_t* __restrict__ Bt, int ldb, int K, char* lds, const int TID, Epi epi) {
    constexpr int LDT = 72;
    bf16_t* As = (bf16_t*)lds; bf16_t* Bs = As + 128 * LDT;
    const int tid = TID, lane = tid & 63, wid = tid >> 6, wm = wid >> 2, wn = wid & 3, fr = lane & 15, fq = lane >> 4;
    const bf16_t* ap[2]; const bf16_t* bp[2]; int so[2];
#pragma unroll
    for (int i = 0; i < 2; ++i) {
        const int c = tid + i * NTHREADS, row = c >> 3, kc = c & 7;
        int ar = row; if (rowidx) ar = (row < nvalid) ? rowidx[row] : rowidx[0];
        ap[i] = A + (size_t)ar * lda + kc * 8; bp[i] = Bt + (size_t)row * ldb + kc * 8; so[i] = row * LDT + kc * 8;
    }
    f32x4 acc[4][2];
#pragma unroll
    for (int mi = 0; mi < 4; ++mi)
#pragma unroll
        for (int ni = 0; ni < 2; ++ni) acc[mi][ni] = (f32x4){0.f, 0.f, 0.f, 0.f};
    u32x4 ra0, ra1, rb0, rb1;
    ra0 = *(const u32x4*)(ap[0]); ra1 = *(const u32x4*)(ap[1]); rb0 = *(const u32x4*)(bp[0]); rb1 = *(const u32x4*)(bp[1]);
    const int nk = K >> 6;
    for (int kt = 0; kt < nk; ++kt) {
        __syncthreads();
        *(u32x4*)(As + so[0]) = ra0; *(u32x4*)(As + so[1]) = ra1; *(u32x4*)(Bs + so[0]) = rb0; *(u32x4*)(Bs + so[1]) = rb1;
        __syncthreads();
        if (kt + 1 < nk) {
            const int ko = (kt + 1) * 64;
            ra0 = *(const u32x4*)(ap[0] + ko); ra1 = *(const u32x4*)(ap[1] + ko); rb0 = *(const u32x4*)(bp[0] + ko); rb1 = *(const u32x4*)(bp[1] + ko);
        }
#pragma unroll
        for (int kk = 0; kk < 2; ++kk) {
            bf16x8 af[4], bfr[2];
#pragma unroll
            for (int mi = 0; mi < 4; ++mi) af[mi] = *(const bf16x8*)(As + (wm * 64 + mi * 16 + fr) * LDT + kk * 32 + fq * 8);
#pragma unroll
            for (int ni = 0; ni < 2; ++ni) bfr[ni] = *(const bf16x8*)(Bs + (wn * 32 + ni * 16 + fr) * LDT + kk * 32 + fq * 8);
#pragma unroll
            for (int mi = 0; mi < 4; ++mi)
#pragma unroll
                for (int ni = 0; ni < 2; ++ni) acc[mi][ni] = __builtin_amdgcn_mfma_f32_16x16x32_bf16(bfr[ni], af[mi], acc[mi][ni], 0, 0, 0);
        }
    }
#pragma unroll
    for (int mi = 0; mi < 4; ++mi)
#pragma unroll
        for (int ni = 0; ni < 2; ++ni) epi(wm * 64 + mi * 16 + fr, wn * 32 + ni * 16 + fq * 4, acc[mi][ni]);
    __syncthreads();
}

__device__ __forceinline__ int g8_lds_byte(int r, int c) { const int st = (r >> 4) * 2 + (c >> 5), rr = r & 15, cc = c & 31, ob = rr * 64 + cc * 2; return st * 1024 + (ob ^ (((ob >> 9) & 1) << 5)); }
__device__ __forceinline__ void g8_stage_rc(int b, int& R, int& C) { const int st = b / 1024, sb = b % 1024, swz = sb ^ (((sb >> 9) & 1) << 5); R = (st >> 1) * 16 + swz / 64; C = (st & 1) * 32 + (swz % 64) / 2; }
struct G8Next { const bf16_t* A; const int* rowidx; const bf16_t* Bt; int nvalid; int valid; };
template <class Epi>
__device__ __forceinline__ void gemm_tile256(const bf16_t* __restrict__ A, int lda, const int* __restrict__ rowidx, int nvalid,
                                             const bf16_t* __restrict__ Bt, int ldb, int K, char* lds, const int TID, const bool pre_issued, const G8Next nx, Epi epi) {
    constexpr int G_HT = 128 * 64;
    bf16_t* shm = (bf16_t*)lds;
    int* icache = (int*)(lds + 133120);
#define G8_SA(b, h) (shm + ((b) * 2 + (h)) * G_HT)
#define G8_SB(b, h) (shm + (4 + (b) * 2 + (h)) * G_HT)
#define G8_SPTR(dst, src) do { unsigned long long _v = (unsigned long long)(src); unsigned _lo = (unsigned)_v, _hi = (unsigned)(_v >> 32); asm volatile("" : "+s"(_lo), "+s"(_hi)); \
        dst = (const char*)(((unsigned long long)_hi << 32) | _lo); } while (0)
#define G8_STAGE(P, BASE, OFF, kt) do { const char* _sb; G8_SPTR(_sb, (const char*)(BASE) + (size_t)(kt) * 128); _Pragma("unroll") for (int _i = 0; _i < 2; ++_i) { \
        __builtin_amdgcn_global_load_lds((const unsigned*)(_sb + (size_t)(OFF)[_i]), (unsigned*)((char*)(P) + tz * 16 + _i * 8192), 16, 0, 0); } } while (0)
#define G8_LDA(dst, b, h) _Pragma("unroll") for (int m = 0; m < 4; ++m) _Pragma("unroll") for (int k = 0; k < 2; ++k) \
        dst[m][k] = *reinterpret_cast<const bf16x8*>((char*)G8_SA(b, h) + g8_lds_byte(wr * 64 + m * 16 + fr, k * 32 + fq * 8))
#define G8_LDB(dst, b, h) _Pragma("unroll") for (int n = 0; n < 2; ++n) _Pragma("unroll") for (int k = 0; k < 2; ++k) \
        dst[n][k] = *reinterpret_cast<const bf16x8*>((char*)G8_SB(b, h) + g8_lds_byte(wc * 32 + n * 16 + fr, k * 32 + fq * 8))
#define G8_MMA(ai, bj, At_, Bt_) do { __builtin_amdgcn_s_setprio(1); \
        _Pragma("unroll") for (int m = 0; m < 4; ++m) _Pragma("unroll") for (int n = 0; n < 2; ++n) _Pragma("unroll") for (int k = 0; k < 2; ++k) \
            acc[ai][bj][m][n] = __builtin_amdgcn_mfma_f32_16x16x32_bf16(Bt_[n][k], At_[m][k], acc[ai][bj][m][n], 0, 0, 0); \
        __builtin_amdgcn_s_setprio(0); } while (0)
#define G8_WAIT_V(n) asm volatile("s_waitcnt vmcnt(" #n ")" ::: "memory")
#define G8_WAIT_L(n) asm volatile("s_waitcnt lgkmcnt(" #n ")" ::: "memory")
#define G8_BAR __builtin_amdgcn_s_barrier()
#define G8_SCHED __builtin_amdgcn_sched_barrier(0)
    int tz = opq_tid(TID);
    int wid = tz >> 6, lane = tz & 63, wr = wid >> 2, wc = wid & 3, fr = lane & 15, fq = lane >> 4;
    unsigned aoff0[2], aoff1[2], boff0[2];
#pragma unroll
    for (int i = 0; i < 2; ++i) {
        int r, c; g8_stage_rc(tz * 16 + i * 8192, r, c);
        int r0 = r, r1 = 128 + r;
        if (rowidx) {
            if (pre_issued) { r0 = icache[r0]; r1 = icache[r1]; }
            else { r0 = (r0 < nvalid) ? rowidx[r0] : rowidx[0]; r1 = (r1 < nvalid) ? rowidx[r1] : rowidx[0]; }
        }
        aoff0[i] = (unsigned)(r0 * lda + c) * 2u; aoff1[i] = (unsigned)(r1 * lda + c) * 2u;
        boff0[i] = (unsigned)(r * ldb + c) * 2u;
    }
    const bf16_t* Bt1 = Bt + (size_t)128 * ldb;
    int nidx = 0;
    if (nx.valid && nx.rowidx && tz < 256) nidx = nx.rowidx[(tz < nx.nvalid) ? tz : 0];
    f32x4 acc[2][2][4][2];
#pragma unroll
    for (int a = 0; a < 2; ++a)
#pragma unroll
        for (int b = 0; b < 2; ++b)
#pragma unroll
            for (int m = 0; m < 4; ++m)
#pragma unroll
                for (int n = 0; n < 2; ++n) acc[a][b][m][n] = (f32x4){0.f, 0.f, 0.f, 0.f};
    bf16x8 At[4][2], B0[2][2], B1[2][2];
    const int nt = K / 64;
    if (!pre_issued) {
        G8_STAGE(G8_SB(0, 0), Bt, boff0, 0); G8_STAGE(G8_SA(0, 0), A, aoff0, 0);
        G8_STAGE(G8_SB(0, 1), Bt1, boff0, 0); G8_STAGE(G8_SA(0, 1), A, aoff1, 0);
    }
    if (wr == 1) G8_BAR;
    G8_WAIT_V(4); G8_BAR;
    G8_STAGE(G8_SB(1, 0), Bt, boff0, 1); G8_STAGE(G8_SA(1, 0), A, aoff0, 1); G8_STAGE(G8_SB(1, 1), Bt1, boff0, 1);
    G8_WAIT_V(6); G8_BAR;
    for (int t = 0; t < nt - 2; t += 2) {
        G8_LDB(B0, 0, 0); G8_SCHED; G8_LDA(At, 0, 0); G8_STAGE(G8_SA(1, 1), A, aoff1, t + 1);
        G8_WAIT_L(8); G8_BAR; G8_WAIT_L(0); G8_MMA(0, 0, At, B0); G8_BAR; G8_SCHED;
        G8_LDB(B1, 0, 1); G8_STAGE(G8_SB(0, 0), Bt, boff0, t + 2);
        G8_BAR; G8_WAIT_L(0); G8_MMA(0, 1, At, B1); G8_BAR;
        G8_LDA(At, 0, 1); G8_STAGE(G8_SA(0, 0), A, aoff0, t + 2);
        G8_BAR; G8_WAIT_L(0); G8_MMA(1, 0, At, B0); G8_BAR; G8_SCHED;
        G8_STAGE(G8_SB(0, 1), Bt1, boff0, t + 2);
        G8_WAIT_V(6); G8_BAR; G8_MMA(1, 1, At, B1); G8_BAR;
        G8_LDB(B0, 1, 0); G8_SCHED; G8_LDA(At, 1, 0); G8_STAGE(G8_SA(0, 1), A, aoff1, t + 2);
        G8_WAIT_L(8); G8_BAR; G8_WAIT_L(0); G8_MMA(0, 0, At, B0); G8_BAR; G8_SCHED;
        G8_LDB(B1, 1, 1); G8_STAGE(G8_SB(1, 0), Bt, boff0, t + 3);
        G8_BAR; G8_WAIT_L(0); G8_MMA(0, 1, At, B1); G8_BAR;
        G8_LDA(At, 1, 1); G8_STAGE(G8_SA(1, 0), A, aoff0, t + 3);
        G8_BAR; G8_WAIT_L(0); G8_MMA(1, 0, At, B0); G8_BAR; G8_SCHED;
        G8_STAGE(G8_SB(1, 1), Bt1, boff0, t + 3);
        G8_WAIT_V(6); G8_BAR; G8_MMA(1, 1, At, B1); G8_BAR;
    }
    { G8_LDB(B0, 0, 0); G8_WAIT_V(0); G8_LDA(At, 0, 0); G8_STAGE(G8_SA(1, 1), A, aoff1, nt - 1);
      G8_BAR; G8_WAIT_L(0); G8_MMA(0, 0, At, B0); G8_BAR;
      G8_LDB(B1, 0, 1); G8_BAR; G8_WAIT_L(0); G8_MMA(0, 1, At, B1); G8_BAR;
      G8_LDA(At, 0, 1); G8_WAIT_V(4); G8_BAR; G8_WAIT_L(0); G8_MMA(1, 0, At, B0); G8_MMA(1, 1, At, B1); G8_BAR; }
    { G8_LDB(B0, 1, 0); G8_LDA(At, 1, 0); G8_WAIT_V(2); G8_BAR; G8_WAIT_L(0); G8_MMA(0, 0, At, B0); G8_BAR;
      G8_LDB(B1, 1, 1); G8_WAIT_V(0); G8_BAR; G8_WAIT_L(0); G8_MMA(0, 1, At, B1); G8_BAR;
      G8_LDA(At, 1, 1); G8_BAR; G8_WAIT_L(0); G8_MMA(1, 0, At, B0); G8_MMA(1, 1, At, B1); G8_BAR; }
    if (wr == 0) G8_BAR;
    asm volatile("" : "+v"(tz)); wid = tz >> 6; lane = tz & 63; wr = wid >> 2; wc = wid & 3; fr = lane & 15; fq = lane >> 4;
    if (nx.valid) {
        if (nx.rowidx) { if (tz < 256) icache[tz] = nidx; G8_WAIT_L(0); G8_BAR; }
        unsigned na0[2], na1[2], nb0[2];
#pragma unroll
        for (int i = 0; i < 2; ++i) {
            int r, c; g8_stage_rc(tz * 16 + i * 8192, r, c);
            int r0 = r, r1 = 128 + r;
            if (nx.rowidx) { r0 = icache[r0]; r1 = icache[r1]; }
            na0[i] = (unsigned)(r0 * lda + c) * 2u; na1[i] = (unsigned)(r1 * lda + c) * 2u; nb0[i] = (unsigned)(r * ldb + c) * 2u;
        }
        const bf16_t* nBt1 = nx.Bt + (size_t)128 * ldb;
        G8_STAGE(G8_SB(0, 0), nx.Bt, nb0, 0); G8_STAGE(G8_SA(0, 0), nx.A, na0, 0);
        G8_STAGE(G8_SB(0, 1), nBt1, nb0, 0); G8_STAGE(G8_SA(0, 1), nx.A, na1, 0);
    }
#pragma unroll
    for (int ai = 0; ai < 2; ++ai)
#pragma unroll
        for (int m = 0; m < 4; ++m)
#pragma unroll
            for (int bj = 0; bj < 2; ++bj)
#pragma unroll
                for (int n = 0; n < 2; ++n) epi(ai * 128 + wr * 64 + m * 16 + fr, bj * 128 + wc * 32 + n * 16 + fq * 4, acc[ai][bj][m][n]);
    G8_BAR;
}

#define XU_LOOP(nM_, nN_) const int xu_x = BID & 7, xu_nb = gridDim.x >> 3, xu_own = ((nM_) - xu_x + 7) >> 3, xu_nN = (nN_); for (int xv = BID >> 3; xv < xu_own * xu_nN; xv += xu_nb)
#define XU_UNIT() ((xu_x + 8 * (xv / xu_nN)) * xu_nN + (xv % xu_nN))
__device__ __forceinline__ void ph_inproj(const Params& pkv, KPtr kp_in, int wbase_in, int l, char* lds) {
    PH_HEAD
    const bf16_t* Bt = p.win_t + (size_t)l * NINP * 1024;
    const int ntn = NINP / 256, nunits = (NT / 256) * ntn;
    bool pre = false;
    XU_LOOP(NT / 256, ntn) {
        const int u = XU_UNIT();
        const int mt = u / ntn, nt = u % ntn, un = u + gridDim.x, mt2 = un / ntn, nt2 = un % ntn;
        G8Next nx; nx.valid = 0; nx.rowidx = nullptr; nx.nvalid = 256; nx.A = p.xb + (size_t)mt2 * 256 * 1024; nx.Bt = Bt + (size_t)nt2 * 256 * 1024;
        bf16_t* out = p.pbuf + (size_t)mt * 256 * NINP + nt * 256;
        gemm_tile256(p.xb + (size_t)mt * 256 * 1024, 1024, nullptr, 256, Bt + (size_t)nt * 256 * 1024, 1024, 1024, lds, wbase_in, pre, nx,
                     [=](int r, int c, f32x4 v) mutable { uint2 o; o.x = cvtpk(v[0], v[1]); o.y = cvtpk(v[2], v[3]); *(uint2*)(out + (size_t)r * NINP + c) = o; });
        pre = nx.valid != 0;
    }
}

__device__ __forceinline__ void ph_rope_prep(const Params& pkv, KPtr kp_in, int wbase_in, int l) {
    PH_HEAD
    const int lane = TID & 63, gw = BID * (NTHREADS / 64) + (TID >> 6), nw = gridDim.x * (NTHREADS / 64);
    for (int t = gw; t < NT; t += nw) {
        const int pos = t % SEQ;
        const bf16_t* pr = p.pbuf + (size_t)t * NINP;
        {
            const int h = lane >> 4, i = lane & 15;
            const float c = p.tab_ret[(pos * 16 + i) * 2], s = p.tab_ret[(pos * 16 + i) * 2 + 1];
            float x1 = bf2f(pr[PC_RQ + h * 32 + i]), x2 = bf2f(pr[PC_RQ + h * 32 + 16 + i]);
            ((bf16_t*)p.rq)[(size_t)t * 128 + h * 32 + i] = f2bf(x1 * c - x2 * s); ((bf16_t*)p.rq)[(size_t)t * 128 + h * 32 + 16 + i] = f2bf(x1 * s + x2 * c);
            x1 = bf2f(pr[PC_RK + h * 32 + i]); x2 = bf2f(pr[PC_RK + h * 32 + 16 + i]);
            const float sc = 0.17677669529663687f;
            ((bf16_t*)p.rk)[(size_t)t * 128 + h * 32 + i] = f2bf((x1 * c - x2 * s) * sc); ((bf16_t*)p.rk)[(size_t)t * 128 + h * 32 + 16 + i] = f2bf((x1 * s + x2 * c) * sc);
        }
        {
            for (int e = lane; e < 256; e += 64) {
                const int h = e >> 6, d = e & 63;
                float qv, kv;
                if (d < 16) {
                    const int i = d & 7; const float c = p.tab_dil[(pos * 8 + i) * 2], s = p.tab_dil[(pos * 8 + i) * 2 + 1];
                    const float q1 = bf2f(pr[PC_DQ + h * 64 + i]), q2 = bf2f(pr[PC_DQ + h * 64 + 8 + i]);
                    const float k1 = bf2f(pr[PC_DK + h * 64 + i]), k2 = bf2f(pr[PC_DK + h * 64 + 8 + i]);
                    if (d < 8) { qv = q1 * c - q2 * s; kv = k1 * c - k2 * s; } else { qv = q1 * s + q2 * c; kv = k1 * s + k2 * c; }
                } else { qv = bf2f(pr[PC_DQ + e]); kv = bf2f(pr[PC_DK + e]); }
                ((bf16_t*)p.dq)[(size_t)t * 256 + e] = f2bf(qv * (0.125f * 1.4426950408889634f)); ((bf16_t*)p.dk)[(size_t)t * 256 + e] = f2bf(kv);
            }
        }
        {
            float ss = 0.f;
            for (int e = lane; e < 256; e += 64) { const float v = bf2f(pr[PC_MQ + e]); ss += v * v; }
            ss = wave_sum(ss);
            float s2 = 0.f;
            for (int e = lane; e < 128; e += 64) { const float v = bf2f(pr[PC_MKV + e]); s2 += v * v; }
            s2 = wave_sum(s2);
            if (lane == 0) { p.rsq[t] = rsqrtf(ss * (1.0f / 256.0f) + 1e-6f); p.rskv[t] = rsqrtf(s2 * (1.0f / 128.0f) + 1e-6f); }
            if (lane < 16) {
                const float c = p.tab_mla[(pos * 16 + lane) * 2], s = p.tab_mla[(pos * 16 + lane) * 2 + 1];
                const float x1 = bf2f(pr[PC_MKR + lane]), x2 = bf2f(pr[PC_MKR + 16 + lane]);
                p.kpe[(size_t)t * 32 + lane] = x1 * c - x2 * s; p.kpe[(size_t)t * 32 + 16 + lane] = x1 * s + x2 * c;
            }
        }
    }
}

__device__ __forceinline__ float ret_log_gamma(int h) { return logf(1.0f - exp2f(-5.0f - (float)h)); }

__device__ __forceinline__ void ph_ret_kv(const Params& pkv, KPtr kp_in, int wbase_in, int l, char* lds) {
    PH_HEAD
    float* kz = (float*)lds;
    float* vs = kz + 128 * 32;
    const int tid = TID;
    for (int u = BID; u < NBATCH * NCH * 4; u += gridDim.x) {
        const int h = u & 3, n = (u >> 2) & 63, b = u >> 8;
        const float lg = ret_log_gamma(h);
        const int t0 = b * SEQ + n * BLK;
        __syncthreads();
        for (int e = tid; e < 128 * 32; e += NTHREADS) { const int j = e >> 5, d = e & 31; kz[e] = bf2f(((const bf16_t*)p.rk)[(size_t)(t0 + j) * 128 + h * 32 + d]) * __expf((float)(BLK - 1 - j) * lg); }
        for (int e = tid; e < 128 * 64; e += NTHREADS) { const int j = e >> 6, c = e & 63; vs[e] = bf2f(p.pbuf[(size_t)(t0 + j) * NINP + PC_RV + h * 64 + c]); }
        __syncthreads();
        const int e = tid & 63, d0 = (tid >> 6) * 4;
        float a0 = 0.f, a1 = 0.f, a2 = 0.f, a3 = 0.f;
#pragma unroll 8
        for (int j = 0; j < BLK; ++j) {
            const float vv = vs[j * 64 + e]; const float4 kk = *(const float4*)(kz + j * 32 + d0);
            a0 += kk.x * vv; a1 += kk.y * vv; a2 += kk.z * vv; a3 += kk.w * vv;
        }
        float* out = p.rkv + (size_t)u * 2048;
        out[(d0 + 0) * 64 + e] = a0; out[(d0 + 1) * 64 + e] = a1; out[(d0 + 2) * 64 + e] = a2; out[(d0 + 3) * 64 + e] = a3;
    }
}
__device__ __forceinline__ void ph_ret_scan(const Params& pkv, KPtr kp_in, int wbase_in, int l) {
    PH_HEAD
    const int i = BID * NTHREADS + TID;
    if (i < NBATCH * 4 * 32 * 64) {
        const int e = i & 63, d = (i >> 6) & 31, h = (i >> 11) & 3, b = i >> 13;
        const float cd = __expf((float)BLK * ret_log_gamma(h));
        float s = 0.f;
        for (int n = 0; n < NCH; ++n) {
            const size_t idx = ((((size_t)b * NCH + n) * 4 + h) * 32 + d) * 64 + e;
            p.rstate[idx] = s; s = cd * s + p.rkv[idx];
        }
    }
}
__device__ __forceinline__ void ph_ret_out(const Params& pkv, KPtr kp_in, int wbase_in, int l, char* lds) {
    PH_HEAD
    constexpr int KSTR = 40, VSTR = 132, SSTR = 40, UNIT_BYTES = (128 * KSTR + 64 * VSTR + 64 * SSTR) * 2;
    const int tid = TID, lane = tid & 63, wv = tid >> 6, hb = wv >> 2, w = wv & 3, r = lane & 31, hh = lane >> 5, ht = tid & 255;
    bf16_t* Ks = (bf16_t*)(lds + hb * UNIT_BYTES);
    bf16_t* Vt = Ks + 128 * KSTR;
    bf16_t* St = Vt + 64 * VSTR;
    const bf16_t* rqb = (const bf16_t*)p.rq; const bf16_t* rkb = (const bf16_t*)p.rk;
    int* wq = p.wq + l * 16 + 2;
    volatile int* wslot = (volatile int*)(lds + 2 * UNIT_BYTES);
    for (;;) {
        __syncthreads();
        if (tid == 0) *wslot = atomicAdd(wq, 1);
        __syncthreads();
        const int u0 = __builtin_amdgcn_readfirstlane(*wslot) * 2;
        if (u0 >= NBATCH * NCH * 4) break;
        const int u = u0 + hb, h = u & 3, n = (u >> 2) & 63, b = u >> 8;
        const int t0 = b * SEQ + n * BLK;
        const float lg2 = ret_log_gamma(h) * 1.4426950408889634f;
        __syncthreads();
#pragma unroll
        for (int i = 0; i < 2; ++i) { const int c = ht + i * 256, key = c >> 2, ch = c & 3; *(u32x4*)(Ks + key * KSTR + ch * 8) = *(const u32x4*)(rkb + (size_t)(t0 + key) * 128 + h * 32 + ch * 8); }
#pragma unroll
        for (int i = 0; i < 4; ++i) {
            const int c = ht + i * 256, key = c & 127, ch = c >> 7;
            const u32x4 rv = *(const u32x4*)(p.pbuf + (size_t)(t0 + key) * NINP + PC_RV + h * 64 + ch * 8);
            bf16_t* vd = Vt + (ch * 8) * VSTR + key;
            vd[0] = (bf16_t)(rv[0] & 0xffff); vd[VSTR] = (bf16_t)(rv[0] >> 16); vd[2 * VSTR] = (bf16_t)(rv[1] & 0xffff); vd[3 * VSTR] = (bf16_t)(rv[1] >> 16);
            vd[4 * VSTR] = (bf16_t)(rv[2] & 0xffff); vd[5 * VSTR] = (bf16_t)(rv[2] >> 16); vd[6 * VSTR] = (bf16_t)(rv[3] & 0xffff); vd[7 * VSTR] = (bf16_t)(rv[3] >> 16);
        }
        {
            const float* st = p.rstate + (size_t)u * 2048;
#pragma unroll
            for (int i = 0; i < 8; ++i) { const int c = ht + i * 256, d = c >> 6, e = c & 63; St[e * SSTR + d] = f2bf(st[c]); }
        }
        __syncthreads();
        const int iq = 32 * w + r, t = t0 + iq;
        bf16x8 qf[2];
#pragma unroll
        for (int s = 0; s < 2; ++s) qf[s] = *(const bf16x8*)(rqb + (size_t)t * 128 + h * 32 + 16 * s + 8 * hh);
        f32x16 o0, o1;
#pragma unroll
        for (int i = 0; i < 16; ++i) { o0[i] = 0.f; o1[i] = 0.f; }
#pragma unroll
        for (int s = 0; s < 2; ++s) {
            const bf16x8 sa0 = *(const bf16x8*)(St + r * SSTR + 16 * s + 8 * hh), sa1 = *(const bf16x8*)(St + (32 + r) * SSTR + 16 * s + 8 * hh);
            o0 = __builtin_amdgcn_mfma_f32_32x32x16_bf16(sa0, qf[s], o0, 0, 0, 0);
            o1 = __builtin_amdgcn_mfma_f32_32x32x16_bf16(sa1, qf[s], o1, 0, 0, 0);
        }
        {
            const float xi = __builtin_amdgcn_exp2f((float)(iq + 1) * lg2);
#pragma unroll
            for (int i = 0; i < 16; ++i) { o0[i] *= xi; o1[i] *= xi; }
        }
        float cdec[16];
#pragma unroll
        for (int i = 0; i < 16; ++i) cdec[i] = __builtin_amdgcn_exp2f(-(float)((i & 3) + 8 * (i >> 2) + 4 * hh) * lg2);
        for (int jt = 0; jt <= w; ++jt) {
            f32x16 st;
#pragma unroll
            for (int i = 0; i < 16; ++i) st[i] = 0.f;
#pragma unroll
            for (int s = 0; s < 2; ++s) { const bf16x8 kf = *(const bf16x8*)(Ks + (32 * jt + r) * KSTR + 16 * s + 8 * hh); st = __builtin_amdgcn_mfma_f32_32x32x16_bf16(kf, qf[s], st, 0, 0, 0); }
            const float al = __builtin_amdgcn_exp2f((float)(32 * (w - jt) + r) * lg2);
            if (jt == w) {
#pragma unroll
                for (int i = 0; i < 16; ++i) { const int kr = (i & 3) + 8 * (i >> 2) + 4 * hh; st[i] = (kr <= r) ? st[i] * (al * cdec[i]) : 0.f; }
            } else {
#pragma unroll
                for (int i = 0; i < 16; ++i) st[i] *= al * cdec[i];
            }
#pragma unroll
            for (int s = 0; s < 2; ++s) {
                u32x4 pw; pw[0] = cvtpk(st[8 * s], st[8 * s + 1]); pw[1] = cvtpk(st[8 * s + 2], st[8 * s + 3]); pw[2] = cvtpk(st[8 * s + 4], st[8 * s + 5]); pw[3] = cvtpk(st[8 * s + 6], st[8 * s + 7]);
                const bf16x8 pf = __builtin_bit_cast(bf16x8, pw);
                const bf16_t* va = Vt + r * VSTR + 32 * jt + 16 * s + 4 * hh;
                const s16x4 a0 = *(const s16x4*)(va), a1 = *(const s16x4*)(va + 8), b0 = *(const s16x4*)(va + 32 * VSTR), b1 = *(const s16x4*)(va + 32 * VSTR + 8);
                o0 = __builtin_amdgcn_mfma_f32_32x32x16_bf16(__builtin_shufflevector(a0, a1, 0, 1, 2, 3, 4, 5, 6, 7), pf, o0, 0, 0, 0);
                o1 = __builtin_amdgcn_mfma_f32_32x32x16_bf16(__builtin_shufflevector(b0, b1, 0, 1, 2, 3, 4, 5, 6, 7), pf, o1, 0, 0, 0);
            }
        }
        float ss = 0.f;
#pragma unroll
        for (int i = 0; i < 16; ++i) ss += o0[i] * o0[i] + o1[i] * o1[i];
        ss = xhalf_sum(ss);
        const float rs = rsqrtf(ss * (1.0f / 64.0f) + 1e-6f);
        const float* ng = p.ret_norm_g + l * 256 + h * 64 + 4 * hh;
        const bf16_t* gp = p.pbuf + (size_t)t * NINP + PC_RG + h * 64 + 4 * hh;
        bf16_t* outp = p.mixcat + (size_t)t * 1024 + h * 64 + 4 * hh;
#pragma unroll
        for (int c = 0; c < 2; ++c)
#pragma unroll
            for (int g = 0; g < 4; ++g) {
                const int eo = 32 * c + 8 * g;
                const f32x4 gn = *(const f32x4*)(ng + eo); const uint2 gu = *(const uint2*)(gp + eo);
                const float g0 = __uint_as_float(gu.x << 16), g1 = __uint_as_float(gu.x & 0xffff0000u), g2 = __uint_as_float(gu.y << 16), g3 = __uint_as_float(gu.y & 0xffff0000u);
                const float v0 = (c ? o1[4 * g] : o0[4 * g]) * rs * gn[0], v1 = (c ? o1[4 * g + 1] : o0[4 * g + 1]) * rs * gn[1], v2 = (c ? o1[4 * g + 2] : o0[4 * g + 2]) * rs * gn[2], v3 = (c ? o1[4 * g + 3] : o0[4 * g + 3]) * rs * gn[3];
                uint2 ov; ov.x = cvtpk(g0 * sigmoidf_(g0) * v0, g1 * sigmoidf_(g1) * v1); ov.y = cvtpk(g2 * sigmoidf_(g2) * v2, g3 * sigmoidf_(g3) * v3);
                *(uint2*)(outp + eo) = ov;
            }
    }
}

__device__ __forceinline__ void ph_dil_attn(const Params& pkv, KPtr kp_in, int wbase_in, int l, char* lds) {
    PH_HEAD
    constexpr int KSTR = 72, VSTR = 68;
    bf16_t* Ks = (bf16_t*)lds;
    bf16_t* Vt = Ks + 64 * KSTR;
    const int tid = TID, lane = tid & 63, wv = tid >> 6, r = lane & 31, h = lane >> 5;
    int* wq = p.wq + l * 16 + 1;
    volatile int* wslot = (volatile int*)(lds + 24576);
    for (;;) {
        __syncthreads();
        if (tid == 0) *wslot = atomicAdd(wq, 1);
        __syncthreads();
        const int it = __builtin_amdgcn_readfirstlane(*wslot);
        if (it >= 16 * 96) break;
        const int bh = it & 15, u = it >> 4;
        const int b = bh >> 2, hd = bh & 3;
        int pat, dil, rr, m0;
        if (u < 32) { pat = 0; dil = 1; rr = 0; m0 = u * 256; }
        else if (u < 64) { pat = 1; dil = 4; rr = (u - 32) >> 3; m0 = ((u - 32) & 7) * 256; }
        else { pat = 2; dil = 16; rr = (u - 64) >> 1; m0 = ((u - 64) & 1) * 256; }
        const int qmin = m0 + 32 * wv, qmax = qmin + 31, myq = qmin + r;
        const size_t tok0 = (size_t)b * SEQ + rr;
        bf16x8 qf[4];
        {
            const bf16_t* qrow = (const bf16_t*)p.dq + (tok0 + (size_t)dil * myq) * 256 + hd * 64 + 8 * h;
#pragma unroll
            for (int s = 0; s < 4; ++s) qf[s] = *(const bf16x8*)(qrow + 16 * s);
        }
        f32x16 o0, o1;
#pragma unroll
        for (int i = 0; i < 16; ++i) { o0[i] = 0.f; o1[i] = 0.f; }
        float m = -1e30f, lsum = 0.f;
        const int kk = tid >> 3, kc = tid & 7, vk = tid & 63, vc = tid >> 6;
        const bf16_t* kbase = (const bf16_t*)p.dk + hd * 64 + kc * 8;
        const bf16_t* vbase = p.pbuf + PC_DV + hd * 64 + vc * 8;
        const int j0 = (m0 == 0) ? 2 : 0;
        u32x4 rk, rv;
        {
            const int kb = m0 - 128 + 64 * j0;
            rk = *(const u32x4*)(kbase + (tok0 + (size_t)dil * (kb + kk)) * 256);
            rv = *(const u32x4*)(vbase + (tok0 + (size_t)dil * (kb + vk)) * NINP);
        }
        for (int j = j0; j < 6; ++j) {
            __syncthreads();
            *(u32x4*)(Ks + kk * KSTR + kc * 8) = rk;
            {
                const unsigned w0 = rv[0], w1 = rv[1], w2 = rv[2], w3 = rv[3];
                bf16_t* vd = Vt + (vc * 8) * VSTR + vk;
                vd[0] = (bf16_t)(w0 & 0xffff); vd[VSTR] = (bf16_t)(w0 >> 16); vd[2 * VSTR] = (bf16_t)(w1 & 0xffff); vd[3 * VSTR] = (bf16_t)(w1 >> 16);
                vd[4 * VSTR] = (bf16_t)(w2 & 0xffff); vd[5 * VSTR] = (bf16_t)(w2 >> 16); vd[6 * VSTR] = (bf16_t)(w3 & 0xffff); vd[7 * VSTR] = (bf16_t)(w3 >> 16);
            }
            __syncthreads();
            const int kb = m0 - 128 + 64 * j;
            if (j + 1 < 6) {
                const int kn = kb + 64;
                rk = *(const u32x4*)(kbase + (tok0 + (size_t)dil * (kn + kk)) * 256);
                rv = *(const u32x4*)(vbase + (tok0 + (size_t)dil * (kn + vk)) * NINP);
            }
            const bool need0 = (kb <= qmax) && (kb + 31 >= qmin - 128);
            const bool need1 = (kb + 32 <= qmax) && (kb + 63 >= qmin - 128);
            if (need0 || need1) {
                f32x16 s0, s1;
#pragma unroll
                for (int i = 0; i < 16; ++i) { s0[i] = -3e38f; s1[i] = -3e38f; }
                if (need0) {
#pragma unroll
                    for (int i = 0; i < 16; ++i) s0[i] = 0.f;
#pragma unroll
                    for (int s = 0; s < 4; ++s) { const bf16x8 kf = *(const bf16x8*)(Ks + r * KSTR + 16 * s + 8 * h); s0 = __builtin_amdgcn_mfma_f32_32x32x16_bf16(kf, qf[s], s0, 0, 0, 0); }
                    if (!((kb + 31 <= qmin) && (kb >= qmax - 128))) {
#pragma unroll
                        for (int i = 0; i < 16; ++i) { const int key = kb + (i & 3) + 8 * (i >> 2) + 4 * h; if (key > myq || key < myq - 128) s0[i] = -3e38f; }
                    }
                }
                if (need1) {
#pragma unroll
                    for (int i = 0; i < 16; ++i) s1[i] = 0.f;
#pragma unroll
                    for (int s = 0; s < 4; ++s) { const bf16x8 kf = *(const bf16x8*)(Ks + (32 + r) * KSTR + 16 * s + 8 * h); s1 = __builtin_amdgcn_mfma_f32_32x32x16_bf16(kf, qf[s], s1, 0, 0, 0); }
                    if (!((kb + 63 <= qmin) && (kb + 32 >= qmax - 128))) {
#pragma unroll
                        for (int i = 0; i < 16; ++i) { const int key = kb + 32 + (i & 3) + 8 * (i >> 2) + 4 * h; if (key > myq || key < myq - 128) s1[i] = -3e38f; }
                    }
                }
                float mx = s0[0];
#pragma unroll
                for (int i = 1; i < 16; ++i) mx = fmaxf(mx, s0[i]);
#pragma unroll
                for (int i = 0; i < 16; ++i) mx = fmaxf(mx, s1[i]);
                mx = xhalf_max(mx);
                const float mn = fmaxf(m, mx), alpha = __builtin_amdgcn_exp2f(m - mn);
                m = mn;
                float ps = 0.f;
                if (need0) {
#pragma unroll
                    for (int i = 0; i < 16; ++i) { s0[i] = __builtin_amdgcn_exp2f(s0[i] - mn); ps += s0[i]; }
                }
                if (need1) {
#pragma unroll
                    for (int i = 0; i < 16; ++i) { s1[i] = __builtin_amdgcn_exp2f(s1[i] - mn); ps += s1[i]; }
                }
                lsum = lsum * alpha + ps;
                if (!__all(alpha == 1.0f)) {
#pragma unroll
                    for (int i = 0; i < 16; ++i) { o0[i] *= alpha; o1[i] *= alpha; }
                }
                if (need0) {
#pragma unroll
                    for (int s = 0; s < 2; ++s) {
                        u32x4 pw; pw[0] = cvtpk(s0[8 * s], s0[8 * s + 1]); pw[1] = cvtpk(s0[8 * s + 2], s0[8 * s + 3]); pw[2] = cvtpk(s0[8 * s + 4], s0[8 * s + 5]); pw[3] = cvtpk(s0[8 * s + 6], s0[8 * s + 7]);
                        const bf16x8 pf = __builtin_bit_cast(bf16x8, pw);
                        const bf16_t* va = Vt + r * VSTR + 16 * s + 4 * h;
                        const s16x4 a0 = *(const s16x4*)(va), a1 = *(const s16x4*)(va + 8), b0 = *(const s16x4*)(va + 32 * VSTR), b1 = *(const s16x4*)(va + 32 * VSTR + 8);
                        o0 = __builtin_amdgcn_mfma_f32_32x32x16_bf16(__builtin_shufflevector(a0, a1, 0, 1, 2, 3, 4, 5, 6, 7), pf, o0, 0, 0, 0);
                        o1 = __builtin_amdgcn_mfma_f32_32x32x16_bf16(__builtin_shufflevector(b0, b1, 0, 1, 2, 3, 4, 5, 6, 7), pf, o1, 0, 0, 0);
                    }
                }
                if (need1) {
#pragma unroll
                    for (int s = 0; s < 2; ++s) {
                        u32x4 pw; pw[0] = cvtpk(s1[8 * s], s1[8 * s + 1]); pw[1] = cvtpk(s1[8 * s + 2], s1[8 * s + 3]); pw[2] = cvtpk(s1[8 * s + 4], s1[8 * s + 5]); pw[3] = cvtpk(s1[8 * s + 6], s1[8 * s + 7]);
                        const bf16x8 pf = __builtin_bit_cast(bf16x8, pw);
                        const bf16_t* va = Vt + r * VSTR + 32 + 16 * s + 4 * h;
                        const s16x4 a0 = *(const s16x4*)(va), a1 = *(const s16x4*)(va + 8), b0 = *(const s16x4*)(va + 32 * VSTR), b1 = *(const s16x4*)(va + 32 * VSTR + 8);
                        o0 = __builtin_amdgcn_mfma_f32_32x32x16_bf16(__builtin_shufflevector(a0, a1, 0, 1, 2, 3, 4, 5, 6, 7), pf, o0, 0, 0, 0);
                        o1 = __builtin_amdgcn_mfma_f32_32x32x16_bf16(__builtin_shufflevector(b0, b1, 0, 1, 2, 3, 4, 5, 6, 7), pf, o1, 0, 0, 0);
                    }
                }
            }
        }
        const float lt = xhalf_sum(lsum), inv = 1.0f / lt;
        const size_t tq = tok0 + (size_t)dil * myq;
        float* op = p.dob + ((size_t)pat * NT + tq) * 256 + hd * 64 + 4 * h;
#pragma unroll
        for (int g = 0; g < 4; ++g) {
            *(f32x4*)(op + 8 * g) = (f32x4){o0[4 * g] * inv, o0[4 * g + 1] * inv, o0[4 * g + 2] * inv, o0[4 * g + 3] * inv};
            *(f32x4*)(op + 32 + 8 * g) = (f32x4){o1[4 * g] * inv, o1[4 * g + 1] * inv, o1[4 * g + 2] * inv, o1[4 * g + 3] * inv};
        }
        if (h == 0) p.dlse[((size_t)pat * NT + tq) * 4 + hd] = m + __builtin_amdgcn_logf(lt);
        __syncthreads();
    }
}

__device__ __forceinline__ void ph_rwkv_prep(const Params& pkv, KPtr kp_in, int wbase_in, int l, char* lds) {
    PH_HEAD
    bf16_t* Aw = (bf16_t*)lds; bf16_t* Aa = Aw + 64 * 72; bf16_t* Ag = Aa + 64 * 72; bf16_t* Av = Ag + 64 * 136; float* ssq = (float*)(Av + 64 * 40);
    const int tid = TID, lane = tid & 63, wv = tid >> 6, fr = lane & 15, fq = lane >> 4;
    const int lm = (l > 0) ? l - 1 : 0;
    const float* mu = p.rwkv_mu + l * 1024; const float* vmu = p.vres_mu + lm * 32;
    bf16x8 fw[2][2], fa[2][2], fg[2][4], fv[2];
#pragma unroll
    for (int ni = 0; ni < 2; ++ni) {
        const int n = 32 * wv + 16 * ni + fr;
#pragma unroll
        for (int ks = 0; ks < 2; ++ks) { fw[ni][ks] = *(const bf16x8*)(p.wupt + ((size_t)l * 256 + n) * 64 + 32 * ks + 8 * fq); fa[ni][ks] = *(const bf16x8*)(p.aupt + ((size_t)l * 256 + n) * 64 + 32 * ks + 8 * fq); }
#pragma unroll
        for (int ks = 0; ks < 4; ++ks) fg[ni][ks] = *(const bf16x8*)(p.gupt + ((size_t)l * 256 + n) * 128 + 32 * ks + 8 * fq);
        fv[ni] = *(const bf16x8*)(p.vupt + ((size_t)lm * 256 + n) * 32 + 8 * fq);
    }
    for (int tb = BID * 64; tb < NT; tb += gridDim.x * 64) {
        __syncthreads();
        for (int e = tid; e < 64 * 144; e += NTHREADS) {
            const int tt = e / 144, j = (e % 144) * 2, t = tb + tt;
            const bool first = (t % SEQ) == 0;
            const bf16_t* pr = p.pbuf + (size_t)t * NINP;
            int col; float m0, m1;
            if (j < 256) { col = PC_CWD + j; m0 = mu[768 + j]; m1 = mu[768 + j + 1]; } else { col = PC_VRES + (j - 256); m0 = vmu[j - 256]; m1 = vmu[j - 255]; }
            const unsigned cu = *(const unsigned*)(pr + col), pu = first ? 0u : *(const unsigned*)(pr + col - NINP);
            const float c0 = __uint_as_float(cu << 16), c1 = __uint_as_float(cu & 0xffff0000u), p0 = __uint_as_float(pu << 16), p1 = __uint_as_float(pu & 0xffff0000u);
            float x0 = c0 + (p0 - c0) * m0, x1 = c1 + (p1 - c1) * m1;
            bf16_t* dst;
            if (j < 64) { x0 = tanhf(x0); x1 = tanhf(x1); dst = Aw + tt * 72 + j; }
            else if (j < 128) { dst = Aa + tt * 72 + (j - 64); }
            else if (j < 256) { x0 = sigmoidf_(x0); x1 = sigmoidf_(x1); dst = Ag + tt * 136 + (j - 128); }
            else { dst = Av + tt * 40 + (j - 256); }
            *(unsigned*)dst = cvtpk(x0, x1);
        }
        {
            const f32x4 kkc = *(const f32x4*)(p.rwkv_k_k + l * 256 + lane * 4), mk4 = *(const f32x4*)(mu + 256 + lane * 4);
#pragma unroll
            for (int i = 0; i < 8; ++i) {
                const int tt = wv * 8 + i, t = tb + tt; const bool first = (t % SEQ) == 0;
                const bf16_t* pr = p.pbuf + (size_t)t * NINP + PC_CK + lane * 4;
                const uint2 cu = *(const uint2*)pr; const uint2 pu = first ? make_uint2(0u, 0u) : *(const uint2*)(pr - NINP);
                const float c0 = __uint_as_float(cu.x << 16), c1 = __uint_as_float(cu.x & 0xffff0000u), c2 = __uint_as_float(cu.y << 16), c3 = __uint_as_float(cu.y & 0xffff0000u);
                const float q0 = __uint_as_float(pu.x << 16), q1 = __uint_as_float(pu.x & 0xffff0000u), q2 = __uint_as_float(pu.y << 16), q3 = __uint_as_float(pu.y & 0xffff0000u);
                const float k0 = (c0 + (q0 - c0) * mk4[0]) * kkc[0], k1 = (c1 + (q1 - c1) * mk4[1]) * kkc[1], k2 = (c2 + (q2 - c2) * mk4[2]) * kkc[2], k3 = (c3 + (q3 - c3) * mk4[3]) * kkc[3];
                const float ss = grp16_sum(k0 * k0 + k1 * k1 + k2 * k2 + k3 * k3);
                if ((lane & 15) == 0) ssq[tt * 4 + (lane >> 4)] = ss;
            }
        }
        __syncthreads();
#pragma unroll 1
        for (int mt = 0; mt < 4; ++mt) {
            f32x4 cw[2], ca[2], cg[2], cv[2];
#pragma unroll
            for (int ni = 0; ni < 2; ++ni) { cw[ni] = (f32x4){0.f, 0.f, 0.f, 0.f}; ca[ni] = cw[ni]; cg[ni] = cw[ni]; cv[ni] = cw[ni]; }
            const int arow = 16 * mt + fr;
#pragma unroll
            for (int ks = 0; ks < 2; ++ks) {
                const bf16x8 xw = *(const bf16x8*)(Aw + arow * 72 + 32 * ks + 8 * fq), xa = *(const bf16x8*)(Aa + arow * 72 + 32 * ks + 8 * fq);
#pragma unroll
                for (int ni = 0; ni < 2; ++ni) { cw[ni] = __builtin_amdgcn_mfma_f32_16x16x32_bf16(fw[ni][ks], xw, cw[ni], 0, 0, 0); ca[ni] = __builtin_amdgcn_mfma_f32_16x16x32_bf16(fa[ni][ks], xa, ca[ni], 0, 0, 0); }
            }
#pragma unroll
            for (int ks = 0; ks < 4; ++ks) {
                const bf16x8 xg = *(const bf16x8*)(Ag + arow * 136 + 32 * ks + 8 * fq);
#pragma unroll
                for (int ni = 0; ni < 2; ++ni) cg[ni] = __builtin_amdgcn_mfma_f32_16x16x32_bf16(fg[ni][ks], xg, cg[ni], 0, 0, 0);
            }
            if (l > 0) {
                const bf16x8 xv = *(const bf16x8*)(Av + arow * 40 + 8 * fq);
#pragma unroll
                for (int ni = 0; ni < 2; ++ni) cv[ni] = __builtin_amdgcn_mfma_f32_16x16x32_bf16(fv[ni], xv, cv[ni], 0, 0, 0);
            }
            const int tt = 16 * mt + fr, t = tb + tt; const bool first = (t % SEQ) == 0;
            const float rn = 1.0f / fmaxf(sqrtf(ssq[tt * 4 + (wv >> 1)]), 1e-12f);
            const bf16_t* pr = p.pbuf + (size_t)t * NINP;
#pragma unroll
            for (int ni = 0; ni < 2; ++ni) {
                const int c0 = 32 * wv + 16 * ni + 4 * fq;
                const f32x4 w0 = *(const f32x4*)(p.rwkv_w0 + l * 256 + c0), a0 = *(const f32x4*)(p.rwkv_a0 + l * 256 + c0), kkc = *(const f32x4*)(p.rwkv_k_k + l * 256 + c0), kac = *(const f32x4*)(p.rwkv_k_a + l * 256 + c0);
                const f32x4 v0 = *(const f32x4*)(p.rwkv_v0 + lm * 256 + c0), mr = *(const f32x4*)(mu + c0), mk = *(const f32x4*)(mu + 256 + c0), mv = *(const f32x4*)(mu + 512 + c0);
                const uint2 ru = *(const uint2*)(pr + PC_CR + c0), ku = *(const uint2*)(pr + PC_CK + c0), vu = *(const uint2*)(pr + PC_CV + c0);
                uint2 rp = make_uint2(0u, 0u), kp2 = rp, vp = rp;
                if (!first) { rp = *(const uint2*)(pr + PC_CR + c0 - NINP); kp2 = *(const uint2*)(pr + PC_CK + c0 - NINP); vp = *(const uint2*)(pr + PC_CV + c0 - NINP); }
                const size_t o = (size_t)t * 256 + c0;
                f32x4 vf = (f32x4){0.f, 0.f, 0.f, 0.f};
                if (l > 0) vf = *(const f32x4*)(p.vfirst + o);
                f32x4 o_r, o_w, o_k, o_v, o_a, o_b;
#pragma unroll
                for (int j = 0; j < 4; ++j) {
                    const unsigned rw = (j < 2) ? ru.x : ru.y, kw = (j < 2) ? ku.x : ku.y, vw = (j < 2) ? vu.x : vu.y, rpw = (j < 2) ? rp.x : rp.y, kpw = (j < 2) ? kp2.x : kp2.y, vpw = (j < 2) ? vp.x : vp.y;
                    const float rc = (j & 1) ? __uint_as_float(rw & 0xffff0000u) : __uint_as_float(rw << 16), kc = (j & 1) ? __uint_as_float(kw & 0xffff0000u) : __uint_as_float(kw << 16), vc = (j & 1) ? __uint_as_float(vw & 0xffff0000u) : __uint_as_float(vw << 16);
                    const float rq = (j & 1) ? __uint_as_float(rpw & 0xffff0000u) : __uint_as_float(rpw << 16), kq = (j & 1) ? __uint_as_float(kpw & 0xffff0000u) : __uint_as_float(kpw << 16), vq = (j & 1) ? __uint_as_float(vpw & 0xffff0000u) : __uint_as_float(vpw << 16);
                    const float r = rc + (rq - rc) * mr[j], k = kc + (kq - kc) * mk[j];
                    float v = vc + (vq - vc) * mv[j];
                    const float wpre = w0[j] + cw[ni][j];
                    const float sp = (-wpre > 20.f) ? -wpre : log1pf(__expf(-wpre));
                    const float decay = __expf(-__expf(-sp - 0.5f));
                    const float a = sigmoidf_(a0[j] + ca[ni][j]);
                    const float kk = k * kkc[j] * rn;
                    const float k2 = k * (1.0f + (a - 1.0f) * kac[j]);
                    if (l == 0) vf[j] = v; else v = v + (vf[j] - v) * sigmoidf_(v0[j] + cv[ni][j]);
                    o_r[j] = r; o_w[j] = decay; o_k[j] = k2; o_v[j] = v; o_a[j] = -kk; o_b[j] = kk * a;
                }
                if (l == 0) *(f32x4*)(p.vfirst + o) = vf;
                *(f32x4*)(p.sr + o) = o_r; *(f32x4*)(p.sw + o) = o_w; *(f32x4*)(p.sk + o) = o_k; *(f32x4*)(p.sv + o) = o_v; *(f32x4*)(p.sa + o) = o_a; *(f32x4*)(p.sb + o) = o_b; *(f32x4*)(p.sg + o) = cg[ni];
            }
        }
    }
}

#define MF4(a, b, c) __builtin_amdgcn_mfma_f32_16x16x4f32((a), (b), (c), 0, 0, 0)
#define WSYNC() asm volatile("s_waitcnt lgkmcnt(0)" ::: "memory")
__device__ __forceinline__ f32x4 mm16(const float* A, int sam, int sak, const float* B, int sbk, int sbn, int K, f32x4 acc, int fr, int fq) {
#pragma unroll 4
    for (int kk = 0; kk < K; kk += 4) { const float a = A[fr * sam + (kk + fq) * sak]; const float b = B[(kk + fq) * sbk + fr * sbn]; acc = MF4(a, b, acc); }
    return acc;
}
constexpr int CH_T = 16, CH_N = SEQ / CH_T, CH_LD = 68, CH_WAVE_FLOATS = 6 * 16 * CH_LD + 5 * 16 * 17 + 64;
__device__ __forceinline__ void ph_rwkv_chunkpre(const Params& pkv, KPtr kp_in, int wbase_in, int l, char* lds) {
    PH_HEAD
    const int tid = TID, lane = tid & 63, wv = tid >> 6, fr = lane & 15, fq = lane >> 4;
    if (wv >= 4) return;
    float* L = (float*)lds + wv * CH_WAVE_FLOATS;
    float* At = L; float* Bt = At + 16 * CH_LD; float* Kt = Bt + 16 * CH_LD; float* Rt = Kt + 16 * CH_LD; float* Vv = Rt + 16 * CH_LD; float* W1 = Vv + 16 * CH_LD;
    float* Pst = (float*)lds + 4 * CH_WAVE_FLOATS + wv * 1024;
    float* Aab = W1 + 16 * CH_LD; float* Aak = Aab + 16 * 17; float* Arb = Aak + 16 * 17; float* Ark = Arb + 16 * 17; float* Mm = Ark + 16 * 17; float* gT = Mm + 16 * 17;
    const f32x4 z4 = (f32x4){0.f, 0.f, 0.f, 0.f};
    for (int u = BID * 4 + wv; u < 16 * CH_N; u += gridDim.x * 4) {
        const int bh = u / CH_N, c = u % CH_N, b = bh >> 2, hd = bh & 3;
        const size_t o0 = ((size_t)b * SEQ + (size_t)c * CH_T) * 256 + hd * 64 + lane;
        WSYNC();
        {
            float g = 1.0f;
#pragma unroll
            for (int t = 0; t < CH_T; ++t) {
                const size_t o = o0 + (size_t)t * 256;
                const float w = p.sw[o], a = p.sa[o], bb = p.sb[o], k = p.sk[o], r = p.sr[o], v = p.sv[o];
                const float gp = g; g *= w; const float ig = 1.0f / g;
                At[t * CH_LD + lane] = a * gp; Bt[t * CH_LD + lane] = bb * ig; Kt[t * CH_LD + lane] = k * ig; Rt[t * CH_LD + lane] = r * g; Vv[t * CH_LD + lane] = v;
            }
            gT[lane] = g;
        }
        WSYNC();
        {
            f32x4 gab = z4, gak = z4, grb = z4, grk = z4;
#pragma unroll 4
            for (int kk = 0; kk < 64; kk += 4) {
                const int o = fr * CH_LD + kk + fq;
                const float aA = At[o], aR = Rt[o], bB = Bt[o], bK = Kt[o];
                gab = MF4(aA, bB, gab); gak = MF4(aA, bK, gak); grb = MF4(aR, bB, grb); grk = MF4(aR, bK, grk);
            }
#pragma unroll
            for (int rg = 0; rg < 4; ++rg) {
                const int t = 4 * fq + rg, s = fr;
                Aab[t * 17 + s] = (s < t) ? gab[rg] : 0.f; Aak[t * 17 + s] = (s < t) ? gak[rg] : 0.f;
                Arb[t * 17 + s] = (s <= t) ? grb[rg] : 0.f; Ark[t * 17 + s] = (s <= t) ? grk[rg] : 0.f;
            }
        }
        WSYNC();
        {
            float m[16];
#pragma unroll
            for (int t = 0; t < 16; ++t) {
                float acc = (t == fr) ? 1.0f : 0.f;
#pragma unroll
                for (int s = 0; s < t; ++s) acc += Aab[t * 17 + s] * m[s];
                m[t] = acc;
            }
            if (fq == 0) {
#pragma unroll
                for (int t = 0; t < 16; ++t) Mm[t * 17 + fr] = m[t];
            }
        }
        WSYNC();
        {
            f32x4 m2 = z4, ah[4] = {z4, z4, z4, z4};
#pragma unroll
            for (int kk = 0; kk < 16; kk += 4) {
                const float a = Mm[fr * 17 + kk + fq];
                m2 = MF4(a, Aak[(kk + fq) * 17 + fr], m2);
#pragma unroll
                for (int nt = 0; nt < 4; ++nt) ah[nt] = MF4(a, At[(kk + fq) * CH_LD + 16 * nt + fr], ah[nt]);
            }
            WSYNC();
#pragma unroll
            for (int rg = 0; rg < 4; ++rg) {
                Aak[(4 * fq + rg) * 17 + fr] = m2[rg];
#pragma unroll
                for (int nt = 0; nt < 4; ++nt) At[(4 * fq + rg) * CH_LD + 16 * nt + fr] = ah[nt][rg];
            }
            WSYNC();
            f32x4 w1[4] = {z4, z4, z4, z4};
#pragma unroll
            for (int kk = 0; kk < 16; kk += 4) {
                const float a = Aak[fr * 17 + kk + fq];
#pragma unroll
                for (int nt = 0; nt < 4; ++nt) w1[nt] = MF4(a, Vv[(kk + fq) * CH_LD + 16 * nt + fr], w1[nt]);
            }
#pragma unroll
            for (int nt = 0; nt < 4; ++nt)
#pragma unroll
                for (int rg = 0; rg < 4; ++rg) W1[(4 * fq + rg) * CH_LD + 16 * nt + fr] = w1[nt][rg];
        }
        WSYNC();
        {
            float* rh = p.c_rh + (size_t)u * 1024; float* y1 = p.c_y1 + (size_t)u * 1024;
            f32x4 ar[4], yy[4];
#pragma unroll
            for (int nt = 0; nt < 4; ++nt) {
                yy[nt] = z4;
#pragma unroll
                for (int rg = 0; rg < 4; ++rg) ar[nt][rg] = Rt[(4 * fq + rg) * CH_LD + 16 * nt + fr];
            }
#pragma unroll
            for (int kk = 0; kk < 16; kk += 4) {
                const float arb = Arb[fr * 17 + kk + fq], ark = Ark[fr * 17 + kk + fq];
#pragma unroll
                for (int nt = 0; nt < 4; ++nt) {
                    const int bo = (kk + fq) * CH_LD + 16 * nt + fr;
                    ar[nt] = MF4(arb, At[bo], ar[nt]); yy[nt] = MF4(arb, W1[bo], yy[nt]); yy[nt] = MF4(ark, Vv[bo], yy[nt]);
                }
            }
#pragma unroll
            for (int nt = 0; nt < 4; ++nt)
#pragma unroll
                for (int rg = 0; rg < 4; ++rg) { rh[(4 * fq + rg) * 64 + 16 * nt + fr] = ar[nt][rg]; y1[(4 * fq + rg) * 64 + 16 * nt + fr] = yy[nt][rg]; }
        }
        {
            float* pp = p.c_p + (size_t)u * 4096; float* qq = p.c_q + (size_t)u * 4096;
#pragma unroll 1
            for (int jt = 0; jt < 4; ++jt) {
                f32x4 ap[4] = {z4, z4, z4, z4}, aq[4] = {z4, z4, z4, z4};
#pragma unroll
                for (int kk = 0; kk < 16; kk += 4) {
                    const int ao = (kk + fq) * CH_LD + 16 * jt + fr;
                    const float a_ah = At[ao], a_w1 = W1[ao], a_v = Vv[ao];
#pragma unroll
                    for (int jc = 0; jc < 4; ++jc) {
                        const int bo = (kk + fq) * CH_LD + 16 * jc + fr;
                        const float b_bt = Bt[bo], b_kt = Kt[bo];
                        ap[jc] = MF4(a_ah, b_bt, ap[jc]); aq[jc] = MF4(a_w1, b_bt, aq[jc]); aq[jc] = MF4(a_v, b_kt, aq[jc]);
                    }
                }
                WSYNC();
#pragma unroll
                for (int jc = 0; jc < 4; ++jc) {
                    const float gc = gT[16 * jc + fr];
#pragma unroll
                    for (int rg = 0; rg < 4; ++rg) {
                        const int row = 16 * jt + 4 * fq + rg, col = 16 * jc + fr;
                        Pst[(jc * 64 + 16 * rg + fr) * 4 + fq] = (ap[jc][rg] + ((row == col) ? 1.0f : 0.f)) * gc; qq[row * 64 + col] = aq[jc][rg] * gc;
                    }
                }
                WSYNC();
#pragma unroll
                for (int i = 0; i < 4; ++i) *(f32x4*)(pp + ((jt * 4 + i) * 64 + lane) * 4) = *(const f32x4*)(Pst + (i * 64 + lane) * 4);
            }
        }
    }
}

constexpr int SCANB_BLOCKS = 64;
__device__ __forceinline__ void ph_rwkv_scan(const Params& pkv, KPtr kp_in, int wbase_in, int l, char* lds) {
    PH_HEAD
    if (BID >= SCANB_BLOCKS) return;
    const int tid = TID, lane = tid & 63, wv = tid >> 6, fr = lane & 15, fq = lane >> 4, w = wv & 3;
    const int sid = BID, bh = sid >> 2, ib = sid & 3, b = bh >> 2, hd = bh & 3, ibase = ib * 16;
    float* exch = (float*)lds;
    float* ypart = (float*)lds + 4096;
    for (int i = tid; i < 8192; i += NTHREADS) ((float*)lds)[i] = 0.f;
    if (wv >= 4) {
        __syncthreads();
        for (int c = 0; c < CH_N; ++c) { __builtin_amdgcn_s_barrier(); }
        return;
    }
    f32x4 cur = (f32x4){0.f, 0.f, 0.f, 0.f};
    const size_t ubase = (size_t)bh * CH_N;
    f32x4 pa[4][4]; f32x4 qv[4], rh[4]; float y1v[4];
#define SCAN_LOAD(S, cc) do { const size_t un_ = ubase + ((cc) < CH_N ? (cc) : CH_N - 1); \
        const f32x4* pp_ = (const f32x4*)(p.c_p + un_ * 4096 + (w * 64 + lane) * 4); \
        pa[S][0] = pp_[0]; pa[S][1] = pp_[256]; pa[S][2] = pp_[512]; pa[S][3] = pp_[768]; \
        qv[S] = *(const f32x4*)(p.c_q + un_ * 4096 + (ibase + fr) * 64 + 16 * w + 4 * fq); \
        rh[S] = *(const f32x4*)(p.c_rh + un_ * 1024 + fr * 64 + 16 * w + 4 * fq); \
        y1v[S] = p.c_y1[un_ * 1024 + (4 * w + fq) * 64 + ibase + fr]; } while (0)
#define SCAN_STEP(S, cc) do { const int bufo = ((cc) & 1) * 2048; \
        float exv[16]; { const float* ex = exch + bufo; _Pragma("unroll") for (int kk = 0; kk < 16; ++kk) exv[kk] = ex[64 * kk + lane]; } \
        __builtin_amdgcn_sched_barrier(0); \
        f32x4 yp = (f32x4){0.f, 0.f, 0.f, 0.f}; \
        _Pragma("unroll") for (int rg = 0; rg < 4; ++rg) yp = MF4(rh[S][rg], cur[rg], yp); \
        asm volatile("s_waitcnt lgkmcnt(0)" ::: "memory"); __builtin_amdgcn_sched_barrier(0); \
        f32x4 acc0 = qv[S], acc1 = (f32x4){0.f, 0.f, 0.f, 0.f}; \
        _Pragma("unroll") for (int kq = 0; kq < 4; ++kq) { \
            acc0 = MF4(pa[S][kq][0], exv[4 * kq], acc0); acc1 = MF4(pa[S][kq][1], exv[4 * kq + 1], acc1); \
            acc0 = MF4(pa[S][kq][2], exv[4 * kq + 2], acc0); acc1 = MF4(pa[S][kq][3], exv[4 * kq + 3], acc1); } \
        cur = acc0 + acc1; \
        { float* yd = ypart + bufo + w * 256; _Pragma("unroll") for (int rg = 0; rg < 4; ++rg) yd[(4 * fq + rg) * 16 + fr] = yp[rg]; } \
        { float* ed = exch + (2048 - bufo) + (16 * w) * 16; _Pragma("unroll") for (int rg = 0; rg < 4; ++rg) ed[(4 * fq + rg) * 16 + fr] = cur[rg]; } \
        asm volatile("s_waitcnt lgkmcnt(0)" ::: "memory"); __builtin_amdgcn_s_barrier(); asm volatile("" ::: "memory"); \
        { const float* ys = ypart + bufo + (4 * w + fq) * 16 + fr; const float y = (ys[0] + ys[256]) + (ys[512] + ys[768]) + y1v[S]; \
          p.sy[((size_t)b * SEQ + (size_t)(cc) * CH_T + 4 * w + fq) * 256 + hd * 64 + ibase + fr] = y; } \
        SCAN_LOAD(S, (cc) + 4); } while (0)
    SCAN_LOAD(0, 0); SCAN_LOAD(1, 1); SCAN_LOAD(2, 2); SCAN_LOAD(3, 3);
    __syncthreads();
    for (int c = 0; c < CH_N; c += 4) { SCAN_STEP(0, c); SCAN_STEP(1, c + 1); SCAN_STEP(2, c + 2); SCAN_STEP(3, c + 3); }
}

__device__ __forceinline__ void ph_mla_up(const Params& pkv, KPtr kp_in, int wbase_in, int l, char* lds) {
    PH_HEAD
    const int nq = (NT / 128) * 3, nkv = (NT / 128) * 4;
    for (int u = BID; u < nq + nkv; u += gridDim.x) {
        if (u < nq) {
            const int mt = u / 3, nt = u % 3;
            float* out = p.qu + (size_t)mt * 128 * 384 + nt * 128; const float* rs = p.rsq + mt * 128;
            gemm_tile128(p.pbuf + (size_t)mt * 128 * NINP + PC_MQ, NINP, nullptr, 128, p.wq_t + ((size_t)l * 384 + nt * 128) * 256, 256, 256, lds, TID,
                         [=](int r, int c, f32x4 v) mutable { const float s = rs[r]; *(f32x4*)(out + (size_t)r * 384 + c) = v * s; });
        } else {
            const int uu = u - nq, mt = uu / 4, nt = uu % 4;
            float* out = p.kvu + (size_t)mt * 128 * 512 + nt * 128; const float* rs = p.rskv + mt * 128;
            gemm_tile128(p.pbuf + (size_t)mt * 128 * NINP + PC_MKV, NINP, nullptr, 128, p.wkv_t + ((size_t)l * 512 + nt * 128) * 128, 128, 128, lds, TID,
                         [=](int r, int c, f32x4 v) mutable { const float s = rs[r]; *(f32x4*)(out + (size_t)r * 512 + c) = v * s; });
        }
    }
}

__device__ __forceinline__ void ph_mla_pack(const Params& pkv, KPtr kp_in, int wbase_in, int l) {
    PH_HEAD
    const int lane = TID & 63, gw = BID * (NTHREADS / 64) + (TID >> 6), nw = gridDim.x * (NTHREADS / 64);
    const float SC = 0.10206207261596575f * 1.4426950408889634f;
    for (int t = gw; t < NT; t += nw) {
        const int pos = t % SEQ;
        const float* qp = p.qu + (size_t)t * 384; const float* kvp = p.kvu + (size_t)t * 512; const float* kp2 = p.kpe + (size_t)t * 32;
        bf16_t* mq = p.mq + (size_t)t * 384; bf16_t* mk = p.mk + (size_t)t * 384; bf16_t* mv = p.mv + (size_t)t * 256;
        for (int e = lane; e < 384; e += 64) {
            const int hd = e / 96, d = e % 96;
            float qv, kv;
            if (d < 64) { qv = qp[e]; kv = kvp[hd * 128 + d]; }
            else {
                const int i = (d - 64) & 15; const float c = p.tab_mla[(pos * 16 + i) * 2], sn = p.tab_mla[(pos * 16 + i) * 2 + 1];
                const float x1 = qp[hd * 96 + 64 + i], x2 = qp[hd * 96 + 80 + i];
                qv = (d < 80) ? (x1 * c - x2 * sn) : (x1 * sn + x2 * c);
                kv = kp2[d - 64];
            }
            mq[e] = f2bf(qv * SC); mk[e] = f2bf(kv);
        }
        for (int e = lane; e < 256; e += 64) mv[e] = f2bf(kvp[(e >> 6) * 128 + 64 + (e & 63)]);
    }
}

__device__ __forceinline__ void ph_mla_attn(const Params& pkv, KPtr kp_in, int wbase_in, int l, char* lds) {
    PH_HEAD
    constexpr int KSTR = 104, VSTR = 68;
    bf16_t* Ks = (bf16_t*)lds;
    bf16_t* Vt = Ks + 64 * KSTR;
    const int tid = TID, lane = tid & 63, wv = tid >> 6, r = lane & 31, h = lane >> 5;
    int* wq = p.wq + l * 16;
    volatile int* wslot = (volatile int*)(lds + 24576);
    for (;;) {
        __syncthreads();
        if (tid == 0) *wslot = atomicAdd(wq, 1);
        __syncthreads();
        const int it = __builtin_amdgcn_readfirstlane(*wslot);
        if (it >= 16 * 32) break;
        const int bh = it & 15, qb = 31 - (it >> 4);
        const int b = bh >> 2, hd = bh & 3, q0 = qb * 256;
        const int qmin = q0 + 32 * wv, qmax = qmin + 31, myq = qmin + r;
        bf16x8 qf[6];
        {
            const bf16_t* qrow = p.mq + ((size_t)(b * SEQ + myq) * 4 + hd) * 96 + 8 * h;
#pragma unroll
            for (int s = 0; s < 6; ++s) qf[s] = *(const bf16x8*)(qrow + 16 * s);
        }
        f32x16 o0, o1;
#pragma unroll
        for (int i = 0; i < 16; ++i) { o0[i] = 0.f; o1[i] = 0.f; }
        float m = -1e30f, lsum = 0.f;
        const int nkt = (q0 + 256) / 64;
        const int kk0 = tid / 12, kc0 = tid % 12, kk1 = (tid + 512) / 12, kc1 = (tid + 512) % 12;
        const int vk = tid & 63, vc = tid >> 6;
        const bf16_t* kbase = p.mk + ((size_t)b * SEQ * 4 + hd) * 96;
        const bf16_t* vbase = p.mv + ((size_t)b * SEQ * 4 + hd) * 64;
        u32x4 rk0, rk1, rv;
        rk0 = *(const u32x4*)(kbase + (size_t)kk0 * 384 + kc0 * 8);
        rk1 = (tid < 256) ? *(const u32x4*)(kbase + (size_t)kk1 * 384 + kc1 * 8) : (u32x4){0u, 0u, 0u, 0u};
        rv = *(const u32x4*)(vbase + (size_t)vk * 256 + vc * 8);
        for (int kt = 0; kt < nkt; ++kt) {
            __syncthreads();
            *(u32x4*)(Ks + kk0 * KSTR + kc0 * 8) = rk0;
            if (tid < 256) *(u32x4*)(Ks + kk1 * KSTR + kc1 * 8) = rk1;
            {
                const unsigned w0 = rv[0], w1 = rv[1], w2 = rv[2], w3 = rv[3];
                bf16_t* vd = Vt + (vc * 8) * VSTR + vk;
                vd[0] = (bf16_t)(w0 & 0xffff); vd[VSTR] = (bf16_t)(w0 >> 16); vd[2 * VSTR] = (bf16_t)(w1 & 0xffff); vd[3 * VSTR] = (bf16_t)(w1 >> 16);
                vd[4 * VSTR] = (bf16_t)(w2 & 0xffff); vd[5 * VSTR] = (bf16_t)(w2 >> 16); vd[6 * VSTR] = (bf16_t)(w3 & 0xffff); vd[7 * VSTR] = (bf16_t)(w3 >> 16);
            }
            __syncthreads();
            if (kt + 1 < nkt) {
                const size_t ko = (size_t)(kt + 1) * 64;
                rk0 = *(const u32x4*)(kbase + (ko + kk0) * 384 + kc0 * 8);
                if (tid < 256) rk1 = *(const u32x4*)(kbase + (ko + kk1) * 384 + kc1 * 8);
                rv = *(const u32x4*)(vbase + (ko + vk) * 256 + vc * 8);
            }
            const int kb = kt * 64;
            if (kb <= qmax) {
                const bool need1 = (kb + 32 <= qmax);
                f32x16 s0, s1;
#pragma unroll
                for (int i = 0; i < 16; ++i) { s0[i] = 0.f; s1[i] = -1e30f; }
#pragma unroll
                for (int s = 0; s < 6; ++s) { const bf16x8 kf = *(const bf16x8*)(Ks + r * KSTR + 16 * s + 8 * h); s0 = __builtin_amdgcn_mfma_f32_32x32x16_bf16(kf, qf[s], s0, 0, 0, 0); }
                if (need1) {
#pragma unroll
                    for (int i = 0; i < 16; ++i) s1[i] = 0.f;
#pragma unroll
                    for (int s = 0; s < 6; ++s) { const bf16x8 kf = *(const bf16x8*)(Ks + (32 + r) * KSTR + 16 * s + 8 * h); s1 = __builtin_amdgcn_mfma_f32_32x32x16_bf16(kf, qf[s], s1, 0, 0, 0); }
                }
                if (kb + 63 > qmin) {
#pragma unroll
                    for (int i = 0; i < 16; ++i) {
                        const int key = kb + (i & 3) + 8 * (i >> 2) + 4 * h;
                        if (key > myq) s0[i] = -1e30f;
                        if (key + 32 > myq) s1[i] = -1e30f;
                    }
                }
                float mx = s0[0];
#pragma unroll
                for (int i = 1; i < 16; ++i) mx = fmaxf(mx, s0[i]);
#pragma unroll
                for (int i = 0; i < 16; ++i) mx = fmaxf(mx, s1[i]);
                mx = xhalf_max(mx);
                const float mn = fmaxf(m, mx), alpha = __builtin_amdgcn_exp2f(m - mn);
                m = mn;
                float ps = 0.f;
#pragma unroll
                for (int i = 0; i < 16; ++i) { s0[i] = __builtin_amdgcn_exp2f(s0[i] - mn); ps += s0[i]; }
                if (need1) {
#pragma unroll
                    for (int i = 0; i < 16; ++i) { s1[i] = __builtin_amdgcn_exp2f(s1[i] - mn); ps += s1[i]; }
                }
                lsum = lsum * alpha + ps;
                if (!__all(alpha == 1.0f)) {
#pragma unroll
                    for (int i = 0; i < 16; ++i) { o0[i] *= alpha; o1[i] *= alpha; }
                }
#pragma unroll
                for (int s = 0; s < 2; ++s) {
                    u32x4 pw; pw[0] = cvtpk(s0[8 * s], s0[8 * s + 1]); pw[1] = cvtpk(s0[8 * s + 2], s0[8 * s + 3]); pw[2] = cvtpk(s0[8 * s + 4], s0[8 * s + 5]); pw[3] = cvtpk(s0[8 * s + 6], s0[8 * s + 7]);
                    const bf16x8 pf = __builtin_bit_cast(bf16x8, pw);
                    const bf16_t* va = Vt + r * VSTR + 16 * s + 4 * h;
                    const s16x4 a0 = *(const s16x4*)(va), a1 = *(const s16x4*)(va + 8), b0 = *(const s16x4*)(va + 32 * VSTR), b1 = *(const s16x4*)(va + 32 * VSTR + 8);
                    o0 = __builtin_amdgcn_mfma_f32_32x32x16_bf16(__builtin_shufflevector(a0, a1, 0, 1, 2, 3, 4, 5, 6, 7), pf, o0, 0, 0, 0);
                    o1 = __builtin_amdgcn_mfma_f32_32x32x16_bf16(__builtin_shufflevector(b0, b1, 0, 1, 2, 3, 4, 5, 6, 7), pf, o1, 0, 0, 0);
                }
                if (need1) {
#pragma unroll
                    for (int s = 0; s < 2; ++s) {
                        u32x4 pw; pw[0] = cvtpk(s1[8 * s], s1[8 * s + 1]); pw[1] = cvtpk(s1[8 * s + 2], s1[8 * s + 3]); pw[2] = cvtpk(s1[8 * s + 4], s1[8 * s + 5]); pw[3] = cvtpk(s1[8 * s + 6], s1[8 * s + 7]);
                        const bf16x8 pf = __builtin_bit_cast(bf16x8, pw);
                        const bf16_t* va = Vt + r * VSTR + 32 + 16 * s + 4 * h;
                        const s16x4 a0 = *(const s16x4*)(va), a1 = *(const s16x4*)(va + 8), b0 = *(const s16x4*)(va + 32 * VSTR), b1 = *(const s16x4*)(va + 32 * VSTR + 8);
                        o0 = __builtin_amdgcn_mfma_f32_32x32x16_bf16(__builtin_shufflevector(a0, a1, 0, 1, 2, 3, 4, 5, 6, 7), pf, o0, 0, 0, 0);
                        o1 = __builtin_amdgcn_mfma_f32_32x32x16_bf16(__builtin_shufflevector(b0, b1, 0, 1, 2, 3, 4, 5, 6, 7), pf, o1, 0, 0, 0);
                    }
                }
            }
        }
        const float inv = 1.0f / xhalf_sum(lsum);
        float* op = p.mo + (size_t)(b * SEQ + myq) * 256 + hd * 64 + 4 * h;
#pragma unroll
        for (int g = 0; g < 4; ++g) {
            *(f32x4*)(op + 8 * g) = (f32x4){o0[4 * g] * inv, o0[4 * g + 1] * inv, o0[4 * g + 2] * inv, o0[4 * g + 3] * inv};
            *(f32x4*)(op + 32 + 8 * g) = (f32x4){o1[4 * g] * inv, o1[4 * g + 1] * inv, o1[4 * g + 2] * inv, o1[4 * g + 3] * inv};
        }
        __syncthreads();
    }
}

__device__ __forceinline__ void ph_finalize_mix(const Params& pkv, KPtr kp_in, int wbase_in, int l) {
    PH_HEAD
    const int lane = TID & 63, gw = BID * (NTHREADS / 64) + (TID >> 6), nw = gridDim.x * (NTHREADS / 64);
    const int c = lane * 4, h = lane >> 4;
    for (int t = gw; t < NT; t += nw) {
        bf16_t* outp = p.mixcat + (size_t)t * 1024;
        {
            const float l0 = p.dlse[((size_t)0 * NT + t) * 4 + h], l1 = p.dlse[((size_t)1 * NT + t) * 4 + h], l2 = p.dlse[((size_t)2 * NT + t) * 4 + h];
            const float lm = fmaxf(l0, fmaxf(l1, l2));
            float w0 = __builtin_amdgcn_exp2f(l0 - lm), w1 = __builtin_amdgcn_exp2f(l1 - lm), w2 = __builtin_amdgcn_exp2f(l2 - lm);
            const float wi = 1.0f / (w0 + w1 + w2); w0 *= wi; w1 *= wi; w2 *= wi;
            const float4 v0 = *(const float4*)(p.dob + ((size_t)0 * NT + t) * 256 + c), v1 = *(const float4*)(p.dob + ((size_t)1 * NT + t) * 256 + c), v2 = *(const float4*)(p.dob + ((size_t)2 * NT + t) * 256 + c);
            float4 v; v.x = w0 * v0.x + w1 * v1.x + w2 * v2.x; v.y = w0 * v0.y + w1 * v1.y + w2 * v2.y; v.z = w0 * v0.z + w1 * v1.z + w2 * v2.z; v.w = w0 * v0.w + w1 * v1.w + w2 * v2.w;
            const float ss = wave_sum(v.x * v.x + v.y * v.y + v.z * v.z + v.w * v.w);
            const float rs = rsqrtf(ss * (1.0f / 256.0f) + 1e-6f);
            const float4 g = *(const float4*)(p.dil_norm_g + l * 256 + c);
            ushort4 o; o.x = f2bf(v.x * rs * g.x); o.y = f2bf(v.y * rs * g.y); o.z = f2bf(v.z * rs * g.z); o.w = f2bf(v.w * rs * g.w);
            *(ushort4*)(outp + 256 + c) = o;
        }
        {
            const size_t o4 = (size_t)t * 256 + c;
            const float4 y = *(const float4*)(p.sy + o4), r = *(const float4*)(p.sr + o4), k = *(const float4*)(p.sk + o4), v = *(const float4*)(p.sv + o4), g = *(const float4*)(p.sg + o4);
            const float mean = grp16_sum(y.x + y.y + y.z + y.w) * (1.0f / 64.0f);
            const float dx = y.x - mean, dy = y.y - mean, dz = y.z - mean, dw = y.w - mean;
            const float var = grp16_sum(dx * dx + dy * dy + dz * dz + dw * dw) * (1.0f / 64.0f);
            const float rs = rsqrtf(var + 64e-5f);
            const float4 lg = *(const float4*)(p.rwkv_ln_g + l * 256 + c), lb = *(const float4*)(p.rwkv_ln_b + l * 256 + c), rk = *(const float4*)(p.rwkv_r_k + l * 256 + c);
            const float bonus = grp16_sum(r.x * k.x * rk.x + r.y * k.y * rk.y + r.z * k.z * rk.z + r.w * k.w * rk.w);
            ushort4 o;
            o.x = f2bf((dx * rs * lg.x + lb.x + bonus * v.x) * g.x); o.y = f2bf((dy * rs * lg.y + lb.y + bonus * v.y) * g.y);
            o.z = f2bf((dz * rs * lg.z + lb.z + bonus * v.z) * g.z); o.w = f2bf((dw * rs * lg.w + lb.w + bonus * v.w) * g.w);
            *(ushort4*)(outp + 512 + c) = o;
        }
        {
            const float4 v = *(const float4*)(p.mo + (size_t)t * 256 + c);
            const float ss = wave_sum(v.x * v.x + v.y * v.y + v.z * v.z + v.w * v.w);
            const float rs = rsqrtf(ss * (1.0f / 256.0f) + 1e-6f);
            const float4 g = *(const float4*)(p.mla_out_norm_g + l * 256 + c);
            ushort4 o; o.x = f2bf(v.x * rs * g.x); o.y = f2bf(v.y * rs * g.y); o.z = f2bf(v.z * rs * g.z); o.w = f2bf(v.w * rs * g.w);
            *(ushort4*)(outp + 768 + c) = o;
        }
    }
    (void)h;
}

__device__ __forceinline__ void ph_outproj(const Params& pkv, KPtr kp_in, int wbase_in, int l, char* lds) {
    PH_HEAD
    const float* xin = (l == 0) ? p.x : p.xf; float* y1 = p.y1;
    const bf16_t* Bt = p.wout_t + (size_t)l * 1024 * 1024;
    const int nunits = (NT / 256) * 4;
    bool pre = false;
    XU_LOOP(NT / 256, 4) {
        const int u = XU_UNIT();
        const int mt = u >> 2, nt = u & 3, un = u + gridDim.x;
        G8Next nx; nx.valid = 0; nx.rowidx = nullptr; nx.nvalid = 256; nx.A = p.mixcat + (size_t)(un >> 2) * 256 * 1024; nx.Bt = Bt + (size_t)(un & 3) * 256 * 1024;
        const size_t o0 = (size_t)mt * 256 * 1024 + nt * 256;
        gemm_tile256(p.mixcat + (size_t)mt * 256 * 1024, 1024, nullptr, 256, Bt + (size_t)nt * 256 * 1024, 1024, 1024, lds, wbase_in, pre, nx,
                     [=](int r, int c, f32x4 v) mutable { const size_t o = o0 + (size_t)r * 1024 + c; const f32x4 xv = *(const f32x4*)(xin + o); *(f32x4*)(y1 + o) = xv * ALPHA + v; });
        pre = nx.valid != 0;
    }
}

__device__ __forceinline__ void ph_ln1_router(const Params& pkv, KPtr kp_in, int wbase_in, int l, char* lds) {
    PH_HEAD
    float* Wt = (float*)lds;
    int* hist = (int*)(lds + 131072);
    int* base = hist + 32;
    int* le = base + 32;
    float* lgt = (float*)(le + 512);
    int* lrank = (int*)(lgt + 512);
    const int tid = TID, lane = tid & 63, wv = tid >> 6;
    const float* g1 = p.ln1_g + l * 1024; const float* b1 = p.ln1_b + l * 1024;
    const float* rw = p.router_w + (size_t)l * 1024 * 32; const float* rb = p.router_b + l * 32;
    __syncthreads();
    for (int i = tid; i < 1024 * 32; i += NTHREADS) Wt[(i & 31) * 1024 + (i >> 5)] = rw[i];
    float4 gg[4], bb[4];
#pragma unroll
    for (int m = 0; m < 4; ++m) { gg[m] = *(const float4*)(g1 + m * 256 + lane * 4); bb[m] = *(const float4*)(b1 + m * 256 + lane * 4); }
    for (int tb = BID * 128; tb < NT; tb += gridDim.x * 128) {
        __syncthreads();
        if (tid < 32) hist[tid] = 0;
        __syncthreads();
        for (int tt = wv; tt < 128; tt += 8) {
            const int t = tb + tt;
            float4 y[4]; float s = 0.f;
#pragma unroll
            for (int m = 0; m < 4; ++m) { y[m] = *(const float4*)(p.y1 + (size_t)t * 1024 + m * 256 + lane * 4); s += (y[m].x + y[m].y) + (y[m].z + y[m].w); }
            const float mean = wave_sum(s) * (1.0f / 1024.0f);
            float q = 0.f;
#pragma unroll
            for (int m = 0; m < 4; ++m) { y[m].x -= mean; y[m].y -= mean; y[m].z -= mean; y[m].w -= mean; q += (y[m].x * y[m].x + y[m].y * y[m].y) + (y[m].z * y[m].z + y[m].w * y[m].w); }
            const float rs = rsqrtf(wave_sum(q) * (1.0f / 1024.0f) + 1e-5f);
#pragma unroll
            for (int m = 0; m < 4; ++m) {
                const int c = m * 256 + lane * 4;
                y[m].x = y[m].x * rs * gg[m].x + bb[m].x; y[m].y = y[m].y * rs * gg[m].y + bb[m].y; y[m].z = y[m].z * rs * gg[m].z + bb[m].z; y[m].w = y[m].w * rs * gg[m].w + bb[m].w;
                *(float4*)(p.y1 + (size_t)t * 1024 + c) = y[m];
                uint2 ob; ob.x = cvtpk(y[m].x, y[m].y); ob.y = cvtpk(y[m].z, y[m].w);
                *(uint2*)(p.x1b + (size_t)t * 1024 + c) = ob;
            }
            float lg[32];
#pragma unroll
            for (int e = 0; e < 32; ++e) {
                float a = 0.f;
#pragma unroll
                for (int m = 0; m < 4; ++m) { const f32x4 w = *(const f32x4*)(Wt + e * 1024 + m * 256 + lane * 4); a += (y[m].x * w[0] + y[m].y * w[1]) + (y[m].z * w[2] + y[m].w * w[3]); }
                lg[e] = a;
            }
#pragma unroll
            for (int e = 0; e < 32; ++e) lg[e] = wave_sum(lg[e]) + rb[e];
            int idx[4]; float val[4];
#pragma unroll
            for (int k = 0; k < 4; ++k) {
                float bv = -3.0e38f; int bi = 0;
#pragma unroll
                for (int e = 0; e < 32; ++e) { if (lg[e] > bv) { bv = lg[e]; bi = e; } }
                idx[k] = bi; val[k] = bv;
#pragma unroll
                for (int e = 0; e < 32; ++e) if (e == bi) lg[e] = -3.0e38f;
            }
            const float e1 = __expf(val[1] - val[0]), e2 = __expf(val[2] - val[0]), e3 = __expf(val[3] - val[0]);
            const float inv = 1.0f / (1.0f + e1 + e2 + e3);
            const float gt[4] = {inv, e1 * inv, e2 * inv, e3 * inv};
            if (lane < 4) {
                int ee = idx[0]; float gv = gt[0];
                if (lane == 1) { ee = idx[1]; gv = gt[1]; } else if (lane == 2) { ee = idx[2]; gv = gt[2]; } else if (lane == 3) { ee = idx[3]; gv = gt[3]; }
                le[tt * 4 + lane] = ee; lgt[tt * 4 + lane] = gv;
                lrank[tt * 4 + lane] = atomicAdd(&hist[ee], 1);
            }
        }
        __syncthreads();
        if (tid < 32) base[tid] = atomicAdd(&p.cnt[l * NE + tid], hist[tid]);
        __syncthreads();
        {
            const int tt = tid >> 2, t = tb + tt, e = le[tid], pos = base[e] + lrank[tid];
            p.toke[(size_t)t * 4 + (tid & 3)] = e; p.tokpos[(size_t)t * 4 + (tid & 3)] = pos;
            p.rowtok[(size_t)e * NT + pos] = t; p.rowgate[(size_t)e * NT + pos] = lgt[tid];
        }
    }
}

__device__ __forceinline__ void moe_tile_prefix(KRef p, int l, int* tb  , const int TID) {
    __syncthreads();
    if (TID == 0) { int a = 0; for (int e = 0; e < NE; ++e) { tb[e] = a; a += (p.cnt[l * NE + e] + MOE_TM - 1) / MOE_TM; } tb[NE] = a; }
    __syncthreads();
}
struct MoeUnit { int e, mt, mtg, nt, nvalid; };
__device__ __forceinline__ MoeUnit moe_decode(const int* tb, const int* cnt, int u, int ntshift) {
    MoeUnit m; m.mtg = u >> ntshift; m.nt = u & ((1 << ntshift) - 1);
    int e = 0; while (tb[e + 1] <= m.mtg) ++e;
    m.e = __builtin_amdgcn_readfirstlane(e);
    m.mt = __builtin_amdgcn_readfirstlane(m.mtg - tb[m.e]);
    const int c = __builtin_amdgcn_readfirstlane(cnt[m.e]);
    m.nvalid = min(MOE_TM, c - m.mt * MOE_TM);
    return m;
}
__device__ __forceinline__ void ph_moe_gu(const Params& pkv, KPtr kp_in, int wbase_in, int l, char* lds) {
    PH_HEAD
    int* tb = (int*)(lds + 132096);
    moe_tile_prefix(p, l, tb, TID);
    const int ntile = __builtin_amdgcn_readfirstlane(tb[NE]), nunits = ntile * 8;
    const int* cnt = p.cnt + l * NE;
    bool pre = false;
    XU_LOOP(ntile, 8) {
        const int u = XU_UNIT();
        const MoeUnit m = moe_decode(tb, cnt, u, 3);
        const int un = u + gridDim.x;
        G8Next nx; nx.valid = 0; nx.A = p.x1b; nx.rowidx = nullptr; nx.Bt = nullptr; nx.nvalid = 0;
        if (nx.valid) { const MoeUnit m2 = moe_decode(tb, cnt, un, 3); nx.rowidx = p.rowtok + (size_t)m2.e * NT + m2.mt * MOE_TM; nx.nvalid = m2.nvalid; nx.Bt = p.wgu_t + (((size_t)l * NE + m2.e) * 2048 + m2.nt * 256) * 1024; }
        const float* bias = p.b_gu + ((size_t)l * NE + m.e) * 2048 + m.nt * 256;
        bf16_t* out = p.act + (size_t)m.mtg * MOE_TM * 1024 + m.nt * 128;
        gemm_tile256(p.x1b, 1024, p.rowtok + (size_t)m.e * NT + m.mt * MOE_TM, m.nvalid, p.wgu_t + (((size_t)l * NE + m.e) * 2048 + m.nt * 256) * 1024, 1024, 1024, lds, wbase_in, pre, nx,
                     [=](int r, int c, f32x4 v) mutable {
                         const f32x4 bv = *(const f32x4*)(bias + c); v = v + bv;
                         const float g0 = fminf(v[0], 7.0f), l0 = fminf(fmaxf(v[1], -7.0f), 7.0f), g1 = fminf(v[2], 7.0f), l1 = fminf(fmaxf(v[3], -7.0f), 7.0f);
                         const float a0 = g0 * sigmoidf_(1.702f * g0) * (l0 + 1.0f), a1 = g1 * sigmoidf_(1.702f * g1) * (l1 + 1.0f);
                         *(unsigned*)(out + (size_t)r * 1024 + (c >> 1)) = cvtpk(a0, a1); });
        pre = nx.valid != 0;
    }
}
__device__ __forceinline__ void ph_moe_dn(const Params& pkv, KPtr kp_in, int wbase_in, int l, char* lds) {
    PH_HEAD
    int* tb = (int*)(lds + 132096);
    moe_tile_prefix(p, l, tb, TID);
    const int ntile = __builtin_amdgcn_readfirstlane(tb[NE]), nunits = ntile * 4;
    const int* cnt = p.cnt + l * NE;
    bool pre = false;
    XU_LOOP(ntile, 4) {
        const int u = XU_UNIT();
        const MoeUnit m = moe_decode(tb, cnt, u, 2);
        const int un = u + gridDim.x;
        G8Next nx; nx.valid = 0; nx.A = nullptr; nx.rowidx = nullptr; nx.Bt = nullptr; nx.nvalid = 256;
        if (nx.valid) { const MoeUnit m2 = moe_decode(tb, cnt, un, 2); nx.A = p.act + (size_t)m2.mtg * MOE_TM * 1024; nx.Bt = p.wdn_t + (((size_t)l * NE + m2.e) * 1024 + m2.nt * 256) * 1024; }
        const float* bias = p.b_dn + ((size_t)l * NE + m.e) * 1024 + m.nt * 256;
        const float* gate = p.rowgate + (size_t)m.e * NT + m.mt * MOE_TM;
        bf16_t* out = p.yb + (size_t)m.mtg * MOE_TM * 1024 + m.nt * 256;
        const int nvalid = m.nvalid;
        gemm_tile256(p.act + (size_t)m.mtg * MOE_TM * 1024, 1024, nullptr, 256, p.wdn_t + (((size_t)l * NE + m.e) * 1024 + m.nt * 256) * 1024, 1024, 1024, lds, wbase_in, pre, nx,
                     [=](int r, int c, f32x4 v) mutable {
                         const float g = (r < nvalid) ? gate[r] : 0.f;
                         const f32x4 bv = *(const f32x4*)(bias + c); v = (v + bv) * g;
                         uint2 o; o.x = cvtpk(v[0], v[1]); o.y = cvtpk(v[2], v[3]); *(uint2*)(out + (size_t)r * 1024 + c) = o; });
        pre = nx.valid != 0;
    }
}
__device__ __forceinline__ void ph_combine_ln2(const Params& pkv, KPtr kp_in, int wbase_in, int l, char* lds) {
    PH_HEAD
    int* tb = (int*)(lds + 132096);
    moe_tile_prefix(p, l, tb, TID);
    const int lane = TID & 63, gw = BID * (NTHREADS / 64) + (TID >> 6), nw = gridDim.x * (NTHREADS / 64);
    const float* g2 = p.ln2_g + l * 1024; const float* b2 = p.ln2_b + l * 1024;
    float* dstf = (l == DEPTH - 1) ? p.out : p.xf;
    for (int t = gw; t < NT; t += nw) {
        size_t rows[4];
#pragma unroll
        for (int k = 0; k < 4; ++k) { const int e = p.toke[(size_t)t * 4 + k], pos = p.tokpos[(size_t)t * 4 + k]; rows[k] = (size_t)tb[e] * MOE_TM + pos; }
        float4 y[4]; float s = 0.f;
#pragma unroll
        for (int m = 0; m < 4; ++m) {
            const int c = m * 256 + lane * 4;
            float4 v = *(const float4*)(p.y1 + (size_t)t * 1024 + c);
            v.x *= ALPHA; v.y *= ALPHA; v.z *= ALPHA; v.w *= ALPHA;
#pragma unroll
            for (int k = 0; k < 4; ++k) { const ushort4 yb = *(const ushort4*)(p.yb + rows[k] * 1024 + c); v.x += bf2f(yb.x); v.y += bf2f(yb.y); v.z += bf2f(yb.z); v.w += bf2f(yb.w); }
            y[m] = v; s += v.x + v.y + v.z + v.w;
        }
        const float mean = wave_sum(s) * (1.0f / 1024.0f);
        float q = 0.f;
#pragma unroll
        for (int m = 0; m < 4; ++m) { y[m].x -= mean; y[m].y -= mean; y[m].z -= mean; y[m].w -= mean; q += y[m].x * y[m].x + y[m].y * y[m].y + y[m].z * y[m].z + y[m].w * y[m].w; }
        const float rs = rsqrtf(wave_sum(q) * (1.0f / 1024.0f) + 1e-5f);
#pragma unroll
        for (int m = 0; m < 4; ++m) {
            const int c = m * 256 + lane * 4;
            const float4 g = *(const float4*)(g2 + c), bb = *(const float4*)(b2 + c);
            float4 xv; xv.x = y[m].x * rs * g.x + bb.x; xv.y = y[m].y * rs * g.y + bb.y; xv.z = y[m].z * rs * g.z + bb.z; xv.w = y[m].w * rs * g.w + bb.w;
            *(float4*)(dstf + (size_t)t * 1024 + c) = xv;
            ushort4 ob; ob.x = f2bf(xv.x); ob.y = f2bf(xv.y); ob.z = f2bf(xv.z); ob.w = f2bf(xv.w);
            *(ushort4*)(p.xb + (size_t)t * 1024 + c) = ob;
        }
    }
}

constexpr int PH_PRO = 0, PH_INPROJ = 1, PH_PREP = 2, PH_RETKV = 3, PH_RETSCAN = 4, PH_RETOUT = 5, PH_DIL = 6, PH_RWKVPREP = 7, PH_RWKVSCAN = 8, PH_MLAUP = 9,
              PH_MLAATTN = 10, PH_FINAL = 11, PH_OUTPROJ = 12, PH_LN1 = 13, PH_GU = 14, PH_DN = 15, PH_LN2 = 16;

#ifdef MULTI_LAUNCH
template <int ph>
__global__ void __launch_bounds__(NTHREADS, 2) mega(Params pk, int l) {
    extern __shared__ __attribute__((aligned(16))) char lds[];
    KPtr kp = (KPtr)__builtin_amdgcn_kernarg_segment_ptr();
    const int wbase = __builtin_amdgcn_readfirstlane(threadIdx.x) & ~63;
    if (ph == PH_PRO) ph_prologue(pk, kp, wbase, lds);
    if (ph == PH_INPROJ) ph_inproj(pk, kp, wbase, l, lds);
    if (ph == PH_PREP) ph_rope_prep(pk, kp, wbase, l);
    if (ph == PH_RETKV) ph_ret_kv(pk, kp, wbase, l, lds);
    if (ph == PH_RETSCAN) ph_ret_scan(pk, kp, wbase, l);
    if (ph == PH_RETOUT) ph_ret_out(pk, kp, wbase, l, lds);
    if (ph == PH_DIL) ph_dil_attn(pk, kp, wbase, l, lds);
    if (ph == PH_RWKVPREP) ph_rwkv_prep(pk, kp, wbase, l, lds);
    if (ph == PH_RWKVSCAN) ph_rwkv_scan(pk, kp, wbase, l, lds);
    if (ph == PH_MLAUP) ph_mla_up(pk, kp, wbase, l, lds);
    if (ph == PH_MLAATTN) ph_mla_attn(pk, kp, wbase, l, lds);
    if (ph == PH_FINAL) ph_finalize_mix(pk, kp, wbase, l);
    if (ph == PH_OUTPROJ) ph_outproj(pk, kp, wbase, l, lds);
    if (ph == PH_LN1) ph_ln1_router(pk, kp, wbase, l, lds);
    if (ph == PH_GU) ph_moe_gu(pk, kp, wbase, l, lds);
    if (ph == PH_DN) ph_moe_dn(pk, kp, wbase, l, lds);
    if (ph == PH_LN2) ph_combine_ln2(pk, kp, wbase, l, lds);
}
template <int PH> static void launch_ph(const Params& p, int l, hipStream_t stream) {
    static bool attr_set = false;
    if (!attr_set) { (void)hipFuncSetAttribute((const void*)mega<PH>, hipFuncAttributeMaxDynamicSharedMemorySize, LDS_BYTES); attr_set = true; }
    hipLaunchKernelGGL(mega<PH>, dim3(256), dim3(NTHREADS), LDS_BYTES, stream, p, l);
}
template <int PH> static void launch_layer(const Params& p, int l, hipStream_t stream) {
    launch_ph<PH>(p, l, stream);
    if constexpr (PH < PH_LN2) launch_layer<PH + 1>(p, l, stream);
}

#else
__device__ __forceinline__ void grid_sync(KPtr kp_in, int wbase_in, char* lds) {
    KPtr kp_ = kp_launder(kp_in);
    XcdBarrier b; b.bar = kp_->bar; b.x = xb_xcc_id(); b.st = (volatile LAS unsigned*)(lds + LDS_BYTES - 16);
    xcd_barrier(b, opq_tid(wbase_in));
}
#ifndef PROBE_ID
#define PROBE_ID -1
#endif
#define RUN(ID, call) do { int reps_ = 1; if (PROBE_ID == (ID)) { reps_ = 2; asm volatile("" : "+s"(reps_)); } for (int r_ = 0; r_ < reps_; ++r_) { call; } } while (0)
__global__ void __launch_bounds__(NTHREADS, 2) mega_fused(Params pk) {
    extern __shared__ __attribute__((aligned(16))) char lds[];
    KPtr kp = (KPtr)__builtin_amdgcn_kernarg_segment_ptr();
    const int wbase = __builtin_amdgcn_readfirstlane(threadIdx.x) & ~63;
    volatile LAS unsigned* xbw = (volatile LAS unsigned*)(lds + LDS_BYTES - 16);
    if (threadIdx.x == 0) { xbw[0] = 0u; xbw[1] = 0u; xbw[2] = 0u; xbw[3] = 0u; }
    __syncthreads();
    (void)xcd_barrier_post(pk.bar, xbw);
    RUN(0, ph_prologue(pk, kp, wbase, lds));
    grid_sync(kp, wbase, lds);
    for (int l = 0; l < DEPTH; ++l) {
        RUN(1, ph_inproj(pk, kp, wbase, l, lds));
        grid_sync(kp, wbase, lds);
        RUN(2, ph_rope_prep(pk, kp, wbase, l));
        grid_sync(kp, wbase, lds);
        RUN(3, ph_ret_kv(pk, kp, wbase, l, lds)); RUN(4, ph_rwkv_prep(pk, kp, wbase, l, lds)); RUN(5, ph_mla_up(pk, kp, wbase, l, lds));
        grid_sync(kp, wbase, lds);
        RUN(7, ph_mla_pack(pk, kp, wbase, l)); RUN(8, ph_ret_scan(pk, kp, wbase, l)); RUN(17, ph_rwkv_chunkpre(pk, kp, wbase, l, lds));
        grid_sync(kp, wbase, lds);
        RUN(10, ph_rwkv_scan(pk, kp, wbase, l, lds)); RUN(9, ph_mla_attn(pk, kp, wbase, l, lds)); ph_dil_attn(pk, kp, wbase, l, lds); ph_ret_out(pk, kp, wbase, l, lds);
        grid_sync(kp, wbase, lds);
        RUN(12, ph_finalize_mix(pk, kp, wbase, l));
        grid_sync(kp, wbase, lds);
        RUN(13, ph_outproj(pk, kp, wbase, l, lds));
        grid_sync(kp, wbase, lds);
        ph_ln1_router(pk, kp, wbase, l, lds);
        grid_sync(kp, wbase, lds);
        RUN(14, ph_moe_gu(pk, kp, wbase, l, lds));
        grid_sync(kp, wbase, lds);
        RUN(15, ph_moe_dn(pk, kp, wbase, l, lds));
        grid_sync(kp, wbase, lds);
        RUN(16, ph_combine_ln2(pk, kp, wbase, l, lds));
        grid_sync(kp, wbase, lds);
    }
}
#endif
struct Carver { char* base; size_t off; template <class T> T* take(size_t n) { T* r = (T*)(base + off); off += ((n * sizeof(T) + 255) / 256) * 256; return r; } };

extern "C" void kernel_launch(void* const* d_in, const int* in_sizes, int n_in, void* d_out, int out_size, void* d_ws, size_t ws_size, hipStream_t stream) {
    Params p; memset(&p, 0, sizeof(p));
    const float** ip = (const float**)&p;
    for (int i = 0; i < 35; ++i) ip[i] = (const float*)d_in[i];
    p.out = (float*)d_out;
    Carver c{(char*)d_ws, 0};
    p.bar = c.take<unsigned>(4096); p.cnt = c.take<int>(DEPTH * NE); p.wq = c.take<int>(DEPTH * 16);
    p.tab_ret = c.take<float>((size_t)SEQ * 32); p.tab_dil = c.take<float>((size_t)SEQ * 16); p.tab_mla = c.take<float>((size_t)SEQ * 32);
    p.win_t = c.take<bf16_t>((size_t)DEPTH * NINP * 1024); p.wout_t = c.take<bf16_t>((size_t)DEPTH * 1024 * 1024);
    p.wgu_t = c.take<bf16_t>((size_t)DEPTH * NE * 2048 * 1024); p.wdn_t = c.take<bf16_t>((size_t)DEPTH * NE * 1024 * 1024);
    p.wq_t = c.take<bf16_t>((size_t)DEPTH * 384 * 256); p.wkv_t = c.take<bf16_t>((size_t)DEPTH * 512 * 128);
    p.wupt = c.take<bf16_t>((size_t)DEPTH * 256 * 64); p.aupt = c.take<bf16_t>((size_t)DEPTH * 256 * 64); p.gupt = c.take<bf16_t>((size_t)DEPTH * 256 * 128); p.vupt = c.take<bf16_t>((size_t)DEPTH * 256 * 32);
    p.xf = c.take<float>((size_t)NT * DM); p.xb = c.take<bf16_t>((size_t)NT * DM); p.pbuf = c.take<bf16_t>((size_t)NT * NINP);
    p.mixcat = c.take<bf16_t>((size_t)NT * DM); p.y1 = c.take<float>((size_t)NT * DM); p.x1b = c.take<bf16_t>((size_t)NT * DM);
    p.rq = c.take<float>((size_t)NT * 128); p.rk = c.take<float>((size_t)NT * 128);
    p.rkv = c.take<float>((size_t)NBATCH * NCH * 4 * 32 * 64); p.rstate = c.take<float>((size_t)NBATCH * NCH * 4 * 32 * 64);
    p.dq = c.take<float>((size_t)NT * 256); p.dk = c.take<float>((size_t)NT * 256); p.dob = c.take<float>((size_t)3 * NT * 256); p.dlse = c.take<float>((size_t)3 * NT * 4);
    p.sr = c.take<float>((size_t)NT * 256); p.sw = c.take<float>((size_t)NT * 256); p.sk = c.take<float>((size_t)NT * 256); p.sv = c.take<float>((size_t)NT * 256);
    p.sa = c.take<float>((size_t)NT * 256); p.sb = c.take<float>((size_t)NT * 256); p.sg = c.take<float>((size_t)NT * 256); p.sy = c.take<float>((size_t)NT * 256);
    p.vfirst = c.take<float>((size_t)NT * 256);
    p.c_p = c.take<float>((size_t)16 * (SEQ / 16) * 4096); p.c_q = c.take<float>((size_t)16 * (SEQ / 16) * 4096); p.c_rh = c.take<float>((size_t)16 * (SEQ / 16) * 1024); p.c_y1 = c.take<float>((size_t)16 * (SEQ / 16) * 1024);
    p.rsq = c.take<float>(NT); p.rskv = c.take<float>(NT); p.kpe = c.take<float>((size_t)NT * 32);
    p.qu = c.take<float>((size_t)NT * 384); p.kvu = c.take<float>((size_t)NT * 512); p.mo = c.take<float>((size_t)NT * 256);
    p.mq = c.take<bf16_t>((size_t)NT * 384); p.mk = c.take<bf16_t>((size_t)NT * 384); p.mv = c.take<bf16_t>((size_t)NT * 256);
    p.rowtok = c.take<int>((size_t)NE * NT); p.toke = c.take<int>((size_t)NT * 4); p.tokpos = c.take<int>((size_t)NT * 4); p.rowgate = c.take<float>((size_t)NE * NT);
    p.act = c.take<bf16_t>((size_t)MOE_MAXROWS * 1024); p.yb = c.take<bf16_t>((size_t)MOE_MAXROWS * 1024);
    if (c.off > ws_size) { fprintf(stderr, "workspace too small: need %zu have %zu\n", c.off, ws_size); return; }

#ifdef MULTI_LAUNCH
    launch_ph<PH_PRO>(p, 0, stream);
    for (int l = 0; l < DEPTH; ++l) launch_layer<PH_INPROJ>(p, l, stream);
#else
    static int grid = 0;
    if (!grid) {
        (void)hipFuncSetAttribute((const void*)mega_fused, hipFuncAttributeMaxDynamicSharedMemorySize, LDS_BYTES);
        int dev = 0, cus = 0, per_cu = 0;
        (void)hipGetDevice(&dev);
        (void)hipDeviceGetAttribute(&cus, hipDeviceAttributeMultiprocessorCount, dev);
        (void)hipOccupancyMaxActiveBlocksPerMultiprocessor(&per_cu, mega_fused, NTHREADS, LDS_BYTES);
        if (cus <= 0) cus = 256;
        grid = cus * (per_cu < 1 ? 1 : 1);
    }
    (void)hipMemsetAsync(p.bar, 0, XCD_BAR_WORDS * sizeof(unsigned), stream);
    hipLaunchKernelGGL(mega_fused, dim3(grid), dim3(NTHREADS), LDS_BYTES, stream, p);
#endif
}
```

```cpp
#include <hip/hip_runtime.h>
#include <stdint.h>
#include <string.h>
#include <stdio.h>

typedef unsigned short bf16_t;
typedef short bf16x8 __attribute__((ext_vector_type(8)));
typedef float f32x4 __attribute__((ext_vector_type(4)));
typedef unsigned u32x4 __attribute__((ext_vector_type(4)));
typedef float f32x16 __attribute__((ext_vector_type(16)));
typedef short s16x4 __attribute__((ext_vector_type(4)));
typedef float f32x2_t __attribute__((ext_vector_type(2)));
typedef __bf16 bf16x2_t __attribute__((ext_vector_type(2)));

constexpr int NT = 32768, SEQ = 8192, NBATCH = 4, DM = 1024, NIN = 2976, NINP = 3072, DEPTH = 4, NE = 32, TOPK = 4;
constexpr int BLK = 128, NCH = SEQ / BLK;
constexpr float ALPHA = 1.6817928305074292f;
constexpr int PC_RQ = 0, PC_RK = 128, PC_RV = 256, PC_RG = 512, PC_DQ = 768, PC_DK = 1024, PC_DV = 1280;
constexpr int PC_C = 1536, PC_CR = 1536, PC_CK = 1792, PC_CV = 2048, PC_CWD = 2304, PC_CAD = 2368, PC_CGD = 2432;
constexpr int PC_MQ = 2560, PC_MKV = 2816, PC_MKR = 2944, PC_VRES = 2976;
constexpr int MOE_TM = 256;
constexpr int MOE_MAXROWS = NT * TOPK + NE * MOE_TM;
constexpr int NTHREADS = 512;
constexpr int LDS_BYTES = 147456;

__device__ __forceinline__ bf16_t f2bf(float f) { unsigned u = __float_as_uint(f); u += 0x7fffu + ((u >> 16) & 1u); return (bf16_t)(u >> 16); }
__device__ __forceinline__ unsigned cvtpk(float lo, float hi) { f32x2_t v = {lo, hi}; bf16x2_t b = __builtin_convertvector(v, bf16x2_t); return __builtin_bit_cast(unsigned, b); }
__device__ __forceinline__ float xhalf_max(float v) { auto rr = __builtin_amdgcn_permlane32_swap(__float_as_uint(v), __float_as_uint(v), false, false); return fmaxf(__uint_as_float(rr[0]), __uint_as_float(rr[1])); }
__device__ __forceinline__ float xhalf_sum(float v) { auto rr = __builtin_amdgcn_permlane32_swap(__float_as_uint(v), __float_as_uint(v), false, false); return __uint_as_float(rr[0]) + __uint_as_float(rr[1]); }
__device__ __forceinline__ float bf2f(bf16_t h) { return __uint_as_float(((unsigned)h) << 16); }
template <int CTRL> __device__ __forceinline__ float dpp_f(float v) { return __int_as_float(__builtin_amdgcn_update_dpp(0, __float_as_int(v), CTRL, 0xF, 0xF, true)); }
__device__ __forceinline__ float grp16_sum(float v) {
    v += dpp_f<0x128>(v); v += dpp_f<0x124>(v); v += dpp_f<0x122>(v); v += dpp_f<0x121>(v); return v; }
__device__ __forceinline__ float wave_sum(float v) {
    v = grp16_sum(v);
    const int i = __float_as_int(v);
    return (__int_as_float(__builtin_amdgcn_readlane(i, 0)) + __int_as_float(__builtin_amdgcn_readlane(i, 16))) +
           (__int_as_float(__builtin_amdgcn_readlane(i, 32)) + __int_as_float(__builtin_amdgcn_readlane(i, 48))); }
__device__ __forceinline__ float sigmoidf_(float x) { return __builtin_amdgcn_rcpf(1.0f + __builtin_amdgcn_exp2f(x * -1.4426950408889634f)); }

#define XB_TMO      128
#define XB_XCNT(j)  (256  + 64 * (j))
#define XB_XSUB(j)  (1280 + 64 * (j))
#define XB_XGEN(j)  (2304 + 64 * (j))
#define XB_TOP      3328
#define XB_TOPGEN   3392
#define XCD_BAR_WORDS 3456
#define XB_SPIN_CAP (1u << 22)
#define LAS __attribute__((address_space(3)))
__device__ __forceinline__ unsigned xb_ld(unsigned* p)              { return __hip_atomic_load(p, __ATOMIC_RELAXED, __HIP_MEMORY_SCOPE_AGENT); }
__device__ __forceinline__ unsigned xb_add(unsigned* p, unsigned v) { return __hip_atomic_fetch_add(p, v, __ATOMIC_RELAXED, __HIP_MEMORY_SCOPE_AGENT); }
__device__ __forceinline__ unsigned xb_xcc_id() { return (unsigned)__builtin_amdgcn_s_getreg((3 << 11) | 20) & 0xFu; }
#define XB_SPIN(cond, bar) do { unsigned _sp = 0; while (cond) { __builtin_amdgcn_s_sleep(1); \
    if ((++_sp & 255u) == 0u) { if (xb_ld(&(bar)[XB_TMO])) break; if (_sp > XB_SPIN_CAP) { atomicAdd(&(bar)[XB_TMO], 1u); break; } } } } while (0)
struct XcdBarrier { unsigned* bar; unsigned x; volatile LAS unsigned* st; };
__device__ __forceinline__ XcdBarrier xcd_barrier_post(unsigned* bar, volatile LAS unsigned* st) {
    XcdBarrier b; b.bar = bar; b.x = xb_xcc_id(); b.st = st;
    if (threadIdx.x == 0) (void)xb_add(&bar[XB_XCNT(b.x)], 1u);
    return b;
}
__device__ __forceinline__ void xcd_barrier_complete(unsigned* bar, unsigned x, unsigned& nloc, unsigned& nx) {
    const unsigned G = gridDim.x * gridDim.y * gridDim.z;
    unsigned sum, cnt, mine, sp = 0u;
    for (;;) {
        sum = 0u; cnt = 0u; mine = 0u;
#pragma unroll
        for (unsigned j = 0; j < 16; ++j) { const unsigned c = xb_ld(&bar[XB_XCNT(j)]); sum += c; cnt += (c > 0u) ? 1u : 0u; mine = (j == x) ? c : mine; }
        if (sum == G) break;
        __builtin_amdgcn_s_sleep(1);
        if ((++sp & 255u) == 0u) { if (xb_ld(&bar[XB_TMO])) break; if (sp > XB_SPIN_CAP) { atomicAdd(&bar[XB_TMO], 1u); break; } }
    }
    nloc = mine > 0u ? mine : 1u; nx = cnt > 0u ? cnt : 1u;
}
__device__ __forceinline__ void xcd_barrier(const XcdBarrier& b, const int tid0) {
    asm volatile("s_waitcnt vmcnt(0)" ::: "memory");
    __syncthreads();
    if (tid0 == 0) {
        unsigned* bar = b.bar;
        __builtin_amdgcn_s_waitcnt(0);
        unsigned nloc = b.st[0], nx = b.st[1];
        if (nloc == 0u) { xcd_barrier_complete(bar, b.x, nloc, nx); b.st[0] = nloc; b.st[1] = nx; }
        const unsigned old = xb_add(&bar[XB_XSUB(b.x)], 1u);
        const unsigned gen = old / nloc;
        if (old + 1u == (gen + 1u) * nloc) {
            __builtin_amdgcn_fence(__ATOMIC_RELEASE, "agent");
            asm volatile("s_waitcnt vmcnt(0)" ::: "memory");
            const unsigned og = xb_add(&bar[XB_TOP], 1u);
            const unsigned tg = og / nx;
            if (og + 1u == (tg + 1u) * nx) xb_add(&bar[XB_TOPGEN], 1u);
            else XB_SPIN(xb_ld(&bar[XB_TOPGEN]) == tg, bar);
            __builtin_amdgcn_fence(__ATOMIC_ACQUIRE, "agent");
            xb_add(&bar[XB_XGEN(b.x)], 1u);
            asm volatile("s_waitcnt vmcnt(0)" ::: "memory");
        } else {
            XB_SPIN(xb_ld(&bar[XB_XGEN(b.x)]) == gen, bar);
            __builtin_amdgcn_fence(__ATOMIC_ACQUIRE, "agent");
            asm volatile("s_waitcnt vmcnt(0)" ::: "memory");
        }
    }
    __syncthreads();
}

struct Params {
    const float *x, *w_in, *w_out, *ret_norm_g, *dil_norm_g, *rwkv_mu, *rwkv_w0, *rwkv_w_up, *rwkv_a0, *rwkv_a_up, *rwkv_g_up, *rwkv_k_k, *rwkv_k_a,
        *rwkv_r_k, *rwkv_ln_g, *rwkv_ln_b, *vres_down, *vres_mu, *rwkv_v0, *rwkv_v_up, *mla_q_norm_g, *mla_w_q_up, *mla_kv_norm_g, *mla_w_kv_up,
        *mla_out_norm_g, *ln1_g, *ln1_b, *router_w, *router_b, *w_gu, *b_gu, *w_dn, *b_dn, *ln2_g, *ln2_b;
    float* out;
    unsigned* bar; int* cnt; int* wq;
    float *tab_ret, *tab_dil, *tab_mla;
    bf16_t *win_t, *wout_t, *wgu_t, *wdn_t, *wq_t, *wkv_t, *wupt, *aupt, *gupt, *vupt;
    float* xf; bf16_t* xb; bf16_t* pbuf; bf16_t* mixcat; float* y1; bf16_t* x1b;
    float *rq, *rk, *rkv, *rstate;
    float *dq, *dk, *dob, *dlse;
    float *sr, *sw, *sk, *sv, *sa, *sb, *sg, *sy, *vfirst;
    float *c_p, *c_q, *c_rh, *c_y1;
    float *rsq, *rskv, *kpe, *qu, *kvu, *mo;
    bf16_t *mq, *mk, *mv;
    int *rowtok, *toke, *tokpos; float* rowgate; bf16_t *act, *yb;
};

__device__ __forceinline__ int opq_tid(int wbase) { unsigned z = 0u; asm volatile("" : "+s"(z)); int t = wbase | (int)__builtin_amdgcn_mbcnt_hi(~0u, __builtin_amdgcn_mbcnt_lo(~0u, z)); asm volatile("" : "+v"(t)); return t; }
__device__ __forceinline__ int opq_bid() { int b = blockIdx.x; asm volatile("" : "+s"(b)); return b; }
typedef const __attribute__((address_space(4))) Params* KPtr;
typedef const __attribute__((address_space(4))) Params& KRef;
__device__ __forceinline__ KPtr kp_launder(KPtr k) {
    const unsigned long long v = (unsigned long long)k;
    unsigned lo = (unsigned)v, hi = (unsigned)(v >> 32);
    asm volatile("" : "+s"(lo), "+s"(hi));
    return (KPtr)(((unsigned long long)hi << 32) | lo);
}
#define PH_HEADV (void)kp_in; const Params& p = pkv; const int TID = opq_tid(wbase_in), BID = opq_bid(); (void)TID; (void)BID;
#define PH_HEAD (void)pkv; KPtr kp_ = kp_launder(kp_in); KRef p = *kp_; const int TID = opq_tid(wbase_in), BID = opq_bid(); (void)TID; (void)BID;
template <class F>
__device__ __forceinline__ void tr_tile(F f, bf16_t* dst, int ldd, int k0, int n0, float* tile, const int TID) {
    const int tid = TID;
#pragma unroll
    for (int i = 0; i < 8; ++i) { const int e = tid + i * NTHREADS, kk = e >> 6, nn = e & 63; tile[kk * 65 + nn] = f(k0 + kk, n0 + nn); }
    __syncthreads();
    {
        const int nn = tid >> 3, kc = (tid & 7) * 8;
        u32x4 w;
        w[0] = cvtpk(tile[(kc + 0) * 65 + nn], tile[(kc + 1) * 65 + nn]); w[1] = cvtpk(tile[(kc + 2) * 65 + nn], tile[(kc + 3) * 65 + nn]);
        w[2] = cvtpk(tile[(kc + 4) * 65 + nn], tile[(kc + 5) * 65 + nn]); w[3] = cvtpk(tile[(kc + 6) * 65 + nn], tile[(kc + 7) * 65 + nn]);
        *(u32x4*)(dst + (size_t)(n0 + nn) * ldd + k0 + kc) = w;
    }
    __syncthreads();
}

__device__ __forceinline__ void ph_prologue(const Params& pkv, KPtr kp_in, int wbase_in, char* lds) {
    PH_HEAD
    float* tile = (float*)lds;
    const int nb = gridDim.x, bid = BID, tid = TID;
    for (int t = bid; t < DEPTH * NE * 16 * 32; t += nb) {
        const int le = t >> 9, r = t & 511, tk = r >> 5, tn = r & 31;
        const float* src = p.w_gu + (size_t)le * 1024 * 2048;
        tr_tile([&](int k, int n) { return src[(size_t)k * 2048 + n]; }, p.wgu_t + (size_t)le * 2048 * 1024, 1024, tk * 64, tn * 64, tile, TID);
    }
    for (int t = bid; t < DEPTH * NE * 16 * 16; t += nb) {
        const int le = t >> 8, r = t & 255, tk = r >> 4, tn = r & 15;
        const float* src = p.w_dn + (size_t)le * 1024 * 1024;
        tr_tile([&](int k, int n) { return src[(size_t)k * 1024 + n]; }, p.wdn_t + (size_t)le * 1024 * 1024, 1024, tk * 64, tn * 64, tile, TID);
    }
    for (int t = bid; t < DEPTH * 16 * 48; t += nb) {
        const int l = t / (16 * 48), r = t % (16 * 48), tk = r / 48, tn = r % 48;
        const float* src = p.w_in + (size_t)l * 1024 * NIN;
        const float* vr = p.vres_down + (size_t)(l > 0 ? l - 1 : 0) * 1024 * 32;
        tr_tile([&](int k, int n) { return n < NIN ? src[(size_t)k * NIN + n] : ((n < NIN + 32 && l > 0) ? vr[k * 32 + (n - NIN)] : 0.0f); },
                p.win_t + (size_t)l * NINP * 1024, 1024, tk * 64, tn * 64, tile, TID);
    }
    for (int t = bid; t < DEPTH * 16 * 16; t += nb) {
        const int l = t >> 8, r = t & 255, tk = r >> 4, tn = r & 15;
        const float* src = p.w_out + (size_t)l * 1024 * 1024;
        tr_tile([&](int k, int n) { return src[(size_t)k * 1024 + n]; }, p.wout_t + (size_t)l * 1024 * 1024, 1024, tk * 64, tn * 64, tile, TID);
    }
    for (int t = bid; t < DEPTH * 4 * 6; t += nb) {
        const int l = t / 24, r = t % 24, tk = r / 6, tn = r % 6;
        const float* src = p.mla_w_q_up + (size_t)l * 256 * 384; const float* g = p.mla_q_norm_g + l * 256;
        tr_tile([&](int k, int n) { return src[k * 384 + n] * g[k]; }, p.wq_t + (size_t)l * 384 * 256, 256, tk * 64, tn * 64, tile, TID);
    }
    for (int t = bid; t < DEPTH * 2 * 8; t += nb) {
        const int l = t / 16, r = t % 16, tk = r / 8, tn = r % 8;
        const float* src = p.mla_w_kv_up + (size_t)l * 128 * 512; const float* g = p.mla_kv_norm_g + l * 128;
        tr_tile([&](int k, int n) { return src[k * 512 + n] * g[k]; }, p.wkv_t + (size_t)l * 512 * 128, 128, tk * 64, tn * 64, tile, TID);
    }
    for (int i = bid * NTHREADS + tid; i < DEPTH * 256 * 64; i += nb * NTHREADS) {
        const int l = i / (256 * 64), r = i % (256 * 64), n = r / 64, k = r % 64;
        p.wupt[i] = f2bf(p.rwkv_w_up[((size_t)l * 64 + k) * 256 + n]); p.aupt[i] = f2bf(p.rwkv_a_up[((size_t)l * 64 + k) * 256 + n]);
    }
    for (int i = bid * NTHREADS + tid; i < DEPTH * 256 * 128; i += nb * NTHREADS) {
        const int l = i / (256 * 128), r = i % (256 * 128), n = r / 128, k = r % 128;
        p.gupt[i] = f2bf(p.rwkv_g_up[((size_t)l * 128 + k) * 256 + n]);
    }
    for (int i = bid * NTHREADS + tid; i < (DEPTH - 1) * 256 * 32; i += nb * NTHREADS) {
        const int l = i / (256 * 32), r = i % (256 * 32), n = r / 32, k = r % 32;
        p.vupt[i] = f2bf(p.rwkv_v_up[((size_t)l * 32 + k) * 256 + n]);
    }
    for (int i = bid * NTHREADS + tid; i < SEQ * 40; i += nb * NTHREADS) {
        const int pos = i / 40, j = i % 40;
        double theta, rot; int f; float* dst;
        if (j < 16) { theta = 10000.0; rot = 32.0; f = j; dst = p.tab_ret + ((size_t)pos * 16 + f) * 2; }
        else if (j < 24) { theta = 500000.0; rot = 16.0; f = j - 16; dst = p.tab_dil + ((size_t)pos * 8 + f) * 2; }
        else { theta = 10000.0; rot = 32.0; f = j - 24; dst = p.tab_mla + ((size_t)pos * 16 + f) * 2; }
        const double inv = 1.0 / pow(theta, (2.0 * f) / rot), ang = (double)pos * inv;
        dst[0] = (float)cos(ang); dst[1] = (float)sin(ang);
    }
    for (size_t i = (size_t)bid * NTHREADS + tid; i < (size_t)NT * DM / 4; i += (size_t)nb * NTHREADS) {
        const float4 v = ((const float4*)p.x)[i];
        ushort4 o; o.x = f2bf(v.x); o.y = f2bf(v.y); o.z = f2bf(v.z); o.w = f2bf(v.w);
        ((ushort4*)p.xb)[i] = o;
    }
    if (bid == 0 && tid < DEPTH * NE) p.cnt[tid] = 0;
    if (bid == 0 && tid < DEPTH * 16) p.wq[tid] = 0;
}

template <class Epi>
__device__ __forceinline__ void gemm_tile128(const bf16_t* __restrict__ A, int lda, const int* __restrict__ rowidx, int nvalid,
                                             const bf16_t* __restrict__ Bt, int ldb, int K, char* lds, const int TID, Epi epi) {
    constexpr int LDT = 72;
    bf16_t* As = (bf16_t*)lds; bf16_t* Bs = As + 128 * LDT;
    const int tid = TID, lane = tid & 63, wid = tid >> 6, wm = wid >> 2, wn = wid & 3, fr = lane & 15, fq = lane >> 4;
    const bf16_t* ap[2]; const bf16_t* bp[2]; int so[2];
#pragma unroll
    for (int i = 0; i < 2; ++i) {
        const int c = tid + i * NTHREADS, row = c >> 3, kc = c & 7;
        int ar = row; if (rowidx) ar = (row < nvalid) ? rowidx[row] : rowidx[0];
        ap[i] = A + (size_t)ar * lda + kc * 8; bp[i] = Bt + (size_t)row * ldb + kc * 8; so[i] = row * LDT + kc * 8;
    }
    f32x4 acc[4][2];
#pragma unroll
    for (int mi = 0; mi < 4; ++mi)
#pragma unroll
        for (int ni = 0; ni < 2; ++ni) acc[mi][ni] = (f32x4){0.f, 0.f, 0.f, 0.f};
    u32x4 ra0, ra1, rb0, rb1;
    ra0 = *(const u32x4*)(ap[0]); ra1 = *(const u32x4*)(ap[1]); rb0 = *(const u32x4*)(bp[0]); rb1 = *(const u32x4*)(bp[1]);
    const int nk = K >> 6;
    for (int kt = 0; kt < nk; ++kt) {
        __syncthreads();
        *(u32x4*)(As + so[0]) = ra0; *(u32x4*)(As + so[1]) = ra1; *(u32x4*)(Bs + so[0]) = rb0; *(u32x4*)(Bs + so[1]) = rb1;
        __syncthreads();
        if (kt + 1 < nk) {
            const int ko = (kt + 1) * 64;
            ra0 = *(const u32x4*)(ap[0] + ko); ra1 = *(const u32x4*)(ap[1] + ko); rb0 = *(const u32x4*)(bp[0] + ko); rb1 = *(const u32x4*)(bp[1] + ko);
        }
#pragma unroll
        for (int kk = 0; kk < 2; ++kk) {
            bf16x8 af[4], bfr[2];
#pragma unroll
            for (int mi = 0; mi < 4; ++mi) af[mi] = *(const bf16x8*)(As + (wm * 64 + mi * 16 + fr) * LDT + kk * 32 + fq * 8);
#pragma unroll
            for (int ni = 0; ni < 2; ++ni) bfr[ni] = *(const bf16x8*)(Bs + (wn * 32 + ni * 16 + fr) * LDT + kk * 32 + fq * 8);
#pragma unroll
            for (int mi = 0; mi < 4; ++mi)
#pragma unroll
                for (int ni = 0; ni < 2; ++ni) acc[mi][ni] = __builtin_amdgcn_mfma_f32_16x16x32_bf16(bfr[ni], af[mi], acc[mi][ni], 0, 0, 0);
        }
    }
#pragma unroll
    for (int mi = 0; mi < 4; ++mi) epi(wm * 64 + mi * 16 + fr, wn * 32 + fq * 4, acc[mi][0], acc[mi][1]);
    __syncthreads();
}

__device__ __forceinline__ int g8_lds_byte(int r, int c) { const int st = (r >> 4) * 2 + (c >> 5), rr = r & 15, cc = c & 31, ob = rr * 64 + cc * 2; return st * 1024 + (ob ^ (((ob >> 9) & 1) << 5)); }
__device__ __forceinline__ void g8_stage_rc(int b, int& R, int& C) { const int st = b / 1024, sb = b % 1024, swz = sb ^ (((sb >> 9) & 1) << 5); R = (st >> 1) * 16 + swz / 64; C = (st & 1) * 32 + (swz % 64) / 2; }
struct G8Next { const bf16_t* A; const int* rowidx; const bf16_t* Bt; int nvalid; int valid; };
template <class Epi>
__device__ __forceinline__ void gemm_tile256(const bf16_t* __restrict__ A, int lda, const int* __restrict__ rowidx, int nvalid,
                                             const bf16_t* __restrict__ Bt, int ldb, int K, char* lds, const int TID, const bool pre_issued, const G8Next nx, Epi epi) {
    constexpr int G_HT = 128 * 64;
    bf16_t* shm = (bf16_t*)lds;
    int* icache = (int*)(lds + 133120);
#define G8_SA(b, h) (shm + ((b) * 2 + (h)) * G_HT)
#define G8_SB(b, h) (shm + (4 + (b) * 2 + (h)) * G_HT)
#define G8_SPTR(dst, src) do { unsigned long long _v = (unsigned long long)(src); unsigned _lo = (unsigned)_v, _hi = (unsigned)(_v >> 32); asm volatile("" : "+s"(_lo), "+s"(_hi)); \
        dst = (const char*)(((unsigned long long)_hi << 32) | _lo); } while (0)
#define G8_STAGE(P, BASE, OFF, kt) do { const char* _sb; G8_SPTR(_sb, (const char*)(BASE) + (size_t)(kt) * 128); _Pragma("unroll") for (int _i = 0; _i < 2; ++_i) { \
        __builtin_amdgcn_global_load_lds((const unsigned*)(_sb + (size_t)(OFF)[_i]), (unsigned*)((char*)(P) + tz * 16 + _i * 8192), 16, 0, 0); } } while (0)
#define G8_LDA(dst, b, h) _Pragma("unroll") for (int m = 0; m < 4; ++m) _Pragma("unroll") for (int k = 0; k < 2; ++k) \
        dst[m][k] = *reinterpret_cast<const bf16x8*>((char*)G8_SA(b, h) + g8_lds_byte(wr * 64 + m * 16 + fr, k * 32 + fq * 8))
#define G8_LDB(dst, b, h) _Pragma("unroll") for (int n = 0; n < 2; ++n) _Pragma("unroll") for (int k = 0; k < 2; ++k) \
        dst[n][k] = *reinterpret_cast<const bf16x8*>((char*)G8_SB(b, h) + g8_lds_byte(wc * 32 + n * 16 + fr, k * 32 + fq * 8))
#define G8_MMA(ai, bj, At_, Bt_) do { __builtin_amdgcn_s_setprio(1); \
        _Pragma("unroll") for (int m = 0; m < 4; ++m) _Pragma("unroll") for (int n = 0; n < 2; ++n) _Pragma("unroll") for (int k = 0; k < 2; ++k) \
            acc[ai][bj][m][n] = __builtin_amdgcn_mfma_f32_16x16x32_bf16(Bt_[n][k], At_[m][k], acc[ai][bj][m][n], 0, 0, 0); \
        __builtin_amdgcn_s_setprio(0); } while (0)
#define G8_WAIT_V(n) asm volatile("s_waitcnt vmcnt(" #n ")" ::: "memory")
#define G8_WAIT_L(n) asm volatile("s_waitcnt lgkmcnt(" #n ")" ::: "memory")
#define G8_BAR __builtin_amdgcn_s_barrier()
#define G8_SCHED __builtin_amdgcn_sched_barrier(0)
    int tz = opq_tid(TID);
    int wid = tz >> 6, lane = tz & 63, wr = wid >> 2, wc = wid & 3, fr = lane & 15, fq = lane >> 4;
    unsigned aoff0[2], aoff1[2], boff0[2];
#pragma unroll
    for (int i = 0; i < 2; ++i) {
        int r, c; g8_stage_rc(tz * 16 + i * 8192, r, c);
        int r0 = r, r1 = 128 + r;
        if (rowidx) {
            if (pre_issued) { r0 = icache[r0]; r1 = icache[r1]; }
            else { r0 = (r0 < nvalid) ? rowidx[r0] : rowidx[0]; r1 = (r1 < nvalid) ? rowidx[r1] : rowidx[0]; }
        }
        aoff0[i] = (unsigned)(r0 * lda + c) * 2u; aoff1[i] = (unsigned)(r1 * lda + c) * 2u;
        boff0[i] = (unsigned)(r * ldb + c) * 2u;
    }
    const bf16_t* Bt1 = Bt + (size_t)128 * ldb;
    int nidx = 0;
    if (nx.valid && nx.rowidx && tz < 256) nidx = nx.rowidx[(tz < nx.nvalid) ? tz : 0];
    f32x4 acc[2][2][4][2];
#pragma unroll
    for (int a = 0; a < 2; ++a)
#pragma unroll
        for (int b = 0; b < 2; ++b)
#pragma unroll
            for (int m = 0; m < 4; ++m)
#pragma unroll
                for (int n = 0; n < 2; ++n) acc[a][b][m][n] = (f32x4){0.f, 0.f, 0.f, 0.f};
    bf16x8 At[4][2], B0[2][2], B1[2][2];
    const int nt = K / 64;
    if (!pre_issued) {
        G8_STAGE(G8_SB(0, 0), Bt, boff0, 0); G8_STAGE(G8_SA(0, 0), A, aoff0, 0);
        G8_STAGE(G8_SB(0, 1), Bt1, boff0, 0); G8_STAGE(G8_SA(0, 1), A, aoff1, 0);
    }
    if (wr == 1) G8_BAR;
    if (pre_issued) { G8_WAIT_V(32); } else { G8_WAIT_V(4); }
    G8_BAR;
    G8_STAGE(G8_SB(1, 0), Bt, boff0, 1); G8_STAGE(G8_SA(1, 0), A, aoff0, 1); G8_STAGE(G8_SB(1, 1), Bt1, boff0, 1);
    if (!pre_issued) { G8_WAIT_V(6); }
    G8_BAR;
    for (int t = 0; t < nt - 2; t += 2) {
        G8_LDB(B0, 0, 0); G8_SCHED; G8_LDA(At, 0, 0); G8_STAGE(G8_SA(1, 1), A, aoff1, t + 1);
        G8_WAIT_L(8); G8_BAR; G8_WAIT_L(0); G8_MMA(0, 0, At, B0); G8_BAR; G8_SCHED;
        G8_LDB(B1, 0, 1); G8_STAGE(G8_SB(0, 0), Bt, boff0, t + 2);
        G8_BAR; G8_WAIT_L(0); G8_MMA(0, 1, At, B1); G8_BAR;
        G8_LDA(At, 0, 1); G8_STAGE(G8_SA(0, 0), A, aoff0, t + 2);
        G8_BAR; G8_WAIT_L(0); G8_MMA(1, 0, At, B0); G8_BAR; G8_SCHED;
        G8_STAGE(G8_SB(0, 1), Bt1, boff0, t + 2);
        G8_WAIT_V(6); G8_BAR; G8_MMA(1, 1, At, B1); G8_BAR;
        G8_LDB(B0, 1, 0); G8_SCHED; G8_LDA(At, 1, 0); G8_STAGE(G8_SA(0, 1), A, aoff1, t + 2);
        G8_WAIT_L(8); G8_BAR; G8_WAIT_L(0); G8_MMA(0, 0, At, B0); G8_BAR; G8_SCHED;
        G8_LDB(B1, 1, 1); G8_STAGE(G8_SB(1, 0), Bt, boff0, t + 3);
        G8_BAR; G8_WAIT_L(0); G8_MMA(0, 1, At, B1); G8_BAR;
        G8_LDA(At, 1, 1); G8_STAGE(G8_SA(1, 0), A, aoff0, t + 3);
        G8_BAR; G8_WAIT_L(0); G8_MMA(1, 0, At, B0); G8_BAR; G8_SCHED;
        G8_STAGE(G8_SB(1, 1), Bt1, boff0, t + 3);
        G8_WAIT_V(6); G8_BAR; G8_MMA(1, 1, At, B1); G8_BAR;
    }
    { G8_LDB(B0, 0, 0); G8_WAIT_V(0); G8_LDA(At, 0, 0); G8_STAGE(G8_SA(1, 1), A, aoff1, nt - 1);
      G8_BAR; G8_WAIT_L(0); G8_MMA(0, 0, At, B0); G8_BAR;
      G8_LDB(B1, 0, 1); G8_BAR; G8_WAIT_L(0); G8_MMA(0, 1, At, B1); G8_BAR;
      G8_LDA(At, 0, 1); G8_WAIT_V(4); G8_BAR; G8_WAIT_L(0); G8_MMA(1, 0, At, B0); G8_MMA(1, 1, At, B1); G8_BAR; }
    { G8_LDB(B0, 1, 0); G8_LDA(At, 1, 0); G8_WAIT_V(2); G8_BAR; G8_WAIT_L(0); G8_MMA(0, 0, At, B0); G8_BAR;
      G8_LDB(B1, 1, 1); G8_WAIT_V(0); G8_BAR; G8_WAIT_L(0); G8_MMA(0, 1, At, B1); G8_BAR;
      G8_LDA(At, 1, 1); G8_BAR; G8_WAIT_L(0); G8_MMA(1, 0, At, B0); G8_MMA(1, 1, At, B1); G8_BAR; }
    if (wr == 0) G8_BAR;
    asm volatile("" : "+v"(tz)); wid = tz >> 6; lane = tz & 63; wr = wid >> 2; wc = wid & 3; fr = lane & 15; fq = lane >> 4;
    if (nx.valid) {
        if (nx.rowidx) { if (tz < 256) icache[tz] = nidx; G8_WAIT_L(0); G8_BAR; }
        unsigned na0[2], na1[2], nb0[2];
#pragma unroll
        for (int i = 0; i < 2; ++i) {
            int r, c; g8_stage_rc(tz * 16 + i * 8192, r, c);
            int r0 = r, r1 = 128 + r;
            if (nx.rowidx) { r0 = icache[r0]; r1 = icache[r1]; }
            na0[i] = (unsigned)(r0 * lda + c) * 2u; na1[i] = (unsigned)(r1 * lda + c) * 2u; nb0[i] = (unsigned)(r * ldb + c) * 2u;
        }
        const bf16_t* nBt1 = nx.Bt + (size_t)128 * ldb;
        G8_STAGE(G8_SB(0, 0), nx.Bt, nb0, 0); G8_STAGE(G8_SA(0, 0), nx.A, na0, 0);
        G8_STAGE(G8_SB(0, 1), nBt1, nb0, 0); G8_STAGE(G8_SA(0, 1), nx.A, na1, 0);
    }
#pragma unroll
    for (int ai = 0; ai < 2; ++ai)
#pragma unroll
        for (int m = 0; m < 4; ++m)
#pragma unroll
            for (int bj = 0; bj < 2; ++bj) epi(ai * 128 + wr * 64 + m * 16 + fr, bj * 128 + wc * 32 + fq * 4, acc[ai][bj][m][0], acc[ai][bj][m][1]);
    G8_BAR;
}

#define XU_LOOP(nM_, nN_) const int xu_x = BID & 7, xu_nb = gridDim.x >> 3, xu_own = ((nM_) - xu_x + 7) >> 3, xu_nN = (nN_); for (int xv = BID >> 3; xv < xu_own * xu_nN; xv += xu_nb)
#define XU_UNIT() ((xu_x + 8 * (xv / xu_nN)) * xu_nN + (xv % xu_nN))
#define XU_NEXT_OK ((xv + xu_nb) < xu_own * xu_nN)
#define XU_NEXT_UNIT() ((xu_x + 8 * ((xv + xu_nb) / xu_nN)) * xu_nN + ((xv + xu_nb) % xu_nN))
__device__ __forceinline__ void ph_inproj(const Params& pkv, KPtr kp_in, int wbase_in, int l, char* lds) {
    PH_HEAD
    const bf16_t* Bt = p.win_t + (size_t)l * NINP * 1024;
    const int ntn = NINP / 256, nunits = (NT / 256) * ntn;
    bool pre = false;
    XU_LOOP(NT / 256, ntn) {
        const int u = XU_UNIT();
        const int mt = u / ntn, nt = u % ntn, un = XU_NEXT_UNIT(), mt2 = un / ntn, nt2 = un % ntn;
        G8Next nx; nx.valid = (XU_NEXT_OK) ? 1 : 0; nx.rowidx = nullptr; nx.nvalid = 256; nx.A = p.xb + (size_t)mt2 * 256 * 1024; nx.Bt = Bt + (size_t)nt2 * 256 * 1024;
        bf16_t* out = p.pbuf + (size_t)mt * 256 * NINP + nt * 256;
        const float* tabr = p.tab_ret; const float* tabd = p.tab_dil; bf16_t* rqb = (bf16_t*)p.rq; bf16_t* rkb = (bf16_t*)p.rk; bf16_t* dqb = (bf16_t*)p.dq; bf16_t* dkb = (bf16_t*)p.dk;
        gemm_tile256(p.xb + (size_t)mt * 256 * 1024, 1024, nullptr, 256, Bt + (size_t)nt * 256 * 1024, 1024, 1024, lds, wbase_in, pre, nx,
                     [=](int r, int c, f32x4 v0, f32x4 v1) mutable {
                         const int pos = (mt * 256 + r) % SEQ; const size_t t = (size_t)mt * 256 + r;
                         if (nt == 0) {
                             const int i0 = c & 15, hc = c & 127; const bool isk = c >= 128;
                             const f32x4 cs0 = *(const f32x4*)(tabr + (pos * 16 + i0) * 2), cs1 = *(const f32x4*)(tabr + (pos * 16 + i0) * 2 + 4);
                             const float sc = isk ? 0.17677669529663687f : 1.0f;
                             const f32x4 a = v0 * sc, b = v1 * sc;
                             v0[0] = a[0] * cs0[0] - b[0] * cs0[1]; v1[0] = a[0] * cs0[1] + b[0] * cs0[0]; v0[1] = a[1] * cs0[2] - b[1] * cs0[3]; v1[1] = a[1] * cs0[3] + b[1] * cs0[2];
                             v0[2] = a[2] * cs1[0] - b[2] * cs1[1]; v1[2] = a[2] * cs1[1] + b[2] * cs1[0]; v0[3] = a[3] * cs1[2] - b[3] * cs1[3]; v1[3] = a[3] * cs1[3] + b[3] * cs1[2];
                             bf16_t* dst = (isk ? rkb : rqb) + t * 128 + hc;
                             uint2 o; o.x = cvtpk(v0[0], v0[1]); o.y = cvtpk(v0[2], v0[3]); *(uint2*)dst = o; o.x = cvtpk(v1[0], v1[1]); o.y = cvtpk(v1[2], v1[3]); *(uint2*)(dst + 16) = o;
                         } else if (nt == 3 || nt == 4) {
                             const float sc = (nt == 3) ? (0.125f * 1.4426950408889634f) : 1.0f;
                             v0 = v0 * sc; v1 = v1 * sc;
                             if ((c & 32) == 0) {
                                 f32x4 pv;
#pragma unroll
                                 for (int j = 0; j < 4; ++j) { auto rr = __builtin_amdgcn_permlane32_swap(__float_as_uint(v0[j]), __float_as_uint(v0[j]), false, false); pv[j] = __uint_as_float((c & 8) ? rr[0] : rr[1]); }
                                 const int i0 = c & 7;
                                 const f32x4 cs0 = *(const f32x4*)(tabd + (pos * 8 + i0) * 2), cs1 = *(const f32x4*)(tabd + (pos * 8 + i0) * 2 + 4);
                                 const f32x4 own = v0;
                                 if ((c & 8) == 0) { v0[0] = own[0] * cs0[0] - pv[0] * cs0[1]; v0[1] = own[1] * cs0[2] - pv[1] * cs0[3]; v0[2] = own[2] * cs1[0] - pv[2] * cs1[1]; v0[3] = own[3] * cs1[2] - pv[3] * cs1[3]; }
                                 else { v0[0] = pv[0] * cs0[1] + own[0] * cs0[0]; v0[1] = pv[1] * cs0[3] + own[1] * cs0[2]; v0[2] = pv[2] * cs1[1] + own[2] * cs1[0]; v0[3] = pv[3] * cs1[3] + own[3] * cs1[2]; }
                             }
                             bf16_t* dst = ((nt == 3) ? dqb : dkb) + t * 256 + c;
                             uint2 o; o.x = cvtpk(v0[0], v0[1]); o.y = cvtpk(v0[2], v0[3]); *(uint2*)dst = o; o.x = cvtpk(v1[0], v1[1]); o.y = cvtpk(v1[2], v1[3]); *(uint2*)(dst + 16) = o;
                         } else {
                             uint2 o; o.x = cvtpk(v0[0], v0[1]); o.y = cvtpk(v0[2], v0[3]); *(uint2*)(out + (size_t)r * NINP + c) = o;
                             o.x = cvtpk(v1[0], v1[1]); o.y = cvtpk(v1[2], v1[3]); *(uint2*)(out + (size_t)r * NINP + c + 16) = o;
                         } });
        pre = nx.valid != 0;
    }
}

__device__ __forceinline__ void ph_rope_prep(const Params& pkv, KPtr kp_in, int wbase_in, int l) {
    PH_HEAD
    const int lane = TID & 63, gw = BID * (NTHREADS / 64) + (TID >> 6), nw = gridDim.x * (NTHREADS / 64);
#pragma unroll 2
    for (int t = gw; t < NT; t += nw) {
        const int pos = t % SEQ;
        const bf16_t* pr = p.pbuf + (size_t)t * NINP;
        {
            float ss = 0.f;
            for (int e = lane; e < 256; e += 64) { const float v = bf2f(pr[PC_MQ + e]); ss += v * v; }
            ss = wave_sum(ss);
            float s2 = 0.f;
            for (int e = lane; e < 128; e += 64) { const float v = bf2f(pr[PC_MKV + e]); s2 += v * v; }
            s2 = wave_sum(s2);
            if (lane == 0) { p.rsq[t] = rsqrtf(ss * (1.0f / 256.0f) + 1e-6f); p.rskv[t] = rsqrtf(s2 * (1.0f / 128.0f) + 1e-6f); }
            if (lane < 16) {
                const float c = p.tab_mla[(pos * 16 + lane) * 2], s = p.tab_mla[(pos * 16 + lane) * 2 + 1];
                const float x1 = bf2f(pr[PC_MKR + lane]), x2 = bf2f(pr[PC_MKR + 16 + lane]);
                const bf16_t k1 = f2bf(x1 * c - x2 * s), k2 = f2bf(x1 * s + x2 * c);
#pragma unroll
                for (int hd = 0; hd < 4; ++hd) { p.mk[((size_t)t * 4 + hd) * 96 + 64 + lane] = k1; p.mk[((size_t)t * 4 + hd) * 96 + 80 + lane] = k2; }
            }
        }
    }
}

__device__ __forceinline__ float ret_log_gamma(int h) { return logf(1.0f - exp2f(-5.0f - (float)h)); }

__device__ __forceinline__ void ph_ret_kv(const Params& pkv, KPtr kp_in, int wbase_in, int l, char* lds) {
    PH_HEAD
    float* kz = (float*)lds;
    float* vs = kz + 128 * 32;
    const int tid = TID;
    for (int u = BID; u < NBATCH * NCH * 4; u += gridDim.x) {
        const int h = u & 3, n = (u >> 2) & 63, b = u >> 8;
        const float lg = ret_log_gamma(h);
        const int t0 = b * SEQ + n * BLK;
        __syncthreads();
        for (int e = tid; e < 128 * 32; e += NTHREADS) { const int j = e >> 5, d = e & 31; kz[e] = bf2f(((const bf16_t*)p.rk)[(size_t)(t0 + j) * 128 + h * 32 + d]) * __expf((float)(BLK - 1 - j) * lg); }
        for (int e = tid; e < 128 * 64; e += NTHREADS) { const int j = e >> 6, c = e & 63; vs[e] = bf2f(p.pbuf[(size_t)(t0 + j) * NINP + PC_RV + h * 64 + c]); }
        __syncthreads();
        const int e = tid & 63, d0 = (tid >> 6) * 4;
        float a0 = 0.f, a1 = 0.f, a2 = 0.f, a3 = 0.f;
#pragma unroll 8
        for (int j = 0; j < BLK; ++j) {
            const float vv = vs[j * 64 + e]; const float4 kk = *(const float4*)(kz + j * 32 + d0);
            a0 += kk.x * vv; a1 += kk.y * vv; a2 += kk.z * vv; a3 += kk.w * vv;
        }
        float* out = p.rkv + (size_t)u * 2048;
        out[(d0 + 0) * 64 + e] = a0; out[(d0 + 1) * 64 + e] = a1; out[(d0 + 2) * 64 + e] = a2; out[(d0 + 3) * 64 + e] = a3;
    }
}
__device__ __forceinline__ void ph_ret_scan(const Params& pkv, KPtr kp_in, int wbase_in, int l) {
    PH_HEAD
    const int i = BID * NTHREADS + TID;
    if (i < NBATCH * 4 * 32 * 64) {
        const int e = i & 63, d = (i >> 6) & 31, h = (i >> 11) & 3, b = i >> 13;
        const float cd = __expf((float)BLK * ret_log_gamma(h));
        float s = 0.f;
        for (int n = 0; n < NCH; ++n) {
            const size_t idx = ((((size_t)b * NCH + n) * 4 + h) * 32 + d) * 64 + e;
            p.rstate[idx] = s; s = cd * s + p.rkv[idx];
        }
    }
}
__device__ __forceinline__ void ph_ret_out(const Params& pkv, KPtr kp_in, int wbase_in, int l, char* lds) {
    PH_HEAD
    constexpr int KSTR = 40, VSTR = 132, SSTR = 40, UNIT_BYTES = (128 * KSTR + 64 * VSTR + 64 * SSTR) * 2;
    const int tid = TID, lane = tid & 63, wv = tid >> 6, hb = wv >> 2, w = wv & 3, r = lane & 31, hh = lane >> 5, ht = tid & 255;
    bf16_t* Ks = (bf16_t*)(lds + hb * UNIT_BYTES);
    bf16_t* Vt = Ks + 128 * KSTR;
    bf16_t* St = Vt + 64 * VSTR;
    const bf16_t* rqb = (const bf16_t*)p.rq; const bf16_t* rkb = (const bf16_t*)p.rk;
    int* wq = p.wq + l * 16 + 2;
    volatile int* wslot = (volatile int*)(lds + 2 * UNIT_BYTES);
    for (;;) {
        __syncthreads();
        if (tid == 0) *wslot = atomicAdd(wq, 1);
        __syncthreads();
        const int u0 = __builtin_amdgcn_readfirstlane(*wslot) * 2;
        if (u0 >= NBATCH * NCH * 4) break;
        const int u = u0 + hb, h = u & 3, n = (u >> 2) & 63, b = u >> 8;
        const int t0 = b * SEQ + n * BLK;
        const float lg2 = ret_log_gamma(h) * 1.4426950408889634f;
        __syncthreads();
#pragma unroll
        for (int i = 0; i < 2; ++i) { const int c = ht + i * 256, key = c >> 2, ch = c & 3; *(u32x4*)(Ks + key * KSTR + ch * 8) = *(const u32x4*)(rkb + (size_t)(t0 + key) * 128 + h * 32 + ch * 8); }
#pragma unroll
        for (int i = 0; i < 4; ++i) {
            const int c = ht + i * 256, key = c & 127, ch = c >> 7;
            const u32x4 rv = *(const u32x4*)(p.pbuf + (size_t)(t0 + key) * NINP + PC_RV + h * 64 + ch * 8);
            bf16_t* vd = Vt + (ch * 8) * VSTR + key;
            vd[0] = (bf16_t)(rv[0] & 0xffff); vd[VSTR] = (bf16_t)(rv[0] >> 16); vd[2 * VSTR] = (bf16_t)(rv[1] & 0xffff); vd[3 * VSTR] = (bf16_t)(rv[1] >> 16);
            vd[4 * VSTR] = (bf16_t)(rv[2] & 0xffff); vd[5 * VSTR] = (bf16_t)(rv[2] >> 16); vd[6 * VSTR] = (bf16_t)(rv[3] & 0xffff); vd[7 * VSTR] = (bf16_t)(rv[3] >> 16);
        }
        {
            const float* st = p.rstate + (size_t)u * 2048;
#pragma unroll
            for (int i = 0; i < 8; ++i) { const int c = ht + i * 256, d = c >> 6, e = c & 63; St[e * SSTR + d] = f2bf(st[c]); }
        }
        __syncthreads();
        const int iq = 32 * w + r, t = t0 + iq;
        bf16x8 qf[2];
#pragma unroll
        for (int s = 0; s < 2; ++s) qf[s] = *(const bf16x8*)(rqb + (size_t)t * 128 + h * 32 + 16 * s + 8 * hh);
        f32x16 o0, o1;
#pragma unroll
        for (int i = 0; i < 16; ++i) { o0[i] = 0.f; o1[i] = 0.f; }
#pragma unroll
        for (int s = 0; s < 2; ++s) {
            const bf16x8 sa0 = *(const bf16x8*)(St + r * SSTR + 16 * s + 8 * hh), sa1 = *(const bf16x8*)(St + (32 + r) * SSTR + 16 * s + 8 * hh);
            o0 = __builtin_amdgcn_mfma_f32_32x32x16_bf16(sa0, qf[s], o0, 0, 0, 0);
            o1 = __builtin_amdgcn_mfma_f32_32x32x16_bf16(sa1, qf[s], o1, 0, 0, 0);
        }
        {
            const float xi = __builtin_amdgcn_exp2f((float)(iq + 1) * lg2);
#pragma unroll
            for (int i = 0; i < 16; ++i) { o0[i] *= xi; o1[i] *= xi; }
        }
        float cdec[16];
#pragma unroll
        for (int i = 0; i < 16; ++i) cdec[i] = __builtin_amdgcn_exp2f(-(float)((i & 3) + 8 * (i >> 2) + 4 * hh) * lg2);
        for (int jt = 0; jt <= w; ++jt) {
            f32x16 st;
#pragma unroll
            for (int i = 0; i < 16; ++i) st[i] = 0.f;
#pragma unroll
            for (int s = 0; s < 2; ++s) { const bf16x8 kf = *(const bf16x8*)(Ks + (32 * jt + r) * KSTR + 16 * s + 8 * hh); st = __builtin_amdgcn_mfma_f32_32x32x16_bf16(kf, qf[s], st, 0, 0, 0); }
            const float al = __builtin_amdgcn_exp2f((float)(32 * (w - jt) + r) * lg2);
            if (jt == w) {
#pragma unroll
                for (int i = 0; i < 16; ++i) { const int kr = (i & 3) + 8 * (i >> 2) + 4 * hh; st[i] = (kr <= r) ? st[i] * (al * cdec[i]) : 0.f; }
            } else {
#pragma unroll
                for (int i = 0; i < 16; ++i) st[i] *= al * cdec[i];
            }
#pragma unroll
            for (int s = 0; s < 2; ++s) {
                u32x4 pw; pw[0] = cvtpk(st[8 * s], st[8 * s + 1]); pw[1] = cvtpk(st[8 * s + 2], st[8 * s + 3]); pw[2] = cvtpk(st[8 * s + 4], st[8 * s + 5]); pw[3] = cvtpk(st[8 * s + 6], st[8 * s + 7]);
                const bf16x8 pf = __builtin_bit_cast(bf16x8, pw);
                const bf16_t* va = Vt + r * VSTR + 32 * jt + 16 * s + 4 * hh;
                const s16x4 a0 = *(const s16x4*)(va), a1 = *(const s16x4*)(va + 8), b0 = *(const s16x4*)(va + 32 * VSTR), b1 = *(const s16x4*)(va + 32 * VSTR + 8);
                o0 = __builtin_amdgcn_mfma_f32_32x32x16_bf16(__builtin_shufflevector(a0, a1, 0, 1, 2, 3, 4, 5, 6, 7), pf, o0, 0, 0, 0);
                o1 = __builtin_amdgcn_mfma_f32_32x32x16_bf16(__builtin_shufflevector(b0, b1, 0, 1, 2, 3, 4, 5, 6, 7), pf, o1, 0, 0, 0);
            }
        }
        float ss = 0.f;
#pragma unroll
        for (int i = 0; i < 16; ++i) ss += o0[i] * o0[i] + o1[i] * o1[i];
        ss = xhalf_sum(ss);
        const float rs = rsqrtf(ss * (1.0f / 64.0f) + 1e-6f);
        const float* ng = p.ret_norm_g + l * 256 + h * 64 + 4 * hh;
        const bf16_t* gp = p.pbuf + (size_t)t * NINP + PC_RG + h * 64 + 4 * hh;
        bf16_t* outp = p.mixcat + (size_t)t * 1024 + h * 64 + 4 * hh;
#pragma unroll
        for (int c = 0; c < 2; ++c)
#pragma unroll
            for (int g = 0; g < 4; ++g) {
                const int eo = 32 * c + 8 * g;
                const f32x4 gn = *(const f32x4*)(ng + eo); const uint2 gu = *(const uint2*)(gp + eo);
                const float g0 = __uint_as_float(gu.x << 16), g1 = __uint_as_float(gu.x & 0xffff0000u), g2 = __uint_as_float(gu.y << 16), g3 = __uint_as_float(gu.y & 0xffff0000u);
                const float v0 = (c ? o1[4 * g] : o0[4 * g]) * rs * gn[0], v1 = (c ? o1[4 * g + 1] : o0[4 * g + 1]) * rs * gn[1], v2 = (c ? o1[4 * g + 2] : o0[4 * g + 2]) * rs * gn[2], v3 = (c ? o1[4 * g + 3] : o0[4 * g + 3]) * rs * gn[3];
                uint2 ov; ov.x = cvtpk(g0 * sigmoidf_(g0) * v0, g1 * sigmoidf_(g1) * v1); ov.y = cvtpk(g2 * sigmoidf_(g2) * v2, g3 * sigmoidf_(g3) * v3);
                *(uint2*)(outp + eo) = ov;
            }
    }
}

__device__ __forceinline__ void ph_dil_attn(const Params& pkv, KPtr kp_in, int wbase_in, int l, char* lds) {
    PH_HEAD
    constexpr int KSTR = 72, VSTR = 68;
    bf16_t* Ks = (bf16_t*)lds;
    bf16_t* Vt = Ks + 64 * KSTR;
    const int tid = TID, lane = tid & 63, wv = tid >> 6, r = lane & 31, h = lane >> 5;
    int* wq = p.wq + l * 16 + 1;
    volatile int* wslot = (volatile int*)(lds + 24576);
    for (;;) {
        __syncthreads();
        if (tid == 0) *wslot = atomicAdd(wq, 1);
        __syncthreads();
        const int it = __builtin_amdgcn_readfirstlane(*wslot);
        if (it >= 16 * 96) break;
        const int bh = it & 15, u = it >> 4;
        const int b = bh >> 2, hd = bh & 3;
        int pat, dil, rr, m0;
        if (u < 32) { pat = 0; dil = 1; rr = 0; m0 = u * 256; }
        else if (u < 64) { pat = 1; dil = 4; rr = (u - 32) >> 3; m0 = ((u - 32) & 7) * 256; }
        else { pat = 2; dil = 16; rr = (u - 64) >> 1; m0 = ((u - 64) & 1) * 256; }
        const int qmin = m0 + 32 * wv, qmax = qmin + 31, myq = qmin + r;
        const size_t tok0 = (size_t)b * SEQ + rr;
        bf16x8 qf[4];
        {
            const bf16_t* qrow = (const bf16_t*)p.dq + (tok0 + (size_t)dil * myq) * 256 + hd * 64 + 8 * h;
#pragma unroll
            for (int s = 0; s < 4; ++s) qf[s] = *(const bf16x8*)(qrow + 16 * s);
        }
        f32x16 o0, o1;
#pragma unroll
        for (int i = 0; i < 16; ++i) { o0[i] = 0.f; o1[i] = 0.f; }
        float m = -1e30f, lsum = 0.f;
        const int kk = tid >> 3, kc = tid & 7, vk = tid & 63, vc = tid >> 6;
        const bf16_t* kbase = (const bf16_t*)p.dk + hd * 64 + kc * 8;
        const bf16_t* vbase = p.pbuf + PC_DV + hd * 64 + vc * 8;
        const int j0 = (m0 == 0) ? 2 : 0;
        u32x4 rk, rv;
        {
            const int kb = m0 - 128 + 64 * j0;
            rk = *(const u32x4*)(kbase + (tok0 + (size_t)dil * (kb + kk)) * 256);
            rv = *(const u32x4*)(vbase + (tok0 + (size_t)dil * (kb + vk)) * NINP);
        }
        for (int j = j0; j < 6; ++j) {
            __syncthreads();
            *(u32x4*)(Ks + kk * KSTR + kc * 8) = rk;
            {
                const unsigned w0 = rv[0], w1 = rv[1], w2 = rv[2], w3 = rv[3];
                bf16_t* vd = Vt + (vc * 8) * VSTR + vk;
                vd[0] = (bf16_t)(w0 & 0xffff); vd[VSTR] = (bf16_t)(w0 >> 16); vd[2 * VSTR] = (bf16_t)(w1 & 0xffff); vd[3 * VSTR] = (bf16_t)(w1 >> 16);
                vd[4 * VSTR] = (bf16_t)(w2 & 0xffff); vd[5 * VSTR] = (bf16_t)(w2 >> 16); vd[6 * VSTR] = (bf16_t)(w3 & 0xffff); vd[7 * VSTR] = (bf16_t)(w3 >> 16);
            }
            __syncthreads();
            const int kb = m0 - 128 + 64 * j;
            if (j + 1 < 6) {
                const int kn = kb + 64;
                rk = *(const u32x4*)(kbase + (tok0 + (size_t)dil * (kn + kk)) * 256);
                rv = *(const u32x4*)(vbase + (tok0 + (size_t)dil * (kn + vk)) * NINP);
            }
            const bool need0 = (kb <= qmax) && (kb + 31 >= qmin - 128);
            const bool need1 = (kb + 32 <= qmax) && (kb + 63 >= qmin - 128);
            if (need0 || need1) {
                f32x16 s0, s1;
#pragma unroll
                for (int i = 0; i < 16; ++i) { s0[i] = -3e38f; s1[i] = -3e38f; }
                if (need0) {
#pragma unroll
                    for (int i = 0; i < 16; ++i) s0[i] = 0.f;
#pragma unroll
                    for (int s = 0; s < 4; ++s) { const bf16x8 kf = *(const bf16x8*)(Ks + r * KSTR + 16 * s + 8 * h); s0 = __builtin_amdgcn_mfma_f32_32x32x16_bf16(kf, qf[s], s0, 0, 0, 0); }
                    if (!((kb + 31 <= qmin) && (kb >= qmax - 128))) {
#pragma unroll
                        for (int i = 0; i < 16; ++i) { const int key = kb + (i & 3) + 8 * (i >> 2) + 4 * h; if (key > myq || key < myq - 128) s0[i] = -3e38f; }
                    }
                }
                if (need1) {
#pragma unroll
                    for (int i = 0; i < 16; ++i) s1[i] = 0.f;
#pragma unroll
                    for (int s = 0; s < 4; ++s) { const bf16x8 kf = *(const bf16x8*)(Ks + (32 + r) * KSTR + 16 * s + 8 * h); s1 = __builtin_amdgcn_mfma_f32_32x32x16_bf16(kf, qf[s], s1, 0, 0, 0); }
                    if (!((kb + 63 <= qmin) && (kb + 32 >= qmax - 128))) {
#pragma unroll
                        for (int i = 0; i < 16; ++i) { const int key = kb + 32 + (i & 3) + 8 * (i >> 2) + 4 * h; if (key > myq || key < myq - 128) s1[i] = -3e38f; }
                    }
                }
                float mx = s0[0];
#pragma unroll
                for (int i = 1; i < 16; ++i) mx = fmaxf(mx, s0[i]);
#pragma unroll
                for (int i = 0; i < 16; ++i) mx = fmaxf(mx, s1[i]);
                mx = xhalf_max(mx);
                const float mn = fmaxf(m, mx), alpha = __builtin_amdgcn_exp2f(m - mn);
                m = mn;
                float ps = 0.f;
                if (need0) {
#pragma unroll
                    for (int i = 0; i < 16; ++i) { s0[i] = __builtin_amdgcn_exp2f(s0[i] - mn); ps += s0[i]; }
                }
                if (need1) {
#pragma unroll
                    for (int i = 0; i < 16; ++i) { s1[i] = __builtin_amdgcn_exp2f(s1[i] - mn); ps += s1[i]; }
                }
                lsum = lsum * alpha + ps;
                if (!__all(alpha == 1.0f)) {
#pragma unroll
                    for (int i = 0; i < 16; ++i) { o0[i] *= alpha; o1[i] *= alpha; }
                }
                if (need0) {
#pragma unroll
                    for (int s = 0; s < 2; ++s) {
                        u32x4 pw; pw[0] = cvtpk(s0[8 * s], s0[8 * s + 1]); pw[1] = cvtpk(s0[8 * s + 2], s0[8 * s + 3]); pw[2] = cvtpk(s0[8 * s + 4], s0[8 * s + 5]); pw[3] = cvtpk(s0[8 * s + 6], s0[8 * s + 7]);
                        const bf16x8 pf = __builtin_bit_cast(bf16x8, pw);
                        const bf16_t* va = Vt + r * VSTR + 16 * s + 4 * h;
                        const s16x4 a0 = *(const s16x4*)(va), a1 = *(const s16x4*)(va + 8), b0 = *(const s16x4*)(va + 32 * VSTR), b1 = *(const s16x4*)(va + 32 * VSTR + 8);
                        o0 = __builtin_amdgcn_mfma_f32_32x32x16_bf16(__builtin_shufflevector(a0, a1, 0, 1, 2, 3, 4, 5, 6, 7), pf, o0, 0, 0, 0);
                        o1 = __builtin_amdgcn_mfma_f32_32x32x16_bf16(__builtin_shufflevector(b0, b1, 0, 1, 2, 3, 4, 5, 6, 7), pf, o1, 0, 0, 0);
                    }
                }
                if (need1) {
#pragma unroll
                    for (int s = 0; s < 2; ++s) {
                        u32x4 pw; pw[0] = cvtpk(s1[8 * s], s1[8 * s + 1]); pw[1] = cvtpk(s1[8 * s + 2], s1[8 * s + 3]); pw[2] = cvtpk(s1[8 * s + 4], s1[8 * s + 5]); pw[3] = cvtpk(s1[8 * s + 6], s1[8 * s + 7]);
                        const bf16x8 pf = __builtin_bit_cast(bf16x8, pw);
                        const bf16_t* va = Vt + r * VSTR + 32 + 16 * s + 4 * h;
                        const s16x4 a0 = *(const s16x4*)(va), a1 = *(const s16x4*)(va + 8), b0 = *(const s16x4*)(va + 32 * VSTR), b1 = *(const s16x4*)(va + 32 * VSTR + 8);
                        o0 = __builtin_amdgcn_mfma_f32_32x32x16_bf16(__builtin_shufflevector(a0, a1, 0, 1, 2, 3, 4, 5, 6, 7), pf, o0, 0, 0, 0);
                        o1 = __builtin_amdgcn_mfma_f32_32x32x16_bf16(__builtin_shufflevector(b0, b1, 0, 1, 2, 3, 4, 5, 6, 7), pf, o1, 0, 0, 0);
                    }
                }
            }
        }
        const float lt = xhalf_sum(lsum), inv = 1.0f / lt;
        const size_t tq = tok0 + (size_t)dil * myq;
        float* op = p.dob + ((size_t)pat * NT + tq) * 256 + hd * 64 + 4 * h;
#pragma unroll
        for (int g = 0; g < 4; ++g) {
            *(f32x4*)(op + 8 * g) = (f32x4){o0[4 * g] * inv, o0[4 * g + 1] * inv, o0[4 * g + 2] * inv, o0[4 * g + 3] * inv};
            *(f32x4*)(op + 32 + 8 * g) = (f32x4){o1[4 * g] * inv, o1[4 * g + 1] * inv, o1[4 * g + 2] * inv, o1[4 * g + 3] * inv};
        }
        if (h == 0) p.dlse[((size_t)pat * NT + tq) * 4 + hd] = m + __builtin_amdgcn_logf(lt);
        __syncthreads();
    }
}

__device__ __forceinline__ void ph_rwkv_prep(const Params& pkv, KPtr kp_in, int wbase_in, int l, char* lds) {
    PH_HEAD
    bf16_t* Aw = (bf16_t*)lds; bf16_t* Aa = Aw + 64 * 72; bf16_t* Ag = Aa + 64 * 72; bf16_t* Av = Ag + 64 * 136; float* ssq = (float*)(Av + 64 * 40);
    const int tid = TID, lane = tid & 63, wv = tid >> 6, fr = lane & 15, fq = lane >> 4;
    const int lm = (l > 0) ? l - 1 : 0;
    const float* mu = p.rwkv_mu + l * 1024; const float* vmu = p.vres_mu + lm * 32;
    bf16x8 fw[2][2], fa[2][2], fg[2][4], fv[2];
#pragma unroll
    for (int ni = 0; ni < 2; ++ni) {
        const int n = 32 * wv + 16 * ni + fr;
#pragma unroll
        for (int ks = 0; ks < 2; ++ks) { fw[ni][ks] = *(const bf16x8*)(p.wupt + ((size_t)l * 256 + n) * 64 + 32 * ks + 8 * fq); fa[ni][ks] = *(const bf16x8*)(p.aupt + ((size_t)l * 256 + n) * 64 + 32 * ks + 8 * fq); }
#pragma unroll
        for (int ks = 0; ks < 4; ++ks) fg[ni][ks] = *(const bf16x8*)(p.gupt + ((size_t)l * 256 + n) * 128 + 32 * ks + 8 * fq);
        fv[ni] = *(const bf16x8*)(p.vupt + ((size_t)lm * 256 + n) * 32 + 8 * fq);
    }
    for (int tb = BID * 64; tb < NT; tb += gridDim.x * 64) {
        __syncthreads();
        for (int e = tid; e < 64 * 144; e += NTHREADS) {
            const int tt = e / 144, j = (e % 144) * 2, t = tb + tt;
            const bool first = (t % SEQ) == 0;
            const bf16_t* pr = p.pbuf + (size_t)t * NINP;
            int col; float m0, m1;
            if (j < 256) { col = PC_CWD + j; m0 = mu[768 + j]; m1 = mu[768 + j + 1]; } else { col = PC_VRES + (j - 256); m0 = vmu[j - 256]; m1 = vmu[j - 255]; }
            const unsigned cu = *(const unsigned*)(pr + col), pu = first ? 0u : *(const unsigned*)(pr + col - NINP);
            const float c0 = __uint_as_float(cu << 16), c1 = __uint_as_float(cu & 0xffff0000u), p0 = __uint_as_float(pu << 16), p1 = __uint_as_float(pu & 0xffff0000u);
            float x0 = c0 + (p0 - c0) * m0, x1 = c1 + (p1 - c1) * m1;
            bf16_t* dst;
            if (j < 64) { x0 = 1.0f - 2.0f * __builtin_amdgcn_rcpf(__builtin_amdgcn_exp2f(x0 * 2.8853900817779268f) + 1.0f); x1 = 1.0f - 2.0f * __builtin_amdgcn_rcpf(__builtin_amdgcn_exp2f(x1 * 2.8853900817779268f) + 1.0f); dst = Aw + tt * 72 + j; }
            else if (j < 128) { dst = Aa + tt * 72 + (j - 64); }
            else if (j < 256) { x0 = sigmoidf_(x0); x1 = sigmoidf_(x1); dst = Ag + tt * 136 + (j - 128); }
            else { dst = Av + tt * 40 + (j - 256); }
            *(unsigned*)dst = cvtpk(x0, x1);
        }
        {
            const f32x4 kkc = *(const f32x4*)(p.rwkv_k_k + l * 256 + lane * 4), mk4 = *(const f32x4*)(mu + 256 + lane * 4);
#pragma unroll
            for (int i = 0; i < 8; ++i) {
                const int tt = wv * 8 + i, t = tb + tt; const bool first = (t % SEQ) == 0;
                const bf16_t* pr = p.pbuf + (size_t)t * NINP + PC_CK + lane * 4;
                const uint2 cu = *(const uint2*)pr; const uint2 pu = first ? make_uint2(0u, 0u) : *(const uint2*)(pr - NINP);
                const float c0 = __uint_as_float(cu.x << 16), c1 = __uint_as_float(cu.x & 0xffff0000u), c2 = __uint_as_float(cu.y << 16), c3 = __uint_as_float(cu.y & 0xffff0000u);
                const float q0 = __uint_as_float(pu.x << 16), q1 = __uint_as_float(pu.x & 0xffff0000u), q2 = __uint_as_float(pu.y << 16), q3 = __uint_as_float(pu.y & 0xffff0000u);
                const float k0 = (c0 + (q0 - c0) * mk4[0]) * kkc[0], k1 = (c1 + (q1 - c1) * mk4[1]) * kkc[1], k2 = (c2 + (q2 - c2) * mk4[2]) * kkc[2], k3 = (c3 + (q3 - c3) * mk4[3]) * kkc[3];
                const float ss = grp16_sum(k0 * k0 + k1 * k1 + k2 * k2 + k3 * k3);
                if ((lane & 15) == 0) ssq[tt * 4 + (lane >> 4)] = ss;
            }
        }
        __syncthreads();
#pragma unroll 1
        for (int mt = 0; mt < 4; ++mt) {
            f32x4 cw[2], ca[2], cg[2], cv[2];
#pragma unroll
            for (int ni = 0; ni < 2; ++ni) { cw[ni] = (f32x4){0.f, 0.f, 0.f, 0.f}; ca[ni] = cw[ni]; cg[ni] = cw[ni]; cv[ni] = cw[ni]; }
            const int arow = 16 * mt + fr;
#pragma unroll
            for (int ks = 0; ks < 2; ++ks) {
                const bf16x8 xw = *(const bf16x8*)(Aw + arow * 72 + 32 * ks + 8 * fq), xa = *(const bf16x8*)(Aa + arow * 72 + 32 * ks + 8 * fq);
#pragma unroll
                for (int ni = 0; ni < 2; ++ni) { cw[ni] = __builtin_amdgcn_mfma_f32_16x16x32_bf16(fw[ni][ks], xw, cw[ni], 0, 0, 0); ca[ni] = __builtin_amdgcn_mfma_f32_16x16x32_bf16(fa[ni][ks], xa, ca[ni], 0, 0, 0); }
            }
#pragma unroll
            for (int ks = 0; ks < 4; ++ks) {
                const bf16x8 xg = *(const bf16x8*)(Ag + arow * 136 + 32 * ks + 8 * fq);
#pragma unroll
                for (int ni = 0; ni < 2; ++ni) cg[ni] = __builtin_amdgcn_mfma_f32_16x16x32_bf16(fg[ni][ks], xg, cg[ni], 0, 0, 0);
            }
            if (l > 0) {
                const bf16x8 xv = *(const bf16x8*)(Av + arow * 40 + 8 * fq);
#pragma unroll
                for (int ni = 0; ni < 2; ++ni) cv[ni] = __builtin_amdgcn_mfma_f32_16x16x32_bf16(fv[ni], xv, cv[ni], 0, 0, 0);
            }
            const int tt = 16 * mt + fr, t = tb + tt; const bool first = (t % SEQ) == 0;
            const float rn = 1.0f / fmaxf(sqrtf(ssq[tt * 4 + (wv >> 1)]), 1e-12f);
            const bf16_t* pr = p.pbuf + (size_t)t * NINP;
#pragma unroll
            for (int ni = 0; ni < 2; ++ni) {
                const int c0 = 32 * wv + 16 * ni + 4 * fq;
                const f32x4 w0 = *(const f32x4*)(p.rwkv_w0 + l * 256 + c0), a0 = *(const f32x4*)(p.rwkv_a0 + l * 256 + c0), kkc = *(const f32x4*)(p.rwkv_k_k + l * 256 + c0), kac = *(const f32x4*)(p.rwkv_k_a + l * 256 + c0);
                const f32x4 v0 = *(const f32x4*)(p.rwkv_v0 + lm * 256 + c0), mr = *(const f32x4*)(mu + c0), mk = *(const f32x4*)(mu + 256 + c0), mv = *(const f32x4*)(mu + 512 + c0);
                const uint2 ru = *(const uint2*)(pr + PC_CR + c0), ku = *(const uint2*)(pr + PC_CK + c0), vu = *(const uint2*)(pr + PC_CV + c0);
                uint2 rp = make_uint2(0u, 0u), kp2 = rp, vp = rp;
                if (!first) { rp = *(const uint2*)(pr + PC_CR + c0 - NINP); kp2 = *(const uint2*)(pr + PC_CK + c0 - NINP); vp = *(const uint2*)(pr + PC_CV + c0 - NINP); }
                const size_t o = (size_t)t * 256 + c0;
                f32x4 vf = (f32x4){0.f, 0.f, 0.f, 0.f};
                if (l > 0) vf = *(const f32x4*)(p.vfirst + o);
                f32x4 o_r, o_w, o_k, o_v, o_a, o_b;
#pragma unroll
                for (int j = 0; j < 4; ++j) {
                    const unsigned rw = (j < 2) ? ru.x : ru.y, kw = (j < 2) ? ku.x : ku.y, vw = (j < 2) ? vu.x : vu.y, rpw = (j < 2) ? rp.x : rp.y, kpw = (j < 2) ? kp2.x : kp2.y, vpw = (j < 2) ? vp.x : vp.y;
                    const float rc = (j & 1) ? __uint_as_float(rw & 0xffff0000u) : __uint_as_float(rw << 16), kc = (j & 1) ? __uint_as_float(kw & 0xffff0000u) : __uint_as_float(kw << 16), vc = (j & 1) ? __uint_as_float(vw & 0xffff0000u) : __uint_as_float(vw << 16);
                    const float rq = (j & 1) ? __uint_as_float(rpw & 0xffff0000u) : __uint_as_float(rpw << 16), kq = (j & 1) ? __uint_as_float(kpw & 0xffff0000u) : __uint_as_float(kpw << 16), vq = (j & 1) ? __uint_as_float(vpw & 0xffff0000u) : __uint_as_float(vpw << 16);
                    const float r = rc + (rq - rc) * mr[j], k = kc + (kq - kc) * mk[j];
                    float v = vc + (vq - vc) * mv[j];
                    const float wpre = w0[j] + cw[ni][j];
                    const float sp = (-wpre > 20.f) ? -wpre : 0.6931471805599453f * __builtin_amdgcn_logf(1.0f + __builtin_amdgcn_exp2f(wpre * -1.4426950408889634f));
                    const float decay = __builtin_amdgcn_exp2f(-1.4426950408889634f * __builtin_amdgcn_exp2f((-sp - 0.5f) * 1.4426950408889634f));
                    const float a = sigmoidf_(a0[j] + ca[ni][j]);
                    const float kk = k * kkc[j] * rn;
                    const float k2 = k * (1.0f + (a - 1.0f) * kac[j]);
                    if (l == 0) vf[j] = v; else v = v + (vf[j] - v) * sigmoidf_(v0[j] + cv[ni][j]);
                    o_r[j] = r; o_w[j] = decay; o_k[j] = k2; o_v[j] = v; o_a[j] = -kk; o_b[j] = kk * a;
                }
                if (l == 0) *(f32x4*)(p.vfirst + o) = vf;
                *(f32x4*)(p.sr + o) = o_r; *(f32x4*)(p.sw + o) = o_w; *(f32x4*)(p.sk + o) = o_k; *(f32x4*)(p.sv + o) = o_v; *(f32x4*)(p.sa + o) = o_a; *(f32x4*)(p.sb + o) = o_b; *(f32x4*)(p.sg + o) = cg[ni];
            }
        }
    }
}

#define MF4(a, b, c) __builtin_amdgcn_mfma_f32_16x16x4f32((a), (b), (c), 0, 0, 0)
#define WSYNC() asm volatile("s_waitcnt lgkmcnt(0)" ::: "memory")
__device__ __forceinline__ f32x4 mm16(const float* A, int sam, int sak, const float* B, int sbk, int sbn, int K, f32x4 acc, int fr, int fq) {
#pragma unroll 4
    for (int kk = 0; kk < K; kk += 4) { const float a = A[fr * sam + (kk + fq) * sak]; const float b = B[(kk + fq) * sbk + fr * sbn]; acc = MF4(a, b, acc); }
    return acc;
}
constexpr int CH_T = 16, CH_N = SEQ / CH_T, CH_LD = 68, CH_WAVE_FLOATS = 6 * 16 * CH_LD + 5 * 16 * 17 + 64;
__device__ __forceinline__ void ph_rwkv_chunkpre(const Params& pkv, KPtr kp_in, int wbase_in, int l, char* lds) {
    PH_HEAD
    const int tid = TID, lane = tid & 63, wv = tid >> 6, fr = lane & 15, fq = lane >> 4;
    if (wv >= 4) return;
    float* L = (float*)lds + wv * CH_WAVE_FLOATS;
    float* At = L; float* Bt = At + 16 * CH_LD; float* Kt = Bt + 16 * CH_LD; float* Rt = Kt + 16 * CH_LD; float* Vv = Rt + 16 * CH_LD; float* W1 = Vv + 16 * CH_LD;
    float* Pst = (float*)lds + 4 * CH_WAVE_FLOATS + wv * 1024;
    float* Aab = W1 + 16 * CH_LD; float* Aak = Aab + 16 * 17; float* Arb = Aak + 16 * 17; float* Ark = Arb + 16 * 17; float* Mm = Ark + 16 * 17; float* gT = Mm + 16 * 17;
    const f32x4 z4 = (f32x4){0.f, 0.f, 0.f, 0.f};
    for (int u = BID * 4 + wv; u < 16 * CH_N; u += gridDim.x * 4) {
        const int bh = u / CH_N, c = u % CH_N, b = bh >> 2, hd = bh & 3;
        const size_t o0 = ((size_t)b * SEQ + (size_t)c * CH_T) * 256 + hd * 64 + lane;
        WSYNC();
        {
            float g = 1.0f;
#pragma unroll
            for (int t = 0; t < CH_T; ++t) {
                const size_t o = o0 + (size_t)t * 256;
                const float w = p.sw[o], a = p.sa[o], bb = p.sb[o], k = p.sk[o], r = p.sr[o], v = p.sv[o];
                const float gp = g; g *= w; const float ig = 1.0f / g;
                At[t * CH_LD + lane] = a * gp; Bt[t * CH_LD + lane] = bb * ig; Kt[t * CH_LD + lane] = k * ig; Rt[t * CH_LD + lane] = r * g; Vv[t * CH_LD + lane] = v;
            }
            gT[lane] = g;
        }
        WSYNC();
        {
            f32x4 gab = z4, gak = z4, grb = z4, grk = z4;
#pragma unroll 4
            for (int kk = 0; kk < 64; kk += 4) {
                const int o = fr * CH_LD + kk + fq;
                const float aA = At[o], aR = Rt[o], bB = Bt[o], bK = Kt[o];
                gab = MF4(aA, bB, gab); gak = MF4(aA, bK, gak); grb = MF4(aR, bB, grb); grk = MF4(aR, bK, grk);
            }
#pragma unroll
            for (int rg = 0; rg < 4; ++rg) {
                const int t = 4 * fq + rg, s = fr;
                Aab[t * 17 + s] = (s < t) ? gab[rg] : 0.f; Aak[t * 17 + s] = (s < t) ? gak[rg] : 0.f;
                Arb[t * 17 + s] = (s <= t) ? grb[rg] : 0.f; Ark[t * 17 + s] = (s <= t) ? grk[rg] : 0.f;
            }
        }
        WSYNC();
        {
            float m[16];
#pragma unroll
            for (int t = 0; t < 16; ++t) {
                float acc = (t == fr) ? 1.0f : 0.f;
#pragma unroll
                for (int s = 0; s < t; ++s) acc += Aab[t * 17 + s] * m[s];
                m[t] = acc;
            }
            if (fq == 0) {
#pragma unroll
                for (int t = 0; t < 16; ++t) Mm[t * 17 + fr] = m[t];
            }
        }
        WSYNC();
        {
            f32x4 m2 = z4, ah[4] = {z4, z4, z4, z4};
#pragma unroll
            for (int kk = 0; kk < 16; kk += 4) {
                const float a = Mm[fr * 17 + kk + fq];
                m2 = MF4(a, Aak[(kk + fq) * 17 + fr], m2);
#pragma unroll
                for (int nt = 0; nt < 4; ++nt) ah[nt] = MF4(a, At[(kk + fq) * CH_LD + 16 * nt + fr], ah[nt]);
            }
            WSYNC();
#pragma unroll
            for (int rg = 0; rg < 4; ++rg) {
                Aak[(4 * fq + rg) * 17 + fr] = m2[rg];
#pragma unroll
                for (int nt = 0; nt < 4; ++nt) At[(4 * fq + rg) * CH_LD + 16 * nt + fr] = ah[nt][rg];
            }
            WSYNC();
            f32x4 w1[4] = {z4, z4, z4, z4};
#pragma unroll
            for (int kk = 0; kk < 16; kk += 4) {
                const float a = Aak[fr * 17 + kk + fq];
#pragma unroll
                for (int nt = 0; nt < 4; ++nt) w1[nt] = MF4(a, Vv[(kk + fq) * CH_LD + 16 * nt + fr], w1[nt]);
            }
#pragma unroll
            for (int nt = 0; nt < 4; ++nt)
#pragma unroll
                for (int rg = 0; rg < 4; ++rg) W1[(4 * fq + rg) * CH_LD + 16 * nt + fr] = w1[nt][rg];
        }
        WSYNC();
        {
            float* rh = p.c_rh + (size_t)u * 1024; float* y1 = p.c_y1 + (size_t)u * 1024;
            f32x4 ar[4], yy[4];
#pragma unroll
            for (int nt = 0; nt < 4; ++nt) {
                yy[nt] = z4;
#pragma unroll
                for (int rg = 0; rg < 4; ++rg) ar[nt][rg] = Rt[(4 * fq + rg) * CH_LD + 16 * nt + fr];
            }
#pragma unroll
            for (int kk = 0; kk < 16; kk += 4) {
                const float arb = Arb[fr * 17 + kk + fq], ark = Ark[fr * 17 + kk + fq];
#pragma unroll
                for (int nt = 0; nt < 4; ++nt) {
                    const int bo = (kk + fq) * CH_LD + 16 * nt + fr;
                    ar[nt] = MF4(arb, At[bo], ar[nt]); yy[nt] = MF4(arb, W1[bo], yy[nt]); yy[nt] = MF4(ark, Vv[bo], yy[nt]);
                }
            }
#pragma unroll
            for (int nt = 0; nt < 4; ++nt)
#pragma unroll
                for (int rg = 0; rg < 4; ++rg) { rh[(4 * fq + rg) * 64 + 16 * nt + fr] = ar[nt][rg]; y1[(4 * fq + rg) * 64 + 16 * nt + fr] = yy[nt][rg]; }
        }
        {
            float* pp = p.c_p + (size_t)u * 4096; float* qq = p.c_q + (size_t)u * 4096;
#pragma unroll 1
            for (int jt = 0; jt < 4; ++jt) {
                f32x4 ap[4] = {z4, z4, z4, z4}, aq[4] = {z4, z4, z4, z4};
#pragma unroll
                for (int kk = 0; kk < 16; kk += 4) {
                    const int ao = (kk + fq) * CH_LD + 16 * jt + fr;
                    const float a_ah = At[ao], a_w1 = W1[ao], a_v = Vv[ao];
#pragma unroll
                    for (int jc = 0; jc < 4; ++jc) {
                        const int bo = (kk + fq) * CH_LD + 16 * jc + fr;
                        const float b_bt = Bt[bo], b_kt = Kt[bo];
                        ap[jc] = MF4(a_ah, b_bt, ap[jc]); aq[jc] = MF4(a_w1, b_bt, aq[jc]); aq[jc] = MF4(a_v, b_kt, aq[jc]);
                    }
                }
                WSYNC();
#pragma unroll
                for (int jc = 0; jc < 4; ++jc) {
                    const float gc = gT[16 * jc + fr];
#pragma unroll
                    for (int rg = 0; rg < 4; ++rg) {
                        const int row = 16 * jt + 4 * fq + rg, col = 16 * jc + fr;
                        Pst[(jc * 64 + 16 * rg + fr) * 4 + fq] = (ap[jc][rg] + ((row == col) ? 1.0f : 0.f)) * gc; qq[row * 64 + col] = aq[jc][rg] * gc;
                    }
                }
                WSYNC();
#pragma unroll
                for (int i = 0; i < 4; ++i) *(f32x4*)(pp + ((jt * 4 + i) * 64 + lane) * 4) = *(const f32x4*)(Pst + (i * 64 + lane) * 4);
            }
        }
    }
}

constexpr int SCANB_BLOCKS = 64;
__device__ __forceinline__ void ph_rwkv_scan(const Params& pkv, KPtr kp_in, int wbase_in, int l, char* lds) {
    PH_HEAD
    if (BID >= SCANB_BLOCKS) return;
    const int tid = TID, lane = tid & 63, wv = tid >> 6, fr = lane & 15, fq = lane >> 4, w = wv & 3;
    const int sid = BID, bh = sid >> 2, ib = sid & 3, b = bh >> 2, hd = bh & 3, ibase = ib * 16;
    float* exch = (float*)lds;
    float* ypart = (float*)lds + 4096;
    for (int i = tid; i < 8192; i += NTHREADS) ((float*)lds)[i] = 0.f;
    if (wv >= 4) {
        __syncthreads();
        for (int c = 0; c < CH_N; ++c) { __builtin_amdgcn_s_barrier(); }
        return;
    }
    f32x4 cur = (f32x4){0.f, 0.f, 0.f, 0.f};
    const size_t ubase = (size_t)bh * CH_N;
    f32x4 pa[4][4]; f32x4 qv[4], rh[4]; float y1v[4];
#define SCAN_LOAD(S, cc) do { const size_t un_ = ubase + ((cc) < CH_N ? (cc) : CH_N - 1); \
        const f32x4* pp_ = (const f32x4*)(p.c_p + un_ * 4096 + (w * 64 + lane) * 4); \
        pa[S][0] = pp_[0]; pa[S][1] = pp_[256]; pa[S][2] = pp_[512]; pa[S][3] = pp_[768]; \
        qv[S] = *(const f32x4*)(p.c_q + un_ * 4096 + (ibase + fr) * 64 + 16 * w + 4 * fq); \
        rh[S] = *(const f32x4*)(p.c_rh + un_ * 1024 + fr * 64 + 16 * w + 4 * fq); \
        y1v[S] = p.c_y1[un_ * 1024 + (4 * w + fq) * 64 + ibase + fr]; } while (0)
#define SCAN_STEP(S, cc) do { const int bufo = ((cc) & 1) * 2048; \
        float exv[16]; { const float* ex = exch + bufo; _Pragma("unroll") for (int kk = 0; kk < 16; ++kk) exv[kk] = ex[64 * kk + lane]; } \
        __builtin_amdgcn_sched_barrier(0); \
        f32x4 yp = (f32x4){0.f, 0.f, 0.f, 0.f}; \
        _Pragma("unroll") for (int rg = 0; rg < 4; ++rg) yp = MF4(rh[S][rg], cur[rg], yp); \
        asm volatile("s_waitcnt lgkmcnt(0)" ::: "memory"); __builtin_amdgcn_sched_barrier(0); \
        f32x4 acc0 = qv[S], acc1 = (f32x4){0.f, 0.f, 0.f, 0.f}; \
        _Pragma("unroll") for (int kq = 0; kq < 4; ++kq) { \
            acc0 = MF4(pa[S][kq][0], exv[4 * kq], acc0); acc1 = MF4(pa[S][kq][1], exv[4 * kq + 1], acc1); \
            acc0 = MF4(pa[S][kq][2], exv[4 * kq + 2], acc0); acc1 = MF4(pa[S][kq][3], exv[4 * kq + 3], acc1); } \
        cur = acc0 + acc1; \
        { float* yd = ypart + bufo + w * 256; _Pragma("unroll") for (int rg = 0; rg < 4; ++rg) yd[(4 * fq + rg) * 16 + fr] = yp[rg]; } \
        { float* ed = exch + (2048 - bufo) + (16 * w) * 16; _Pragma("unroll") for (int rg = 0; rg < 4; ++rg) ed[(4 * fq + rg) * 16 + fr] = cur[rg]; } \
        asm volatile("s_waitcnt lgkmcnt(0)" ::: "memory"); __builtin_amdgcn_s_barrier(); asm volatile("" ::: "memory"); \
        { const float* ys = ypart + bufo + (4 * w + fq) * 16 + fr; const float y = (ys[0] + ys[256]) + (ys[512] + ys[768]) + y1v[S]; \
          p.sy[((size_t)b * SEQ + (size_t)(cc) * CH_T + 4 * w + fq) * 256 + hd * 64 + ibase + fr] = y; } \
        SCAN_LOAD(S, (cc) + 4); } while (0)
    SCAN_LOAD(0, 0); SCAN_LOAD(1, 1); SCAN_LOAD(2, 2); SCAN_LOAD(3, 3);
    __syncthreads();
    for (int c = 0; c < CH_N; c += 4) { SCAN_STEP(0, c); SCAN_STEP(1, c + 1); SCAN_STEP(2, c + 2); SCAN_STEP(3, c + 3); }
}

__device__ __forceinline__ void ph_mla_up(const Params& pkv, KPtr kp_in, int wbase_in, int l, char* lds) {
    PH_HEAD
    const int nq = (NT / 128) * 3, nkv = (NT / 128) * 4;
    const float SC = 0.10206207261596575f * 1.4426950408889634f;
    float* rsl = (float*)(lds + 40960);
    const int tid = TID;
    for (int u = BID; u < nq + nkv; u += gridDim.x) {
        const bool isq = u < nq;
        const int mt = isq ? u / 3 : (u - nq) / 4, t0 = mt * 128;
        {
            const int row = tid >> 2, part = tid & 3, ncol = isq ? 256 : 128, per = ncol / 4;
            const bf16_t* src = p.pbuf + (size_t)(t0 + row) * NINP + (isq ? PC_MQ : PC_MKV) + part * per;
            float ss = 0.f;
            for (int i = 0; i < per; i += 8) {
                const u32x4 w = *(const u32x4*)(src + i);
#pragma unroll
                for (int k = 0; k < 4; ++k) { const float a = __uint_as_float(w[k] << 16), b = __uint_as_float(w[k] & 0xffff0000u); ss += a * a + b * b; }
            }
            ss += dpp_f<0xB1>(ss); ss += dpp_f<0x4E>(ss);
            __syncthreads();
            if (part == 0) rsl[row] = rsqrtf(ss / (float)ncol + 1e-6f);
            if (!isq && (u - nq) % 4 == 0) {
                for (int e = tid; e < 128 * 16; e += NTHREADS) {
                    const int rr = e >> 4, i = e & 15, t = t0 + rr, pos = t % SEQ;
                    const bf16_t* pr = p.pbuf + (size_t)t * NINP + PC_MKR;
                    const float c = p.tab_mla[(pos * 16 + i) * 2], sn = p.tab_mla[(pos * 16 + i) * 2 + 1], x1 = bf2f(pr[i]), x2 = bf2f(pr[16 + i]);
                    const bf16_t k1 = f2bf(x1 * c - x2 * sn), k2 = f2bf(x1 * sn + x2 * c);
#pragma unroll
                    for (int hd = 0; hd < 4; ++hd) { p.mk[((size_t)t * 4 + hd) * 96 + 64 + i] = k1; p.mk[((size_t)t * 4 + hd) * 96 + 80 + i] = k2; }
                }
            }
            __syncthreads();
        }
        if (isq) {
            const int nt = u % 3;
            bf16_t* mq = p.mq + (size_t)mt * 128 * 384 + nt * 128; const float* tab = p.tab_mla;
            gemm_tile128(p.pbuf + (size_t)mt * 128 * NINP + PC_MQ, NINP, nullptr, 128, p.wq_t + ((size_t)l * 384 + nt * 128) * 256, 256, 256, lds, TID,
                         [=](int r, int c, f32x4 v0, f32x4 v1) mutable {
                             const float sc = rsl[r] * SC; v0 = v0 * sc; v1 = v1 * sc;
                             const int col = nt * 128 + c;
                             if ((col % 96) >= 64) {
                                 const int i0 = (col % 96) - 64, pos = (t0 + r) % SEQ;
                                 const f32x4 cs0 = *(const f32x4*)(tab + (pos * 16 + i0) * 2), cs1 = *(const f32x4*)(tab + (pos * 16 + i0) * 2 + 4);
                                 const f32x4 a = v0, b = v1;
                                 v0[0] = a[0] * cs0[0] - b[0] * cs0[1]; v1[0] = a[0] * cs0[1] + b[0] * cs0[0];
                                 v0[1] = a[1] * cs0[2] - b[1] * cs0[3]; v1[1] = a[1] * cs0[3] + b[1] * cs0[2];
                                 v0[2] = a[2] * cs1[0] - b[2] * cs1[1]; v1[2] = a[2] * cs1[1] + b[2] * cs1[0];
                                 v0[3] = a[3] * cs1[2] - b[3] * cs1[3]; v1[3] = a[3] * cs1[3] + b[3] * cs1[2];
                             }
                             uint2 o0, o1; o0.x = cvtpk(v0[0], v0[1]); o0.y = cvtpk(v0[2], v0[3]); o1.x = cvtpk(v1[0], v1[1]); o1.y = cvtpk(v1[2], v1[3]);
                             *(uint2*)(mq + (size_t)r * 384 + c) = o0; *(uint2*)(mq + (size_t)r * 384 + c + 16) = o1; });
        } else {
            const int hd = (u - nq) % 4;
            bf16_t* mk = p.mk + ((size_t)mt * 128 * 4 + hd) * 96; bf16_t* mv = p.mv + ((size_t)mt * 128 * 4 + hd) * 64;
            gemm_tile128(p.pbuf + (size_t)mt * 128 * NINP + PC_MKV, NINP, nullptr, 128, p.wkv_t + ((size_t)l * 512 + hd * 128) * 128, 128, 128, lds, TID,
                         [=](int r, int c, f32x4 v0, f32x4 v1) mutable {
                             const float sc = rsl[r]; v0 = v0 * sc; v1 = v1 * sc;
                             uint2 o0, o1; o0.x = cvtpk(v0[0], v0[1]); o0.y = cvtpk(v0[2], v0[3]); o1.x = cvtpk(v1[0], v1[1]); o1.y = cvtpk(v1[2], v1[3]);
                             if (c < 64) { *(uint2*)(mk + (size_t)r * 384 + c) = o0; *(uint2*)(mk + (size_t)r * 384 + c + 16) = o1; }
                             else { *(uint2*)(mv + (size_t)r * 256 + (c - 64)) = o0; *(uint2*)(mv + (size_t)r * 256 + (c - 64) + 16) = o1; } });
        }
    }
}

__device__ __forceinline__ void ph_mla_pack(const Params& pkv, KPtr kp_in, int wbase_in, int l) {
    PH_HEAD
    const int lane = TID & 63, gw = BID * (NTHREADS / 64) + (TID >> 6), nw = gridDim.x * (NTHREADS / 64);
    const float SC = 0.10206207261596575f * 1.4426950408889634f;
#pragma unroll 2
    for (int t = gw; t < NT; t += nw) {
        const int pos = t % SEQ;
        const float* qp = p.qu + (size_t)t * 384; const float* kvp = p.kvu + (size_t)t * 512; const float* kp2 = p.kpe + (size_t)t * 32;
        bf16_t* mq = p.mq + (size_t)t * 384; bf16_t* mk = p.mk + (size_t)t * 384; bf16_t* mv = p.mv + (size_t)t * 256;
        for (int e = lane; e < 384; e += 64) {
            const int hd = e / 96, d = e % 96;
            float qv, kv;
            if (d < 64) { qv = qp[e]; kv = kvp[hd * 128 + d]; }
            else {
                const int i = (d - 64) & 15; const float c = p.tab_mla[(pos * 16 + i) * 2], sn = p.tab_mla[(pos * 16 + i) * 2 + 1];
                const float x1 = qp[hd * 96 + 64 + i], x2 = qp[hd * 96 + 80 + i];
                qv = (d < 80) ? (x1 * c - x2 * sn) : (x1 * sn + x2 * c);
                kv = kp2[d - 64];
            }
            mq[e] = f2bf(qv * SC); mk[e] = f2bf(kv);
        }
        for (int e = lane; e < 256; e += 64) mv[e] = f2bf(kvp[(e >> 6) * 128 + 64 + (e & 63)]);
    }
}

__device__ __forceinline__ void ph_mla_attn(const Params& pkv, KPtr kp_in, int wbase_in, int l, char* lds) {
    PH_HEAD
    constexpr int KSTR = 104, VSTR = 68;
    bf16_t* Ks = (bf16_t*)lds;
    bf16_t* Vt = Ks + 64 * KSTR;
    const int tid = TID, lane = tid & 63, wv = tid >> 6, r = lane & 31, h = lane >> 5;
    int* wq = p.wq + l * 16;
    volatile int* wslot = (volatile int*)(lds + 24576);
    for (;;) {
        __syncthreads();
        if (tid == 0) *wslot = atomicAdd(wq, 1);
        __syncthreads();
        const int it = __builtin_amdgcn_readfirstlane(*wslot);
        if (it >= 16 * 32) break;
        const int bh = it & 15, qb = 31 - (it >> 4);
        const int b = bh >> 2, hd = bh & 3, q0 = qb * 256;
        const int qmin = q0 + 32 * wv, qmax = qmin + 31, myq = qmin + r;
        bf16x8 qf[6];
        {
            const bf16_t* qrow = p.mq + ((size_t)(b * SEQ + myq) * 4 + hd) * 96 + 8 * h;
#pragma unroll
            for (int s = 0; s < 6; ++s) qf[s] = *(const bf16x8*)(qrow + 16 * s);
        }
        f32x16 o0, o1;
#pragma unroll
        for (int i = 0; i < 16; ++i) { o0[i] = 0.f; o1[i] = 0.f; }
        float m = -1e30f, lsum = 0.f;
        const int nkt = (q0 + 256) / 64;
        const int kk0 = tid / 12, kc0 = tid % 12, kk1 = (tid + 512) / 12, kc1 = (tid + 512) % 12;
        const int vk = tid & 63, vc = tid >> 6;
        const bf16_t* kbase = p.mk + ((size_t)b * SEQ * 4 + hd) * 96;
        const bf16_t* vbase = p.mv + ((size_t)b * SEQ * 4 + hd) * 64;
        u32x4 rk0, rk1, rv;
        rk0 = *(const u32x4*)(kbase + (size_t)kk0 * 384 + kc0 * 8);
        rk1 = (tid < 256) ? *(const u32x4*)(kbase + (size_t)kk1 * 384 + kc1 * 8) : (u32x4){0u, 0u, 0u, 0u};
        rv = *(const u32x4*)(vbase + (size_t)vk * 256 + vc * 8);
        for (int kt = 0; kt < nkt; ++kt) {
            __syncthreads();
            *(u32x4*)(Ks + kk0 * KSTR + kc0 * 8) = rk0;
            if (tid < 256) *(u32x4*)(Ks + kk1 * KSTR + kc1 * 8) = rk1;
            {
                const unsigned w0 = rv[0], w1 = rv[1], w2 = rv[2], w3 = rv[3];
                bf16_t* vd = Vt + (vc * 8) * VSTR + vk;
                vd[0] = (bf16_t)(w0 & 0xffff); vd[VSTR] = (bf16_t)(w0 >> 16); vd[2 * VSTR] = (bf16_t)(w1 & 0xffff); vd[3 * VSTR] = (bf16_t)(w1 >> 16);
                vd[4 * VSTR] = (bf16_t)(w2 & 0xffff); vd[5 * VSTR] = (bf16_t)(w2 >> 16); vd[6 * VSTR] = (bf16_t)(w3 & 0xffff); vd[7 * VSTR] = (bf16_t)(w3 >> 16);
            }
            __syncthreads();
            if (kt + 1 < nkt) {
                const size_t ko = (size_t)(kt + 1) * 64;
                rk0 = *(const u32x4*)(kbase + (ko + kk0) * 384 + kc0 * 8);
                if (tid < 256) rk1 = *(const u32x4*)(kbase + (ko + kk1) * 384 + kc1 * 8);
                rv = *(const u32x4*)(vbase + (ko + vk) * 256 + vc * 8);
            }
            const int kb = kt * 64;
            if (kb <= qmax) {
                const bool need1 = (kb + 32 <= qmax);
                f32x16 s0, s1;
#pragma unroll
                for (int i = 0; i < 16; ++i) { s0[i] = 0.f; s1[i] = -1e30f; }
#pragma unroll
                for (int s = 0; s < 6; ++s) { const bf16x8 kf = *(const bf16x8*)(Ks + r * KSTR + 16 * s + 8 * h); s0 = __builtin_amdgcn_mfma_f32_32x32x16_bf16(kf, qf[s], s0, 0, 0, 0); }
                if (need1) {
#pragma unroll
                    for (int i = 0; i < 16; ++i) s1[i] = 0.f;
#pragma unroll
                    for (int s = 0; s < 6; ++s) { const bf16x8 kf = *(const bf16x8*)(Ks + (32 + r) * KSTR + 16 * s + 8 * h); s1 = __builtin_amdgcn_mfma_f32_32x32x16_bf16(kf, qf[s], s1, 0, 0, 0); }
                }
                if (kb + 63 > qmin) {
#pragma unroll
                    for (int i = 0; i < 16; ++i) {
                        const int key = kb + (i & 3) + 8 * (i >> 2) + 4 * h;
                        if (key > myq) s0[i] = -1e30f;
                        if (key + 32 > myq) s1[i] = -1e30f;
                    }
                }
                float mx = s0[0];
#pragma unroll
                for (int i = 1; i < 16; ++i) mx = fmaxf(mx, s0[i]);
#pragma unroll
                for (int i = 0; i < 16; ++i) mx = fmaxf(mx, s1[i]);
                mx = xhalf_max(mx);
                const float mn = fmaxf(m, mx), alpha = __builtin_amdgcn_exp2f(m - mn);
                m = mn;
                float ps = 0.f;
#pragma unroll
                for (int i = 0; i < 16; ++i) { s0[i] = __builtin_amdgcn_exp2f(s0[i] - mn); ps += s0[i]; }
                if (need1) {
#pragma unroll
                    for (int i = 0; i < 16; ++i) { s1[i] = __builtin_amdgcn_exp2f(s1[i] - mn); ps += s1[i]; }
                }
                lsum = lsum * alpha + ps;
                if (!__all(alpha == 1.0f)) {
#pragma unroll
                    for (int i = 0; i < 16; ++i) { o0[i] *= alpha; o1[i] *= alpha; }
                }
#pragma unroll
                for (int s = 0; s < 2; ++s) {
                    u32x4 pw; pw[0] = cvtpk(s0[8 * s], s0[8 * s + 1]); pw[1] = cvtpk(s0[8 * s + 2], s0[8 * s + 3]); pw[2] = cvtpk(s0[8 * s + 4], s0[8 * s + 5]); pw[3] = cvtpk(s0[8 * s + 6], s0[8 * s + 7]);
                    const bf16x8 pf = __builtin_bit_cast(bf16x8, pw);
                    const bf16_t* va = Vt + r * VSTR + 16 * s + 4 * h;
                    const s16x4 a0 = *(const s16x4*)(va), a1 = *(const s16x4*)(va + 8), b0 = *(const s16x4*)(va + 32 * VSTR), b1 = *(const s16x4*)(va + 32 * VSTR + 8);
                    o0 = __builtin_amdgcn_mfma_f32_32x32x16_bf16(__builtin_shufflevector(a0, a1, 0, 1, 2, 3, 4, 5, 6, 7), pf, o0, 0, 0, 0);
                    o1 = __builtin_amdgcn_mfma_f32_32x32x16_bf16(__builtin_shufflevector(b0, b1, 0, 1, 2, 3, 4, 5, 6, 7), pf, o1, 0, 0, 0);
                }
                if (need1) {
#pragma unroll
                    for (int s = 0; s < 2; ++s) {
                        u32x4 pw; pw[0] = cvtpk(s1[8 * s], s1[8 * s + 1]); pw[1] = cvtpk(s1[8 * s + 2], s1[8 * s + 3]); pw[2] = cvtpk(s1[8 * s + 4], s1[8 * s + 5]); pw[3] = cvtpk(s1[8 * s + 6], s1[8 * s + 7]);
                        const bf16x8 pf = __builtin_bit_cast(bf16x8, pw);
                        const bf16_t* va = Vt + r * VSTR + 32 + 16 * s + 4 * h;
                        const s16x4 a0 = *(const s16x4*)(va), a1 = *(const s16x4*)(va + 8), b0 = *(const s16x4*)(va + 32 * VSTR), b1 = *(const s16x4*)(va + 32 * VSTR + 8);
                        o0 = __builtin_amdgcn_mfma_f32_32x32x16_bf16(__builtin_shufflevector(a0, a1, 0, 1, 2, 3, 4, 5, 6, 7), pf, o0, 0, 0, 0);
                        o1 = __builtin_amdgcn_mfma_f32_32x32x16_bf16(__builtin_shufflevector(b0, b1, 0, 1, 2, 3, 4, 5, 6, 7), pf, o1, 0, 0, 0);
                    }
                }
            }
        }
        const float inv = 1.0f / xhalf_sum(lsum);
        float* op = p.mo + (size_t)(b * SEQ + myq) * 256 + hd * 64 + 4 * h;
#pragma unroll
        for (int g = 0; g < 4; ++g) {
            *(f32x4*)(op + 8 * g) = (f32x4){o0[4 * g] * inv, o0[4 * g + 1] * inv, o0[4 * g + 2] * inv, o0[4 * g + 3] * inv};
            *(f32x4*)(op + 32 + 8 * g) = (f32x4){o1[4 * g] * inv, o1[4 * g + 1] * inv, o1[4 * g + 2] * inv, o1[4 * g + 3] * inv};
        }
        __syncthreads();
    }
}

__device__ __forceinline__ void ph_finalize_mix(const Params& pkv, KPtr kp_in, int wbase_in, int l) {
    PH_HEAD
    const int lane = TID & 63, gw = BID * (NTHREADS / 64) + (TID >> 6), nw = gridDim.x * (NTHREADS / 64);
    const int c = lane * 4, h = lane >> 4;
#pragma unroll 2
    for (int t = gw; t < NT; t += nw) {
        bf16_t* outp = p.mixcat + (size_t)t * 1024;
        {
            const float l0 = p.dlse[((size_t)0 * NT + t) * 4 + h], l1 = p.dlse[((size_t)1 * NT + t) * 4 + h], l2 = p.dlse[((size_t)2 * NT + t) * 4 + h];
            const float lm = fmaxf(l0, fmaxf(l1, l2));
            float w0 = __builtin_amdgcn_exp2f(l0 - lm), w1 = __builtin_amdgcn_exp2f(l1 - lm), w2 = __builtin_amdgcn_exp2f(l2 - lm);
            const float wi = 1.0f / (w0 + w1 + w2); w0 *= wi; w1 *= wi; w2 *= wi;
            const float4 v0 = *(const float4*)(p.dob + ((size_t)0 * NT + t) * 256 + c), v1 = *(const float4*)(p.dob + ((size_t)1 * NT + t) * 256 + c), v2 = *(const float4*)(p.dob + ((size_t)2 * NT + t) * 256 + c);
            float4 v; v.x = w0 * v0.x + w1 * v1.x + w2 * v2.x; v.y = w0 * v0.y + w1 * v1.y + w2 * v2.y; v.z = w0 * v0.z + w1 * v1.z + w2 * v2.z; v.w = w0 * v0.w + w1 * v1.w + w2 * v2.w;
            const float ss = wave_sum(v.x * v.x + v.y * v.y + v.z * v.z + v.w * v.w);
            const float rs = rsqrtf(ss * (1.0f / 256.0f) + 1e-6f);
            const float4 g = *(const float4*)(p.dil_norm_g + l * 256 + c);
            ushort4 o; o.x = f2bf(v.x * rs * g.x); o.y = f2bf(v.y * rs * g.y); o.z = f2bf(v.z * rs * g.z); o.w = f2bf(v.w * rs * g.w);
            *(ushort4*)(outp + 256 + c) = o;
        }
        {
            const size_t o4 = (size_t)t * 256 + c;
            const float4 y = *(const float4*)(p.sy + o4), r = *(const float4*)(p.sr + o4), k = *(const float4*)(p.sk + o4), v = *(const float4*)(p.sv + o4), g = *(const float4*)(p.sg + o4);
            const float mean = grp16_sum(y.x + y.y + y.z + y.w) * (1.0f / 64.0f);
            const float dx = y.x - mean, dy = y.y - mean, dz = y.z - mean, dw = y.w - mean;
            const float var = grp16_sum(dx * dx + dy * dy + dz * dz + dw * dw) * (1.0f / 64.0f);
            const float rs = rsqrtf(var + 64e-5f);
            const float4 lg = *(const float4*)(p.rwkv_ln_g + l * 256 + c), lb = *(const float4*)(p.rwkv_ln_b + l * 256 + c), rk = *(const float4*)(p.rwkv_r_k + l * 256 + c);
            const float bonus = grp16_sum(r.x * k.x * rk.x + r.y * k.y * rk.y + r.z * k.z * rk.z + r.w * k.w * rk.w);
            ushort4 o;
            o.x = f2bf((dx * rs * lg.x + lb.x + bonus * v.x) * g.x); o.y = f2bf((dy * rs * lg.y + lb.y + bonus * v.y) * g.y);
            o.z = f2bf((dz * rs * lg.z + lb.z + bonus * v.z) * g.z); o.w = f2bf((dw * rs * lg.w + lb.w + bonus * v.w) * g.w);
            *(ushort4*)(outp + 512 + c) = o;
        }
        {
            const float4 v = *(const float4*)(p.mo + (size_t)t * 256 + c);
            const float ss = wave_sum(v.x * v.x + v.y * v.y + v.z * v.z + v.w * v.w);
            const float rs = rsqrtf(ss * (1.0f / 256.0f) + 1e-6f);
            const float4 g = *(const float4*)(p.mla_out_norm_g + l * 256 + c);
            ushort4 o; o.x = f2bf(v.x * rs * g.x); o.y = f2bf(v.y * rs * g.y); o.z = f2bf(v.z * rs * g.z); o.w = f2bf(v.w * rs * g.w);
            *(ushort4*)(outp + 768 + c) = o;
        }
    }
    (void)h;
}

__device__ __forceinline__ void ph_outproj(const Params& pkv, KPtr kp_in, int wbase_in, int l, char* lds) {
    PH_HEAD
    const float* xin = (l == 0) ? p.x : p.xf; float* y1 = p.y1;
    const bf16_t* Bt = p.wout_t + (size_t)l * 1024 * 1024;
    const int nunits = (NT / 256) * 4;
    bool pre = false;
    XU_LOOP(NT / 256, 4) {
        const int u = XU_UNIT();
        const int mt = u >> 2, nt = u & 3, un = XU_NEXT_UNIT();
        G8Next nx; nx.valid = (XU_NEXT_OK) ? 1 : 0; nx.rowidx = nullptr; nx.nvalid = 256; nx.A = p.mixcat + (size_t)(un >> 2) * 256 * 1024; nx.Bt = Bt + (size_t)(un & 3) * 256 * 1024;
        const size_t o0 = (size_t)mt * 256 * 1024 + nt * 256;
        gemm_tile256(p.mixcat + (size_t)mt * 256 * 1024, 1024, nullptr, 256, Bt + (size_t)nt * 256 * 1024, 1024, 1024, lds, wbase_in, pre, nx,
                     [=](int r, int c, f32x4 v0, f32x4 v1) mutable { const size_t o = o0 + (size_t)r * 1024 + c; const f32x4 xa = *(const f32x4*)(xin + o), xb2 = *(const f32x4*)(xin + o + 16); *(f32x4*)(y1 + o) = xa * ALPHA + v0; *(f32x4*)(y1 + o + 16) = xb2 * ALPHA + v1; });
        pre = nx.valid != 0;
    }
}

__device__ __forceinline__ void ph_ln1_router(const Params& pkv, KPtr kp_in, int wbase_in, int l, char* lds) {
    PH_HEAD
    float* Wt = (float*)lds;
    int* hist = (int*)(lds + 131584);
    int* base = hist + 32;
    int* le = base + 32;
    float* lgt = (float*)(le + 512);
    int* lrank = (int*)(lgt + 512);
    const int tid = TID, lane = tid & 63, wv = tid >> 6;
    const float* g1 = p.ln1_g + l * 1024; const float* b1 = p.ln1_b + l * 1024;
    const float* rw = p.router_w + (size_t)l * 1024 * 32; const float* rb = p.router_b + l * 32;
    __syncthreads();
    for (int i = tid; i < 1024 * 32; i += NTHREADS) Wt[(i & 31) * 1028 + (i >> 5)] = rw[i];
    float4 gg[4], bb[4];
#pragma unroll
    for (int m = 0; m < 4; ++m) { gg[m] = *(const float4*)(g1 + m * 256 + lane * 4); bb[m] = *(const float4*)(b1 + m * 256 + lane * 4); }
    for (int tb = BID * 128; tb < NT; tb += gridDim.x * 128) {
        __syncthreads();
        if (tid < 32) hist[tid] = 0;
        __syncthreads();
        float4 yn[4];
#pragma unroll
        for (int m = 0; m < 4; ++m) yn[m] = *(const float4*)(p.y1 + (size_t)(tb + wv) * 1024 + m * 256 + lane * 4);
        for (int tt = wv; tt < 128; tt += 8) {
            const int t = tb + tt;
            float4 y[4]; float s = 0.f;
#pragma unroll
            for (int m = 0; m < 4; ++m) { y[m] = yn[m]; s += (y[m].x + y[m].y) + (y[m].z + y[m].w); }
            {
                const int t2 = tb + ((tt + 8 < 128) ? tt + 8 : tt);
#pragma unroll
                for (int m = 0; m < 4; ++m) yn[m] = *(const float4*)(p.y1 + (size_t)t2 * 1024 + m * 256 + lane * 4);
            }
            const float mean = wave_sum(s) * (1.0f / 1024.0f);
            float q = 0.f;
#pragma unroll
            for (int m = 0; m < 4; ++m) { y[m].x -= mean; y[m].y -= mean; y[m].z -= mean; y[m].w -= mean; q += (y[m].x * y[m].x + y[m].y * y[m].y) + (y[m].z * y[m].z + y[m].w * y[m].w); }
            const float rs = rsqrtf(wave_sum(q) * (1.0f / 1024.0f) + 1e-5f);
#pragma unroll
            for (int m = 0; m < 4; ++m) {
                const int c = m * 256 + lane * 4;
                y[m].x = y[m].x * rs * gg[m].x + bb[m].x; y[m].y = y[m].y * rs * gg[m].y + bb[m].y; y[m].z = y[m].z * rs * gg[m].z + bb[m].z; y[m].w = y[m].w * rs * gg[m].w + bb[m].w;
                *(float4*)(p.y1 + (size_t)t * 1024 + c) = y[m];
                uint2 ob; ob.x = cvtpk(y[m].x, y[m].y); ob.y = cvtpk(y[m].z, y[m].w);
                *(uint2*)(p.x1b + (size_t)t * 1024 + c) = ob;
            }
            float lg[32];
#pragma unroll
            for (int e = 0; e < 32; ++e) {
                float a = 0.f;
#pragma unroll
                for (int m = 0; m < 4; ++m) { const f32x4 w = *(const f32x4*)(Wt + e * 1028 + m * 256 + lane * 4); a += (y[m].x * w[0] + y[m].y * w[1]) + (y[m].z * w[2] + y[m].w * w[3]); }
                lg[e] = a;
            }
#pragma unroll
            for (int e = 0; e < 32; ++e) lg[e] = wave_sum(lg[e]) + rb[e];
            int idx[4]; float val[4];
#pragma unroll
            for (int k = 0; k < 4; ++k) {
                float bv = -3.0e38f; int bi = 0;
#pragma unroll
                for (int e = 0; e < 32; ++e) { if (lg[e] > bv) { bv = lg[e]; bi = e; } }
                idx[k] = bi; val[k] = bv;
#pragma unroll
                for (int e = 0; e < 32; ++e) if (e == bi) lg[e] = -3.0e38f;
            }
            const float e1 = __expf(val[1] - val[0]), e2 = __expf(val[2] - val[0]), e3 = __expf(val[3] - val[0]);
            const float inv = 1.0f / (1.0f + e1 + e2 + e3);
            const float gt[4] = {inv, e1 * inv, e2 * inv, e3 * inv};
            if (lane < 4) {
                int ee = idx[0]; float gv = gt[0];
                if (lane == 1) { ee = idx[1]; gv = gt[1]; } else if (lane == 2) { ee = idx[2]; gv = gt[2]; } else if (lane == 3) { ee = idx[3]; gv = gt[3]; }
                le[tt * 4 + lane] = ee; lgt[tt * 4 + lane] = gv;
                lrank[tt * 4 + lane] = atomicAdd(&hist[ee], 1);
            }
        }
        __syncthreads();
        if (tid < 32) base[tid] = atomicAdd(&p.cnt[l * NE + tid], hist[tid]);
        __syncthreads();
        {
            const int tt = tid >> 2, t = tb + tt, e = le[tid], pos = base[e] + lrank[tid];
            p.toke[(size_t)t * 4 + (tid & 3)] = e; p.tokpos[(size_t)t * 4 + (tid & 3)] = pos;
            p.rowtok[(size_t)e * NT + pos] = t; p.rowgate[(size_t)e * NT + pos] = lgt[tid];
        }
    }
}

__device__ __forceinline__ void moe_tile_prefix(KRef p, int l, int* tb  , const int TID) {
    __syncthreads();
    if (TID == 0) { int a = 0; for (int e = 0; e < NE; ++e) { tb[e] = a; a += (p.cnt[l * NE + e] + MOE_TM - 1) / MOE_TM; } tb[NE] = a; }
    __syncthreads();
}
struct MoeUnit { int e, mt, mtg, nt, nvalid; };
__device__ __forceinline__ MoeUnit moe_decode(const int* tb, const int* cnt, int u, int ntshift) {
    MoeUnit m; m.mtg = u >> ntshift; m.nt = u & ((1 << ntshift) - 1);
    int e = 0; while (tb[e + 1] <= m.mtg) ++e;
    m.e = __builtin_amdgcn_readfirstlane(e);
    m.mt = __builtin_amdgcn_readfirstlane(m.mtg - tb[m.e]);
    const int c = __builtin_amdgcn_readfirstlane(cnt[m.e]);
    m.nvalid = min(MOE_TM, c - m.mt * MOE_TM);
    return m;
}
__device__ __forceinline__ void ph_moe_gu(const Params& pkv, KPtr kp_in, int wbase_in, int l, char* lds) {
    PH_HEAD
    int* tb = (int*)(lds + 132096);
    moe_tile_prefix(p, l, tb, TID);
    const int ntile = __builtin_amdgcn_readfirstlane(tb[NE]), nunits = ntile * 8;
    const int* cnt = p.cnt + l * NE;
    bool pre = false;
    XU_LOOP(ntile, 8) {
        const int u = XU_UNIT();
        const MoeUnit m = moe_decode(tb, cnt, u, 3);
        const int un = XU_NEXT_UNIT();
        G8Next nx; nx.valid = (XU_NEXT_OK) ? 1 : 0; nx.A = p.x1b; nx.rowidx = nullptr; nx.Bt = nullptr; nx.nvalid = 0;
        if (nx.valid) { const MoeUnit m2 = moe_decode(tb, cnt, un, 3); nx.rowidx = p.rowtok + (size_t)m2.e * NT + m2.mt * MOE_TM; nx.nvalid = m2.nvalid; nx.Bt = p.wgu_t + (((size_t)l * NE + m2.e) * 2048 + m2.nt * 256) * 1024; }
        const float* bias = p.b_gu + ((size_t)l * NE + m.e) * 2048 + m.nt * 256;
        bf16_t* out = p.act + (size_t)m.mtg * MOE_TM * 1024 + m.nt * 128;
        gemm_tile256(p.x1b, 1024, p.rowtok + (size_t)m.e * NT + m.mt * MOE_TM, m.nvalid, p.wgu_t + (((size_t)l * NE + m.e) * 2048 + m.nt * 256) * 1024, 1024, 1024, lds, wbase_in, pre, nx,
                     [=](int r, int c, f32x4 va, f32x4 vb) mutable {
#pragma unroll
                         for (int hh = 0; hh < 2; ++hh) {
                             f32x4 v = hh ? vb : va; const int cc = c + 16 * hh;
                             const f32x4 bv = *(const f32x4*)(bias + cc); v = v + bv;
                             const float g0 = fminf(v[0], 7.0f), l0 = fminf(fmaxf(v[1], -7.0f), 7.0f), g1 = fminf(v[2], 7.0f), l1 = fminf(fmaxf(v[3], -7.0f), 7.0f);
                             const float a0 = g0 * sigmoidf_(1.702f * g0) * (l0 + 1.0f), a1 = g1 * sigmoidf_(1.702f * g1) * (l1 + 1.0f);
                             *(unsigned*)(out + (size_t)r * 1024 + (cc >> 1)) = cvtpk(a0, a1);
                         } });
        pre = nx.valid != 0;
    }
}
__device__ __forceinline__ void ph_moe_dn(const Params& pkv, KPtr kp_in, int wbase_in, int l, char* lds) {
    PH_HEAD
    int* tb = (int*)(lds + 132096);
    moe_tile_prefix(p, l, tb, TID);
    const int ntile = __builtin_amdgcn_readfirstlane(tb[NE]), nunits = ntile * 4;
    const int* cnt = p.cnt + l * NE;
    bool pre = false;
    XU_LOOP(ntile, 4) {
        const int u = XU_UNIT();
        const MoeUnit m = moe_decode(tb, cnt, u, 2);
        const int un = XU_NEXT_UNIT();
        G8Next nx; nx.valid = (XU_NEXT_OK) ? 1 : 0; nx.A = nullptr; nx.rowidx = nullptr; nx.Bt = nullptr; nx.nvalid = 256;
        if (nx.valid) { const MoeUnit m2 = moe_decode(tb, cnt, un, 2); nx.A = p.act + (size_t)m2.mtg * MOE_TM * 1024; nx.Bt = p.wdn_t + (((size_t)l * NE + m2.e) * 1024 + m2.nt * 256) * 1024; }
        const float* bias = p.b_dn + ((size_t)l * NE + m.e) * 1024 + m.nt * 256;
        const float* gate = p.rowgate + (size_t)m.e * NT + m.mt * MOE_TM;
        bf16_t* out = p.yb + (size_t)m.mtg * MOE_TM * 1024 + m.nt * 256;
        const int nvalid = m.nvalid;
        gemm_tile256(p.act + (size_t)m.mtg * MOE_TM * 1024, 1024, nullptr, 256, p.wdn_t + (((size_t)l * NE + m.e) * 1024 + m.nt * 256) * 1024, 1024, 1024, lds, wbase_in, pre, nx,
                     [=](int r, int c, f32x4 v0, f32x4 v1) mutable {
                         const float g = (r < nvalid) ? gate[r] : 0.f;
                         const f32x4 b0 = *(const f32x4*)(bias + c), b1 = *(const f32x4*)(bias + c + 16); v0 = (v0 + b0) * g; v1 = (v1 + b1) * g;
                         uint2 o; o.x = cvtpk(v0[0], v0[1]); o.y = cvtpk(v0[2], v0[3]); *(uint2*)(out + (size_t)r * 1024 + c) = o;
                         o.x = cvtpk(v1[0], v1[1]); o.y = cvtpk(v1[2], v1[3]); *(uint2*)(out + (size_t)r * 1024 + c + 16) = o; });
        pre = nx.valid != 0;
    }
}
__device__ __forceinline__ void ph_combine_ln2(const Params& pkv, KPtr kp_in, int wbase_in, int l, char* lds) {
    PH_HEAD
    int* tb = (int*)(lds + 132096);
    moe_tile_prefix(p, l, tb, TID);
    const int lane = TID & 63, gw = BID * (NTHREADS / 64) + (TID >> 6), nw = gridDim.x * (NTHREADS / 64);
    const float* g2 = p.ln2_g + l * 1024; const float* b2 = p.ln2_b + l * 1024;
    float* dstf = (l == DEPTH - 1) ? p.out : p.xf;
#pragma unroll 2
    for (int t = gw; t < NT; t += nw) {
        size_t rows[4];
#pragma unroll
        for (int k = 0; k < 4; ++k) { const int e = p.toke[(size_t)t * 4 + k], pos = p.tokpos[(size_t)t * 4 + k]; rows[k] = (size_t)tb[e] * MOE_TM + pos; }
        float4 y[4]; float s = 0.f;
#pragma unroll
        for (int m = 0; m < 4; ++m) {
            const int c = m * 256 + lane * 4;
            float4 v = *(const float4*)(p.y1 + (size_t)t * 1024 + c);
            v.x *= ALPHA; v.y *= ALPHA; v.z *= ALPHA; v.w *= ALPHA;
#pragma unroll
            for (int k = 0; k < 4; ++k) { const ushort4 yb = *(const ushort4*)(p.yb + rows[k] * 1024 + c); v.x += bf2f(yb.x); v.y += bf2f(yb.y); v.z += bf2f(yb.z); v.w += bf2f(yb.w); }
            y[m] = v; s += v.x + v.y + v.z + v.w;
        }
        const float mean = wave_sum(s) * (1.0f / 1024.0f);
        float q = 0.f;
#pragma unroll
        for (int m = 0; m < 4; ++m) { y[m].x -= mean; y[m].y -= mean; y[m].z -= mean; y[m].w -= mean; q += y[m].x * y[m].x + y[m].y * y[m].y + y[m].z * y[m].z + y[m].w * y[m].w; }
        const float rs = rsqrtf(wave_sum(q) * (1.0f / 1024.0f) + 1e-5f);
#pragma unroll
        for (int m = 0; m < 4; ++m) {
            const int c = m * 256 + lane * 4;
            const float4 g = *(const float4*)(g2 + c), bb = *(const float4*)(b2 + c);
            float4 xv; xv.x = y[m].x * rs * g.x + bb.x; xv.y = y[m].y * rs * g.y + bb.y; xv.z = y[m].z * rs * g.z + bb.z; xv.w = y[m].w * rs * g.w + bb.w;
            *(float4*)(dstf + (size_t)t * 1024 + c) = xv;
            ushort4 ob; ob.x = f2bf(xv.x); ob.y = f2bf(xv.y); ob.z = f2bf(xv.z); ob.w = f2bf(xv.w);
            *(ushort4*)(p.xb + (size_t)t * 1024 + c) = ob;
        }
    }
}

constexpr int PH_PRO = 0, PH_INPROJ = 1, PH_PREP = 2, PH_RETKV = 3, PH_RETSCAN = 4, PH_RETOUT = 5, PH_DIL = 6, PH_RWKVPREP = 7, PH_RWKVSCAN = 8, PH_MLAUP = 9,
              PH_MLAATTN = 10, PH_FINAL = 11, PH_OUTPROJ = 12, PH_LN1 = 13, PH_GU = 14, PH_DN = 15, PH_LN2 = 16;

#ifdef MULTI_LAUNCH
template <int ph>
__global__ void __launch_bounds__(NTHREADS, 2) mega(Params pk, int l) {
    extern __shared__ __attribute__((aligned(16))) char lds[];
    KPtr kp = (KPtr)__builtin_amdgcn_kernarg_segment_ptr();
    const int wbase = __builtin_amdgcn_readfirstlane(threadIdx.x) & ~63;
    if (ph == PH_PRO) ph_prologue(pk, kp, wbase, lds);
    if (ph == PH_INPROJ) ph_inproj(pk, kp, wbase, l, lds);
    if (ph == PH_PREP) ph_rope_prep(pk, kp, wbase, l);
    if (ph == PH_RETKV) ph_ret_kv(pk, kp, wbase, l, lds);
    if (ph == PH_RETSCAN) ph_ret_scan(pk, kp, wbase, l);
    if (ph == PH_RETOUT) ph_ret_out(pk, kp, wbase, l, lds);
    if (ph == PH_DIL) ph_dil_attn(pk, kp, wbase, l, lds);
    if (ph == PH_RWKVPREP) ph_rwkv_prep(pk, kp, wbase, l, lds);
    if (ph == PH_RWKVSCAN) ph_rwkv_scan(pk, kp, wbase, l, lds);
    if (ph == PH_MLAUP) ph_mla_up(pk, kp, wbase, l, lds);
    if (ph == PH_MLAATTN) ph_mla_attn(pk, kp, wbase, l, lds);
    if (ph == PH_FINAL) ph_finalize_mix(pk, kp, wbase, l);
    if (ph == PH_OUTPROJ) ph_outproj(pk, kp, wbase, l, lds);
    if (ph == PH_LN1) ph_ln1_router(pk, kp, wbase, l, lds);
    if (ph == PH_GU) ph_moe_gu(pk, kp, wbase, l, lds);
    if (ph == PH_DN) ph_moe_dn(pk, kp, wbase, l, lds);
    if (ph == PH_LN2) ph_combine_ln2(pk, kp, wbase, l, lds);
}
template <int PH> static void launch_ph(const Params& p, int l, hipStream_t stream) {
    static bool attr_set = false;
    if (!attr_set) { (void)hipFuncSetAttribute((const void*)mega<PH>, hipFuncAttributeMaxDynamicSharedMemorySize, LDS_BYTES); attr_set = true; }
    hipLaunchKernelGGL(mega<PH>, dim3(256), dim3(NTHREADS), LDS_BYTES, stream, p, l);
}
template <int PH> static void launch_layer(const Params& p, int l, hipStream_t stream) {
    launch_ph<PH>(p, l, stream);
    if constexpr (PH < PH_LN2) launch_layer<PH + 1>(p, l, stream);
}

#else
__device__ __forceinline__ void grid_sync(KPtr kp_in, int wbase_in, char* lds) {
    KPtr kp_ = kp_launder(kp_in);
    XcdBarrier b; b.bar = kp_->bar; b.x = xb_xcc_id(); b.st = (volatile LAS unsigned*)(lds + LDS_BYTES - 16);
    xcd_barrier(b, opq_tid(wbase_in));
}
#ifndef PROBE_ID
#define PROBE_ID -1
#endif
#define RUN(ID, call) do { int reps_ = 1; if (PROBE_ID == (ID)) { reps_ = 2; asm volatile("" : "+s"(reps_)); } for (int r_ = 0; r_ < reps_; ++r_) { call; } } while (0)
__global__ void __launch_bounds__(NTHREADS, 2) mega_fused(Params pk) {
    extern __shared__ __attribute__((aligned(16))) char lds[];
    KPtr kp = (KPtr)__builtin_amdgcn_kernarg_segment_ptr();
    const int wbase = __builtin_amdgcn_readfirstlane(threadIdx.x) & ~63;
    volatile LAS unsigned* xbw = (volatile LAS unsigned*)(lds + LDS_BYTES - 16);
    if (threadIdx.x == 0) { xbw[0] = 0u; xbw[1] = 0u; xbw[2] = 0u; xbw[3] = 0u; }
    __syncthreads();
    (void)xcd_barrier_post(pk.bar, xbw);
    RUN(0, ph_prologue(pk, kp, wbase, lds));
    grid_sync(kp, wbase, lds);
    for (int l = 0; l < DEPTH; ++l) {
        RUN(1, ph_inproj(pk, kp, wbase, l, lds));
        grid_sync(kp, wbase, lds);
        RUN(3, ph_ret_kv(pk, kp, wbase, l, lds)); RUN(4, ph_rwkv_prep(pk, kp, wbase, l, lds)); RUN(5, ph_mla_up(pk, kp, wbase, l, lds));
        grid_sync(kp, wbase, lds);
        RUN(8, ph_ret_scan(pk, kp, wbase, l)); RUN(17, ph_rwkv_chunkpre(pk, kp, wbase, l, lds));
        grid_sync(kp, wbase, lds);
        RUN(10, ph_rwkv_scan(pk, kp, wbase, l, lds)); RUN(9, ph_mla_attn(pk, kp, wbase, l, lds)); ph_dil_attn(pk, kp, wbase, l, lds); ph_ret_out(pk, kp, wbase, l, lds);
        grid_sync(kp, wbase, lds);
        RUN(12, ph_finalize_mix(pk, kp, wbase, l));
        grid_sync(kp, wbase, lds);
        RUN(13, ph_outproj(pk, kp, wbase, l, lds));
        grid_sync(kp, wbase, lds);
        ph_ln1_router(pk, kp, wbase, l, lds);
        grid_sync(kp, wbase, lds);
        RUN(14, ph_moe_gu(pk, kp, wbase, l, lds));
        grid_sync(kp, wbase, lds);
        RUN(15, ph_moe_dn(pk, kp, wbase, l, lds));
        grid_sync(kp, wbase, lds);
        RUN(16, ph_combine_ln2(pk, kp, wbase, l, lds));
        grid_sync(kp, wbase, lds);
    }
}
#endif
struct Carver { char* base; size_t off; template <class T> T* take(size_t n) { T* r = (T*)(base + off); off += ((n * sizeof(T) + 255) / 256) * 256; return r; } };

extern "C" void kernel_launch(void* const* d_in, const int* in_sizes, int n_in, void* d_out, int out_size, void* d_ws, size_t ws_size, hipStream_t stream) {
    Params p; memset(&p, 0, sizeof(p));
    const float** ip = (const float**)&p;
    for (int i = 0; i < 35; ++i) ip[i] = (const float*)d_in[i];
    p.out = (float*)d_out;
    Carver c{(char*)d_ws, 0};
    p.bar = c.take<unsigned>(4096); p.cnt = c.take<int>(DEPTH * NE); p.wq = c.take<int>(DEPTH * 16);
    p.tab_ret = c.take<float>((size_t)SEQ * 32); p.tab_dil = c.take<float>((size_t)SEQ * 16); p.tab_mla = c.take<float>((size_t)SEQ * 32);
    p.win_t = c.take<bf16_t>((size_t)DEPTH * NINP * 1024); p.wout_t = c.take<bf16_t>((size_t)DEPTH * 1024 * 1024);
    p.wgu_t = c.take<bf16_t>((size_t)DEPTH * NE * 2048 * 1024); p.wdn_t = c.take<bf16_t>((size_t)DEPTH * NE * 1024 * 1024);
    p.wq_t = c.take<bf16_t>((size_t)DEPTH * 384 * 256); p.wkv_t = c.take<bf16_t>((size_t)DEPTH * 512 * 128);
    p.wupt = c.take<bf16_t>((size_t)DEPTH * 256 * 64); p.aupt = c.take<bf16_t>((size_t)DEPTH * 256 * 64); p.gupt = c.take<bf16_t>((size_t)DEPTH * 256 * 128); p.vupt = c.take<bf16_t>((size_t)DEPTH * 256 * 32);
    p.xf = c.take<float>((size_t)NT * DM); p.xb = c.take<bf16_t>((size_t)NT * DM); p.pbuf = c.take<bf16_t>((size_t)NT * NINP);
    p.mixcat = c.take<bf16_t>((size_t)NT * DM); p.y1 = c.take<float>((size_t)NT * DM); p.x1b = c.take<bf16_t>((size_t)NT * DM);
    p.rq = c.take<float>((size_t)NT * 128); p.rk = c.take<float>((size_t)NT * 128);
    p.rkv = c.take<float>((size_t)NBATCH * NCH * 4 * 32 * 64); p.rstate = c.take<float>((size_t)NBATCH * NCH * 4 * 32 * 64);
    p.dq = c.take<float>((size_t)NT * 256); p.dk = c.take<float>((size_t)NT * 256); p.dob = c.take<float>((size_t)3 * NT * 256); p.dlse = c.take<float>((size_t)3 * NT * 4);
    p.sr = c.take<float>((size_t)NT * 256); p.sw = c.take<float>((size_t)NT * 256); p.sk = c.take<float>((size_t)NT * 256); p.sv = c.take<float>((size_t)NT * 256);
    p.sa = c.take<float>((size_t)NT * 256); p.sb = c.take<float>((size_t)NT * 256); p.sg = c.take<float>((size_t)NT * 256); p.sy = c.take<float>((size_t)NT * 256);
    p.vfirst = c.take<float>((size_t)NT * 256);
    p.c_p = c.take<float>((size_t)16 * (SEQ / 16) * 4096); p.c_q = c.take<float>((size_t)16 * (SEQ / 16) * 4096); p.c_rh = c.take<float>((size_t)16 * (SEQ / 16) * 1024); p.c_y1 = c.take<float>((size_t)16 * (SEQ / 16) * 1024);
    p.rsq = c.take<float>(NT); p.rskv = c.take<float>(NT); p.kpe = c.take<float>((size_t)NT * 32);
    p.qu = c.take<float>((size_t)NT * 384); p.kvu = c.take<float>((size_t)NT * 512); p.mo = c.take<float>((size_t)NT * 256);
    p.mq = c.take<bf16_t>((size_t)NT * 384); p.mk = c.take<bf16_t>((size_t)NT * 384); p.mv = c.take<bf16_t>((size_t)NT * 256);
    p.rowtok = c.take<int>((size_t)NE * NT); p.toke = c.take<int>((size_t)NT * 4); p.tokpos = c.take<int>((size_t)NT * 4); p.rowgate = c.take<float>((size_t)NE * NT);
    p.act = c.take<bf16_t>((size_t)MOE_MAXROWS * 1024); p.yb = c.take<bf16_t>((size_t)MOE_MAXROWS * 1024);
    if (c.off > ws_size) { fprintf(stderr, "workspace too small: need %zu have %zu\n", c.off, ws_size); return; }

#ifdef MULTI_LAUNCH
    launch_ph<PH_PRO>(p, 0, stream);
    for (int l = 0; l < DEPTH; ++l) launch_layer<PH_INPROJ>(p, l, stream);
#else
    static int grid = 0;
    if (!grid) {
        (void)hipFuncSetAttribute((const void*)mega_fused, hipFuncAttributeMaxDynamicSharedMemorySize, LDS_BYTES);
        int dev = 0, cus = 0, per_cu = 0;
        (void)hipGetDevice(&dev);
        (void)hipDeviceGetAttribute(&cus, hipDeviceAttributeMultiprocessorCount, dev);
        (void)hipOccupancyMaxActiveBlocksPerMultiprocessor(&per_cu, mega_fused, NTHREADS, LDS_BYTES);
        if (cus <= 0) cus = 256;
        grid = cus * (per_cu < 1 ? 1 : 1);
    }
    (void)hipMemsetAsync(p.bar, 0, XCD_BAR_WORDS * sizeof(unsigned), stream);
    hipLaunchKernelGGL(mega_fused, dim3(grid), dim3(NTHREADS), LDS_BYTES, stream, p);
#endif
}
```

```cpp
#include <hip/hip_runtime.h>
#include <stdint.h>
#include <string.h>
#include <stdio.h>

typedef unsigned short bf16_t;
typedef short bf16x8 __attribute__((ext_vector_type(8)));
typedef float f32x4 __attribute__((ext_vector_type(4)));
typedef unsigned u32x4 __attribute__((ext_vector_type(4)));
typedef float f32x16 __attribute__((ext_vector_type(16)));
typedef short s16x4 __attribute__((ext_vector_type(4)));
typedef float f32x2_t __attribute__((ext_vector_type(2)));
typedef __bf16 bf16x2_t __attribute__((ext_vector_type(2)));

constexpr int NT = 32768, SEQ = 8192, NBATCH = 4, DM = 1024, NIN = 2976, NINP = 3072, DEPTH = 4, NE = 32, TOPK = 4;
constexpr int BLK = 128, NCH = SEQ / BLK;
constexpr float ALPHA = 1.6817928305074292f;
constexpr int PC_RQ = 0, PC_RK = 128, PC_RV = 256, PC_RG = 512, PC_DQ = 768, PC_DK = 1024, PC_DV = 1280;
constexpr int PC_C = 1536, PC_CR = 1536, PC_CK = 1792, PC_CV = 2048, PC_CWD = 2304, PC_CAD = 2368, PC_CGD = 2432;
constexpr int PC_MQ = 2560, PC_MKV = 2816, PC_MKR = 2944, PC_VRES = 2976;
constexpr int MOE_TM = 256;
constexpr int MOE_MAXROWS = NT * TOPK + NE * MOE_TM;
constexpr int NTHREADS = 512;
constexpr int LDS_BYTES = 147456;

__device__ __forceinline__ bf16_t f2bf(float f) { unsigned u = __float_as_uint(f); u += 0x7fffu + ((u >> 16) & 1u); return (bf16_t)(u >> 16); }
__device__ __forceinline__ unsigned cvtpk(float lo, float hi) { f32x2_t v = {lo, hi}; bf16x2_t b = __builtin_convertvector(v, bf16x2_t); return __builtin_bit_cast(unsigned, b); }
__device__ __forceinline__ float xhalf_max(float v) { auto rr = __builtin_amdgcn_permlane32_swap(__float_as_uint(v), __float_as_uint(v), false, false); return fmaxf(__uint_as_float(rr[0]), __uint_as_float(rr[1])); }
__device__ __forceinline__ float xhalf_sum(float v) { auto rr = __builtin_amdgcn_permlane32_swap(__float_as_uint(v), __float_as_uint(v), false, false); return __uint_as_float(rr[0]) + __uint_as_float(rr[1]); }
__device__ __forceinline__ float bf2f(bf16_t h) { return __uint_as_float(((unsigned)h) << 16); }
template <int CTRL> __device__ __forceinline__ float dpp_f(float v) { return __int_as_float(__builtin_amdgcn_update_dpp(0, __float_as_int(v), CTRL, 0xF, 0xF, true)); }
__device__ __forceinline__ float grp16_sum(float v) {
    v += dpp_f<0x128>(v); v += dpp_f<0x124>(v); v += dpp_f<0x122>(v); v += dpp_f<0x121>(v); return v; }
__device__ __forceinline__ float wave_sum(float v) {
    v = grp16_sum(v);
    const int i = __float_as_int(v);
    return (__int_as_float(__builtin_amdgcn_readlane(i, 0)) + __int_as_float(__builtin_amdgcn_readlane(i, 16))) +
           (__int_as_float(__builtin_amdgcn_readlane(i, 32)) + __int_as_float(__builtin_amdgcn_readlane(i, 48))); }
__device__ __forceinline__ float sigmoidf_(float x) { return __builtin_amdgcn_rcpf(1.0f + __builtin_amdgcn_exp2f(x * -1.4426950408889634f)); }

#define XB_TMO      128
#define XB_XCNT(j)  (256  + 64 * (j))
#define XB_XSUB(j)  (1280 + 64 * (j))
#define XB_XGEN(j)  (2304 + 64 * (j))
#define XB_TOP      3328
#define XB_TOPGEN   3392
#define XCD_BAR_WORDS 3456
#define XB_SPIN_CAP (1u << 22)
#define LAS __attribute__((address_space(3)))
__device__ __forceinline__ unsigned xb_ld(unsigned* p)              { return __hip_atomic_load(p, __ATOMIC_RELAXED, __HIP_MEMORY_SCOPE_AGENT); }
__device__ __forceinline__ unsigned xb_add(unsigned* p, unsigned v) { return __hip_atomic_fetch_add(p, v, __ATOMIC_RELAXED, __HIP_MEMORY_SCOPE_AGENT); }
__device__ __forceinline__ unsigned xb_xcc_id() { return (unsigned)__builtin_amdgcn_s_getreg((3 << 11) | 20) & 0xFu; }
#define XB_SPIN(cond, bar) do { unsigned _sp = 0; while (cond) { __builtin_amdgcn_s_sleep(1); \
    if ((++_sp & 255u) == 0u) { if (xb_ld(&(bar)[XB_TMO])) break; if (_sp > XB_SPIN_CAP) { atomicAdd(&(bar)[XB_TMO], 1u); break; } } } } while (0)
struct XcdBarrier { unsigned* bar; unsigned x; volatile LAS unsigned* st; };
__device__ __forceinline__ XcdBarrier xcd_barrier_post(unsigned* bar, volatile LAS unsigned* st) {
    XcdBarrier b; b.bar = bar; b.x = xb_xcc_id(); b.st = st;
    if (threadIdx.x == 0) (void)xb_add(&bar[XB_XCNT(b.x)], 1u);
    return b;
}
__device__ __forceinline__ void xcd_barrier_complete(unsigned* bar, unsigned x, unsigned& nloc, unsigned& nx) {
    const unsigned G = gridDim.x * gridDim.y * gridDim.z;
    unsigned sum, cnt, mine, sp = 0u;
    for (;;) {
        sum = 0u; cnt = 0u; mine = 0u;
#pragma unroll
        for (unsigned j = 0; j < 16; ++j) { const unsigned c = xb_ld(&bar[XB_XCNT(j)]); sum += c; cnt += (c > 0u) ? 1u : 0u; mine = (j == x) ? c : mine; }
        if (sum == G) break;
        __builtin_amdgcn_s_sleep(1);
        if ((++sp & 255u) == 0u) { if (xb_ld(&bar[XB_TMO])) break; if (sp > XB_SPIN_CAP) { atomicAdd(&bar[XB_TMO], 1u); break; } }
    }
    nloc = mine > 0u ? mine : 1u; nx = cnt > 0u ? cnt : 1u;
}
__device__ __forceinline__ void xcd_barrier(const XcdBarrier& b, const int tid0) {
    asm volatile("s_waitcnt vmcnt(0)" ::: "memory");
    __syncthreads();
    if (tid0 == 0) {
        unsigned* bar = b.bar;
        __builtin_amdgcn_s_waitcnt(0);
        unsigned nloc = b.st[0], nx = b.st[1];
        if (nloc == 0u) { xcd_barrier_complete(bar, b.x, nloc, nx); b.st[0] = nloc; b.st[1] = nx; }
        const unsigned old = xb_add(&bar[XB_XSUB(b.x)], 1u);
        const unsigned gen = old / nloc;
        if (old + 1u == (gen + 1u) * nloc) {
            __builtin_amdgcn_fence(__ATOMIC_RELEASE, "agent");
            asm volatile("s_waitcnt vmcnt(0)" ::: "memory");
            const unsigned og = xb_add(&bar[XB_TOP], 1u);
            const unsigned tg = og / nx;
            if (og + 1u == (tg + 1u) * nx) xb_add(&bar[XB_TOPGEN], 1u);
            else XB_SPIN(xb_ld(&bar[XB_TOPGEN]) == tg, bar);
            __builtin_amdgcn_fence(__ATOMIC_ACQUIRE, "agent");
            xb_add(&bar[XB_XGEN(b.x)], 1u);
            asm volatile("s_waitcnt vmcnt(0)" ::: "memory");
        } else {
            XB_SPIN(xb_ld(&bar[XB_XGEN(b.x)]) == gen, bar);
            __builtin_amdgcn_fence(__ATOMIC_ACQUIRE, "agent");
            asm volatile("s_waitcnt vmcnt(0)" ::: "memory");
        }
    }
    __syncthreads();
}

struct Params {
    const float *x, *w_in, *w_out, *ret_norm_g, *dil_norm_g, *rwkv_mu, *rwkv_w0, *rwkv_w_up, *rwkv_a0, *rwkv_a_up, *rwkv_g_up, *rwkv_k_k, *rwkv_k_a,
        *rwkv_r_k, *rwkv_ln_g, *rwkv_ln_b, *vres_down, *vres_mu, *rwkv_v0, *rwkv_v_up, *mla_q_norm_g, *mla_w_q_up, *mla_kv_norm_g, *mla_w_kv_up,
        *mla_out_norm_g, *ln1_g, *ln1_b, *router_w, *router_b, *w_gu, *b_gu, *w_dn, *b_dn, *ln2_g, *ln2_b;
    float* out;
    unsigned* bar; int* cnt; int* wq;
    float *tab_ret, *tab_dil, *tab_mla;
    bf16_t *win_t, *wout_t, *wgu_t, *wdn_t, *wq_t, *wkv_t, *wupt, *aupt, *gupt, *vupt;
    float* xf; bf16_t* xb; bf16_t* pbuf; bf16_t* mixcat; float* y1; bf16_t* x1b;
    float *rq, *rk, *rkv, *rstate;
    float *dq, *dk, *dob, *dlse;
    float *sr, *sw, *sk, *sv, *sa, *sb, *sg, *sy, *vfirst;
    float *c_p, *c_q, *c_rh, *c_y1;
    float *rsq, *rskv, *kpe, *qu, *kvu, *mo;
    bf16_t *mq, *mk, *mv;
    int *rowtok, *toke, *tokpos; float* rowgate; bf16_t *act, *yb;
};

__device__ __forceinline__ int opq_tid(int wbase) { unsigned z = 0u; asm volatile("" : "+s"(z)); int t = wbase | (int)__builtin_amdgcn_mbcnt_hi(~0u, __builtin_amdgcn_mbcnt_lo(~0u, z)); asm volatile("" : "+v"(t)); return t; }
__device__ __forceinline__ int opq_bid() { int b = blockIdx.x; asm volatile("" : "+s"(b)); return b; }
typedef const __attribute__((address_space(4))) Params* KPtr;
typedef const __attribute__((address_space(4))) Params& KRef;
__device__ __forceinline__ KPtr kp_launder(KPtr k) {
    const unsigned long long v = (unsigned long long)k;
    unsigned lo = (unsigned)v, hi = (unsigned)(v >> 32);
    asm volatile("" : "+s"(lo), "+s"(hi));
    return (KPtr)(((unsigned long long)hi << 32) | lo);
}
#define PH_HEADV (void)kp_in; const Params& p = pkv; const int TID = opq_tid(wbase_in), BID = opq_bid(); (void)TID; (void)BID;
#define PH_HEAD (void)pkv; KPtr kp_ = kp_launder(kp_in); KRef p = *kp_; const int TID = opq_tid(wbase_in), BID = opq_bid(); (void)TID; (void)BID;
template <class F>
__device__ __forceinline__ void tr_tile(F f, bf16_t* dst, int ldd, int k0, int n0, float* tile, const int TID) {
    const int tid = TID;
#pragma unroll
    for (int i = 0; i < 8; ++i) { const int e = tid + i * NTHREADS, kk = e >> 6, nn = e & 63; tile[kk * 65 + nn] = f(k0 + kk, n0 + nn); }
    __syncthreads();
    {
        const int nn = tid >> 3, kc = (tid & 7) * 8;
        u32x4 w;
        w[0] = cvtpk(tile[(kc + 0) * 65 + nn], tile[(kc + 1) * 65 + nn]); w[1] = cvtpk(tile[(kc + 2) * 65 + nn], tile[(kc + 3) * 65 + nn]);
        w[2] = cvtpk(tile[(kc + 4) * 65 + nn], tile[(kc + 5) * 65 + nn]); w[3] = cvtpk(tile[(kc + 6) * 65 + nn], tile[(kc + 7) * 65 + nn]);
        *(u32x4*)(dst + (size_t)(n0 + nn) * ldd + k0 + kc) = w;
    }
    __syncthreads();
}

__device__ __forceinline__ void ph_prologue(const Params& pkv, KPtr kp_in, int wbase_in, char* lds) {
    PH_HEAD
    float* tile = (float*)lds;
    const int nb = gridDim.x, bid = BID, tid = TID;
    for (int t = bid; t < DEPTH * NE * 16 * 32; t += nb) {
        const int le = t >> 9, r = t & 511, tk = r >> 5, tn = r & 31;
        const float* src = p.w_gu + (size_t)le * 1024 * 2048;
        tr_tile([&](int k, int n) { return src[(size_t)k * 2048 + n]; }, p.wgu_t + (size_t)le * 2048 * 1024, 1024, tk * 64, tn * 64, tile, TID);
    }
    for (int t = bid; t < DEPTH * NE * 16 * 16; t += nb) {
        const int le = t >> 8, r = t & 255, tk = r >> 4, tn = r & 15;
        const float* src = p.w_dn + (size_t)le * 1024 * 1024;
        tr_tile([&](int k, int n) { return src[(size_t)k * 1024 + n]; }, p.wdn_t + (size_t)le * 1024 * 1024, 1024, tk * 64, tn * 64, tile, TID);
    }
    for (int t = bid; t < DEPTH * 16 * 48; t += nb) {
        const int l = t / (16 * 48), r = t % (16 * 48), tk = r / 48, tn = r % 48;
        const float* src = p.w_in + (size_t)l * 1024 * NIN;
        const float* vr = p.vres_down + (size_t)(l > 0 ? l - 1 : 0) * 1024 * 32;
        tr_tile([&](int k, int n) { return n < NIN ? src[(size_t)k * NIN + n] : ((n < NIN + 32 && l > 0) ? vr[k * 32 + (n - NIN)] : 0.0f); },
                p.win_t + (size_t)l * NINP * 1024, 1024, tk * 64, tn * 64, tile, TID);
    }
    for (int t = bid; t < DEPTH * 16 * 16; t += nb) {
        const int l = t >> 8, r = t & 255, tk = r >> 4, tn = r & 15;
        const float* src = p.w_out + (size_t)l * 1024 * 1024;
        tr_tile([&](int k, int n) { return src[(size_t)k * 1024 + n]; }, p.wout_t + (size_t)l * 1024 * 1024, 1024, tk * 64, tn * 64, tile, TID);
    }
    for (int t = bid; t < DEPTH * 4 * 6; t += nb) {
        const int l = t / 24, r = t % 24, tk = r / 6, tn = r % 6;
        const float* src = p.mla_w_q_up + (size_t)l * 256 * 384; const float* g = p.mla_q_norm_g + l * 256;
        tr_tile([&](int k, int n) { return src[k * 384 + n] * g[k]; }, p.wq_t + (size_t)l * 384 * 256, 256, tk * 64, tn * 64, tile, TID);
    }
    for (int t = bid; t < DEPTH * 2 * 8; t += nb) {
        const int l = t / 16, r = t % 16, tk = r / 8, tn = r % 8;
        const float* src = p.mla_w_kv_up + (size_t)l * 128 * 512; const float* g = p.mla_kv_norm_g + l * 128;
        tr_tile([&](int k, int n) { return src[k * 512 + n] * g[k]; }, p.wkv_t + (size_t)l * 512 * 128, 128, tk * 64, tn * 64, tile, TID);
    }
    for (int i = bid * NTHREADS + tid; i < DEPTH * 256 * 64; i += nb * NTHREADS) {
        const int l = i / (256 * 64), r = i % (256 * 64), n = r / 64, k = r % 64;
        p.wupt[i] = f2bf(p.rwkv_w_up[((size_t)l * 64 + k) * 256 + n]); p.aupt[i] = f2bf(p.rwkv_a_up[((size_t)l * 64 + k) * 256 + n]);
    }
    for (int i = bid * NTHREADS + tid; i < DEPTH * 256 * 128; i += nb * NTHREADS) {
        const int l = i / (256 * 128), r = i % (256 * 128), n = r / 128, k = r % 128;
        p.gupt[i] = f2bf(p.rwkv_g_up[((size_t)l * 128 + k) * 256 + n]);
    }
    for (int i = bid * NTHREADS + tid; i < (DEPTH - 1) * 256 * 32; i += nb * NTHREADS) {
        const int l = i / (256 * 32), r = i % (256 * 32), n = r / 32, k = r % 32;
        p.vupt[i] = f2bf(p.rwkv_v_up[((size_t)l * 32 + k) * 256 + n]);
    }
    for (int i = bid * NTHREADS + tid; i < SEQ * 40; i += nb * NTHREADS) {
        const int pos = i / 40, j = i % 40;
        double theta, rot; int f; float* dst;
        if (j < 16) { theta = 10000.0; rot = 32.0; f = j; dst = p.tab_ret + ((size_t)pos * 16 + f) * 2; }
        else if (j < 24) { theta = 500000.0; rot = 16.0; f = j - 16; dst = p.tab_dil + ((size_t)pos * 8 + f) * 2; }
        else { theta = 10000.0; rot = 32.0; f = j - 24; dst = p.tab_mla + ((size_t)pos * 16 + f) * 2; }
        const double inv = 1.0 / pow(theta, (2.0 * f) / rot), ang = (double)pos * inv;
        dst[0] = (float)cos(ang); dst[1] = (float)sin(ang);
    }
    for (size_t i = (size_t)bid * NTHREADS + tid; i < (size_t)NT * DM / 4; i += (size_t)nb * NTHREADS) {
        const float4 v = ((const float4*)p.x)[i];
        ushort4 o; o.x = f2bf(v.x); o.y = f2bf(v.y); o.z = f2bf(v.z); o.w = f2bf(v.w);
        ((ushort4*)p.xb)[i] = o;
    }
    if (bid == 0 && tid < DEPTH * NE) p.cnt[tid] = 0;
    if (bid == 0 && tid < DEPTH * 16) p.wq[tid] = 0;
}

template <class Epi>
__device__ __forceinline__ void gemm_tile128(const bf16_t* __restrict__ A, int lda, const int* __restrict__ rowidx, int nvalid,
                                             const bf16_t* __restrict__ Bt, int ldb, int K, char* lds, const int TID, Epi epi) {
    constexpr int LDT = 72;
    bf16_t* As = (bf16_t*)lds; bf16_t* Bs = As + 128 * LDT;
    const int tid = TID, lane = tid & 63, wid = tid >> 6, wm = wid >> 2, wn = wid & 3, fr = lane & 15, fq = lane >> 4;
    const bf16_t* ap[2]; const bf16_t* bp[2]; int so[2];
#pragma unroll
    for (int i = 0; i < 2; ++i) {
        const int c = tid + i * NTHREADS, row = c >> 3, kc = c & 7;
        int ar = row; if (rowidx) ar = (row < nvalid) ? rowidx[row] : rowidx[0];
        ap[i] = A + (size_t)ar * lda + kc * 8; bp[i] = Bt + (size_t)row * ldb + kc * 8; so[i] = row * LDT + kc * 8;
    }
    f32x4 acc[4][2];
#pragma unroll
    for (int mi = 0; mi < 4; ++mi)
#pragma unroll
        for (int ni = 0; ni < 2; ++ni) acc[mi][ni] = (f32x4){0.f, 0.f, 0.f, 0.f};
    u32x4 ra0, ra1, rb0, rb1;
    ra0 = *(const u32x4*)(ap[0]); ra1 = *(const u32x4*)(ap[1]); rb0 = *(const u32x4*)(bp[0]); rb1 = *(const u32x4*)(bp[1]);
    const int nk = K >> 6;
    for (int kt = 0; kt < nk; ++kt) {
        __syncthreads();
        *(u32x4*)(As + so[0]) = ra0; *(u32x4*)(As + so[1]) = ra1; *(u32x4*)(Bs + so[0]) = rb0; *(u32x4*)(Bs + so[1]) = rb1;
        __syncthreads();
        if (kt + 1 < nk) {
            const int ko = (kt + 1) * 64;
            ra0 = *(const u32x4*)(ap[0] + ko); ra1 = *(const u32x4*)(ap[1] + ko); rb0 = *(const u32x4*)(bp[0] + ko); rb1 = *(const u32x4*)(bp[1] + ko);
        }
#pragma unroll
        for (int kk = 0; kk < 2; ++kk) {
            bf16x8 af[4], bfr[2];
#pragma unroll
            for (int mi = 0; mi < 4; ++mi) af[mi] = *(const bf16x8*)(As + (wm * 64 + mi * 16 + fr) * LDT + kk * 32 + fq * 8);
#pragma unroll
            for (int ni = 0; ni < 2; ++ni) bfr[ni] = *(const bf16x8*)(Bs + (wn * 32 + ni * 16 + fr) * LDT + kk * 32 + fq * 8);
#pragma unroll
            for (int mi = 0; mi < 4; ++mi)
#pragma unroll
                for (int ni = 0; ni < 2; ++ni) acc[mi][ni] = __builtin_amdgcn_mfma_f32_16x16x32_bf16(bfr[ni], af[mi], acc[mi][ni], 0, 0, 0);
        }
    }
#pragma unroll
    for (int mi = 0; mi < 4; ++mi) epi(wm * 64 + mi * 16 + fr, wn * 32 + fq * 4, acc[mi][0], acc[mi][1]);
    __syncthreads();
}

__device__ __forceinline__ int g8_lds_byte(int r, int c) { const int st = (r >> 4) * 2 + (c >> 5), rr = r & 15, cc = c & 31, ob = rr * 64 + cc * 2; return st * 1024 + (ob ^ (((ob >> 9) & 1) << 5)); }
__device__ __forceinline__ void g8_stage_rc(int b, int& R, int& C) { const int st = b / 1024, sb = b % 1024, swz = sb ^ (((sb >> 9) & 1) << 5); R = (st >> 1) * 16 + swz / 64; C = (st & 1) * 32 + (swz % 64) / 2; }
struct G8Out { bf16_t* out; int ld; int w; };
struct G8Next { const bf16_t* A; const int* rowidx; const bf16_t* Bt; int nvalid; int valid; int perm; };
__device__ __forceinline__ int g8_perm32(int rho) { const int n = rho >> 4, i = rho & 15; return 8 * (i >> 2) + 4 * n + (i & 3); }
template <class Epi>
__device__ __forceinline__ void gemm_tile256(const bf16_t* __restrict__ A, int lda, const int* __restrict__ rowidx, int nvalid,
                                             const bf16_t* __restrict__ Bt, int ldb, int K, char* lds, const int TID, const bool pre_issued, const G8Next nx, const bool perm, const G8Out so, Epi epi) {
    constexpr int G_HT = 128 * 64;
    bf16_t* shm = (bf16_t*)lds;
    int* icache = (int*)(lds + 133120);
#define G8_SA(b, h) (shm + ((b) * 2 + (h)) * G_HT)
#define G8_SB(b, h) (shm + (4 + (b) * 2 + (h)) * G_HT)
#define G8_SPTR(dst, src) do { unsigned long long _v = (unsigned long long)(src); unsigned _lo = (unsigned)_v, _hi = (unsigned)(_v >> 32); asm volatile("" : "+s"(_lo), "+s"(_hi)); \
        dst = (const char*)(((unsigned long long)_hi << 32) | _lo); } while (0)
#define G8_STAGE(P, BASE, OFF, kt) do { const char* _sb; G8_SPTR(_sb, (const char*)(BASE) + (size_t)(kt) * 128); _Pragma("unroll") for (int _i = 0; _i < 2; ++_i) { \
        __builtin_amdgcn_global_load_lds((const unsigned*)(_sb + (size_t)(OFF)[_i]), (unsigned*)((char*)(P) + tz * 16 + _i * 8192), 16, 0, 0); } } while (0)
#define G8_LDA(dst, b, h) _Pragma("unroll") for (int m = 0; m < 4; ++m) _Pragma("unroll") for (int k = 0; k < 2; ++k) \
        dst[m][k] = *reinterpret_cast<const bf16x8*>((char*)G8_SA(b, h) + g8_lds_byte(wr * 64 + m * 16 + fr, k * 32 + fq * 8))
#define G8_LDB(dst, b, h) _Pragma("unroll") for (int n = 0; n < 2; ++n) _Pragma("unroll") for (int k = 0; k < 2; ++k) \
        dst[n][k] = *reinterpret_cast<const bf16x8*>((char*)G8_SB(b, h) + g8_lds_byte(wc * 32 + n * 16 + fr, k * 32 + fq * 8))
#define G8_MMA(ai, bj, At_, Bt_) do { __builtin_amdgcn_s_setprio(1); \
        _Pragma("unroll") for (int m = 0; m < 4; ++m) _Pragma("unroll") for (int n = 0; n < 2; ++n) _Pragma("unroll") for (int k = 0; k < 2; ++k) \
            acc[ai][bj][m][n] = __builtin_amdgcn_mfma_f32_16x16x32_bf16(Bt_[n][k], At_[m][k], acc[ai][bj][m][n], 0, 0, 0); \
        __builtin_amdgcn_s_setprio(0); } while (0)
#define G8_WAIT_V(n) asm volatile("s_waitcnt vmcnt(" #n ")" ::: "memory")
#define G8_WAIT_L(n) asm volatile("s_waitcnt lgkmcnt(" #n ")" ::: "memory")
#define G8_BAR __builtin_amdgcn_s_barrier()
#define G8_SCHED __builtin_amdgcn_sched_barrier(0)
    int tz = opq_tid(TID);
    int wid = tz >> 6, lane = tz & 63, wr = wid >> 2, wc = wid & 3, fr = lane & 15, fq = lane >> 4;
    unsigned aoff0[2], aoff1[2], boff0[2];
#pragma unroll
    for (int i = 0; i < 2; ++i) {
        int r, c; g8_stage_rc(tz * 16 + i * 8192, r, c);
        int r0 = r, r1 = 128 + r;
        if (rowidx) {
            if (pre_issued) { r0 = icache[r0]; r1 = icache[r1]; }
            else { r0 = (r0 < nvalid) ? rowidx[r0] : rowidx[0]; r1 = (r1 < nvalid) ? rowidx[r1] : rowidx[0]; }
        }
        aoff0[i] = (unsigned)(r0 * lda + c) * 2u; aoff1[i] = (unsigned)(r1 * lda + c) * 2u;
        const int rb = perm ? ((r & ~31) + g8_perm32(r & 31)) : r;
        boff0[i] = (unsigned)(rb * ldb + c) * 2u;
    }
    const bf16_t* Bt1 = Bt + (size_t)128 * ldb;
    int nidx = 0;
    if (nx.valid && nx.rowidx && tz < 256) nidx = nx.rowidx[(tz < nx.nvalid) ? tz : 0];
    f32x4 acc[2][2][4][2];
#pragma unroll
    for (int a = 0; a < 2; ++a)
#pragma unroll
        for (int b = 0; b < 2; ++b)
#pragma unroll
            for (int m = 0; m < 4; ++m)
#pragma unroll
                for (int n = 0; n < 2; ++n) acc[a][b][m][n] = (f32x4){0.f, 0.f, 0.f, 0.f};
    bf16x8 At[4][2], B0[2][2], B1[2][2];
    const int nt = K / 64;
    if (!pre_issued) {
        G8_STAGE(G8_SB(0, 0), Bt, boff0, 0); G8_STAGE(G8_SA(0, 0), A, aoff0, 0);
        G8_STAGE(G8_SB(0, 1), Bt1, boff0, 0); G8_STAGE(G8_SA(0, 1), A, aoff1, 0);
    }
    if (wr == 1) G8_BAR;
    if (pre_issued) { G8_WAIT_V(32); } else { G8_WAIT_V(4); }
    G8_BAR;
    G8_STAGE(G8_SB(1, 0), Bt, boff0, 1); G8_STAGE(G8_SA(1, 0), A, aoff0, 1); G8_STAGE(G8_SB(1, 1), Bt1, boff0, 1);
    if (!pre_issued) { G8_WAIT_V(6); }
    G8_BAR;
    for (int t = 0; t < nt - 2; t += 2) {
        G8_LDB(B0, 0, 0); G8_SCHED; G8_LDA(At, 0, 0); G8_STAGE(G8_SA(1, 1), A, aoff1, t + 1);
        G8_WAIT_L(8); G8_BAR; G8_WAIT_L(0); G8_MMA(0, 0, At, B0); G8_BAR; G8_SCHED;
        G8_LDB(B1, 0, 1); G8_STAGE(G8_SB(0, 0), Bt, boff0, t + 2);
        G8_BAR; G8_WAIT_L(0); G8_MMA(0, 1, At, B1); G8_BAR;
        G8_LDA(At, 0, 1); G8_STAGE(G8_SA(0, 0), A, aoff0, t + 2);
        G8_BAR; G8_WAIT_L(0); G8_MMA(1, 0, At, B0); G8_BAR; G8_SCHED;
        G8_STAGE(G8_SB(0, 1), Bt1, boff0, t + 2);
        G8_WAIT_V(6); G8_BAR; G8_MMA(1, 1, At, B1); G8_BAR;
        G8_LDB(B0, 1, 0); G8_SCHED; G8_LDA(At, 1, 0); G8_STAGE(G8_SA(0, 1), A, aoff1, t + 2);
        G8_WAIT_L(8); G8_BAR; G8_WAIT_L(0); G8_MMA(0, 0, At, B0); G8_BAR; G8_SCHED;
        G8_LDB(B1, 1, 1); G8_STAGE(G8_SB(1, 0), Bt, boff0, t + 3);
        G8_BAR; G8_WAIT_L(0); G8_MMA(0, 1, At, B1); G8_BAR;
        G8_LDA(At, 1, 1); G8_STAGE(G8_SA(1, 0), A, aoff0, t + 3);
        G8_BAR; G8_WAIT_L(0); G8_MMA(1, 0, At, B0); G8_BAR; G8_SCHED;
        G8_STAGE(G8_SB(1, 1), Bt1, boff0, t + 3);
        G8_WAIT_V(6); G8_BAR; G8_MMA(1, 1, At, B1); G8_BAR;
    }
    { G8_LDB(B0, 0, 0); G8_WAIT_V(0); G8_LDA(At, 0, 0); G8_STAGE(G8_SA(1, 1), A, aoff1, nt - 1);
      G8_BAR; G8_WAIT_L(0); G8_MMA(0, 0, At, B0); G8_BAR;
      G8_LDB(B1, 0, 1); G8_BAR; G8_WAIT_L(0); G8_MMA(0, 1, At, B1); G8_BAR;
      G8_LDA(At, 0, 1); G8_WAIT_V(4); G8_BAR; G8_WAIT_L(0); G8_MMA(1, 0, At, B0); G8_MMA(1, 1, At, B1); G8_BAR; }
    { G8_LDB(B0, 1, 0); G8_LDA(At, 1, 0); G8_WAIT_V(2); G8_BAR; G8_WAIT_L(0); G8_MMA(0, 0, At, B0); G8_BAR;
      G8_LDB(B1, 1, 1); G8_WAIT_V(0); G8_BAR; G8_WAIT_L(0); G8_MMA(0, 1, At, B1); G8_BAR;
      G8_LDA(At, 1, 1); G8_BAR; G8_WAIT_L(0); G8_MMA(1, 0, At, B0); G8_MMA(1, 1, At, B1); G8_BAR; }
    if (wr == 0) G8_BAR;
    asm volatile("" : "+v"(tz)); wid = tz >> 6; lane = tz & 63; wr = wid >> 2; wc = wid & 3; fr = lane & 15; fq = lane >> 4;
    if (nx.valid) {
        if (nx.rowidx) { if (tz < 256) icache[tz] = nidx; G8_WAIT_L(0); G8_BAR; }
        unsigned na0[2], na1[2], nb0[2];
#pragma unroll
        for (int i = 0; i < 2; ++i) {
            int r, c; g8_stage_rc(tz * 16 + i * 8192, r, c);
            int r0 = r, r1 = 128 + r;
            if (nx.rowidx) { r0 = icache[r0]; r1 = icache[r1]; }
            const int rb = nx.perm ? ((r & ~31) + g8_perm32(r & 31)) : r;
            na0[i] = (unsigned)(r0 * lda + c) * 2u; na1[i] = (unsigned)(r1 * lda + c) * 2u; nb0[i] = (unsigned)(rb * ldb + c) * 2u;
        }
        const bf16_t* nBt1 = nx.Bt + (size_t)128 * ldb;
        G8_STAGE(G8_SB(0, 0), nx.Bt, nb0, 0); G8_STAGE(G8_SA(0, 0), nx.A, na0, 0);
        G8_STAGE(G8_SB(0, 1), nBt1, nb0, 0); G8_STAGE(G8_SA(0, 1), nx.A, na1, 0);
    }
    if (so.w == 0) {
#pragma unroll
        for (int ai = 0; ai < 2; ++ai)
#pragma unroll
            for (int m = 0; m < 4; ++m)
#pragma unroll
                for (int bj = 0; bj < 2; ++bj) (void)epi(ai * 128 + wr * 64 + m * 16 + fr, bj * 128 + wc * 32 + (perm ? fq * 8 : fq * 4), acc[ai][bj][m][0], acc[ai][bj][m][1]);
    } else {
        const int sw = so.w * 2 + 32;
        char* sl = (char*)lds;
#pragma unroll
        for (int ai = 0; ai < 2; ++ai) {
#pragma unroll
            for (int m = 0; m < 4; ++m)
#pragma unroll
                for (int bj = 0; bj < 2; ++bj) {
                    const int rr = wr * 64 + m * 16 + fr, c = bj * 128 + wc * 32 + fq * 8;
                    const u32x4 o = epi(ai * 128 + rr, c, acc[ai][bj][m][0], acc[ai][bj][m][1]);
                    if (so.w == 256) *(u32x4*)(sl + rr * sw + c * 2) = o; else *(uint2*)(sl + rr * sw + c) = make_uint2(o[0], o[1]);
                }
            G8_WAIT_L(0); G8_BAR;
            {
                const int rpi = 1024 / (so.w * 2), cpr = so.w / 8;
#pragma unroll 4
                for (int i = 0; i < 16 / rpi; ++i) {
                    const int row = wid * 16 + i * rpi + lane / cpr, ch = lane % cpr;
                    const u32x4 v = *(const u32x4*)(sl + row * sw + ch * 16);
                    *(u32x4*)(so.out + (size_t)(ai * 128 + row) * so.ld + ch * 8) = v;
                }
            }
            G8_WAIT_L(0); G8_BAR;
        }
    }
    G8_BAR;
}

#define XU_LOOP(nM_, nN_) const int xu_x = BID & 7, xu_nb = gridDim.x >> 3, xu_own = ((nM_) - xu_x + 7) >> 3, xu_nN = (nN_); for (int xv = BID >> 3; xv < xu_own * xu_nN; xv += xu_nb)
#define XU_UNIT() ((xu_x + 8 * (xv / xu_nN)) * xu_nN + (xv % xu_nN))
#define XU_NEXT_OK ((xv + xu_nb) < xu_own * xu_nN)
#define XU_NEXT_UNIT() ((xu_x + 8 * ((xv + xu_nb) / xu_nN)) * xu_nN + ((xv + xu_nb) % xu_nN))
__device__ __forceinline__ void ph_inproj(const Params& pkv, KPtr kp_in, int wbase_in, int l, char* lds) {
    PH_HEAD
    const bf16_t* Bt = p.win_t + (size_t)l * NINP * 1024;
    const int ntn = NINP / 256, nunits = (NT / 256) * ntn;
    bool pre = false;
    XU_LOOP(NT / 256, ntn) {
        const int u = XU_UNIT();
        const int mt = u / ntn, nt = u % ntn, un = XU_NEXT_UNIT(), mt2 = un / ntn, nt2 = un % ntn;
        G8Next nx; nx.valid = 0; nx.rowidx = nullptr; nx.nvalid = 256; nx.A = p.xb + (size_t)mt2 * 256 * 1024; nx.Bt = Bt + (size_t)nt2 * 256 * 1024; nx.perm = !(nt2 == 0 || nt2 == 3 || nt2 == 4);
        const bool perm = !(nt == 0 || nt == 3 || nt == 4);
        bf16_t* out = p.pbuf + (size_t)mt * 256 * NINP + nt * 256;
        const float* tabr = p.tab_ret; const float* tabd = p.tab_dil; bf16_t* rqb = (bf16_t*)p.rq; bf16_t* rkb = (bf16_t*)p.rk; bf16_t* dqb = (bf16_t*)p.dq; bf16_t* dkb = (bf16_t*)p.dk;
        G8Out so; so.out = out; so.ld = NINP; so.w = perm ? 256 : 0;
        gemm_tile256(p.xb + (size_t)mt * 256 * 1024, 1024, nullptr, 256, Bt + (size_t)nt * 256 * 1024, 1024, 1024, lds, wbase_in, pre, nx, perm, so,
                     [=](int r, int c, f32x4 v0, f32x4 v1) mutable {
                         const int pos = (mt * 256 + r) % SEQ; const size_t t = (size_t)mt * 256 + r;
                         if (nt == 0) {
                             const int i0 = c & 15, hc = c & 127; const bool isk = c >= 128;
                             const f32x4 cs0 = *(const f32x4*)(tabr + (pos * 16 + i0) * 2), cs1 = *(const f32x4*)(tabr + (pos * 16 + i0) * 2 + 4);
                             const float sc = isk ? 0.17677669529663687f : 1.0f;
                             const f32x4 a = v0 * sc, b = v1 * sc;
                             v0[0] = a[0] * cs0[0] - b[0] * cs0[1]; v1[0] = a[0] * cs0[1] + b[0] * cs0[0]; v0[1] = a[1] * cs0[2] - b[1] * cs0[3]; v1[1] = a[1] * cs0[3] + b[1] * cs0[2];
                             v0[2] = a[2] * cs1[0] - b[2] * cs1[1]; v1[2] = a[2] * cs1[1] + b[2] * cs1[0]; v0[3] = a[3] * cs1[2] - b[3] * cs1[3]; v1[3] = a[3] * cs1[3] + b[3] * cs1[2];
                             bf16_t* dst = (isk ? rkb : rqb) + t * 128 + hc;
                             uint2 o; o.x = cvtpk(v0[0], v0[1]); o.y = cvtpk(v0[2], v0[3]); *(uint2*)dst = o; o.x = cvtpk(v1[0], v1[1]); o.y = cvtpk(v1[2], v1[3]); *(uint2*)(dst + 16) = o;
                         } else if (nt == 3 || nt == 4) {
                             const float sc = (nt == 3) ? (0.125f * 1.4426950408889634f) : 1.0f;
                             v0 = v0 * sc; v1 = v1 * sc;
                             if ((c & 32) == 0) {
                                 f32x4 pv;
#pragma unroll
                                 for (int j = 0; j < 4; ++j) { auto rr = __builtin_amdgcn_permlane32_swap(__float_as_uint(v0[j]), __float_as_uint(v0[j]), false, false); pv[j] = __uint_as_float((c & 8) ? rr[0] : rr[1]); }
                                 const int i0 = c & 7;
                                 const f32x4 cs0 = *(const f32x4*)(tabd + (pos * 8 + i0) * 2), cs1 = *(const f32x4*)(tabd + (pos * 8 + i0) * 2 + 4);
                                 const f32x4 own = v0;
                                 if ((c & 8) == 0) { v0[0] = own[0] * cs0[0] - pv[0] * cs0[1]; v0[1] = own[1] * cs0[2] - pv[1] * cs0[3]; v0[2] = own[2] * cs1[0] - pv[2] * cs1[1]; v0[3] = own[3] * cs1[2] - pv[3] * cs1[3]; }
                                 else { v0[0] = pv[0] * cs0[1] + own[0] * cs0[0]; v0[1] = pv[1] * cs0[3] + own[1] * cs0[2]; v0[2] = pv[2] * cs1[1] + own[2] * cs1[0]; v0[3] = pv[3] * cs1[3] + own[3] * cs1[2]; }
                             }
                             bf16_t* dst = ((nt == 3) ? dqb : dkb) + t * 256 + c;
                             uint2 o; o.x = cvtpk(v0[0], v0[1]); o.y = cvtpk(v0[2], v0[3]); *(uint2*)dst = o; o.x = cvtpk(v1[0], v1[1]); o.y = cvtpk(v1[2], v1[3]); *(uint2*)(dst + 16) = o;
                         } else {
                             u32x4 o; o[0] = cvtpk(v0[0], v0[1]); o[1] = cvtpk(v0[2], v0[3]); o[2] = cvtpk(v1[0], v1[1]); o[3] = cvtpk(v1[2], v1[3]); return o;
                         }
                         return (u32x4){0u, 0u, 0u, 0u}; });
        pre = nx.valid != 0;
    }
}

__device__ __forceinline__ void ph_rope_prep(const Params& pkv, KPtr kp_in, int wbase_in, int l) {
    PH_HEAD
    const int lane = TID & 63, gw = BID * (NTHREADS / 64) + (TID >> 6), nw = gridDim.x * (NTHREADS / 64);
#pragma unroll 2
    for (int t = gw; t < NT; t += nw) {
        const int pos = t % SEQ;
        const bf16_t* pr = p.pbuf + (size_t)t * NINP;
        {
            float ss = 0.f;
            for (int e = lane; e < 256; e += 64) { const float v = bf2f(pr[PC_MQ + e]); ss += v * v; }
            ss = wave_sum(ss);
            float s2 = 0.f;
            for (int e = lane; e < 128; e += 64) { const float v = bf2f(pr[PC_MKV + e]); s2 += v * v; }
            s2 = wave_sum(s2);
            if (lane == 0) { p.rsq[t] = rsqrtf(ss * (1.0f / 256.0f) + 1e-6f); p.rskv[t] = rsqrtf(s2 * (1.0f / 128.0f) + 1e-6f); }
            if (lane < 16) {
                const float c = p.tab_mla[(pos * 16 + lane) * 2], s = p.tab_mla[(pos * 16 + lane) * 2 + 1];
                const float x1 = bf2f(pr[PC_MKR + lane]), x2 = bf2f(pr[PC_MKR + 16 + lane]);
                const bf16_t k1 = f2bf(x1 * c - x2 * s), k2 = f2bf(x1 * s + x2 * c);
#pragma unroll
                for (int hd = 0; hd < 4; ++hd) { p.mk[((size_t)t * 4 + hd) * 96 + 64 + lane] = k1; p.mk[((size_t)t * 4 + hd) * 96 + 80 + lane] = k2; }
            }
        }
    }
}

__device__ __forceinline__ float ret_log_gamma(int h) { return logf(1.0f - exp2f(-5.0f - (float)h)); }

__device__ __forceinline__ void ph_ret_kv(const Params& pkv, KPtr kp_in, int wbase_in, int l, char* lds) {
    PH_HEAD
    float* kz = (float*)lds;
    float* vs = kz + 128 * 32;
    const int tid = TID;
    for (int u = BID; u < NBATCH * NCH * 4; u += gridDim.x) {
        const int h = u & 3, n = (u >> 2) & 63, b = u >> 8;
        const float lg = ret_log_gamma(h);
        const int t0 = b * SEQ + n * BLK;
        __syncthreads();
        for (int e = tid; e < 128 * 32; e += NTHREADS) { const int j = e >> 5, d = e & 31; kz[e] = bf2f(((const bf16_t*)p.rk)[(size_t)(t0 + j) * 128 + h * 32 + d]) * __expf((float)(BLK - 1 - j) * lg); }
        for (int e = tid; e < 128 * 64; e += NTHREADS) { const int j = e >> 6, c = e & 63; vs[e] = bf2f(p.pbuf[(size_t)(t0 + j) * NINP + PC_RV + h * 64 + c]); }
        __syncthreads();
        const int e = tid & 63, d0 = (tid >> 6) * 4;
        float a0 = 0.f, a1 = 0.f, a2 = 0.f, a3 = 0.f;
#pragma unroll 8
        for (int j = 0; j < BLK; ++j) {
            const float vv = vs[j * 64 + e]; const float4 kk = *(const float4*)(kz + j * 32 + d0);
            a0 += kk.x * vv; a1 += kk.y * vv; a2 += kk.z * vv; a3 += kk.w * vv;
        }
        float* out = p.rkv + (size_t)u * 2048;
        out[(d0 + 0) * 64 + e] = a0; out[(d0 + 1) * 64 + e] = a1; out[(d0 + 2) * 64 + e] = a2; out[(d0 + 3) * 64 + e] = a3;
    }
}
__device__ __forceinline__ void ph_ret_scan(const Params& pkv, KPtr kp_in, int wbase_in, int l) {
    PH_HEAD
    const int i = BID * NTHREADS + TID;
    if (i < NBATCH * 4 * 32 * 64) {
        const int e = i & 63, d = (i >> 6) & 31, h = (i >> 11) & 3, b = i >> 13;
        const float cd = __expf((float)BLK * ret_log_gamma(h));
        float s = 0.f;
        for (int n = 0; n < NCH; ++n) {
            const size_t idx = ((((size_t)b * NCH + n) * 4 + h) * 32 + d) * 64 + e;
            p.rstate[idx] = s; s = cd * s + p.rkv[idx];
        }
    }
}
__device__ __forceinline__ void ph_ret_out(const Params& pkv, KPtr kp_in, int wbase_in, int l, char* lds) {
    PH_HEAD
    constexpr int KSTR = 40, VSTR = 132, SSTR = 40, UNIT_BYTES = (128 * KSTR + 64 * VSTR + 64 * SSTR) * 2;
    const int tid = TID, lane = tid & 63, wv = tid >> 6, hb = wv >> 2, w = wv & 3, r = lane & 31, hh = lane >> 5, ht = tid & 255;
    bf16_t* Ks = (bf16_t*)(lds + hb * UNIT_BYTES);
    bf16_t* Vt = Ks + 128 * KSTR;
    bf16_t* St = Vt + 64 * VSTR;
    const bf16_t* rqb = (const bf16_t*)p.rq; const bf16_t* rkb = (const bf16_t*)p.rk;
    int* wq = p.wq + l * 16 + 2;
    volatile int* wslot = (volatile int*)(lds + 2 * UNIT_BYTES);
    for (;;) {
        __syncthreads();
        if (tid == 0) *wslot = atomicAdd(wq, 1);
        __syncthreads();
        const int u0 = __builtin_amdgcn_readfirstlane(*wslot) * 2;
        if (u0 >= NBATCH * NCH * 4) break;
        const int u = u0 + hb, h = u & 3, n = (u >> 2) & 63, b = u >> 8;
        const int t0 = b * SEQ + n * BLK;
        const float lg2 = ret_log_gamma(h) * 1.4426950408889634f;
        __syncthreads();
#pragma unroll
        for (int i = 0; i < 2; ++i) { const int c = ht + i * 256, key = c >> 2, ch = c & 3; *(u32x4*)(Ks + key * KSTR + ch * 8) = *(const u32x4*)(rkb + (size_t)(t0 + key) * 128 + h * 32 + ch * 8); }
#pragma unroll
        for (int i = 0; i < 4; ++i) {
            const int c = ht + i * 256, key = c & 127, ch = c >> 7;
            const u32x4 rv = *(const u32x4*)(p.pbuf + (size_t)(t0 + key) * NINP + PC_RV + h * 64 + ch * 8);
            bf16_t* vd = Vt + (ch * 8) * VSTR + key;
            vd[0] = (bf16_t)(rv[0] & 0xffff); vd[VSTR] = (bf16_t)(rv[0] >> 16); vd[2 * VSTR] = (bf16_t)(rv[1] & 0xffff); vd[3 * VSTR] = (bf16_t)(rv[1] >> 16);
            vd[4 * VSTR] = (bf16_t)(rv[2] & 0xffff); vd[5 * VSTR] = (bf16_t)(rv[2] >> 16); vd[6 * VSTR] = (bf16_t)(rv[3] & 0xffff); vd[7 * VSTR] = (bf16_t)(rv[3] >> 16);
        }
        {
            const float* st = p.rstate + (size_t)u * 2048;
#pragma unroll
            for (int i = 0; i < 8; ++i) { const int c = ht + i * 256, d = c >> 6, e = c & 63; St[e * SSTR + d] = f2bf(st[c]); }
        }
        __syncthreads();
        const int iq = 32 * w + r, t = t0 + iq;
        bf16x8 qf[2];
#pragma unroll
        for (int s = 0; s < 2; ++s) qf[s] = *(const bf16x8*)(rqb + (size_t)t * 128 + h * 32 + 16 * s + 8 * hh);
        f32x16 o0, o1;
#pragma unroll
        for (int i = 0; i < 16; ++i) { o0[i] = 0.f; o1[i] = 0.f; }
#pragma unroll
        for (int s = 0; s < 2; ++s) {
            const bf16x8 sa0 = *(const bf16x8*)(St + r * SSTR + 16 * s + 8 * hh), sa1 = *(const bf16x8*)(St + (32 + r) * SSTR + 16 * s + 8 * hh);
            o0 = __builtin_amdgcn_mfma_f32_32x32x16_bf16(sa0, qf[s], o0, 0, 0, 0);
            o1 = __builtin_amdgcn_mfma_f32_32x32x16_bf16(sa1, qf[s], o1, 0, 0, 0);
        }
        {
            const float xi = __builtin_amdgcn_exp2f((float)(iq + 1) * lg2);
#pragma unroll
            for (int i = 0; i < 16; ++i) { o0[i] *= xi; o1[i] *= xi; }
        }
        float cdec[16];
#pragma unroll
        for (int i = 0; i < 16; ++i) cdec[i] = __builtin_amdgcn_exp2f(-(float)((i & 3) + 8 * (i >> 2) + 4 * hh) * lg2);
        for (int jt = 0; jt <= w; ++jt) {
            f32x16 st;
#pragma unroll
            for (int i = 0; i < 16; ++i) st[i] = 0.f;
#pragma unroll
            for (int s = 0; s < 2; ++s) { const bf16x8 kf = *(const bf16x8*)(Ks + (32 * jt + r) * KSTR + 16 * s + 8 * hh); st = __builtin_amdgcn_mfma_f32_32x32x16_bf16(kf, qf[s], st, 0, 0, 0); }
            const float al = __builtin_amdgcn_exp2f((float)(32 * (w - jt) + r) * lg2);
            if (jt == w) {
#pragma unroll
                for (int i = 0; i < 16; ++i) { const int kr = (i & 3) + 8 * (i >> 2) + 4 * hh; st[i] = (kr <= r) ? st[i] * (al * cdec[i]) : 0.f; }
            } else {
#pragma unroll
                for (int i = 0; i < 16; ++i) st[i] *= al * cdec[i];
            }
#pragma unroll
            for (int s = 0; s < 2; ++s) {
                u32x4 pw; pw[0] = cvtpk(st[8 * s], st[8 * s + 1]); pw[1] = cvtpk(st[8 * s + 2], st[8 * s + 3]); pw[2] = cvtpk(st[8 * s + 4], st[8 * s + 5]); pw[3] = cvtpk(st[8 * s + 6], st[8 * s + 7]);
                const bf16x8 pf = __builtin_bit_cast(bf16x8, pw);
                const bf16_t* va = Vt + r * VSTR + 32 * jt + 16 * s + 4 * hh;
                const s16x4 a0 = *(const s16x4*)(va), a1 = *(const s16x4*)(va + 8), b0 = *(const s16x4*)(va + 32 * VSTR), b1 = *(const s16x4*)(va + 32 * VSTR + 8);
                o0 = __builtin_amdgcn_mfma_f32_32x32x16_bf16(__builtin_shufflevector(a0, a1, 0, 1, 2, 3, 4, 5, 6, 7), pf, o0, 0, 0, 0);
                o1 = __builtin_amdgcn_mfma_f32_32x32x16_bf16(__builtin_shufflevector(b0, b1, 0, 1, 2, 3, 4, 5, 6, 7), pf, o1, 0, 0, 0);
            }
        }
        float ss = 0.f;
#pragma unroll
        for (int i = 0; i < 16; ++i) ss += o0[i] * o0[i] + o1[i] * o1[i];
        ss = xhalf_sum(ss);
        const float rs = rsqrtf(ss * (1.0f / 64.0f) + 1e-6f);
        const float* ng = p.ret_norm_g + l * 256 + h * 64 + 4 * hh;
        const bf16_t* gp = p.pbuf + (size_t)t * NINP + PC_RG + h * 64 + 4 * hh;
        bf16_t* outp = p.mixcat + (size_t)t * 1024 + h * 64 + 4 * hh;
#pragma unroll
        for (int c = 0; c < 2; ++c)
#pragma unroll
            for (int g = 0; g < 4; ++g) {
                const int eo = 32 * c + 8 * g;
                const f32x4 gn = *(const f32x4*)(ng + eo); const uint2 gu = *(const uint2*)(gp + eo);
                const float g0 = __uint_as_float(gu.x << 16), g1 = __uint_as_float(gu.x & 0xffff0000u), g2 = __uint_as_float(gu.y << 16), g3 = __uint_as_float(gu.y & 0xffff0000u);
                const float v0 = (c ? o1[4 * g] : o0[4 * g]) * rs * gn[0], v1 = (c ? o1[4 * g + 1] : o0[4 * g + 1]) * rs * gn[1], v2 = (c ? o1[4 * g + 2] : o0[4 * g + 2]) * rs * gn[2], v3 = (c ? o1[4 * g + 3] : o0[4 * g + 3]) * rs * gn[3];
                uint2 ov; ov.x = cvtpk(g0 * sigmoidf_(g0) * v0, g1 * sigmoidf_(g1) * v1); ov.y = cvtpk(g2 * sigmoidf_(g2) * v2, g3 * sigmoidf_(g3) * v3);
                *(uint2*)(outp + eo) = ov;
            }
    }
}

__device__ __forceinline__ void ph_dil_attn(const Params& pkv, KPtr kp_in, int wbase_in, int l, char* lds) {
    PH_HEAD
    constexpr int KSTR = 72, VSTR = 68;
    bf16_t* Ks = (bf16_t*)lds;
    bf16_t* Vt = Ks + 64 * KSTR;
    const int tid = TID, lane = tid & 63, wv = tid >> 6, r = lane & 31, h = lane >> 5;
    int* wq = p.wq + l * 16 + 1;
    volatile int* wslot = (volatile int*)(lds + 24576);
    for (;;) {
        __syncthreads();
        if (tid == 0) *wslot = atomicAdd(wq, 1);
        __syncthreads();
        const int it = __builtin_amdgcn_readfirstlane(*wslot);
        if (it >= 16 * 96) break;
        const int bh = it & 15, u = it >> 4;
        const int b = bh >> 2, hd = bh & 3;
        int pat, dil, rr, m0;
        if (u < 32) { pat = 0; dil = 1; rr = 0; m0 = u * 256; }
        else if (u < 64) { pat = 1; dil = 4; rr = (u - 32) >> 3; m0 = ((u - 32) & 7) * 256; }
        else { pat = 2; dil = 16; rr = (u - 64) >> 1; m0 = ((u - 64) & 1) * 256; }
        const int qmin = m0 + 32 * wv, qmax = qmin + 31, myq = qmin + r;
        const size_t tok0 = (size_t)b * SEQ + rr;
        bf16x8 qf[4];
        {
            const bf16_t* qrow = (const bf16_t*)p.dq + (tok0 + (size_t)dil * myq) * 256 + hd * 64 + 8 * h;
#pragma unroll
            for (int s = 0; s < 4; ++s) qf[s] = *(const bf16x8*)(qrow + 16 * s);
        }
        f32x16 o0, o1;
#pragma unroll
        for (int i = 0; i < 16; ++i) { o0[i] = 0.f; o1[i] = 0.f; }
        float m = -1e30f, lsum = 0.f;
        const int kk = tid >> 3, kc = tid & 7, vk = tid & 63, vc = tid >> 6;
        const bf16_t* kbase = (const bf16_t*)p.dk + hd * 64 + kc * 8;
        const bf16_t* vbase = p.pbuf + PC_DV + hd * 64 + vc * 8;
        const int j0 = (m0 == 0) ? 2 : 0;
        u32x4 rk, rv;
        {
            const int kb = m0 - 128 + 64 * j0;
            rk = *(const u32x4*)(kbase + (tok0 + (size_t)dil * (kb + kk)) * 256);
            rv = *(const u32x4*)(vbase + (tok0 + (size_t)dil * (kb + vk)) * NINP);
        }
        for (int j = j0; j < 6; ++j) {
            __syncthreads();
            *(u32x4*)(Ks + kk * KSTR + kc * 8) = rk;
            {
                const unsigned w0 = rv[0], w1 = rv[1], w2 = rv[2], w3 = rv[3];
                bf16_t* vd = Vt + (vc * 8) * VSTR + vk;
                vd[0] = (bf16_t)(w0 & 0xffff); vd[VSTR] = (bf16_t)(w0 >> 16); vd[2 * VSTR] = (bf16_t)(w1 & 0xffff); vd[3 * VSTR] = (bf16_t)(w1 >> 16);
                vd[4 * VSTR] = (bf16_t)(w2 & 0xffff); vd[5 * VSTR] = (bf16_t)(w2 >> 16); vd[6 * VSTR] = (bf16_t)(w3 & 0xffff); vd[7 * VSTR] = (bf16_t)(w3 >> 16);
            }
            __syncthreads();
            const int kb = m0 - 128 + 64 * j;
            if (j + 1 < 6) {
                const int kn = kb + 64;
                rk = *(const u32x4*)(kbase + (tok0 + (size_t)dil * (kn + kk)) * 256);
                rv = *(const u32x4*)(vbase + (tok0 + (size_t)dil * (kn + vk)) * NINP);
            }
            const bool need0 = (kb <= qmax) && (kb + 31 >= qmin - 128);
            const bool need1 = (kb + 32 <= qmax) && (kb + 63 >= qmin - 128);
            if (need0 || need1) {
                f32x16 s0, s1;
#pragma unroll
                for (int i = 0; i < 16; ++i) { s0[i] = -3e38f; s1[i] = -3e38f; }
                if (need0) {
#pragma unroll
                    for (int i = 0; i < 16; ++i) s0[i] = 0.f;
#pragma unroll
                    for (int s = 0; s < 4; ++s) { const bf16x8 kf = *(const bf16x8*)(Ks + r * KSTR + 16 * s + 8 * h); s0 = __builtin_amdgcn_mfma_f32_32x32x16_bf16(kf, qf[s], s0, 0, 0, 0); }
                    if (!((kb + 31 <= qmin) && (kb >= qmax - 128))) {
#pragma unroll
                        for (int i = 0; i < 16; ++i) { const int key = kb + (i & 3) + 8 * (i >> 2) + 4 * h; if (key > myq || key < myq - 128) s0[i] = -3e38f; }
                    }
                }
                if (need1) {
#pragma unroll
                    for (int i = 0; i < 16; ++i) s1[i] = 0.f;
#pragma unroll
                    for (int s = 0; s < 4; ++s) { const bf16x8 kf = *(const bf16x8*)(Ks + (32 + r) * KSTR + 16 * s + 8 * h); s1 = __builtin_amdgcn_mfma_f32_32x32x16_bf16(kf, qf[s], s1, 0, 0, 0); }
                    if (!((kb + 63 <= qmin) && (kb + 32 >= qmax - 128))) {
#pragma unroll
                        for (int i = 0; i < 16; ++i) { const int key = kb + 32 + (i & 3) + 8 * (i >> 2) + 4 * h; if (key > myq || key < myq - 128) s1[i] = -3e38f; }
                    }
                }
                float mx = s0[0];
#pragma unroll
                for (int i = 1; i < 16; ++i) mx = fmaxf(mx, s0[i]);
#pragma unroll
                for (int i = 0; i < 16; ++i) mx = fmaxf(mx, s1[i]);
                mx = xhalf_max(mx);
                const float mn = fmaxf(m, mx), alpha = __builtin_amdgcn_exp2f(m - mn);
                m = mn;
                float ps = 0.f;
                if (need0) {
#pragma unroll
                    for (int i = 0; i < 16; ++i) { s0[i] = __builtin_amdgcn_exp2f(s0[i] - mn); ps += s0[i]; }
                }
                if (need1) {
#pragma unroll
                    for (int i = 0; i < 16; ++i) { s1[i] = __builtin_amdgcn_exp2f(s1[i] - mn); ps += s1[i]; }
                }
                lsum = lsum * alpha + ps;
                if (!__all(alpha == 1.0f)) {
#pragma unroll
                    for (int i = 0; i < 16; ++i) { o0[i] *= alpha; o1[i] *= alpha; }
                }
                if (need0) {
#pragma unroll
                    for (int s = 0; s < 2; ++s) {
                        u32x4 pw; pw[0] = cvtpk(s0[8 * s], s0[8 * s + 1]); pw[1] = cvtpk(s0[8 * s + 2], s0[8 * s + 3]); pw[2] = cvtpk(s0[8 * s + 4], s0[8 * s + 5]); pw[3] = cvtpk(s0[8 * s + 6], s0[8 * s + 7]);
                        const bf16x8 pf = __builtin_bit_cast(bf16x8, pw);
                        const bf16_t* va = Vt + r * VSTR + 16 * s + 4 * h;
                        const s16x4 a0 = *(const s16x4*)(va), a1 = *(const s16x4*)(va + 8), b0 = *(const s16x4*)(va + 32 * VSTR), b1 = *(const s16x4*)(va + 32 * VSTR + 8);
                        o0 = __builtin_amdgcn_mfma_f32_32x32x16_bf16(__builtin_shufflevector(a0, a1, 0, 1, 2, 3, 4, 5, 6, 7), pf, o0, 0, 0, 0);
                        o1 = __builtin_amdgcn_mfma_f32_32x32x16_bf16(__builtin_shufflevector(b0, b1, 0, 1, 2, 3, 4, 5, 6, 7), pf, o1, 0, 0, 0);
                    }
                }
                if (need1) {
#pragma unroll
                    for (int s = 0; s < 2; ++s) {
                        u32x4 pw; pw[0] = cvtpk(s1[8 * s], s1[8 * s + 1]); pw[1] = cvtpk(s1[8 * s + 2], s1[8 * s + 3]); pw[2] = cvtpk(s1[8 * s + 4], s1[8 * s + 5]); pw[3] = cvtpk(s1[8 * s + 6], s1[8 * s + 7]);
                        const bf16x8 pf = __builtin_bit_cast(bf16x8, pw);
                        const bf16_t* va = Vt + r * VSTR + 32 + 16 * s + 4 * h;
                        const s16x4 a0 = *(const s16x4*)(va), a1 = *(const s16x4*)(va + 8), b0 = *(const s16x4*)(va + 32 * VSTR), b1 = *(const s16x4*)(va + 32 * VSTR + 8);
                        o0 = __builtin_amdgcn_mfma_f32_32x32x16_bf16(__builtin_shufflevector(a0, a1, 0, 1, 2, 3, 4, 5, 6, 7), pf, o0, 0, 0, 0);
                        o1 = __builtin_amdgcn_mfma_f32_32x32x16_bf16(__builtin_shufflevector(b0, b1, 0, 1, 2, 3, 4, 5, 6, 7), pf, o1, 0, 0, 0);
                    }
                }
            }
        }
        const float lt = xhalf_sum(lsum), inv = 1.0f / lt;
        const size_t tq = tok0 + (size_t)dil * myq;
        float* op = p.dob + ((size_t)pat * NT + tq) * 256 + hd * 64 + 4 * h;
#pragma unroll
        for (int g = 0; g < 4; ++g) {
            *(f32x4*)(op + 8 * g) = (f32x4){o0[4 * g] * inv, o0[4 * g + 1] * inv, o0[4 * g + 2] * inv, o0[4 * g + 3] * inv};
            *(f32x4*)(op + 32 + 8 * g) = (f32x4){o1[4 * g] * inv, o1[4 * g + 1] * inv, o1[4 * g + 2] * inv, o1[4 * g + 3] * inv};
        }
        if (h == 0) p.dlse[((size_t)pat * NT + tq) * 4 + hd] = m + __builtin_amdgcn_logf(lt);
        __syncthreads();
    }
}

__device__ __forceinline__ void ph_rwkv_prep(const Params& pkv, KPtr kp_in, int wbase_in, int l, char* lds) {
    PH_HEAD
    bf16_t* Aw = (bf16_t*)lds; bf16_t* Aa = Aw + 64 * 72; bf16_t* Ag = Aa + 64 * 72; bf16_t* Av = Ag + 64 * 136; float* ssq = (float*)(Av + 64 * 40);
    const int tid = TID, lane = tid & 63, wv = tid >> 6, fr = lane & 15, fq = lane >> 4;
    const int lm = (l > 0) ? l - 1 : 0;
    const float* mu = p.rwkv_mu + l * 1024; const float* vmu = p.vres_mu + lm * 32;
    bf16x8 fw[2][2], fa[2][2], fg[2][4], fv[2];
#pragma unroll
    for (int ni = 0; ni < 2; ++ni) {
        const int n = 32 * wv + 16 * ni + fr;
#pragma unroll
        for (int ks = 0; ks < 2; ++ks) { fw[ni][ks] = *(const bf16x8*)(p.wupt + ((size_t)l * 256 + n) * 64 + 32 * ks + 8 * fq); fa[ni][ks] = *(const bf16x8*)(p.aupt + ((size_t)l * 256 + n) * 64 + 32 * ks + 8 * fq); }
#pragma unroll
        for (int ks = 0; ks < 4; ++ks) fg[ni][ks] = *(const bf16x8*)(p.gupt + ((size_t)l * 256 + n) * 128 + 32 * ks + 8 * fq);
        fv[ni] = *(const bf16x8*)(p.vupt + ((size_t)lm * 256 + n) * 32 + 8 * fq);
    }
    for (int tb = BID * 64; tb < NT; tb += gridDim.x * 64) {
        __syncthreads();
        for (int e = tid; e < 64 * 144; e += NTHREADS) {
            const int tt = e / 144, j = (e % 144) * 2, t = tb + tt;
            const bool first = (t % SEQ) == 0;
            const bf16_t* pr = p.pbuf + (size_t)t * NINP;
            int col; float m0, m1;
            if (j < 256) { col = PC_CWD + j; m0 = mu[768 + j]; m1 = mu[768 + j + 1]; } else { col = PC_VRES + (j - 256); m0 = vmu[j - 256]; m1 = vmu[j - 255]; }
            const unsigned cu = *(const unsigned*)(pr + col), pu = first ? 0u : *(const unsigned*)(pr + col - NINP);
            const float c0 = __uint_as_float(cu << 16), c1 = __uint_as_float(cu & 0xffff0000u), p0 = __uint_as_float(pu << 16), p1 = __uint_as_float(pu & 0xffff0000u);
            float x0 = c0 + (p0 - c0) * m0, x1 = c1 + (p1 - c1) * m1;
            bf16_t* dst;
            if (j < 64) { x0 = 1.0f - 2.0f * __builtin_amdgcn_rcpf(__builtin_amdgcn_exp2f(x0 * 2.8853900817779268f) + 1.0f); x1 = 1.0f - 2.0f * __builtin_amdgcn_rcpf(__builtin_amdgcn_exp2f(x1 * 2.8853900817779268f) + 1.0f); dst = Aw + tt * 72 + j; }
            else if (j < 128) { dst = Aa + tt * 72 + (j - 64); }
            else if (j < 256) { x0 = sigmoidf_(x0); x1 = sigmoidf_(x1); dst = Ag + tt * 136 + (j - 128); }
            else { dst = Av + tt * 40 + (j - 256); }
            *(unsigned*)dst = cvtpk(x0, x1);
        }
        {
            const f32x4 kkc = *(const f32x4*)(p.rwkv_k_k + l * 256 + lane * 4), mk4 = *(const f32x4*)(mu + 256 + lane * 4);
#pragma unroll
            for (int i = 0; i < 8; ++i) {
                const int tt = wv * 8 + i, t = tb + tt; const bool first = (t % SEQ) == 0;
                const bf16_t* pr = p.pbuf + (size_t)t * NINP + PC_CK + lane * 4;
                const uint2 cu = *(const uint2*)pr; const uint2 pu = first ? make_uint2(0u, 0u) : *(const uint2*)(pr - NINP);
                const float c0 = __uint_as_float(cu.x << 16), c1 = __uint_as_float(cu.x & 0xffff0000u), c2 = __uint_as_float(cu.y << 16), c3 = __uint_as_float(cu.y & 0xffff0000u);
                const float q0 = __uint_as_float(pu.x << 16), q1 = __uint_as_float(pu.x & 0xffff0000u), q2 = __uint_as_float(pu.y << 16), q3 = __uint_as_float(pu.y & 0xffff0000u);
                const float k0 = (c0 + (q0 - c0) * mk4[0]) * kkc[0], k1 = (c1 + (q1 - c1) * mk4[1]) * kkc[1], k2 = (c2 + (q2 - c2) * mk4[2]) * kkc[2], k3 = (c3 + (q3 - c3) * mk4[3]) * kkc[3];
                const float ss = grp16_sum(k0 * k0 + k1 * k1 + k2 * k2 + k3 * k3);
                if ((lane & 15) == 0) ssq[tt * 4 + (lane >> 4)] = ss;
            }
        }
        __syncthreads();
#pragma unroll 1
        for (int mt = 0; mt < 4; ++mt) {
            f32x4 cw[2], ca[2], cg[2], cv[2];
#pragma unroll
            for (int ni = 0; ni < 2; ++ni) { cw[ni] = (f32x4){0.f, 0.f, 0.f, 0.f}; ca[ni] = cw[ni]; cg[ni] = cw[ni]; cv[ni] = cw[ni]; }
            const int arow = 16 * mt + fr;
#pragma unroll
            for (int ks = 0; ks < 2; ++ks) {
                const bf16x8 xw = *(const bf16x8*)(Aw + arow * 72 + 32 * ks + 8 * fq), xa = *(const bf16x8*)(Aa + arow * 72 + 32 * ks + 8 * fq);
#pragma unroll
                for (int ni = 0; ni < 2; ++ni) { cw[ni] = __builtin_amdgcn_mfma_f32_16x16x32_bf16(fw[ni][ks], xw, cw[ni], 0, 0, 0); ca[ni] = __builtin_amdgcn_mfma_f32_16x16x32_bf16(fa[ni][ks], xa, ca[ni], 0, 0, 0); }
            }
#pragma unroll
            for (int ks = 0; ks < 4; ++ks) {
                const bf16x8 xg = *(const bf16x8*)(Ag + arow * 136 + 32 * ks + 8 * fq);
#pragma unroll
                for (int ni = 0; ni < 2; ++ni) cg[ni] = __builtin_amdgcn_mfma_f32_16x16x32_bf16(fg[ni][ks], xg, cg[ni], 0, 0, 0);
            }
            if (l > 0) {
                const bf16x8 xv = *(const bf16x8*)(Av + arow * 40 + 8 * fq);
#pragma unroll
                for (int ni = 0; ni < 2; ++ni) cv[ni] = __builtin_amdgcn_mfma_f32_16x16x32_bf16(fv[ni], xv, cv[ni], 0, 0, 0);
            }
            const int tt = 16 * mt + fr, t = tb + tt; const bool first = (t % SEQ) == 0;
            const float rn = 1.0f / fmaxf(sqrtf(ssq[tt * 4 + (wv >> 1)]), 1e-12f);
            const bf16_t* pr = p.pbuf + (size_t)t * NINP;
#pragma unroll
            for (int ni = 0; ni < 2; ++ni) {
                const int c0 = 32 * wv + 16 * ni + 4 * fq;
                const f32x4 w0 = *(const f32x4*)(p.rwkv_w0 + l * 256 + c0), a0 = *(const f32x4*)(p.rwkv_a0 + l * 256 + c0), kkc = *(const f32x4*)(p.rwkv_k_k + l * 256 + c0), kac = *(const f32x4*)(p.rwkv_k_a + l * 256 + c0);
                const f32x4 v0 = *(const f32x4*)(p.rwkv_v0 + lm * 256 + c0), mr = *(const f32x4*)(mu + c0), mk = *(const f32x4*)(mu + 256 + c0), mv = *(const f32x4*)(mu + 512 + c0);
                const uint2 ru = *(const uint2*)(pr + PC_CR + c0), ku = *(const uint2*)(pr + PC_CK + c0), vu = *(const uint2*)(pr + PC_CV + c0);
                uint2 rp = make_uint2(0u, 0u), kp2 = rp, vp = rp;
                if (!first) { rp = *(const uint2*)(pr + PC_CR + c0 - NINP); kp2 = *(const uint2*)(pr + PC_CK + c0 - NINP); vp = *(const uint2*)(pr + PC_CV + c0 - NINP); }
                const size_t o = (size_t)t * 256 + c0;
                f32x4 vf = (f32x4){0.f, 0.f, 0.f, 0.f};
                if (l > 0) vf = *(const f32x4*)(p.vfirst + o);
                f32x4 o_r, o_w, o_k, o_v, o_a, o_b;
#pragma unroll
                for (int j = 0; j < 4; ++j) {
                    const unsigned rw = (j < 2) ? ru.x : ru.y, kw = (j < 2) ? ku.x : ku.y, vw = (j < 2) ? vu.x : vu.y, rpw = (j < 2) ? rp.x : rp.y, kpw = (j < 2) ? kp2.x : kp2.y, vpw = (j < 2) ? vp.x : vp.y;
                    const float rc = (j & 1) ? __uint_as_float(rw & 0xffff0000u) : __uint_as_float(rw << 16), kc = (j & 1) ? __uint_as_float(kw & 0xffff0000u) : __uint_as_float(kw << 16), vc = (j & 1) ? __uint_as_float(vw & 0xffff0000u) : __uint_as_float(vw << 16);
                    const float rq = (j & 1) ? __uint_as_float(rpw & 0xffff0000u) : __uint_as_float(rpw << 16), kq = (j & 1) ? __uint_as_float(kpw & 0xffff0000u) : __uint_as_float(kpw << 16), vq = (j & 1) ? __uint_as_float(vpw & 0xffff0000u) : __uint_as_float(vpw << 16);
                    const float r = rc + (rq - rc) * mr[j], k = kc + (kq - kc) * mk[j];
                    float v = vc + (vq - vc) * mv[j];
                    const float wpre = w0[j] + cw[ni][j];
                    const float sp = (-wpre > 20.f) ? -wpre : 0.6931471805599453f * __builtin_amdgcn_logf(1.0f + __builtin_amdgcn_exp2f(wpre * -1.4426950408889634f));
                    const float decay = __builtin_amdgcn_exp2f(-1.4426950408889634f * __builtin_amdgcn_exp2f((-sp - 0.5f) * 1.4426950408889634f));
                    const float a = sigmoidf_(a0[j] + ca[ni][j]);
                    const float kk = k * kkc[j] * rn;
                    const float k2 = k * (1.0f + (a - 1.0f) * kac[j]);
                    if (l == 0) vf[j] = v; else v = v + (vf[j] - v) * sigmoidf_(v0[j] + cv[ni][j]);
                    o_r[j] = r; o_w[j] = decay; o_k[j] = k2; o_v[j] = v; o_a[j] = -kk; o_b[j] = kk * a;
                }
                if (l == 0) *(f32x4*)(p.vfirst + o) = vf;
                *(f32x4*)(p.sr + o) = o_r; *(f32x4*)(p.sw + o) = o_w; *(f32x4*)(p.sk + o) = o_k; *(f32x4*)(p.sv + o) = o_v; *(f32x4*)(p.sa + o) = o_a; *(f32x4*)(p.sb + o) = o_b; *(f32x4*)(p.sg + o) = cg[ni];
            }
        }
    }
}

#define MF4(a, b, c) __builtin_amdgcn_mfma_f32_16x16x4f32((a), (b), (c), 0, 0, 0)
#define WSYNC() asm volatile("s_waitcnt lgkmcnt(0)" ::: "memory")
__device__ __forceinline__ f32x4 mm16(const float* A, int sam, int sak, const float* B, int sbk, int sbn, int K, f32x4 acc, int fr, int fq) {
#pragma unroll 4
    for (int kk = 0; kk < K; kk += 4) { const float a = A[fr * sam + (kk + fq) * sak]; const float b = B[(kk + fq) * sbk + fr * sbn]; acc = MF4(a, b, acc); }
    return acc;
}
constexpr int CH_T = 16, CH_N = SEQ / CH_T, CH_LD = 68, CH_WAVE_FLOATS = 6 * 16 * CH_LD + 5 * 16 * 17 + 64;
__device__ __forceinline__ void ph_rwkv_chunkpre(const Params& pkv, KPtr kp_in, int wbase_in, int l, char* lds) {
    PH_HEAD
    const int tid = TID, lane = tid & 63, wv = tid >> 6, fr = lane & 15, fq = lane >> 4;
    if (wv >= 4) return;
    float* L = (float*)lds + wv * CH_WAVE_FLOATS;
    float* At = L; float* Bt = At + 16 * CH_LD; float* Kt = Bt + 16 * CH_LD; float* Rt = Kt + 16 * CH_LD; float* Vv = Rt + 16 * CH_LD; float* W1 = Vv + 16 * CH_LD;
    float* Pst = (float*)lds + 4 * CH_WAVE_FLOATS + wv * 1024;
    float* Aab = W1 + 16 * CH_LD; float* Aak = Aab + 16 * 17; float* Arb = Aak + 16 * 17; float* Ark = Arb + 16 * 17; float* Mm = Ark + 16 * 17; float* gT = Mm + 16 * 17;
    const f32x4 z4 = (f32x4){0.f, 0.f, 0.f, 0.f};
    for (int u = BID * 4 + wv; u < 16 * CH_N; u += gridDim.x * 4) {
        const int bh = u / CH_N, c = u % CH_N, b = bh >> 2, hd = bh & 3;
        const size_t o0 = ((size_t)b * SEQ + (size_t)c * CH_T) * 256 + hd * 64 + lane;
        WSYNC();
        {
            float g = 1.0f;
#pragma unroll
            for (int t = 0; t < CH_T; ++t) {
                const size_t o = o0 + (size_t)t * 256;
                const float w = p.sw[o], a = p.sa[o], bb = p.sb[o], k = p.sk[o], r = p.sr[o], v = p.sv[o];
                const float gp = g; g *= w; const float ig = 1.0f / g;
                At[t * CH_LD + lane] = a * gp; Bt[t * CH_LD + lane] = bb * ig; Kt[t * CH_LD + lane] = k * ig; Rt[t * CH_LD + lane] = r * g; Vv[t * CH_LD + lane] = v;
            }
            gT[lane] = g;
        }
        WSYNC();
        {
            f32x4 gab = z4, gak = z4, grb = z4, grk = z4;
#pragma unroll 4
            for (int kk = 0; kk < 64; kk += 4) {
                const int o = fr * CH_LD + kk + fq;
                const float aA = At[o], aR = Rt[o], bB = Bt[o], bK = Kt[o];
                gab = MF4(aA, bB, gab); gak = MF4(aA, bK, gak); grb = MF4(aR, bB, grb); grk = MF4(aR, bK, grk);
            }
#pragma unroll
            for (int rg = 0; rg < 4; ++rg) {
                const int t = 4 * fq + rg, s = fr;
                Aab[t * 17 + s] = (s < t) ? gab[rg] : 0.f; Aak[t * 17 + s] = (s < t) ? gak[rg] : 0.f;
                Arb[t * 17 + s] = (s <= t) ? grb[rg] : 0.f; Ark[t * 17 + s] = (s <= t) ? grk[rg] : 0.f;
            }
        }
        WSYNC();
        {
            float m[16];
#pragma unroll
            for (int t = 0; t < 16; ++t) {
                float acc = (t == fr) ? 1.0f : 0.f;
#pragma unroll
                for (int s = 0; s < t; ++s) acc += Aab[t * 17 + s] * m[s];
                m[t] = acc;
            }
            if (fq == 0) {
#pragma unroll
                for (int t = 0; t < 16; ++t) Mm[t * 17 + fr] = m[t];
            }
        }
        WSYNC();
        {
            f32x4 m2 = z4, ah[4] = {z4, z4, z4, z4};
#pragma unroll
            for (int kk = 0; kk < 16; kk += 4) {
                const float a = Mm[fr * 17 + kk + fq];
                m2 = MF4(a, Aak[(kk + fq) * 17 + fr], m2);
#pragma unroll
                for (int nt = 0; nt < 4; ++nt) ah[nt] = MF4(a, At[(kk + fq) * CH_LD + 16 * nt + fr], ah[nt]);
            }
            WSYNC();
#pragma unroll
            for (int rg = 0; rg < 4; ++rg) {
                Aak[(4 * fq + rg) * 17 + fr] = m2[rg];
#pragma unroll
                for (int nt = 0; nt < 4; ++nt) At[(4 * fq + rg) * CH_LD + 16 * nt + fr] = ah[nt][rg];
            }
            WSYNC();
            f32x4 w1[4] = {z4, z4, z4, z4};
#pragma unroll
            for (int kk = 0; kk < 16; kk += 4) {
                const float a = Aak[fr * 17 + kk + fq];
#pragma unroll
                for (int nt = 0; nt < 4; ++nt) w1[nt] = MF4(a, Vv[(kk + fq) * CH_LD + 16 * nt + fr], w1[nt]);
            }
#pragma unroll
            for (int nt = 0; nt < 4; ++nt)
#pragma unroll
                for (int rg = 0; rg < 4; ++rg) W1[(4 * fq + rg) * CH_LD + 16 * nt + fr] = w1[nt][rg];
        }
        WSYNC();
        {
            float* rh = p.c_rh + (size_t)u * 1024; float* y1 = p.c_y1 + (size_t)u * 1024;
            f32x4 ar[4], yy[4];
#pragma unroll
            for (int nt = 0; nt < 4; ++nt) {
                yy[nt] = z4;
#pragma unroll
                for (int rg = 0; rg < 4; ++rg) ar[nt][rg] = Rt[(4 * fq + rg) * CH_LD + 16 * nt + fr];
            }
#pragma unroll
            for (int kk = 0; kk < 16; kk += 4) {
                const float arb = Arb[fr * 17 + kk + fq], ark = Ark[fr * 17 + kk + fq];
#pragma unroll
                for (int nt = 0; nt < 4; ++nt) {
                    const int bo = (kk + fq) * CH_LD + 16 * nt + fr;
                    ar[nt] = MF4(arb, At[bo], ar[nt]); yy[nt] = MF4(arb, W1[bo], yy[nt]); yy[nt] = MF4(ark, Vv[bo], yy[nt]);
                }
            }
#pragma unroll
            for (int nt = 0; nt < 4; ++nt)
#pragma unroll
                for (int rg = 0; rg < 4; ++rg) Pst[(4 * fq + rg) * 64 + 16 * nt + fr] = ar[nt][rg];
            WSYNC();
#pragma unroll
            for (int i = 0; i < 4; ++i) *(f32x4*)(rh + (i * 64 + lane) * 4) = *(const f32x4*)(Pst + (i * 64 + lane) * 4);
            WSYNC();
#pragma unroll
            for (int nt = 0; nt < 4; ++nt)
#pragma unroll
                for (int rg = 0; rg < 4; ++rg) Pst[(4 * fq + rg) * 64 + 16 * nt + fr] = yy[nt][rg];
            WSYNC();
#pragma unroll
            for (int i = 0; i < 4; ++i) *(f32x4*)(y1 + (i * 64 + lane) * 4) = *(const f32x4*)(Pst + (i * 64 + lane) * 4);
            WSYNC();
        }
        {
            float* pp = p.c_p + (size_t)u * 4096; float* qq = p.c_q + (size_t)u * 4096;
#pragma unroll 1
            for (int jt = 0; jt < 4; ++jt) {
                f32x4 ap[4] = {z4, z4, z4, z4}, aq[4] = {z4, z4, z4, z4};
#pragma unroll
                for (int kk = 0; kk < 16; kk += 4) {
                    const int ao = (kk + fq) * CH_LD + 16 * jt + fr;
                    const float a_ah = At[ao], a_w1 = W1[ao], a_v = Vv[ao];
#pragma unroll
                    for (int jc = 0; jc < 4; ++jc) {
                        const int bo = (kk + fq) * CH_LD + 16 * jc + fr;
                        const float b_bt = Bt[bo], b_kt = Kt[bo];
                        ap[jc] = MF4(a_ah, b_bt, ap[jc]); aq[jc] = MF4(a_w1, b_bt, aq[jc]); aq[jc] = MF4(a_v, b_kt, aq[jc]);
                    }
                }
                WSYNC();
#pragma unroll
                for (int jc = 0; jc < 4; ++jc) {
                    const float gc = gT[16 * jc + fr];
#pragma unroll
                    for (int rg = 0; rg < 4; ++rg) {
                        const int row = 16 * jt + 4 * fq + rg, col = 16 * jc + fr;
                        Pst[(jc * 64 + 16 * rg + fr) * 4 + fq] = (ap[jc][rg] + ((row == col) ? 1.0f : 0.f)) * gc; aq[jc][rg] *= gc;
                    }
                }
                WSYNC();
#pragma unroll
                for (int i = 0; i < 4; ++i) *(f32x4*)(pp + ((jt * 4 + i) * 64 + lane) * 4) = *(const f32x4*)(Pst + (i * 64 + lane) * 4);
                WSYNC();
#pragma unroll
                for (int jc = 0; jc < 4; ++jc)
#pragma unroll
                    for (int rg = 0; rg < 4; ++rg) Pst[(4 * fq + rg) * 64 + 16 * jc + fr] = aq[jc][rg];
                WSYNC();
#pragma unroll
                for (int i = 0; i < 4; ++i) *(f32x4*)(qq + (size_t)jt * 1024 + (i * 64 + lane) * 4) = *(const f32x4*)(Pst + (i * 64 + lane) * 4);
            }
        }
    }
}

constexpr int SCANB_BLOCKS = 64;
__device__ __forceinline__ void ph_rwkv_scan(const Params& pkv, KPtr kp_in, int wbase_in, int l, char* lds) {
    PH_HEAD
    if (BID >= SCANB_BLOCKS) return;
    const int tid = TID, lane = tid & 63, wv = tid >> 6, fr = lane & 15, fq = lane >> 4, w = wv & 3;
    const int bh = (BID & 7) + 8 * (BID >> 5), ib = (BID >> 3) & 3, b = bh >> 2, hd = bh & 3, ibase = ib * 16;
    float* exch = (float*)lds;
    float* ypart = (float*)lds + 4096;
    for (int i = tid; i < 8192; i += NTHREADS) ((float*)lds)[i] = 0.f;
    if (wv >= 4) {
        __syncthreads();
        for (int c = 0; c < CH_N; ++c) { __builtin_amdgcn_s_barrier(); }
        return;
    }
    f32x4 cur = (f32x4){0.f, 0.f, 0.f, 0.f};
    const size_t ubase = (size_t)bh * CH_N;
    f32x4 pa[4][4]; f32x4 qv[4], rh[4]; float y1v[4];
#define SCAN_LOAD(S, cc) do { const size_t un_ = ubase + ((cc) < CH_N ? (cc) : CH_N - 1); \
        const f32x4* pp_ = (const f32x4*)(p.c_p + un_ * 4096 + (w * 64 + lane) * 4); \
        pa[S][0] = pp_[0]; pa[S][1] = pp_[256]; pa[S][2] = pp_[512]; pa[S][3] = pp_[768]; \
        qv[S] = *(const f32x4*)(p.c_q + un_ * 4096 + (ibase + fr) * 64 + 16 * w + 4 * fq); \
        rh[S] = *(const f32x4*)(p.c_rh + un_ * 1024 + fr * 64 + 16 * w + 4 * fq); \
        y1v[S] = p.c_y1[un_ * 1024 + (4 * w + fq) * 64 + ibase + fr]; } while (0)
#define SCAN_STEP(S, cc) do { const int bufo = ((cc) & 1) * 2048; \
        float exv[16]; { const float* ex = exch + bufo; _Pragma("unroll") for (int kk = 0; kk < 16; ++kk) exv[kk] = ex[64 * kk + lane]; } \
        __builtin_amdgcn_sched_barrier(0); \
        f32x4 yp = (f32x4){0.f, 0.f, 0.f, 0.f}; \
        _Pragma("unroll") for (int rg = 0; rg < 4; ++rg) yp = MF4(rh[S][rg], cur[rg], yp); \
        asm volatile("s_waitcnt lgkmcnt(0)" ::: "memory"); __builtin_amdgcn_sched_barrier(0); \
        f32x4 acc0 = qv[S], acc1 = (f32x4){0.f, 0.f, 0.f, 0.f}; \
        _Pragma("unroll") for (int kq = 0; kq < 4; ++kq) { \
            acc0 = MF4(pa[S][kq][0], exv[4 * kq], acc0); acc1 = MF4(pa[S][kq][1], exv[4 * kq + 1], acc1); \
            acc0 = MF4(pa[S][kq][2], exv[4 * kq + 2], acc0); acc1 = MF4(pa[S][kq][3], exv[4 * kq + 3], acc1); } \
        cur = acc0 + acc1; \
        { float* yd = ypart + bufo + w * 256; _Pragma("unroll") for (int rg = 0; rg < 4; ++rg) yd[(4 * fq + rg) * 16 + fr] = yp[rg]; } \
        { float* ed = exch + (2048 - bufo) + (16 * w) * 16; _Pragma("unroll") for (int rg = 0; rg < 4; ++rg) ed[(4 * fq + rg) * 16 + fr] = cur[rg]; } \
        asm volatile("s_waitcnt lgkmcnt(0)" ::: "memory"); __builtin_amdgcn_s_barrier(); asm volatile("" ::: "memory"); \
        { const float* ys = ypart + bufo + (4 * w + fq) * 16 + fr; const float y = (ys[0] + ys[256]) + (ys[512] + ys[768]) + y1v[S]; \
          p.sy[((size_t)b * SEQ + (size_t)(cc) * CH_T + 4 * w + fq) * 256 + hd * 64 + ibase + fr] = y; } \
        SCAN_LOAD(S, (cc) + 4); } while (0)
    SCAN_LOAD(0, 0); SCAN_LOAD(1, 1); SCAN_LOAD(2, 2); SCAN_LOAD(3, 3);
    __syncthreads();
    for (int c = 0; c < CH_N; c += 4) { SCAN_STEP(0, c); SCAN_STEP(1, c + 1); SCAN_STEP(2, c + 2); SCAN_STEP(3, c + 3); }
}

__device__ __forceinline__ void ph_mla_up(const Params& pkv, KPtr kp_in, int wbase_in, int l, char* lds) {
    PH_HEAD
    const int nq = (NT / 128) * 3, nkv = (NT / 128) * 4;
    const float SC = 0.10206207261596575f * 1.4426950408889634f;
    float* rsl = (float*)(lds + 40960);
    const int tid = TID;
    for (int u = BID; u < nq + nkv; u += gridDim.x) {
        const bool isq = u < nq;
        const int mt = isq ? u / 3 : (u - nq) / 4, t0 = mt * 128;
        {
            const int row = tid >> 2, part = tid & 3, ncol = isq ? 256 : 128, per = ncol / 4;
            const bf16_t* src = p.pbuf + (size_t)(t0 + row) * NINP + (isq ? PC_MQ : PC_MKV) + part * per;
            float ss = 0.f;
            for (int i = 0; i < per; i += 8) {
                const u32x4 w = *(const u32x4*)(src + i);
#pragma unroll
                for (int k = 0; k < 4; ++k) { const float a = __uint_as_float(w[k] << 16), b = __uint_as_float(w[k] & 0xffff0000u); ss += a * a + b * b; }
            }
            ss += dpp_f<0xB1>(ss); ss += dpp_f<0x4E>(ss);
            __syncthreads();
            if (part == 0) rsl[row] = rsqrtf(ss / (float)ncol + 1e-6f);
            if (!isq && (u - nq) % 4 == 0) {
                for (int e = tid; e < 128 * 16; e += NTHREADS) {
                    const int rr = e >> 4, i = e & 15, t = t0 + rr, pos = t % SEQ;
                    const bf16_t* pr = p.pbuf + (size_t)t * NINP + PC_MKR;
                    const float c = p.tab_mla[(pos * 16 + i) * 2], sn = p.tab_mla[(pos * 16 + i) * 2 + 1], x1 = bf2f(pr[i]), x2 = bf2f(pr[16 + i]);
                    const bf16_t k1 = f2bf(x1 * c - x2 * sn), k2 = f2bf(x1 * sn + x2 * c);
#pragma unroll
                    for (int hd = 0; hd < 4; ++hd) { p.mk[((size_t)t * 4 + hd) * 96 + 64 + i] = k1; p.mk[((size_t)t * 4 + hd) * 96 + 80 + i] = k2; }
                }
            }
            __syncthreads();
        }
        if (isq) {
            const int nt = u % 3;
            bf16_t* mq = p.mq + (size_t)mt * 128 * 384 + nt * 128; const float* tab = p.tab_mla;
            gemm_tile128(p.pbuf + (size_t)mt * 128 * NINP + PC_MQ, NINP, nullptr, 128, p.wq_t + ((size_t)l * 384 + nt * 128) * 256, 256, 256, lds, TID,
                         [=](int r, int c, f32x4 v0, f32x4 v1) mutable {
                             const float sc = rsl[r] * SC; v0 = v0 * sc; v1 = v1 * sc;
                             const int col = nt * 128 + c;
                             if ((col % 96) >= 64) {
                                 const int i0 = (col % 96) - 64, pos = (t0 + r) % SEQ;
                                 const f32x4 cs0 = *(const f32x4*)(tab + (pos * 16 + i0) * 2), cs1 = *(const f32x4*)(tab + (pos * 16 + i0) * 2 + 4);
                                 const f32x4 a = v0, b = v1;
                                 v0[0] = a[0] * cs0[0] - b[0] * cs0[1]; v1[0] = a[0] * cs0[1] + b[0] * cs0[0];
                                 v0[1] = a[1] * cs0[2] - b[1] * cs0[3]; v1[1] = a[1] * cs0[3] + b[1] * cs0[2];
                                 v0[2] = a[2] * cs1[0] - b[2] * cs1[1]; v1[2] = a[2] * cs1[1] + b[2] * cs1[0];
                                 v0[3] = a[3] * cs1[2] - b[3] * cs1[3]; v1[3] = a[3] * cs1[3] + b[3] * cs1[2];
                             }
                             uint2 o0, o1; o0.x = cvtpk(v0[0], v0[1]); o0.y = cvtpk(v0[2], v0[3]); o1.x = cvtpk(v1[0], v1[1]); o1.y = cvtpk(v1[2], v1[3]);
                             *(uint2*)(mq + (size_t)r * 384 + c) = o0; *(uint2*)(mq + (size_t)r * 384 + c + 16) = o1; });
        } else {
            const int hd = (u - nq) % 4;
            bf16_t* mk = p.mk + ((size_t)mt * 128 * 4 + hd) * 96; bf16_t* mv = p.mv + ((size_t)mt * 128 * 4 + hd) * 64;
            gemm_tile128(p.pbuf + (size_t)mt * 128 * NINP + PC_MKV, NINP, nullptr, 128, p.wkv_t + ((size_t)l * 512 + hd * 128) * 128, 128, 128, lds, TID,
                         [=](int r, int c, f32x4 v0, f32x4 v1) mutable {
                             const float sc = rsl[r]; v0 = v0 * sc; v1 = v1 * sc;
                             uint2 o0, o1; o0.x = cvtpk(v0[0], v0[1]); o0.y = cvtpk(v0[2], v0[3]); o1.x = cvtpk(v1[0], v1[1]); o1.y = cvtpk(v1[2], v1[3]);
                             if (c < 64) { *(uint2*)(mk + (size_t)r * 384 + c) = o0; *(uint2*)(mk + (size_t)r * 384 + c + 16) = o1; }
                             else { *(uint2*)(mv + (size_t)r * 256 + (c - 64)) = o0; *(uint2*)(mv + (size_t)r * 256 + (c - 64) + 16) = o1; } });
        }
    }
}

__device__ __forceinline__ void ph_mla_pack(const Params& pkv, KPtr kp_in, int wbase_in, int l) {
    PH_HEAD
    const int lane = TID & 63, gw = BID * (NTHREADS / 64) + (TID >> 6), nw = gridDim.x * (NTHREADS / 64);
    const float SC = 0.10206207261596575f * 1.4426950408889634f;
#pragma unroll 2
    for (int t = gw; t < NT; t += nw) {
        const int pos = t % SEQ;
        const float* qp = p.qu + (size_t)t * 384; const float* kvp = p.kvu + (size_t)t * 512; const float* kp2 = p.kpe + (size_t)t * 32;
        bf16_t* mq = p.mq + (size_t)t * 384; bf16_t* mk = p.mk + (size_t)t * 384; bf16_t* mv = p.mv + (size_t)t * 256;
        for (int e = lane; e < 384; e += 64) {
            const int hd = e / 96, d = e % 96;
            float qv, kv;
            if (d < 64) { qv = qp[e]; kv = kvp[hd * 128 + d]; }
            else {
                const int i = (d - 64) & 15; const float c = p.tab_mla[(pos * 16 + i) * 2], sn = p.tab_mla[(pos * 16 + i) * 2 + 1];
                const float x1 = qp[hd * 96 + 64 + i], x2 = qp[hd * 96 + 80 + i];
                qv = (d < 80) ? (x1 * c - x2 * sn) : (x1 * sn + x2 * c);
                kv = kp2[d - 64];
            }
            mq[e] = f2bf(qv * SC); mk[e] = f2bf(kv);
        }
        for (int e = lane; e < 256; e += 64) mv[e] = f2bf(kvp[(e >> 6) * 128 + 64 + (e & 63)]);
    }
}

__device__ __forceinline__ void ph_mla_attn(const Params& pkv, KPtr kp_in, int wbase_in, int l, char* lds) {
    PH_HEAD
    constexpr int KSTR = 104, VSTR = 68;
    bf16_t* Ks = (bf16_t*)lds;
    bf16_t* Vt = Ks + 64 * KSTR;
    const int tid = TID, lane = tid & 63, wv = tid >> 6, r = lane & 31, h = lane >> 5;
    int* wq = p.wq + l * 16;
    volatile int* wslot = (volatile int*)(lds + 24576);
    for (;;) {
        __syncthreads();
        if (tid == 0) *wslot = atomicAdd(wq, 1);
        __syncthreads();
        const int it = __builtin_amdgcn_readfirstlane(*wslot);
        if (it >= 16 * 32) break;
        const int bh = it & 15, qb = 31 - (it >> 4);
        const int b = bh >> 2, hd = bh & 3, q0 = qb * 256;
        const int qmin = q0 + 32 * wv, qmax = qmin + 31, myq = qmin + r;
        bf16x8 qf[6];
        {
            const bf16_t* qrow = p.mq + ((size_t)(b * SEQ + myq) * 4 + hd) * 96 + 8 * h;
#pragma unroll
            for (int s = 0; s < 6; ++s) qf[s] = *(const bf16x8*)(qrow + 16 * s);
        }
        f32x16 o0, o1;
#pragma unroll
        for (int i = 0; i < 16; ++i) { o0[i] = 0.f; o1[i] = 0.f; }
        float m = -1e30f, lsum = 0.f;
        const int nkt = (q0 + 256) / 64;
        const int kk0 = tid / 12, kc0 = tid % 12, kk1 = (tid + 512) / 12, kc1 = (tid + 512) % 12;
        const int vk = tid & 63, vc = tid >> 6;
        const bf16_t* kbase = p.mk + ((size_t)b * SEQ * 4 + hd) * 96;
        const bf16_t* vbase = p.mv + ((size_t)b * SEQ * 4 + hd) * 64;
        u32x4 rk0, rk1, rv;
        rk0 = *(const u32x4*)(kbase + (size_t)kk0 * 384 + kc0 * 8);
        rk1 = (tid < 256) ? *(const u32x4*)(kbase + (size_t)kk1 * 384 + kc1 * 8) : (u32x4){0u, 0u, 0u, 0u};
        rv = *(const u32x4*)(vbase + (size_t)vk * 256 + vc * 8);
        for (int kt = 0; kt < nkt; ++kt) {
            __syncthreads();
            *(u32x4*)(Ks + kk0 * KSTR + kc0 * 8) = rk0;
            if (tid < 256) *(u32x4*)(Ks + kk1 * KSTR + kc1 * 8) = rk1;
            {
                const unsigned w0 = rv[0], w1 = rv[1], w2 = rv[2], w3 = rv[3];
                bf16_t* vd = Vt + (vc * 8) * VSTR + vk;
                vd[0] = (bf16_t)(w0 & 0xffff); vd[VSTR] = (bf16_t)(w0 >> 16); vd[2 * VSTR] = (bf16_t)(w1 & 0xffff); vd[3 * VSTR] = (bf16_t)(w1 >> 16);
                vd[4 * VSTR] = (bf16_t)(w2 & 0xffff); vd[5 * VSTR] = (bf16_t)(w2 >> 16); vd[6 * VSTR] = (bf16_t)(w3 & 0xffff); vd[7 * VSTR] = (bf16_t)(w3 >> 16);
            }
            __syncthreads();
            if (kt + 1 < nkt) {
                const size_t ko = (size_t)(kt + 1) * 64;
                rk0 = *(const u32x4*)(kbase + (ko + kk0) * 384 + kc0 * 8);
                if (tid < 256) rk1 = *(const u32x4*)(kbase + (ko + kk1) * 384 + kc1 * 8);
                rv = *(const u32x4*)(vbase + (ko + vk) * 256 + vc * 8);
            }
            const int kb = kt * 64;
            if (kb <= qmax) {
                const bool need1 = (kb + 32 <= qmax);
                f32x16 s0, s1;
#pragma unroll
                for (int i = 0; i < 16; ++i) { s0[i] = 0.f; s1[i] = -1e30f; }
#pragma unroll
                for (int s = 0; s < 6; ++s) { const bf16x8 kf = *(const bf16x8*)(Ks + r * KSTR + 16 * s + 8 * h); s0 = __builtin_amdgcn_mfma_f32_32x32x16_bf16(kf, qf[s], s0, 0, 0, 0); }
                if (need1) {
#pragma unroll
                    for (int i = 0; i < 16; ++i) s1[i] = 0.f;
#pragma unroll
                    for (int s = 0; s < 6; ++s) { const bf16x8 kf = *(const bf16x8*)(Ks + (32 + r) * KSTR + 16 * s + 8 * h); s1 = __builtin_amdgcn_mfma_f32_32x32x16_bf16(kf, qf[s], s1, 0, 0, 0); }
                }
                if (kb + 63 > qmin) {
#pragma unroll
                    for (int i = 0; i < 16; ++i) {
                        const int key = kb + (i & 3) + 8 * (i >> 2) + 4 * h;
                        if (key > myq) s0[i] = -1e30f;
                        if (key + 32 > myq) s1[i] = -1e30f;
                    }
                }
                float mx = s0[0];
#pragma unroll
                for (int i = 1; i < 16; ++i) mx = fmaxf(mx, s0[i]);
#pragma unroll
                for (int i = 0; i < 16; ++i) mx = fmaxf(mx, s1[i]);
                mx = xhalf_max(mx);
                const float mn = fmaxf(m, mx), alpha = __builtin_amdgcn_exp2f(m - mn);
                m = mn;
                float ps = 0.f;
#pragma unroll
                for (int i = 0; i < 16; ++i) { s0[i] = __builtin_amdgcn_exp2f(s0[i] - mn); ps += s0[i]; }
                if (need1) {
#pragma unroll
                    for (int i = 0; i < 16; ++i) { s1[i] = __builtin_amdgcn_exp2f(s1[i] - mn); ps += s1[i]; }
                }
                lsum = lsum * alpha + ps;
                if (!__all(alpha == 1.0f)) {
#pragma unroll
                    for (int i = 0; i < 16; ++i) { o0[i] *= alpha; o1[i] *= alpha; }
                }
#pragma unroll
                for (int s = 0; s < 2; ++s) {
                    u32x4 pw; pw[0] = cvtpk(s0[8 * s], s0[8 * s + 1]); pw[1] = cvtpk(s0[8 * s + 2], s0[8 * s + 3]); pw[2] = cvtpk(s0[8 * s + 4], s0[8 * s + 5]); pw[3] = cvtpk(s0[8 * s + 6], s0[8 * s + 7]);
                    const bf16x8 pf = __builtin_bit_cast(bf16x8, pw);
                    const bf16_t* va = Vt + r * VSTR + 16 * s + 4 * h;
                    const s16x4 a0 = *(const s16x4*)(va), a1 = *(const s16x4*)(va + 8), b0 = *(const s16x4*)(va + 32 * VSTR), b1 = *(const s16x4*)(va + 32 * VSTR + 8);
                    o0 = __builtin_amdgcn_mfma_f32_32x32x16_bf16(__builtin_shufflevector(a0, a1, 0, 1, 2, 3, 4, 5, 6, 7), pf, o0, 0, 0, 0);
                    o1 = __builtin_amdgcn_mfma_f32_32x32x16_bf16(__builtin_shufflevector(b0, b1, 0, 1, 2, 3, 4, 5, 6, 7), pf, o1, 0, 0, 0);
                }
                if (need1) {
#pragma unroll
                    for (int s = 0; s < 2; ++s) {
                        u32x4 pw; pw[0] = cvtpk(s1[8 * s], s1[8 * s + 1]); pw[1] = cvtpk(s1[8 * s + 2], s1[8 * s + 3]); pw[2] = cvtpk(s1[8 * s + 4], s1[8 * s + 5]); pw[3] = cvtpk(s1[8 * s + 6], s1[8 * s + 7]);
                        const bf16x8 pf = __builtin_bit_cast(bf16x8, pw);
                        const bf16_t* va = Vt + r * VSTR + 32 + 16 * s + 4 * h;
                        const s16x4 a0 = *(const s16x4*)(va), a1 = *(const s16x4*)(va + 8), b0 = *(const s16x4*)(va + 32 * VSTR), b1 = *(const s16x4*)(va + 32 * VSTR + 8);
                        o0 = __builtin_amdgcn_mfma_f32_32x32x16_bf16(__builtin_shufflevector(a0, a1, 0, 1, 2, 3, 4, 5, 6, 7), pf, o0, 0, 0, 0);
                        o1 = __builtin_amdgcn_mfma_f32_32x32x16_bf16(__builtin_shufflevector(b0, b1, 0, 1, 2, 3, 4, 5, 6, 7), pf, o1, 0, 0, 0);
                    }
                }
            }
        }
        const float inv = 1.0f / xhalf_sum(lsum);
        float* op = p.mo + (size_t)(b * SEQ + myq) * 256 + hd * 64 + 4 * h;
#pragma unroll
        for (int g = 0; g < 4; ++g) {
            *(f32x4*)(op + 8 * g) = (f32x4){o0[4 * g] * inv, o0[4 * g + 1] * inv, o0[4 * g + 2] * inv, o0[4 * g + 3] * inv};
            *(f32x4*)(op + 32 + 8 * g) = (f32x4){o1[4 * g] * inv, o1[4 * g + 1] * inv, o1[4 * g + 2] * inv, o1[4 * g + 3] * inv};
        }
        __syncthreads();
    }
}

__device__ __forceinline__ void ph_finalize_mix(const Params& pkv, KPtr kp_in, int wbase_in, int l) {
    PH_HEAD
    const int lane = TID & 63, gw = BID * (NTHREADS / 64) + (TID >> 6), nw = gridDim.x * (NTHREADS / 64);
    const int c = lane * 4, h = lane >> 4;
    const float4 gd = *(const float4*)(p.dil_norm_g + l * 256 + c), gm = *(const float4*)(p.mla_out_norm_g + l * 256 + c);
    const float4 lg = *(const float4*)(p.rwkv_ln_g + l * 256 + c), lb = *(const float4*)(p.rwkv_ln_b + l * 256 + c), rk = *(const float4*)(p.rwkv_r_k + l * 256 + c);
    float nl0, nl1, nl2; float4 nd0, nd1, nd2, nsy, nsr, nsk, nsv, nsg, nmo;
    auto load = [&](int t) {
        nl0 = p.dlse[((size_t)0 * NT + t) * 4 + h]; nl1 = p.dlse[((size_t)1 * NT + t) * 4 + h]; nl2 = p.dlse[((size_t)2 * NT + t) * 4 + h];
        nd0 = *(const float4*)(p.dob + ((size_t)0 * NT + t) * 256 + c); nd1 = *(const float4*)(p.dob + ((size_t)1 * NT + t) * 256 + c); nd2 = *(const float4*)(p.dob + ((size_t)2 * NT + t) * 256 + c);
        const size_t o4 = (size_t)t * 256 + c;
        nsy = *(const float4*)(p.sy + o4); nsr = *(const float4*)(p.sr + o4); nsk = *(const float4*)(p.sk + o4); nsv = *(const float4*)(p.sv + o4); nsg = *(const float4*)(p.sg + o4);
        nmo = *(const float4*)(p.mo + o4);
    };
    int t = gw;
    if (t < NT) load(t);
    for (; t < NT; t += nw) {
        const float l0 = nl0, l1 = nl1, l2 = nl2; const float4 v0 = nd0, v1 = nd1, v2 = nd2, y = nsy, r = nsr, k = nsk, vv = nsv, g = nsg, mo = nmo;
        if (t + nw < NT) load(t + nw);
        bf16_t* outp = p.mixcat + (size_t)t * 1024;
        {
            const float lm = fmaxf(l0, fmaxf(l1, l2));
            float w0 = __builtin_amdgcn_exp2f(l0 - lm), w1 = __builtin_amdgcn_exp2f(l1 - lm), w2 = __builtin_amdgcn_exp2f(l2 - lm);
            const float wi = __builtin_amdgcn_rcpf(w0 + w1 + w2); w0 *= wi; w1 *= wi; w2 *= wi;
            float4 v; v.x = w0 * v0.x + w1 * v1.x + w2 * v2.x; v.y = w0 * v0.y + w1 * v1.y + w2 * v2.y; v.z = w0 * v0.z + w1 * v1.z + w2 * v2.z; v.w = w0 * v0.w + w1 * v1.w + w2 * v2.w;
            const float ss = wave_sum(v.x * v.x + v.y * v.y + v.z * v.z + v.w * v.w);
            const float rs = rsqrtf(ss * (1.0f / 256.0f) + 1e-6f);
            uint2 o; o.x = cvtpk(v.x * rs * gd.x, v.y * rs * gd.y); o.y = cvtpk(v.z * rs * gd.z, v.w * rs * gd.w);
            *(uint2*)(outp + 256 + c) = o;
        }
        {
            const float mean = grp16_sum(y.x + y.y + y.z + y.w) * (1.0f / 64.0f);
            const float dx = y.x - mean, dy = y.y - mean, dz = y.z - mean, dw = y.w - mean;
            const float var = grp16_sum(dx * dx + dy * dy + dz * dz + dw * dw) * (1.0f / 64.0f);
            const float rs = rsqrtf(var + 64e-5f);
            const float bonus = grp16_sum(r.x * k.x * rk.x + r.y * k.y * rk.y + r.z * k.z * rk.z + r.w * k.w * rk.w);
            uint2 o;
            o.x = cvtpk((dx * rs * lg.x + lb.x + bonus * vv.x) * g.x, (dy * rs * lg.y + lb.y + bonus * vv.y) * g.y);
            o.y = cvtpk((dz * rs * lg.z + lb.z + bonus * vv.z) * g.z, (dw * rs * lg.w + lb.w + bonus * vv.w) * g.w);
            *(uint2*)(outp + 512 + c) = o;
        }
        {
            const float ss = wave_sum(mo.x * mo.x + mo.y * mo.y + mo.z * mo.z + mo.w * mo.w);
            const float rs = rsqrtf(ss * (1.0f / 256.0f) + 1e-6f);
            uint2 o; o.x = cvtpk(mo.x * rs * gm.x, mo.y * rs * gm.y); o.y = cvtpk(mo.z * rs * gm.z, mo.w * rs * gm.w);
            *(uint2*)(outp + 768 + c) = o;
        }
    }
}

__device__ __forceinline__ void ph_outproj(const Params& pkv, KPtr kp_in, int wbase_in, int l, char* lds) {
    PH_HEAD
    const float* xin = (l == 0) ? p.x : p.xf; float* y1 = p.y1;
    const bf16_t* Bt = p.wout_t + (size_t)l * 1024 * 1024;
    const int nunits = (NT / 256) * 4;
    bool pre = false;
    XU_LOOP(NT / 256, 4) {
        const int u = XU_UNIT();
        const int mt = u >> 2, nt = u & 3, un = XU_NEXT_UNIT();
        G8Next nx; nx.valid = 0; nx.rowidx = nullptr; nx.nvalid = 256; nx.A = p.mixcat + (size_t)(un >> 2) * 256 * 1024; nx.Bt = Bt + (size_t)(un & 3) * 256 * 1024; nx.perm = 1;
        const size_t o0 = (size_t)mt * 256 * 1024 + nt * 256;
        G8Out so; so.out = nullptr; so.ld = 0; so.w = 0;
        gemm_tile256(p.mixcat + (size_t)mt * 256 * 1024, 1024, nullptr, 256, Bt + (size_t)nt * 256 * 1024, 1024, 1024, lds, wbase_in, pre, nx, true, so,
                     [=](int r, int c, f32x4 v0, f32x4 v1) mutable { const size_t o = o0 + (size_t)r * 1024 + c; const f32x4 xa = *(const f32x4*)(xin + o), xb2 = *(const f32x4*)(xin + o + 4); *(f32x4*)(y1 + o) = xa * ALPHA + v0; *(f32x4*)(y1 + o + 4) = xb2 * ALPHA + v1; return (u32x4){0u, 0u, 0u, 0u}; });
        pre = nx.valid != 0;
    }
}

__device__ __forceinline__ void ph_ln1_router(const Params& pkv, KPtr kp_in, int wbase_in, int l, char* lds) {
    PH_HEAD
    float* Wt = (float*)lds;
    int* hist = (int*)(lds + 131584);
    int* base = hist + 32;
    int* le = base + 32;
    float* lgt = (float*)(le + 512);
    int* lrank = (int*)(lgt + 512);
    const int tid = TID, lane = tid & 63, wv = tid >> 6;
    const float* g1 = p.ln1_g + l * 1024; const float* b1 = p.ln1_b + l * 1024;
    const float* rw = p.router_w + (size_t)l * 1024 * 32; const float* rb = p.router_b + l * 32;
    __syncthreads();
    for (int i = tid; i < 1024 * 32; i += NTHREADS) Wt[(i & 31) * 1028 + (i >> 5)] = rw[i];
    float4 gg[4], bb[4];
#pragma unroll
    for (int m = 0; m < 4; ++m) { gg[m] = *(const float4*)(g1 + m * 256 + lane * 4); bb[m] = *(const float4*)(b1 + m * 256 + lane * 4); }
    for (int tb = BID * 128; tb < NT; tb += gridDim.x * 128) {
        __syncthreads();
        if (tid < 32) hist[tid] = 0;
        __syncthreads();
        float4 yn[4];
#pragma unroll
        for (int m = 0; m < 4; ++m) yn[m] = *(const float4*)(p.y1 + (size_t)(tb + wv) * 1024 + m * 256 + lane * 4);
        for (int tt = wv; tt < 128; tt += 8) {
            const int t = tb + tt;
            float4 y[4]; float s = 0.f;
#pragma unroll
            for (int m = 0; m < 4; ++m) { y[m] = yn[m]; s += (y[m].x + y[m].y) + (y[m].z + y[m].w); }
            {
                const int t2 = tb + ((tt + 8 < 128) ? tt + 8 : tt);
#pragma unroll
                for (int m = 0; m < 4; ++m) yn[m] = *(const float4*)(p.y1 + (size_t)t2 * 1024 + m * 256 + lane * 4);
            }
            const float mean = wave_sum(s) * (1.0f / 1024.0f);
            float q = 0.f;
#pragma unroll
            for (int m = 0; m < 4; ++m) { y[m].x -= mean; y[m].y -= mean; y[m].z -= mean; y[m].w -= mean; q += (y[m].x * y[m].x + y[m].y * y[m].y) + (y[m].z * y[m].z + y[m].w * y[m].w); }
            const float rs = rsqrtf(wave_sum(q) * (1.0f / 1024.0f) + 1e-5f);
#pragma unroll
            for (int m = 0; m < 4; ++m) {
                const int c = m * 256 + lane * 4;
                y[m].x = y[m].x * rs * gg[m].x + bb[m].x; y[m].y = y[m].y * rs * gg[m].y + bb[m].y; y[m].z = y[m].z * rs * gg[m].z + bb[m].z; y[m].w = y[m].w * rs * gg[m].w + bb[m].w;
                *(float4*)(p.y1 + (size_t)t * 1024 + c) = y[m];
                uint2 ob; ob.x = cvtpk(y[m].x, y[m].y); ob.y = cvtpk(y[m].z, y[m].w);
                *(uint2*)(p.x1b + (size_t)t * 1024 + c) = ob;
            }
            float lg[32];
#pragma unroll
            for (int e = 0; e < 32; ++e) {
                float a = 0.f;
#pragma unroll
                for (int m = 0; m < 4; ++m) { const f32x4 w = *(const f32x4*)(Wt + e * 1028 + m * 256 + lane * 4); a += (y[m].x * w[0] + y[m].y * w[1]) + (y[m].z * w[2] + y[m].w * w[3]); }
                lg[e] = a;
            }
#pragma unroll
            for (int e = 0; e < 32; ++e) lg[e] = wave_sum(lg[e]) + rb[e];
            int idx[4]; float val[4];
#pragma unroll
            for (int k = 0; k < 4; ++k) {
                float bv = -3.0e38f; int bi = 0;
#pragma unroll
                for (int e = 0; e < 32; ++e) { if (lg[e] > bv) { bv = lg[e]; bi = e; } }
                idx[k] = bi; val[k] = bv;
#pragma unroll
                for (int e = 0; e < 32; ++e) if (e == bi) lg[e] = -3.0e38f;
            }
            const float e1 = __expf(val[1] - val[0]), e2 = __expf(val[2] - val[0]), e3 = __expf(val[3] - val[0]);
            const float inv = 1.0f / (1.0f + e1 + e2 + e3);
            const float gt[4] = {inv, e1 * inv, e2 * inv, e3 * inv};
            if (lane < 4) {
                int ee = idx[0]; float gv = gt[0];
                if (lane == 1) { ee = idx[1]; gv = gt[1]; } else if (lane == 2) { ee = idx[2]; gv = gt[2]; } else if (lane == 3) { ee = idx[3]; gv = gt[3]; }
                le[tt * 4 + lane] = ee; lgt[tt * 4 + lane] = gv;
                lrank[tt * 4 + lane] = atomicAdd(&hist[ee], 1);
            }
        }
        __syncthreads();
        if (tid < 32) base[tid] = atomicAdd(&p.cnt[l * NE + tid], hist[tid]);
        __syncthreads();
        {
            const int tt = tid >> 2, t = tb + tt, e = le[tid], pos = base[e] + lrank[tid];
            p.toke[(size_t)t * 4 + (tid & 3)] = e; p.tokpos[(size_t)t * 4 + (tid & 3)] = pos;
            p.rowtok[(size_t)e * NT + pos] = t; p.rowgate[(size_t)e * NT + pos] = lgt[tid];
        }
    }
}

__device__ __forceinline__ void moe_tile_prefix(KRef p, int l, int* tb  , const int TID) {
    __syncthreads();
    if (TID == 0) { int a = 0; for (int e = 0; e < NE; ++e) { tb[e] = a; a += (p.cnt[l * NE + e] + MOE_TM - 1) / MOE_TM; } tb[NE] = a; }
    __syncthreads();
}
struct MoeUnit { int e, mt, mtg, nt, nvalid; };
__device__ __forceinline__ MoeUnit moe_decode(const int* tb, const int* cnt, int u, int ntshift) {
    MoeUnit m; m.mtg = u >> ntshift; m.nt = u & ((1 << ntshift) - 1);
    int e = 0; while (tb[e + 1] <= m.mtg) ++e;
    m.e = __builtin_amdgcn_readfirstlane(e);
    m.mt = __builtin_amdgcn_readfirstlane(m.mtg - tb[m.e]);
    const int c = __builtin_amdgcn_readfirstlane(cnt[m.e]);
    m.nvalid = min(MOE_TM, c - m.mt * MOE_TM);
    return m;
}
__device__ __forceinline__ void ph_moe_gu(const Params& pkv, KPtr kp_in, int wbase_in, int l, char* lds) {
    PH_HEAD
    int* tb = (int*)(lds + 132096);
    moe_tile_prefix(p, l, tb, TID);
    const int ntile = __builtin_amdgcn_readfirstlane(tb[NE]), nunits = ntile * 8;
    const int* cnt = p.cnt + l * NE;
    bool pre = false;
    XU_LOOP(ntile, 8) {
        const int u = XU_UNIT();
        const MoeUnit m = moe_decode(tb, cnt, u, 3);
        const int un = XU_NEXT_UNIT();
        G8Next nx; nx.valid = 0; nx.A = p.x1b; nx.rowidx = nullptr; nx.Bt = nullptr; nx.nvalid = 0;
        if (nx.valid) { const MoeUnit m2 = moe_decode(tb, cnt, un, 3); nx.rowidx = p.rowtok + (size_t)m2.e * NT + m2.mt * MOE_TM; nx.nvalid = m2.nvalid; nx.Bt = p.wgu_t + (((size_t)l * NE + m2.e) * 2048 + m2.nt * 256) * 1024; } nx.perm = 1;
        const float* bias = p.b_gu + ((size_t)l * NE + m.e) * 2048 + m.nt * 256;
        bf16_t* out = p.act + (size_t)m.mtg * MOE_TM * 1024 + m.nt * 128;
        gemm_tile256(p.x1b, 1024, p.rowtok + (size_t)m.e * NT + m.mt * MOE_TM, m.nvalid, p.wgu_t + (((size_t)l * NE + m.e) * 2048 + m.nt * 256) * 1024, 1024, 1024, lds, wbase_in, pre, nx, true, G8Out{out, 1024, 128},
                     [=](int r, int c, f32x4 va, f32x4 vb) mutable {
                         uint2 o;
#pragma unroll
                         for (int hh = 0; hh < 2; ++hh) {
                             f32x4 v = hh ? vb : va; const int cc = c + 4 * hh;
                             const f32x4 bv = *(const f32x4*)(bias + cc); v = v + bv;
                             const float g0 = fminf(v[0], 7.0f), l0 = fminf(fmaxf(v[1], -7.0f), 7.0f), g1 = fminf(v[2], 7.0f), l1 = fminf(fmaxf(v[3], -7.0f), 7.0f);
                             const float a0 = g0 * sigmoidf_(1.702f * g0) * (l0 + 1.0f), a1 = g1 * sigmoidf_(1.702f * g1) * (l1 + 1.0f);
                             if (hh) o.y = cvtpk(a0, a1); else o.x = cvtpk(a0, a1);
                         }
                         return (u32x4){o.x, o.y, 0u, 0u}; });
        pre = nx.valid != 0;
    }
}
__device__ __forceinline__ void ph_moe_dn(const Params& pkv, KPtr kp_in, int wbase_in, int l, char* lds) {
    PH_HEAD
    int* tb = (int*)(lds + 132096);
    moe_tile_prefix(p, l, tb, TID);
    const int ntile = __builtin_amdgcn_readfirstlane(tb[NE]), nunits = ntile * 4;
    const int* cnt = p.cnt + l * NE;
    bool pre = false;
    XU_LOOP(ntile, 4) {
        const int u = XU_UNIT();
        const MoeUnit m = moe_decode(tb, cnt, u, 2);
        const int un = XU_NEXT_UNIT();
        G8Next nx; nx.valid = 0; nx.A = nullptr; nx.rowidx = nullptr; nx.Bt = nullptr; nx.nvalid = 256;
        if (nx.valid) { const MoeUnit m2 = moe_decode(tb, cnt, un, 2); nx.A = p.act + (size_t)m2.mtg * MOE_TM * 1024; nx.Bt = p.wdn_t + (((size_t)l * NE + m2.e) * 1024 + m2.nt * 256) * 1024; } nx.perm = 1;
        const float* bias = p.b_dn + ((size_t)l * NE + m.e) * 1024 + m.nt * 256;
        const float* gate = p.rowgate + (size_t)m.e * NT + m.mt * MOE_TM;
        bf16_t* out = p.yb + (size_t)m.mtg * MOE_TM * 1024 + m.nt * 256;
        const int nvalid = m.nvalid;
        gemm_tile256(p.act + (size_t)m.mtg * MOE_TM * 1024, 1024, nullptr, 256, p.wdn_t + (((size_t)l * NE + m.e) * 1024 + m.nt * 256) * 1024, 1024, 1024, lds, wbase_in, pre, nx, true, G8Out{out, 1024, 256},
                     [=](int r, int c, f32x4 v0, f32x4 v1) mutable {
                         const float g = (r < nvalid) ? gate[r] : 0.f;
                         const f32x4 b0 = *(const f32x4*)(bias + c), b1 = *(const f32x4*)(bias + c + 4); v0 = (v0 + b0) * g; v1 = (v1 + b1) * g;
                         u32x4 o; o[0] = cvtpk(v0[0], v0[1]); o[1] = cvtpk(v0[2], v0[3]); o[2] = cvtpk(v1[0], v1[1]); o[3] = cvtpk(v1[2], v1[3]); return o; });
        pre = nx.valid != 0;
    }
}
__device__ __forceinline__ void ph_combine_ln2(const Params& pkv, KPtr kp_in, int wbase_in, int l, char* lds) {
    PH_HEAD
    int* tb = (int*)(lds + 132096);
    moe_tile_prefix(p, l, tb, TID);
    const int lane = TID & 63, gw = BID * (NTHREADS / 64) + (TID >> 6), nw = gridDim.x * (NTHREADS / 64);
    float4 gg[4], bb[4];
#pragma unroll
    for (int m = 0; m < 4; ++m) { gg[m] = *(const float4*)(p.ln2_g + l * 1024 + m * 256 + lane * 4); bb[m] = *(const float4*)(p.ln2_b + l * 1024 + m * 256 + lane * 4); }
    float* dstf = (l == DEPTH - 1) ? p.out : p.xf;
    float4 ny[4]; uint2 nb[4][4]; int4 ne, npz;
    auto load_idx = [&](int t) { ne = *(const int4*)(p.toke + (size_t)t * 4); npz = *(const int4*)(p.tokpos + (size_t)t * 4); };
    auto load_rows = [&](int t) {
        const size_t r0 = (size_t)tb[ne.x] * MOE_TM + npz.x, r1 = (size_t)tb[ne.y] * MOE_TM + npz.y, r2 = (size_t)tb[ne.z] * MOE_TM + npz.z, r3 = (size_t)tb[ne.w] * MOE_TM + npz.w;
#pragma unroll
        for (int m = 0; m < 4; ++m) {
            const int c = m * 256 + lane * 4;
            ny[m] = *(const float4*)(p.y1 + (size_t)t * 1024 + c);
            nb[m][0] = *(const uint2*)(p.yb + r0 * 1024 + c); nb[m][1] = *(const uint2*)(p.yb + r1 * 1024 + c); nb[m][2] = *(const uint2*)(p.yb + r2 * 1024 + c); nb[m][3] = *(const uint2*)(p.yb + r3 * 1024 + c);
        }
    };
    int t = gw;
    if (t < NT) { load_idx(t); load_rows(t); if (t + nw < NT) load_idx(t + nw); }
    for (; t < NT; t += nw) {
        float4 y[4]; float s = 0.f;
#pragma unroll
        for (int m = 0; m < 4; ++m) {
            float4 v = ny[m];
            v.x *= ALPHA; v.y *= ALPHA; v.z *= ALPHA; v.w *= ALPHA;
#pragma unroll
            for (int k = 0; k < 4; ++k) { const uint2 w = nb[m][k]; v.x += __uint_as_float(w.x << 16); v.y += __uint_as_float(w.x & 0xffff0000u); v.z += __uint_as_float(w.y << 16); v.w += __uint_as_float(w.y & 0xffff0000u); }
            y[m] = v; s += (v.x + v.y) + (v.z + v.w);
        }
        if (t + nw < NT) { load_rows(t + nw); if (t + 2 * nw < NT) load_idx(t + 2 * nw); }
        const float mean = wave_sum(s) * (1.0f / 1024.0f);
        float q = 0.f;
#pragma unroll
        for (int m = 0; m < 4; ++m) { y[m].x -= mean; y[m].y -= mean; y[m].z -= mean; y[m].w -= mean; q += (y[m].x * y[m].x + y[m].y * y[m].y) + (y[m].z * y[m].z + y[m].w * y[m].w); }
        const float rs = rsqrtf(wave_sum(q) * (1.0f / 1024.0f) + 1e-5f);
#pragma unroll
        for (int m = 0; m < 4; ++m) {
            const int c = m * 256 + lane * 4;
            float4 xv; xv.x = y[m].x * rs * gg[m].x + bb[m].x; xv.y = y[m].y * rs * gg[m].y + bb[m].y; xv.z = y[m].z * rs * gg[m].z + bb[m].z; xv.w = y[m].w * rs * gg[m].w + bb[m].w;
            *(float4*)(dstf + (size_t)t * 1024 + c) = xv;
            uint2 ob; ob.x = cvtpk(xv.x, xv.y); ob.y = cvtpk(xv.z, xv.w);
            *(uint2*)(p.xb + (size_t)t * 1024 + c) = ob;
        }
    }
}

constexpr int PH_PRO = 0, PH_INPROJ = 1, PH_PREP = 2, PH_RETKV = 3, PH_RETSCAN = 4, PH_RETOUT = 5, PH_DIL = 6, PH_RWKVPREP = 7, PH_RWKVSCAN = 8, PH_MLAUP = 9,
              PH_MLAATTN = 10, PH_FINAL = 11, PH_OUTPROJ = 12, PH_LN1 = 13, PH_GU = 14, PH_DN = 15, PH_LN2 = 16;

#ifdef MULTI_LAUNCH
template <int ph>
__global__ void __launch_bounds__(NTHREADS, 2) mega(Params pk, int l) {
    extern __shared__ __attribute__((aligned(16))) char lds[];
    KPtr kp = (KPtr)__builtin_amdgcn_kernarg_segment_ptr();
    const int wbase = __builtin_amdgcn_readfirstlane(threadIdx.x) & ~63;
    if (ph == PH_PRO) ph_prologue(pk, kp, wbase, lds);
    if (ph == PH_INPROJ) ph_inproj(pk, kp, wbase, l, lds);
    if (ph == PH_PREP) ph_rope_prep(pk, kp, wbase, l);
    if (ph == PH_RETKV) ph_ret_kv(pk, kp, wbase, l, lds);
    if (ph == PH_RETSCAN) ph_ret_scan(pk, kp, wbase, l);
    if (ph == PH_RETOUT) ph_ret_out(pk, kp, wbase, l, lds);
    if (ph == PH_DIL) ph_dil_attn(pk, kp, wbase, l, lds);
    if (ph == PH_RWKVPREP) ph_rwkv_prep(pk, kp, wbase, l, lds);
    if (ph == PH_RWKVSCAN) ph_rwkv_scan(pk, kp, wbase, l, lds);
    if (ph == PH_MLAUP) ph_mla_up(pk, kp, wbase, l, lds);
    if (ph == PH_MLAATTN) ph_mla_attn(pk, kp, wbase, l, lds);
    if (ph == PH_FINAL) ph_finalize_mix(pk, kp, wbase, l);
    if (ph == PH_OUTPROJ) ph_outproj(pk, kp, wbase, l, lds);
    if (ph == PH_LN1) ph_ln1_router(pk, kp, wbase, l, lds);
    if (ph == PH_GU) ph_moe_gu(pk, kp, wbase, l, lds);
    if (ph == PH_DN) ph_moe_dn(pk, kp, wbase, l, lds);
    if (ph == PH_LN2) ph_combine_ln2(pk, kp, wbase, l, lds);
}
template <int PH> static void launch_ph(const Params& p, int l, hipStream_t stream) {
    static bool attr_set = false;
    if (!attr_set) { (void)hipFuncSetAttribute((const void*)mega<PH>, hipFuncAttributeMaxDynamicSharedMemorySize, LDS_BYTES); attr_set = true; }
    hipLaunchKernelGGL(mega<PH>, dim3(256), dim3(NTHREADS), LDS_BYTES, stream, p, l);
}
template <int PH> static void launch_layer(const Params& p, int l, hipStream_t stream) {
    launch_ph<PH>(p, l, stream);
    if constexpr (PH < PH_LN2) launch_layer<PH + 1>(p, l, stream);
}

#else
__device__ __forceinline__ void grid_sync(KPtr kp_in, int wbase_in, char* lds) {
    KPtr kp_ = kp_launder(kp_in);
    XcdBarrier b; b.bar = kp_->bar; b.x = xb_xcc_id(); b.st = (volatile LAS unsigned*)(lds + LDS_BYTES - 16);
    xcd_barrier(b, opq_tid(wbase_in));
}
#ifndef PROBE_ID
#define PROBE_ID -1
#endif
#define RUN(ID, call) do { int reps_ = 1; if (PROBE_ID == (ID)) { reps_ = 2; asm volatile("" : "+s"(reps_)); } for (int r_ = 0; r_ < reps_; ++r_) { call; } } while (0)
__global__ void __launch_bounds__(NTHREADS, 2) mega_fused(Params pk) {
    extern __shared__ __attribute__((aligned(16))) char lds[];
    KPtr kp = (KPtr)__builtin_amdgcn_kernarg_segment_ptr();
    const int wbase = __builtin_amdgcn_readfirstlane(threadIdx.x) & ~63;
    volatile LAS unsigned* xbw = (volatile LAS unsigned*)(lds + LDS_BYTES - 16);
    if (threadIdx.x == 0) { xbw[0] = 0u; xbw[1] = 0u; xbw[2] = 0u; xbw[3] = 0u; }
    __syncthreads();
    (void)xcd_barrier_post(pk.bar, xbw);
    RUN(0, ph_prologue(pk, kp, wbase, lds));
    grid_sync(kp, wbase, lds);
    for (int l = 0; l < DEPTH; ++l) {
        RUN(1, ph_inproj(pk, kp, wbase, l, lds));
        grid_sync(kp, wbase, lds);
        RUN(3, ph_ret_kv(pk, kp, wbase, l, lds)); RUN(4, ph_rwkv_prep(pk, kp, wbase, l, lds)); RUN(5, ph_mla_up(pk, kp, wbase, l, lds));
        grid_sync(kp, wbase, lds);
        RUN(8, ph_ret_scan(pk, kp, wbase, l)); RUN(17, ph_rwkv_chunkpre(pk, kp, wbase, l, lds));
        grid_sync(kp, wbase, lds);
        RUN(10, ph_rwkv_scan(pk, kp, wbase, l, lds)); RUN(9, ph_mla_attn(pk, kp, wbase, l, lds)); ph_dil_attn(pk, kp, wbase, l, lds); ph_ret_out(pk, kp, wbase, l, lds);
        grid_sync(kp, wbase, lds);
        RUN(12, ph_finalize_mix(pk, kp, wbase, l));
        grid_sync(kp, wbase, lds);
        RUN(13, ph_outproj(pk, kp, wbase, l, lds));
        grid_sync(kp, wbase, lds);
        ph_ln1_router(pk, kp, wbase, l, lds);
        grid_sync(kp, wbase, lds);
        RUN(14, ph_moe_gu(pk, kp, wbase, l, lds));
        grid_sync(kp, wbase, lds);
        RUN(15, ph_moe_dn(pk, kp, wbase, l, lds));
        grid_sync(kp, wbase, lds);
        RUN(16, ph_combine_ln2(pk, kp, wbase, l, lds));
        grid_sync(kp, wbase, lds);
    }
}
#endif
struct Carver { char* base; size_t off; template <class T> T* take(size_t n) { T* r = (T*)(base + off); off += ((n * sizeof(T) + 255) / 256) * 256; return r; } };

extern "C" void kernel_launch(void* const* d_in, const int* in_sizes, int n_in, void* d_out, int out_size, void* d_ws, size_t ws_size, hipStream_t stream) {
    Params p; memset(&p, 0, sizeof(p));
    const float** ip = (const float**)&p;
    for (int i = 0; i < 35; ++i) ip[i] = (const float*)d_in[i];
    p.out = (float*)d_out;
    Carver c{(char*)d_ws, 0};
    p.bar = c.take<unsigned>(4096); p.cnt = c.take<int>(DEPTH * NE); p.wq = c.take<int>(DEPTH * 16);
    p.tab_ret = c.take<float>((size_t)SEQ * 32); p.tab_dil = c.take<float>((size_t)SEQ * 16); p.tab_mla = c.take<float>((size_t)SEQ * 32);
    p.win_t = c.take<bf16_t>((size_t)DEPTH * NINP * 1024); p.wout_t = c.take<bf16_t>((size_t)DEPTH * 1024 * 1024);
    p.wgu_t = c.take<bf16_t>((size_t)DEPTH * NE * 2048 * 1024); p.wdn_t = c.take<bf16_t>((size_t)DEPTH * NE * 1024 * 1024);
    p.wq_t = c.take<bf16_t>((size_t)DEPTH * 384 * 256); p.wkv_t = c.take<bf16_t>((size_t)DEPTH * 512 * 128);
    p.wupt = c.take<bf16_t>((size_t)DEPTH * 256 * 64); p.aupt = c.take<bf16_t>((size_t)DEPTH * 256 * 64); p.gupt = c.take<bf16_t>((size_t)DEPTH * 256 * 128); p.vupt = c.take<bf16_t>((size_t)DEPTH * 256 * 32);
    p.xf = c.take<float>((size_t)NT * DM); p.xb = c.take<bf16_t>((size_t)NT * DM); p.pbuf = c.take<bf16_t>((size_t)NT * NINP);
    p.mixcat = c.take<bf16_t>((size_t)NT * DM); p.y1 = c.take<float>((size_t)NT * DM); p.x1b = c.take<bf16_t>((size_t)NT * DM);
    p.rq = c.take<float>((size_t)NT * 128); p.rk = c.take<float>((size_t)NT * 128);
    p.rkv = c.take<float>((size_t)NBATCH * NCH * 4 * 32 * 64); p.rstate = c.take<float>((size_t)NBATCH * NCH * 4 * 32 * 64);
    p.dq = c.take<float>((size_t)NT * 256); p.dk = c.take<float>((size_t)NT * 256); p.dob = c.take<float>((size_t)3 * NT * 256); p.dlse = c.take<float>((size_t)3 * NT * 4);
    p.sr = c.take<float>((size_t)NT * 256); p.sw = c.take<float>((size_t)NT * 256); p.sk = c.take<float>((size_t)NT * 256); p.sv = c.take<float>((size_t)NT * 256);
    p.sa = c.take<float>((size_t)NT * 256); p.sb = c.take<float>((size_t)NT * 256); p.sg = c.take<float>((size_t)NT * 256); p.sy = c.take<float>((size_t)NT * 256);
    p.vfirst = c.take<float>((size_t)NT * 256);
    p.c_p = c.take<float>((size_t)16 * (SEQ / 16) * 4096); p.c_q = c.take<float>((size_t)16 * (SEQ / 16) * 4096); p.c_rh = c.take<float>((size_t)16 * (SEQ / 16) * 1024); p.c_y1 = c.take<float>((size_t)16 * (SEQ / 16) * 1024);
    p.rsq = c.take<float>(NT); p.rskv = c.take<float>(NT); p.kpe = c.take<float>((size_t)NT * 32);
    p.qu = c.take<float>((size_t)NT * 384); p.kvu = c.take<float>((size_t)NT * 512); p.mo = c.take<float>((size_t)NT * 256);
    p.mq = c.take<bf16_t>((size_t)NT * 384); p.mk = c.take<bf16_t>((size_t)NT * 384); p.mv = c.take<bf16_t>((size_t)NT * 256);
    p.rowtok = c.take<int>((size_t)NE * NT); p.toke = c.take<int>((size_t)NT * 4); p.tokpos = c.take<int>((size_t)NT * 4); p.rowgate = c.take<float>((size_t)NE * NT);
    p.act = c.take<bf16_t>((size_t)MOE_MAXROWS * 1024); p.yb = c.take<bf16_t>((size_t)MOE_MAXROWS * 1024);
    if (c.off > ws_size) { fprintf(stderr, "workspace too small: need %zu have %zu\n", c.off, ws_size); return; }

#ifdef MULTI_LAUNCH
    launch_ph<PH_PRO>(p, 0, stream);
    for (int l = 0; l < DEPTH; ++l) launch_layer<PH_INPROJ>(p, l, stream);
#else
    static int grid = 0;
    if (!grid) {
        (void)hipFuncSetAttribute((const void*)mega_fused, hipFuncAttributeMaxDynamicSharedMemorySize, LDS_BYTES);
        int dev = 0, cus = 0, per_cu = 0;
        (void)hipGetDevice(&dev);
        (void)hipDeviceGetAttribute(&cus, hipDeviceAttributeMultiprocessorCount, dev);
        (void)hipOccupancyMaxActiveBlocksPerMultiprocessor(&per_cu, mega_fused, NTHREADS, LDS_BYTES);
        if (cus <= 0) cus = 256;
        grid = cus * (per_cu < 1 ? 1 : 1);
    }
    (void)hipMemsetAsync(p.bar, 0, XCD_BAR_WORDS * sizeof(unsigned), stream);
    hipLaunchKernelGGL(mega_fused, dim3(grid), dim3(NTHREADS), LDS_BYTES, stream, p);
#endif
}
```

```cpp
#include <hip/hip_runtime.h>
#include <stdint.h>
#include <string.h>
#include <stdio.h>

typedef unsigned short bf16_t;
typedef short bf16x8 __attribute__((ext_vector_type(8)));
typedef float f32x4 __attribute__((ext_vector_type(4)));
typedef unsigned u32x4 __attribute__((ext_vector_type(4)));
typedef float f32x16 __attribute__((ext_vector_type(16)));
typedef short s16x4 __attribute__((ext_vector_type(4)));
typedef float f32x2_t __attribute__((ext_vector_type(2)));
typedef __bf16 bf16x2_t __attribute__((ext_vector_type(2)));

constexpr int NT = 32768, SEQ = 8192, NBATCH = 4, DM = 1024, NIN = 2976, NINP = 3072, DEPTH = 4, NE = 32, TOPK = 4;
constexpr int BLK = 128, NCH = SEQ / BLK;
constexpr float ALPHA = 1.6817928305074292f;
constexpr int PC_RQ = 0, PC_RK = 128, PC_RV = 256, PC_RG = 512, PC_DQ = 768, PC_DK = 1024, PC_DV = 1280;
constexpr int PC_C = 1536, PC_CR = 1536, PC_CK = 1792, PC_CV = 2048, PC_CWD = 2304, PC_CAD = 2368, PC_CGD = 2432;
constexpr int PC_MQ = 2560, PC_MKV = 2816, PC_MKR = 2944, PC_VRES = 2976;
constexpr int MOE_TM = 256;
constexpr int MOE_MAXROWS = NT * TOPK + NE * MOE_TM;
constexpr int NTHREADS = 512;
constexpr int LDS_BYTES = 147456;

__device__ __forceinline__ bf16_t f2bf(float f) { unsigned u = __float_as_uint(f); u += 0x7fffu + ((u >> 16) & 1u); return (bf16_t)(u >> 16); }
__device__ __forceinline__ unsigned cvtpk(float lo, float hi) { f32x2_t v = {lo, hi}; bf16x2_t b = __builtin_convertvector(v, bf16x2_t); return __builtin_bit_cast(unsigned, b); }
__device__ __forceinline__ float xhalf_max(float v) { auto rr = __builtin_amdgcn_permlane32_swap(__float_as_uint(v), __float_as_uint(v), false, false); return fmaxf(__uint_as_float(rr[0]), __uint_as_float(rr[1])); }
__device__ __forceinline__ float xhalf_sum(float v) { auto rr = __builtin_amdgcn_permlane32_swap(__float_as_uint(v), __float_as_uint(v), false, false); return __uint_as_float(rr[0]) + __uint_as_float(rr[1]); }
__device__ __forceinline__ float bf2f(bf16_t h) { return __uint_as_float(((unsigned)h) << 16); }
template <int CTRL> __device__ __forceinline__ float dpp_f(float v) { return __int_as_float(__builtin_amdgcn_update_dpp(0, __float_as_int(v), CTRL, 0xF, 0xF, true)); }
__device__ __forceinline__ float grp16_sum(float v) {
    v += dpp_f<0x128>(v); v += dpp_f<0x124>(v); v += dpp_f<0x122>(v); v += dpp_f<0x121>(v); return v; }
__device__ __forceinline__ float wave_sum(float v) {
    v = grp16_sum(v);
    const int i = __float_as_int(v);
    return (__int_as_float(__builtin_amdgcn_readlane(i, 0)) + __int_as_float(__builtin_amdgcn_readlane(i, 16))) +
           (__int_as_float(__builtin_amdgcn_readlane(i, 32)) + __int_as_float(__builtin_amdgcn_readlane(i, 48))); }
__device__ __forceinline__ float sigmoidf_(float x) { return __builtin_amdgcn_rcpf(1.0f + __builtin_amdgcn_exp2f(x * -1.4426950408889634f)); }

#define XB_TMO      128
#define XB_XCNT(j)  (256  + 64 * (j))
#define XB_XSUB(j)  (1280 + 64 * (j))
#define XB_XGEN(j)  (2304 + 64 * (j))
#define XB_TOP      3328
#define XB_TOPGEN   3392
#define XCD_BAR_WORDS 3456
#define XB_SPIN_CAP (1u << 22)
#define LAS __attribute__((address_space(3)))
__device__ __forceinline__ unsigned xb_ld(unsigned* p)              { return __hip_atomic_load(p, __ATOMIC_RELAXED, __HIP_MEMORY_SCOPE_AGENT); }
__device__ __forceinline__ unsigned xb_add(unsigned* p, unsigned v) { return __hip_atomic_fetch_add(p, v, __ATOMIC_RELAXED, __HIP_MEMORY_SCOPE_AGENT); }
__device__ __forceinline__ unsigned xb_xcc_id() { return (unsigned)__builtin_amdgcn_s_getreg((3 << 11) | 20) & 0xFu; }
#define XB_SPIN(cond, bar) do { unsigned _sp = 0; while (cond) { __builtin_amdgcn_s_sleep(1); \
    if ((++_sp & 255u) == 0u) { if (xb_ld(&(bar)[XB_TMO])) break; if (_sp > XB_SPIN_CAP) { atomicAdd(&(bar)[XB_TMO], 1u); break; } } } } while (0)
struct XcdBarrier { unsigned* bar; unsigned x; volatile LAS unsigned* st; };
__device__ __forceinline__ XcdBarrier xcd_barrier_post(unsigned* bar, volatile LAS unsigned* st) {
    XcdBarrier b; b.bar = bar; b.x = xb_xcc_id(); b.st = st;
    if (threadIdx.x == 0) (void)xb_add(&bar[XB_XCNT(b.x)], 1u);
    return b;
}
__device__ __forceinline__ void xcd_barrier_complete(unsigned* bar, unsigned x, unsigned& nloc, unsigned& nx) {
    const unsigned G = gridDim.x * gridDim.y * gridDim.z;
    unsigned sum, cnt, mine, sp = 0u;
    for (;;) {
        sum = 0u; cnt = 0u; mine = 0u;
#pragma unroll
        for (unsigned j = 0; j < 16; ++j) { const unsigned c = xb_ld(&bar[XB_XCNT(j)]); sum += c; cnt += (c > 0u) ? 1u : 0u; mine = (j == x) ? c : mine; }
        if (sum == G) break;
        __builtin_amdgcn_s_sleep(1);
        if ((++sp & 255u) == 0u) { if (xb_ld(&bar[XB_TMO])) break; if (sp > XB_SPIN_CAP) { atomicAdd(&bar[XB_TMO], 1u); break; } }
    }
    nloc = mine > 0u ? mine : 1u; nx = cnt > 0u ? cnt : 1u;
}
__device__ __forceinline__ void xcd_barrier(const XcdBarrier& b, const int tid0) {
    asm volatile("s_waitcnt vmcnt(0)" ::: "memory");
    __syncthreads();
    if (tid0 == 0) {
        unsigned* bar = b.bar;
        __builtin_amdgcn_s_waitcnt(0);
        unsigned nloc = b.st[0], nx = b.st[1];
        if (nloc == 0u) { xcd_barrier_complete(bar, b.x, nloc, nx); b.st[0] = nloc; b.st[1] = nx; }
        const unsigned old = xb_add(&bar[XB_XSUB(b.x)], 1u);
        const unsigned gen = old / nloc;
        if (old + 1u == (gen + 1u) * nloc) {
            __builtin_amdgcn_fence(__ATOMIC_RELEASE, "agent");
            asm volatile("s_waitcnt vmcnt(0)" ::: "memory");
            const unsigned og = xb_add(&bar[XB_TOP], 1u);
            const unsigned tg = og / nx;
            if (og + 1u == (tg + 1u) * nx) xb_add(&bar[XB_TOPGEN], 1u);
            else XB_SPIN(xb_ld(&bar[XB_TOPGEN]) == tg, bar);
            __builtin_amdgcn_fence(__ATOMIC_ACQUIRE, "agent");
            xb_add(&bar[XB_XGEN(b.x)], 1u);
            asm volatile("s_waitcnt vmcnt(0)" ::: "memory");
        } else {
            XB_SPIN(xb_ld(&bar[XB_XGEN(b.x)]) == gen, bar);
            __builtin_amdgcn_fence(__ATOMIC_ACQUIRE, "agent");
            asm volatile("s_waitcnt vmcnt(0)" ::: "memory");
        }
    }
    __syncthreads();
}

struct Params {
    const float *x, *w_in, *w_out, *ret_norm_g, *dil_norm_g, *rwkv_mu, *rwkv_w0, *rwkv_w_up, *rwkv_a0, *rwkv_a_up, *rwkv_g_up, *rwkv_k_k, *rwkv_k_a,
        *rwkv_r_k, *rwkv_ln_g, *rwkv_ln_b, *vres_down, *vres_mu, *rwkv_v0, *rwkv_v_up, *mla_q_norm_g, *mla_w_q_up, *mla_kv_norm_g, *mla_w_kv_up,
        *mla_out_norm_g, *ln1_g, *ln1_b, *router_w, *router_b, *w_gu, *b_gu, *w_dn, *b_dn, *ln2_g, *ln2_b;
    float* out;
    unsigned* bar; int* cnt; int* wq;
    float *tab_ret, *tab_dil, *tab_mla;
    bf16_t *win_t, *wout_t, *wgu_t, *wdn_t, *wq_t, *wkv_t, *wupt, *aupt, *gupt, *vupt;
    float* xf; bf16_t* xb; bf16_t* pbuf; bf16_t* mixcat; float* y1; bf16_t* x1b;
    float *rq, *rk, *rkv, *rstate;
    float *dq, *dk, *dob, *dlse;
    float *sr, *sw, *sk, *sv, *sa, *sb, *sg, *sy, *vfirst;
    float *c_p, *c_q, *c_rh, *c_y1;
    float *rsq, *rskv, *kpe, *qu, *kvu, *mo;
    bf16_t *mq, *mk, *mv;
    int *rowtok, *toke, *tokpos; float* rowgate; bf16_t *act, *yb;
};

__device__ __forceinline__ int opq_tid(int wbase) { unsigned z = 0u; asm volatile("" : "+s"(z)); int t = wbase | (int)__builtin_amdgcn_mbcnt_hi(~0u, __builtin_amdgcn_mbcnt_lo(~0u, z)); asm volatile("" : "+v"(t)); return t; }
__device__ __forceinline__ int opq_bid() { int b = blockIdx.x; asm volatile("" : "+s"(b)); return b; }
typedef const __attribute__((address_space(4))) Params* KPtr;
typedef const __attribute__((address_space(4))) Params& KRef;
__device__ __forceinline__ KPtr kp_launder(KPtr k) {
    const unsigned long long v = (unsigned long long)k;
    unsigned lo = (unsigned)v, hi = (unsigned)(v >> 32);
    asm volatile("" : "+s"(lo), "+s"(hi));
    return (KPtr)(((unsigned long long)hi << 32) | lo);
}
#define PH_HEADV (void)kp_in; const Params& p = pkv; const int TID = opq_tid(wbase_in), BID = opq_bid(); (void)TID; (void)BID;
#define PH_HEAD (void)pkv; KPtr kp_ = kp_launder(kp_in); KRef p = *kp_; const int TID = opq_tid(wbase_in), BID = opq_bid(); (void)TID; (void)BID;
template <class F>
__device__ __forceinline__ void tr_tile(F f, bf16_t* dst, int ldd, int k0, int n0, float* tile, const int TID) {
    const int tid = TID;
#pragma unroll
    for (int i = 0; i < 8; ++i) { const int e = tid + i * NTHREADS, kk = e >> 6, nn = e & 63; tile[kk * 65 + nn] = f(k0 + kk, n0 + nn); }
    __syncthreads();
    {
        const int nn = tid >> 3, kc = (tid & 7) * 8;
        u32x4 w;
        w[0] = cvtpk(tile[(kc + 0) * 65 + nn], tile[(kc + 1) * 65 + nn]); w[1] = cvtpk(tile[(kc + 2) * 65 + nn], tile[(kc + 3) * 65 + nn]);
        w[2] = cvtpk(tile[(kc + 4) * 65 + nn], tile[(kc + 5) * 65 + nn]); w[3] = cvtpk(tile[(kc + 6) * 65 + nn], tile[(kc + 7) * 65 + nn]);
        *(u32x4*)(dst + (size_t)(n0 + nn) * ldd + k0 + kc) = w;
    }
    __syncthreads();
}

__device__ __forceinline__ void ph_prologue(const Params& pkv, KPtr kp_in, int wbase_in, char* lds) {
    PH_HEAD
    float* tile = (float*)lds;
    const int nb = gridDim.x, bid = BID, tid = TID;
    for (int t = bid; t < DEPTH * NE * 16 * 32; t += nb) {
        const int le = t >> 9, r = t & 511, tk = r >> 5, tn = r & 31;
        const float* src = p.w_gu + (size_t)le * 1024 * 2048;
        tr_tile([&](int k, int n) { return src[(size_t)k * 2048 + n]; }, p.wgu_t + (size_t)le * 2048 * 1024, 1024, tk * 64, tn * 64, tile, TID);
    }
    for (int t = bid; t < DEPTH * NE * 16 * 16; t += nb) {
        const int le = t >> 8, r = t & 255, tk = r >> 4, tn = r & 15;
        const float* src = p.w_dn + (size_t)le * 1024 * 1024;
        tr_tile([&](int k, int n) { return src[(size_t)k * 1024 + n]; }, p.wdn_t + (size_t)le * 1024 * 1024, 1024, tk * 64, tn * 64, tile, TID);
    }
    for (int t = bid; t < DEPTH * 16 * 48; t += nb) {
        const int l = t / (16 * 48), r = t % (16 * 48), tk = r / 48, tn = r % 48;
        const float* src = p.w_in + (size_t)l * 1024 * NIN;
        const float* vr = p.vres_down + (size_t)(l > 0 ? l - 1 : 0) * 1024 * 32;
        tr_tile([&](int k, int n) { return n < NIN ? src[(size_t)k * NIN + n] : ((n < NIN + 32 && l > 0) ? vr[k * 32 + (n - NIN)] : 0.0f); },
                p.win_t + (size_t)l * NINP * 1024, 1024, tk * 64, tn * 64, tile, TID);
    }
    for (int t = bid; t < DEPTH * 16 * 16; t += nb) {
        const int l = t >> 8, r = t & 255, tk = r >> 4, tn = r & 15;
        const float* src = p.w_out + (size_t)l * 1024 * 1024;
        tr_tile([&](int k, int n) { return src[(size_t)k * 1024 + n]; }, p.wout_t + (size_t)l * 1024 * 1024, 1024, tk * 64, tn * 64, tile, TID);
    }
    for (int t = bid; t < DEPTH * 4 * 6; t += nb) {
        const int l = t / 24, r = t % 24, tk = r / 6, tn = r % 6;
        const float* src = p.mla_w_q_up + (size_t)l * 256 * 384; const float* g = p.mla_q_norm_g + l * 256;
        tr_tile([&](int k, int n) { return src[k * 384 + n] * g[k]; }, p.wq_t + (size_t)l * 384 * 256, 256, tk * 64, tn * 64, tile, TID);
    }
    for (int t = bid; t < DEPTH * 2 * 8; t += nb) {
        const int l = t / 16, r = t % 16, tk = r / 8, tn = r % 8;
        const float* src = p.mla_w_kv_up + (size_t)l * 128 * 512; const float* g = p.mla_kv_norm_g + l * 128;
        tr_tile([&](int k, int n) { return src[k * 512 + n] * g[k]; }, p.wkv_t + (size_t)l * 512 * 128, 128, tk * 64, tn * 64, tile, TID);
    }
    for (int i = bid * NTHREADS + tid; i < DEPTH * 256 * 64; i += nb * NTHREADS) {
        const int l = i / (256 * 64), r = i % (256 * 64), n = r / 64, k = r % 64;
        p.wupt[i] = f2bf(p.rwkv_w_up[((size_t)l * 64 + k) * 256 + n]); p.aupt[i] = f2bf(p.rwkv_a_up[((size_t)l * 64 + k) * 256 + n]);
    }
    for (int i = bid * NTHREADS + tid; i < DEPTH * 256 * 128; i += nb * NTHREADS) {
        const int l = i / (256 * 128), r = i % (256 * 128), n = r / 128, k = r % 128;
        p.gupt[i] = f2bf(p.rwkv_g_up[((size_t)l * 128 + k) * 256 + n]);
    }
    for (int i = bid * NTHREADS + tid; i < (DEPTH - 1) * 256 * 32; i += nb * NTHREADS) {
        const int l = i / (256 * 32), r = i % (256 * 32), n = r / 32, k = r % 32;
        p.vupt[i] = f2bf(p.rwkv_v_up[((size_t)l * 32 + k) * 256 + n]);
    }
    for (int i = bid * NTHREADS + tid; i < SEQ * 40; i += nb * NTHREADS) {
        const int pos = i / 40, j = i % 40;
        double theta, rot; int f; float* dst;
        if (j < 16) { theta = 10000.0; rot = 32.0; f = j; dst = p.tab_ret + ((size_t)pos * 16 + f) * 2; }
        else if (j < 24) { theta = 500000.0; rot = 16.0; f = j - 16; dst = p.tab_dil + ((size_t)pos * 8 + f) * 2; }
        else { theta = 10000.0; rot = 32.0; f = j - 24; dst = p.tab_mla + ((size_t)pos * 16 + f) * 2; }
        const double inv = 1.0 / pow(theta, (2.0 * f) / rot), ang = (double)pos * inv;
        dst[0] = (float)cos(ang); dst[1] = (float)sin(ang);
    }
    for (size_t i = (size_t)bid * NTHREADS + tid; i < (size_t)NT * DM / 4; i += (size_t)nb * NTHREADS) {
        const float4 v = ((const float4*)p.x)[i];
        ushort4 o; o.x = f2bf(v.x); o.y = f2bf(v.y); o.z = f2bf(v.z); o.w = f2bf(v.w);
        ((ushort4*)p.xb)[i] = o;
    }
    if (bid == 0 && tid < DEPTH * NE) p.cnt[tid] = 0;
    if (bid == 0 && tid < DEPTH * 16) p.wq[tid] = 0;
}

template <class Epi>
__device__ __forceinline__ void gemm_tile128(const bf16_t* __restrict__ A, int lda, const int* __restrict__ rowidx, int nvalid,
                                             const bf16_t* __restrict__ Bt, int ldb, int K, char* lds, const int TID, Epi epi) {
    constexpr int LDT = 72;
    bf16_t* As = (bf16_t*)lds; bf16_t* Bs = As + 128 * LDT;
    const int tid = TID, lane = tid & 63, wid = tid >> 6, wm = wid >> 2, wn = wid & 3, fr = lane & 15, fq = lane >> 4;
    const bf16_t* ap[2]; const bf16_t* bp[2]; int so[2];
#pragma unroll
    for (int i = 0; i < 2; ++i) {
        const int c = tid + i * NTHREADS, row = c >> 3, kc = c & 7;
        int ar = row; if (rowidx) ar = (row < nvalid) ? rowidx[row] : rowidx[0];
        ap[i] = A + (size_t)ar * lda + kc * 8; bp[i] = Bt + (size_t)row * ldb + kc * 8; so[i] = row * LDT + kc * 8;
    }
    f32x4 acc[4][2];
#pragma unroll
    for (int mi = 0; mi < 4; ++mi)
#pragma unroll
        for (int ni = 0; ni < 2; ++ni) acc[mi][ni] = (f32x4){0.f, 0.f, 0.f, 0.f};
    u32x4 ra0, ra1, rb0, rb1;
    ra0 = *(const u32x4*)(ap[0]); ra1 = *(const u32x4*)(ap[1]); rb0 = *(const u32x4*)(bp[0]); rb1 = *(const u32x4*)(bp[1]);
    const int nk = K >> 6;
    for (int kt = 0; kt < nk; ++kt) {
        __syncthreads();
        *(u32x4*)(As + so[0]) = ra0; *(u32x4*)(As + so[1]) = ra1; *(u32x4*)(Bs + so[0]) = rb0; *(u32x4*)(Bs + so[1]) = rb1;
        __syncthreads();
        if (kt + 1 < nk) {
            const int ko = (kt + 1) * 64;
            ra0 = *(const u32x4*)(ap[0] + ko); ra1 = *(const u32x4*)(ap[1] + ko); rb0 = *(const u32x4*)(bp[0] + ko); rb1 = *(const u32x4*)(bp[1] + ko);
        }
#pragma unroll
        for (int kk = 0; kk < 2; ++kk) {
            bf16x8 af[4], bfr[2];
#pragma unroll
            for (int mi = 0; mi < 4; ++mi) af[mi] = *(const bf16x8*)(As + (wm * 64 + mi * 16 + fr) * LDT + kk * 32 + fq * 8);
#pragma unroll
            for (int ni = 0; ni < 2; ++ni) bfr[ni] = *(const bf16x8*)(Bs + (wn * 32 + ni * 16 + fr) * LDT + kk * 32 + fq * 8);
#pragma unroll
            for (int mi = 0; mi < 4; ++mi)
#pragma unroll
                for (int ni = 0; ni < 2; ++ni) acc[mi][ni] = __builtin_amdgcn_mfma_f32_16x16x32_bf16(bfr[ni], af[mi], acc[mi][ni], 0, 0, 0);
        }
    }
#pragma unroll
    for (int mi = 0; mi < 4; ++mi) epi(wm * 64 + mi * 16 + fr, wn * 32 + fq * 4, acc[mi][0], acc[mi][1]);
    __syncthreads();
}

__device__ __forceinline__ int g8_lds_byte(int r, int c) { const int st = (r >> 4) * 2 + (c >> 5), rr = r & 15, cc = c & 31, ob = rr * 64 + cc * 2; return st * 1024 + (ob ^ (((ob >> 9) & 1) << 5)); }
__device__ __forceinline__ void g8_stage_rc(int b, int& R, int& C) { const int st = b / 1024, sb = b % 1024, swz = sb ^ (((sb >> 9) & 1) << 5); R = (st >> 1) * 16 + swz / 64; C = (st & 1) * 32 + (swz % 64) / 2; }
struct G8Out { bf16_t* out; int ld; int w; };
struct G8Next { const bf16_t* A; const int* rowidx; const bf16_t* Bt; int nvalid; int valid; int perm; };
__device__ __forceinline__ int g8_perm32(int rho) { const int n = rho >> 4, i = rho & 15; return 8 * (i >> 2) + 4 * n + (i & 3); }
template <class Epi>
__device__ __forceinline__ void gemm_tile256(const bf16_t* __restrict__ A, int lda, const int* __restrict__ rowidx, int nvalid,
                                             const bf16_t* __restrict__ Bt, int ldb, int K, char* lds, const int TID, const bool pre_issued, const G8Next nx, const bool perm, const G8Out so, Epi epi) {
    constexpr int G_HT = 128 * 64;
    bf16_t* shm = (bf16_t*)lds;
    int* icache = (int*)(lds + 133120);
#define G8_SA(b, h) (shm + ((b) * 2 + (h)) * G_HT)
#define G8_SB(b, h) (shm + (4 + (b) * 2 + (h)) * G_HT)
#define G8_SPTR(dst, src) do { unsigned long long _v = (unsigned long long)(src); unsigned _lo = (unsigned)_v, _hi = (unsigned)(_v >> 32); asm volatile("" : "+s"(_lo), "+s"(_hi)); \
        dst = (const char*)(((unsigned long long)_hi << 32) | _lo); } while (0)
#define G8_STAGE(P, BASE, OFF, kt) do { const char* _sb; G8_SPTR(_sb, (const char*)(BASE) + (size_t)(kt) * 128); _Pragma("unroll") for (int _i = 0; _i < 2; ++_i) { \
        __builtin_amdgcn_global_load_lds((const unsigned*)(_sb + (size_t)(OFF)[_i]), (unsigned*)((char*)(P) + tz * 16 + _i * 8192), 16, 0, 0); } } while (0)
#define G8_LDA(dst, b, h) _Pragma("unroll") for (int m = 0; m < 4; ++m) _Pragma("unroll") for (int k = 0; k < 2; ++k) \
        dst[m][k] = *reinterpret_cast<const bf16x8*>((char*)G8_SA(b, h) + g8_lds_byte(wr * 64 + m * 16 + fr, k * 32 + fq * 8))
#define G8_LDB(dst, b, h) _Pragma("unroll") for (int n = 0; n < 2; ++n) _Pragma("unroll") for (int k = 0; k < 2; ++k) \
        dst[n][k] = *reinterpret_cast<const bf16x8*>((char*)G8_SB(b, h) + g8_lds_byte(wc * 32 + n * 16 + fr, k * 32 + fq * 8))
#define G8_MMA(ai, bj, At_, Bt_) do { __builtin_amdgcn_s_setprio(1); \
        _Pragma("unroll") for (int m = 0; m < 4; ++m) _Pragma("unroll") for (int n = 0; n < 2; ++n) _Pragma("unroll") for (int k = 0; k < 2; ++k) \
            acc[ai][bj][m][n] = __builtin_amdgcn_mfma_f32_16x16x32_bf16(Bt_[n][k], At_[m][k], acc[ai][bj][m][n], 0, 0, 0); \
        __builtin_amdgcn_s_setprio(0); } while (0)
#define G8_WAIT_V(n) asm volatile("s_waitcnt vmcnt(" #n ")" ::: "memory")
#define G8_WAIT_L(n) asm volatile("s_waitcnt lgkmcnt(" #n ")" ::: "memory")
#define G8_BAR __builtin_amdgcn_s_barrier()
#define G8_SCHED __builtin_amdgcn_sched_barrier(0)
    int tz = opq_tid(TID);
    int wid = tz >> 6, lane = tz & 63, wr = wid >> 2, wc = wid & 3, fr = lane & 15, fq = lane >> 4;
    unsigned aoff0[2], aoff1[2], boff0[2];
#pragma unroll
    for (int i = 0; i < 2; ++i) {
        int r, c; g8_stage_rc(tz * 16 + i * 8192, r, c);
        int r0 = r, r1 = 128 + r;
        if (rowidx) {
            if (pre_issued) { r0 = icache[r0]; r1 = icache[r1]; }
            else { r0 = (r0 < nvalid) ? rowidx[r0] : rowidx[0]; r1 = (r1 < nvalid) ? rowidx[r1] : rowidx[0]; }
        }
        aoff0[i] = (unsigned)(r0 * lda + c) * 2u; aoff1[i] = (unsigned)(r1 * lda + c) * 2u;
        const int rb = perm ? ((r & ~31) + g8_perm32(r & 31)) : r;
        boff0[i] = (unsigned)(rb * ldb + c) * 2u;
    }
    const bf16_t* Bt1 = Bt + (size_t)128 * ldb;
    int nidx = 0;
    if (nx.valid && nx.rowidx && tz < 256) nidx = nx.rowidx[(tz < nx.nvalid) ? tz : 0];
    f32x4 acc[2][2][4][2];
#pragma unroll
    for (int a = 0; a < 2; ++a)
#pragma unroll
        for (int b = 0; b < 2; ++b)
#pragma unroll
            for (int m = 0; m < 4; ++m)
#pragma unroll
                for (int n = 0; n < 2; ++n) acc[a][b][m][n] = (f32x4){0.f, 0.f, 0.f, 0.f};
    bf16x8 At[4][2], B0[2][2], B1[2][2];
    const int nt = K / 64;
    if (!pre_issued) {
        G8_STAGE(G8_SB(0, 0), Bt, boff0, 0); G8_STAGE(G8_SA(0, 0), A, aoff0, 0);
        G8_STAGE(G8_SB(0, 1), Bt1, boff0, 0); G8_STAGE(G8_SA(0, 1), A, aoff1, 0);
    }
    if (wr == 1) G8_BAR;
    if (pre_issued) { G8_WAIT_V(32); } else { G8_WAIT_V(4); }
    G8_BAR;
    G8_STAGE(G8_SB(1, 0), Bt, boff0, 1); G8_STAGE(G8_SA(1, 0), A, aoff0, 1); G8_STAGE(G8_SB(1, 1), Bt1, boff0, 1);
    if (!pre_issued) { G8_WAIT_V(6); }
    G8_BAR;
    for (int t = 0; t < nt - 2; t += 2) {
        G8_LDB(B0, 0, 0); G8_SCHED; G8_LDA(At, 0, 0); G8_STAGE(G8_SA(1, 1), A, aoff1, t + 1);
        G8_WAIT_L(8); G8_BAR; G8_WAIT_L(0); G8_MMA(0, 0, At, B0); G8_BAR; G8_SCHED;
        G8_LDB(B1, 0, 1); G8_STAGE(G8_SB(0, 0), Bt, boff0, t + 2);
        G8_BAR; G8_WAIT_L(0); G8_MMA(0, 1, At, B1); G8_BAR;
        G8_LDA(At, 0, 1); G8_STAGE(G8_SA(0, 0), A, aoff0, t + 2);
        G8_BAR; G8_WAIT_L(0); G8_MMA(1, 0, At, B0); G8_BAR; G8_SCHED;
        G8_STAGE(G8_SB(0, 1), Bt1, boff0, t + 2);
        G8_WAIT_V(6); G8_BAR; G8_MMA(1, 1, At, B1); G8_BAR;
        G8_LDB(B0, 1, 0); G8_SCHED; G8_LDA(At, 1, 0); G8_STAGE(G8_SA(0, 1), A, aoff1, t + 2);
        G8_WAIT_L(8); G8_BAR; G8_WAIT_L(0); G8_MMA(0, 0, At, B0); G8_BAR; G8_SCHED;
        G8_LDB(B1, 1, 1); G8_STAGE(G8_SB(1, 0), Bt, boff0, t + 3);
        G8_BAR; G8_WAIT_L(0); G8_MMA(0, 1, At, B1); G8_BAR;
        G8_LDA(At, 1, 1); G8_STAGE(G8_SA(1, 0), A, aoff0, t + 3);
        G8_BAR; G8_WAIT_L(0); G8_MMA(1, 0, At, B0); G8_BAR; G8_SCHED;
        G8_STAGE(G8_SB(1, 1), Bt1, boff0, t + 3);
        G8_WAIT_V(6); G8_BAR; G8_MMA(1, 1, At, B1); G8_BAR;
    }
    { G8_LDB(B0, 0, 0); G8_WAIT_V(0); G8_LDA(At, 0, 0); G8_STAGE(G8_SA(1, 1), A, aoff1, nt - 1);
      G8_BAR; G8_WAIT_L(0); G8_MMA(0, 0, At, B0); G8_BAR;
      G8_LDB(B1, 0, 1); G8_BAR; G8_WAIT_L(0); G8_MMA(0, 1, At, B1); G8_BAR;
      G8_LDA(At, 0, 1); G8_WAIT_V(4); G8_BAR; G8_WAIT_L(0); G8_MMA(1, 0, At, B0); G8_MMA(1, 1, At, B1); G8_BAR; }
    { G8_LDB(B0, 1, 0); G8_LDA(At, 1, 0); G8_WAIT_V(2); G8_BAR; G8_WAIT_L(0); G8_MMA(0, 0, At, B0); G8_BAR;
      G8_LDB(B1, 1, 1); G8_WAIT_V(0); G8_BAR; G8_WAIT_L(0); G8_MMA(0, 1, At, B1); G8_BAR;
      G8_LDA(At, 1, 1); G8_BAR; G8_WAIT_L(0); G8_MMA(1, 0, At, B0); G8_MMA(1, 1, At, B1); G8_BAR; }
    if (wr == 0) G8_BAR;
    asm volatile("" : "+v"(tz)); wid = tz >> 6; lane = tz & 63; wr = wid >> 2; wc = wid & 3; fr = lane & 15; fq = lane >> 4;
    if (nx.valid) {
        if (nx.rowidx) { if (tz < 256) icache[tz] = nidx; G8_WAIT_L(0); G8_BAR; }
        unsigned na0[2], na1[2], nb0[2];
#pragma unroll
        for (int i = 0; i < 2; ++i) {
            int r, c; g8_stage_rc(tz * 16 + i * 8192, r, c);
            int r0 = r, r1 = 128 + r;
            if (nx.rowidx) { r0 = icache[r0]; r1 = icache[r1]; }
            const int rb = nx.perm ? ((r & ~31) + g8_perm32(r & 31)) : r;
            na0[i] = (unsigned)(r0 * lda + c) * 2u; na1[i] = (unsigned)(r1 * lda + c) * 2u; nb0[i] = (unsigned)(rb * ldb + c) * 2u;
        }
        const bf16_t* nBt1 = nx.Bt + (size_t)128 * ldb;
        G8_STAGE(G8_SB(0, 0), nx.Bt, nb0, 0); G8_STAGE(G8_SA(0, 0), nx.A, na0, 0);
        G8_STAGE(G8_SB(0, 1), nBt1, nb0, 0); G8_STAGE(G8_SA(0, 1), nx.A, na1, 0);
    }
    if (so.w == 0) {
#pragma unroll
        for (int ai = 0; ai < 2; ++ai)
#pragma unroll
            for (int m = 0; m < 4; ++m)
#pragma unroll
                for (int bj = 0; bj < 2; ++bj) (void)epi(ai * 128 + wr * 64 + m * 16 + fr, bj * 128 + wc * 32 + (perm ? fq * 8 : fq * 4), acc[ai][bj][m][0], acc[ai][bj][m][1]);
    } else {
        const int sw = so.w * 2 + 32;
        char* sl = (char*)lds;
#pragma unroll
        for (int ai = 0; ai < 2; ++ai) {
#pragma unroll
            for (int m = 0; m < 4; ++m)
#pragma unroll
                for (int bj = 0; bj < 2; ++bj) {
                    const int rr = wr * 64 + m * 16 + fr, c = bj * 128 + wc * 32 + fq * 8;
                    const u32x4 o = epi(ai * 128 + rr, c, acc[ai][bj][m][0], acc[ai][bj][m][1]);
                    if (so.w == 256) *(u32x4*)(sl + rr * sw + c * 2) = o; else *(uint2*)(sl + rr * sw + c) = make_uint2(o[0], o[1]);
                }
            G8_WAIT_L(0); G8_BAR;
            {
                const int rpi = 1024 / (so.w * 2), cpr = so.w / 8;
#pragma unroll 4
                for (int i = 0; i < 16 / rpi; ++i) {
                    const int row = wid * 16 + i * rpi + lane / cpr, ch = lane % cpr;
                    const u32x4 v = *(const u32x4*)(sl + row * sw + ch * 16);
                    *(u32x4*)(so.out + (size_t)(ai * 128 + row) * so.ld + ch * 8) = v;
                }
            }
            G8_WAIT_L(0); G8_BAR;
        }
    }
    G8_BAR;
}

#define XU_LOOP(nM_, nN_) const int xu_x = BID & 7, xu_nb = gridDim.x >> 3, xu_own = ((nM_) - xu_x + 7) >> 3, xu_nN = (nN_); for (int xv = BID >> 3; xv < xu_own * xu_nN; xv += xu_nb)
#define XU_UNIT() ((xu_x + 8 * (xv / xu_nN)) * xu_nN + (xv % xu_nN))
#define XU_NEXT_OK ((xv + xu_nb) < xu_own * xu_nN)
#define XU_NEXT_UNIT() ((xu_x + 8 * ((xv + xu_nb) / xu_nN)) * xu_nN + ((xv + xu_nb) % xu_nN))
__device__ __forceinline__ void ph_inproj(const Params& pkv, KPtr kp_in, int wbase_in, int l, char* lds) {
    PH_HEAD
    const bf16_t* Bt = p.win_t + (size_t)l * NINP * 1024;
    const int ntn = NINP / 256, nunits = (NT / 256) * ntn;
    bool pre = false;
    XU_LOOP(NT / 256, ntn) {
        const int u = XU_UNIT();
        const int mt = u / ntn, nt = u % ntn, un = XU_NEXT_UNIT(), mt2 = un / ntn, nt2 = un % ntn;
        G8Next nx; nx.valid = 0; nx.rowidx = nullptr; nx.nvalid = 256; nx.A = p.xb + (size_t)mt2 * 256 * 1024; nx.Bt = Bt + (size_t)nt2 * 256 * 1024; nx.perm = !(nt2 == 0 || nt2 == 3 || nt2 == 4);
        const bool perm = !(nt == 0 || nt == 3 || nt == 4);
        bf16_t* out = p.pbuf + (size_t)mt * 256 * NINP + nt * 256;
        const float* tabr = p.tab_ret; const float* tabd = p.tab_dil; bf16_t* rqb = (bf16_t*)p.rq; bf16_t* rkb = (bf16_t*)p.rk; bf16_t* dqb = (bf16_t*)p.dq; bf16_t* dkb = (bf16_t*)p.dk;
        G8Out so; so.out = out; so.ld = NINP; so.w = perm ? 256 : 0;
        gemm_tile256(p.xb + (size_t)mt * 256 * 1024, 1024, nullptr, 256, Bt + (size_t)nt * 256 * 1024, 1024, 1024, lds, wbase_in, pre, nx, perm, so,
                     [=](int r, int c, f32x4 v0, f32x4 v1) mutable {
                         const int pos = (mt * 256 + r) % SEQ; const size_t t = (size_t)mt * 256 + r;
                         if (nt == 0) {
                             const int i0 = c & 15, hc = c & 127; const bool isk = c >= 128;
                             const f32x4 cs0 = *(const f32x4*)(tabr + (pos * 16 + i0) * 2), cs1 = *(const f32x4*)(tabr + (pos * 16 + i0) * 2 + 4);
                             const float sc = isk ? 0.17677669529663687f : 1.0f;
                             const f32x4 a = v0 * sc, b = v1 * sc;
                             v0[0] = a[0] * cs0[0] - b[0] * cs0[1]; v1[0] = a[0] * cs0[1] + b[0] * cs0[0]; v0[1] = a[1] * cs0[2] - b[1] * cs0[3]; v1[1] = a[1] * cs0[3] + b[1] * cs0[2];
                             v0[2] = a[2] * cs1[0] - b[2] * cs1[1]; v1[2] = a[2] * cs1[1] + b[2] * cs1[0]; v0[3] = a[3] * cs1[2] - b[3] * cs1[3]; v1[3] = a[3] * cs1[3] + b[3] * cs1[2];
                             bf16_t* dst = (isk ? rkb : rqb) + t * 128 + hc;
                             uint2 o; o.x = cvtpk(v0[0], v0[1]); o.y = cvtpk(v0[2], v0[3]); *(uint2*)dst = o; o.x = cvtpk(v1[0], v1[1]); o.y = cvtpk(v1[2], v1[3]); *(uint2*)(dst + 16) = o;
                         } else if (nt == 3 || nt == 4) {
                             const float sc = (nt == 3) ? (0.125f * 1.4426950408889634f) : 1.0f;
                             v0 = v0 * sc; v1 = v1 * sc;
                             if ((c & 32) == 0) {
                                 f32x4 pv;
#pragma unroll
                                 for (int j = 0; j < 4; ++j) { auto rr = __builtin_amdgcn_permlane32_swap(__float_as_uint(v0[j]), __float_as_uint(v0[j]), false, false); pv[j] = __uint_as_float((c & 8) ? rr[0] : rr[1]); }
                                 const int i0 = c & 7;
                                 const f32x4 cs0 = *(const f32x4*)(tabd + (pos * 8 + i0) * 2), cs1 = *(const f32x4*)(tabd + (pos * 8 + i0) * 2 + 4);
                                 const f32x4 own = v0;
                                 if ((c & 8) == 0) { v0[0] = own[0] * cs0[0] - pv[0] * cs0[1]; v0[1] = own[1] * cs0[2] - pv[1] * cs0[3]; v0[2] = own[2] * cs1[0] - pv[2] * cs1[1]; v0[3] = own[3] * cs1[2] - pv[3] * cs1[3]; }
                                 else { v0[0] = pv[0] * cs0[1] + own[0] * cs0[0]; v0[1] = pv[1] * cs0[3] + own[1] * cs0[2]; v0[2] = pv[2] * cs1[1] + own[2] * cs1[0]; v0[3] = pv[3] * cs1[3] + own[3] * cs1[2]; }
                             }
                             bf16_t* dst = ((nt == 3) ? dqb : dkb) + t * 256 + c;
                             uint2 o; o.x = cvtpk(v0[0], v0[1]); o.y = cvtpk(v0[2], v0[3]); *(uint2*)dst = o; o.x = cvtpk(v1[0], v1[1]); o.y = cvtpk(v1[2], v1[3]); *(uint2*)(dst + 16) = o;
                         } else {
                             u32x4 o; o[0] = cvtpk(v0[0], v0[1]); o[1] = cvtpk(v0[2], v0[3]); o[2] = cvtpk(v1[0], v1[1]); o[3] = cvtpk(v1[2], v1[3]); return o;
                         }
                         return (u32x4){0u, 0u, 0u, 0u}; });
        pre = nx.valid != 0;
    }
}

__device__ __forceinline__ void ph_rope_prep(const Params& pkv, KPtr kp_in, int wbase_in, int l) {
    PH_HEAD
    const int lane = TID & 63, gw = BID * (NTHREADS / 64) + (TID >> 6), nw = gridDim.x * (NTHREADS / 64);
#pragma unroll 2
    for (int t = gw; t < NT; t += nw) {
        const int pos = t % SEQ;
        const bf16_t* pr = p.pbuf + (size_t)t * NINP;
        {
            float ss = 0.f;
            for (int e = lane; e < 256; e += 64) { const float v = bf2f(pr[PC_MQ + e]); ss += v * v; }
            ss = wave_sum(ss);
            float s2 = 0.f;
            for (int e = lane; e < 128; e += 64) { const float v = bf2f(pr[PC_MKV + e]); s2 += v * v; }
            s2 = wave_sum(s2);
            if (lane == 0) { p.rsq[t] = rsqrtf(ss * (1.0f / 256.0f) + 1e-6f); p.rskv[t] = rsqrtf(s2 * (1.0f / 128.0f) + 1e-6f); }
            if (lane < 16) {
                const float c = p.tab_mla[(pos * 16 + lane) * 2], s = p.tab_mla[(pos * 16 + lane) * 2 + 1];
                const float x1 = bf2f(pr[PC_MKR + lane]), x2 = bf2f(pr[PC_MKR + 16 + lane]);
                const bf16_t k1 = f2bf(x1 * c - x2 * s), k2 = f2bf(x1 * s + x2 * c);
#pragma unroll
                for (int hd = 0; hd < 4; ++hd) { p.mk[((size_t)t * 4 + hd) * 96 + 64 + lane] = k1; p.mk[((size_t)t * 4 + hd) * 96 + 80 + lane] = k2; }
            }
        }
    }
}

__device__ __forceinline__ float ret_log_gamma(int h) { return logf(1.0f - exp2f(-5.0f - (float)h)); }

__device__ __forceinline__ void ph_ret_kv(const Params& pkv, KPtr kp_in, int wbase_in, int l, char* lds) {
    PH_HEAD
    float* kz = (float*)lds;
    float* vs = kz + 128 * 32;
    const int tid = TID;
    for (int u = BID; u < NBATCH * NCH * 4; u += gridDim.x) {
        const int h = u & 3, n = (u >> 2) & 63, b = u >> 8;
        const float lg = ret_log_gamma(h);
        const int t0 = b * SEQ + n * BLK;
        __syncthreads();
        for (int e = tid; e < 128 * 32; e += NTHREADS) { const int j = e >> 5, d = e & 31; kz[e] = bf2f(((const bf16_t*)p.rk)[(size_t)(t0 + j) * 128 + h * 32 + d]) * __expf((float)(BLK - 1 - j) * lg); }
        for (int e = tid; e < 128 * 64; e += NTHREADS) { const int j = e >> 6, c = e & 63; vs[e] = bf2f(p.pbuf[(size_t)(t0 + j) * NINP + PC_RV + h * 64 + c]); }
        __syncthreads();
        const int e = tid & 63, d0 = (tid >> 6) * 4;
        float a0 = 0.f, a1 = 0.f, a2 = 0.f, a3 = 0.f;
#pragma unroll 8
        for (int j = 0; j < BLK; ++j) {
            const float vv = vs[j * 64 + e]; const float4 kk = *(const float4*)(kz + j * 32 + d0);
            a0 += kk.x * vv; a1 += kk.y * vv; a2 += kk.z * vv; a3 += kk.w * vv;
        }
        float* out = p.rkv + (size_t)u * 2048;
        out[(d0 + 0) * 64 + e] = a0; out[(d0 + 1) * 64 + e] = a1; out[(d0 + 2) * 64 + e] = a2; out[(d0 + 3) * 64 + e] = a3;
    }
}
__device__ __forceinline__ void ph_ret_scan(const Params& pkv, KPtr kp_in, int wbase_in, int l) {
    PH_HEAD
    const int i = BID * NTHREADS + TID;
    if (i < NBATCH * 4 * 32 * 64) {
        const int e = i & 63, d = (i >> 6) & 31, h = (i >> 11) & 3, b = i >> 13;
        const float cd = __expf((float)BLK * ret_log_gamma(h));
        float s = 0.f;
        for (int n = 0; n < NCH; ++n) {
            const size_t idx = ((((size_t)b * NCH + n) * 4 + h) * 32 + d) * 64 + e;
            p.rstate[idx] = s; s = cd * s + p.rkv[idx];
        }
    }
}
__device__ __forceinline__ void ph_ret_out(const Params& pkv, KPtr kp_in, int wbase_in, int l, char* lds) {
    PH_HEAD
    constexpr int KSTR = 40, VSTR = 132, SSTR = 40, UNIT_BYTES = (128 * KSTR + 64 * VSTR + 64 * SSTR) * 2;
    const int tid = TID, lane = tid & 63, wv = tid >> 6, hb = wv >> 2, w = wv & 3, r = lane & 31, hh = lane >> 5, ht = tid & 255;
    bf16_t* Ks = (bf16_t*)(lds + hb * UNIT_BYTES);
    bf16_t* Vt = Ks + 128 * KSTR;
    bf16_t* St = Vt + 64 * VSTR;
    const bf16_t* rqb = (const bf16_t*)p.rq; const bf16_t* rkb = (const bf16_t*)p.rk;
    int* wq = p.wq + l * 16 + 2;
    volatile int* wslot = (volatile int*)(lds + 2 * UNIT_BYTES);
    for (;;) {
        __syncthreads();
        if (tid == 0) *wslot = atomicAdd(wq, 1);
        __syncthreads();
        const int u0 = __builtin_amdgcn_readfirstlane(*wslot) * 2;
        if (u0 >= NBATCH * NCH * 4) break;
        const int u = u0 + hb, h = u & 3, n = (u >> 2) & 63, b = u >> 8;
        const int t0 = b * SEQ + n * BLK;
        const float lg2 = ret_log_gamma(h) * 1.4426950408889634f;
        __syncthreads();
#pragma unroll
        for (int i = 0; i < 2; ++i) { const int c = ht + i * 256, key = c >> 2, ch = c & 3; *(u32x4*)(Ks + key * KSTR + ch * 8) = *(const u32x4*)(rkb + (size_t)(t0 + key) * 128 + h * 32 + ch * 8); }
#pragma unroll
        for (int i = 0; i < 4; ++i) {
            const int c = ht + i * 256, key = c & 127, ch = c >> 7;
            const u32x4 rv = *(const u32x4*)(p.pbuf + (size_t)(t0 + key) * NINP + PC_RV + h * 64 + ch * 8);
            bf16_t* vd = Vt + (ch * 8) * VSTR + key;
            vd[0] = (bf16_t)(rv[0] & 0xffff); vd[VSTR] = (bf16_t)(rv[0] >> 16); vd[2 * VSTR] = (bf16_t)(rv[1] & 0xffff); vd[3 * VSTR] = (bf16_t)(rv[1] >> 16);
            vd[4 * VSTR] = (bf16_t)(rv[2] & 0xffff); vd[5 * VSTR] = (bf16_t)(rv[2] >> 16); vd[6 * VSTR] = (bf16_t)(rv[3] & 0xffff); vd[7 * VSTR] = (bf16_t)(rv[3] >> 16);
        }
        {
            const float* st = p.rstate + (size_t)u * 2048;
#pragma unroll
            for (int i = 0; i < 8; ++i) { const int c = ht + i * 256, d = c >> 6, e = c & 63; St[e * SSTR + d] = f2bf(st[c]); }
        }
        __syncthreads();
        const int iq = 32 * w + r, t = t0 + iq;
        bf16x8 qf[2];
#pragma unroll
        for (int s = 0; s < 2; ++s) qf[s] = *(const bf16x8*)(rqb + (size_t)t * 128 + h * 32 + 16 * s + 8 * hh);
        f32x16 o0, o1;
#pragma unroll
        for (int i = 0; i < 16; ++i) { o0[i] = 0.f; o1[i] = 0.f; }
#pragma unroll
        for (int s = 0; s < 2; ++s) {
            const bf16x8 sa0 = *(const bf16x8*)(St + r * SSTR + 16 * s + 8 * hh), sa1 = *(const bf16x8*)(St + (32 + r) * SSTR + 16 * s + 8 * hh);
            o0 = __builtin_amdgcn_mfma_f32_32x32x16_bf16(sa0, qf[s], o0, 0, 0, 0);
            o1 = __builtin_amdgcn_mfma_f32_32x32x16_bf16(sa1, qf[s], o1, 0, 0, 0);
        }
        {
            const float xi = __builtin_amdgcn_exp2f((float)(iq + 1) * lg2);
#pragma unroll
            for (int i = 0; i < 16; ++i) { o0[i] *= xi; o1[i] *= xi; }
        }
        float cdec[16];
#pragma unroll
        for (int i = 0; i < 16; ++i) cdec[i] = __builtin_amdgcn_exp2f(-(float)((i & 3) + 8 * (i >> 2) + 4 * hh) * lg2);
        for (int jt = 0; jt <= w; ++jt) {
            f32x16 st;
#pragma unroll
            for (int i = 0; i < 16; ++i) st[i] = 0.f;
#pragma unroll
            for (int s = 0; s < 2; ++s) { const bf16x8 kf = *(const bf16x8*)(Ks + (32 * jt + r) * KSTR + 16 * s + 8 * hh); st = __builtin_amdgcn_mfma_f32_32x32x16_bf16(kf, qf[s], st, 0, 0, 0); }
            const float al = __builtin_amdgcn_exp2f((float)(32 * (w - jt) + r) * lg2);
            if (jt == w) {
#pragma unroll
                for (int i = 0; i < 16; ++i) { const int kr = (i & 3) + 8 * (i >> 2) + 4 * hh; st[i] = (kr <= r) ? st[i] * (al * cdec[i]) : 0.f; }
            } else {
#pragma unroll
                for (int i = 0; i < 16; ++i) st[i] *= al * cdec[i];
            }
#pragma unroll
            for (int s = 0; s < 2; ++s) {
                u32x4 pw; pw[0] = cvtpk(st[8 * s], st[8 * s + 1]); pw[1] = cvtpk(st[8 * s + 2], st[8 * s + 3]); pw[2] = cvtpk(st[8 * s + 4], st[8 * s + 5]); pw[3] = cvtpk(st[8 * s + 6], st[8 * s + 7]);
                const bf16x8 pf = __builtin_bit_cast(bf16x8, pw);
                const bf16_t* va = Vt + r * VSTR + 32 * jt + 16 * s + 4 * hh;
                const s16x4 a0 = *(const s16x4*)(va), a1 = *(const s16x4*)(va + 8), b0 = *(const s16x4*)(va + 32 * VSTR), b1 = *(const s16x4*)(va + 32 * VSTR + 8);
                o0 = __builtin_amdgcn_mfma_f32_32x32x16_bf16(__builtin_shufflevector(a0, a1, 0, 1, 2, 3, 4, 5, 6, 7), pf, o0, 0, 0, 0);
                o1 = __builtin_amdgcn_mfma_f32_32x32x16_bf16(__builtin_shufflevector(b0, b1, 0, 1, 2, 3, 4, 5, 6, 7), pf, o1, 0, 0, 0);
            }
        }
        float ss = 0.f;
#pragma unroll
        for (int i = 0; i < 16; ++i) ss += o0[i] * o0[i] + o1[i] * o1[i];
        ss = xhalf_sum(ss);
        const float rs = rsqrtf(ss * (1.0f / 64.0f) + 1e-6f);
        const float* ng = p.ret_norm_g + l * 256 + h * 64 + 4 * hh;
        const bf16_t* gp = p.pbuf + (size_t)t * NINP + PC_RG + h * 64 + 4 * hh;
        bf16_t* outp = p.mixcat + (size_t)t * 1024 + h * 64 + 4 * hh;
#pragma unroll
        for (int c = 0; c < 2; ++c)
#pragma unroll
            for (int g = 0; g < 4; ++g) {
                const int eo = 32 * c + 8 * g;
                const f32x4 gn = *(const f32x4*)(ng + eo); const uint2 gu = *(const uint2*)(gp + eo);
                const float g0 = __uint_as_float(gu.x << 16), g1 = __uint_as_float(gu.x & 0xffff0000u), g2 = __uint_as_float(gu.y << 16), g3 = __uint_as_float(gu.y & 0xffff0000u);
                const float v0 = (c ? o1[4 * g] : o0[4 * g]) * rs * gn[0], v1 = (c ? o1[4 * g + 1] : o0[4 * g + 1]) * rs * gn[1], v2 = (c ? o1[4 * g + 2] : o0[4 * g + 2]) * rs * gn[2], v3 = (c ? o1[4 * g + 3] : o0[4 * g + 3]) * rs * gn[3];
                uint2 ov; ov.x = cvtpk(g0 * sigmoidf_(g0) * v0, g1 * sigmoidf_(g1) * v1); ov.y = cvtpk(g2 * sigmoidf_(g2) * v2, g3 * sigmoidf_(g3) * v3);
                *(uint2*)(outp + eo) = ov;
            }
    }
}

__device__ __forceinline__ void ph_dil_attn(const Params& pkv, KPtr kp_in, int wbase_in, int l, char* lds) {
    PH_HEAD
    constexpr int KSTR = 72, VSTR = 68;
    bf16_t* Ks = (bf16_t*)lds;
    bf16_t* Vt = Ks + 64 * KSTR;
    const int tid = TID, lane = tid & 63, wv = tid >> 6, r = lane & 31, h = lane >> 5;
    int* wq = p.wq + l * 16 + 1;
    volatile int* wslot = (volatile int*)(lds + 24576);
    for (;;) {
        __syncthreads();
        if (tid == 0) *wslot = atomicAdd(wq, 1);
        __syncthreads();
        const int it = __builtin_amdgcn_readfirstlane(*wslot);
        if (it >= 16 * 96) break;
        const int bh = it & 15, u = it >> 4;
        const int b = bh >> 2, hd = bh & 3;
        int pat, dil, rr, m0;
        if (u < 32) { pat = 0; dil = 1; rr = 0; m0 = u * 256; }
        else if (u < 64) { pat = 1; dil = 4; rr = (u - 32) >> 3; m0 = ((u - 32) & 7) * 256; }
        else { pat = 2; dil = 16; rr = (u - 64) >> 1; m0 = ((u - 64) & 1) * 256; }
        const int qmin = m0 + 32 * wv, qmax = qmin + 31, myq = qmin + r;
        const size_t tok0 = (size_t)b * SEQ + rr;
        bf16x8 qf[4];
        {
            const bf16_t* qrow = (const bf16_t*)p.dq + (tok0 + (size_t)dil * myq) * 256 + hd * 64 + 8 * h;
#pragma unroll
            for (int s = 0; s < 4; ++s) qf[s] = *(const bf16x8*)(qrow + 16 * s);
        }
        f32x16 o0, o1;
#pragma unroll
        for (int i = 0; i < 16; ++i) { o0[i] = 0.f; o1[i] = 0.f; }
        float m = -1e30f, lsum = 0.f;
        const int kk = tid >> 3, kc = tid & 7, vk = tid & 63, vc = tid >> 6;
        const bf16_t* kbase = (const bf16_t*)p.dk + hd * 64 + kc * 8;
        const bf16_t* vbase = p.pbuf + PC_DV + hd * 64 + vc * 8;
        const int j0 = (m0 == 0) ? 2 : 0;
        u32x4 rk, rv;
        {
            const int kb = m0 - 128 + 64 * j0;
            rk = *(const u32x4*)(kbase + (tok0 + (size_t)dil * (kb + kk)) * 256);
            rv = *(const u32x4*)(vbase + (tok0 + (size_t)dil * (kb + vk)) * NINP);
        }
        for (int j = j0; j < 6; ++j) {
            __syncthreads();
            *(u32x4*)(Ks + kk * KSTR + kc * 8) = rk;
            {
                const unsigned w0 = rv[0], w1 = rv[1], w2 = rv[2], w3 = rv[3];
                bf16_t* vd = Vt + (vc * 8) * VSTR + vk;
                vd[0] = (bf16_t)(w0 & 0xffff); vd[VSTR] = (bf16_t)(w0 >> 16); vd[2 * VSTR] = (bf16_t)(w1 & 0xffff); vd[3 * VSTR] = (bf16_t)(w1 >> 16);
                vd[4 * VSTR] = (bf16_t)(w2 & 0xffff); vd[5 * VSTR] = (bf16_t)(w2 >> 16); vd[6 * VSTR] = (bf16_t)(w3 & 0xffff); vd[7 * VSTR] = (bf16_t)(w3 >> 16);
            }
            __syncthreads();
            const int kb = m0 - 128 + 64 * j;
            if (j + 1 < 6) {
                const int kn = kb + 64;
                rk = *(const u32x4*)(kbase + (tok0 + (size_t)dil * (kn + kk)) * 256);
                rv = *(const u32x4*)(vbase + (tok0 + (size_t)dil * (kn + vk)) * NINP);
            }
            const bool need0 = (kb <= qmax) && (kb + 31 >= qmin - 128);
            const bool need1 = (kb + 32 <= qmax) && (kb + 63 >= qmin - 128);
            if (need0 || need1) {
                f32x16 s0, s1;
#pragma unroll
                for (int i = 0; i < 16; ++i) { s0[i] = -3e38f; s1[i] = -3e38f; }
                if (need0) {
#pragma unroll
                    for (int i = 0; i < 16; ++i) s0[i] = 0.f;
#pragma unroll
                    for (int s = 0; s < 4; ++s) { const bf16x8 kf = *(const bf16x8*)(Ks + r * KSTR + 16 * s + 8 * h); s0 = __builtin_amdgcn_mfma_f32_32x32x16_bf16(kf, qf[s], s0, 0, 0, 0); }
                    if (!((kb + 31 <= qmin) && (kb >= qmax - 128))) {
#pragma unroll
                        for (int i = 0; i < 16; ++i) { const int key = kb + (i & 3) + 8 * (i >> 2) + 4 * h; if (key > myq || key < myq - 128) s0[i] = -3e38f; }
                    }
                }
                if (need1) {
#pragma unroll
                    for (int i = 0; i < 16; ++i) s1[i] = 0.f;
#pragma unroll
                    for (int s = 0; s < 4; ++s) { const bf16x8 kf = *(const bf16x8*)(Ks + (32 + r) * KSTR + 16 * s + 8 * h); s1 = __builtin_amdgcn_mfma_f32_32x32x16_bf16(kf, qf[s], s1, 0, 0, 0); }
                    if (!((kb + 63 <= qmin) && (kb + 32 >= qmax - 128))) {
#pragma unroll
                        for (int i = 0; i < 16; ++i) { const int key = kb + 32 + (i & 3) + 8 * (i >> 2) + 4 * h; if (key > myq || key < myq - 128) s1[i] = -3e38f; }
                    }
                }
                float mx = s0[0];
#pragma unroll
                for (int i = 1; i < 16; ++i) mx = fmaxf(mx, s0[i]);
#pragma unroll
                for (int i = 0; i < 16; ++i) mx = fmaxf(mx, s1[i]);
                mx = xhalf_max(mx);
                const float mn = fmaxf(m, mx), alpha = __builtin_amdgcn_exp2f(m - mn);
                m = mn;
                float ps = 0.f;
                if (need0) {
#pragma unroll
                    for (int i = 0; i < 16; ++i) { s0[i] = __builtin_amdgcn_exp2f(s0[i] - mn); ps += s0[i]; }
                }
                if (need1) {
#pragma unroll
                    for (int i = 0; i < 16; ++i) { s1[i] = __builtin_amdgcn_exp2f(s1[i] - mn); ps += s1[i]; }
                }
                lsum = lsum * alpha + ps;
                if (!__all(alpha == 1.0f)) {
#pragma unroll
                    for (int i = 0; i < 16; ++i) { o0[i] *= alpha; o1[i] *= alpha; }
                }
                if (need0) {
#pragma unroll
                    for (int s = 0; s < 2; ++s) {
                        u32x4 pw; pw[0] = cvtpk(s0[8 * s], s0[8 * s + 1]); pw[1] = cvtpk(s0[8 * s + 2], s0[8 * s + 3]); pw[2] = cvtpk(s0[8 * s + 4], s0[8 * s + 5]); pw[3] = cvtpk(s0[8 * s + 6], s0[8 * s + 7]);
                        const bf16x8 pf = __builtin_bit_cast(bf16x8, pw);
                        const bf16_t* va = Vt + r * VSTR + 16 * s + 4 * h;
                        const s16x4 a0 = *(const s16x4*)(va), a1 = *(const s16x4*)(va + 8), b0 = *(const s16x4*)(va + 32 * VSTR), b1 = *(const s16x4*)(va + 32 * VSTR + 8);
                        o0 = __builtin_amdgcn_mfma_f32_32x32x16_bf16(__builtin_shufflevector(a0, a1, 0, 1, 2, 3, 4, 5, 6, 7), pf, o0, 0, 0, 0);
                        o1 = __builtin_amdgcn_mfma_f32_32x32x16_bf16(__builtin_shufflevector(b0, b1, 0, 1, 2, 3, 4, 5, 6, 7), pf, o1, 0, 0, 0);
                    }
                }
                if (need1) {
#pragma unroll
                    for (int s = 0; s < 2; ++s) {
                        u32x4 pw; pw[0] = cvtpk(s1[8 * s], s1[8 * s + 1]); pw[1] = cvtpk(s1[8 * s + 2], s1[8 * s + 3]); pw[2] = cvtpk(s1[8 * s + 4], s1[8 * s + 5]); pw[3] = cvtpk(s1[8 * s + 6], s1[8 * s + 7]);
                        const bf16x8 pf = __builtin_bit_cast(bf16x8, pw);
                        const bf16_t* va = Vt + r * VSTR + 32 + 16 * s + 4 * h;
                        const s16x4 a0 = *(const s16x4*)(va), a1 = *(const s16x4*)(va + 8), b0 = *(const s16x4*)(va + 32 * VSTR), b1 = *(const s16x4*)(va + 32 * VSTR + 8);
                        o0 = __builtin_amdgcn_mfma_f32_32x32x16_bf16(__builtin_shufflevector(a0, a1, 0, 1, 2, 3, 4, 5, 6, 7), pf, o0, 0, 0, 0);
                        o1 = __builtin_amdgcn_mfma_f32_32x32x16_bf16(__builtin_shufflevector(b0, b1, 0, 1, 2, 3, 4, 5, 6, 7), pf, o1, 0, 0, 0);
                    }
                }
            }
        }
        const float lt = xhalf_sum(lsum), inv = 1.0f / lt;
        const size_t tq = tok0 + (size_t)dil * myq;
        float* op = p.dob + ((size_t)pat * NT + tq) * 256 + hd * 64 + 4 * h;
#pragma unroll
        for (int g = 0; g < 4; ++g) {
            *(f32x4*)(op + 8 * g) = (f32x4){o0[4 * g] * inv, o0[4 * g + 1] * inv, o0[4 * g + 2] * inv, o0[4 * g + 3] * inv};
            *(f32x4*)(op + 32 + 8 * g) = (f32x4){o1[4 * g] * inv, o1[4 * g + 1] * inv, o1[4 * g + 2] * inv, o1[4 * g + 3] * inv};
        }
        if (h == 0) p.dlse[((size_t)pat * NT + tq) * 4 + hd] = m + __builtin_amdgcn_logf(lt);
        __syncthreads();
    }
}

__device__ __forceinline__ void ph_rwkv_prep(const Params& pkv, KPtr kp_in, int wbase_in, int l, char* lds) {
    PH_HEAD
    bf16_t* Aw = (bf16_t*)lds; bf16_t* Aa = Aw + 64 * 72; bf16_t* Ag = Aa + 64 * 72; bf16_t* Av = Ag + 64 * 136; float* ssq = (float*)(Av + 64 * 40);
    const int tid = TID, lane = tid & 63, wv = tid >> 6, fr = lane & 15, fq = lane >> 4;
    const int lm = (l > 0) ? l - 1 : 0;
    const float* mu = p.rwkv_mu + l * 1024; const float* vmu = p.vres_mu + lm * 32;
    bf16x8 fw[2][2], fa[2][2], fg[2][4], fv[2];
#pragma unroll
    for (int ni = 0; ni < 2; ++ni) {
        const int n = 32 * wv + 16 * ni + fr;
#pragma unroll
        for (int ks = 0; ks < 2; ++ks) { fw[ni][ks] = *(const bf16x8*)(p.wupt + ((size_t)l * 256 + n) * 64 + 32 * ks + 8 * fq); fa[ni][ks] = *(const bf16x8*)(p.aupt + ((size_t)l * 256 + n) * 64 + 32 * ks + 8 * fq); }
#pragma unroll
        for (int ks = 0; ks < 4; ++ks) fg[ni][ks] = *(const bf16x8*)(p.gupt + ((size_t)l * 256 + n) * 128 + 32 * ks + 8 * fq);
        fv[ni] = *(const bf16x8*)(p.vupt + ((size_t)lm * 256 + n) * 32 + 8 * fq);
    }
    for (int tb = BID * 64; tb < NT; tb += gridDim.x * 64) {
        __syncthreads();
        for (int e = tid; e < 64 * 144; e += NTHREADS) {
            const int tt = e / 144, j = (e % 144) * 2, t = tb + tt;
            const bool first = (t % SEQ) == 0;
            const bf16_t* pr = p.pbuf + (size_t)t * NINP;
            int col; float m0, m1;
            if (j < 256) { col = PC_CWD + j; m0 = mu[768 + j]; m1 = mu[768 + j + 1]; } else { col = PC_VRES + (j - 256); m0 = vmu[j - 256]; m1 = vmu[j - 255]; }
            const unsigned cu = *(const unsigned*)(pr + col), pu = first ? 0u : *(const unsigned*)(pr + col - NINP);
            const float c0 = __uint_as_float(cu << 16), c1 = __uint_as_float(cu & 0xffff0000u), p0 = __uint_as_float(pu << 16), p1 = __uint_as_float(pu & 0xffff0000u);
            float x0 = c0 + (p0 - c0) * m0, x1 = c1 + (p1 - c1) * m1;
            bf16_t* dst;
            if (j < 64) { x0 = 1.0f - 2.0f * __builtin_amdgcn_rcpf(__builtin_amdgcn_exp2f(x0 * 2.8853900817779268f) + 1.0f); x1 = 1.0f - 2.0f * __builtin_amdgcn_rcpf(__builtin_amdgcn_exp2f(x1 * 2.8853900817779268f) + 1.0f); dst = Aw + tt * 72 + j; }
            else if (j < 128) { dst = Aa + tt * 72 + (j - 64); }
            else if (j < 256) { x0 = sigmoidf_(x0); x1 = sigmoidf_(x1); dst = Ag + tt * 136 + (j - 128); }
            else { dst = Av + tt * 40 + (j - 256); }
            *(unsigned*)dst = cvtpk(x0, x1);
        }
        {
            const f32x4 kkc = *(const f32x4*)(p.rwkv_k_k + l * 256 + lane * 4), mk4 = *(const f32x4*)(mu + 256 + lane * 4);
#pragma unroll
            for (int i = 0; i < 8; ++i) {
                const int tt = wv * 8 + i, t = tb + tt; const bool first = (t % SEQ) == 0;
                const bf16_t* pr = p.pbuf + (size_t)t * NINP + PC_CK + lane * 4;
                const uint2 cu = *(const uint2*)pr; const uint2 pu = first ? make_uint2(0u, 0u) : *(const uint2*)(pr - NINP);
                const float c0 = __uint_as_float(cu.x << 16), c1 = __uint_as_float(cu.x & 0xffff0000u), c2 = __uint_as_float(cu.y << 16), c3 = __uint_as_float(cu.y & 0xffff0000u);
                const float q0 = __uint_as_float(pu.x << 16), q1 = __uint_as_float(pu.x & 0xffff0000u), q2 = __uint_as_float(pu.y << 16), q3 = __uint_as_float(pu.y & 0xffff0000u);
                const float k0 = (c0 + (q0 - c0) * mk4[0]) * kkc[0], k1 = (c1 + (q1 - c1) * mk4[1]) * kkc[1], k2 = (c2 + (q2 - c2) * mk4[2]) * kkc[2], k3 = (c3 + (q3 - c3) * mk4[3]) * kkc[3];
                const float ss = grp16_sum(k0 * k0 + k1 * k1 + k2 * k2 + k3 * k3);
                if ((lane & 15) == 0) ssq[tt * 4 + (lane >> 4)] = ss;
            }
        }
        __syncthreads();
#pragma unroll 1
        for (int mt = 0; mt < 4; ++mt) {
            f32x4 cw[2], ca[2], cg[2], cv[2];
#pragma unroll
            for (int ni = 0; ni < 2; ++ni) { cw[ni] = (f32x4){0.f, 0.f, 0.f, 0.f}; ca[ni] = cw[ni]; cg[ni] = cw[ni]; cv[ni] = cw[ni]; }
            const int arow = 16 * mt + fr;
#pragma unroll
            for (int ks = 0; ks < 2; ++ks) {
                const bf16x8 xw = *(const bf16x8*)(Aw + arow * 72 + 32 * ks + 8 * fq), xa = *(const bf16x8*)(Aa + arow * 72 + 32 * ks + 8 * fq);
#pragma unroll
                for (int ni = 0; ni < 2; ++ni) { cw[ni] = __builtin_amdgcn_mfma_f32_16x16x32_bf16(fw[ni][ks], xw, cw[ni], 0, 0, 0); ca[ni] = __builtin_amdgcn_mfma_f32_16x16x32_bf16(fa[ni][ks], xa, ca[ni], 0, 0, 0); }
            }
#pragma unroll
            for (int ks = 0; ks < 4; ++ks) {
                const bf16x8 xg = *(const bf16x8*)(Ag + arow * 136 + 32 * ks + 8 * fq);
#pragma unroll
                for (int ni = 0; ni < 2; ++ni) cg[ni] = __builtin_amdgcn_mfma_f32_16x16x32_bf16(fg[ni][ks], xg, cg[ni], 0, 0, 0);
            }
            if (l > 0) {
                const bf16x8 xv = *(const bf16x8*)(Av + arow * 40 + 8 * fq);
#pragma unroll
                for (int ni = 0; ni < 2; ++ni) cv[ni] = __builtin_amdgcn_mfma_f32_16x16x32_bf16(fv[ni], xv, cv[ni], 0, 0, 0);
            }
            const int tt = 16 * mt + fr, t = tb + tt; const bool first = (t % SEQ) == 0;
            const float rn = 1.0f / fmaxf(sqrtf(ssq[tt * 4 + (wv >> 1)]), 1e-12f);
            const bf16_t* pr = p.pbuf + (size_t)t * NINP;
#pragma unroll
            for (int ni = 0; ni < 2; ++ni) {
                const int c0 = 32 * wv + 16 * ni + 4 * fq;
                const f32x4 w0 = *(const f32x4*)(p.rwkv_w0 + l * 256 + c0), a0 = *(const f32x4*)(p.rwkv_a0 + l * 256 + c0), kkc = *(const f32x4*)(p.rwkv_k_k + l * 256 + c0), kac = *(const f32x4*)(p.rwkv_k_a + l * 256 + c0);
                const f32x4 v0 = *(const f32x4*)(p.rwkv_v0 + lm * 256 + c0), mr = *(const f32x4*)(mu + c0), mk = *(const f32x4*)(mu + 256 + c0), mv = *(const f32x4*)(mu + 512 + c0);
                const uint2 ru = *(const uint2*)(pr + PC_CR + c0), ku = *(const uint2*)(pr + PC_CK + c0), vu = *(const uint2*)(pr + PC_CV + c0);
                uint2 rp = make_uint2(0u, 0u), kp2 = rp, vp = rp;
                if (!first) { rp = *(const uint2*)(pr + PC_CR + c0 - NINP); kp2 = *(const uint2*)(pr + PC_CK + c0 - NINP); vp = *(const uint2*)(pr + PC_CV + c0 - NINP); }
                const size_t o = (size_t)t * 256 + c0;
                f32x4 vf = (f32x4){0.f, 0.f, 0.f, 0.f};
                if (l > 0) vf = *(const f32x4*)(p.vfirst + o);
                f32x4 o_r, o_w, o_k, o_v, o_a, o_b;
#pragma unroll
                for (int j = 0; j < 4; ++j) {
                    const unsigned rw = (j < 2) ? ru.x : ru.y, kw = (j < 2) ? ku.x : ku.y, vw = (j < 2) ? vu.x : vu.y, rpw = (j < 2) ? rp.x : rp.y, kpw = (j < 2) ? kp2.x : kp2.y, vpw = (j < 2) ? vp.x : vp.y;
                    const float rc = (j & 1) ? __uint_as_float(rw & 0xffff0000u) : __uint_as_float(rw << 16), kc = (j & 1) ? __uint_as_float(kw & 0xffff0000u) : __uint_as_float(kw << 16), vc = (j & 1) ? __uint_as_float(vw & 0xffff0000u) : __uint_as_float(vw << 16);
                    const float rq = (j & 1) ? __uint_as_float(rpw & 0xffff0000u) : __uint_as_float(rpw << 16), kq = (j & 1) ? __uint_as_float(kpw & 0xffff0000u) : __uint_as_float(kpw << 16), vq = (j & 1) ? __uint_as_float(vpw & 0xffff0000u) : __uint_as_float(vpw << 16);
                    const float r = rc + (rq - rc) * mr[j], k = kc + (kq - kc) * mk[j];
                    float v = vc + (vq - vc) * mv[j];
                    const float wpre = w0[j] + cw[ni][j];
                    const float sp = (-wpre > 20.f) ? -wpre : 0.6931471805599453f * __builtin_amdgcn_logf(1.0f + __builtin_amdgcn_exp2f(wpre * -1.4426950408889634f));
                    const float decay = __builtin_amdgcn_exp2f(-1.4426950408889634f * __builtin_amdgcn_exp2f((-sp - 0.5f) * 1.4426950408889634f));
                    const float a = sigmoidf_(a0[j] + ca[ni][j]);
                    const float kk = k * kkc[j] * rn;
                    const float k2 = k * (1.0f + (a - 1.0f) * kac[j]);
                    if (l == 0) vf[j] = v; else v = v + (vf[j] - v) * sigmoidf_(v0[j] + cv[ni][j]);
                    o_r[j] = r; o_w[j] = decay; o_k[j] = k2; o_v[j] = v; o_a[j] = -kk; o_b[j] = kk * a;
                }
                if (l == 0) *(f32x4*)(p.vfirst + o) = vf;
                *(f32x4*)(p.sr + o) = o_r; *(f32x4*)(p.sw + o) = o_w; *(f32x4*)(p.sk + o) = o_k; *(f32x4*)(p.sv + o) = o_v; *(f32x4*)(p.sa + o) = o_a; *(f32x4*)(p.sb + o) = o_b; *(f32x4*)(p.sg + o) = cg[ni];
            }
        }
    }
}

#define MF4(a, b, c) __builtin_amdgcn_mfma_f32_16x16x4f32((a), (b), (c), 0, 0, 0)
#define WSYNC() asm volatile("s_waitcnt lgkmcnt(0)" ::: "memory")
__device__ __forceinline__ f32x4 mm16(const float* A, int sam, int sak, const float* B, int sbk, int sbn, int K, f32x4 acc, int fr, int fq) {
#pragma unroll 4
    for (int kk = 0; kk < K; kk += 4) { const float a = A[fr * sam + (kk + fq) * sak]; const float b = B[(kk + fq) * sbk + fr * sbn]; acc = MF4(a, b, acc); }
    return acc;
}
constexpr int CH_T = 16, CH_N = SEQ / CH_T, CH_LD = 68, CH_WAVE_FLOATS = 6 * 16 * CH_LD + 5 * 16 * 17 + 64;
__device__ __forceinline__ void ph_rwkv_chunkpre(const Params& pkv, KPtr kp_in, int wbase_in, int l, char* lds) {
    PH_HEAD
    const int tid = TID, lane = tid & 63, wv = tid >> 6, fr = lane & 15, fq = lane >> 4;
    if (wv >= 4) return;
    float* L = (float*)lds + wv * CH_WAVE_FLOATS;
    float* At = L; float* Bt = At + 16 * CH_LD; float* Kt = Bt + 16 * CH_LD; float* Rt = Kt + 16 * CH_LD; float* Vv = Rt + 16 * CH_LD; float* W1 = Vv + 16 * CH_LD;
    float* Pst = (float*)lds + 4 * CH_WAVE_FLOATS + wv * 1024;
    float* Aab = W1 + 16 * CH_LD; float* Aak = Aab + 16 * 17; float* Arb = Aak + 16 * 17; float* Ark = Arb + 16 * 17; float* Mm = Ark + 16 * 17; float* gT = Mm + 16 * 17;
    const f32x4 z4 = (f32x4){0.f, 0.f, 0.f, 0.f};
    for (int u = BID * 4 + wv; u < 16 * CH_N; u += gridDim.x * 4) {
        const int bh = u / CH_N, c = u % CH_N, b = bh >> 2, hd = bh & 3;
        const size_t o0 = ((size_t)b * SEQ + (size_t)c * CH_T) * 256 + hd * 64 + lane;
        WSYNC();
        {
            float g = 1.0f;
#pragma unroll
            for (int t = 0; t < CH_T; ++t) {
                const size_t o = o0 + (size_t)t * 256;
                const float w = p.sw[o], a = p.sa[o], bb = p.sb[o], k = p.sk[o], r = p.sr[o], v = p.sv[o];
                const float gp = g; g *= w; const float ig = 1.0f / g;
                At[t * CH_LD + lane] = a * gp; Bt[t * CH_LD + lane] = bb * ig; Kt[t * CH_LD + lane] = k * ig; Rt[t * CH_LD + lane] = r * g; Vv[t * CH_LD + lane] = v;
            }
            gT[lane] = g;
        }
        WSYNC();
        {
            f32x4 gab = z4, gak = z4, grb = z4, grk = z4;
#pragma unroll
            for (int k0 = 0; k0 < 64; k0 += 32) {
                float aA[8], aR[8], bB[8], bK[8];
#pragma unroll
                for (int q = 0; q < 8; ++q) { const int o = fr * CH_LD + k0 + 4 * q + fq; aA[q] = At[o]; aR[q] = Rt[o]; bB[q] = Bt[o]; bK[q] = Kt[o]; }
                WSYNC(); __builtin_amdgcn_sched_barrier(0);
#pragma unroll
                for (int q = 0; q < 8; ++q) { gab = MF4(aA[q], bB[q], gab); gak = MF4(aA[q], bK[q], gak); grb = MF4(aR[q], bB[q], grb); grk = MF4(aR[q], bK[q], grk); }
            }
#pragma unroll
            for (int rg = 0; rg < 4; ++rg) {
                const int t = 4 * fq + rg, s = fr;
                Aab[t * 17 + s] = (s < t) ? gab[rg] : 0.f; Aak[t * 17 + s] = (s < t) ? gak[rg] : 0.f;
                Arb[t * 17 + s] = (s <= t) ? grb[rg] : 0.f; Ark[t * 17 + s] = (s <= t) ? grk[rg] : 0.f;
            }
        }
        WSYNC();
        {
            float m[16];
#pragma unroll
            for (int t = 0; t < 16; ++t) {
                float acc = (t == fr) ? 1.0f : 0.f;
#pragma unroll
                for (int s = 0; s < t; ++s) acc += Aab[t * 17 + s] * m[s];
                m[t] = acc;
            }
            if (fq == 0) {
#pragma unroll
                for (int t = 0; t < 16; ++t) Mm[t * 17 + fr] = m[t];
            }
        }
        WSYNC();
        {
            f32x4 m2 = z4, ah[4] = {z4, z4, z4, z4};
#pragma unroll
            for (int kk = 0; kk < 16; kk += 4) {
                const float a = Mm[fr * 17 + kk + fq];
                m2 = MF4(a, Aak[(kk + fq) * 17 + fr], m2);
#pragma unroll
                for (int nt = 0; nt < 4; ++nt) ah[nt] = MF4(a, At[(kk + fq) * CH_LD + 16 * nt + fr], ah[nt]);
            }
            WSYNC();
#pragma unroll
            for (int rg = 0; rg < 4; ++rg) {
                Aak[(4 * fq + rg) * 17 + fr] = m2[rg];
#pragma unroll
                for (int nt = 0; nt < 4; ++nt) At[(4 * fq + rg) * CH_LD + 16 * nt + fr] = ah[nt][rg];
            }
            WSYNC();
            f32x4 w1[4] = {z4, z4, z4, z4};
#pragma unroll
            for (int kk = 0; kk < 16; kk += 4) {
                const float a = Aak[fr * 17 + kk + fq];
#pragma unroll
                for (int nt = 0; nt < 4; ++nt) w1[nt] = MF4(a, Vv[(kk + fq) * CH_LD + 16 * nt + fr], w1[nt]);
            }
#pragma unroll
            for (int nt = 0; nt < 4; ++nt)
#pragma unroll
                for (int rg = 0; rg < 4; ++rg) W1[(4 * fq + rg) * CH_LD + 16 * nt + fr] = w1[nt][rg];
        }
        WSYNC();
        {
            float* rh = p.c_rh + (size_t)u * 1024; float* y1 = p.c_y1 + (size_t)u * 1024;
            f32x4 ar[4], yy[4];
#pragma unroll
            for (int nt = 0; nt < 4; ++nt) {
                yy[nt] = z4;
#pragma unroll
                for (int rg = 0; rg < 4; ++rg) ar[nt][rg] = Rt[(4 * fq + rg) * CH_LD + 16 * nt + fr];
            }
#pragma unroll
            for (int kk = 0; kk < 16; kk += 4) {
                const float arb = Arb[fr * 17 + kk + fq], ark = Ark[fr * 17 + kk + fq];
#pragma unroll
                for (int nt = 0; nt < 4; ++nt) {
                    const int bo = (kk + fq) * CH_LD + 16 * nt + fr;
                    ar[nt] = MF4(arb, At[bo], ar[nt]); yy[nt] = MF4(arb, W1[bo], yy[nt]); yy[nt] = MF4(ark, Vv[bo], yy[nt]);
                }
            }
#pragma unroll
            for (int nt = 0; nt < 4; ++nt)
#pragma unroll
                for (int rg = 0; rg < 4; ++rg) Pst[(4 * fq + rg) * 64 + 16 * nt + fr] = ar[nt][rg];
            WSYNC();
#pragma unroll
            for (int i = 0; i < 4; ++i) *(f32x4*)(rh + (i * 64 + lane) * 4) = *(const f32x4*)(Pst + (i * 64 + lane) * 4);
            WSYNC();
#pragma unroll
            for (int nt = 0; nt < 4; ++nt)
#pragma unroll
                for (int rg = 0; rg < 4; ++rg) Pst[(4 * fq + rg) * 64 + 16 * nt + fr] = yy[nt][rg];
            WSYNC();
#pragma unroll
            for (int i = 0; i < 4; ++i) *(f32x4*)(y1 + (i * 64 + lane) * 4) = *(const f32x4*)(Pst + (i * 64 + lane) * 4);
            WSYNC();
        }
        {
            float* pp = p.c_p + (size_t)u * 4096; float* qq = p.c_q + (size_t)u * 4096;
#pragma unroll 1
            for (int jt = 0; jt < 4; ++jt) {
                f32x4 ap[4] = {z4, z4, z4, z4}, aq[4] = {z4, z4, z4, z4};
                {
                    float a_ah[4], a_w1[4], a_v[4], b_bt[4][4], b_kt[4][4];
#pragma unroll
                    for (int q = 0; q < 4; ++q) {
                        const int ao = (4 * q + fq) * CH_LD + 16 * jt + fr;
                        a_ah[q] = At[ao]; a_w1[q] = W1[ao]; a_v[q] = Vv[ao];
#pragma unroll
                        for (int jc = 0; jc < 4; ++jc) { const int bo = (4 * q + fq) * CH_LD + 16 * jc + fr; b_bt[q][jc] = Bt[bo]; b_kt[q][jc] = Kt[bo]; }
                    }
                    WSYNC(); __builtin_amdgcn_sched_barrier(0);
#pragma unroll
                    for (int q = 0; q < 4; ++q)
#pragma unroll
                        for (int jc = 0; jc < 4; ++jc) { ap[jc] = MF4(a_ah[q], b_bt[q][jc], ap[jc]); aq[jc] = MF4(a_w1[q], b_bt[q][jc], aq[jc]); aq[jc] = MF4(a_v[q], b_kt[q][jc], aq[jc]); }
                }
                WSYNC();
#pragma unroll
                for (int jc = 0; jc < 4; ++jc) {
                    const float gc = gT[16 * jc + fr];
#pragma unroll
                    for (int rg = 0; rg < 4; ++rg) {
                        const int row = 16 * jt + 4 * fq + rg, col = 16 * jc + fr;
                        Pst[(jc * 64 + 16 * rg + fr) * 4 + fq] = (ap[jc][rg] + ((row == col) ? 1.0f : 0.f)) * gc; aq[jc][rg] *= gc;
                    }
                }
                WSYNC();
#pragma unroll
                for (int i = 0; i < 4; ++i) *(f32x4*)(pp + ((jt * 4 + i) * 64 + lane) * 4) = *(const f32x4*)(Pst + (i * 64 + lane) * 4);
                WSYNC();
#pragma unroll
                for (int jc = 0; jc < 4; ++jc)
#pragma unroll
                    for (int rg = 0; rg < 4; ++rg) Pst[(4 * fq + rg) * 64 + 16 * jc + fr] = aq[jc][rg];
                WSYNC();
#pragma unroll
                for (int i = 0; i < 4; ++i) *(f32x4*)(qq + (size_t)jt * 1024 + (i * 64 + lane) * 4) = *(const f32x4*)(Pst + (i * 64 + lane) * 4);
            }
        }
    }
}

constexpr int SCANB_BLOCKS = 64;
__device__ __forceinline__ void ph_rwkv_scan(const Params& pkv, KPtr kp_in, int wbase_in, int l, char* lds) {
    PH_HEAD
    if (BID >= SCANB_BLOCKS) return;
    const int tid = TID, lane = tid & 63, wv = tid >> 6, fr = lane & 15, fq = lane >> 4, w = wv & 3;
    const int bh = (BID & 7) + 8 * (BID >> 5), ib = (BID >> 3) & 3, b = bh >> 2, hd = bh & 3, ibase = ib * 16;
    float* exch = (float*)lds;
    float* ypart = (float*)lds + 4096;
    for (int i = tid; i < 8192; i += NTHREADS) ((float*)lds)[i] = 0.f;
    if (wv >= 4) {
        __syncthreads();
        for (int c = 0; c < CH_N; ++c) { __builtin_amdgcn_s_barrier(); }
        return;
    }
    f32x4 cur = (f32x4){0.f, 0.f, 0.f, 0.f};
    const size_t ubase = (size_t)bh * CH_N;
    f32x4 pa[4][4]; f32x4 qv[4], rh[4]; float y1v[4];
#define SCAN_LOAD(S, cc) do { const size_t un_ = ubase + ((cc) < CH_N ? (cc) : CH_N - 1); \
        const f32x4* pp_ = (const f32x4*)(p.c_p + un_ * 4096 + (w * 64 + lane) * 4); \
        pa[S][0] = pp_[0]; pa[S][1] = pp_[256]; pa[S][2] = pp_[512]; pa[S][3] = pp_[768]; \
        qv[S] = *(const f32x4*)(p.c_q + un_ * 4096 + (ibase + fr) * 64 + 16 * w + 4 * fq); \
        rh[S] = *(const f32x4*)(p.c_rh + un_ * 1024 + fr * 64 + 16 * w + 4 * fq); \
        y1v[S] = p.c_y1[un_ * 1024 + (4 * w + fq) * 64 + ibase + fr]; } while (0)
#define SCAN_STEP(S, cc) do { const int bufo = ((cc) & 1) * 2048; \
        float exv[16]; { const float* ex = exch + bufo; _Pragma("unroll") for (int kk = 0; kk < 16; ++kk) exv[kk] = ex[64 * kk + lane]; } \
        __builtin_amdgcn_sched_barrier(0); \
        f32x4 yp = (f32x4){0.f, 0.f, 0.f, 0.f}; \
        _Pragma("unroll") for (int rg = 0; rg < 4; ++rg) yp = MF4(rh[S][rg], cur[rg], yp); \
        asm volatile("s_waitcnt lgkmcnt(0)" ::: "memory"); __builtin_amdgcn_sched_barrier(0); \
        f32x4 acc0 = qv[S], acc1 = (f32x4){0.f, 0.f, 0.f, 0.f}; \
        _Pragma("unroll") for (int kq = 0; kq < 4; ++kq) { \
            acc0 = MF4(pa[S][kq][0], exv[4 * kq], acc0); acc1 = MF4(pa[S][kq][1], exv[4 * kq + 1], acc1); \
            acc0 = MF4(pa[S][kq][2], exv[4 * kq + 2], acc0); acc1 = MF4(pa[S][kq][3], exv[4 * kq + 3], acc1); } \
        cur = acc0 + acc1; \
        { float* yd = ypart + bufo + w * 256; _Pragma("unroll") for (int rg = 0; rg < 4; ++rg) yd[(4 * fq + rg) * 16 + fr] = yp[rg]; } \
        { float* ed = exch + (2048 - bufo) + (16 * w) * 16; _Pragma("unroll") for (int rg = 0; rg < 4; ++rg) ed[(4 * fq + rg) * 16 + fr] = cur[rg]; } \
        asm volatile("s_waitcnt lgkmcnt(0)" ::: "memory"); __builtin_amdgcn_s_barrier(); asm volatile("" ::: "memory"); \
        { const float* ys = ypart + bufo + (4 * w + fq) * 16 + fr; const float y = (ys[0] + ys[256]) + (ys[512] + ys[768]) + y1v[S]; \
          p.sy[((size_t)b * SEQ + (size_t)(cc) * CH_T + 4 * w + fq) * 256 + hd * 64 + ibase + fr] = y; } \
        SCAN_LOAD(S, (cc) + 4); } while (0)
    SCAN_LOAD(0, 0); SCAN_LOAD(1, 1); SCAN_LOAD(2, 2); SCAN_LOAD(3, 3);
    __syncthreads();
    for (int c = 0; c < CH_N; c += 4) { SCAN_STEP(0, c); SCAN_STEP(1, c + 1); SCAN_STEP(2, c + 2); SCAN_STEP(3, c + 3); }
}

__device__ __forceinline__ void ph_mla_up(const Params& pkv, KPtr kp_in, int wbase_in, int l, char* lds) {
    PH_HEAD
    const int nq = (NT / 128) * 3, nkv = (NT / 128) * 4;
    const float SC = 0.10206207261596575f * 1.4426950408889634f;
    float* rsl = (float*)(lds + 40960);
    const int tid = TID;
    for (int u = BID; u < nq + nkv; u += gridDim.x) {
        const bool isq = u < nq;
        const int mt = isq ? u / 3 : (u - nq) / 4, t0 = mt * 128;
        {
            const int row = tid >> 2, part = tid & 3, ncol = isq ? 256 : 128, per = ncol / 4;
            const bf16_t* src = p.pbuf + (size_t)(t0 + row) * NINP + (isq ? PC_MQ : PC_MKV) + part * per;
            float ss = 0.f;
            for (int i = 0; i < per; i += 8) {
                const u32x4 w = *(const u32x4*)(src + i);
#pragma unroll
                for (int k = 0; k < 4; ++k) { const float a = __uint_as_float(w[k] << 16), b = __uint_as_float(w[k] & 0xffff0000u); ss += a * a + b * b; }
            }
            ss += dpp_f<0xB1>(ss); ss += dpp_f<0x4E>(ss);
            __syncthreads();
            if (part == 0) rsl[row] = rsqrtf(ss / (float)ncol + 1e-6f);
            if (!isq && (u - nq) % 4 == 0) {
                for (int e = tid; e < 128 * 16; e += NTHREADS) {
                    const int rr = e >> 4, i = e & 15, t = t0 + rr, pos = t % SEQ;
                    const bf16_t* pr = p.pbuf + (size_t)t * NINP + PC_MKR;
                    const float c = p.tab_mla[(pos * 16 + i) * 2], sn = p.tab_mla[(pos * 16 + i) * 2 + 1], x1 = bf2f(pr[i]), x2 = bf2f(pr[16 + i]);
                    const bf16_t k1 = f2bf(x1 * c - x2 * sn), k2 = f2bf(x1 * sn + x2 * c);
#pragma unroll
                    for (int hd = 0; hd < 4; ++hd) { p.mk[((size_t)t * 4 + hd) * 96 + 64 + i] = k1; p.mk[((size_t)t * 4 + hd) * 96 + 80 + i] = k2; }
                }
            }
            __syncthreads();
        }
        if (isq) {
            const int nt = u % 3;
            bf16_t* mq = p.mq + (size_t)mt * 128 * 384 + nt * 128; const float* tab = p.tab_mla;
            gemm_tile128(p.pbuf + (size_t)mt * 128 * NINP + PC_MQ, NINP, nullptr, 128, p.wq_t + ((size_t)l * 384 + nt * 128) * 256, 256, 256, lds, TID,
                         [=](int r, int c, f32x4 v0, f32x4 v1) mutable {
                             const float sc = rsl[r] * SC; v0 = v0 * sc; v1 = v1 * sc;
                             const int col = nt * 128 + c;
                             if ((col % 96) >= 64) {
                                 const int i0 = (col % 96) - 64, pos = (t0 + r) % SEQ;
                                 const f32x4 cs0 = *(const f32x4*)(tab + (pos * 16 + i0) * 2), cs1 = *(const f32x4*)(tab + (pos * 16 + i0) * 2 + 4);
                                 const f32x4 a = v0, b = v1;
                                 v0[0] = a[0] * cs0[0] - b[0] * cs0[1]; v1[0] = a[0] * cs0[1] + b[0] * cs0[0];
                                 v0[1] = a[1] * cs0[2] - b[1] * cs0[3]; v1[1] = a[1] * cs0[3] + b[1] * cs0[2];
                                 v0[2] = a[2] * cs1[0] - b[2] * cs1[1]; v1[2] = a[2] * cs1[1] + b[2] * cs1[0];
                                 v0[3] = a[3] * cs1[2] - b[3] * cs1[3]; v1[3] = a[3] * cs1[3] + b[3] * cs1[2];
                             }
                             uint2 o0, o1; o0.x = cvtpk(v0[0], v0[1]); o0.y = cvtpk(v0[2], v0[3]); o1.x = cvtpk(v1[0], v1[1]); o1.y = cvtpk(v1[2], v1[3]);
                             *(uint2*)(mq + (size_t)r * 384 + c) = o0; *(uint2*)(mq + (size_t)r * 384 + c + 16) = o1; });
        } else {
            const int hd = (u - nq) % 4;
            bf16_t* mk = p.mk + ((size_t)mt * 128 * 4 + hd) * 96; bf16_t* mv = p.mv + ((size_t)mt * 128 * 4 + hd) * 64;
            gemm_tile128(p.pbuf + (size_t)mt * 128 * NINP + PC_MKV, NINP, nullptr, 128, p.wkv_t + ((size_t)l * 512 + hd * 128) * 128, 128, 128, lds, TID,
                         [=](int r, int c, f32x4 v0, f32x4 v1) mutable {
                             const float sc = rsl[r]; v0 = v0 * sc; v1 = v1 * sc;
                             uint2 o0, o1; o0.x = cvtpk(v0[0], v0[1]); o0.y = cvtpk(v0[2], v0[3]); o1.x = cvtpk(v1[0], v1[1]); o1.y = cvtpk(v1[2], v1[3]);
                             if (c < 64) { *(uint2*)(mk + (size_t)r * 384 + c) = o0; *(uint2*)(mk + (size_t)r * 384 + c + 16) = o1; }
                             else { *(uint2*)(mv + (size_t)r * 256 + (c - 64)) = o0; *(uint2*)(mv + (size_t)r * 256 + (c - 64) + 16) = o1; } });
        }
    }
}

__device__ __forceinline__ void ph_mla_pack(const Params& pkv, KPtr kp_in, int wbase_in, int l) {
    PH_HEAD
    const int lane = TID & 63, gw = BID * (NTHREADS / 64) + (TID >> 6), nw = gridDim.x * (NTHREADS / 64);
    const float SC = 0.10206207261596575f * 1.4426950408889634f;
#pragma unroll 2
    for (int t = gw; t < NT; t += nw) {
        const int pos = t % SEQ;
        const float* qp = p.qu + (size_t)t * 384; const float* kvp = p.kvu + (size_t)t * 512; const float* kp2 = p.kpe + (size_t)t * 32;
        bf16_t* mq = p.mq + (size_t)t * 384; bf16_t* mk = p.mk + (size_t)t * 384; bf16_t* mv = p.mv + (size_t)t * 256;
        for (int e = lane; e < 384; e += 64) {
            const int hd = e / 96, d = e % 96;
            float qv, kv;
            if (d < 64) { qv = qp[e]; kv = kvp[hd * 128 + d]; }
            else {
                const int i = (d - 64) & 15; const float c = p.tab_mla[(pos * 16 + i) * 2], sn = p.tab_mla[(pos * 16 + i) * 2 + 1];
                const float x1 = qp[hd * 96 + 64 + i], x2 = qp[hd * 96 + 80 + i];
                qv = (d < 80) ? (x1 * c - x2 * sn) : (x1 * sn + x2 * c);
                kv = kp2[d - 64];
            }
            mq[e] = f2bf(qv * SC); mk[e] = f2bf(kv);
        }
        for (int e = lane; e < 256; e += 64) mv[e] = f2bf(kvp[(e >> 6) * 128 + 64 + (e & 63)]);
    }
}

__device__ __forceinline__ void ph_mla_attn(const Params& pkv, KPtr kp_in, int wbase_in, int l, char* lds) {
    PH_HEAD
    constexpr int KSTR = 104, VSTR = 68;
    bf16_t* Ks = (bf16_t*)lds;
    bf16_t* Vt = Ks + 64 * KSTR;
    const int tid = TID, lane = tid & 63, wv = tid >> 6, r = lane & 31, h = lane >> 5;
    int* wq = p.wq + l * 16;
    volatile int* wslot = (volatile int*)(lds + 24576);
    for (;;) {
        __syncthreads();
        if (tid == 0) *wslot = atomicAdd(wq, 1);
        __syncthreads();
        const int it = __builtin_amdgcn_readfirstlane(*wslot);
        if (it >= 16 * 32) break;
        const int bh = it & 15, qb = 31 - (it >> 4);
        const int b = bh >> 2, hd = bh & 3, q0 = qb * 256;
        const int qmin = q0 + 32 * wv, qmax = qmin + 31, myq = qmin + r;
        bf16x8 qf[6];
        {
            const bf16_t* qrow = p.mq + ((size_t)(b * SEQ + myq) * 4 + hd) * 96 + 8 * h;
#pragma unroll
            for (int s = 0; s < 6; ++s) qf[s] = *(const bf16x8*)(qrow + 16 * s);
        }
        f32x16 o0, o1;
#pragma unroll
        for (int i = 0; i < 16; ++i) { o0[i] = 0.f; o1[i] = 0.f; }
        float m = -1e30f, lsum = 0.f;
        const int nkt = (q0 + 256) / 64;
        const int kk0 = tid / 12, kc0 = tid % 12, kk1 = (tid + 512) / 12, kc1 = (tid + 512) % 12;
        const int vk = tid & 63, vc = tid >> 6;
        const bf16_t* kbase = p.mk + ((size_t)b * SEQ * 4 + hd) * 96;
        const bf16_t* vbase = p.mv + ((size_t)b * SEQ * 4 + hd) * 64;
        u32x4 rk0, rk1, rv;
        rk0 = *(const u32x4*)(kbase + (size_t)kk0 * 384 + kc0 * 8);
        rk1 = (tid < 256) ? *(const u32x4*)(kbase + (size_t)kk1 * 384 + kc1 * 8) : (u32x4){0u, 0u, 0u, 0u};
        rv = *(const u32x4*)(vbase + (size_t)vk * 256 + vc * 8);
        for (int kt = 0; kt < nkt; ++kt) {
            __syncthreads();
            *(u32x4*)(Ks + kk0 * KSTR + kc0 * 8) = rk0;
            if (tid < 256) *(u32x4*)(Ks + kk1 * KSTR + kc1 * 8) = rk1;
            {
                const unsigned w0 = rv[0], w1 = rv[1], w2 = rv[2], w3 = rv[3];
                bf16_t* vd = Vt + (vc * 8) * VSTR + vk;
                vd[0] = (bf16_t)(w0 & 0xffff); vd[VSTR] = (bf16_t)(w0 >> 16); vd[2 * VSTR] = (bf16_t)(w1 & 0xffff); vd[3 * VSTR] = (bf16_t)(w1 >> 16);
                vd[4 * VSTR] = (bf16_t)(w2 & 0xffff); vd[5 * VSTR] = (bf16_t)(w2 >> 16); vd[6 * VSTR] = (bf16_t)(w3 & 0xffff); vd[7 * VSTR] = (bf16_t)(w3 >> 16);
            }
            __syncthreads();
            if (kt + 1 < nkt) {
                const size_t ko = (size_t)(kt + 1) * 64;
                rk0 = *(const u32x4*)(kbase + (ko + kk0) * 384 + kc0 * 8);
                if (tid < 256) rk1 = *(const u32x4*)(kbase + (ko + kk1) * 384 + kc1 * 8);
                rv = *(const u32x4*)(vbase + (ko + vk) * 256 + vc * 8);
            }
            const int kb = kt * 64;
            if (kb <= qmax) {
                const bool need1 = (kb + 32 <= qmax);
                f32x16 s0, s1;
#pragma unroll
                for (int i = 0; i < 16; ++i) { s0[i] = 0.f; s1[i] = -1e30f; }
#pragma unroll
                for (int s = 0; s < 6; ++s) { const bf16x8 kf = *(const bf16x8*)(Ks + r * KSTR + 16 * s + 8 * h); s0 = __builtin_amdgcn_mfma_f32_32x32x16_bf16(kf, qf[s], s0, 0, 0, 0); }
                if (need1) {
#pragma unroll
                    for (int i = 0; i < 16; ++i) s1[i] = 0.f;
#pragma unroll
                    for (int s = 0; s < 6; ++s) { const bf16x8 kf = *(const bf16x8*)(Ks + (32 + r) * KSTR + 16 * s + 8 * h); s1 = __builtin_amdgcn_mfma_f32_32x32x16_bf16(kf, qf[s], s1, 0, 0, 0); }
                }
                if (kb + 63 > qmin) {
#pragma unroll
                    for (int i = 0; i < 16; ++i) {
                        const int key = kb + (i & 3) + 8 * (i >> 2) + 4 * h;
                        if (key > myq) s0[i] = -1e30f;
                        if (key + 32 > myq) s1[i] = -1e30f;
                    }
                }
                float mx = s0[0];
#pragma unroll
                for (int i = 1; i < 16; ++i) mx = fmaxf(mx, s0[i]);
#pragma unroll
                for (int i = 0; i < 16; ++i) mx = fmaxf(mx, s1[i]);
                mx = xhalf_max(mx);
                const float mn = fmaxf(m, mx), alpha = __builtin_amdgcn_exp2f(m - mn);
                m = mn;
                float ps = 0.f;
#pragma unroll
                for (int i = 0; i < 16; ++i) { s0[i] = __builtin_amdgcn_exp2f(s0[i] - mn); ps += s0[i]; }
                if (need1) {
#pragma unroll
                    for (int i = 0; i < 16; ++i) { s1[i] = __builtin_amdgcn_exp2f(s1[i] - mn); ps += s1[i]; }
                }
                lsum = lsum * alpha + ps;
                if (!__all(alpha == 1.0f)) {
#pragma unroll
                    for (int i = 0; i < 16; ++i) { o0[i] *= alpha; o1[i] *= alpha; }
                }
#pragma unroll
                for (int s = 0; s < 2; ++s) {
                    u32x4 pw; pw[0] = cvtpk(s0[8 * s], s0[8 * s + 1]); pw[1] = cvtpk(s0[8 * s + 2], s0[8 * s + 3]); pw[2] = cvtpk(s0[8 * s + 4], s0[8 * s + 5]); pw[3] = cvtpk(s0[8 * s + 6], s0[8 * s + 7]);
                    const bf16x8 pf = __builtin_bit_cast(bf16x8, pw);
                    const bf16_t* va = Vt + r * VSTR + 16 * s + 4 * h;
                    const s16x4 a0 = *(const s16x4*)(va), a1 = *(const s16x4*)(va + 8), b0 = *(const s16x4*)(va + 32 * VSTR), b1 = *(const s16x4*)(va + 32 * VSTR + 8);
                    o0 = __builtin_amdgcn_mfma_f32_32x32x16_bf16(__builtin_shufflevector(a0, a1, 0, 1, 2, 3, 4, 5, 6, 7), pf, o0, 0, 0, 0);
                    o1 = __builtin_amdgcn_mfma_f32_32x32x16_bf16(__builtin_shufflevector(b0, b1, 0, 1, 2, 3, 4, 5, 6, 7), pf, o1, 0, 0, 0);
                }
                if (need1) {
#pragma unroll
                    for (int s = 0; s < 2; ++s) {
                        u32x4 pw; pw[0] = cvtpk(s1[8 * s], s1[8 * s + 1]); pw[1] = cvtpk(s1[8 * s + 2], s1[8 * s + 3]); pw[2] = cvtpk(s1[8 * s + 4], s1[8 * s + 5]); pw[3] = cvtpk(s1[8 * s + 6], s1[8 * s + 7]);
                        const bf16x8 pf = __builtin_bit_cast(bf16x8, pw);
                        const bf16_t* va = Vt + r * VSTR + 32 + 16 * s + 4 * h;
                        const s16x4 a0 = *(const s16x4*)(va), a1 = *(const s16x4*)(va + 8), b0 = *(const s16x4*)(va + 32 * VSTR), b1 = *(const s16x4*)(va + 32 * VSTR + 8);
                        o0 = __builtin_amdgcn_mfma_f32_32x32x16_bf16(__builtin_shufflevector(a0, a1, 0, 1, 2, 3, 4, 5, 6, 7), pf, o0, 0, 0, 0);
                        o1 = __builtin_amdgcn_mfma_f32_32x32x16_bf16(__builtin_shufflevector(b0, b1, 0, 1, 2, 3, 4, 5, 6, 7), pf, o1, 0, 0, 0);
                    }
                }
            }
        }
        const float inv = 1.0f / xhalf_sum(lsum);
        float* op = p.mo + (size_t)(b * SEQ + myq) * 256 + hd * 64 + 4 * h;
#pragma unroll
        for (int g = 0; g < 4; ++g) {
            *(f32x4*)(op + 8 * g) = (f32x4){o0[4 * g] * inv, o0[4 * g + 1] * inv, o0[4 * g + 2] * inv, o0[4 * g + 3] * inv};
            *(f32x4*)(op + 32 + 8 * g) = (f32x4){o1[4 * g] * inv, o1[4 * g + 1] * inv, o1[4 * g + 2] * inv, o1[4 * g + 3] * inv};
        }
        __syncthreads();
    }
}

__device__ __forceinline__ void ph_finalize_mix(const Params& pkv, KPtr kp_in, int wbase_in, int l) {
    PH_HEAD
    const int lane = TID & 63, gw = BID * (NTHREADS / 64) + (TID >> 6), nw = gridDim.x * (NTHREADS / 64);
    const int c = lane * 4, h = lane >> 4;
    const float4 gd = *(const float4*)(p.dil_norm_g + l * 256 + c), gm = *(const float4*)(p.mla_out_norm_g + l * 256 + c);
    const float4 lg = *(const float4*)(p.rwkv_ln_g + l * 256 + c), lb = *(const float4*)(p.rwkv_ln_b + l * 256 + c), rk = *(const float4*)(p.rwkv_r_k + l * 256 + c);
    float nl0, nl1, nl2; float4 nd0, nd1, nd2, nsy, nsr, nsk, nsv, nsg, nmo;
    auto load = [&](int t) {
        nl0 = p.dlse[((size_t)0 * NT + t) * 4 + h]; nl1 = p.dlse[((size_t)1 * NT + t) * 4 + h]; nl2 = p.dlse[((size_t)2 * NT + t) * 4 + h];
        nd0 = *(const float4*)(p.dob + ((size_t)0 * NT + t) * 256 + c); nd1 = *(const float4*)(p.dob + ((size_t)1 * NT + t) * 256 + c); nd2 = *(const float4*)(p.dob + ((size_t)2 * NT + t) * 256 + c);
        const size_t o4 = (size_t)t * 256 + c;
        nsy = *(const float4*)(p.sy + o4); nsr = *(const float4*)(p.sr + o4); nsk = *(const float4*)(p.sk + o4); nsv = *(const float4*)(p.sv + o4); nsg = *(const float4*)(p.sg + o4);
        nmo = *(const float4*)(p.mo + o4);
    };
    int t = gw;
    if (t < NT) load(t);
    for (; t < NT; t += nw) {
        const float l0 = nl0, l1 = nl1, l2 = nl2; const float4 v0 = nd0, v1 = nd1, v2 = nd2, y = nsy, r = nsr, k = nsk, vv = nsv, g = nsg, mo = nmo;
        if (t + nw < NT) load(t + nw);
        bf16_t* outp = p.mixcat + (size_t)t * 1024;
        {
            const float lm = fmaxf(l0, fmaxf(l1, l2));
            float w0 = __builtin_amdgcn_exp2f(l0 - lm), w1 = __builtin_amdgcn_exp2f(l1 - lm), w2 = __builtin_amdgcn_exp2f(l2 - lm);
            const float wi = __builtin_amdgcn_rcpf(w0 + w1 + w2); w0 *= wi; w1 *= wi; w2 *= wi;
            float4 v; v.x = w0 * v0.x + w1 * v1.x + w2 * v2.x; v.y = w0 * v0.y + w1 * v1.y + w2 * v2.y; v.z = w0 * v0.z + w1 * v1.z + w2 * v2.z; v.w = w0 * v0.w + w1 * v1.w + w2 * v2.w;
            const float ss = wave_sum(v.x * v.x + v.y * v.y + v.z * v.z + v.w * v.w);
            const float rs = rsqrtf(ss * (1.0f / 256.0f) + 1e-6f);
            uint2 o; o.x = cvtpk(v.x * rs * gd.x, v.y * rs * gd.y); o.y = cvtpk(v.z * rs * gd.z, v.w * rs * gd.w);
            *(uint2*)(outp + 256 + c) = o;
        }
        {
            const float mean = grp16_sum(y.x + y.y + y.z + y.w) * (1.0f / 64.0f);
            const float dx = y.x - mean, dy = y.y - mean, dz = y.z - mean, dw = y.w - mean;
            const float var = grp16_sum(dx * dx + dy * dy + dz * dz + dw * dw) * (1.0f / 64.0f);
            const float rs = rsqrtf(var + 64e-5f);
            const float bonus = grp16_sum(r.x * k.x * rk.x + r.y * k.y * rk.y + r.z * k.z * rk.z + r.w * k.w * rk.w);
            uint2 o;
            o.x = cvtpk((dx * rs * lg.x + lb.x + bonus * vv.x) * g.x, (dy * rs * lg.y + lb.y + bonus * vv.y) * g.y);
            o.y = cvtpk((dz * rs * lg.z + lb.z + bonus * vv.z) * g.z, (dw * rs * lg.w + lb.w + bonus * vv.w) * g.w);
            *(uint2*)(outp + 512 + c) = o;
        }
        {
            const float ss = wave_sum(mo.x * mo.x + mo.y * mo.y + mo.z * mo.z + mo.w * mo.w);
            const float rs = rsqrtf(ss * (1.0f / 256.0f) + 1e-6f);
            uint2 o; o.x = cvtpk(mo.x * rs * gm.x, mo.y * rs * gm.y); o.y = cvtpk(mo.z * rs * gm.z, mo.w * rs * gm.w);
            *(uint2*)(outp + 768 + c) = o;
        }
    }
}

__device__ __forceinline__ void ph_outproj(const Params& pkv, KPtr kp_in, int wbase_in, int l, char* lds) {
    PH_HEAD
    const float* xin = (l == 0) ? p.x : p.xf; float* y1 = p.y1;
    const bf16_t* Bt = p.wout_t + (size_t)l * 1024 * 1024;
    const int nunits = (NT / 256) * 4;
    bool pre = false;
    XU_LOOP(NT / 256, 4) {
        const int u = XU_UNIT();
        const int mt = u >> 2, nt = u & 3, un = XU_NEXT_UNIT();
        G8Next nx; nx.valid = 0; nx.rowidx = nullptr; nx.nvalid = 256; nx.A = p.mixcat + (size_t)(un >> 2) * 256 * 1024; nx.Bt = Bt + (size_t)(un & 3) * 256 * 1024; nx.perm = 1;
        const size_t o0 = (size_t)mt * 256 * 1024 + nt * 256;
        G8Out so; so.out = nullptr; so.ld = 0; so.w = 0;
        gemm_tile256(p.mixcat + (size_t)mt * 256 * 1024, 1024, nullptr, 256, Bt + (size_t)nt * 256 * 1024, 1024, 1024, lds, wbase_in, pre, nx, true, so,
                     [=](int r, int c, f32x4 v0, f32x4 v1) mutable { const size_t o = o0 + (size_t)r * 1024 + c; const f32x4 xa = *(const f32x4*)(xin + o), xb2 = *(const f32x4*)(xin + o + 4); *(f32x4*)(y1 + o) = xa * ALPHA + v0; *(f32x4*)(y1 + o + 4) = xb2 * ALPHA + v1; return (u32x4){0u, 0u, 0u, 0u}; });
        pre = nx.valid != 0;
    }
}

__device__ __forceinline__ void ph_ln1_router(const Params& pkv, KPtr kp_in, int wbase_in, int l, char* lds) {
    PH_HEAD
    float* Wt = (float*)lds;
    int* hist = (int*)(lds + 131584);
    int* base = hist + 32;
    int* le = base + 32;
    float* lgt = (float*)(le + 512);
    int* lrank = (int*)(lgt + 512);
    const int tid = TID, lane = tid & 63, wv = tid >> 6;
    const float* g1 = p.ln1_g + l * 1024; const float* b1 = p.ln1_b + l * 1024;
    const float* rw = p.router_w + (size_t)l * 1024 * 32; const float* rb = p.router_b + l * 32;
    __syncthreads();
    for (int i = tid; i < 1024 * 32; i += NTHREADS) Wt[(i & 31) * 1028 + (i >> 5)] = rw[i];
    float4 gg[4], bb[4];
#pragma unroll
    for (int m = 0; m < 4; ++m) { gg[m] = *(const float4*)(g1 + m * 256 + lane * 4); bb[m] = *(const float4*)(b1 + m * 256 + lane * 4); }
    for (int tb = BID * 128; tb < NT; tb += gridDim.x * 128) {
        __syncthreads();
        if (tid < 32) hist[tid] = 0;
        __syncthreads();
        float4 yn[4];
#pragma unroll
        for (int m = 0; m < 4; ++m) yn[m] = *(const float4*)(p.y1 + (size_t)(tb + wv) * 1024 + m * 256 + lane * 4);
        for (int tt = wv; tt < 128; tt += 8) {
            const int t = tb + tt;
            float4 y[4]; float s = 0.f;
#pragma unroll
            for (int m = 0; m < 4; ++m) { y[m] = yn[m]; s += (y[m].x + y[m].y) + (y[m].z + y[m].w); }
            {
                const int t2 = tb + ((tt + 8 < 128) ? tt + 8 : tt);
#pragma unroll
                for (int m = 0; m < 4; ++m) yn[m] = *(const float4*)(p.y1 + (size_t)t2 * 1024 + m * 256 + lane * 4);
            }
            const float mean = wave_sum(s) * (1.0f / 1024.0f);
            float q = 0.f;
#pragma unroll
            for (int m = 0; m < 4; ++m) { y[m].x -= mean; y[m].y -= mean; y[m].z -= mean; y[m].w -= mean; q += (y[m].x * y[m].x + y[m].y * y[m].y) + (y[m].z * y[m].z + y[m].w * y[m].w); }
            const float rs = rsqrtf(wave_sum(q) * (1.0f / 1024.0f) + 1e-5f);
#pragma unroll
            for (int m = 0; m < 4; ++m) {
                const int c = m * 256 + lane * 4;
                y[m].x = y[m].x * rs * gg[m].x + bb[m].x; y[m].y = y[m].y * rs * gg[m].y + bb[m].y; y[m].z = y[m].z * rs * gg[m].z + bb[m].z; y[m].w = y[m].w * rs * gg[m].w + bb[m].w;
                *(float4*)(p.y1 + (size_t)t * 1024 + c) = y[m];
                uint2 ob; ob.x = cvtpk(y[m].x, y[m].y); ob.y = cvtpk(y[m].z, y[m].w);
                *(uint2*)(p.x1b + (size_t)t * 1024 + c) = ob;
            }
            float lg[32];
#pragma unroll
            for (int e = 0; e < 32; ++e) {
                float a = 0.f;
#pragma unroll
                for (int m = 0; m < 4; ++m) { const f32x4 w = *(const f32x4*)(Wt + e * 1028 + m * 256 + lane * 4); a += (y[m].x * w[0] + y[m].y * w[1]) + (y[m].z * w[2] + y[m].w * w[3]); }
                lg[e] = a;
            }
            float s16[16];
#pragma unroll
            for (int e = 0; e < 16; ++e) { auto rr = __builtin_amdgcn_permlane32_swap(__float_as_uint(lg[e]), __float_as_uint(lg[e + 16]), false, false); s16[e] = __uint_as_float(rr[0]) + __uint_as_float(rr[1]); }
            const bool b4 = (lane & 16) != 0, b3 = (lane & 8) != 0, b2 = (lane & 4) != 0, b1 = (lane & 2) != 0;
            float u8[8];
#pragma unroll
            for (int j = 0; j < 8; ++j) { const float snd = b4 ? s16[j] : s16[j + 8], kp = b4 ? s16[j + 8] : s16[j]; u8[j] = kp + __int_as_float(__builtin_amdgcn_ds_swizzle(__float_as_int(snd), 0x401F)); }
            float w4[4];
#pragma unroll
            for (int j = 0; j < 4; ++j) { const float snd = b3 ? u8[j] : u8[j + 4], kp = b3 ? u8[j + 4] : u8[j]; w4[j] = kp + dpp_f<0x128>(snd); }
            float z2[2];
#pragma unroll
            for (int j = 0; j < 2; ++j) {
                const float snd = b2 ? w4[j] : w4[j + 2], kp = b2 ? w4[j + 2] : w4[j];
                z2[j] = kp + dpp_f<0x141>(snd);
            }
            float lgt1;
            { const float snd = b1 ? z2[0] : z2[1], kp = b1 ? z2[1] : z2[0]; lgt1 = kp + dpp_f<0x4E>(snd); }
            lgt1 += dpp_f<0xB1>(lgt1);
            const int myexp = lane >> 1;
            float myv = lgt1 + rb[myexp];
            int idx[4]; float val[4];
#pragma unroll
            for (int k = 0; k < 4; ++k) {
                float mx = myv;
                mx = fmaxf(mx, dpp_f<0x128>(mx)); mx = fmaxf(mx, dpp_f<0x124>(mx)); mx = fmaxf(mx, dpp_f<0x122>(mx)); mx = fmaxf(mx, dpp_f<0x121>(mx));
                mx = fmaxf(mx, __int_as_float(__builtin_amdgcn_ds_swizzle(__float_as_int(mx), 0x401F)));
                mx = xhalf_max(mx);
                float ci = (myv == mx) ? (float)(31 - myexp) : -1.0f;
                ci = fmaxf(ci, dpp_f<0x128>(ci)); ci = fmaxf(ci, dpp_f<0x124>(ci)); ci = fmaxf(ci, dpp_f<0x122>(ci)); ci = fmaxf(ci, dpp_f<0x121>(ci));
                ci = fmaxf(ci, __int_as_float(__builtin_amdgcn_ds_swizzle(__float_as_int(ci), 0x401F)));
                ci = xhalf_max(ci);
                const int bi = 31 - (int)ci;
                idx[k] = bi; val[k] = mx;
                if (myexp == bi) myv = -3.0e38f;
            }
            const float e1 = __expf(val[1] - val[0]), e2 = __expf(val[2] - val[0]), e3 = __expf(val[3] - val[0]);
            const float inv = 1.0f / (1.0f + e1 + e2 + e3);
            const float gt[4] = {inv, e1 * inv, e2 * inv, e3 * inv};
            if (lane < 4) {
                int ee = idx[0]; float gv = gt[0];
                if (lane == 1) { ee = idx[1]; gv = gt[1]; } else if (lane == 2) { ee = idx[2]; gv = gt[2]; } else if (lane == 3) { ee = idx[3]; gv = gt[3]; }
                le[tt * 4 + lane] = ee; lgt[tt * 4 + lane] = gv;
                lrank[tt * 4 + lane] = atomicAdd(&hist[ee], 1);
            }
        }
        __syncthreads();
        if (tid < 32) base[tid] = atomicAdd(&p.cnt[l * NE + tid], hist[tid]);
        __syncthreads();
        {
            const int tt = tid >> 2, t = tb + tt, e = le[tid], pos = base[e] + lrank[tid];
            p.toke[(size_t)t * 4 + (tid & 3)] = e; p.tokpos[(size_t)t * 4 + (tid & 3)] = pos;
            p.rowtok[(size_t)e * NT + pos] = t; p.rowgate[(size_t)e * NT + pos] = lgt[tid];
        }
    }
}

__device__ __forceinline__ void moe_tile_prefix(KRef p, int l, int* tb  , const int TID) {
    __syncthreads();
    if (TID == 0) { int a = 0; for (int e = 0; e < NE; ++e) { tb[e] = a; a += (p.cnt[l * NE + e] + MOE_TM - 1) / MOE_TM; } tb[NE] = a; }
    __syncthreads();
}
struct MoeUnit { int e, mt, mtg, nt, nvalid; };
__device__ __forceinline__ MoeUnit moe_decode(const int* tb, const int* cnt, int u, int ntshift) {
    MoeUnit m; m.mtg = u >> ntshift; m.nt = u & ((1 << ntshift) - 1);
    int e = 0; while (tb[e + 1] <= m.mtg) ++e;
    m.e = __builtin_amdgcn_readfirstlane(e);
    m.mt = __builtin_amdgcn_readfirstlane(m.mtg - tb[m.e]);
    const int c = __builtin_amdgcn_readfirstlane(cnt[m.e]);
    m.nvalid = min(MOE_TM, c - m.mt * MOE_TM);
    return m;
}
__device__ __forceinline__ void ph_moe_gu(const Params& pkv, KPtr kp_in, int wbase_in, int l, char* lds) {
    PH_HEAD
    int* tb = (int*)(lds + 132096);
    moe_tile_prefix(p, l, tb, TID);
    const int ntile = __builtin_amdgcn_readfirstlane(tb[NE]), nunits = ntile * 8;
    const int* cnt = p.cnt + l * NE;
    bool pre = false;
    XU_LOOP(ntile, 8) {
        const int u = XU_UNIT();
        const MoeUnit m = moe_decode(tb, cnt, u, 3);
        const int un = XU_NEXT_UNIT();
        G8Next nx; nx.valid = 0; nx.A = p.x1b; nx.rowidx = nullptr; nx.Bt = nullptr; nx.nvalid = 0;
        if (nx.valid) { const MoeUnit m2 = moe_decode(tb, cnt, un, 3); nx.rowidx = p.rowtok + (size_t)m2.e * NT + m2.mt * MOE_TM; nx.nvalid = m2.nvalid; nx.Bt = p.wgu_t + (((size_t)l * NE + m2.e) * 2048 + m2.nt * 256) * 1024; } nx.perm = 1;
        const float* bias = p.b_gu + ((size_t)l * NE + m.e) * 2048 + m.nt * 256;
        bf16_t* out = p.act + (size_t)m.mtg * MOE_TM * 1024 + m.nt * 128;
        gemm_tile256(p.x1b, 1024, p.rowtok + (size_t)m.e * NT + m.mt * MOE_TM, m.nvalid, p.wgu_t + (((size_t)l * NE + m.e) * 2048 + m.nt * 256) * 1024, 1024, 1024, lds, wbase_in, pre, nx, true, G8Out{out, 1024, 128},
                     [=](int r, int c, f32x4 va, f32x4 vb) mutable {
                         uint2 o;
#pragma unroll
                         for (int hh = 0; hh < 2; ++hh) {
                             f32x4 v = hh ? vb : va; const int cc = c + 4 * hh;
                             const f32x4 bv = *(const f32x4*)(bias + cc); v = v + bv;
                             const float g0 = fminf(v[0], 7.0f), l0 = fminf(fmaxf(v[1], -7.0f), 7.0f), g1 = fminf(v[2], 7.0f), l1 = fminf(fmaxf(v[3], -7.0f), 7.0f);
                             const float a0 = g0 * sigmoidf_(1.702f * g0) * (l0 + 1.0f), a1 = g1 * sigmoidf_(1.702f * g1) * (l1 + 1.0f);
                             if (hh) o.y = cvtpk(a0, a1); else o.x = cvtpk(a0, a1);
                         }
                         return (u32x4){o.x, o.y, 0u, 0u}; });
        pre = nx.valid != 0;
    }
}
__device__ __forceinline__ void ph_moe_dn(const Params& pkv, KPtr kp_in, int wbase_in, int l, char* lds) {
    PH_HEAD
    int* tb = (int*)(lds + 132096);
    moe_tile_prefix(p, l, tb, TID);
    const int ntile = __builtin_amdgcn_readfirstlane(tb[NE]), nunits = ntile * 4;
    const int* cnt = p.cnt + l * NE;
    bool pre = false;
    XU_LOOP(ntile, 4) {
        const int u = XU_UNIT();
        const MoeUnit m = moe_decode(tb, cnt, u, 2);
        const int un = XU_NEXT_UNIT();
        G8Next nx; nx.valid = 0; nx.A = nullptr; nx.rowidx = nullptr; nx.Bt = nullptr; nx.nvalid = 256;
        if (nx.valid) { const MoeUnit m2 = moe_decode(tb, cnt, un, 2); nx.A = p.act + (size_t)m2.mtg * MOE_TM * 1024; nx.Bt = p.wdn_t + (((size_t)l * NE + m2.e) * 1024 + m2.nt * 256) * 1024; } nx.perm = 1;
        const float* bias = p.b_dn + ((size_t)l * NE + m.e) * 1024 + m.nt * 256;
        const float* gate = p.rowgate + (size_t)m.e * NT + m.mt * MOE_TM;
        bf16_t* out = p.yb + (size_t)m.mtg * MOE_TM * 1024 + m.nt * 256;
        const int nvalid = m.nvalid;
        gemm_tile256(p.act + (size_t)m.mtg * MOE_TM * 1024, 1024, nullptr, 256, p.wdn_t + (((size_t)l * NE + m.e) * 1024 + m.nt * 256) * 1024, 1024, 1024, lds, wbase_in, pre, nx, true, G8Out{out, 1024, 256},
                     [=](int r, int c, f32x4 v0, f32x4 v1) mutable {
                         const float g = (r < nvalid) ? gate[r] : 0.f;
                         const f32x4 b0 = *(const f32x4*)(bias + c), b1 = *(const f32x4*)(bias + c + 4); v0 = (v0 + b0) * g; v1 = (v1 + b1) * g;
                         u32x4 o; o[0] = cvtpk(v0[0], v0[1]); o[1] = cvtpk(v0[2], v0[3]); o[2] = cvtpk(v1[0], v1[1]); o[3] = cvtpk(v1[2], v1[3]); return o; });
        pre = nx.valid != 0;
    }
}
__device__ __forceinline__ void ph_combine_ln2(const Params& pkv, KPtr kp_in, int wbase_in, int l, char* lds) {
    PH_HEAD
    int* tb = (int*)(lds + 132096);
    moe_tile_prefix(p, l, tb, TID);
    const int lane = TID & 63, gw = BID * (NTHREADS / 64) + (TID >> 6), nw = gridDim.x * (NTHREADS / 64);
    float4 gg[4], bb[4];
#pragma unroll
    for (int m = 0; m < 4; ++m) { gg[m] = *(const float4*)(p.ln2_g + l * 1024 + m * 256 + lane * 4); bb[m] = *(const float4*)(p.ln2_b + l * 1024 + m * 256 + lane * 4); }
    float* dstf = (l == DEPTH - 1) ? p.out : p.xf;
    float4 ny[4]; uint2 nb[4][4]; int4 ne, npz;
    auto load_idx = [&](int t) { ne = *(const int4*)(p.toke + (size_t)t * 4); npz = *(const int4*)(p.tokpos + (size_t)t * 4); };
    auto load_rows = [&](int t) {
        const size_t r0 = (size_t)tb[ne.x] * MOE_TM + npz.x, r1 = (size_t)tb[ne.y] * MOE_TM + npz.y, r2 = (size_t)tb[ne.z] * MOE_TM + npz.z, r3 = (size_t)tb[ne.w] * MOE_TM + npz.w;
#pragma unroll
        for (int m = 0; m < 4; ++m) {
            const int c = m * 256 + lane * 4;
            ny[m] = *(const float4*)(p.y1 + (size_t)t * 1024 + c);
            nb[m][0] = *(const uint2*)(p.yb + r0 * 1024 + c); nb[m][1] = *(const uint2*)(p.yb + r1 * 1024 + c); nb[m][2] = *(const uint2*)(p.yb + r2 * 1024 + c); nb[m][3] = *(const uint2*)(p.yb + r3 * 1024 + c);
        }
    };
    int t = gw;
    if (t < NT) { load_idx(t); load_rows(t); if (t + nw < NT) load_idx(t + nw); }
    for (; t < NT; t += nw) {
        float4 y[4]; float s = 0.f;
#pragma unroll
        for (int m = 0; m < 4; ++m) {
            float4 v = ny[m];
            v.x *= ALPHA; v.y *= ALPHA; v.z *= ALPHA; v.w *= ALPHA;
#pragma unroll
            for (int k = 0; k < 4; ++k) { const uint2 w = nb[m][k]; v.x += __uint_as_float(w.x << 16); v.y += __uint_as_float(w.x & 0xffff0000u); v.z += __uint_as_float(w.y << 16); v.w += __uint_as_float(w.y & 0xffff0000u); }
            y[m] = v; s += (v.x + v.y) + (v.z + v.w);
        }
        if (t + nw < NT) { load_rows(t + nw); if (t + 2 * nw < NT) load_idx(t + 2 * nw); }
        const float mean = wave_sum(s) * (1.0f / 1024.0f);
        float q = 0.f;
#pragma unroll
        for (int m = 0; m < 4; ++m) { y[m].x -= mean; y[m].y -= mean; y[m].z -= mean; y[m].w -= mean; q += (y[m].x * y[m].x + y[m].y * y[m].y) + (y[m].z * y[m].z + y[m].w * y[m].w); }
        const float rs = rsqrtf(wave_sum(q) * (1.0f / 1024.0f) + 1e-5f);
#pragma unroll
        for (int m = 0; m < 4; ++m) {
            const int c = m * 256 + lane * 4;
            float4 xv; xv.x = y[m].x * rs * gg[m].x + bb[m].x; xv.y = y[m].y * rs * gg[m].y + bb[m].y; xv.z = y[m].z * rs * gg[m].z + bb[m].z; xv.w = y[m].w * rs * gg[m].w + bb[m].w;
            *(float4*)(dstf + (size_t)t * 1024 + c) = xv;
            uint2 ob; ob.x = cvtpk(xv.x, xv.y); ob.y = cvtpk(xv.z, xv.w);
            *(uint2*)(p.xb + (size_t)t * 1024 + c) = ob;
        }
    }
}

constexpr int PH_PRO = 0, PH_INPROJ = 1, PH_PREP = 2, PH_RETKV = 3, PH_RETSCAN = 4, PH_RETOUT = 5, PH_DIL = 6, PH_RWKVPREP = 7, PH_RWKVSCAN = 8, PH_MLAUP = 9,
              PH_MLAATTN = 10, PH_FINAL = 11, PH_OUTPROJ = 12, PH_LN1 = 13, PH_GU = 14, PH_DN = 15, PH_LN2 = 16;

#ifdef MULTI_LAUNCH
template <int ph>
__global__ void __launch_bounds__(NTHREADS, 2) mega(Params pk, int l) {
    extern __shared__ __attribute__((aligned(16))) char lds[];
    KPtr kp = (KPtr)__builtin_amdgcn_kernarg_segment_ptr();
    const int wbase = __builtin_amdgcn_readfirstlane(threadIdx.x) & ~63;
    if (ph == PH_PRO) ph_prologue(pk, kp, wbase, lds);
    if (ph == PH_INPROJ) ph_inproj(pk, kp, wbase, l, lds);
    if (ph == PH_PREP) ph_rope_prep(pk, kp, wbase, l);
    if (ph == PH_RETKV) ph_ret_kv(pk, kp, wbase, l, lds);
    if (ph == PH_RETSCAN) ph_ret_scan(pk, kp, wbase, l);
    if (ph == PH_RETOUT) ph_ret_out(pk, kp, wbase, l, lds);
    if (ph == PH_DIL) ph_dil_attn(pk, kp, wbase, l, lds);
    if (ph == PH_RWKVPREP) ph_rwkv_prep(pk, kp, wbase, l, lds);
    if (ph == PH_RWKVSCAN) ph_rwkv_scan(pk, kp, wbase, l, lds);
    if (ph == PH_MLAUP) ph_mla_up(pk, kp, wbase, l, lds);
    if (ph == PH_MLAATTN) ph_mla_attn(pk, kp, wbase, l, lds);
    if (ph == PH_FINAL) ph_finalize_mix(pk, kp, wbase, l);
    if (ph == PH_OUTPROJ) ph_outproj(pk, kp, wbase, l, lds);
    if (ph == PH_LN1) ph_ln1_router(pk, kp, wbase, l, lds);
    if (ph == PH_GU) ph_moe_gu(pk, kp, wbase, l, lds);
    if (ph == PH_DN) ph_moe_dn(pk, kp, wbase, l, lds);
    if (ph == PH_LN2) ph_combine_ln2(pk, kp, wbase, l, lds);
}
template <int PH> static void launch_ph(const Params& p, int l, hipStream_t stream) {
    static bool attr_set = false;
    if (!attr_set) { (void)hipFuncSetAttribute((const void*)mega<PH>, hipFuncAttributeMaxDynamicSharedMemorySize, LDS_BYTES); attr_set = true; }
    hipLaunchKernelGGL(mega<PH>, dim3(256), dim3(NTHREADS), LDS_BYTES, stream, p, l);
}
template <int PH> static void launch_layer(const Params& p, int l, hipStream_t stream) {
    launch_ph<PH>(p, l, stream);
    if constexpr (PH < PH_LN2) launch_layer<PH + 1>(p, l, stream);
}

#else
__device__ __forceinline__ void grid_sync(KPtr kp_in, int wbase_in, char* lds) {
    KPtr kp_ = kp_launder(kp_in);
    XcdBarrier b; b.bar = kp_->bar; b.x = xb_xcc_id(); b.st = (volatile LAS unsigned*)(lds + LDS_BYTES - 16);
    xcd_barrier(b, opq_tid(wbase_in));
}
#ifndef PROBE_ID
#define PROBE_ID -1
#endif
#define RUN(ID, call) do { int reps_ = 1; if (PROBE_ID == (ID)) { reps_ = 2; asm volatile("" : "+s"(reps_)); } for (int r_ = 0; r_ < reps_; ++r_) { call; } } while (0)
__global__ void __launch_bounds__(NTHREADS, 2) mega_fused(Params pk) {
    extern __shared__ __attribute__((aligned(16))) char lds[];
    KPtr kp = (KPtr)__builtin_amdgcn_kernarg_segment_ptr();
    const int wbase = __builtin_amdgcn_readfirstlane(threadIdx.x) & ~63;
    volatile LAS unsigned* xbw = (volatile LAS unsigned*)(lds + LDS_BYTES - 16);
    if (threadIdx.x == 0) { xbw[0] = 0u; xbw[1] = 0u; xbw[2] = 0u; xbw[3] = 0u; }
    __syncthreads();
    (void)xcd_barrier_post(pk.bar, xbw);
    RUN(0, ph_prologue(pk, kp, wbase, lds));
    grid_sync(kp, wbase, lds);
    for (int l = 0; l < DEPTH; ++l) {
        RUN(1, ph_inproj(pk, kp, wbase, l, lds));
        grid_sync(kp, wbase, lds);
        RUN(3, ph_ret_kv(pk, kp, wbase, l, lds)); RUN(4, ph_rwkv_prep(pk, kp, wbase, l, lds)); RUN(5, ph_mla_up(pk, kp, wbase, l, lds));
        grid_sync(kp, wbase, lds);
        RUN(8, ph_ret_scan(pk, kp, wbase, l)); RUN(17, ph_rwkv_chunkpre(pk, kp, wbase, l, lds));
        grid_sync(kp, wbase, lds);
        RUN(10, ph_rwkv_scan(pk, kp, wbase, l, lds)); RUN(9, ph_mla_attn(pk, kp, wbase, l, lds)); ph_dil_attn(pk, kp, wbase, l, lds); ph_ret_out(pk, kp, wbase, l, lds);
        grid_sync(kp, wbase, lds);
        RUN(12, ph_finalize_mix(pk, kp, wbase, l));
        grid_sync(kp, wbase, lds);
        RUN(13, ph_outproj(pk, kp, wbase, l, lds));
        grid_sync(kp, wbase, lds);
        ph_ln1_router(pk, kp, wbase, l, lds);
        grid_sync(kp, wbase, lds);
        RUN(14, ph_moe_gu(pk, kp, wbase, l, lds));
        grid_sync(kp, wbase, lds);
        RUN(15, ph_moe_dn(pk, kp, wbase, l, lds));
        grid_sync(kp, wbase, lds);
        RUN(16, ph_combine_ln2(pk, kp, wbase, l, lds));
        grid_sync(kp, wbase, lds);
    }
}
#endif
struct Carver { char* base; size_t off; template <class T> T* take(size_t n) { T* r = (T*)(base + off); off += ((n * sizeof(T) + 255) / 256) * 256; return r; } };

extern "C" void kernel_launch(void* const* d_in, const int* in_sizes, int n_in, void* d_out, int out_size, void* d_ws, size_t ws_size, hipStream_t stream) {
    Params p; memset(&p, 0, sizeof(p));
    const float** ip = (const float**)&p;
    for (int i = 0; i < 35; ++i) ip[i] = (const float*)d_in[i];
    p.out = (float*)d_out;
    Carver c{(char*)d_ws, 0};
    p.bar = c.take<unsigned>(4096); p.cnt = c.take<int>(DEPTH * NE); p.wq = c.take<int>(DEPTH * 16);
    p.tab_ret = c.take<float>((size_t)SEQ * 32); p.tab_dil = c.take<float>((size_t)SEQ * 16); p.tab_mla = c.take<float>((size_t)SEQ * 32);
    p.win_t = c.take<bf16_t>((size_t)DEPTH * NINP * 1024); p.wout_t = c.take<bf16_t>((size_t)DEPTH * 1024 * 1024);
    p.wgu_t = c.take<bf16_t>((size_t)DEPTH * NE * 2048 * 1024); p.wdn_t = c.take<bf16_t>((size_t)DEPTH * NE * 1024 * 1024);
    p.wq_t = c.take<bf16_t>((size_t)DEPTH * 384 * 256); p.wkv_t = c.take<bf16_t>((size_t)DEPTH * 512 * 128);
    p.wupt = c.take<bf16_t>((size_t)DEPTH * 256 * 64); p.aupt = c.take<bf16_t>((size_t)DEPTH * 256 * 64); p.gupt = c.take<bf16_t>((size_t)DEPTH * 256 * 128); p.vupt = c.take<bf16_t>((size_t)DEPTH * 256 * 32);
    p.xf = c.take<float>((size_t)NT * DM); p.xb = c.take<bf16_t>((size_t)NT * DM); p.pbuf = c.take<bf16_t>((size_t)NT * NINP);
    p.mixcat = c.take<bf16_t>((size_t)NT * DM); p.y1 = c.take<float>((size_t)NT * DM); p.x1b = c.take<bf16_t>((size_t)NT * DM);
    p.rq = c.take<float>((size_t)NT * 128); p.rk = c.take<float>((size_t)NT * 128);
    p.rkv = c.take<float>((size_t)NBATCH * NCH * 4 * 32 * 64); p.rstate = c.take<float>((size_t)NBATCH * NCH * 4 * 32 * 64);
    p.dq = c.take<float>((size_t)NT * 256); p.dk = c.take<float>((size_t)NT * 256); p.dob = c.take<float>((size_t)3 * NT * 256); p.dlse = c.take<float>((size_t)3 * NT * 4);
    p.sr = c.take<float>((size_t)NT * 256); p.sw = c.take<float>((size_t)NT * 256); p.sk = c.take<float>((size_t)NT * 256); p.sv = c.take<float>((size_t)NT * 256);
    p.sa = c.take<float>((size_t)NT * 256); p.sb = c.take<float>((size_t)NT * 256); p.sg = c.take<float>((size_t)NT * 256); p.sy = c.take<float>((size_t)NT * 256);
    p.vfirst = c.take<float>((size_t)NT * 256);
    p.c_p = c.take<float>((size_t)16 * (SEQ / 16) * 4096); p.c_q = c.take<float>((size_t)16 * (SEQ / 16) * 4096); p.c_rh = c.take<float>((size_t)16 * (SEQ / 16) * 1024); p.c_y1 = c.take<float>((size_t)16 * (SEQ / 16) * 1024);
    p.rsq = c.take<float>(NT); p.rskv = c.take<float>(NT); p.kpe = c.take<float>((size_t)NT * 32);
    p.qu = c.take<float>((size_t)NT * 384); p.kvu = c.take<float>((size_t)NT * 512); p.mo = c.take<float>((size_t)NT * 256);
    p.mq = c.take<bf16_t>((size_t)NT * 384); p.mk = c.take<bf16_t>((size_t)NT * 384); p.mv = c.take<bf16_t>((size_t)NT * 256);
    p.rowtok = c.take<int>((size_t)NE * NT); p.toke = c.take<int>((size_t)NT * 4); p.tokpos = c.take<int>((size_t)NT * 4); p.rowgate = c.take<float>((size_t)NE * NT);
    p.act = c.take<bf16_t>((size_t)MOE_MAXROWS * 1024); p.yb = c.take<bf16_t>((size_t)MOE_MAXROWS * 1024);
    if (c.off > ws_size) { fprintf(stderr, "workspace too small: need %zu have %zu\n", c.off, ws_size); return; }

#ifdef MULTI_LAUNCH
    launch_ph<PH_PRO>(p, 0, stream);
    for (int l = 0; l < DEPTH; ++l) launch_layer<PH_INPROJ>(p, l, stream);
#else
    static int grid = 0;
    if (!grid) {
        (void)hipFuncSetAttribute((const void*)mega_fused, hipFuncAttributeMaxDynamicSharedMemorySize, LDS_BYTES);
        int dev = 0, cus = 0, per_cu = 0;
        (void)hipGetDevice(&dev);
        (void)hipDeviceGetAttribute(&cus, hipDeviceAttributeMultiprocessorCount, dev);
        (void)hipOccupancyMaxActiveBlocksPerMultiprocessor(&per_cu, mega_fused, NTHREADS, LDS_BYTES);
        if (cus <= 0) cus = 256;
        grid = cus * (per_cu < 1 ? 1 : 1);
    }
    (void)hipMemsetAsync(p.bar, 0, XCD_BAR_WORDS * sizeof(unsigned), stream);
    hipLaunchKernelGGL(mega_fused, dim3(grid), dim3(NTHREADS), LDS_BYTES, stream, p);
#endif
}
```

```cpp
#include <hip/hip_runtime.h>
#include <stdint.h>
#include <string.h>
#include <stdio.h>

typedef unsigned short bf16_t;
typedef short bf16x8 __attribute__((ext_vector_type(8)));
typedef float f32x4 __attribute__((ext_vector_type(4)));
typedef unsigned u32x4 __attribute__((ext_vector_type(4)));
typedef float f32x16 __attribute__((ext_vector_type(16)));
typedef short s16x4 __attribute__((ext_vector_type(4)));
typedef float f32x2_t __attribute__((ext_vector_type(2)));
typedef __bf16 bf16x2_t __attribute__((ext_vector_type(2)));

constexpr int NT = 32768, SEQ = 8192, NBATCH = 4, DM = 1024, NIN = 2976, NINP = 3072, DEPTH = 4, NE = 32, TOPK = 4;
constexpr int BLK = 128, NCH = SEQ / BLK;
constexpr float ALPHA = 1.6817928305074292f;
constexpr int PC_RQ = 0, PC_RK = 128, PC_RV = 256, PC_RG = 512, PC_DQ = 768, PC_DK = 1024, PC_DV = 1280;
constexpr int PC_C = 1536, PC_CR = 1536, PC_CK = 1792, PC_CV = 2048, PC_CWD = 2304, PC_CAD = 2368, PC_CGD = 2432;
constexpr int PC_MQ = 2560, PC_MKV = 2816, PC_MKR = 2944, PC_VRES = 2976;
constexpr int MOE_TM = 256;
constexpr int MOE_MAXROWS = NT * TOPK + NE * MOE_TM;
constexpr int NTHREADS = 512;
constexpr int LDS_BYTES = 147456;

__device__ __forceinline__ bf16_t f2bf(float f) { unsigned u = __float_as_uint(f); u += 0x7fffu + ((u >> 16) & 1u); return (bf16_t)(u >> 16); }
__device__ __forceinline__ unsigned cvtpk(float lo, float hi) { f32x2_t v = {lo, hi}; bf16x2_t b = __builtin_convertvector(v, bf16x2_t); return __builtin_bit_cast(unsigned, b); }
__device__ __forceinline__ float xhalf_max(float v) { auto rr = __builtin_amdgcn_permlane32_swap(__float_as_uint(v), __float_as_uint(v), false, false); return fmaxf(__uint_as_float(rr[0]), __uint_as_float(rr[1])); }
__device__ __forceinline__ float xhalf_sum(float v) { auto rr = __builtin_amdgcn_permlane32_swap(__float_as_uint(v), __float_as_uint(v), false, false); return __uint_as_float(rr[0]) + __uint_as_float(rr[1]); }
__device__ __forceinline__ float bf2f(bf16_t h) { return __uint_as_float(((unsigned)h) << 16); }
template <int CTRL> __device__ __forceinline__ float dpp_f(float v) { return __int_as_float(__builtin_amdgcn_update_dpp(0, __float_as_int(v), CTRL, 0xF, 0xF, true)); }
__device__ __forceinline__ float grp16_sum(float v) {
    v += dpp_f<0x128>(v); v += dpp_f<0x124>(v); v += dpp_f<0x122>(v); v += dpp_f<0x121>(v); return v; }
__device__ __forceinline__ float wave_sum(float v) {
    v = grp16_sum(v);
    const int i = __float_as_int(v);
    return (__int_as_float(__builtin_amdgcn_readlane(i, 0)) + __int_as_float(__builtin_amdgcn_readlane(i, 16))) +
           (__int_as_float(__builtin_amdgcn_readlane(i, 32)) + __int_as_float(__builtin_amdgcn_readlane(i, 48))); }
__device__ __forceinline__ float sigmoidf_(float x) { return __builtin_amdgcn_rcpf(1.0f + __builtin_amdgcn_exp2f(x * -1.4426950408889634f)); }

#define XB_TMO      128
#define XB_XCNT(j)  (256  + 64 * (j))
#define XB_XSUB(j)  (1280 + 64 * (j))
#define XB_XGEN(j)  (2304 + 64 * (j))
#define XB_TOP      3328
#define XB_TOPGEN   3392
#define XCD_BAR_WORDS 3456
#define XB_SPIN_CAP (1u << 22)
#define LAS __attribute__((address_space(3)))
__device__ __forceinline__ unsigned xb_ld(unsigned* p)              { return __hip_atomic_load(p, __ATOMIC_RELAXED, __HIP_MEMORY_SCOPE_AGENT); }
__device__ __forceinline__ unsigned xb_add(unsigned* p, unsigned v) { return __hip_atomic_fetch_add(p, v, __ATOMIC_RELAXED, __HIP_MEMORY_SCOPE_AGENT); }
__device__ __forceinline__ unsigned xb_xcc_id() { return (unsigned)__builtin_amdgcn_s_getreg((3 << 11) | 20) & 0xFu; }
#define XB_SPIN(cond, bar) do { unsigned _sp = 0; while (cond) { __builtin_amdgcn_s_sleep(1); \
    if ((++_sp & 255u) == 0u) { if (xb_ld(&(bar)[XB_TMO])) break; if (_sp > XB_SPIN_CAP) { atomicAdd(&(bar)[XB_TMO], 1u); break; } } } } while (0)
struct XcdBarrier { unsigned* bar; unsigned x; volatile LAS unsigned* st; };
__device__ __forceinline__ XcdBarrier xcd_barrier_post(unsigned* bar, volatile LAS unsigned* st) {
    XcdBarrier b; b.bar = bar; b.x = xb_xcc_id(); b.st = st;
    if (threadIdx.x == 0) (void)xb_add(&bar[XB_XCNT(b.x)], 1u);
    return b;
}
__device__ __forceinline__ void xcd_barrier_complete(unsigned* bar, unsigned x, unsigned& nloc, unsigned& nx) {
    const unsigned G = gridDim.x * gridDim.y * gridDim.z;
    unsigned sum, cnt, mine, sp = 0u;
    for (;;) {
        sum = 0u; cnt = 0u; mine = 0u;
#pragma unroll
        for (unsigned j = 0; j < 16; ++j) { const unsigned c = xb_ld(&bar[XB_XCNT(j)]); sum += c; cnt += (c > 0u) ? 1u : 0u; mine = (j == x) ? c : mine; }
        if (sum == G) break;
        __builtin_amdgcn_s_sleep(1);
        if ((++sp & 255u) == 0u) { if (xb_ld(&bar[XB_TMO])) break; if (sp > XB_SPIN_CAP) { atomicAdd(&bar[XB_TMO], 1u); break; } }
    }
    nloc = mine > 0u ? mine : 1u; nx = cnt > 0u ? cnt : 1u;
}
__device__ __forceinline__ void xcd_barrier(const XcdBarrier& b, const int tid0) {
    asm volatile("s_waitcnt vmcnt(0)" ::: "memory");
    __syncthreads();
    if (tid0 == 0) {
        unsigned* bar = b.bar;
        __builtin_amdgcn_s_waitcnt(0);
        unsigned nloc = b.st[0], nx = b.st[1];
        if (nloc == 0u) { xcd_barrier_complete(bar, b.x, nloc, nx); b.st[0] = nloc; b.st[1] = nx; }
        const unsigned old = xb_add(&bar[XB_XSUB(b.x)], 1u);
        const unsigned gen = old / nloc;
        if (old + 1u == (gen + 1u) * nloc) {
            __builtin_amdgcn_fence(__ATOMIC_RELEASE, "agent");
            asm volatile("s_waitcnt vmcnt(0)" ::: "memory");
            const unsigned og = xb_add(&bar[XB_TOP], 1u);
            const unsigned tg = og / nx;
            if (og + 1u == (tg + 1u) * nx) xb_add(&bar[XB_TOPGEN], 1u);
            else XB_SPIN(xb_ld(&bar[XB_TOPGEN]) == tg, bar);
            __builtin_amdgcn_fence(__ATOMIC_ACQUIRE, "agent");
            xb_add(&bar[XB_XGEN(b.x)], 1u);
            asm volatile("s_waitcnt vmcnt(0)" ::: "memory");
        } else {
            XB_SPIN(xb_ld(&bar[XB_XGEN(b.x)]) == gen, bar);
            __builtin_amdgcn_fence(__ATOMIC_ACQUIRE, "agent");
            asm volatile("s_waitcnt vmcnt(0)" ::: "memory");
        }
    }
    __syncthreads();
}

struct Params {
    const float *x, *w_in, *w_out, *ret_norm_g, *dil_norm_g, *rwkv_mu, *rwkv_w0, *rwkv_w_up, *rwkv_a0, *rwkv_a_up, *rwkv_g_up, *rwkv_k_k, *rwkv_k_a,
        *rwkv_r_k, *rwkv_ln_g, *rwkv_ln_b, *vres_down, *vres_mu, *rwkv_v0, *rwkv_v_up, *mla_q_norm_g, *mla_w_q_up, *mla_kv_norm_g, *mla_w_kv_up,
        *mla_out_norm_g, *ln1_g, *ln1_b, *router_w, *router_b, *w_gu, *b_gu, *w_dn, *b_dn, *ln2_g, *ln2_b;
    float* out;
    unsigned* bar; int* cnt; int* wq;
    float *tab_ret, *tab_dil, *tab_mla;
    bf16_t *win_t, *wout_t, *wgu_t, *wdn_t, *wq_t, *wkv_t, *wupt, *aupt, *gupt, *vupt;
    float* xf; bf16_t* xb; bf16_t* pbuf; bf16_t* mixcat; float* y1; bf16_t* x1b;
    float *rq, *rk, *rkv, *rstate;
    float *dq, *dk, *dob, *dlse;
    float *sr, *sw, *sk, *sv, *sa, *sb, *sg, *sy, *vfirst;
    float *c_p, *c_q, *c_rh, *c_y1;
    float *rsq, *rskv, *kpe, *qu, *kvu, *mo;
    bf16_t *mq, *mk, *mv;
    int *rowtok, *toke, *tokpos; float* rowgate; bf16_t *act, *yb;
};

__device__ __forceinline__ int opq_tid(int wbase) { unsigned z = 0u; asm volatile("" : "+s"(z)); int t = wbase | (int)__builtin_amdgcn_mbcnt_hi(~0u, __builtin_amdgcn_mbcnt_lo(~0u, z)); asm volatile("" : "+v"(t)); return t; }
__device__ __forceinline__ int opq_bid() { int b = blockIdx.x; asm volatile("" : "+s"(b)); return b; }
typedef const __attribute__((address_space(4))) Params* KPtr;
typedef const __attribute__((address_space(4))) Params& KRef;
__device__ __forceinline__ KPtr kp_launder(KPtr k) {
    const unsigned long long v = (unsigned long long)k;
    unsigned lo = (unsigned)v, hi = (unsigned)(v >> 32);
    asm volatile("" : "+s"(lo), "+s"(hi));
    return (KPtr)(((unsigned long long)hi << 32) | lo);
}
#define PH_HEADV (void)kp_in; const Params& p = pkv; const int TID = opq_tid(wbase_in), BID = opq_bid(); (void)TID; (void)BID;
#define PH_HEAD (void)pkv; KPtr kp_ = kp_launder(kp_in); KRef p = *kp_; const int TID = opq_tid(wbase_in), BID = opq_bid(); (void)TID; (void)BID;
template <class F>
__device__ __forceinline__ void tr_tile(F f, bf16_t* dst, int ldd, int k0, int n0, float* tile, const int TID) {
    const int tid = TID;
#pragma unroll
    for (int i = 0; i < 8; ++i) { const int e = tid + i * NTHREADS, kk = e >> 6, nn = e & 63; tile[kk * 65 + nn] = f(k0 + kk, n0 + nn); }
    __syncthreads();
    {
        const int nn = tid >> 3, kc = (tid & 7) * 8;
        u32x4 w;
        w[0] = cvtpk(tile[(kc + 0) * 65 + nn], tile[(kc + 1) * 65 + nn]); w[1] = cvtpk(tile[(kc + 2) * 65 + nn], tile[(kc + 3) * 65 + nn]);
        w[2] = cvtpk(tile[(kc + 4) * 65 + nn], tile[(kc + 5) * 65 + nn]); w[3] = cvtpk(tile[(kc + 6) * 65 + nn], tile[(kc + 7) * 65 + nn]);
        *(u32x4*)(dst + (size_t)(n0 + nn) * ldd + k0 + kc) = w;
    }
    __syncthreads();
}

__device__ __forceinline__ void ph_prologue(const Params& pkv, KPtr kp_in, int wbase_in, char* lds) {
    PH_HEAD
    float* tile = (float*)lds;
    const int nb = gridDim.x, bid = BID, tid = TID;
    for (int t = bid; t < DEPTH * NE * 16 * 32; t += nb) {
        const int le = t >> 9, r = t & 511, tk = r >> 5, tn = r & 31;
        const float* src = p.w_gu + (size_t)le * 1024 * 2048;
        tr_tile([&](int k, int n) { return src[(size_t)k * 2048 + n]; }, p.wgu_t + (size_t)le * 2048 * 1024, 1024, tk * 64, tn * 64, tile, TID);
    }
    for (int t = bid; t < DEPTH * NE * 16 * 16; t += nb) {
        const int le = t >> 8, r = t & 255, tk = r >> 4, tn = r & 15;
        const float* src = p.w_dn + (size_t)le * 1024 * 1024;
        tr_tile([&](int k, int n) { return src[(size_t)k * 1024 + n]; }, p.wdn_t + (size_t)le * 1024 * 1024, 1024, tk * 64, tn * 64, tile, TID);
    }
    for (int t = bid; t < DEPTH * 16 * 48; t += nb) {
        const int l = t / (16 * 48), r = t % (16 * 48), tk = r / 48, tn = r % 48;
        const float* src = p.w_in + (size_t)l * 1024 * NIN;
        const float* vr = p.vres_down + (size_t)(l > 0 ? l - 1 : 0) * 1024 * 32;
        tr_tile([&](int k, int n) { return n < NIN ? src[(size_t)k * NIN + n] : ((n < NIN + 32 && l > 0) ? vr[k * 32 + (n - NIN)] : 0.0f); },
                p.win_t + (size_t)l * NINP * 1024, 1024, tk * 64, tn * 64, tile, TID);
    }
    for (int t = bid; t < DEPTH * 16 * 16; t += nb) {
        const int l = t >> 8, r = t & 255, tk = r >> 4, tn = r & 15;
        const float* src = p.w_out + (size_t)l * 1024 * 1024;
        tr_tile([&](int k, int n) { return src[(size_t)k * 1024 + n]; }, p.wout_t + (size_t)l * 1024 * 1024, 1024, tk * 64, tn * 64, tile, TID);
    }
    for (int t = bid; t < DEPTH * 4 * 6; t += nb) {
        const int l = t / 24, r = t % 24, tk = r / 6, tn = r % 6;
        const float* src = p.mla_w_q_up + (size_t)l * 256 * 384; const float* g = p.mla_q_norm_g + l * 256;
        tr_tile([&](int k, int n) { return src[k * 384 + n] * g[k]; }, p.wq_t + (size_t)l * 384 * 256, 256, tk * 64, tn * 64, tile, TID);
    }
    for (int t = bid; t < DEPTH * 2 * 8; t += nb) {
        const int l = t / 16, r = t % 16, tk = r / 8, tn = r % 8;
        const float* src = p.mla_w_kv_up + (size_t)l * 128 * 512; const float* g = p.mla_kv_norm_g + l * 128;
        tr_tile([&](int k, int n) { return src[k * 512 + n] * g[k]; }, p.wkv_t + (size_t)l * 512 * 128, 128, tk * 64, tn * 64, tile, TID);
    }
    for (int i = bid * NTHREADS + tid; i < DEPTH * 256 * 64; i += nb * NTHREADS) {
        const int l = i / (256 * 64), r = i % (256 * 64), n = r / 64, k = r % 64;
        p.wupt[i] = f2bf(p.rwkv_w_up[((size_t)l * 64 + k) * 256 + n]); p.aupt[i] = f2bf(p.rwkv_a_up[((size_t)l * 64 + k) * 256 + n]);
    }
    for (int i = bid * NTHREADS + tid; i < DEPTH * 256 * 128; i += nb * NTHREADS) {
        const int l = i / (256 * 128), r = i % (256 * 128), n = r / 128, k = r % 128;
        p.gupt[i] = f2bf(p.rwkv_g_up[((size_t)l * 128 + k) * 256 + n]);
    }
    for (int i = bid * NTHREADS + tid; i < (DEPTH - 1) * 256 * 32; i += nb * NTHREADS) {
        const int l = i / (256 * 32), r = i % (256 * 32), n = r / 32, k = r % 32;
        p.vupt[i] = f2bf(p.rwkv_v_up[((size_t)l * 32 + k) * 256 + n]);
    }
    for (int i = bid * NTHREADS + tid; i < SEQ * 40; i += nb * NTHREADS) {
        const int pos = i / 40, j = i % 40;
        double theta, rot; int f; float* dst;
        if (j < 16) { theta = 10000.0; rot = 32.0; f = j; dst = p.tab_ret + ((size_t)pos * 16 + f) * 2; }
        else if (j < 24) { theta = 500000.0; rot = 16.0; f = j - 16; dst = p.tab_dil + ((size_t)pos * 8 + f) * 2; }
        else { theta = 10000.0; rot = 32.0; f = j - 24; dst = p.tab_mla + ((size_t)pos * 16 + f) * 2; }
        const double inv = 1.0 / pow(theta, (2.0 * f) / rot), ang = (double)pos * inv;
        dst[0] = (float)cos(ang); dst[1] = (float)sin(ang);
    }
    for (size_t i = (size_t)bid * NTHREADS + tid; i < (size_t)NT * DM / 4; i += (size_t)nb * NTHREADS) {
        const float4 v = ((const float4*)p.x)[i];
        ushort4 o; o.x = f2bf(v.x); o.y = f2bf(v.y); o.z = f2bf(v.z); o.w = f2bf(v.w);
        ((ushort4*)p.xb)[i] = o;
    }
    if (bid == 0 && tid < DEPTH * NE) p.cnt[tid] = 0;
    if (bid == 0 && tid < DEPTH * 16) p.wq[tid] = 0;
}

template <class Epi>
__device__ __forceinline__ void gemm_tile128(const bf16_t* __restrict__ A, int lda, const int* __restrict__ rowidx, int nvalid,
                                             const bf16_t* __restrict__ Bt, int ldb, int K, char* lds, const int TID, Epi epi) {
    constexpr int LDT = 72;
    bf16_t* As = (bf16_t*)lds; bf16_t* Bs = As + 128 * LDT;
    const int tid = TID, lane = tid & 63, wid = tid >> 6, wm = wid >> 2, wn = wid & 3, fr = lane & 15, fq = lane >> 4;
    const bf16_t* ap[2]; const bf16_t* bp[2]; int so[2];
#pragma unroll
    for (int i = 0; i < 2; ++i) {
        const int c = tid + i * NTHREADS, row = c >> 3, kc = c & 7;
        int ar = row; if (rowidx) ar = (row < nvalid) ? rowidx[row] : rowidx[0];
        ap[i] = A + (size_t)ar * lda + kc * 8; bp[i] = Bt + (size_t)row * ldb + kc * 8; so[i] = row * LDT + kc * 8;
    }
    f32x4 acc[4][2];
#pragma unroll
    for (int mi = 0; mi < 4; ++mi)
#pragma unroll
        for (int ni = 0; ni < 2; ++ni) acc[mi][ni] = (f32x4){0.f, 0.f, 0.f, 0.f};
    u32x4 ra0, ra1, rb0, rb1;
    ra0 = *(const u32x4*)(ap[0]); ra1 = *(const u32x4*)(ap[1]); rb0 = *(const u32x4*)(bp[0]); rb1 = *(const u32x4*)(bp[1]);
    const int nk = K >> 6;
    for (int kt = 0; kt < nk; ++kt) {
        __syncthreads();
        *(u32x4*)(As + so[0]) = ra0; *(u32x4*)(As + so[1]) = ra1; *(u32x4*)(Bs + so[0]) = rb0; *(u32x4*)(Bs + so[1]) = rb1;
        __syncthreads();
        if (kt + 1 < nk) {
            const int ko = (kt + 1) * 64;
            ra0 = *(const u32x4*)(ap[0] + ko); ra1 = *(const u32x4*)(ap[1] + ko); rb0 = *(const u32x4*)(bp[0] + ko); rb1 = *(const u32x4*)(bp[1] + ko);
        }
#pragma unroll
        for (int kk = 0; kk < 2; ++kk) {
            bf16x8 af[4], bfr[2];
#pragma unroll
            for (int mi = 0; mi < 4; ++mi) af[mi] = *(const bf16x8*)(As + (wm * 64 + mi * 16 + fr) * LDT + kk * 32 + fq * 8);
#pragma unroll
            for (int ni = 0; ni < 2; ++ni) bfr[ni] = *(const bf16x8*)(Bs + (wn * 32 + ni * 16 + fr) * LDT + kk * 32 + fq * 8);
#pragma unroll
            for (int mi = 0; mi < 4; ++mi)
#pragma unroll
                for (int ni = 0; ni < 2; ++ni) acc[mi][ni] = __builtin_amdgcn_mfma_f32_16x16x32_bf16(bfr[ni], af[mi], acc[mi][ni], 0, 0, 0);
        }
    }
#pragma unroll
    for (int mi = 0; mi < 4; ++mi) epi(wm * 64 + mi * 16 + fr, wn * 32 + fq * 4, acc[mi][0], acc[mi][1]);
    __syncthreads();
}

__device__ __forceinline__ int g8_lds_byte(int r, int c) { const int st = (r >> 4) * 2 + (c >> 5), rr = r & 15, cc = c & 31, ob = rr * 64 + cc * 2; return st * 1024 + (ob ^ (((ob >> 9) & 1) << 5)); }
__device__ __forceinline__ void g8_stage_rc(int b, int& R, int& C) { const int st = b / 1024, sb = b % 1024, swz = sb ^ (((sb >> 9) & 1) << 5); R = (st >> 1) * 16 + swz / 64; C = (st & 1) * 32 + (swz % 64) / 2; }
struct G8Out { bf16_t* out; int ld; int w; };
struct G8Next { const bf16_t* A; const int* rowidx; const bf16_t* Bt; int nvalid; int valid; int perm; };
__device__ __forceinline__ int g8_perm32(int rho) { const int n = rho >> 4, i = rho & 15; return 8 * (i >> 2) + 4 * n + (i & 3); }
template <class Epi>
__device__ __forceinline__ void gemm_tile256(const bf16_t* __restrict__ A, int lda, const int* __restrict__ rowidx, int nvalid,
                                             const bf16_t* __restrict__ Bt, int ldb, int K, char* lds, const int TID, const bool pre_issued, const G8Next nx, const bool perm, const G8Out so, Epi epi) {
    constexpr int G_HT = 128 * 64;
    bf16_t* shm = (bf16_t*)lds;
    int* icache = (int*)(lds + 133120);
#define G8_SA(b, h) (shm + ((b) * 2 + (h)) * G_HT)
#define G8_SB(b, h) (shm + (4 + (b) * 2 + (h)) * G_HT)
#define G8_SPTR(dst, src) do { unsigned long long _v = (unsigned long long)(src); unsigned _lo = (unsigned)_v, _hi = (unsigned)(_v >> 32); asm volatile("" : "+s"(_lo), "+s"(_hi)); \
        dst = (const char*)(((unsigned long long)_hi << 32) | _lo); } while (0)
#define G8_STAGE(P, BASE, OFF, kt) do { const char* _sb; G8_SPTR(_sb, (const char*)(BASE) + (size_t)(kt) * 128); _Pragma("unroll") for (int _i = 0; _i < 2; ++_i) { \
        __builtin_amdgcn_global_load_lds((const unsigned*)(_sb + (size_t)(OFF)[_i]), (unsigned*)((char*)(P) + tz * 16 + _i * 8192), 16, 0, 0); } } while (0)
#define G8_LDA(dst, b, h) _Pragma("unroll") for (int m = 0; m < 4; ++m) _Pragma("unroll") for (int k = 0; k < 2; ++k) \
        dst[m][k] = *reinterpret_cast<const bf16x8*>((char*)G8_SA(b, h) + g8_lds_byte(wr * 64 + m * 16 + fr, k * 32 + fq * 8))
#define G8_LDB(dst, b, h) _Pragma("unroll") for (int n = 0; n < 2; ++n) _Pragma("unroll") for (int k = 0; k < 2; ++k) \
        dst[n][k] = *reinterpret_cast<const bf16x8*>((char*)G8_SB(b, h) + g8_lds_byte(wc * 32 + n * 16 + fr, k * 32 + fq * 8))
#define G8_MMA(ai, bj, At_, Bt_) do { __builtin_amdgcn_s_setprio(1); \
        _Pragma("unroll") for (int m = 0; m < 4; ++m) _Pragma("unroll") for (int n = 0; n < 2; ++n) _Pragma("unroll") for (int k = 0; k < 2; ++k) \
            acc[ai][bj][m][n] = __builtin_amdgcn_mfma_f32_16x16x32_bf16(Bt_[n][k], At_[m][k], acc[ai][bj][m][n], 0, 0, 0); \
        __builtin_amdgcn_s_setprio(0); } while (0)
#define G8_WAIT_V(n) asm volatile("s_waitcnt vmcnt(" #n ")" ::: "memory")
#define G8_WAIT_L(n) asm volatile("s_waitcnt lgkmcnt(" #n ")" ::: "memory")
#define G8_BAR __builtin_amdgcn_s_barrier()
#define G8_SCHED __builtin_amdgcn_sched_barrier(0)
    int tz = opq_tid(TID);
    int wid = tz >> 6, lane = tz & 63, wr = wid >> 2, wc = wid & 3, fr = lane & 15, fq = lane >> 4;
    unsigned aoff0[2], aoff1[2], boff0[2];
#pragma unroll
    for (int i = 0; i < 2; ++i) {
        int r, c; g8_stage_rc(tz * 16 + i * 8192, r, c);
        int r0 = r, r1 = 128 + r;
        if (rowidx) {
            if (pre_issued) { r0 = icache[r0]; r1 = icache[r1]; }
            else { r0 = (r0 < nvalid) ? rowidx[r0] : rowidx[0]; r1 = (r1 < nvalid) ? rowidx[r1] : rowidx[0]; }
        }
        aoff0[i] = (unsigned)(r0 * lda + c) * 2u; aoff1[i] = (unsigned)(r1 * lda + c) * 2u;
        const int rb = perm ? ((r & ~31) + g8_perm32(r & 31)) : r;
        boff0[i] = (unsigned)(rb * ldb + c) * 2u;
    }
    const bf16_t* Bt1 = Bt + (size_t)128 * ldb;
    int nidx = 0;
    if (nx.valid && nx.rowidx && tz < 256) nidx = nx.rowidx[(tz < nx.nvalid) ? tz : 0];
    f32x4 acc[2][2][4][2];
#pragma unroll
    for (int a = 0; a < 2; ++a)
#pragma unroll
        for (int b = 0; b < 2; ++b)
#pragma unroll
            for (int m = 0; m < 4; ++m)
#pragma unroll
                for (int n = 0; n < 2; ++n) acc[a][b][m][n] = (f32x4){0.f, 0.f, 0.f, 0.f};
    bf16x8 At[4][2], B0[2][2], B1[2][2];
    const int nt = K / 64;
    if (!pre_issued) {
        G8_STAGE(G8_SB(0, 0), Bt, boff0, 0); G8_STAGE(G8_SA(0, 0), A, aoff0, 0);
        G8_STAGE(G8_SB(0, 1), Bt1, boff0, 0); G8_STAGE(G8_SA(0, 1), A, aoff1, 0);
    }
    if (wr == 1) G8_BAR;
    if (pre_issued) { G8_WAIT_V(32); } else { G8_WAIT_V(4); }
    G8_BAR;
    G8_STAGE(G8_SB(1, 0), Bt, boff0, 1); G8_STAGE(G8_SA(1, 0), A, aoff0, 1); G8_STAGE(G8_SB(1, 1), Bt1, boff0, 1);
    if (!pre_issued) { G8_WAIT_V(6); }
    G8_BAR;
    for (int t = 0; t < nt - 2; t += 2) {
        G8_LDB(B0, 0, 0); G8_SCHED; G8_LDA(At, 0, 0); G8_STAGE(G8_SA(1, 1), A, aoff1, t + 1);
        G8_WAIT_L(8); G8_BAR; G8_WAIT_L(0); G8_MMA(0, 0, At, B0); G8_BAR; G8_SCHED;
        G8_LDB(B1, 0, 1); G8_STAGE(G8_SB(0, 0), Bt, boff0, t + 2);
        G8_BAR; G8_WAIT_L(0); G8_MMA(0, 1, At, B1); G8_BAR;
        G8_LDA(At, 0, 1); G8_STAGE(G8_SA(0, 0), A, aoff0, t + 2);
        G8_BAR; G8_WAIT_L(0); G8_MMA(1, 0, At, B0); G8_BAR; G8_SCHED;
        G8_STAGE(G8_SB(0, 1), Bt1, boff0, t + 2);
        G8_WAIT_V(6); G8_BAR; G8_MMA(1, 1, At, B1); G8_BAR;
        G8_LDB(B0, 1, 0); G8_SCHED; G8_LDA(At, 1, 0); G8_STAGE(G8_SA(0, 1), A, aoff1, t + 2);
        G8_WAIT_L(8); G8_BAR; G8_WAIT_L(0); G8_MMA(0, 0, At, B0); G8_BAR; G8_SCHED;
        G8_LDB(B1, 1, 1); G8_STAGE(G8_SB(1, 0), Bt, boff0, t + 3);
        G8_BAR; G8_WAIT_L(0); G8_MMA(0, 1, At, B1); G8_BAR;
        G8_LDA(At, 1, 1); G8_STAGE(G8_SA(1, 0), A, aoff0, t + 3);
        G8_BAR; G8_WAIT_L(0); G8_MMA(1, 0, At, B0); G8_BAR; G8_SCHED;
        G8_STAGE(G8_SB(1, 1), Bt1, boff0, t + 3);
        G8_WAIT_V(6); G8_BAR; G8_MMA(1, 1, At, B1); G8_BAR;
    }
    { G8_LDB(B0, 0, 0); G8_WAIT_V(0); G8_LDA(At, 0, 0); G8_STAGE(G8_SA(1, 1), A, aoff1, nt - 1);
      G8_BAR; G8_WAIT_L(0); G8_MMA(0, 0, At, B0); G8_BAR;
      G8_LDB(B1, 0, 1); G8_BAR; G8_WAIT_L(0); G8_MMA(0, 1, At, B1); G8_BAR;
      G8_LDA(At, 0, 1); G8_WAIT_V(4); G8_BAR; G8_WAIT_L(0); G8_MMA(1, 0, At, B0); G8_MMA(1, 1, At, B1); G8_BAR; }
    { G8_LDB(B0, 1, 0); G8_LDA(At, 1, 0); G8_WAIT_V(2); G8_BAR; G8_WAIT_L(0); G8_MMA(0, 0, At, B0); G8_BAR;
      G8_LDB(B1, 1, 1); G8_WAIT_V(0); G8_BAR; G8_WAIT_L(0); G8_MMA(0, 1, At, B1); G8_BAR;
      G8_LDA(At, 1, 1); G8_BAR; G8_WAIT_L(0); G8_MMA(1, 0, At, B0); G8_MMA(1, 1, At, B1); G8_BAR; }
    if (wr == 0) G8_BAR;
    asm volatile("" : "+v"(tz)); wid = tz >> 6; lane = tz & 63; wr = wid >> 2; wc = wid & 3; fr = lane & 15; fq = lane >> 4;
    if (nx.valid) {
        if (nx.rowidx) { if (tz < 256) icache[tz] = nidx; G8_WAIT_L(0); G8_BAR; }
        unsigned na0[2], na1[2], nb0[2];
#pragma unroll
        for (int i = 0; i < 2; ++i) {
            int r, c; g8_stage_rc(tz * 16 + i * 8192, r, c);
            int r0 = r, r1 = 128 + r;
            if (nx.rowidx) { r0 = icache[r0]; r1 = icache[r1]; }
            const int rb = nx.perm ? ((r & ~31) + g8_perm32(r & 31)) : r;
            na0[i] = (unsigned)(r0 * lda + c) * 2u; na1[i] = (unsigned)(r1 * lda + c) * 2u; nb0[i] = (unsigned)(rb * ldb + c) * 2u;
        }
        const bf16_t* nBt1 = nx.Bt + (size_t)128 * ldb;
        G8_STAGE(G8_SB(0, 0), nx.Bt, nb0, 0); G8_STAGE(G8_SA(0, 0), nx.A, na0, 0);
        G8_STAGE(G8_SB(0, 1), nBt1, nb0, 0); G8_STAGE(G8_SA(0, 1), nx.A, na1, 0);
    }
    if (so.w == 0) {
#pragma unroll
        for (int ai = 0; ai < 2; ++ai)
#pragma unroll
            for (int m = 0; m < 4; ++m)
#pragma unroll
                for (int bj = 0; bj < 2; ++bj) (void)epi(ai * 128 + wr * 64 + m * 16 + fr, bj * 128 + wc * 32 + (perm ? fq * 8 : fq * 4), acc[ai][bj][m][0], acc[ai][bj][m][1]);
    } else {
        const int sw = so.w * 2 + 32;
        char* sl = (char*)lds;
#pragma unroll
        for (int ai = 0; ai < 2; ++ai) {
#pragma unroll
            for (int m = 0; m < 4; ++m)
#pragma unroll
                for (int bj = 0; bj < 2; ++bj) {
                    const int rr = wr * 64 + m * 16 + fr, c = bj * 128 + wc * 32 + fq * 8;
                    const u32x4 o = epi(ai * 128 + rr, c, acc[ai][bj][m][0], acc[ai][bj][m][1]);
                    if (so.w == 256) *(u32x4*)(sl + rr * sw + c * 2) = o; else *(uint2*)(sl + rr * sw + c) = make_uint2(o[0], o[1]);
                }
            G8_WAIT_L(0); G8_BAR;
            {
                const int rpi = 1024 / (so.w * 2), cpr = so.w / 8;
#pragma unroll 4
                for (int i = 0; i < 16 / rpi; ++i) {
                    const int row = wid * 16 + i * rpi + lane / cpr, ch = lane % cpr;
                    const u32x4 v = *(const u32x4*)(sl + row * sw + ch * 16);
                    *(u32x4*)(so.out + (size_t)(ai * 128 + row) * so.ld + ch * 8) = v;
                }
            }
            G8_WAIT_L(0); G8_BAR;
        }
    }
    G8_BAR;
}

#define XU_LOOP(nM_, nN_) const int xu_x = BID & 7, xu_nb = gridDim.x >> 3, xu_own = ((nM_) - xu_x + 7) >> 3, xu_nN = (nN_); for (int xv = BID >> 3; xv < xu_own * xu_nN; xv += xu_nb)
#define XU_UNIT() ((xu_x + 8 * (xv / xu_nN)) * xu_nN + (xv % xu_nN))
#define XU_NEXT_OK ((xv + xu_nb) < xu_own * xu_nN)
#define XU_NEXT_UNIT() ((xu_x + 8 * ((xv + xu_nb) / xu_nN)) * xu_nN + ((xv + xu_nb) % xu_nN))
__device__ __forceinline__ void ph_inproj(const Params& pkv, KPtr kp_in, int wbase_in, int l, char* lds) {
    PH_HEAD
    const bf16_t* Bt = p.win_t + (size_t)l * NINP * 1024;
    const int ntn = NINP / 256, nunits = (NT / 256) * ntn;
    bool pre = false;
    XU_LOOP(NT / 256, ntn) {
        const int u = XU_UNIT();
        const int mt = u / ntn, nt = u % ntn, un = XU_NEXT_UNIT(), mt2 = un / ntn, nt2 = un % ntn;
        G8Next nx; nx.valid = 0; nx.rowidx = nullptr; nx.nvalid = 256; nx.A = p.xb + (size_t)mt2 * 256 * 1024; nx.Bt = Bt + (size_t)nt2 * 256 * 1024; nx.perm = !(nt2 == 0 || nt2 == 3 || nt2 == 4);
        const bool perm = !(nt == 0 || nt == 3 || nt == 4);
        bf16_t* out = p.pbuf + (size_t)mt * 256 * NINP + nt * 256;
        const float* tabr = p.tab_ret; const float* tabd = p.tab_dil; bf16_t* rqb = (bf16_t*)p.rq; bf16_t* rkb = (bf16_t*)p.rk; bf16_t* dqb = (bf16_t*)p.dq; bf16_t* dkb = (bf16_t*)p.dk;
        G8Out so; so.out = out; so.ld = NINP; so.w = perm ? 256 : 0;
        gemm_tile256(p.xb + (size_t)mt * 256 * 1024, 1024, nullptr, 256, Bt + (size_t)nt * 256 * 1024, 1024, 1024, lds, wbase_in, pre, nx, perm, so,
                     [=](int r, int c, f32x4 v0, f32x4 v1) mutable {
                         const int pos = (mt * 256 + r) % SEQ; const size_t t = (size_t)mt * 256 + r;
                         if (nt == 0) {
                             const int i0 = c & 15, hc = c & 127; const bool isk = c >= 128;
                             const f32x4 cs0 = *(const f32x4*)(tabr + (pos * 16 + i0) * 2), cs1 = *(const f32x4*)(tabr + (pos * 16 + i0) * 2 + 4);
                             const float sc = isk ? 0.17677669529663687f : 1.0f;
                             const f32x4 a = v0 * sc, b = v1 * sc;
                             v0[0] = a[0] * cs0[0] - b[0] * cs0[1]; v1[0] = a[0] * cs0[1] + b[0] * cs0[0]; v0[1] = a[1] * cs0[2] - b[1] * cs0[3]; v1[1] = a[1] * cs0[3] + b[1] * cs0[2];
                             v0[2] = a[2] * cs1[0] - b[2] * cs1[1]; v1[2] = a[2] * cs1[1] + b[2] * cs1[0]; v0[3] = a[3] * cs1[2] - b[3] * cs1[3]; v1[3] = a[3] * cs1[3] + b[3] * cs1[2];
                             bf16_t* dst = (isk ? rkb : rqb) + t * 128 + hc;
                             uint2 o; o.x = cvtpk(v0[0], v0[1]); o.y = cvtpk(v0[2], v0[3]); *(uint2*)dst = o; o.x = cvtpk(v1[0], v1[1]); o.y = cvtpk(v1[2], v1[3]); *(uint2*)(dst + 16) = o;
                         } else if (nt == 3 || nt == 4) {
                             const float sc = (nt == 3) ? (0.125f * 1.4426950408889634f) : 1.0f;
                             v0 = v0 * sc; v1 = v1 * sc;
                             if ((c & 32) == 0) {
                                 f32x4 pv;
#pragma unroll
                                 for (int j = 0; j < 4; ++j) { auto rr = __builtin_amdgcn_permlane32_swap(__float_as_uint(v0[j]), __float_as_uint(v0[j]), false, false); pv[j] = __uint_as_float((c & 8) ? rr[0] : rr[1]); }
                                 const int i0 = c & 7;
                                 const f32x4 cs0 = *(const f32x4*)(tabd + (pos * 8 + i0) * 2), cs1 = *(const f32x4*)(tabd + (pos * 8 + i0) * 2 + 4);
                                 const f32x4 own = v0;
                                 if ((c & 8) == 0) { v0[0] = own[0] * cs0[0] - pv[0] * cs0[1]; v0[1] = own[1] * cs0[2] - pv[1] * cs0[3]; v0[2] = own[2] * cs1[0] - pv[2] * cs1[1]; v0[3] = own[3] * cs1[2] - pv[3] * cs1[3]; }
                                 else { v0[0] = pv[0] * cs0[1] + own[0] * cs0[0]; v0[1] = pv[1] * cs0[3] + own[1] * cs0[2]; v0[2] = pv[2] * cs1[1] + own[2] * cs1[0]; v0[3] = pv[3] * cs1[3] + own[3] * cs1[2]; }
                             }
                             bf16_t* dst = ((nt == 3) ? dqb : dkb) + t * 256 + c;
                             uint2 o; o.x = cvtpk(v0[0], v0[1]); o.y = cvtpk(v0[2], v0[3]); *(uint2*)dst = o; o.x = cvtpk(v1[0], v1[1]); o.y = cvtpk(v1[2], v1[3]); *(uint2*)(dst + 16) = o;
                         } else {
                             u32x4 o; o[0] = cvtpk(v0[0], v0[1]); o[1] = cvtpk(v0[2], v0[3]); o[2] = cvtpk(v1[0], v1[1]); o[3] = cvtpk(v1[2], v1[3]); return o;
                         }
                         return (u32x4){0u, 0u, 0u, 0u}; });
        pre = nx.valid != 0;
    }
}


__device__ __forceinline__ float ret_log_gamma(int h) { return logf(1.0f - exp2f(-5.0f - (float)h)); }

__device__ __forceinline__ void ph_ret_kv(const Params& pkv, KPtr kp_in, int wbase_in, int l, char* lds) {
    PH_HEAD
    float* kz = (float*)lds;
    float* vs = kz + 128 * 32;
    const int tid = TID;
    for (int u = BID; u < NBATCH * NCH * 4; u += gridDim.x) {
        const int h = u & 3, n = (u >> 2) & 63, b = u >> 8;
        const float lg = ret_log_gamma(h);
        const int t0 = b * SEQ + n * BLK;
        __syncthreads();
        for (int e = tid; e < 128 * 32; e += NTHREADS) { const int j = e >> 5, d = e & 31; kz[e] = bf2f(((const bf16_t*)p.rk)[(size_t)(t0 + j) * 128 + h * 32 + d]) * __expf((float)(BLK - 1 - j) * lg); }
        for (int e = tid; e < 128 * 64; e += NTHREADS) { const int j = e >> 6, c = e & 63; vs[e] = bf2f(p.pbuf[(size_t)(t0 + j) * NINP + PC_RV + h * 64 + c]); }
        __syncthreads();
        const int e = tid & 63, d0 = (tid >> 6) * 4;
        float a0 = 0.f, a1 = 0.f, a2 = 0.f, a3 = 0.f;
#pragma unroll 8
        for (int j = 0; j < BLK; ++j) {
            const float vv = vs[j * 64 + e]; const float4 kk = *(const float4*)(kz + j * 32 + d0);
            a0 += kk.x * vv; a1 += kk.y * vv; a2 += kk.z * vv; a3 += kk.w * vv;
        }
        float* out = p.rkv + (size_t)u * 2048;
        out[(d0 + 0) * 64 + e] = a0; out[(d0 + 1) * 64 + e] = a1; out[(d0 + 2) * 64 + e] = a2; out[(d0 + 3) * 64 + e] = a3;
    }
}
__device__ __forceinline__ void ph_ret_scan(const Params& pkv, KPtr kp_in, int wbase_in, int l) {
    PH_HEAD
    const int i = BID * NTHREADS + TID;
    if (i < NBATCH * 4 * 32 * 64) {
        const int e = i & 63, d = (i >> 6) & 31, h = (i >> 11) & 3, b = i >> 13;
        const float cd = __expf((float)BLK * ret_log_gamma(h));
        float s = 0.f;
        for (int n = 0; n < NCH; ++n) {
            const size_t idx = ((((size_t)b * NCH + n) * 4 + h) * 32 + d) * 64 + e;
            p.rstate[idx] = s; s = cd * s + p.rkv[idx];
        }
    }
}
__device__ __forceinline__ void ph_ret_out(const Params& pkv, KPtr kp_in, int wbase_in, int l, char* lds) {
    PH_HEAD
    constexpr int KSTR = 40, VSTR = 132, SSTR = 40, UNIT_BYTES = (128 * KSTR + 64 * VSTR + 64 * SSTR) * 2;
    const int tid = TID, lane = tid & 63, wv = tid >> 6, hb = wv >> 2, w = wv & 3, r = lane & 31, hh = lane >> 5, ht = tid & 255;
    bf16_t* Ks = (bf16_t*)(lds + hb * UNIT_BYTES);
    bf16_t* Vt = Ks + 128 * KSTR;
    bf16_t* St = Vt + 64 * VSTR;
    const bf16_t* rqb = (const bf16_t*)p.rq; const bf16_t* rkb = (const bf16_t*)p.rk;
    int* wq = p.wq + l * 16 + 2;
    volatile int* wslot = (volatile int*)(lds + 2 * UNIT_BYTES);
    for (;;) {
        __syncthreads();
        if (tid == 0) *wslot = atomicAdd(wq, 1);
        __syncthreads();
        const int u0 = __builtin_amdgcn_readfirstlane(*wslot) * 2;
        if (u0 >= NBATCH * NCH * 4) break;
        const int u = u0 + hb, h = u & 3, n = (u >> 2) & 63, b = u >> 8;
        const int t0 = b * SEQ + n * BLK;
        const float lg2 = ret_log_gamma(h) * 1.4426950408889634f;
        __syncthreads();
#pragma unroll
        for (int i = 0; i < 2; ++i) { const int c = ht + i * 256, key = c >> 2, ch = c & 3; *(u32x4*)(Ks + key * KSTR + ch * 8) = *(const u32x4*)(rkb + (size_t)(t0 + key) * 128 + h * 32 + ch * 8); }
#pragma unroll
        for (int i = 0; i < 4; ++i) {
            const int c = ht + i * 256, key = c & 127, ch = c >> 7;
            const u32x4 rv = *(const u32x4*)(p.pbuf + (size_t)(t0 + key) * NINP + PC_RV + h * 64 + ch * 8);
            bf16_t* vd = Vt + (ch * 8) * VSTR + key;
            vd[0] = (bf16_t)(rv[0] & 0xffff); vd[VSTR] = (bf16_t)(rv[0] >> 16); vd[2 * VSTR] = (bf16_t)(rv[1] & 0xffff); vd[3 * VSTR] = (bf16_t)(rv[1] >> 16);
            vd[4 * VSTR] = (bf16_t)(rv[2] & 0xffff); vd[5 * VSTR] = (bf16_t)(rv[2] >> 16); vd[6 * VSTR] = (bf16_t)(rv[3] & 0xffff); vd[7 * VSTR] = (bf16_t)(rv[3] >> 16);
        }
        {
            const float* st = p.rstate + (size_t)u * 2048;
#pragma unroll
            for (int i = 0; i < 8; ++i) { const int c = ht + i * 256, d = c >> 6, e = c & 63; St[e * SSTR + d] = f2bf(st[c]); }
        }
        __syncthreads();
        const int iq = 32 * w + r, t = t0 + iq;
        bf16x8 qf[2];
#pragma unroll
        for (int s = 0; s < 2; ++s) qf[s] = *(const bf16x8*)(rqb + (size_t)t * 128 + h * 32 + 16 * s + 8 * hh);
        f32x16 o0, o1;
#pragma unroll
        for (int i = 0; i < 16; ++i) { o0[i] = 0.f; o1[i] = 0.f; }
#pragma unroll
        for (int s = 0; s < 2; ++s) {
            const bf16x8 sa0 = *(const bf16x8*)(St + r * SSTR + 16 * s + 8 * hh), sa1 = *(const bf16x8*)(St + (32 + r) * SSTR + 16 * s + 8 * hh);
            o0 = __builtin_amdgcn_mfma_f32_32x32x16_bf16(sa0, qf[s], o0, 0, 0, 0);
            o1 = __builtin_amdgcn_mfma_f32_32x32x16_bf16(sa1, qf[s], o1, 0, 0, 0);
        }
        {
            const float xi = __builtin_amdgcn_exp2f((float)(iq + 1) * lg2);
#pragma unroll
            for (int i = 0; i < 16; ++i) { o0[i] *= xi; o1[i] *= xi; }
        }
        float cdec[16];
#pragma unroll
        for (int i = 0; i < 16; ++i) cdec[i] = __builtin_amdgcn_exp2f(-(float)((i & 3) + 8 * (i >> 2) + 4 * hh) * lg2);
        for (int jt = 0; jt <= w; ++jt) {
            f32x16 st;
#pragma unroll
            for (int i = 0; i < 16; ++i) st[i] = 0.f;
#pragma unroll
            for (int s = 0; s < 2; ++s) { const bf16x8 kf = *(const bf16x8*)(Ks + (32 * jt + r) * KSTR + 16 * s + 8 * hh); st = __builtin_amdgcn_mfma_f32_32x32x16_bf16(kf, qf[s], st, 0, 0, 0); }
            const float al = __builtin_amdgcn_exp2f((float)(32 * (w - jt) + r) * lg2);
            if (jt == w) {
#pragma unroll
                for (int i = 0; i < 16; ++i) { const int kr = (i & 3) + 8 * (i >> 2) + 4 * hh; st[i] = (kr <= r) ? st[i] * (al * cdec[i]) : 0.f; }
            } else {
#pragma unroll
                for (int i = 0; i < 16; ++i) st[i] *= al * cdec[i];
            }
#pragma unroll
            for (int s = 0; s < 2; ++s) {
                u32x4 pw; pw[0] = cvtpk(st[8 * s], st[8 * s + 1]); pw[1] = cvtpk(st[8 * s + 2], st[8 * s + 3]); pw[2] = cvtpk(st[8 * s + 4], st[8 * s + 5]); pw[3] = cvtpk(st[8 * s + 6], st[8 * s + 7]);
                const bf16x8 pf = __builtin_bit_cast(bf16x8, pw);
                const bf16_t* va = Vt + r * VSTR + 32 * jt + 16 * s + 4 * hh;
                const s16x4 a0 = *(const s16x4*)(va), a1 = *(const s16x4*)(va + 8), b0 = *(const s16x4*)(va + 32 * VSTR), b1 = *(const s16x4*)(va + 32 * VSTR + 8);
                o0 = __builtin_amdgcn_mfma_f32_32x32x16_bf16(__builtin_shufflevector(a0, a1, 0, 1, 2, 3, 4, 5, 6, 7), pf, o0, 0, 0, 0);
                o1 = __builtin_amdgcn_mfma_f32_32x32x16_bf16(__builtin_shufflevector(b0, b1, 0, 1, 2, 3, 4, 5, 6, 7), pf, o1, 0, 0, 0);
            }
        }
        float ss = 0.f;
#pragma unroll
        for (int i = 0; i < 16; ++i) ss += o0[i] * o0[i] + o1[i] * o1[i];
        ss = xhalf_sum(ss);
        const float rs = rsqrtf(ss * (1.0f / 64.0f) + 1e-6f);
        const float* ng = p.ret_norm_g + l * 256 + h * 64 + 4 * hh;
        const bf16_t* gp = p.pbuf + (size_t)t * NINP + PC_RG + h * 64 + 4 * hh;
        bf16_t* outp = p.mixcat + (size_t)t * 1024 + h * 64 + 4 * hh;
#pragma unroll
        for (int c = 0; c < 2; ++c)
#pragma unroll
            for (int g = 0; g < 4; ++g) {
                const int eo = 32 * c + 8 * g;
                const f32x4 gn = *(const f32x4*)(ng + eo); const uint2 gu = *(const uint2*)(gp + eo);
                const float g0 = __uint_as_float(gu.x << 16), g1 = __uint_as_float(gu.x & 0xffff0000u), g2 = __uint_as_float(gu.y << 16), g3 = __uint_as_float(gu.y & 0xffff0000u);
                const float v0 = (c ? o1[4 * g] : o0[4 * g]) * rs * gn[0], v1 = (c ? o1[4 * g + 1] : o0[4 * g + 1]) * rs * gn[1], v2 = (c ? o1[4 * g + 2] : o0[4 * g + 2]) * rs * gn[2], v3 = (c ? o1[4 * g + 3] : o0[4 * g + 3]) * rs * gn[3];
                uint2 ov; ov.x = cvtpk(g0 * sigmoidf_(g0) * v0, g1 * sigmoidf_(g1) * v1); ov.y = cvtpk(g2 * sigmoidf_(g2) * v2, g3 * sigmoidf_(g3) * v3);
                *(uint2*)(outp + eo) = ov;
            }
    }
}

__device__ __forceinline__ void ph_dil_attn(const Params& pkv, KPtr kp_in, int wbase_in, int l, char* lds) {
    PH_HEAD
    constexpr int KSTR = 72, VSTR = 68;
    bf16_t* Ks = (bf16_t*)lds;
    bf16_t* Vt = Ks + 64 * KSTR;
    const int tid = TID, lane = tid & 63, wv = tid >> 6, r = lane & 31, h = lane >> 5;
    int* wq = p.wq + l * 16 + 1;
    volatile int* wslot = (volatile int*)(lds + 24576);
    for (;;) {
        __syncthreads();
        if (tid == 0) *wslot = atomicAdd(wq, 1);
        __syncthreads();
        const int it = __builtin_amdgcn_readfirstlane(*wslot);
        if (it >= 16 * 96) break;
        const int bh = it & 15, u = it >> 4;
        const int b = bh >> 2, hd = bh & 3;
        int pat, dil, rr, m0;
        if (u < 32) { pat = 0; dil = 1; rr = 0; m0 = u * 256; }
        else if (u < 64) { pat = 1; dil = 4; rr = (u - 32) >> 3; m0 = ((u - 32) & 7) * 256; }
        else { pat = 2; dil = 16; rr = (u - 64) >> 1; m0 = ((u - 64) & 1) * 256; }
        const int qmin = m0 + 32 * wv, qmax = qmin + 31, myq = qmin + r;
        const size_t tok0 = (size_t)b * SEQ + rr;
        bf16x8 qf[4];
        {
            const bf16_t* qrow = (const bf16_t*)p.dq + (tok0 + (size_t)dil * myq) * 256 + hd * 64 + 8 * h;
#pragma unroll
            for (int s = 0; s < 4; ++s) qf[s] = *(const bf16x8*)(qrow + 16 * s);
        }
        f32x16 o0, o1;
#pragma unroll
        for (int i = 0; i < 16; ++i) { o0[i] = 0.f; o1[i] = 0.f; }
        float m = -1e30f, lsum = 0.f;
        const int kk = tid >> 3, kc = tid & 7, vk = tid & 63, vc = tid >> 6;
        const bf16_t* kbase = (const bf16_t*)p.dk + hd * 64 + kc * 8;
        const bf16_t* vbase = p.pbuf + PC_DV + hd * 64 + vc * 8;
        const int j0 = (m0 == 0) ? 2 : 0;
        u32x4 rk, rv;
        {
            const int kb = m0 - 128 + 64 * j0;
            rk = *(const u32x4*)(kbase + (tok0 + (size_t)dil * (kb + kk)) * 256);
            rv = *(const u32x4*)(vbase + (tok0 + (size_t)dil * (kb + vk)) * NINP);
        }
        for (int j = j0; j < 6; ++j) {
            __syncthreads();
            *(u32x4*)(Ks + kk * KSTR + kc * 8) = rk;
            {
                const unsigned w0 = rv[0], w1 = rv[1], w2 = rv[2], w3 = rv[3];
                bf16_t* vd = Vt + (vc * 8) * VSTR + vk;
                vd[0] = (bf16_t)(w0 & 0xffff); vd[VSTR] = (bf16_t)(w0 >> 16); vd[2 * VSTR] = (bf16_t)(w1 & 0xffff); vd[3 * VSTR] = (bf16_t)(w1 >> 16);
                vd[4 * VSTR] = (bf16_t)(w2 & 0xffff); vd[5 * VSTR] = (bf16_t)(w2 >> 16); vd[6 * VSTR] = (bf16_t)(w3 & 0xffff); vd[7 * VSTR] = (bf16_t)(w3 >> 16);
            }
            __syncthreads();
            const int kb = m0 - 128 + 64 * j;
            if (j + 1 < 6) {
                const int kn = kb + 64;
                rk = *(const u32x4*)(kbase + (tok0 + (size_t)dil * (kn + kk)) * 256);
                rv = *(const u32x4*)(vbase + (tok0 + (size_t)dil * (kn + vk)) * NINP);
            }
            const bool need0 = (kb <= qmax) && (kb + 31 >= qmin - 128);
            const bool need1 = (kb + 32 <= qmax) && (kb + 63 >= qmin - 128);
            if (need0 || need1) {
                f32x16 s0, s1;
#pragma unroll
                for (int i = 0; i < 16; ++i) { s0[i] = -3e38f; s1[i] = -3e38f; }
                if (need0) {
#pragma unroll
                    for (int i = 0; i < 16; ++i) s0[i] = 0.f;
#pragma unroll
                    for (int s = 0; s < 4; ++s) { const bf16x8 kf = *(const bf16x8*)(Ks + r * KSTR + 16 * s + 8 * h); s0 = __builtin_amdgcn_mfma_f32_32x32x16_bf16(kf, qf[s], s0, 0, 0, 0); }
                    if (!((kb + 31 <= qmin) && (kb >= qmax - 128))) {
#pragma unroll
                        for (int i = 0; i < 16; ++i) { const int key = kb + (i & 3) + 8 * (i >> 2) + 4 * h; if (key > myq || key < myq - 128) s0[i] = -3e38f; }
                    }
                }
                if (need1) {
#pragma unroll
                    for (int i = 0; i < 16; ++i) s1[i] = 0.f;
#pragma unroll
                    for (int s = 0; s < 4; ++s) { const bf16x8 kf = *(const bf16x8*)(Ks + (32 + r) * KSTR + 16 * s + 8 * h); s1 = __builtin_amdgcn_mfma_f32_32x32x16_bf16(kf, qf[s], s1, 0, 0, 0); }
                    if (!((kb + 63 <= qmin) && (kb + 32 >= qmax - 128))) {
#pragma unroll
                        for (int i = 0; i < 16; ++i) { const int key = kb + 32 + (i & 3) + 8 * (i >> 2) + 4 * h; if (key > myq || key < myq - 128) s1[i] = -3e38f; }
                    }
                }
                float mx = s0[0];
#pragma unroll
                for (int i = 1; i < 16; ++i) mx = fmaxf(mx, s0[i]);
#pragma unroll
                for (int i = 0; i < 16; ++i) mx = fmaxf(mx, s1[i]);
                mx = xhalf_max(mx);
                const float mn = fmaxf(m, mx), alpha = __builtin_amdgcn_exp2f(m - mn);
                m = mn;
                float ps = 0.f;
                if (need0) {
#pragma unroll
                    for (int i = 0; i < 16; ++i) { s0[i] = __builtin_amdgcn_exp2f(s0[i] - mn); ps += s0[i]; }
                }
                if (need1) {
#pragma unroll
                    for (int i = 0; i < 16; ++i) { s1[i] = __builtin_amdgcn_exp2f(s1[i] - mn); ps += s1[i]; }
                }
                lsum = lsum * alpha + ps;
                if (!__all(alpha == 1.0f)) {
#pragma unroll
                    for (int i = 0; i < 16; ++i) { o0[i] *= alpha; o1[i] *= alpha; }
                }
                if (need0) {
#pragma unroll
                    for (int s = 0; s < 2; ++s) {
                        u32x4 pw; pw[0] = cvtpk(s0[8 * s], s0[8 * s + 1]); pw[1] = cvtpk(s0[8 * s + 2], s0[8 * s + 3]); pw[2] = cvtpk(s0[8 * s + 4], s0[8 * s + 5]); pw[3] = cvtpk(s0[8 * s + 6], s0[8 * s + 7]);
                        const bf16x8 pf = __builtin_bit_cast(bf16x8, pw);
                        const bf16_t* va = Vt + r * VSTR + 16 * s + 4 * h;
                        const s16x4 a0 = *(const s16x4*)(va), a1 = *(const s16x4*)(va + 8), b0 = *(const s16x4*)(va + 32 * VSTR), b1 = *(const s16x4*)(va + 32 * VSTR + 8);
                        o0 = __builtin_amdgcn_mfma_f32_32x32x16_bf16(__builtin_shufflevector(a0, a1, 0, 1, 2, 3, 4, 5, 6, 7), pf, o0, 0, 0, 0);
                        o1 = __builtin_amdgcn_mfma_f32_32x32x16_bf16(__builtin_shufflevector(b0, b1, 0, 1, 2, 3, 4, 5, 6, 7), pf, o1, 0, 0, 0);
                    }
                }
                if (need1) {
#pragma unroll
                    for (int s = 0; s < 2; ++s) {
                        u32x4 pw; pw[0] = cvtpk(s1[8 * s], s1[8 * s + 1]); pw[1] = cvtpk(s1[8 * s + 2], s1[8 * s + 3]); pw[2] = cvtpk(s1[8 * s + 4], s1[8 * s + 5]); pw[3] = cvtpk(s1[8 * s + 6], s1[8 * s + 7]);
                        const bf16x8 pf = __builtin_bit_cast(bf16x8, pw);
                        const bf16_t* va = Vt + r * VSTR + 32 + 16 * s + 4 * h;
                        const s16x4 a0 = *(const s16x4*)(va), a1 = *(const s16x4*)(va + 8), b0 = *(const s16x4*)(va + 32 * VSTR), b1 = *(const s16x4*)(va + 32 * VSTR + 8);
                        o0 = __builtin_amdgcn_mfma_f32_32x32x16_bf16(__builtin_shufflevector(a0, a1, 0, 1, 2, 3, 4, 5, 6, 7), pf, o0, 0, 0, 0);
                        o1 = __builtin_amdgcn_mfma_f32_32x32x16_bf16(__builtin_shufflevector(b0, b1, 0, 1, 2, 3, 4, 5, 6, 7), pf, o1, 0, 0, 0);
                    }
                }
            }
        }
        const float lt = xhalf_sum(lsum), inv = 1.0f / lt;
        const size_t tq = tok0 + (size_t)dil * myq;
        float* op = p.dob + ((size_t)pat * NT + tq) * 256 + hd * 64 + 4 * h;
#pragma unroll
        for (int g = 0; g < 4; ++g) {
            *(f32x4*)(op + 8 * g) = (f32x4){o0[4 * g] * inv, o0[4 * g + 1] * inv, o0[4 * g + 2] * inv, o0[4 * g + 3] * inv};
            *(f32x4*)(op + 32 + 8 * g) = (f32x4){o1[4 * g] * inv, o1[4 * g + 1] * inv, o1[4 * g + 2] * inv, o1[4 * g + 3] * inv};
        }
        if (h == 0) p.dlse[((size_t)pat * NT + tq) * 4 + hd] = m + __builtin_amdgcn_logf(lt);
        __syncthreads();
    }
}

__device__ __forceinline__ void ph_rwkv_prep(const Params& pkv, KPtr kp_in, int wbase_in, int l, char* lds) {
    PH_HEAD
    bf16_t* Aw = (bf16_t*)lds; bf16_t* Aa = Aw + 64 * 72; bf16_t* Ag = Aa + 64 * 72; bf16_t* Av = Ag + 64 * 136; float* ssq = (float*)(Av + 64 * 40);
    const int tid = TID, lane = tid & 63, wv = tid >> 6, fr = lane & 15, fq = lane >> 4;
    const int lm = (l > 0) ? l - 1 : 0;
    const float* mu = p.rwkv_mu + l * 1024; const float* vmu = p.vres_mu + lm * 32;
    bf16x8 fw[2][2], fa[2][2], fg[2][4], fv[2];
#pragma unroll
    for (int ni = 0; ni < 2; ++ni) {
        const int n = 32 * wv + 16 * ni + fr;
#pragma unroll
        for (int ks = 0; ks < 2; ++ks) { fw[ni][ks] = *(const bf16x8*)(p.wupt + ((size_t)l * 256 + n) * 64 + 32 * ks + 8 * fq); fa[ni][ks] = *(const bf16x8*)(p.aupt + ((size_t)l * 256 + n) * 64 + 32 * ks + 8 * fq); }
#pragma unroll
        for (int ks = 0; ks < 4; ++ks) fg[ni][ks] = *(const bf16x8*)(p.gupt + ((size_t)l * 256 + n) * 128 + 32 * ks + 8 * fq);
        fv[ni] = *(const bf16x8*)(p.vupt + ((size_t)lm * 256 + n) * 32 + 8 * fq);
    }
    for (int tb = BID * 64; tb < NT; tb += gridDim.x * 64) {
        __syncthreads();
        for (int e = tid; e < 64 * 144; e += NTHREADS) {
            const int tt = e / 144, j = (e % 144) * 2, t = tb + tt;
            const bool first = (t % SEQ) == 0;
            const bf16_t* pr = p.pbuf + (size_t)t * NINP;
            int col; float m0, m1;
            if (j < 256) { col = PC_CWD + j; m0 = mu[768 + j]; m1 = mu[768 + j + 1]; } else { col = PC_VRES + (j - 256); m0 = vmu[j - 256]; m1 = vmu[j - 255]; }
            const unsigned cu = *(const unsigned*)(pr + col), pu = first ? 0u : *(const unsigned*)(pr + col - NINP);
            const float c0 = __uint_as_float(cu << 16), c1 = __uint_as_float(cu & 0xffff0000u), p0 = __uint_as_float(pu << 16), p1 = __uint_as_float(pu & 0xffff0000u);
            float x0 = c0 + (p0 - c0) * m0, x1 = c1 + (p1 - c1) * m1;
            bf16_t* dst;
            if (j < 64) { x0 = 1.0f - 2.0f * __builtin_amdgcn_rcpf(__builtin_amdgcn_exp2f(x0 * 2.8853900817779268f) + 1.0f); x1 = 1.0f - 2.0f * __builtin_amdgcn_rcpf(__builtin_amdgcn_exp2f(x1 * 2.8853900817779268f) + 1.0f); dst = Aw + tt * 72 + j; }
            else if (j < 128) { dst = Aa + tt * 72 + (j - 64); }
            else if (j < 256) { x0 = sigmoidf_(x0); x1 = sigmoidf_(x1); dst = Ag + tt * 136 + (j - 128); }
            else { dst = Av + tt * 40 + (j - 256); }
            *(unsigned*)dst = cvtpk(x0, x1);
        }
        {
            const f32x4 kkc = *(const f32x4*)(p.rwkv_k_k + l * 256 + lane * 4), mk4 = *(const f32x4*)(mu + 256 + lane * 4);
#pragma unroll
            for (int i = 0; i < 8; ++i) {
                const int tt = wv * 8 + i, t = tb + tt; const bool first = (t % SEQ) == 0;
                const bf16_t* pr = p.pbuf + (size_t)t * NINP + PC_CK + lane * 4;
                const uint2 cu = *(const uint2*)pr; const uint2 pu = first ? make_uint2(0u, 0u) : *(const uint2*)(pr - NINP);
                const float c0 = __uint_as_float(cu.x << 16), c1 = __uint_as_float(cu.x & 0xffff0000u), c2 = __uint_as_float(cu.y << 16), c3 = __uint_as_float(cu.y & 0xffff0000u);
                const float q0 = __uint_as_float(pu.x << 16), q1 = __uint_as_float(pu.x & 0xffff0000u), q2 = __uint_as_float(pu.y << 16), q3 = __uint_as_float(pu.y & 0xffff0000u);
                const float k0 = (c0 + (q0 - c0) * mk4[0]) * kkc[0], k1 = (c1 + (q1 - c1) * mk4[1]) * kkc[1], k2 = (c2 + (q2 - c2) * mk4[2]) * kkc[2], k3 = (c3 + (q3 - c3) * mk4[3]) * kkc[3];
                const float ss = grp16_sum(k0 * k0 + k1 * k1 + k2 * k2 + k3 * k3);
                if ((lane & 15) == 0) ssq[tt * 4 + (lane >> 4)] = ss;
            }
        }
        __syncthreads();
#pragma unroll 1
        for (int mt = 0; mt < 4; ++mt) {
            f32x4 cw[2], ca[2], cg[2], cv[2];
#pragma unroll
            for (int ni = 0; ni < 2; ++ni) { cw[ni] = (f32x4){0.f, 0.f, 0.f, 0.f}; ca[ni] = cw[ni]; cg[ni] = cw[ni]; cv[ni] = cw[ni]; }
            const int arow = 16 * mt + fr;
#pragma unroll
            for (int ks = 0; ks < 2; ++ks) {
                const bf16x8 xw = *(const bf16x8*)(Aw + arow * 72 + 32 * ks + 8 * fq), xa = *(const bf16x8*)(Aa + arow * 72 + 32 * ks + 8 * fq);
#pragma unroll
                for (int ni = 0; ni < 2; ++ni) { cw[ni] = __builtin_amdgcn_mfma_f32_16x16x32_bf16(fw[ni][ks], xw, cw[ni], 0, 0, 0); ca[ni] = __builtin_amdgcn_mfma_f32_16x16x32_bf16(fa[ni][ks], xa, ca[ni], 0, 0, 0); }
            }
#pragma unroll
            for (int ks = 0; ks < 4; ++ks) {
                const bf16x8 xg = *(const bf16x8*)(Ag + arow * 136 + 32 * ks + 8 * fq);
#pragma unroll
                for (int ni = 0; ni < 2; ++ni) cg[ni] = __builtin_amdgcn_mfma_f32_16x16x32_bf16(fg[ni][ks], xg, cg[ni], 0, 0, 0);
            }
            if (l > 0) {
                const bf16x8 xv = *(const bf16x8*)(Av + arow * 40 + 8 * fq);
#pragma unroll
                for (int ni = 0; ni < 2; ++ni) cv[ni] = __builtin_amdgcn_mfma_f32_16x16x32_bf16(fv[ni], xv, cv[ni], 0, 0, 0);
            }
            const int tt = 16 * mt + fr, t = tb + tt; const bool first = (t % SEQ) == 0;
            const float rn = 1.0f / fmaxf(sqrtf(ssq[tt * 4 + (wv >> 1)]), 1e-12f);
            const bf16_t* pr = p.pbuf + (size_t)t * NINP;
#pragma unroll
            for (int ni = 0; ni < 2; ++ni) {
                const int c0 = 32 * wv + 16 * ni + 4 * fq;
                const f32x4 w0 = *(const f32x4*)(p.rwkv_w0 + l * 256 + c0), a0 = *(const f32x4*)(p.rwkv_a0 + l * 256 + c0), kkc = *(const f32x4*)(p.rwkv_k_k + l * 256 + c0), kac = *(const f32x4*)(p.rwkv_k_a + l * 256 + c0);
                const f32x4 v0 = *(const f32x4*)(p.rwkv_v0 + lm * 256 + c0), mr = *(const f32x4*)(mu + c0), mk = *(const f32x4*)(mu + 256 + c0), mv = *(const f32x4*)(mu + 512 + c0);
                const uint2 ru = *(const uint2*)(pr + PC_CR + c0), ku = *(const uint2*)(pr + PC_CK + c0), vu = *(const uint2*)(pr + PC_CV + c0);
                uint2 rp = make_uint2(0u, 0u), kp2 = rp, vp = rp;
                if (!first) { rp = *(const uint2*)(pr + PC_CR + c0 - NINP); kp2 = *(const uint2*)(pr + PC_CK + c0 - NINP); vp = *(const uint2*)(pr + PC_CV + c0 - NINP); }
                const size_t o = (size_t)t * 256 + c0;
                f32x4 vf = (f32x4){0.f, 0.f, 0.f, 0.f};
                if (l > 0) vf = *(const f32x4*)(p.vfirst + o);
                f32x4 o_r, o_w, o_k, o_v, o_a, o_b;
#pragma unroll
                for (int j = 0; j < 4; ++j) {
                    const unsigned rw = (j < 2) ? ru.x : ru.y, kw = (j < 2) ? ku.x : ku.y, vw = (j < 2) ? vu.x : vu.y, rpw = (j < 2) ? rp.x : rp.y, kpw = (j < 2) ? kp2.x : kp2.y, vpw = (j < 2) ? vp.x : vp.y;
                    const float rc = (j & 1) ? __uint_as_float(rw & 0xffff0000u) : __uint_as_float(rw << 16), kc = (j & 1) ? __uint_as_float(kw & 0xffff0000u) : __uint_as_float(kw << 16), vc = (j & 1) ? __uint_as_float(vw & 0xffff0000u) : __uint_as_float(vw << 16);
                    const float rq = (j & 1) ? __uint_as_float(rpw & 0xffff0000u) : __uint_as_float(rpw << 16), kq = (j & 1) ? __uint_as_float(kpw & 0xffff0000u) : __uint_as_float(kpw << 16), vq = (j & 1) ? __uint_as_float(vpw & 0xffff0000u) : __uint_as_float(vpw << 16);
                    const float r = rc + (rq - rc) * mr[j], k = kc + (kq - kc) * mk[j];
                    float v = vc + (vq - vc) * mv[j];
                    const float wpre = w0[j] + cw[ni][j];
                    const float sp = (-wpre > 20.f) ? -wpre : 0.6931471805599453f * __builtin_amdgcn_logf(1.0f + __builtin_amdgcn_exp2f(wpre * -1.4426950408889634f));
                    const float decay = __builtin_amdgcn_exp2f(-1.4426950408889634f * __builtin_amdgcn_exp2f((-sp - 0.5f) * 1.4426950408889634f));
                    const float a = sigmoidf_(a0[j] + ca[ni][j]);
                    const float kk = k * kkc[j] * rn;
                    const float k2 = k * (1.0f + (a - 1.0f) * kac[j]);
                    if (l == 0) vf[j] = v; else v = v + (vf[j] - v) * sigmoidf_(v0[j] + cv[ni][j]);
                    o_r[j] = r; o_w[j] = decay; o_k[j] = k2; o_v[j] = v; o_a[j] = -kk; o_b[j] = kk * a;
                }
                if (l == 0) *(f32x4*)(p.vfirst + o) = vf;
                *(f32x4*)(p.sr + o) = o_r; *(f32x4*)(p.sw + o) = o_w; *(f32x4*)(p.sk + o) = o_k; *(f32x4*)(p.sv + o) = o_v; *(f32x4*)(p.sa + o) = o_a; *(f32x4*)(p.sb + o) = o_b; *(f32x4*)(p.sg + o) = cg[ni];
            }
        }
    }
}

#define MF4(a, b, c) __builtin_amdgcn_mfma_f32_16x16x4f32((a), (b), (c), 0, 0, 0)
#define WSYNC() asm volatile("s_waitcnt lgkmcnt(0)" ::: "memory")
__device__ __forceinline__ f32x4 mm16(const float* A, int sam, int sak, const float* B, int sbk, int sbn, int K, f32x4 acc, int fr, int fq) {
#pragma unroll 4
    for (int kk = 0; kk < K; kk += 4) { const float a = A[fr * sam + (kk + fq) * sak]; const float b = B[(kk + fq) * sbk + fr * sbn]; acc = MF4(a, b, acc); }
    return acc;
}
constexpr int CH_T = 16, CH_N = SEQ / CH_T, CH_LD = 68, CH_WAVE_FLOATS = 6 * 16 * CH_LD + 5 * 16 * 17 + 64;
__device__ __forceinline__ void ph_rwkv_chunkpre(const Params& pkv, KPtr kp_in, int wbase_in, int l, char* lds) {
    PH_HEAD
    const int tid = TID, lane = tid & 63, wv = tid >> 6, fr = lane & 15, fq = lane >> 4;
    if (wv >= 4) return;
    float* L = (float*)lds + wv * CH_WAVE_FLOATS;
    float* At = L; float* Bt = At + 16 * CH_LD; float* Kt = Bt + 16 * CH_LD; float* Rt = Kt + 16 * CH_LD; float* Vv = Rt + 16 * CH_LD; float* W1 = Vv + 16 * CH_LD;
    float* Pst = (float*)lds + 4 * CH_WAVE_FLOATS + wv * 1024;
    float* Aab = W1 + 16 * CH_LD; float* Aak = Aab + 16 * 17; float* Arb = Aak + 16 * 17; float* Ark = Arb + 16 * 17; float* Mm = Ark + 16 * 17; float* gT = Mm + 16 * 17;
    const f32x4 z4 = (f32x4){0.f, 0.f, 0.f, 0.f};
    for (int u = BID * 4 + wv; u < 16 * CH_N; u += gridDim.x * 4) {
        const int bh = u / CH_N, c = u % CH_N, b = bh >> 2, hd = bh & 3;
        const size_t o0 = ((size_t)b * SEQ + (size_t)c * CH_T) * 256 + hd * 64 + lane;
        WSYNC();
        {
            float g = 1.0f;
#pragma unroll
            for (int t = 0; t < CH_T; ++t) {
                const size_t o = o0 + (size_t)t * 256;
                const float w = p.sw[o], a = p.sa[o], bb = p.sb[o], k = p.sk[o], r = p.sr[o], v = p.sv[o];
                const float gp = g; g *= w; const float ig = 1.0f / g;
                At[t * CH_LD + lane] = a * gp; Bt[t * CH_LD + lane] = bb * ig; Kt[t * CH_LD + lane] = k * ig; Rt[t * CH_LD + lane] = r * g; Vv[t * CH_LD + lane] = v;
            }
            gT[lane] = g;
        }
        WSYNC();
        {
            f32x4 gab = z4, gak = z4, grb = z4, grk = z4;
#pragma unroll
            for (int k0 = 0; k0 < 64; k0 += 32) {
                float aA[8], aR[8], bB[8], bK[8];
#pragma unroll
                for (int q = 0; q < 8; ++q) { const int o = fr * CH_LD + k0 + 4 * q + fq; aA[q] = At[o]; aR[q] = Rt[o]; bB[q] = Bt[o]; bK[q] = Kt[o]; }
                WSYNC(); __builtin_amdgcn_sched_barrier(0);
#pragma unroll
                for (int q = 0; q < 8; ++q) { gab = MF4(aA[q], bB[q], gab); gak = MF4(aA[q], bK[q], gak); grb = MF4(aR[q], bB[q], grb); grk = MF4(aR[q], bK[q], grk); }
            }
#pragma unroll
            for (int rg = 0; rg < 4; ++rg) {
                const int t = 4 * fq + rg, s = fr;
                Aab[t * 17 + s] = (s < t) ? gab[rg] : 0.f; Aak[t * 17 + s] = (s < t) ? gak[rg] : 0.f;
                Arb[t * 17 + s] = (s <= t) ? grb[rg] : 0.f; Ark[t * 17 + s] = (s <= t) ? grk[rg] : 0.f;
            }
        }
        WSYNC();
        {
            float m[16];
#pragma unroll
            for (int t = 0; t < 16; ++t) {
                float acc = (t == fr) ? 1.0f : 0.f;
#pragma unroll
                for (int s = 0; s < t; ++s) acc += Aab[t * 17 + s] * m[s];
                m[t] = acc;
            }
            if (fq == 0) {
#pragma unroll
                for (int t = 0; t < 16; ++t) Mm[t * 17 + fr] = m[t];
            }
        }
        WSYNC();
        {
            f32x4 m2 = z4, ah[4] = {z4, z4, z4, z4};
#pragma unroll
            for (int kk = 0; kk < 16; kk += 4) {
                const float a = Mm[fr * 17 + kk + fq];
                m2 = MF4(a, Aak[(kk + fq) * 17 + fr], m2);
#pragma unroll
                for (int nt = 0; nt < 4; ++nt) ah[nt] = MF4(a, At[(kk + fq) * CH_LD + 16 * nt + fr], ah[nt]);
            }
            WSYNC();
#pragma unroll
            for (int rg = 0; rg < 4; ++rg) {
                Aak[(4 * fq + rg) * 17 + fr] = m2[rg];
#pragma unroll
                for (int nt = 0; nt < 4; ++nt) At[(4 * fq + rg) * CH_LD + 16 * nt + fr] = ah[nt][rg];
            }
            WSYNC();
            f32x4 w1[4] = {z4, z4, z4, z4};
#pragma unroll
            for (int kk = 0; kk < 16; kk += 4) {
                const float a = Aak[fr * 17 + kk + fq];
#pragma unroll
                for (int nt = 0; nt < 4; ++nt) w1[nt] = MF4(a, Vv[(kk + fq) * CH_LD + 16 * nt + fr], w1[nt]);
            }
#pragma unroll
            for (int nt = 0; nt < 4; ++nt)
#pragma unroll
                for (int rg = 0; rg < 4; ++rg) W1[(4 * fq + rg) * CH_LD + 16 * nt + fr] = w1[nt][rg];
        }
        WSYNC();
        {
            float* rh = p.c_rh + (size_t)u * 1024; float* y1 = p.c_y1 + (size_t)u * 1024;
            f32x4 ar[4], yy[4];
#pragma unroll
            for (int nt = 0; nt < 4; ++nt) {
                yy[nt] = z4;
#pragma unroll
                for (int rg = 0; rg < 4; ++rg) ar[nt][rg] = Rt[(4 * fq + rg) * CH_LD + 16 * nt + fr];
            }
#pragma unroll
            for (int kk = 0; kk < 16; kk += 4) {
                const float arb = Arb[fr * 17 + kk + fq], ark = Ark[fr * 17 + kk + fq];
#pragma unroll
                for (int nt = 0; nt < 4; ++nt) {
                    const int bo = (kk + fq) * CH_LD + 16 * nt + fr;
                    ar[nt] = MF4(arb, At[bo], ar[nt]); yy[nt] = MF4(arb, W1[bo], yy[nt]); yy[nt] = MF4(ark, Vv[bo], yy[nt]);
                }
            }
#pragma unroll
            for (int nt = 0; nt < 4; ++nt)
#pragma unroll
                for (int rg = 0; rg < 4; ++rg) Pst[(4 * fq + rg) * 64 + 16 * nt + fr] = ar[nt][rg];
            WSYNC();
#pragma unroll
            for (int i = 0; i < 4; ++i) *(f32x4*)(rh + (i * 64 + lane) * 4) = *(const f32x4*)(Pst + (i * 64 + lane) * 4);
            WSYNC();
#pragma unroll
            for (int nt = 0; nt < 4; ++nt)
#pragma unroll
                for (int rg = 0; rg < 4; ++rg) Pst[(4 * fq + rg) * 64 + 16 * nt + fr] = yy[nt][rg];
            WSYNC();
#pragma unroll
            for (int i = 0; i < 4; ++i) *(f32x4*)(y1 + (i * 64 + lane) * 4) = *(const f32x4*)(Pst + (i * 64 + lane) * 4);
            WSYNC();
        }
        {
            float* pp = p.c_p + (size_t)u * 4096; float* qq = p.c_q + (size_t)u * 4096;
#pragma unroll 1
            for (int jt = 0; jt < 4; ++jt) {
                f32x4 ap[4] = {z4, z4, z4, z4}, aq[4] = {z4, z4, z4, z4};
                {
                    float a_ah[4], a_w1[4], a_v[4], b_bt[4][4], b_kt[4][4];
#pragma unroll
                    for (int q = 0; q < 4; ++q) {
                        const int ao = (4 * q + fq) * CH_LD + 16 * jt + fr;
                        a_ah[q] = At[ao]; a_w1[q] = W1[ao]; a_v[q] = Vv[ao];
#pragma unroll
                        for (int jc = 0; jc < 4; ++jc) { const int bo = (4 * q + fq) * CH_LD + 16 * jc + fr; b_bt[q][jc] = Bt[bo]; b_kt[q][jc] = Kt[bo]; }
                    }
                    WSYNC(); __builtin_amdgcn_sched_barrier(0);
#pragma unroll
                    for (int q = 0; q < 4; ++q)
#pragma unroll
                        for (int jc = 0; jc < 4; ++jc) { ap[jc] = MF4(a_ah[q], b_bt[q][jc], ap[jc]); aq[jc] = MF4(a_w1[q], b_bt[q][jc], aq[jc]); aq[jc] = MF4(a_v[q], b_kt[q][jc], aq[jc]); }
                }
                WSYNC();
#pragma unroll
                for (int jc = 0; jc < 4; ++jc) {
                    const float gc = gT[16 * jc + fr];
#pragma unroll
                    for (int rg = 0; rg < 4; ++rg) {
                        const int row = 16 * jt + 4 * fq + rg, col = 16 * jc + fr;
                        Pst[(jc * 64 + 16 * rg + fr) * 4 + fq] = (ap[jc][rg] + ((row == col) ? 1.0f : 0.f)) * gc; aq[jc][rg] *= gc;
                    }
                }
                WSYNC();
#pragma unroll
                for (int i = 0; i < 4; ++i) *(f32x4*)(pp + ((jt * 4 + i) * 64 + lane) * 4) = *(const f32x4*)(Pst + (i * 64 + lane) * 4);
                WSYNC();
#pragma unroll
                for (int jc = 0; jc < 4; ++jc)
#pragma unroll
                    for (int rg = 0; rg < 4; ++rg) Pst[(4 * fq + rg) * 64 + 16 * jc + fr] = aq[jc][rg];
                WSYNC();
#pragma unroll
                for (int i = 0; i < 4; ++i) *(f32x4*)(qq + (size_t)jt * 1024 + (i * 64 + lane) * 4) = *(const f32x4*)(Pst + (i * 64 + lane) * 4);
            }
        }
    }
}

constexpr int SCANB_BLOCKS = 64;
__device__ __forceinline__ void ph_rwkv_scan(const Params& pkv, KPtr kp_in, int wbase_in, int l, char* lds) {
    PH_HEAD
    if (BID >= SCANB_BLOCKS) return;
    const int tid = TID, lane = tid & 63, wv = tid >> 6, fr = lane & 15, fq = lane >> 4, w = wv & 3;
    const int bh = (BID & 7) + 8 * (BID >> 5), ib = (BID >> 3) & 3, b = bh >> 2, hd = bh & 3, ibase = ib * 16;
    float* exch = (float*)lds;
    float* ypart = (float*)lds + 4096;
    for (int i = tid; i < 8192; i += NTHREADS) ((float*)lds)[i] = 0.f;
    if (wv >= 4) {
        __syncthreads();
        for (int c = 0; c < CH_N; ++c) { __builtin_amdgcn_s_barrier(); }
        return;
    }
    f32x4 cur = (f32x4){0.f, 0.f, 0.f, 0.f};
    const size_t ubase = (size_t)bh * CH_N;
    f32x4 pa[4][4]; f32x4 qv[4], rh[4]; float y1v[4];
#define SCAN_LOAD(S, cc) do { const size_t un_ = ubase + ((cc) < CH_N ? (cc) : CH_N - 1); \
        const f32x4* pp_ = (const f32x4*)(p.c_p + un_ * 4096 + (w * 64 + lane) * 4); \
        pa[S][0] = pp_[0]; pa[S][1] = pp_[256]; pa[S][2] = pp_[512]; pa[S][3] = pp_[768]; \
        qv[S] = *(const f32x4*)(p.c_q + un_ * 4096 + (ibase + fr) * 64 + 16 * w + 4 * fq); \
        rh[S] = *(const f32x4*)(p.c_rh + un_ * 1024 + fr * 64 + 16 * w + 4 * fq); \
        y1v[S] = p.c_y1[un_ * 1024 + (4 * w + fq) * 64 + ibase + fr]; } while (0)
#define SCAN_STEP(S, cc) do { const int bufo = ((cc) & 1) * 2048; \
        float exv[16]; { const float* ex = exch + bufo; _Pragma("unroll") for (int kk = 0; kk < 16; ++kk) exv[kk] = ex[64 * kk + lane]; } \
        __builtin_amdgcn_sched_barrier(0); \
        f32x4 yp = (f32x4){0.f, 0.f, 0.f, 0.f}; \
        _Pragma("unroll") for (int rg = 0; rg < 4; ++rg) yp = MF4(rh[S][rg], cur[rg], yp); \
        asm volatile("s_waitcnt lgkmcnt(0)" ::: "memory"); __builtin_amdgcn_sched_barrier(0); \
        f32x4 acc0 = qv[S], acc1 = (f32x4){0.f, 0.f, 0.f, 0.f}; \
        _Pragma("unroll") for (int kq = 0; kq < 4; ++kq) { \
            acc0 = MF4(pa[S][kq][0], exv[4 * kq], acc0); acc1 = MF4(pa[S][kq][1], exv[4 * kq + 1], acc1); \
            acc0 = MF4(pa[S][kq][2], exv[4 * kq + 2], acc0); acc1 = MF4(pa[S][kq][3], exv[4 * kq + 3], acc1); } \
        cur = acc0 + acc1; \
        { float* yd = ypart + bufo + w * 256; _Pragma("unroll") for (int rg = 0; rg < 4; ++rg) yd[(4 * fq + rg) * 16 + fr] = yp[rg]; } \
        { float* ed = exch + (2048 - bufo) + (16 * w) * 16; _Pragma("unroll") for (int rg = 0; rg < 4; ++rg) ed[(4 * fq + rg) * 16 + fr] = cur[rg]; } \
        asm volatile("s_waitcnt lgkmcnt(0)" ::: "memory"); __builtin_amdgcn_s_barrier(); asm volatile("" ::: "memory"); \
        { const float* ys = ypart + bufo + (4 * w + fq) * 16 + fr; const float y = (ys[0] + ys[256]) + (ys[512] + ys[768]) + y1v[S]; \
          p.sy[((size_t)b * SEQ + (size_t)(cc) * CH_T + 4 * w + fq) * 256 + hd * 64 + ibase + fr] = y; } \
        SCAN_LOAD(S, (cc) + 4); } while (0)
    SCAN_LOAD(0, 0); SCAN_LOAD(1, 1); SCAN_LOAD(2, 2); SCAN_LOAD(3, 3);
    __syncthreads();
    for (int c = 0; c < CH_N; c += 4) { SCAN_STEP(0, c); SCAN_STEP(1, c + 1); SCAN_STEP(2, c + 2); SCAN_STEP(3, c + 3); }
}

__device__ __forceinline__ void ph_mla_up(const Params& pkv, KPtr kp_in, int wbase_in, int l, char* lds) {
    PH_HEAD
    const int nq = (NT / 128) * 3, nkv = (NT / 128) * 4;
    const float SC = 0.10206207261596575f * 1.4426950408889634f;
    float* rsl = (float*)(lds + 40960);
    const int tid = TID;
    for (int u = BID; u < nq + nkv; u += gridDim.x) {
        const bool isq = u < nq;
        const int mt = isq ? u / 3 : (u - nq) / 4, t0 = mt * 128;
        {
            const int row = tid >> 2, part = tid & 3, ncol = isq ? 256 : 128, per = ncol / 4;
            const bf16_t* src = p.pbuf + (size_t)(t0 + row) * NINP + (isq ? PC_MQ : PC_MKV) + part * per;
            float ss = 0.f;
            for (int i = 0; i < per; i += 8) {
                const u32x4 w = *(const u32x4*)(src + i);
#pragma unroll
                for (int k = 0; k < 4; ++k) { const float a = __uint_as_float(w[k] << 16), b = __uint_as_float(w[k] & 0xffff0000u); ss += a * a + b * b; }
            }
            ss += dpp_f<0xB1>(ss); ss += dpp_f<0x4E>(ss);
            __syncthreads();
            if (part == 0) rsl[row] = rsqrtf(ss / (float)ncol + 1e-6f);
            if (!isq && (u - nq) % 4 == 0) {
                for (int e = tid; e < 128 * 16; e += NTHREADS) {
                    const int rr = e >> 4, i = e & 15, t = t0 + rr, pos = t % SEQ;
                    const bf16_t* pr = p.pbuf + (size_t)t * NINP + PC_MKR;
                    const float c = p.tab_mla[(pos * 16 + i) * 2], sn = p.tab_mla[(pos * 16 + i) * 2 + 1], x1 = bf2f(pr[i]), x2 = bf2f(pr[16 + i]);
                    const bf16_t k1 = f2bf(x1 * c - x2 * sn), k2 = f2bf(x1 * sn + x2 * c);
#pragma unroll
                    for (int hd = 0; hd < 4; ++hd) { p.mk[((size_t)t * 4 + hd) * 96 + 64 + i] = k1; p.mk[((size_t)t * 4 + hd) * 96 + 80 + i] = k2; }
                }
            }
            __syncthreads();
        }
        if (isq) {
            const int nt = u % 3;
            bf16_t* mq = p.mq + (size_t)mt * 128 * 384 + nt * 128; const float* tab = p.tab_mla;
            gemm_tile128(p.pbuf + (size_t)mt * 128 * NINP + PC_MQ, NINP, nullptr, 128, p.wq_t + ((size_t)l * 384 + nt * 128) * 256, 256, 256, lds, TID,
                         [=](int r, int c, f32x4 v0, f32x4 v1) mutable {
                             const float sc = rsl[r] * SC; v0 = v0 * sc; v1 = v1 * sc;
                             const int col = nt * 128 + c;
                             if ((col % 96) >= 64) {
                                 const int i0 = (col % 96) - 64, pos = (t0 + r) % SEQ;
                                 const f32x4 cs0 = *(const f32x4*)(tab + (pos * 16 + i0) * 2), cs1 = *(const f32x4*)(tab + (pos * 16 + i0) * 2 + 4);
                                 const f32x4 a = v0, b = v1;
                                 v0[0] = a[0] * cs0[0] - b[0] * cs0[1]; v1[0] = a[0] * cs0[1] + b[0] * cs0[0];
                                 v0[1] = a[1] * cs0[2] - b[1] * cs0[3]; v1[1] = a[1] * cs0[3] + b[1] * cs0[2];
                                 v0[2] = a[2] * cs1[0] - b[2] * cs1[1]; v1[2] = a[2] * cs1[1] + b[2] * cs1[0];
                                 v0[3] = a[3] * cs1[2] - b[3] * cs1[3]; v1[3] = a[3] * cs1[3] + b[3] * cs1[2];
                             }
                             uint2 o0, o1; o0.x = cvtpk(v0[0], v0[1]); o0.y = cvtpk(v0[2], v0[3]); o1.x = cvtpk(v1[0], v1[1]); o1.y = cvtpk(v1[2], v1[3]);
                             *(uint2*)(mq + (size_t)r * 384 + c) = o0; *(uint2*)(mq + (size_t)r * 384 + c + 16) = o1; });
        } else {
            const int hd = (u - nq) % 4;
            bf16_t* mk = p.mk + ((size_t)mt * 128 * 4 + hd) * 96; bf16_t* mv = p.mv + ((size_t)mt * 128 * 4 + hd) * 64;
            gemm_tile128(p.pbuf + (size_t)mt * 128 * NINP + PC_MKV, NINP, nullptr, 128, p.wkv_t + ((size_t)l * 512 + hd * 128) * 128, 128, 128, lds, TID,
                         [=](int r, int c, f32x4 v0, f32x4 v1) mutable {
                             const float sc = rsl[r]; v0 = v0 * sc; v1 = v1 * sc;
                             uint2 o0, o1; o0.x = cvtpk(v0[0], v0[1]); o0.y = cvtpk(v0[2], v0[3]); o1.x = cvtpk(v1[0], v1[1]); o1.y = cvtpk(v1[2], v1[3]);
                             if (c < 64) { *(uint2*)(mk + (size_t)r * 384 + c) = o0; *(uint2*)(mk + (size_t)r * 384 + c + 16) = o1; }
                             else { *(uint2*)(mv + (size_t)r * 256 + (c - 64)) = o0; *(uint2*)(mv + (size_t)r * 256 + (c - 64) + 16) = o1; } });
        }
    }
}


__device__ __forceinline__ void ph_mla_attn(const Params& pkv, KPtr kp_in, int wbase_in, int l, char* lds) {
    PH_HEAD
    constexpr int KSTR = 104, VSTR = 68;
    bf16_t* Ks = (bf16_t*)lds;
    bf16_t* Vt = Ks + 64 * KSTR;
    const int tid = TID, lane = tid & 63, wv = tid >> 6, r = lane & 31, h = lane >> 5;
    int* wq = p.wq + l * 16;
    volatile int* wslot = (volatile int*)(lds + 24576);
    for (;;) {
        __syncthreads();
        if (tid == 0) *wslot = atomicAdd(wq, 1);
        __syncthreads();
        const int it = __builtin_amdgcn_readfirstlane(*wslot);
        if (it >= 16 * 32) break;
        const int bh = it & 15, qb = 31 - (it >> 4);
        const int b = bh >> 2, hd = bh & 3, q0 = qb * 256;
        const int qmin = q0 + 32 * wv, qmax = qmin + 31, myq = qmin + r;
        bf16x8 qf[6];
        {
            const bf16_t* qrow = p.mq + ((size_t)(b * SEQ + myq) * 4 + hd) * 96 + 8 * h;
#pragma unroll
            for (int s = 0; s < 6; ++s) qf[s] = *(const bf16x8*)(qrow + 16 * s);
        }
        f32x16 o0, o1;
#pragma unroll
        for (int i = 0; i < 16; ++i) { o0[i] = 0.f; o1[i] = 0.f; }
        float m = -1e30f, lsum = 0.f;
        const int nkt = (q0 + 256) / 64;
        const int kk0 = tid / 12, kc0 = tid % 12, kk1 = (tid + 512) / 12, kc1 = (tid + 512) % 12;
        const int vk = tid & 63, vc = tid >> 6;
        const bf16_t* kbase = p.mk + ((size_t)b * SEQ * 4 + hd) * 96;
        const bf16_t* vbase = p.mv + ((size_t)b * SEQ * 4 + hd) * 64;
        u32x4 rk0, rk1, rv;
        rk0 = *(const u32x4*)(kbase + (size_t)kk0 * 384 + kc0 * 8);
        rk1 = (tid < 256) ? *(const u32x4*)(kbase + (size_t)kk1 * 384 + kc1 * 8) : (u32x4){0u, 0u, 0u, 0u};
        rv = *(const u32x4*)(vbase + (size_t)vk * 256 + vc * 8);
        for (int kt = 0; kt < nkt; ++kt) {
            __syncthreads();
            *(u32x4*)(Ks + kk0 * KSTR + kc0 * 8) = rk0;
            if (tid < 256) *(u32x4*)(Ks + kk1 * KSTR + kc1 * 8) = rk1;
            {
                const unsigned w0 = rv[0], w1 = rv[1], w2 = rv[2], w3 = rv[3];
                bf16_t* vd = Vt + (vc * 8) * VSTR + vk;
                vd[0] = (bf16_t)(w0 & 0xffff); vd[VSTR] = (bf16_t)(w0 >> 16); vd[2 * VSTR] = (bf16_t)(w1 & 0xffff); vd[3 * VSTR] = (bf16_t)(w1 >> 16);
                vd[4 * VSTR] = (bf16_t)(w2 & 0xffff); vd[5 * VSTR] = (bf16_t)(w2 >> 16); vd[6 * VSTR] = (bf16_t)(w3 & 0xffff); vd[7 * VSTR] = (bf16_t)(w3 >> 16);
            }
            __syncthreads();
            if (kt + 1 < nkt) {
                const size_t ko = (size_t)(kt + 1) * 64;
                rk0 = *(const u32x4*)(kbase + (ko + kk0) * 384 + kc0 * 8);
                if (tid < 256) rk1 = *(const u32x4*)(kbase + (ko + kk1) * 384 + kc1 * 8);
                rv = *(const u32x4*)(vbase + (ko + vk) * 256 + vc * 8);
            }
            const int kb = kt * 64;
            if (kb <= qmax) {
                const bool need1 = (kb + 32 <= qmax);
                f32x16 s0, s1;
#pragma unroll
                for (int i = 0; i < 16; ++i) { s0[i] = 0.f; s1[i] = -1e30f; }
#pragma unroll
                for (int s = 0; s < 6; ++s) { const bf16x8 kf = *(const bf16x8*)(Ks + r * KSTR + 16 * s + 8 * h); s0 = __builtin_amdgcn_mfma_f32_32x32x16_bf16(kf, qf[s], s0, 0, 0, 0); }
                if (need1) {
#pragma unroll
                    for (int i = 0; i < 16; ++i) s1[i] = 0.f;
#pragma unroll
                    for (int s = 0; s < 6; ++s) { const bf16x8 kf = *(const bf16x8*)(Ks + (32 + r) * KSTR + 16 * s + 8 * h); s1 = __builtin_amdgcn_mfma_f32_32x32x16_bf16(kf, qf[s], s1, 0, 0, 0); }
                }
                if (kb + 63 > qmin) {
#pragma unroll
                    for (int i = 0; i < 16; ++i) {
                        const int key = kb + (i & 3) + 8 * (i >> 2) + 4 * h;
                        if (key > myq) s0[i] = -1e30f;
                        if (key + 32 > myq) s1[i] = -1e30f;
                    }
                }
                float mx = s0[0];
#pragma unroll
                for (int i = 1; i < 16; ++i) mx = fmaxf(mx, s0[i]);
#pragma unroll
                for (int i = 0; i < 16; ++i) mx = fmaxf(mx, s1[i]);
                mx = xhalf_max(mx);
                const float mn = fmaxf(m, mx), alpha = __builtin_amdgcn_exp2f(m - mn);
                m = mn;
                float ps = 0.f;
#pragma unroll
                for (int i = 0; i < 16; ++i) { s0[i] = __builtin_amdgcn_exp2f(s0[i] - mn); ps += s0[i]; }
                if (need1) {
#pragma unroll
                    for (int i = 0; i < 16; ++i) { s1[i] = __builtin_amdgcn_exp2f(s1[i] - mn); ps += s1[i]; }
                }
                lsum = lsum * alpha + ps;
                if (!__all(alpha == 1.0f)) {
#pragma unroll
                    for (int i = 0; i < 16; ++i) { o0[i] *= alpha; o1[i] *= alpha; }
                }
#pragma unroll
                for (int s = 0; s < 2; ++s) {
                    u32x4 pw; pw[0] = cvtpk(s0[8 * s], s0[8 * s + 1]); pw[1] = cvtpk(s0[8 * s + 2], s0[8 * s + 3]); pw[2] = cvtpk(s0[8 * s + 4], s0[8 * s + 5]); pw[3] = cvtpk(s0[8 * s + 6], s0[8 * s + 7]);
                    const bf16x8 pf = __builtin_bit_cast(bf16x8, pw);
                    const bf16_t* va = Vt + r * VSTR + 16 * s + 4 * h;
                    const s16x4 a0 = *(const s16x4*)(va), a1 = *(const s16x4*)(va + 8), b0 = *(const s16x4*)(va + 32 * VSTR), b1 = *(const s16x4*)(va + 32 * VSTR + 8);
                    o0 = __builtin_amdgcn_mfma_f32_32x32x16_bf16(__builtin_shufflevector(a0, a1, 0, 1, 2, 3, 4, 5, 6, 7), pf, o0, 0, 0, 0);
                    o1 = __builtin_amdgcn_mfma_f32_32x32x16_bf16(__builtin_shufflevector(b0, b1, 0, 1, 2, 3, 4, 5, 6, 7), pf, o1, 0, 0, 0);
                }
                if (need1) {
#pragma unroll
                    for (int s = 0; s < 2; ++s) {
                        u32x4 pw; pw[0] = cvtpk(s1[8 * s], s1[8 * s + 1]); pw[1] = cvtpk(s1[8 * s + 2], s1[8 * s + 3]); pw[2] = cvtpk(s1[8 * s + 4], s1[8 * s + 5]); pw[3] = cvtpk(s1[8 * s + 6], s1[8 * s + 7]);
                        const bf16x8 pf = __builtin_bit_cast(bf16x8, pw);
                        const bf16_t* va = Vt + r * VSTR + 32 + 16 * s + 4 * h;
                        const s16x4 a0 = *(const s16x4*)(va), a1 = *(const s16x4*)(va + 8), b0 = *(const s16x4*)(va + 32 * VSTR), b1 = *(const s16x4*)(va + 32 * VSTR + 8);
                        o0 = __builtin_amdgcn_mfma_f32_32x32x16_bf16(__builtin_shufflevector(a0, a1, 0, 1, 2, 3, 4, 5, 6, 7), pf, o0, 0, 0, 0);
                        o1 = __builtin_amdgcn_mfma_f32_32x32x16_bf16(__builtin_shufflevector(b0, b1, 0, 1, 2, 3, 4, 5, 6, 7), pf, o1, 0, 0, 0);
                    }
                }
            }
        }
        const float inv = 1.0f / xhalf_sum(lsum);
        float* op = p.mo + (size_t)(b * SEQ + myq) * 256 + hd * 64 + 4 * h;
#pragma unroll
        for (int g = 0; g < 4; ++g) {
            *(f32x4*)(op + 8 * g) = (f32x4){o0[4 * g] * inv, o0[4 * g + 1] * inv, o0[4 * g + 2] * inv, o0[4 * g + 3] * inv};
            *(f32x4*)(op + 32 + 8 * g) = (f32x4){o1[4 * g] * inv, o1[4 * g + 1] * inv, o1[4 * g + 2] * inv, o1[4 * g + 3] * inv};
        }
        __syncthreads();
    }
}

__device__ __forceinline__ void ph_finalize_mix(const Params& pkv, KPtr kp_in, int wbase_in, int l) {
    PH_HEAD
    const int lane = TID & 63, gw = BID * (NTHREADS / 64) + (TID >> 6), nw = gridDim.x * (NTHREADS / 64);
    const int c = lane * 4, h = lane >> 4;
    const float4 gd = *(const float4*)(p.dil_norm_g + l * 256 + c), gm = *(const float4*)(p.mla_out_norm_g + l * 256 + c);
    const float4 lg = *(const float4*)(p.rwkv_ln_g + l * 256 + c), lb = *(const float4*)(p.rwkv_ln_b + l * 256 + c), rk = *(const float4*)(p.rwkv_r_k + l * 256 + c);
    float nl0, nl1, nl2; float4 nd0, nd1, nd2, nsy, nsr, nsk, nsv, nsg, nmo;
    auto load = [&](int t) {
        nl0 = p.dlse[((size_t)0 * NT + t) * 4 + h]; nl1 = p.dlse[((size_t)1 * NT + t) * 4 + h]; nl2 = p.dlse[((size_t)2 * NT + t) * 4 + h];
        nd0 = *(const float4*)(p.dob + ((size_t)0 * NT + t) * 256 + c); nd1 = *(const float4*)(p.dob + ((size_t)1 * NT + t) * 256 + c); nd2 = *(const float4*)(p.dob + ((size_t)2 * NT + t) * 256 + c);
        const size_t o4 = (size_t)t * 256 + c;
        nsy = *(const float4*)(p.sy + o4); nsr = *(const float4*)(p.sr + o4); nsk = *(const float4*)(p.sk + o4); nsv = *(const float4*)(p.sv + o4); nsg = *(const float4*)(p.sg + o4);
        nmo = *(const float4*)(p.mo + o4);
    };
    int t = gw;
    if (t < NT) load(t);
    for (; t < NT; t += nw) {
        const float l0 = nl0, l1 = nl1, l2 = nl2; const float4 v0 = nd0, v1 = nd1, v2 = nd2, y = nsy, r = nsr, k = nsk, vv = nsv, g = nsg, mo = nmo;
        if (t + nw < NT) load(t + nw);
        bf16_t* outp = p.mixcat + (size_t)t * 1024;
        {
            const float lm = fmaxf(l0, fmaxf(l1, l2));
            float w0 = __builtin_amdgcn_exp2f(l0 - lm), w1 = __builtin_amdgcn_exp2f(l1 - lm), w2 = __builtin_amdgcn_exp2f(l2 - lm);
            const float wi = __builtin_amdgcn_rcpf(w0 + w1 + w2); w0 *= wi; w1 *= wi; w2 *= wi;
            float4 v; v.x = w0 * v0.x + w1 * v1.x + w2 * v2.x; v.y = w0 * v0.y + w1 * v1.y + w2 * v2.y; v.z = w0 * v0.z + w1 * v1.z + w2 * v2.z; v.w = w0 * v0.w + w1 * v1.w + w2 * v2.w;
            const float ss = wave_sum(v.x * v.x + v.y * v.y + v.z * v.z + v.w * v.w);
            const float rs = rsqrtf(ss * (1.0f / 256.0f) + 1e-6f);
            uint2 o; o.x = cvtpk(v.x * rs * gd.x, v.y * rs * gd.y); o.y = cvtpk(v.z * rs * gd.z, v.w * rs * gd.w);
            *(uint2*)(outp + 256 + c) = o;
        }
        {
            const float mean = grp16_sum(y.x + y.y + y.z + y.w) * (1.0f / 64.0f);
            const float dx = y.x - mean, dy = y.y - mean, dz = y.z - mean, dw = y.w - mean;
            const float var = grp16_sum(dx * dx + dy * dy + dz * dz + dw * dw) * (1.0f / 64.0f);
            const float rs = rsqrtf(var + 64e-5f);
            const float bonus = grp16_sum(r.x * k.x * rk.x + r.y * k.y * rk.y + r.z * k.z * rk.z + r.w * k.w * rk.w);
            uint2 o;
            o.x = cvtpk((dx * rs * lg.x + lb.x + bonus * vv.x) * g.x, (dy * rs * lg.y + lb.y + bonus * vv.y) * g.y);
            o.y = cvtpk((dz * rs * lg.z + lb.z + bonus * vv.z) * g.z, (dw * rs * lg.w + lb.w + bonus * vv.w) * g.w);
            *(uint2*)(outp + 512 + c) = o;
        }
        {
            const float ss = wave_sum(mo.x * mo.x + mo.y * mo.y + mo.z * mo.z + mo.w * mo.w);
            const float rs = rsqrtf(ss * (1.0f / 256.0f) + 1e-6f);
            uint2 o; o.x = cvtpk(mo.x * rs * gm.x, mo.y * rs * gm.y); o.y = cvtpk(mo.z * rs * gm.z, mo.w * rs * gm.w);
            *(uint2*)(outp + 768 + c) = o;
        }
    }
}

__device__ __forceinline__ void ph_outproj(const Params& pkv, KPtr kp_in, int wbase_in, int l, char* lds) {
    PH_HEAD
    const float* xin = (l == 0) ? p.x : p.xf; float* y1 = p.y1;
    const bf16_t* Bt = p.wout_t + (size_t)l * 1024 * 1024;
    const int nunits = (NT / 256) * 4;
    bool pre = false;
    XU_LOOP(NT / 256, 4) {
        const int u = XU_UNIT();
        const int mt = u >> 2, nt = u & 3, un = XU_NEXT_UNIT();
        G8Next nx; nx.valid = 0; nx.rowidx = nullptr; nx.nvalid = 256; nx.A = p.mixcat + (size_t)(un >> 2) * 256 * 1024; nx.Bt = Bt + (size_t)(un & 3) * 256 * 1024; nx.perm = 1;
        const size_t o0 = (size_t)mt * 256 * 1024 + nt * 256;
        G8Out so; so.out = nullptr; so.ld = 0; so.w = 0;
        gemm_tile256(p.mixcat + (size_t)mt * 256 * 1024, 1024, nullptr, 256, Bt + (size_t)nt * 256 * 1024, 1024, 1024, lds, wbase_in, pre, nx, true, so,
                     [=](int r, int c, f32x4 v0, f32x4 v1) mutable { const size_t o = o0 + (size_t)r * 1024 + c; const f32x4 xa = *(const f32x4*)(xin + o), xb2 = *(const f32x4*)(xin + o + 4); *(f32x4*)(y1 + o) = xa * ALPHA + v0; *(f32x4*)(y1 + o + 4) = xb2 * ALPHA + v1; return (u32x4){0u, 0u, 0u, 0u}; });
        pre = nx.valid != 0;
    }
}

__device__ __forceinline__ void ph_ln1_router(const Params& pkv, KPtr kp_in, int wbase_in, int l, char* lds) {
    PH_HEAD
    float* Wt = (float*)lds;
    int* hist = (int*)(lds + 131584);
    int* base = hist + 32;
    int* le = base + 32;
    float* lgt = (float*)(le + 512);
    int* lrank = (int*)(lgt + 512);
    const int tid = TID, lane = tid & 63, wv = tid >> 6;
    const float* g1 = p.ln1_g + l * 1024; const float* b1 = p.ln1_b + l * 1024;
    const float* rw = p.router_w + (size_t)l * 1024 * 32; const float* rb = p.router_b + l * 32;
    __syncthreads();
    for (int i = tid; i < 1024 * 32; i += NTHREADS) Wt[(i & 31) * 1028 + (i >> 5)] = rw[i];
    float4 gg[4], bb[4];
#pragma unroll
    for (int m = 0; m < 4; ++m) { gg[m] = *(const float4*)(g1 + m * 256 + lane * 4); bb[m] = *(const float4*)(b1 + m * 256 + lane * 4); }
    for (int tb = BID * 128; tb < NT; tb += gridDim.x * 128) {
        __syncthreads();
        if (tid < 32) hist[tid] = 0;
        __syncthreads();
        float4 yn[4];
#pragma unroll
        for (int m = 0; m < 4; ++m) yn[m] = *(const float4*)(p.y1 + (size_t)(tb + wv) * 1024 + m * 256 + lane * 4);
        for (int tt = wv; tt < 128; tt += 8) {
            const int t = tb + tt;
            float4 y[4]; float s = 0.f;
#pragma unroll
            for (int m = 0; m < 4; ++m) { y[m] = yn[m]; s += (y[m].x + y[m].y) + (y[m].z + y[m].w); }
            {
                const int t2 = tb + ((tt + 8 < 128) ? tt + 8 : tt);
#pragma unroll
                for (int m = 0; m < 4; ++m) yn[m] = *(const float4*)(p.y1 + (size_t)t2 * 1024 + m * 256 + lane * 4);
            }
            const float mean = wave_sum(s) * (1.0f / 1024.0f);
            float q = 0.f;
#pragma unroll
            for (int m = 0; m < 4; ++m) { y[m].x -= mean; y[m].y -= mean; y[m].z -= mean; y[m].w -= mean; q += (y[m].x * y[m].x + y[m].y * y[m].y) + (y[m].z * y[m].z + y[m].w * y[m].w); }
            const float rs = rsqrtf(wave_sum(q) * (1.0f / 1024.0f) + 1e-5f);
#pragma unroll
            for (int m = 0; m < 4; ++m) {
                const int c = m * 256 + lane * 4;
                y[m].x = y[m].x * rs * gg[m].x + bb[m].x; y[m].y = y[m].y * rs * gg[m].y + bb[m].y; y[m].z = y[m].z * rs * gg[m].z + bb[m].z; y[m].w = y[m].w * rs * gg[m].w + bb[m].w;
                *(float4*)(p.y1 + (size_t)t * 1024 + c) = y[m];
                uint2 ob; ob.x = cvtpk(y[m].x, y[m].y); ob.y = cvtpk(y[m].z, y[m].w);
                *(uint2*)(p.x1b + (size_t)t * 1024 + c) = ob;
            }
            float lg[32];
#pragma unroll
            for (int e = 0; e < 32; ++e) {
                float a = 0.f;
#pragma unroll
                for (int m = 0; m < 4; ++m) { const f32x4 w = *(const f32x4*)(Wt + e * 1028 + m * 256 + lane * 4); a += (y[m].x * w[0] + y[m].y * w[1]) + (y[m].z * w[2] + y[m].w * w[3]); }
                lg[e] = a;
            }
            float s16[16];
#pragma unroll
            for (int e = 0; e < 16; ++e) { auto rr = __builtin_amdgcn_permlane32_swap(__float_as_uint(lg[e]), __float_as_uint(lg[e + 16]), false, false); s16[e] = __uint_as_float(rr[0]) + __uint_as_float(rr[1]); }
            const bool b4 = (lane & 16) != 0, b3 = (lane & 8) != 0, b2 = (lane & 4) != 0, b1 = (lane & 2) != 0;
            float u8[8];
#pragma unroll
            for (int j = 0; j < 8; ++j) { const float snd = b4 ? s16[j] : s16[j + 8], kp = b4 ? s16[j + 8] : s16[j]; u8[j] = kp + __int_as_float(__builtin_amdgcn_ds_swizzle(__float_as_int(snd), 0x401F)); }
            float w4[4];
#pragma unroll
            for (int j = 0; j < 4; ++j) { const float snd = b3 ? u8[j] : u8[j + 4], kp = b3 ? u8[j + 4] : u8[j]; w4[j] = kp + dpp_f<0x128>(snd); }
            float z2[2];
#pragma unroll
            for (int j = 0; j < 2; ++j) {
                const float snd = b2 ? w4[j] : w4[j + 2], kp = b2 ? w4[j + 2] : w4[j];
                z2[j] = kp + dpp_f<0x141>(snd);
            }
            float lgt1;
            { const float snd = b1 ? z2[0] : z2[1], kp = b1 ? z2[1] : z2[0]; lgt1 = kp + dpp_f<0x4E>(snd); }
            lgt1 += dpp_f<0xB1>(lgt1);
            const int myexp = lane >> 1;
            float myv = lgt1 + rb[myexp];
            int idx[4]; float val[4];
#pragma unroll
            for (int k = 0; k < 4; ++k) {
                float mx = myv;
                mx = fmaxf(mx, dpp_f<0x128>(mx)); mx = fmaxf(mx, dpp_f<0x124>(mx)); mx = fmaxf(mx, dpp_f<0x122>(mx)); mx = fmaxf(mx, dpp_f<0x121>(mx));
                mx = fmaxf(mx, __int_as_float(__builtin_amdgcn_ds_swizzle(__float_as_int(mx), 0x401F)));
                mx = xhalf_max(mx);
                float ci = (myv == mx) ? (float)(31 - myexp) : -1.0f;
                ci = fmaxf(ci, dpp_f<0x128>(ci)); ci = fmaxf(ci, dpp_f<0x124>(ci)); ci = fmaxf(ci, dpp_f<0x122>(ci)); ci = fmaxf(ci, dpp_f<0x121>(ci));
                ci = fmaxf(ci, __int_as_float(__builtin_amdgcn_ds_swizzle(__float_as_int(ci), 0x401F)));
                ci = xhalf_max(ci);
                const int bi = 31 - (int)ci;
                idx[k] = bi; val[k] = mx;
                if (myexp == bi) myv = -3.0e38f;
            }
            const float e1 = __expf(val[1] - val[0]), e2 = __expf(val[2] - val[0]), e3 = __expf(val[3] - val[0]);
            const float inv = 1.0f / (1.0f + e1 + e2 + e3);
            const float gt[4] = {inv, e1 * inv, e2 * inv, e3 * inv};
            if (lane < 4) {
                int ee = idx[0]; float gv = gt[0];
                if (lane == 1) { ee = idx[1]; gv = gt[1]; } else if (lane == 2) { ee = idx[2]; gv = gt[2]; } else if (lane == 3) { ee = idx[3]; gv = gt[3]; }
                le[tt * 4 + lane] = ee; lgt[tt * 4 + lane] = gv;
                lrank[tt * 4 + lane] = atomicAdd(&hist[ee], 1);
            }
        }
        __syncthreads();
        if (tid < 32) base[tid] = atomicAdd(&p.cnt[l * NE + tid], hist[tid]);
        __syncthreads();
        {
            const int tt = tid >> 2, t = tb + tt, e = le[tid], pos = base[e] + lrank[tid];
            p.toke[(size_t)t * 4 + (tid & 3)] = e; p.tokpos[(size_t)t * 4 + (tid & 3)] = pos;
            p.rowtok[(size_t)e * NT + pos] = t; p.rowgate[(size_t)e * NT + pos] = lgt[tid];
        }
    }
}

__device__ __forceinline__ void moe_tile_prefix(KRef p, int l, int* tb  , const int TID) {
    __syncthreads();
    if (TID == 0) { int a = 0; for (int e = 0; e < NE; ++e) { tb[e] = a; a += (p.cnt[l * NE + e] + MOE_TM - 1) / MOE_TM; } tb[NE] = a; }
    __syncthreads();
}
struct MoeUnit { int e, mt, mtg, nt, nvalid; };
__device__ __forceinline__ MoeUnit moe_decode(const int* tb, const int* cnt, int u, int ntshift) {
    MoeUnit m; m.mtg = u >> ntshift; m.nt = u & ((1 << ntshift) - 1);
    int e = 0; while (tb[e + 1] <= m.mtg) ++e;
    m.e = __builtin_amdgcn_readfirstlane(e);
    m.mt = __builtin_amdgcn_readfirstlane(m.mtg - tb[m.e]);
    const int c = __builtin_amdgcn_readfirstlane(cnt[m.e]);
    m.nvalid = min(MOE_TM, c - m.mt * MOE_TM);
    return m;
}
__device__ __forceinline__ void ph_moe_gu(const Params& pkv, KPtr kp_in, int wbase_in, int l, char* lds) {
    PH_HEAD
    int* tb = (int*)(lds + 132096);
    moe_tile_prefix(p, l, tb, TID);
    const int ntile = __builtin_amdgcn_readfirstlane(tb[NE]), nunits = ntile * 8;
    const int* cnt = p.cnt + l * NE;
    bool pre = false;
    XU_LOOP(ntile, 8) {
        const int u = XU_UNIT();
        const MoeUnit m = moe_decode(tb, cnt, u, 3);
        const int un = XU_NEXT_UNIT();
        G8Next nx; nx.valid = 0; nx.A = p.x1b; nx.rowidx = nullptr; nx.Bt = nullptr; nx.nvalid = 0;
        if (nx.valid) { const MoeUnit m2 = moe_decode(tb, cnt, un, 3); nx.rowidx = p.rowtok + (size_t)m2.e * NT + m2.mt * MOE_TM; nx.nvalid = m2.nvalid; nx.Bt = p.wgu_t + (((size_t)l * NE + m2.e) * 2048 + m2.nt * 256) * 1024; } nx.perm = 1;
        const float* bias = p.b_gu + ((size_t)l * NE + m.e) * 2048 + m.nt * 256;
        bf16_t* out = p.act + (size_t)m.mtg * MOE_TM * 1024 + m.nt * 128;
        gemm_tile256(p.x1b, 1024, p.rowtok + (size_t)m.e * NT + m.mt * MOE_TM, m.nvalid, p.wgu_t + (((size_t)l * NE + m.e) * 2048 + m.nt * 256) * 1024, 1024, 1024, lds, wbase_in, pre, nx, true, G8Out{out, 1024, 128},
                     [=](int r, int c, f32x4 va, f32x4 vb) mutable {
                         uint2 o;
#pragma unroll
                         for (int hh = 0; hh < 2; ++hh) {
                             f32x4 v = hh ? vb : va; const int cc = c + 4 * hh;
                             const f32x4 bv = *(const f32x4*)(bias + cc); v = v + bv;
                             const float g0 = fminf(v[0], 7.0f), l0 = fminf(fmaxf(v[1], -7.0f), 7.0f), g1 = fminf(v[2], 7.0f), l1 = fminf(fmaxf(v[3], -7.0f), 7.0f);
                             const float a0 = g0 * sigmoidf_(1.702f * g0) * (l0 + 1.0f), a1 = g1 * sigmoidf_(1.702f * g1) * (l1 + 1.0f);
                             if (hh) o.y = cvtpk(a0, a1); else o.x = cvtpk(a0, a1);
                         }
                         return (u32x4){o.x, o.y, 0u, 0u}; });
        pre = nx.valid != 0;
    }
}
__device__ __forceinline__ void ph_moe_dn(const Params& pkv, KPtr kp_in, int wbase_in, int l, char* lds) {
    PH_HEAD
    int* tb = (int*)(lds + 132096);
    moe_tile_prefix(p, l, tb, TID);
    const int ntile = __builtin_amdgcn_readfirstlane(tb[NE]), nunits = ntile * 4;
    const int* cnt = p.cnt + l * NE;
    bool pre = false;
    XU_LOOP(ntile, 4) {
        const int u = XU_UNIT();
        const MoeUnit m = moe_decode(tb, cnt, u, 2);
        const int un = XU_NEXT_UNIT();
        G8Next nx; nx.valid = 0; nx.A = nullptr; nx.rowidx = nullptr; nx.Bt = nullptr; nx.nvalid = 256;
        if (nx.valid) { const MoeUnit m2 = moe_decode(tb, cnt, un, 2); nx.A = p.act + (size_t)m2.mtg * MOE_TM * 1024; nx.Bt = p.wdn_t + (((size_t)l * NE + m2.e) * 1024 + m2.nt * 256) * 1024; } nx.perm = 1;
        const float* bias = p.b_dn + ((size_t)l * NE + m.e) * 1024 + m.nt * 256;
        const float* gate = p.rowgate + (size_t)m.e * NT + m.mt * MOE_TM;
        bf16_t* out = p.yb + (size_t)m.mtg * MOE_TM * 1024 + m.nt * 256;
        const int nvalid = m.nvalid;
        gemm_tile256(p.act + (size_t)m.mtg * MOE_TM * 1024, 1024, nullptr, 256, p.wdn_t + (((size_t)l * NE + m.e) * 1024 + m.nt * 256) * 1024, 1024, 1024, lds, wbase_in, pre, nx, true, G8Out{out, 1024, 256},
                     [=](int r, int c, f32x4 v0, f32x4 v1) mutable {
                         const float g = (r < nvalid) ? gate[r] : 0.f;
                         const f32x4 b0 = *(const f32x4*)(bias + c), b1 = *(const f32x4*)(bias + c + 4); v0 = (v0 + b0) * g; v1 = (v1 + b1) * g;
                         u32x4 o; o[0] = cvtpk(v0[0], v0[1]); o[1] = cvtpk(v0[2], v0[3]); o[2] = cvtpk(v1[0], v1[1]); o[3] = cvtpk(v1[2], v1[3]); return o; });
        pre = nx.valid != 0;
    }
}
__device__ __forceinline__ void ph_combine_ln2(const Params& pkv, KPtr kp_in, int wbase_in, int l, char* lds) {
    PH_HEAD
    int* tb = (int*)(lds + 132096);
    moe_tile_prefix(p, l, tb, TID);
    const int lane = TID & 63, gw = BID * (NTHREADS / 64) + (TID >> 6), nw = gridDim.x * (NTHREADS / 64);
    float4 gg[4], bb[4];
#pragma unroll
    for (int m = 0; m < 4; ++m) { gg[m] = *(const float4*)(p.ln2_g + l * 1024 + m * 256 + lane * 4); bb[m] = *(const float4*)(p.ln2_b + l * 1024 + m * 256 + lane * 4); }
    float* dstf = (l == DEPTH - 1) ? p.out : p.xf;
    float4 ny[4]; uint2 nb[4][4]; int4 ne, npz;
    auto load_idx = [&](int t) { ne = *(const int4*)(p.toke + (size_t)t * 4); npz = *(const int4*)(p.tokpos + (size_t)t * 4); };
    auto load_rows = [&](int t) {
        const size_t r0 = (size_t)tb[ne.x] * MOE_TM + npz.x, r1 = (size_t)tb[ne.y] * MOE_TM + npz.y, r2 = (size_t)tb[ne.z] * MOE_TM + npz.z, r3 = (size_t)tb[ne.w] * MOE_TM + npz.w;
#pragma unroll
        for (int m = 0; m < 4; ++m) {
            const int c = m * 256 + lane * 4;
            ny[m] = *(const float4*)(p.y1 + (size_t)t * 1024 + c);
            nb[m][0] = *(const uint2*)(p.yb + r0 * 1024 + c); nb[m][1] = *(const uint2*)(p.yb + r1 * 1024 + c); nb[m][2] = *(const uint2*)(p.yb + r2 * 1024 + c); nb[m][3] = *(const uint2*)(p.yb + r3 * 1024 + c);
        }
    };
    int t = gw;
    if (t < NT) { load_idx(t); load_rows(t); if (t + nw < NT) load_idx(t + nw); }
    for (; t < NT; t += nw) {
        float4 y[4]; float s = 0.f;
#pragma unroll
        for (int m = 0; m < 4; ++m) {
            float4 v = ny[m];
            v.x *= ALPHA; v.y *= ALPHA; v.z *= ALPHA; v.w *= ALPHA;
#pragma unroll
            for (int k = 0; k < 4; ++k) { const uint2 w = nb[m][k]; v.x += __uint_as_float(w.x << 16); v.y += __uint_as_float(w.x & 0xffff0000u); v.z += __uint_as_float(w.y << 16); v.w += __uint_as_float(w.y & 0xffff0000u); }
            y[m] = v; s += (v.x + v.y) + (v.z + v.w);
        }
        if (t + nw < NT) { load_rows(t + nw); if (t + 2 * nw < NT) load_idx(t + 2 * nw); }
        const float mean = wave_sum(s) * (1.0f / 1024.0f);
        float q = 0.f;
#pragma unroll
        for (int m = 0; m < 4; ++m) { y[m].x -= mean; y[m].y -= mean; y[m].z -= mean; y[m].w -= mean; q += (y[m].x * y[m].x + y[m].y * y[m].y) + (y[m].z * y[m].z + y[m].w * y[m].w); }
        const float rs = rsqrtf(wave_sum(q) * (1.0f / 1024.0f) + 1e-5f);
#pragma unroll
        for (int m = 0; m < 4; ++m) {
            const int c = m * 256 + lane * 4;
            float4 xv; xv.x = y[m].x * rs * gg[m].x + bb[m].x; xv.y = y[m].y * rs * gg[m].y + bb[m].y; xv.z = y[m].z * rs * gg[m].z + bb[m].z; xv.w = y[m].w * rs * gg[m].w + bb[m].w;
            *(float4*)(dstf + (size_t)t * 1024 + c) = xv;
            uint2 ob; ob.x = cvtpk(xv.x, xv.y); ob.y = cvtpk(xv.z, xv.w);
            *(uint2*)(p.xb + (size_t)t * 1024 + c) = ob;
        }
    }
}

constexpr int PH_PRO = 0, PH_INPROJ = 1, PH_PREP = 2, PH_RETKV = 3, PH_RETSCAN = 4, PH_RETOUT = 5, PH_DIL = 6, PH_RWKVPREP = 7, PH_RWKVSCAN = 8, PH_MLAUP = 9,
              PH_MLAATTN = 10, PH_FINAL = 11, PH_OUTPROJ = 12, PH_LN1 = 13, PH_GU = 14, PH_DN = 15, PH_LN2 = 16;

__device__ __forceinline__ void grid_sync(KPtr kp_in, int wbase_in, char* lds) {
    KPtr kp_ = kp_launder(kp_in);
    XcdBarrier b; b.bar = kp_->bar; b.x = xb_xcc_id(); b.st = (volatile LAS unsigned*)(lds + LDS_BYTES - 16);
    xcd_barrier(b, opq_tid(wbase_in));
}
#ifndef PROBE_ID
#define PROBE_ID -1
#endif
#define RUN(ID, call) do { int reps_ = 1; if (PROBE_ID == (ID)) { reps_ = 2; asm volatile("" : "+s"(reps_)); } for (int r_ = 0; r_ < reps_; ++r_) { call; } } while (0)
__global__ void __launch_bounds__(NTHREADS, 2) mega_fused(Params pk) {
    extern __shared__ __attribute__((aligned(16))) char lds[];
    KPtr kp = (KPtr)__builtin_amdgcn_kernarg_segment_ptr();
    const int wbase = __builtin_amdgcn_readfirstlane(threadIdx.x) & ~63;
    volatile LAS unsigned* xbw = (volatile LAS unsigned*)(lds + LDS_BYTES - 16);
    if (threadIdx.x == 0) { xbw[0] = 0u; xbw[1] = 0u; xbw[2] = 0u; xbw[3] = 0u; }
    __syncthreads();
    (void)xcd_barrier_post(pk.bar, xbw);
    RUN(0, ph_prologue(pk, kp, wbase, lds));
    grid_sync(kp, wbase, lds);
    for (int l = 0; l < DEPTH; ++l) {
        RUN(1, ph_inproj(pk, kp, wbase, l, lds));
        grid_sync(kp, wbase, lds);
        RUN(3, ph_ret_kv(pk, kp, wbase, l, lds)); RUN(4, ph_rwkv_prep(pk, kp, wbase, l, lds)); RUN(5, ph_mla_up(pk, kp, wbase, l, lds));
        grid_sync(kp, wbase, lds);
        RUN(8, ph_ret_scan(pk, kp, wbase, l)); RUN(17, ph_rwkv_chunkpre(pk, kp, wbase, l, lds));
        grid_sync(kp, wbase, lds);
        RUN(10, ph_rwkv_scan(pk, kp, wbase, l, lds)); RUN(9, ph_mla_attn(pk, kp, wbase, l, lds)); ph_dil_attn(pk, kp, wbase, l, lds); ph_ret_out(pk, kp, wbase, l, lds);
        grid_sync(kp, wbase, lds);
        RUN(12, ph_finalize_mix(pk, kp, wbase, l));
        grid_sync(kp, wbase, lds);
        RUN(13, ph_outproj(pk, kp, wbase, l, lds));
        grid_sync(kp, wbase, lds);
        ph_ln1_router(pk, kp, wbase, l, lds);
        grid_sync(kp, wbase, lds);
        RUN(14, ph_moe_gu(pk, kp, wbase, l, lds));
        grid_sync(kp, wbase, lds);
        RUN(15, ph_moe_dn(pk, kp, wbase, l, lds));
        grid_sync(kp, wbase, lds);
        RUN(16, ph_combine_ln2(pk, kp, wbase, l, lds));
        grid_sync(kp, wbase, lds);
    }
}
struct Carver { char* base; size_t off; template <class T> T* take(size_t n) { T* r = (T*)(base + off); off += ((n * sizeof(T) + 255) / 256) * 256; return r; } };

extern "C" void kernel_launch(void* const* d_in, const int* in_sizes, int n_in, void* d_out, int out_size, void* d_ws, size_t ws_size, hipStream_t stream) {
    Params p; memset(&p, 0, sizeof(p));
    const float** ip = (const float**)&p;
    for (int i = 0; i < 35; ++i) ip[i] = (const float*)d_in[i];
    p.out = (float*)d_out;
    Carver c{(char*)d_ws, 0};
    p.bar = c.take<unsigned>(4096); p.cnt = c.take<int>(DEPTH * NE); p.wq = c.take<int>(DEPTH * 16);
    p.tab_ret = c.take<float>((size_t)SEQ * 32); p.tab_dil = c.take<float>((size_t)SEQ * 16); p.tab_mla = c.take<float>((size_t)SEQ * 32);
    p.win_t = c.take<bf16_t>((size_t)DEPTH * NINP * 1024); p.wout_t = c.take<bf16_t>((size_t)DEPTH * 1024 * 1024);
    p.wgu_t = c.take<bf16_t>((size_t)DEPTH * NE * 2048 * 1024); p.wdn_t = c.take<bf16_t>((size_t)DEPTH * NE * 1024 * 1024);
    p.wq_t = c.take<bf16_t>((size_t)DEPTH * 384 * 256); p.wkv_t = c.take<bf16_t>((size_t)DEPTH * 512 * 128);
    p.wupt = c.take<bf16_t>((size_t)DEPTH * 256 * 64); p.aupt = c.take<bf16_t>((size_t)DEPTH * 256 * 64); p.gupt = c.take<bf16_t>((size_t)DEPTH * 256 * 128); p.vupt = c.take<bf16_t>((size_t)DEPTH * 256 * 32);
    p.xf = c.take<float>((size_t)NT * DM); p.xb = c.take<bf16_t>((size_t)NT * DM); p.pbuf = c.take<bf16_t>((size_t)NT * NINP);
    p.mixcat = c.take<bf16_t>((size_t)NT * DM); p.y1 = c.take<float>((size_t)NT * DM); p.x1b = c.take<bf16_t>((size_t)NT * DM);
    p.rq = c.take<float>((size_t)NT * 128); p.rk = c.take<float>((size_t)NT * 128);
    p.rkv = c.take<float>((size_t)NBATCH * NCH * 4 * 32 * 64); p.rstate = c.take<float>((size_t)NBATCH * NCH * 4 * 32 * 64);
    p.dq = c.take<float>((size_t)NT * 256); p.dk = c.take<float>((size_t)NT * 256); p.dob = c.take<float>((size_t)3 * NT * 256); p.dlse = c.take<float>((size_t)3 * NT * 4);
    p.sr = c.take<float>((size_t)NT * 256); p.sw = c.take<float>((size_t)NT * 256); p.sk = c.take<float>((size_t)NT * 256); p.sv = c.take<float>((size_t)NT * 256);
    p.sa = c.take<float>((size_t)NT * 256); p.sb = c.take<float>((size_t)NT * 256); p.sg = c.take<float>((size_t)NT * 256); p.sy = c.take<float>((size_t)NT * 256);
    p.vfirst = c.take<float>((size_t)NT * 256);
    p.c_p = c.take<float>((size_t)16 * (SEQ / 16) * 4096); p.c_q = c.take<float>((size_t)16 * (SEQ / 16) * 4096); p.c_rh = c.take<float>((size_t)16 * (SEQ / 16) * 1024); p.c_y1 = c.take<float>((size_t)16 * (SEQ / 16) * 1024);
    p.rsq = c.take<float>(NT); p.rskv = c.take<float>(NT); p.kpe = c.take<float>((size_t)NT * 32);
    p.qu = c.take<float>((size_t)NT * 384); p.kvu = c.take<float>((size_t)NT * 512); p.mo = c.take<float>((size_t)NT * 256);
    p.mq = c.take<bf16_t>((size_t)NT * 384); p.mk = c.take<bf16_t>((size_t)NT * 384); p.mv = c.take<bf16_t>((size_t)NT * 256);
    p.rowtok = c.take<int>((size_t)NE * NT); p.toke = c.take<int>((size_t)NT * 4); p.tokpos = c.take<int>((size_t)NT * 4); p.rowgate = c.take<float>((size_t)NE * NT);
    p.act = c.take<bf16_t>((size_t)MOE_MAXROWS * 1024); p.yb = c.take<bf16_t>((size_t)MOE_MAXROWS * 1024);
    if (c.off > ws_size) { fprintf(stderr, "workspace too small: need %zu have %zu\n", c.off, ws_size); return; }

    static int grid = 0;
    if (!grid) {
        (void)hipFuncSetAttribute((const void*)mega_fused, hipFuncAttributeMaxDynamicSharedMemorySize, LDS_BYTES);
        int dev = 0, cus = 0, per_cu = 0;
        (void)hipGetDevice(&dev);
        (void)hipDeviceGetAttribute(&cus, hipDeviceAttributeMultiprocessorCount, dev);
        (void)hipOccupancyMaxActiveBlocksPerMultiprocessor(&per_cu, mega_fused, NTHREADS, LDS_BYTES);
        if (cus <= 0) cus = 256;
        grid = cus * (per_cu < 1 ? 1 : 1);
    }
    (void)hipMemsetAsync(p.bar, 0, XCD_BAR_WORDS * sizeof(unsigned), stream);
    hipLaunchKernelGGL(mega_fused, dim3(grid), dim3(NTHREADS), LDS_BYTES, stream, p);
}
```

```cpp
#include <hip/hip_runtime.h>
#include <stdint.h>
#include <string.h>
#include <stdio.h>

typedef unsigned short bf16_t;
typedef short bf16x8 __attribute__((ext_vector_type(8)));
typedef float f32x4 __attribute__((ext_vector_type(4)));
typedef unsigned u32x4 __attribute__((ext_vector_type(4)));
typedef float f32x16 __attribute__((ext_vector_type(16)));
typedef short s16x4 __attribute__((ext_vector_type(4)));
typedef float f32x2_t __attribute__((ext_vector_type(2)));
typedef __bf16 bf16x2_t __attribute__((ext_vector_type(2)));

constexpr int NT = 32768, SEQ = 8192, NBATCH = 4, DM = 1024, NIN = 2976, NINP = 3072, DEPTH = 4, NE = 32, TOPK = 4;
constexpr int BLK = 128, NCH = SEQ / BLK;
constexpr float ALPHA = 1.6817928305074292f;
constexpr int PC_RQ = 0, PC_RK = 128, PC_RV = 256, PC_RG = 512, PC_DQ = 768, PC_DK = 1024, PC_DV = 1280;
constexpr int PC_C = 1536, PC_CR = 1536, PC_CK = 1792, PC_CV = 2048, PC_CWD = 2304, PC_CAD = 2368, PC_CGD = 2432;
constexpr int PC_MQ = 2560, PC_MKV = 2816, PC_MKR = 2944, PC_VRES = 2976;
constexpr int MOE_TM = 256;
constexpr int MOE_MAXROWS = NT * TOPK + NE * MOE_TM;
constexpr int NTHREADS = 512;
constexpr int LDS_BYTES = 147456;

__device__ __forceinline__ bf16_t f2bf(float f) { unsigned u = __float_as_uint(f); u += 0x7fffu + ((u >> 16) & 1u); return (bf16_t)(u >> 16); }
__device__ __forceinline__ unsigned cvtpk(float lo, float hi) { f32x2_t v = {lo, hi}; bf16x2_t b = __builtin_convertvector(v, bf16x2_t); return __builtin_bit_cast(unsigned, b); }
__device__ __forceinline__ float xhalf_max(float v) { auto rr = __builtin_amdgcn_permlane32_swap(__float_as_uint(v), __float_as_uint(v), false, false); return fmaxf(__uint_as_float(rr[0]), __uint_as_float(rr[1])); }
__device__ __forceinline__ float xhalf_sum(float v) { auto rr = __builtin_amdgcn_permlane32_swap(__float_as_uint(v), __float_as_uint(v), false, false); return __uint_as_float(rr[0]) + __uint_as_float(rr[1]); }
__device__ __forceinline__ float bf2f(bf16_t h) { return __uint_as_float(((unsigned)h) << 16); }
template <int CTRL> __device__ __forceinline__ float dpp_f(float v) { return __int_as_float(__builtin_amdgcn_update_dpp(0, __float_as_int(v), CTRL, 0xF, 0xF, true)); }
__device__ __forceinline__ float grp16_sum(float v) {
    v += dpp_f<0x128>(v); v += dpp_f<0x124>(v); v += dpp_f<0x122>(v); v += dpp_f<0x121>(v); return v; }
__device__ __forceinline__ float wave_sum(float v) {
    v = grp16_sum(v);
    const int i = __float_as_int(v);
    return (__int_as_float(__builtin_amdgcn_readlane(i, 0)) + __int_as_float(__builtin_amdgcn_readlane(i, 16))) +
           (__int_as_float(__builtin_amdgcn_readlane(i, 32)) + __int_as_float(__builtin_amdgcn_readlane(i, 48))); }
__device__ __forceinline__ float sigmoidf_(float x) { return __builtin_amdgcn_rcpf(1.0f + __builtin_amdgcn_exp2f(x * -1.4426950408889634f)); }

#define XB_TMO      128
#define XB_XCNT(j)  (256  + 64 * (j))
#define XB_XSUB(j)  (1280 + 64 * (j))
#define XB_XGEN(j)  (2304 + 64 * (j))
#define XB_TOP      3328
#define XB_TOPGEN   3392
#define XCD_BAR_WORDS 3456
#define XB_SPIN_CAP (1u << 22)
#define LAS __attribute__((address_space(3)))
__device__ __forceinline__ unsigned xb_ld(unsigned* p)              { return __hip_atomic_load(p, __ATOMIC_RELAXED, __HIP_MEMORY_SCOPE_AGENT); }
__device__ __forceinline__ unsigned xb_add(unsigned* p, unsigned v) { return __hip_atomic_fetch_add(p, v, __ATOMIC_RELAXED, __HIP_MEMORY_SCOPE_AGENT); }
__device__ __forceinline__ unsigned xb_xcc_id() { return (unsigned)__builtin_amdgcn_s_getreg((3 << 11) | 20) & 0xFu; }
#define XB_SPIN(cond, bar) do { unsigned _sp = 0; while (cond) { __builtin_amdgcn_s_sleep(1); \
    if ((++_sp & 255u) == 0u) { if (xb_ld(&(bar)[XB_TMO])) break; if (_sp > XB_SPIN_CAP) { atomicAdd(&(bar)[XB_TMO], 1u); break; } } } } while (0)
struct XcdBarrier { unsigned* bar; unsigned x; volatile LAS unsigned* st; };
__device__ __forceinline__ XcdBarrier xcd_barrier_post(unsigned* bar, volatile LAS unsigned* st) {
    XcdBarrier b; b.bar = bar; b.x = xb_xcc_id(); b.st = st;
    if (threadIdx.x == 0) (void)xb_add(&bar[XB_XCNT(b.x)], 1u);
    return b;
}
__device__ __forceinline__ void xcd_barrier_complete(unsigned* bar, unsigned x, unsigned& nloc, unsigned& nx) {
    const unsigned G = gridDim.x * gridDim.y * gridDim.z;
    unsigned sum, cnt, mine, sp = 0u;
    for (;;) {
        sum = 0u; cnt = 0u; mine = 0u;
#pragma unroll
        for (unsigned j = 0; j < 16; ++j) { const unsigned c = xb_ld(&bar[XB_XCNT(j)]); sum += c; cnt += (c > 0u) ? 1u : 0u; mine = (j == x) ? c : mine; }
        if (sum == G) break;
        __builtin_amdgcn_s_sleep(1);
        if ((++sp & 255u) == 0u) { if (xb_ld(&bar[XB_TMO])) break; if (sp > XB_SPIN_CAP) { atomicAdd(&bar[XB_TMO], 1u); break; } }
    }
    nloc = mine > 0u ? mine : 1u; nx = cnt > 0u ? cnt : 1u;
}
__device__ __forceinline__ void xcd_barrier(const XcdBarrier& b, const int tid0) {
    asm volatile("s_waitcnt vmcnt(0)" ::: "memory");
    __syncthreads();
    if (tid0 == 0) {
        unsigned* bar = b.bar;
        __builtin_amdgcn_s_waitcnt(0);
        unsigned nloc = b.st[0], nx = b.st[1];
        if (nloc == 0u) { xcd_barrier_complete(bar, b.x, nloc, nx); b.st[0] = nloc; b.st[1] = nx; }
        const unsigned old = xb_add(&bar[XB_XSUB(b.x)], 1u);
        const unsigned gen = old / nloc;
        if (old + 1u == (gen + 1u) * nloc) {
            __builtin_amdgcn_fence(__ATOMIC_RELEASE, "agent");
            asm volatile("s_waitcnt vmcnt(0)" ::: "memory");
            const unsigned og = xb_add(&bar[XB_TOP], 1u);
            const unsigned tg = og / nx;
            if (og + 1u == (tg + 1u) * nx) xb_add(&bar[XB_TOPGEN], 1u);
            else XB_SPIN(xb_ld(&bar[XB_TOPGEN]) == tg, bar);
            __builtin_amdgcn_fence(__ATOMIC_ACQUIRE, "agent");
            xb_add(&bar[XB_XGEN(b.x)], 1u);
            asm volatile("s_waitcnt vmcnt(0)" ::: "memory");
        } else {
            XB_SPIN(xb_ld(&bar[XB_XGEN(b.x)]) == gen, bar);
            __builtin_amdgcn_fence(__ATOMIC_ACQUIRE, "agent");
            asm volatile("s_waitcnt vmcnt(0)" ::: "memory");
        }
    }
    __syncthreads();
}

struct Params {
    const float *x, *w_in, *w_out, *ret_norm_g, *dil_norm_g, *rwkv_mu, *rwkv_w0, *rwkv_w_up, *rwkv_a0, *rwkv_a_up, *rwkv_g_up, *rwkv_k_k, *rwkv_k_a,
        *rwkv_r_k, *rwkv_ln_g, *rwkv_ln_b, *vres_down, *vres_mu, *rwkv_v0, *rwkv_v_up, *mla_q_norm_g, *mla_w_q_up, *mla_kv_norm_g, *mla_w_kv_up,
        *mla_out_norm_g, *ln1_g, *ln1_b, *router_w, *router_b, *w_gu, *b_gu, *w_dn, *b_dn, *ln2_g, *ln2_b;
    float* out;
    unsigned* bar; int* cnt; int* wq;
    float *tab_ret, *tab_dil, *tab_mla;
    bf16_t *win_t, *wout_t, *wgu_t, *wdn_t, *wq_t, *wkv_t, *wupt, *aupt, *gupt, *vupt;
    float* xf; bf16_t* xb; bf16_t* pbuf; bf16_t* mixcat; float* y1; bf16_t* x1b;
    float *rq, *rk, *rkv, *rstate;
    float *dq, *dk, *dob, *dlse;
    float *sr, *sw, *sk, *sv, *sa, *sb, *sg, *sy, *vfirst;
    float *c_p, *c_q, *c_rh, *c_y1, *c_g;
    float *rsq, *rskv, *kpe, *qu, *kvu, *mo;
    bf16_t *mq, *mk, *mv;
    int *rowtok, *toke, *tokpos; float* rowgate; bf16_t *act, *yb;
};

__device__ __forceinline__ int opq_tid(int wbase) { unsigned z = 0u; asm volatile("" : "+s"(z)); int t = wbase | (int)__builtin_amdgcn_mbcnt_hi(~0u, __builtin_amdgcn_mbcnt_lo(~0u, z)); asm volatile("" : "+v"(t)); return t; }
__device__ __forceinline__ int opq_bid() { int b = blockIdx.x; asm volatile("" : "+s"(b)); return b; }
typedef const __attribute__((address_space(4))) Params* KPtr;
typedef const __attribute__((address_space(4))) Params& KRef;
__device__ __forceinline__ KPtr kp_launder(KPtr k) {
    const unsigned long long v = (unsigned long long)k;
    unsigned lo = (unsigned)v, hi = (unsigned)(v >> 32);
    asm volatile("" : "+s"(lo), "+s"(hi));
    return (KPtr)(((unsigned long long)hi << 32) | lo);
}
#define PH_HEADV (void)kp_in; const Params& p = pkv; const int TID = opq_tid(wbase_in), BID = opq_bid(); (void)TID; (void)BID;
#define PH_HEAD (void)pkv; KPtr kp_ = kp_launder(kp_in); KRef p = *kp_; const int TID = opq_tid(wbase_in), BID = opq_bid(); (void)TID; (void)BID;
template <class F>
__device__ __forceinline__ void tr_tile(F f, bf16_t* dst, int ldd, int k0, int n0, float* tile, const int TID) {
    const int tid = TID;
#pragma unroll
    for (int i = 0; i < 8; ++i) { const int e = tid + i * NTHREADS, kk = e >> 6, nn = e & 63; tile[kk * 65 + nn] = f(k0 + kk, n0 + nn); }
    __syncthreads();
    {
        const int nn = tid >> 3, kc = (tid & 7) * 8;
        u32x4 w;
        w[0] = cvtpk(tile[(kc + 0) * 65 + nn], tile[(kc + 1) * 65 + nn]); w[1] = cvtpk(tile[(kc + 2) * 65 + nn], tile[(kc + 3) * 65 + nn]);
        w[2] = cvtpk(tile[(kc + 4) * 65 + nn], tile[(kc + 5) * 65 + nn]); w[3] = cvtpk(tile[(kc + 6) * 65 + nn], tile[(kc + 7) * 65 + nn]);
        *(u32x4*)(dst + (size_t)(n0 + nn) * ldd + k0 + kc) = w;
    }
    __syncthreads();
}

__device__ __forceinline__ void ph_prologue(const Params& pkv, KPtr kp_in, int wbase_in, char* lds) {
    PH_HEAD
    float* tile = (float*)lds;
    const int nb = gridDim.x, bid = BID, tid = TID;
    for (int t = bid; t < DEPTH * NE * 16 * 32; t += nb) {
        const int le = t >> 9, r = t & 511, tk = r >> 5, tn = r & 31;
        const float* src = p.w_gu + (size_t)le * 1024 * 2048;
        tr_tile([&](int k, int n) { return src[(size_t)k * 2048 + n]; }, p.wgu_t + (size_t)le * 2048 * 1024, 1024, tk * 64, tn * 64, tile, TID);
    }
    for (int t = bid; t < DEPTH * NE * 16 * 16; t += nb) {
        const int le = t >> 8, r = t & 255, tk = r >> 4, tn = r & 15;
        const float* src = p.w_dn + (size_t)le * 1024 * 1024;
        tr_tile([&](int k, int n) { return src[(size_t)k * 1024 + n]; }, p.wdn_t + (size_t)le * 1024 * 1024, 1024, tk * 64, tn * 64, tile, TID);
    }
    for (int t = bid; t < DEPTH * 16 * 48; t += nb) {
        const int l = t / (16 * 48), r = t % (16 * 48), tk = r / 48, tn = r % 48;
        const float* src = p.w_in + (size_t)l * 1024 * NIN;
        const float* vr = p.vres_down + (size_t)(l > 0 ? l - 1 : 0) * 1024 * 32;
        tr_tile([&](int k, int n) { return n < NIN ? src[(size_t)k * NIN + n] : ((n < NIN + 32 && l > 0) ? vr[k * 32 + (n - NIN)] : 0.0f); },
                p.win_t + (size_t)l * NINP * 1024, 1024, tk * 64, tn * 64, tile, TID);
    }
    for (int t = bid; t < DEPTH * 16 * 16; t += nb) {
        const int l = t >> 8, r = t & 255, tk = r >> 4, tn = r & 15;
        const float* src = p.w_out + (size_t)l * 1024 * 1024;
        tr_tile([&](int k, int n) { return src[(size_t)k * 1024 + n]; }, p.wout_t + (size_t)l * 1024 * 1024, 1024, tk * 64, tn * 64, tile, TID);
    }
    for (int t = bid; t < DEPTH * 4 * 6; t += nb) {
        const int l = t / 24, r = t % 24, tk = r / 6, tn = r % 6;
        const float* src = p.mla_w_q_up + (size_t)l * 256 * 384; const float* g = p.mla_q_norm_g + l * 256;
        tr_tile([&](int k, int n) { return src[k * 384 + n] * g[k]; }, p.wq_t + (size_t)l * 384 * 256, 256, tk * 64, tn * 64, tile, TID);
    }
    for (int t = bid; t < DEPTH * 2 * 8; t += nb) {
        const int l = t / 16, r = t % 16, tk = r / 8, tn = r % 8;
        const float* src = p.mla_w_kv_up + (size_t)l * 128 * 512; const float* g = p.mla_kv_norm_g + l * 128;
        tr_tile([&](int k, int n) { return src[k * 512 + n] * g[k]; }, p.wkv_t + (size_t)l * 512 * 128, 128, tk * 64, tn * 64, tile, TID);
    }
    for (int i = bid * NTHREADS + tid; i < DEPTH * 256 * 64; i += nb * NTHREADS) {
        const int l = i / (256 * 64), r = i % (256 * 64), n = r / 64, k = r % 64;
        p.wupt[i] = f2bf(p.rwkv_w_up[((size_t)l * 64 + k) * 256 + n]); p.aupt[i] = f2bf(p.rwkv_a_up[((size_t)l * 64 + k) * 256 + n]);
    }
    for (int i = bid * NTHREADS + tid; i < DEPTH * 256 * 128; i += nb * NTHREADS) {
        const int l = i / (256 * 128), r = i % (256 * 128), n = r / 128, k = r % 128;
        p.gupt[i] = f2bf(p.rwkv_g_up[((size_t)l * 128 + k) * 256 + n]);
    }
    for (int i = bid * NTHREADS + tid; i < (DEPTH - 1) * 256 * 32; i += nb * NTHREADS) {
        const int l = i / (256 * 32), r = i % (256 * 32), n = r / 32, k = r % 32;
        p.vupt[i] = f2bf(p.rwkv_v_up[((size_t)l * 32 + k) * 256 + n]);
    }
    for (int i = bid * NTHREADS + tid; i < SEQ * 40; i += nb * NTHREADS) {
        const int pos = i / 40, j = i % 40;
        double theta, rot; int f; float* dst;
        if (j < 16) { theta = 10000.0; rot = 32.0; f = j; dst = p.tab_ret + ((size_t)pos * 16 + f) * 2; }
        else if (j < 24) { theta = 500000.0; rot = 16.0; f = j - 16; dst = p.tab_dil + ((size_t)pos * 8 + f) * 2; }
        else { theta = 10000.0; rot = 32.0; f = j - 24; dst = p.tab_mla + ((size_t)pos * 16 + f) * 2; }
        const double inv = 1.0 / pow(theta, (2.0 * f) / rot), ang = (double)pos * inv;
        dst[0] = (float)cos(ang); dst[1] = (float)sin(ang);
    }
    for (size_t i = (size_t)bid * NTHREADS + tid; i < (size_t)NT * DM / 4; i += (size_t)nb * NTHREADS) {
        const float4 v = ((const float4*)p.x)[i];
        ushort4 o; o.x = f2bf(v.x); o.y = f2bf(v.y); o.z = f2bf(v.z); o.w = f2bf(v.w);
        ((ushort4*)p.xb)[i] = o;
    }
    if (bid == 0 && tid < DEPTH * NE) p.cnt[tid] = 0;
    if (bid == 0 && tid < DEPTH * 16) p.wq[tid] = 0;
}

template <class Pre, class Epi, class Aux>
__device__ __forceinline__ void gemm_tile128(const bf16_t* __restrict__ A, int lda, const int* __restrict__ rowidx, int nvalid,
                                             const bf16_t* __restrict__ Bt, int ldb, int K, char* lds, const int TID, Pre pre, Epi epi, Aux aux) {
    constexpr int LDT = 72;
    bf16_t* As = (bf16_t*)lds; bf16_t* Bs = As + 128 * LDT;
    const int tid = TID, lane = tid & 63, wid = tid >> 6, wm = wid >> 2, wn = wid & 3, fr = lane & 15, fq = lane >> 4;
    const bf16_t* ap[2]; const bf16_t* bp[2]; int so[2];
#pragma unroll
    for (int i = 0; i < 2; ++i) {
        const int c = tid + i * NTHREADS, row = c >> 3, kc = c & 7;
        int ar = row; if (rowidx) ar = (row < nvalid) ? rowidx[row] : rowidx[0];
        ap[i] = A + (size_t)ar * lda + kc * 8; bp[i] = Bt + (size_t)row * ldb + kc * 8; so[i] = row * LDT + kc * 8;
    }
    f32x4 acc[4][2];
#pragma unroll
    for (int mi = 0; mi < 4; ++mi)
#pragma unroll
        for (int ni = 0; ni < 2; ++ni) acc[mi][ni] = (f32x4){0.f, 0.f, 0.f, 0.f};
    u32x4 ra0[4], ra1[4], rb0[4], rb1[4];
    const int nk = K >> 6;
#pragma unroll
    for (int kt = 0; kt < 4; ++kt)
        if (kt < nk) { const int ko = kt * 64; ra0[kt] = *(const u32x4*)(ap[0] + ko); ra1[kt] = *(const u32x4*)(ap[1] + ko); rb0[kt] = *(const u32x4*)(bp[0] + ko); rb1[kt] = *(const u32x4*)(bp[1] + ko); }
    pre();
    u32x4 ax0[4], ax1[4];
#pragma unroll
    for (int mi = 0; mi < 4; ++mi) { ax0[mi] = aux(wm * 64 + mi * 16 + fr, wn * 32 + fq * 4, 0); ax1[mi] = aux(wm * 64 + mi * 16 + fr, wn * 32 + fq * 4, 1); }
#pragma unroll
    for (int kt = 0; kt < 4; ++kt) {
        if (kt < nk) {
            __syncthreads();
            *(u32x4*)(As + so[0]) = ra0[kt]; *(u32x4*)(As + so[1]) = ra1[kt]; *(u32x4*)(Bs + so[0]) = rb0[kt]; *(u32x4*)(Bs + so[1]) = rb1[kt];
            __syncthreads();
#pragma unroll
            for (int kk = 0; kk < 2; ++kk) {
                bf16x8 af[4], bfr[2];
#pragma unroll
                for (int mi = 0; mi < 4; ++mi) af[mi] = *(const bf16x8*)(As + (wm * 64 + mi * 16 + fr) * LDT + kk * 32 + fq * 8);
#pragma unroll
                for (int ni = 0; ni < 2; ++ni) bfr[ni] = *(const bf16x8*)(Bs + (wn * 32 + ni * 16 + fr) * LDT + kk * 32 + fq * 8);
#pragma unroll
                for (int mi = 0; mi < 4; ++mi)
#pragma unroll
                    for (int ni = 0; ni < 2; ++ni) acc[mi][ni] = __builtin_amdgcn_mfma_f32_16x16x32_bf16(bfr[ni], af[mi], acc[mi][ni], 0, 0, 0);
            }
        }
    }
#pragma unroll
    for (int mi = 0; mi < 4; ++mi) epi(wm * 64 + mi * 16 + fr, wn * 32 + fq * 4, acc[mi][0], acc[mi][1], ax0[mi], ax1[mi]);
    __syncthreads();
}

__device__ __forceinline__ int g8_lds_byte(int r, int c) { const int st = (r >> 4) * 2 + (c >> 5), rr = r & 15, cc = c & 31, ob = rr * 64 + cc * 2; return st * 1024 + (ob ^ (((ob >> 9) & 1) << 5)); }
__device__ __forceinline__ void g8_stage_rc(int b, int& R, int& C) { const int st = b / 1024, sb = b % 1024, swz = sb ^ (((sb >> 9) & 1) << 5); R = (st >> 1) * 16 + swz / 64; C = (st & 1) * 32 + (swz % 64) / 2; }
struct G8Out { bf16_t* out; int ld; int w; int plain; };
struct G8Next { const bf16_t* A; const int* rowidx; const bf16_t* Bt; int nvalid; int valid; int perm; };
__device__ __forceinline__ int g8_perm32(int rho) { const int n = rho >> 4, i = rho & 15; return 8 * (i >> 2) + 4 * n + (i & 3); }
template <class Epi, class Aux>
__device__ __forceinline__ void gemm_tile256(const bf16_t* __restrict__ A, int lda, const int* __restrict__ rowidx, int nvalid,
                                             const bf16_t* __restrict__ Bt, int ldb, int K, char* lds, const int TID, const bool pre_issued, const G8Next nx, const bool perm, const G8Out so, const float* __restrict__ binit, Epi epi, Aux aux) {
    constexpr int G_HT = 128 * 64;
    bf16_t* shm = (bf16_t*)lds;
    int* icache = (int*)(lds + 133120);
#define G8_SA(b, h) (shm + ((b) * 2 + (h)) * G_HT)
#define G8_SB(b, h) (shm + (4 + (b) * 2 + (h)) * G_HT)
#define G8_SPTR(dst, src) do { unsigned long long _v = (unsigned long long)(src); unsigned _lo = (unsigned)_v, _hi = (unsigned)(_v >> 32); asm volatile("" : "+s"(_lo), "+s"(_hi)); \
        dst = (const char*)(((unsigned long long)_hi << 32) | _lo); } while (0)
#define G8_STAGE(P, BASE, OFF, kt) do { const char* _sb; G8_SPTR(_sb, (const char*)(BASE) + (size_t)(kt) * 128); _Pragma("unroll") for (int _i = 0; _i < 2; ++_i) { \
        __builtin_amdgcn_global_load_lds((const unsigned*)(_sb + (size_t)(OFF)[_i]), (unsigned*)((char*)(P) + tz * 16 + _i * 8192), 16, 0, 0); } } while (0)
#define G8_LDA(dst, b, h) _Pragma("unroll") for (int m = 0; m < 4; ++m) _Pragma("unroll") for (int k = 0; k < 2; ++k) \
        dst[m][k] = *reinterpret_cast<const bf16x8*>((char*)G8_SA(b, h) + g8_lds_byte(wr * 64 + m * 16 + fr, k * 32 + fq * 8))
#define G8_LDB(dst, b, h) _Pragma("unroll") for (int n = 0; n < 2; ++n) _Pragma("unroll") for (int k = 0; k < 2; ++k) \
        dst[n][k] = *reinterpret_cast<const bf16x8*>((char*)G8_SB(b, h) + g8_lds_byte(wc * 32 + n * 16 + fr, k * 32 + fq * 8))
#define G8_MMA(ai, bj, At_, Bt_) do { __builtin_amdgcn_s_setprio(1); \
        _Pragma("unroll") for (int m = 0; m < 4; ++m) _Pragma("unroll") for (int n = 0; n < 2; ++n) _Pragma("unroll") for (int k = 0; k < 2; ++k) \
            acc[ai][bj][m][n] = __builtin_amdgcn_mfma_f32_16x16x32_bf16(Bt_[n][k], At_[m][k], acc[ai][bj][m][n], 0, 0, 0); \
        __builtin_amdgcn_s_setprio(0); } while (0)
#define G8_WAIT_V(n) asm volatile("s_waitcnt vmcnt(" #n ")" ::: "memory")
#define G8_WAIT_L(n) asm volatile("s_waitcnt lgkmcnt(" #n ")" ::: "memory")
#define G8_BAR __builtin_amdgcn_s_barrier()
#define G8_SCHED __builtin_amdgcn_sched_barrier(0)
    int tz = opq_tid(TID);
    int wid = tz >> 6, lane = tz & 63, wr = wid >> 2, wc = wid & 3, fr = lane & 15, fq = lane >> 4;
    unsigned aoff0[2], aoff1[2], boff0[2];
#pragma unroll
    for (int i = 0; i < 2; ++i) {
        int r, c; g8_stage_rc(tz * 16 + i * 8192, r, c);
        int r0 = r, r1 = 128 + r;
        if (rowidx) {
            if (pre_issued) { r0 = icache[r0]; r1 = icache[r1]; }
            else { r0 = (r0 < nvalid) ? rowidx[r0] : rowidx[0]; r1 = (r1 < nvalid) ? rowidx[r1] : rowidx[0]; }
        }
        aoff0[i] = (unsigned)(r0 * lda + c) * 2u; aoff1[i] = (unsigned)(r1 * lda + c) * 2u;
        const int rb = perm ? ((r & ~31) + g8_perm32(r & 31)) : r;
        boff0[i] = (unsigned)(rb * ldb + c) * 2u;
    }
    const bf16_t* Bt1 = Bt + (size_t)128 * ldb;
    int nidx = 0;
    if (nx.valid && nx.rowidx && tz < 256) nidx = nx.rowidx[(tz < nx.nvalid) ? tz : 0];
    f32x4 acc[2][2][4][2];
#pragma unroll
    for (int a = 0; a < 2; ++a)
#pragma unroll
        for (int b = 0; b < 2; ++b)
#pragma unroll
            for (int m = 0; m < 4; ++m)
#pragma unroll
                for (int n = 0; n < 2; ++n) acc[a][b][m][n] = (f32x4){0.f, 0.f, 0.f, 0.f};
    if (binit) {
#pragma unroll
        for (int b = 0; b < 2; ++b)
#pragma unroll
            for (int n = 0; n < 2; ++n) {
                const f32x4 bv = *(const f32x4*)(binit + b * 128 + wc * 32 + (perm ? fq * 8 + 4 * n : n * 16 + fq * 4));
#pragma unroll
                for (int a = 0; a < 2; ++a)
#pragma unroll
                    for (int m = 0; m < 4; ++m) acc[a][b][m][n] = bv;
            }
    }
    bf16x8 At[4][2], B0[2][2], B1[2][2];
    const int nt = K / 64;
    if (!pre_issued) {
        G8_STAGE(G8_SB(0, 0), Bt, boff0, 0); G8_STAGE(G8_SA(0, 0), A, aoff0, 0);
        G8_STAGE(G8_SB(0, 1), Bt1, boff0, 0); G8_STAGE(G8_SA(0, 1), A, aoff1, 0);
    }
    if (wr == 1) G8_BAR;
    if (pre_issued) { G8_WAIT_V(32); } else { G8_WAIT_V(4); }
    G8_BAR;
    G8_STAGE(G8_SB(1, 0), Bt, boff0, 1); G8_STAGE(G8_SA(1, 0), A, aoff0, 1); G8_STAGE(G8_SB(1, 1), Bt1, boff0, 1);
    if (!pre_issued) { G8_WAIT_V(6); }
    G8_BAR;
    for (int t = 0; t < nt - 2; t += 2) {
        G8_LDB(B0, 0, 0); G8_SCHED; G8_LDA(At, 0, 0); G8_STAGE(G8_SA(1, 1), A, aoff1, t + 1);
        G8_WAIT_L(8); G8_BAR; G8_WAIT_L(0); G8_MMA(0, 0, At, B0); G8_BAR; G8_SCHED;
        G8_LDB(B1, 0, 1); G8_STAGE(G8_SB(0, 0), Bt, boff0, t + 2);
        G8_BAR; G8_WAIT_L(0); G8_MMA(0, 1, At, B1); G8_BAR;
        G8_LDA(At, 0, 1); G8_STAGE(G8_SA(0, 0), A, aoff0, t + 2);
        G8_BAR; G8_WAIT_L(0); G8_MMA(1, 0, At, B0); G8_BAR; G8_SCHED;
        G8_STAGE(G8_SB(0, 1), Bt1, boff0, t + 2);
        G8_WAIT_V(6); G8_BAR; G8_MMA(1, 1, At, B1); G8_BAR;
        G8_LDB(B0, 1, 0); G8_SCHED; G8_LDA(At, 1, 0); G8_STAGE(G8_SA(0, 1), A, aoff1, t + 2);
        G8_WAIT_L(8); G8_BAR; G8_WAIT_L(0); G8_MMA(0, 0, At, B0); G8_BAR; G8_SCHED;
        G8_LDB(B1, 1, 1); G8_STAGE(G8_SB(1, 0), Bt, boff0, t + 3);
        G8_BAR; G8_WAIT_L(0); G8_MMA(0, 1, At, B1); G8_BAR;
        G8_LDA(At, 1, 1); G8_STAGE(G8_SA(1, 0), A, aoff0, t + 3);
        G8_BAR; G8_WAIT_L(0); G8_MMA(1, 0, At, B0); G8_BAR; G8_SCHED;
        G8_STAGE(G8_SB(1, 1), Bt1, boff0, t + 3);
        G8_WAIT_V(6); G8_BAR; G8_MMA(1, 1, At, B1); G8_BAR;
    }
    { G8_LDB(B0, 0, 0); G8_WAIT_V(0); G8_LDA(At, 0, 0); G8_STAGE(G8_SA(1, 1), A, aoff1, nt - 1);
      G8_BAR; G8_WAIT_L(0); G8_MMA(0, 0, At, B0); G8_BAR;
      G8_LDB(B1, 0, 1); G8_BAR; G8_WAIT_L(0); G8_MMA(0, 1, At, B1); G8_BAR;
      G8_LDA(At, 0, 1); G8_WAIT_V(4); G8_BAR; G8_WAIT_L(0); G8_MMA(1, 0, At, B0); G8_MMA(1, 1, At, B1); G8_BAR; }
    { G8_LDB(B0, 1, 0); G8_LDA(At, 1, 0); G8_WAIT_V(2); G8_BAR; G8_WAIT_L(0); G8_MMA(0, 0, At, B0); G8_BAR;
      G8_LDB(B1, 1, 1); G8_WAIT_V(0); G8_BAR; G8_WAIT_L(0); G8_MMA(0, 1, At, B1); G8_BAR;
      G8_LDA(At, 1, 1); G8_BAR; G8_WAIT_L(0); G8_MMA(1, 0, At, B0); G8_MMA(1, 1, At, B1); G8_BAR; }
    if (wr == 0) G8_BAR;
    asm volatile("" : "+v"(tz)); wid = tz >> 6; lane = tz & 63; wr = wid >> 2; wc = wid & 3; fr = lane & 15; fq = lane >> 4;
    if (nx.valid) {
        if (nx.rowidx) { if (tz < 256) icache[tz] = nidx; G8_WAIT_L(0); G8_BAR; }
        unsigned na0[2], na1[2], nb0[2];
#pragma unroll
        for (int i = 0; i < 2; ++i) {
            int r, c; g8_stage_rc(tz * 16 + i * 8192, r, c);
            int r0 = r, r1 = 128 + r;
            if (nx.rowidx) { r0 = icache[r0]; r1 = icache[r1]; }
            const int rb = nx.perm ? ((r & ~31) + g8_perm32(r & 31)) : r;
            na0[i] = (unsigned)(r0 * lda + c) * 2u; na1[i] = (unsigned)(r1 * lda + c) * 2u; nb0[i] = (unsigned)(rb * ldb + c) * 2u;
        }
        const bf16_t* nBt1 = nx.Bt + (size_t)128 * ldb;
        G8_STAGE(G8_SB(0, 0), nx.Bt, nb0, 0); G8_STAGE(G8_SA(0, 0), nx.A, na0, 0);
        G8_STAGE(G8_SB(0, 1), nBt1, nb0, 0); G8_STAGE(G8_SA(0, 1), nx.A, na1, 0);
    }
    if (so.w == 0) {
#pragma unroll
        for (int ai = 0; ai < 2; ++ai)
#pragma unroll
            for (int m = 0; m < 4; ++m)
#pragma unroll
                for (int bj = 0; bj < 2; ++bj) (void)epi(ai * 128 + wr * 64 + m * 16 + fr, bj * 128 + wc * 32 + (perm ? fq * 8 : fq * 4), acc[ai][bj][m][0], acc[ai][bj][m][1], (u32x4){0u, 0u, 0u, 0u});
    } else {
        const int sw = so.w * 2 + 32;
        char* sl = (char*)lds;
        u32x4 ax[2][4][2];
#pragma unroll
        for (int ai = 0; ai < 2; ++ai)
#pragma unroll
            for (int m = 0; m < 4; ++m)
#pragma unroll
                for (int bj = 0; bj < 2; ++bj) ax[ai][m][bj] = aux(ai * 128 + wr * 64 + m * 16 + fr, bj * 128 + wc * 32 + fq * 8);
#pragma unroll
        for (int ai = 0; ai < 2; ++ai) {
#pragma unroll
            for (int m = 0; m < 4; ++m)
#pragma unroll
                for (int bj = 0; bj < 2; ++bj) {
                    const int rr = wr * 64 + m * 16 + fr, c = bj * 128 + wc * 32 + fq * 8;
                    const u32x4 o = epi(ai * 128 + rr, c, acc[ai][bj][m][0], acc[ai][bj][m][1], ax[ai][m][bj]);
                    if (so.w == 256) *(u32x4*)(sl + rr * sw + c * 2) = o; else *(uint2*)(sl + rr * sw + c) = make_uint2(o[0], o[1]);
                }
            G8_WAIT_L(0); G8_BAR;
            {
                const int rpi = 1024 / (so.w * 2), cpr = so.w / 8;
#pragma unroll 4
                for (int i = 0; i < 16 / rpi; ++i) {
                    const int row = wid * 16 + i * rpi + lane / cpr, ch = lane % cpr;
                    const u32x4 v = *(const u32x4*)(sl + row * sw + ch * 16);
                    if (so.plain) *(u32x4*)(so.out + (size_t)(ai * 128 + row) * so.ld + ch * 8) = v; else __builtin_nontemporal_store(v, (u32x4*)(so.out + (size_t)(ai * 128 + row) * so.ld + ch * 8));
                }
            }
            G8_WAIT_L(0); G8_BAR;
        }
    }
    G8_BAR;
}

#define XU_LOOP(nM_, nN_) const int xu_x = BID & 7, xu_nb = gridDim.x >> 3, xu_own = ((nM_) - xu_x + 7) >> 3, xu_nN = (nN_); for (int xv = BID >> 3; xv < xu_own * xu_nN; xv += xu_nb)
#define XU_UNIT() ((xu_x + 8 * (xv / xu_nN)) * xu_nN + (xv % xu_nN))
#define XU_NEXT_OK ((xv + xu_nb) < xu_own * xu_nN)
#define XU_NEXT_UNIT() ((xu_x + 8 * ((xv + xu_nb) / xu_nN)) * xu_nN + ((xv + xu_nb) % xu_nN))
__device__ __forceinline__ void ph_inproj(const Params& pkv, KPtr kp_in, int wbase_in, int l, char* lds) {
    PH_HEAD
    const bf16_t* Bt = p.win_t + (size_t)l * NINP * 1024;
    const int ntn = NINP / 256, nunits = (NT / 256) * ntn;
    bool pre = false;
    XU_LOOP(NT / 256, ntn) {
        const int u = XU_UNIT();
        const int mt = u / ntn, nt = u % ntn, un = XU_NEXT_UNIT(), mt2 = un / ntn, nt2 = un % ntn;
        G8Next nx; nx.valid = 0; nx.rowidx = nullptr; nx.nvalid = 256; nx.A = p.xb + (size_t)mt2 * 256 * 1024; nx.Bt = Bt + (size_t)nt2 * 256 * 1024; nx.perm = !(nt2 == 0 || nt2 == 3 || nt2 == 4);
        const bool perm = !(nt == 0 || nt == 3 || nt == 4);
        bf16_t* out = p.pbuf + (size_t)mt * 256 * NINP + nt * 256;
        const float* tabr = p.tab_ret; const float* tabd = p.tab_dil; bf16_t* rqb = (bf16_t*)p.rq; bf16_t* rkb = (bf16_t*)p.rk; bf16_t* dqb = (bf16_t*)p.dq; bf16_t* dkb = (bf16_t*)p.dk;
        G8Out so; so.out = out; so.ld = NINP; so.w = perm ? 256 : 0; so.plain = 0;
        gemm_tile256(p.xb + (size_t)mt * 256 * 1024, 1024, nullptr, 256, Bt + (size_t)nt * 256 * 1024, 1024, 1024, lds, wbase_in, pre, nx, perm, so, nullptr,
                     [=](int r, int c, f32x4 v0, f32x4 v1, u32x4) mutable {
                         const int pos = (mt * 256 + r) % SEQ; const size_t t = (size_t)mt * 256 + r;
                         if (nt == 0) {
                             const int i0 = c & 15, hc = c & 127; const bool isk = c >= 128;
                             const f32x4 cs0 = *(const f32x4*)(tabr + (pos * 16 + i0) * 2), cs1 = *(const f32x4*)(tabr + (pos * 16 + i0) * 2 + 4);
                             const float sc = isk ? 0.17677669529663687f : 1.0f;
                             const f32x4 a = v0 * sc, b = v1 * sc;
                             v0[0] = a[0] * cs0[0] - b[0] * cs0[1]; v1[0] = a[0] * cs0[1] + b[0] * cs0[0]; v0[1] = a[1] * cs0[2] - b[1] * cs0[3]; v1[1] = a[1] * cs0[3] + b[1] * cs0[2];
                             v0[2] = a[2] * cs1[0] - b[2] * cs1[1]; v1[2] = a[2] * cs1[1] + b[2] * cs1[0]; v0[3] = a[3] * cs1[2] - b[3] * cs1[3]; v1[3] = a[3] * cs1[3] + b[3] * cs1[2];
                             bf16_t* dst = (isk ? rkb : rqb) + t * 128 + hc;
                             uint2 o; o.x = cvtpk(v0[0], v0[1]); o.y = cvtpk(v0[2], v0[3]); *(uint2*)dst = o; o.x = cvtpk(v1[0], v1[1]); o.y = cvtpk(v1[2], v1[3]); *(uint2*)(dst + 16) = o;
                         } else if (nt == 3 || nt == 4) {
                             const float sc = (nt == 3) ? (0.125f * 1.4426950408889634f) : 1.0f;
                             v0 = v0 * sc; v1 = v1 * sc;
                             if ((c & 32) == 0) {
                                 f32x4 pv;
#pragma unroll
                                 for (int j = 0; j < 4; ++j) { auto rr = __builtin_amdgcn_permlane32_swap(__float_as_uint(v0[j]), __float_as_uint(v0[j]), false, false); pv[j] = __uint_as_float((c & 8) ? rr[0] : rr[1]); }
                                 const int i0 = c & 7;
                                 const f32x4 cs0 = *(const f32x4*)(tabd + (pos * 8 + i0) * 2), cs1 = *(const f32x4*)(tabd + (pos * 8 + i0) * 2 + 4);
                                 const f32x4 own = v0;
                                 if ((c & 8) == 0) { v0[0] = own[0] * cs0[0] - pv[0] * cs0[1]; v0[1] = own[1] * cs0[2] - pv[1] * cs0[3]; v0[2] = own[2] * cs1[0] - pv[2] * cs1[1]; v0[3] = own[3] * cs1[2] - pv[3] * cs1[3]; }
                                 else { v0[0] = pv[0] * cs0[1] + own[0] * cs0[0]; v0[1] = pv[1] * cs0[3] + own[1] * cs0[2]; v0[2] = pv[2] * cs1[1] + own[2] * cs1[0]; v0[3] = pv[3] * cs1[3] + own[3] * cs1[2]; }
                             }
                             bf16_t* dst = ((nt == 3) ? dqb : dkb) + t * 256 + c;
                             uint2 o; o.x = cvtpk(v0[0], v0[1]); o.y = cvtpk(v0[2], v0[3]); *(uint2*)dst = o; o.x = cvtpk(v1[0], v1[1]); o.y = cvtpk(v1[2], v1[3]); *(uint2*)(dst + 16) = o;
                         } else {
                             u32x4 o; o[0] = cvtpk(v0[0], v0[1]); o[1] = cvtpk(v0[2], v0[3]); o[2] = cvtpk(v1[0], v1[1]); o[3] = cvtpk(v1[2], v1[3]); return o;
                         }
                         return (u32x4){0u, 0u, 0u, 0u}; },
                     [](int, int) { return (u32x4){0u, 0u, 0u, 0u}; });
        pre = nx.valid != 0;
    }
}


__device__ __forceinline__ float ret_log_gamma(int h) { return logf(1.0f - exp2f(-5.0f - (float)h)); }

__device__ __forceinline__ void ph_ret_kv(const Params& pkv, KPtr kp_in, int wbase_in, int l, char* lds) {
    PH_HEAD
    float* kz = (float*)lds;
    float* vs = kz + 128 * 32;
    const int tid = TID;
    for (int u = BID; u < NBATCH * NCH * 4; u += gridDim.x) {
        const int h = u & 3, n = (u >> 2) & 63, b = u >> 8;
        const float lg = ret_log_gamma(h);
        const int t0 = b * SEQ + n * BLK;
        __syncthreads();
        {
            const int jk = tid >> 2, dk = (tid & 3) * 8;
            const u32x4 kw = *(const u32x4*)((const bf16_t*)p.rk + (size_t)(t0 + jk) * 128 + h * 32 + dk);
            u32x4 vw[2];
#pragma unroll
            for (int i = 0; i < 2; ++i) { const int idx = tid + i * NTHREADS, jv = idx >> 3, cv = (idx & 7) * 8; vw[i] = *(const u32x4*)(p.pbuf + (size_t)(t0 + jv) * NINP + PC_RV + h * 64 + cv); }
            const float dec = __expf((float)(BLK - 1 - jk) * lg);
            float* kd = kz + jk * 32 + dk;
            *(float4*)kd = make_float4(__uint_as_float(kw[0] << 16) * dec, __uint_as_float(kw[0] & 0xffff0000u) * dec, __uint_as_float(kw[1] << 16) * dec, __uint_as_float(kw[1] & 0xffff0000u) * dec);
            *(float4*)(kd + 4) = make_float4(__uint_as_float(kw[2] << 16) * dec, __uint_as_float(kw[2] & 0xffff0000u) * dec, __uint_as_float(kw[3] << 16) * dec, __uint_as_float(kw[3] & 0xffff0000u) * dec);
#pragma unroll
            for (int i = 0; i < 2; ++i) {
                const int idx = tid + i * NTHREADS, jv = idx >> 3, cv = (idx & 7) * 8; float* vd = vs + jv * 64 + cv;
                *(float4*)vd = make_float4(__uint_as_float(vw[i][0] << 16), __uint_as_float(vw[i][0] & 0xffff0000u), __uint_as_float(vw[i][1] << 16), __uint_as_float(vw[i][1] & 0xffff0000u));
                *(float4*)(vd + 4) = make_float4(__uint_as_float(vw[i][2] << 16), __uint_as_float(vw[i][2] & 0xffff0000u), __uint_as_float(vw[i][3] << 16), __uint_as_float(vw[i][3] & 0xffff0000u));
            }
        }
        __syncthreads();
        const int e = tid & 63, d0 = (tid >> 6) * 4;
        float a0 = 0.f, a1 = 0.f, a2 = 0.f, a3 = 0.f;
#pragma unroll 8
        for (int j = 0; j < BLK; ++j) {
            const float vv = vs[j * 64 + e]; const float4 kk = *(const float4*)(kz + j * 32 + d0);
            a0 += kk.x * vv; a1 += kk.y * vv; a2 += kk.z * vv; a3 += kk.w * vv;
        }
        float* out = p.rkv + (size_t)u * 2048;
        out[(d0 + 0) * 64 + e] = a0; out[(d0 + 1) * 64 + e] = a1; out[(d0 + 2) * 64 + e] = a2; out[(d0 + 3) * 64 + e] = a3;
    }
}
__device__ __forceinline__ void ph_ret_scan(const Params& pkv, KPtr kp_in, int wbase_in, int l) {
    PH_HEAD
    const int i = BID * NTHREADS + TID;
    if (i < NBATCH * 4 * 32 * 64) {
        const int e = i & 63, d = (i >> 6) & 31, h = (i >> 11) & 3, b = i >> 13;
        const float cd = __expf((float)BLK * ret_log_gamma(h));
        float s = 0.f;
#pragma unroll 1
        for (int n0 = 0; n0 < NCH; n0 += 16) {
            float v[16];
#pragma unroll
            for (int q = 0; q < 16; ++q) v[q] = p.rkv[((((size_t)b * NCH + n0 + q) * 4 + h) * 32 + d) * 64 + e];
#pragma unroll
            for (int q = 0; q < 16; ++q) { p.rstate[((((size_t)b * NCH + n0 + q) * 4 + h) * 32 + d) * 64 + e] = s; s = cd * s + v[q]; }
        }
    }
}
__device__ __forceinline__ void ph_ret_out(const Params& pkv, KPtr kp_in, int wbase_in, int l, char* lds) {
    PH_HEAD
    constexpr int KSTR = 40, VSTR = 132, SSTR = 40, UNIT_BYTES = (128 * KSTR + 64 * VSTR + 64 * SSTR) * 2;
    const int tid = TID, lane = tid & 63, wv = tid >> 6, hb = wv >> 2, w = wv & 3, r = lane & 31, hh = lane >> 5, ht = tid & 255;
    bf16_t* Ks = (bf16_t*)(lds + hb * UNIT_BYTES);
    bf16_t* Vt = Ks + 128 * KSTR;
    bf16_t* St = Vt + 64 * VSTR;
    const bf16_t* rqb = (const bf16_t*)p.rq; const bf16_t* rkb = (const bf16_t*)p.rk;
    int* wq = p.wq + l * 16 + 2;
    volatile int* wslot = (volatile int*)(lds + 2 * UNIT_BYTES);
    for (;;) {
        __syncthreads();
        if (tid == 0) *wslot = atomicAdd(wq, 1);
        __syncthreads();
        const int u0 = __builtin_amdgcn_readfirstlane(*wslot) * 2;
        if (u0 >= NBATCH * NCH * 4) break;
        const int u = u0 + hb, h = u & 3, n = (u >> 2) & 63, b = u >> 8;
        const int t0 = b * SEQ + n * BLK;
        const float lg2 = ret_log_gamma(h) * 1.4426950408889634f;
        __syncthreads();
#pragma unroll
        for (int i = 0; i < 2; ++i) { const int c = ht + i * 256, key = c >> 2, ch = c & 3; *(u32x4*)(Ks + key * KSTR + ch * 8) = *(const u32x4*)(rkb + (size_t)(t0 + key) * 128 + h * 32 + ch * 8); }
#pragma unroll
        for (int i = 0; i < 4; ++i) {
            const int c = ht + i * 256, key = c & 127, ch = c >> 7;
            const u32x4 rv = *(const u32x4*)(p.pbuf + (size_t)(t0 + key) * NINP + PC_RV + h * 64 + ch * 8);
            bf16_t* vd = Vt + (ch * 8) * VSTR + key;
            vd[0] = (bf16_t)(rv[0] & 0xffff); vd[VSTR] = (bf16_t)(rv[0] >> 16); vd[2 * VSTR] = (bf16_t)(rv[1] & 0xffff); vd[3 * VSTR] = (bf16_t)(rv[1] >> 16);
            vd[4 * VSTR] = (bf16_t)(rv[2] & 0xffff); vd[5 * VSTR] = (bf16_t)(rv[2] >> 16); vd[6 * VSTR] = (bf16_t)(rv[3] & 0xffff); vd[7 * VSTR] = (bf16_t)(rv[3] >> 16);
        }
        {
            const float* st = p.rstate + (size_t)u * 2048;
#pragma unroll
            for (int i = 0; i < 8; ++i) { const int c = ht + i * 256, d = c >> 6, e = c & 63; St[e * SSTR + d] = f2bf(st[c]); }
        }
        __syncthreads();
        const int iq = 32 * w + r, t = t0 + iq;
        bf16x8 qf[2];
#pragma unroll
        for (int s = 0; s < 2; ++s) qf[s] = *(const bf16x8*)(rqb + (size_t)t * 128 + h * 32 + 16 * s + 8 * hh);
        f32x16 o0, o1;
#pragma unroll
        for (int i = 0; i < 16; ++i) { o0[i] = 0.f; o1[i] = 0.f; }
#pragma unroll
        for (int s = 0; s < 2; ++s) {
            const bf16x8 sa0 = *(const bf16x8*)(St + r * SSTR + 16 * s + 8 * hh), sa1 = *(const bf16x8*)(St + (32 + r) * SSTR + 16 * s + 8 * hh);
            o0 = __builtin_amdgcn_mfma_f32_32x32x16_bf16(sa0, qf[s], o0, 0, 0, 0);
            o1 = __builtin_amdgcn_mfma_f32_32x32x16_bf16(sa1, qf[s], o1, 0, 0, 0);
        }
        {
            const float xi = __builtin_amdgcn_exp2f((float)(iq + 1) * lg2);
#pragma unroll
            for (int i = 0; i < 16; ++i) { o0[i] *= xi; o1[i] *= xi; }
        }
        float cdec[16];
#pragma unroll
        for (int i = 0; i < 16; ++i) cdec[i] = __builtin_amdgcn_exp2f(-(float)((i & 3) + 8 * (i >> 2) + 4 * hh) * lg2);
        for (int jt = 0; jt <= w; ++jt) {
            f32x16 st;
#pragma unroll
            for (int i = 0; i < 16; ++i) st[i] = 0.f;
#pragma unroll
            for (int s = 0; s < 2; ++s) { const bf16x8 kf = *(const bf16x8*)(Ks + (32 * jt + r) * KSTR + 16 * s + 8 * hh); st = __builtin_amdgcn_mfma_f32_32x32x16_bf16(kf, qf[s], st, 0, 0, 0); }
            const float al = __builtin_amdgcn_exp2f((float)(32 * (w - jt) + r) * lg2);
            if (jt == w) {
#pragma unroll
                for (int i = 0; i < 16; ++i) { const int kr = (i & 3) + 8 * (i >> 2) + 4 * hh; st[i] = (kr <= r) ? st[i] * (al * cdec[i]) : 0.f; }
            } else {
#pragma unroll
                for (int i = 0; i < 16; ++i) st[i] *= al * cdec[i];
            }
#pragma unroll
            for (int s = 0; s < 2; ++s) {
                u32x4 pw; pw[0] = cvtpk(st[8 * s], st[8 * s + 1]); pw[1] = cvtpk(st[8 * s + 2], st[8 * s + 3]); pw[2] = cvtpk(st[8 * s + 4], st[8 * s + 5]); pw[3] = cvtpk(st[8 * s + 6], st[8 * s + 7]);
                const bf16x8 pf = __builtin_bit_cast(bf16x8, pw);
                const bf16_t* va = Vt + r * VSTR + 32 * jt + 16 * s + 4 * hh;
                const s16x4 a0 = *(const s16x4*)(va), a1 = *(const s16x4*)(va + 8), b0 = *(const s16x4*)(va + 32 * VSTR), b1 = *(const s16x4*)(va + 32 * VSTR + 8);
                o0 = __builtin_amdgcn_mfma_f32_32x32x16_bf16(__builtin_shufflevector(a0, a1, 0, 1, 2, 3, 4, 5, 6, 7), pf, o0, 0, 0, 0);
                o1 = __builtin_amdgcn_mfma_f32_32x32x16_bf16(__builtin_shufflevector(b0, b1, 0, 1, 2, 3, 4, 5, 6, 7), pf, o1, 0, 0, 0);
            }
        }
        float ss = 0.f;
#pragma unroll
        for (int i = 0; i < 16; ++i) ss += o0[i] * o0[i] + o1[i] * o1[i];
        ss = xhalf_sum(ss);
        const float rs = rsqrtf(ss * (1.0f / 64.0f) + 1e-6f);
        const float* ng = p.ret_norm_g + l * 256 + h * 64 + 4 * hh;
        const bf16_t* gp = p.pbuf + (size_t)t * NINP + PC_RG + h * 64 + 4 * hh;
        bf16_t* outp = p.mixcat + (size_t)t * 1024 + h * 64 + 4 * hh;
#pragma unroll
        for (int c = 0; c < 2; ++c)
#pragma unroll
            for (int g = 0; g < 4; ++g) {
                const int eo = 32 * c + 8 * g;
                const f32x4 gn = *(const f32x4*)(ng + eo); const uint2 gu = *(const uint2*)(gp + eo);
                const float g0 = __uint_as_float(gu.x << 16), g1 = __uint_as_float(gu.x & 0xffff0000u), g2 = __uint_as_float(gu.y << 16), g3 = __uint_as_float(gu.y & 0xffff0000u);
                const float v0 = (c ? o1[4 * g] : o0[4 * g]) * rs * gn[0], v1 = (c ? o1[4 * g + 1] : o0[4 * g + 1]) * rs * gn[1], v2 = (c ? o1[4 * g + 2] : o0[4 * g + 2]) * rs * gn[2], v3 = (c ? o1[4 * g + 3] : o0[4 * g + 3]) * rs * gn[3];
                uint2 ov; ov.x = cvtpk(g0 * sigmoidf_(g0) * v0, g1 * sigmoidf_(g1) * v1); ov.y = cvtpk(g2 * sigmoidf_(g2) * v2, g3 * sigmoidf_(g3) * v3);
                *(uint2*)(outp + eo) = ov;
            }
    }
}

__device__ __forceinline__ void ph_dil_attn(const Params& pkv, KPtr kp_in, int wbase_in, int l, char* lds) {
    PH_HEAD
    constexpr int KSTR = 72, VSTR = 68;
    bf16_t* Ks = (bf16_t*)lds;
    bf16_t* Vt = Ks + 64 * KSTR;
    const int tid = TID, lane = tid & 63, wv = tid >> 6, r = lane & 31, h = lane >> 5;
    int* wq = p.wq + l * 16 + 1;
    volatile int* wslot = (volatile int*)(lds + 24576);
    for (;;) {
        __syncthreads();
        if (tid == 0) *wslot = atomicAdd(wq, 1);
        __syncthreads();
        const int it = __builtin_amdgcn_readfirstlane(*wslot);
        if (it >= 16 * 96) break;
        const int bh = it & 15, u = it >> 4;
        const int b = bh >> 2, hd = bh & 3;
        int pat, dil, rr, m0;
        if (u < 32) { pat = 0; dil = 1; rr = 0; m0 = u * 256; }
        else if (u < 64) { pat = 1; dil = 4; rr = (u - 32) >> 3; m0 = ((u - 32) & 7) * 256; }
        else { pat = 2; dil = 16; rr = (u - 64) >> 1; m0 = ((u - 64) & 1) * 256; }
        const int qmin = m0 + 32 * wv, qmax = qmin + 31, myq = qmin + r;
        const size_t tok0 = (size_t)b * SEQ + rr;
        bf16x8 qf[4];
        {
            const bf16_t* qrow = (const bf16_t*)p.dq + (tok0 + (size_t)dil * myq) * 256 + hd * 64 + 8 * h;
#pragma unroll
            for (int s = 0; s < 4; ++s) qf[s] = *(const bf16x8*)(qrow + 16 * s);
        }
        f32x16 o0, o1;
#pragma unroll
        for (int i = 0; i < 16; ++i) { o0[i] = 0.f; o1[i] = 0.f; }
        float m = -1e30f, lsum = 0.f;
        const int kk = tid >> 3, kc = tid & 7, vk = tid & 63, vc = tid >> 6;
        const bf16_t* kbase = (const bf16_t*)p.dk + hd * 64 + kc * 8;
        const bf16_t* vbase = p.pbuf + PC_DV + hd * 64 + vc * 8;
        const int j0 = (m0 == 0) ? 2 : 0;
        u32x4 rk, rv;
        {
            const int kb = m0 - 128 + 64 * j0;
            rk = *(const u32x4*)(kbase + (tok0 + (size_t)dil * (kb + kk)) * 256);
            rv = *(const u32x4*)(vbase + (tok0 + (size_t)dil * (kb + vk)) * NINP);
        }
        for (int j = j0; j < 6; ++j) {
            __syncthreads();
            *(u32x4*)(Ks + kk * KSTR + kc * 8) = rk;
            {
                const unsigned w0 = rv[0], w1 = rv[1], w2 = rv[2], w3 = rv[3];
                bf16_t* vd = Vt + (vc * 8) * VSTR + vk;
                vd[0] = (bf16_t)(w0 & 0xffff); vd[VSTR] = (bf16_t)(w0 >> 16); vd[2 * VSTR] = (bf16_t)(w1 & 0xffff); vd[3 * VSTR] = (bf16_t)(w1 >> 16);
                vd[4 * VSTR] = (bf16_t)(w2 & 0xffff); vd[5 * VSTR] = (bf16_t)(w2 >> 16); vd[6 * VSTR] = (bf16_t)(w3 & 0xffff); vd[7 * VSTR] = (bf16_t)(w3 >> 16);
            }
            __syncthreads();
            const int kb = m0 - 128 + 64 * j;
            if (j + 1 < 6) {
                const int kn = kb + 64;
                rk = *(const u32x4*)(kbase + (tok0 + (size_t)dil * (kn + kk)) * 256);
                rv = *(const u32x4*)(vbase + (tok0 + (size_t)dil * (kn + vk)) * NINP);
            }
            const bool need0 = (kb <= qmax) && (kb + 31 >= qmin - 128);
            const bool need1 = (kb + 32 <= qmax) && (kb + 63 >= qmin - 128);
            if (need0 || need1) {
                f32x16 s0, s1;
#pragma unroll
                for (int i = 0; i < 16; ++i) { s0[i] = -3e38f; s1[i] = -3e38f; }
                if (need0) {
#pragma unroll
                    for (int i = 0; i < 16; ++i) s0[i] = 0.f;
#pragma unroll
                    for (int s = 0; s < 4; ++s) { const bf16x8 kf = *(const bf16x8*)(Ks + r * KSTR + 16 * s + 8 * h); s0 = __builtin_amdgcn_mfma_f32_32x32x16_bf16(kf, qf[s], s0, 0, 0, 0); }
                    if (!((kb + 31 <= qmin) && (kb >= qmax - 128))) {
#pragma unroll
                        for (int i = 0; i < 16; ++i) { const int key = kb + (i & 3) + 8 * (i >> 2) + 4 * h; if (key > myq || key < myq - 128) s0[i] = -3e38f; }
                    }
                }
                if (need1) {
#pragma unroll
                    for (int i = 0; i < 16; ++i) s1[i] = 0.f;
#pragma unroll
                    for (int s = 0; s < 4; ++s) { const bf16x8 kf = *(const bf16x8*)(Ks + (32 + r) * KSTR + 16 * s + 8 * h); s1 = __builtin_amdgcn_mfma_f32_32x32x16_bf16(kf, qf[s], s1, 0, 0, 0); }
                    if (!((kb + 63 <= qmin) && (kb + 32 >= qmax - 128))) {
#pragma unroll
                        for (int i = 0; i < 16; ++i) { const int key = kb + 32 + (i & 3) + 8 * (i >> 2) + 4 * h; if (key > myq || key < myq - 128) s1[i] = -3e38f; }
                    }
                }
                float mx = s0[0];
#pragma unroll
                for (int i = 1; i < 16; ++i) mx = fmaxf(mx, s0[i]);
#pragma unroll
                for (int i = 0; i < 16; ++i) mx = fmaxf(mx, s1[i]);
                mx = xhalf_max(mx);
                const float mn = fmaxf(m, mx), alpha = __builtin_amdgcn_exp2f(m - mn);
                m = mn;
                float ps = 0.f;
                if (need0) {
#pragma unroll
                    for (int i = 0; i < 16; ++i) { s0[i] = __builtin_amdgcn_exp2f(s0[i] - mn); ps += s0[i]; }
                }
                if (need1) {
#pragma unroll
                    for (int i = 0; i < 16; ++i) { s1[i] = __builtin_amdgcn_exp2f(s1[i] - mn); ps += s1[i]; }
                }
                lsum = lsum * alpha + ps;
                if (!__all(alpha == 1.0f)) {
#pragma unroll
                    for (int i = 0; i < 16; ++i) { o0[i] *= alpha; o1[i] *= alpha; }
                }
                if (need0) {
#pragma unroll
                    for (int s = 0; s < 2; ++s) {
                        u32x4 pw; pw[0] = cvtpk(s0[8 * s], s0[8 * s + 1]); pw[1] = cvtpk(s0[8 * s + 2], s0[8 * s + 3]); pw[2] = cvtpk(s0[8 * s + 4], s0[8 * s + 5]); pw[3] = cvtpk(s0[8 * s + 6], s0[8 * s + 7]);
                        const bf16x8 pf = __builtin_bit_cast(bf16x8, pw);
                        const bf16_t* va = Vt + r * VSTR + 16 * s + 4 * h;
                        const s16x4 a0 = *(const s16x4*)(va), a1 = *(const s16x4*)(va + 8), b0 = *(const s16x4*)(va + 32 * VSTR), b1 = *(const s16x4*)(va + 32 * VSTR + 8);
                        o0 = __builtin_amdgcn_mfma_f32_32x32x16_bf16(__builtin_shufflevector(a0, a1, 0, 1, 2, 3, 4, 5, 6, 7), pf, o0, 0, 0, 0);
                        o1 = __builtin_amdgcn_mfma_f32_32x32x16_bf16(__builtin_shufflevector(b0, b1, 0, 1, 2, 3, 4, 5, 6, 7), pf, o1, 0, 0, 0);
                    }
                }
                if (need1) {
#pragma unroll
                    for (int s = 0; s < 2; ++s) {
                        u32x4 pw; pw[0] = cvtpk(s1[8 * s], s1[8 * s + 1]); pw[1] = cvtpk(s1[8 * s + 2], s1[8 * s + 3]); pw[2] = cvtpk(s1[8 * s + 4], s1[8 * s + 5]); pw[3] = cvtpk(s1[8 * s + 6], s1[8 * s + 7]);
                        const bf16x8 pf = __builtin_bit_cast(bf16x8, pw);
                        const bf16_t* va = Vt + r * VSTR + 32 + 16 * s + 4 * h;
                        const s16x4 a0 = *(const s16x4*)(va), a1 = *(const s16x4*)(va + 8), b0 = *(const s16x4*)(va + 32 * VSTR), b1 = *(const s16x4*)(va + 32 * VSTR + 8);
                        o0 = __builtin_amdgcn_mfma_f32_32x32x16_bf16(__builtin_shufflevector(a0, a1, 0, 1, 2, 3, 4, 5, 6, 7), pf, o0, 0, 0, 0);
                        o1 = __builtin_amdgcn_mfma_f32_32x32x16_bf16(__builtin_shufflevector(b0, b1, 0, 1, 2, 3, 4, 5, 6, 7), pf, o1, 0, 0, 0);
                    }
                }
            }
        }
        const float lt = xhalf_sum(lsum), inv = 1.0f / lt;
        const size_t tq = tok0 + (size_t)dil * myq;
        bf16_t* op = (bf16_t*)p.dob + ((size_t)pat * NT + tq) * 256 + hd * 64 + 4 * h;
#pragma unroll
        for (int g = 0; g < 4; ++g) {
            uint2 w0; w0.x = cvtpk(o0[4 * g] * inv, o0[4 * g + 1] * inv); w0.y = cvtpk(o0[4 * g + 2] * inv, o0[4 * g + 3] * inv);
            uint2 w1; w1.x = cvtpk(o1[4 * g] * inv, o1[4 * g + 1] * inv); w1.y = cvtpk(o1[4 * g + 2] * inv, o1[4 * g + 3] * inv);
            *(uint2*)(op + 8 * g) = w0; *(uint2*)(op + 32 + 8 * g) = w1;
        }
        if (h == 0) p.dlse[((size_t)pat * NT + tq) * 4 + hd] = m + __builtin_amdgcn_logf(lt);
        __syncthreads();
    }
}

__device__ __forceinline__ void ph_rwkv_prep(const Params& pkv, KPtr kp_in, int wbase_in, int l, char* lds) {
    PH_HEAD
    bf16_t* Aw = (bf16_t*)lds; bf16_t* Aa = Aw + 64 * 72; bf16_t* Ag = Aa + 64 * 72; bf16_t* Av = Ag + 64 * 136; float* ssq = (float*)(Av + 64 * 40);
    const int tid = TID, lane = tid & 63, wv = tid >> 6, fr = lane & 15, fq = lane >> 4;
    const int lm = (l > 0) ? l - 1 : 0;
    const float* mu = p.rwkv_mu + l * 1024; const float* vmu = p.vres_mu + lm * 32;
    bf16x8 fw[2][2], fa[2][2], fg[2][4], fv[2];
#pragma unroll
    for (int ni = 0; ni < 2; ++ni) {
        const int n = 32 * wv + 16 * ni + fr;
#pragma unroll
        for (int ks = 0; ks < 2; ++ks) { fw[ni][ks] = *(const bf16x8*)(p.wupt + ((size_t)l * 256 + n) * 64 + 32 * ks + 8 * fq); fa[ni][ks] = *(const bf16x8*)(p.aupt + ((size_t)l * 256 + n) * 64 + 32 * ks + 8 * fq); }
#pragma unroll
        for (int ks = 0; ks < 4; ++ks) fg[ni][ks] = *(const bf16x8*)(p.gupt + ((size_t)l * 256 + n) * 128 + 32 * ks + 8 * fq);
        fv[ni] = *(const bf16x8*)(p.vupt + ((size_t)lm * 256 + n) * 32 + 8 * fq);
    }
    for (int tb = BID * 64; tb < NT; tb += gridDim.x * 64) {
        __syncthreads();
        uint2 n_ru[2], n_ku[2], n_vu[2], n_rp[2], n_kp[2], n_vp[2]; f32x4 n_vf[2];
#define PREP_PRELOAD(mt_) do { const int t_ = tb + 16 * (mt_) + fr; const bool first_ = (t_ % SEQ) == 0; const bf16_t* pr_ = p.pbuf + (size_t)t_ * NINP; \
        _Pragma("unroll") for (int ni = 0; ni < 2; ++ni) { const int c0 = 32 * wv + 16 * ni + 4 * fq; \
            n_ru[ni] = *(const uint2*)(pr_ + PC_CR + c0); n_ku[ni] = *(const uint2*)(pr_ + PC_CK + c0); n_vu[ni] = *(const uint2*)(pr_ + PC_CV + c0); \
            n_rp[ni] = make_uint2(0u, 0u); n_kp[ni] = n_rp[ni]; n_vp[ni] = n_rp[ni]; \
            if (!first_) { n_rp[ni] = *(const uint2*)(pr_ + PC_CR + c0 - NINP); n_kp[ni] = *(const uint2*)(pr_ + PC_CK + c0 - NINP); n_vp[ni] = *(const uint2*)(pr_ + PC_CV + c0 - NINP); } \
            n_vf[ni] = (f32x4){0.f, 0.f, 0.f, 0.f}; if (l > 0) n_vf[ni] = *(const f32x4*)(p.vfirst + (size_t)t_ * 256 + c0); } } while (0)
        PREP_PRELOAD(0);
#pragma unroll 1
        for (int jb = 0; jb < 18; jb += 9) {
            unsigned cu_[9], pu_[9]; float m0_[9], m1_[9];
#pragma unroll
            for (int q = 0; q < 9; ++q) {
                const int e = tid + (jb + q) * NTHREADS, tt = e / 144, j = (e % 144) * 2, t = tb + tt;
                const bool first = (t % SEQ) == 0;
                const bf16_t* pr = p.pbuf + (size_t)t * NINP;
                const int col = (j < 256) ? PC_CWD + j : PC_VRES + (j - 256);
                cu_[q] = *(const unsigned*)(pr + col); pu_[q] = first ? 0u : *(const unsigned*)(pr + col - NINP);
                if (j < 256) { m0_[q] = mu[768 + j]; m1_[q] = mu[768 + j + 1]; } else { m0_[q] = vmu[j - 256]; m1_[q] = vmu[j - 255]; }
            }
#pragma unroll
            for (int q = 0; q < 9; ++q) {
                const int e = tid + (jb + q) * NTHREADS, tt = e / 144, j = (e % 144) * 2;
                const float m0 = m0_[q], m1 = m1_[q];
                const unsigned cu = cu_[q], pu = pu_[q];
                const float c0 = __uint_as_float(cu << 16), c1 = __uint_as_float(cu & 0xffff0000u), p0 = __uint_as_float(pu << 16), p1 = __uint_as_float(pu & 0xffff0000u);
                float x0 = c0 + (p0 - c0) * m0, x1 = c1 + (p1 - c1) * m1;
                bf16_t* dst;
                if (j < 64) { x0 = 1.0f - 2.0f * __builtin_amdgcn_rcpf(__builtin_amdgcn_exp2f(x0 * 2.8853900817779268f) + 1.0f); x1 = 1.0f - 2.0f * __builtin_amdgcn_rcpf(__builtin_amdgcn_exp2f(x1 * 2.8853900817779268f) + 1.0f); dst = Aw + tt * 72 + j; }
                else if (j < 128) { dst = Aa + tt * 72 + (j - 64); }
                else if (j < 256) { x0 = sigmoidf_(x0); x1 = sigmoidf_(x1); dst = Ag + tt * 136 + (j - 128); }
                else { dst = Av + tt * 40 + (j - 256); }
                *(unsigned*)dst = cvtpk(x0, x1);
            }
        }
        {
            const f32x4 kkc = *(const f32x4*)(p.rwkv_k_k + l * 256 + lane * 4), mk4 = *(const f32x4*)(mu + 256 + lane * 4);
            uint2 cu8[8], pu8[8];
#pragma unroll
            for (int i = 0; i < 8; ++i) {
                const int tt = wv * 8 + i, t = tb + tt; const bool first = (t % SEQ) == 0;
                const bf16_t* pr = p.pbuf + (size_t)t * NINP + PC_CK + lane * 4;
                cu8[i] = *(const uint2*)pr; pu8[i] = first ? make_uint2(0u, 0u) : *(const uint2*)(pr - NINP);
            }
#pragma unroll
            for (int i = 0; i < 8; ++i) {
                const int tt = wv * 8 + i;
                const uint2 cu = cu8[i], pu = pu8[i];
                const float c0 = __uint_as_float(cu.x << 16), c1 = __uint_as_float(cu.x & 0xffff0000u), c2 = __uint_as_float(cu.y << 16), c3 = __uint_as_float(cu.y & 0xffff0000u);
                const float q0 = __uint_as_float(pu.x << 16), q1 = __uint_as_float(pu.x & 0xffff0000u), q2 = __uint_as_float(pu.y << 16), q3 = __uint_as_float(pu.y & 0xffff0000u);
                const float k0 = (c0 + (q0 - c0) * mk4[0]) * kkc[0], k1 = (c1 + (q1 - c1) * mk4[1]) * kkc[1], k2 = (c2 + (q2 - c2) * mk4[2]) * kkc[2], k3 = (c3 + (q3 - c3) * mk4[3]) * kkc[3];
                const float ss = grp16_sum(k0 * k0 + k1 * k1 + k2 * k2 + k3 * k3);
                if ((lane & 15) == 0) ssq[tt * 4 + (lane >> 4)] = ss;
            }
        }
        __syncthreads();
#pragma unroll 1
        for (int mt = 0; mt < 4; ++mt) {
            uint2 c_ru[2], c_ku[2], c_vu[2], c_rp[2], c_kp[2], c_vp[2]; f32x4 c_vf[2];
#pragma unroll
            for (int ni = 0; ni < 2; ++ni) { c_ru[ni] = n_ru[ni]; c_ku[ni] = n_ku[ni]; c_vu[ni] = n_vu[ni]; c_rp[ni] = n_rp[ni]; c_kp[ni] = n_kp[ni]; c_vp[ni] = n_vp[ni]; c_vf[ni] = n_vf[ni]; }
            if (mt + 1 < 4) PREP_PRELOAD(mt + 1);
            f32x4 cw[2], ca[2], cg[2], cv[2];
#pragma unroll
            for (int ni = 0; ni < 2; ++ni) { cw[ni] = (f32x4){0.f, 0.f, 0.f, 0.f}; ca[ni] = cw[ni]; cg[ni] = cw[ni]; cv[ni] = cw[ni]; }
            const int arow = 16 * mt + fr;
#pragma unroll
            for (int ks = 0; ks < 2; ++ks) {
                const bf16x8 xw = *(const bf16x8*)(Aw + arow * 72 + 32 * ks + 8 * fq), xa = *(const bf16x8*)(Aa + arow * 72 + 32 * ks + 8 * fq);
#pragma unroll
                for (int ni = 0; ni < 2; ++ni) { cw[ni] = __builtin_amdgcn_mfma_f32_16x16x32_bf16(fw[ni][ks], xw, cw[ni], 0, 0, 0); ca[ni] = __builtin_amdgcn_mfma_f32_16x16x32_bf16(fa[ni][ks], xa, ca[ni], 0, 0, 0); }
            }
#pragma unroll
            for (int ks = 0; ks < 4; ++ks) {
                const bf16x8 xg = *(const bf16x8*)(Ag + arow * 136 + 32 * ks + 8 * fq);
#pragma unroll
                for (int ni = 0; ni < 2; ++ni) cg[ni] = __builtin_amdgcn_mfma_f32_16x16x32_bf16(fg[ni][ks], xg, cg[ni], 0, 0, 0);
            }
            if (l > 0) {
                const bf16x8 xv = *(const bf16x8*)(Av + arow * 40 + 8 * fq);
#pragma unroll
                for (int ni = 0; ni < 2; ++ni) cv[ni] = __builtin_amdgcn_mfma_f32_16x16x32_bf16(fv[ni], xv, cv[ni], 0, 0, 0);
            }
            const int tt = 16 * mt + fr, t = tb + tt; const bool first = (t % SEQ) == 0;
            const float rn = 1.0f / fmaxf(sqrtf(ssq[tt * 4 + (wv >> 1)]), 1e-12f);
            const bf16_t* pr = p.pbuf + (size_t)t * NINP;
#pragma unroll
            for (int ni = 0; ni < 2; ++ni) {
                const int c0 = 32 * wv + 16 * ni + 4 * fq;
                const f32x4 w0 = *(const f32x4*)(p.rwkv_w0 + l * 256 + c0), a0 = *(const f32x4*)(p.rwkv_a0 + l * 256 + c0), kkc = *(const f32x4*)(p.rwkv_k_k + l * 256 + c0), kac = *(const f32x4*)(p.rwkv_k_a + l * 256 + c0);
                const f32x4 v0 = *(const f32x4*)(p.rwkv_v0 + lm * 256 + c0), mr = *(const f32x4*)(mu + c0), mk = *(const f32x4*)(mu + 256 + c0), mv = *(const f32x4*)(mu + 512 + c0);
                const uint2 ru = c_ru[ni], ku = c_ku[ni], vu = c_vu[ni], rp = c_rp[ni], kp2 = c_kp[ni], vp = c_vp[ni];
                const size_t o = (size_t)t * 256 + c0;
                f32x4 vf = c_vf[ni];
                f32x4 o_r, o_w, o_k, o_v, o_a, o_b;
#pragma unroll
                for (int j = 0; j < 4; ++j) {
                    const unsigned rw = (j < 2) ? ru.x : ru.y, kw = (j < 2) ? ku.x : ku.y, vw = (j < 2) ? vu.x : vu.y, rpw = (j < 2) ? rp.x : rp.y, kpw = (j < 2) ? kp2.x : kp2.y, vpw = (j < 2) ? vp.x : vp.y;
                    const float rc = (j & 1) ? __uint_as_float(rw & 0xffff0000u) : __uint_as_float(rw << 16), kc = (j & 1) ? __uint_as_float(kw & 0xffff0000u) : __uint_as_float(kw << 16), vc = (j & 1) ? __uint_as_float(vw & 0xffff0000u) : __uint_as_float(vw << 16);
                    const float rq = (j & 1) ? __uint_as_float(rpw & 0xffff0000u) : __uint_as_float(rpw << 16), kq = (j & 1) ? __uint_as_float(kpw & 0xffff0000u) : __uint_as_float(kpw << 16), vq = (j & 1) ? __uint_as_float(vpw & 0xffff0000u) : __uint_as_float(vpw << 16);
                    const float r = rc + (rq - rc) * mr[j], k = kc + (kq - kc) * mk[j];
                    float v = vc + (vq - vc) * mv[j];
                    const float wpre = w0[j] + cw[ni][j];
                    const float sp = (-wpre > 20.f) ? -wpre : 0.6931471805599453f * __builtin_amdgcn_logf(1.0f + __builtin_amdgcn_exp2f(wpre * -1.4426950408889634f));
                    const float decay = __builtin_amdgcn_exp2f(-1.4426950408889634f * __builtin_amdgcn_exp2f((-sp - 0.5f) * 1.4426950408889634f));
                    const float a = sigmoidf_(a0[j] + ca[ni][j]);
                    const float kk = k * kkc[j] * rn;
                    const float k2 = k * (1.0f + (a - 1.0f) * kac[j]);
                    if (l == 0) vf[j] = v; else v = v + (vf[j] - v) * sigmoidf_(v0[j] + cv[ni][j]);
                    o_r[j] = r; o_w[j] = decay; o_k[j] = k2; o_v[j] = v; o_a[j] = -kk; o_b[j] = kk * a;
                }
                if (l == 0) *(f32x4*)(p.vfirst + o) = vf;
                *(f32x4*)(p.sr + o) = o_r; *(f32x4*)(p.sw + o) = o_w; *(f32x4*)(p.sk + o) = o_k; *(f32x4*)(p.sv + o) = o_v; *(f32x4*)(p.sa + o) = o_a; *(f32x4*)(p.sb + o) = o_b; { uint2 gq; gq.x = cvtpk(cg[ni][0], cg[ni][1]); gq.y = cvtpk(cg[ni][2], cg[ni][3]); *(uint2*)((bf16_t*)p.sg + o) = gq; }
            }
        }
    }
}

#define MF4(a, b, c) __builtin_amdgcn_mfma_f32_16x16x4f32((a), (b), (c), 0, 0, 0)
#define WSYNC() asm volatile("s_waitcnt lgkmcnt(0)" ::: "memory")
__device__ __forceinline__ f32x4 mm16(const float* A, int sam, int sak, const float* B, int sbk, int sbn, int K, f32x4 acc, int fr, int fq) {
#pragma unroll 4
    for (int kk = 0; kk < K; kk += 4) { const float a = A[fr * sam + (kk + fq) * sak]; const float b = B[(kk + fq) * sbk + fr * sbn]; acc = MF4(a, b, acc); }
    return acc;
}
constexpr int CH_T = 16, CH_N = SEQ / CH_T, CH_LD = 68, CH_WAVE_FLOATS = 6 * 16 * CH_LD + 5 * 16 * 17 + 64;
__device__ __forceinline__ void ph_rwkv_chunkpre(const Params& pkv, KPtr kp_in, int wbase_in, int l, char* lds) {
    PH_HEAD
    const int tid = TID, lane = tid & 63, wv = tid >> 6, fr = lane & 15, fq = lane >> 4;
    if (wv >= 4) return;
    float* L = (float*)lds + wv * CH_WAVE_FLOATS;
    float* At = L; float* Bt = At + 16 * CH_LD; float* Kt = Bt + 16 * CH_LD; float* Rt = Kt + 16 * CH_LD; float* Vv = Rt + 16 * CH_LD; float* W1 = Vv + 16 * CH_LD;
    float* Pst = (float*)lds + 4 * CH_WAVE_FLOATS + wv * 1024;
    float* Aab = W1 + 16 * CH_LD; float* Aak = Aab + 16 * 17; float* Arb = Aak + 16 * 17; float* Ark = Arb + 16 * 17; float* Mm = Ark + 16 * 17; float* gT = Mm + 16 * 17;
    const f32x4 z4 = (f32x4){0.f, 0.f, 0.f, 0.f};
    float iw[CH_T], ia[CH_T], ib[CH_T], ik[CH_T], ir[CH_T], iv[CH_T];
#define CHP_LOAD(uu) do { const int u_ = ((uu) < 16 * CH_N) ? (uu) : (16 * CH_N - 1); const int bh_ = u_ / CH_N, c_ = u_ % CH_N; \
        const size_t o0_ = ((size_t)(bh_ >> 2) * SEQ + (size_t)c_ * CH_T) * 256 + (bh_ & 3) * 64 + lane; \
        _Pragma("unroll") for (int t = 0; t < CH_T; ++t) { const size_t o = o0_ + (size_t)t * 256; iw[t] = p.sw[o]; ia[t] = p.sa[o]; ib[t] = p.sb[o]; ik[t] = p.sk[o]; ir[t] = p.sr[o]; iv[t] = p.sv[o]; } } while (0)
    CHP_LOAD(BID * 4 + wv);
    for (int u = BID * 4 + wv; u < 16 * CH_N; u += gridDim.x * 4) {
        const int bh = u / CH_N, c = u % CH_N, b = bh >> 2, hd = bh & 3;
        (void)b; (void)hd; (void)c;
        WSYNC();
        {
            float g = 1.0f;
#pragma unroll
            for (int t = 0; t < CH_T; ++t) {
                const float w = iw[t], a = ia[t], bb = ib[t], k = ik[t], r = ir[t], v = iv[t];
                const float gp = g; g *= w; const float ig = 1.0f / g;
                At[t * CH_LD + lane] = a * gp; Bt[t * CH_LD + lane] = bb * ig; Kt[t * CH_LD + lane] = k * ig; Rt[t * CH_LD + lane] = r * g; Vv[t * CH_LD + lane] = v;
            }
            gT[lane] = g;
        }
        CHP_LOAD(u + gridDim.x * 4);
        WSYNC();
        {
            f32x4 gab = z4, gak = z4, grb = z4, grk = z4;
#pragma unroll
            for (int k0 = 0; k0 < 64; k0 += 32) {
                float aA[8], aR[8], bB[8], bK[8];
#pragma unroll
                for (int q = 0; q < 8; ++q) { const int o = fr * CH_LD + k0 + 4 * q + fq; aA[q] = At[o]; aR[q] = Rt[o]; bB[q] = Bt[o]; bK[q] = Kt[o]; }
                WSYNC(); __builtin_amdgcn_sched_barrier(0);
#pragma unroll
                for (int q = 0; q < 8; ++q) { gab = MF4(aA[q], bB[q], gab); gak = MF4(aA[q], bK[q], gak); grb = MF4(aR[q], bB[q], grb); grk = MF4(aR[q], bK[q], grk); }
            }
#pragma unroll
            for (int rg = 0; rg < 4; ++rg) {
                const int t = 4 * fq + rg, s = fr;
                Aab[t * 17 + s] = (s < t) ? gab[rg] : 0.f; Aak[t * 17 + s] = (s < t) ? gak[rg] : 0.f;
                Arb[t * 17 + s] = (s <= t) ? grb[rg] : 0.f; Ark[t * 17 + s] = (s <= t) ? grk[rg] : 0.f;
            }
        }
        WSYNC();
        {
            float m[16];
#pragma unroll
            for (int t = 0; t < 16; ++t) {
                float acc = (t == fr) ? 1.0f : 0.f;
#pragma unroll
                for (int s = 0; s < t; ++s) acc += Aab[t * 17 + s] * m[s];
                m[t] = acc;
            }
            if (fq == 0) {
#pragma unroll
                for (int t = 0; t < 16; ++t) Mm[t * 17 + fr] = m[t];
            }
        }
        WSYNC();
        {
            f32x4 m2 = z4, ah[4] = {z4, z4, z4, z4};
#pragma unroll
            for (int kk = 0; kk < 16; kk += 4) {
                const float a = Mm[fr * 17 + kk + fq];
                m2 = MF4(a, Aak[(kk + fq) * 17 + fr], m2);
#pragma unroll
                for (int nt = 0; nt < 4; ++nt) ah[nt] = MF4(a, At[(kk + fq) * CH_LD + 16 * nt + fr], ah[nt]);
            }
            WSYNC();
#pragma unroll
            for (int rg = 0; rg < 4; ++rg) {
                Aak[(4 * fq + rg) * 17 + fr] = m2[rg];
#pragma unroll
                for (int nt = 0; nt < 4; ++nt) At[(4 * fq + rg) * CH_LD + 16 * nt + fr] = ah[nt][rg];
            }
            WSYNC();
            f32x4 w1[4] = {z4, z4, z4, z4};
#pragma unroll
            for (int kk = 0; kk < 16; kk += 4) {
                const float a = Aak[fr * 17 + kk + fq];
#pragma unroll
                for (int nt = 0; nt < 4; ++nt) w1[nt] = MF4(a, Vv[(kk + fq) * CH_LD + 16 * nt + fr], w1[nt]);
            }
#pragma unroll
            for (int nt = 0; nt < 4; ++nt)
#pragma unroll
                for (int rg = 0; rg < 4; ++rg) W1[(4 * fq + rg) * CH_LD + 16 * nt + fr] = w1[nt][rg];
        }
        WSYNC();
        {
            float* rh = p.c_rh + (size_t)u * 1024; float* y1 = p.c_y1 + (size_t)u * 1024;
            f32x4 ar[4], yy[4];
#pragma unroll
            for (int nt = 0; nt < 4; ++nt) {
                yy[nt] = z4;
#pragma unroll
                for (int rg = 0; rg < 4; ++rg) ar[nt][rg] = Rt[(4 * fq + rg) * CH_LD + 16 * nt + fr];
            }
#pragma unroll
            for (int kk = 0; kk < 16; kk += 4) {
                const float arb = Arb[fr * 17 + kk + fq], ark = Ark[fr * 17 + kk + fq];
#pragma unroll
                for (int nt = 0; nt < 4; ++nt) {
                    const int bo = (kk + fq) * CH_LD + 16 * nt + fr;
                    ar[nt] = MF4(arb, At[bo], ar[nt]); yy[nt] = MF4(arb, W1[bo], yy[nt]); yy[nt] = MF4(ark, Vv[bo], yy[nt]);
                }
            }
#pragma unroll
            for (int nt = 0; nt < 4; ++nt)
#pragma unroll
                for (int rg = 0; rg < 4; ++rg) Pst[(nt * 64 + 16 * (fr >> 2) + 4 * fq + rg) * 4 + (fr & 3)] = ar[nt][rg];
            WSYNC();
#pragma unroll
            for (int i = 0; i < 4; ++i) *(f32x4*)(rh + (i * 64 + lane) * 4) = *(const f32x4*)(Pst + (i * 64 + lane) * 4);
            WSYNC();
#pragma unroll
            for (int nt = 0; nt < 4; ++nt)
#pragma unroll
                for (int rg = 0; rg < 4; ++rg) Pst[(nt * 64 + lane) * 4 + rg] = yy[nt][rg];
            WSYNC();
#pragma unroll
            for (int i = 0; i < 4; ++i) *(f32x4*)(y1 + (i * 64 + lane) * 4) = *(const f32x4*)(Pst + (i * 64 + lane) * 4);
            WSYNC();
        }
        {
            bf16_t* ppb = (bf16_t*)p.c_p + (size_t)u * 4096; bf16_t* qqb = (bf16_t*)p.c_q + (size_t)u * 4096;
#pragma unroll 1
            for (int jt = 0; jt < 4; ++jt) {
                f32x4 ap[4] = {z4, z4, z4, z4}, aq[4] = {z4, z4, z4, z4};
                {
                    float a_ah[4], a_w1[4], a_v[4], b_bt[4][4], b_kt[4][4];
#pragma unroll
                    for (int q = 0; q < 4; ++q) {
                        const int ao = (4 * q + fq) * CH_LD + 16 * jt + fr;
                        a_ah[q] = At[ao]; a_w1[q] = W1[ao]; a_v[q] = Vv[ao];
#pragma unroll
                        for (int jc = 0; jc < 4; ++jc) { const int bo = (4 * q + fq) * CH_LD + 16 * jc + fr; b_bt[q][jc] = Bt[bo]; b_kt[q][jc] = Kt[bo]; }
                    }
                    WSYNC(); __builtin_amdgcn_sched_barrier(0);
#pragma unroll
                    for (int q = 0; q < 4; ++q)
#pragma unroll
                        for (int jc = 0; jc < 4; ++jc) { ap[jc] = MF4(a_ah[q], b_bt[q][jc], ap[jc]); aq[jc] = MF4(a_w1[q], b_bt[q][jc], aq[jc]); aq[jc] = MF4(a_v[q], b_kt[q][jc], aq[jc]); }
                }
                WSYNC();
#pragma unroll
                for (int jc = 0; jc < 4; ++jc) {
                    const float gc = gT[16 * jc + fr];
#pragma unroll
                    for (int rg = 0; rg < 4; ++rg) {
                        const int row = 16 * jt + 4 * fq + rg, col = 16 * jc + fr;
                        (void)row; (void)col;
                        Pst[(jc * 64 + lane) * 4 + rg] = ap[jc][rg] * gc; aq[jc][rg] *= gc;
                    }
                }
                WSYNC();
#pragma unroll
                for (int i = 0; i < 4; ++i) { const f32x4 v = *(const f32x4*)(Pst + (i * 64 + lane) * 4); uint2 o; o.x = cvtpk(v[0], v[1]); o.y = cvtpk(v[2], v[3]);
                    *(uint2*)(ppb + ((jt * 4 + i) * 64 + lane) * 4) = o; }
                WSYNC();
#pragma unroll
                for (int jc = 0; jc < 4; ++jc)
#pragma unroll
                    for (int rg = 0; rg < 4; ++rg) Pst[(jc * 64 + 16 * (fr >> 2) + 4 * fq + rg) * 4 + (fr & 3)] = aq[jc][rg];
                WSYNC();
#pragma unroll
                for (int i = 0; i < 4; ++i) { const f32x4 v = *(const f32x4*)(Pst + (i * 64 + lane) * 4); uint2 o; o.x = cvtpk(v[0], v[1]); o.y = cvtpk(v[2], v[3]);
                    *(uint2*)(qqb + (size_t)jt * 1024 + (i * 64 + lane) * 4) = o; }
            }
            p.c_g[(size_t)u * 64 + lane] = gT[lane];
        }
    }
}

constexpr int SCANB_BLOCKS = 64;
__device__ __forceinline__ void ph_rwkv_scan(const Params& pkv, KPtr kp_in, int wbase_in, int l, char* lds) {
    PH_HEAD
    if (BID >= SCANB_BLOCKS) return;
    const int tid = TID, lane = tid & 63, wv = tid >> 6, fr = lane & 15, fq = lane >> 4, w = wv & 3;
    const int bh = (BID & 7) + 8 * (BID >> 5), ib = (BID >> 3) & 3, b = bh >> 2, hd = bh & 3, ibase = ib * 16;
    float* exch = (float*)lds;
    float* ypart = (float*)lds + 4096;
    for (int i = tid; i < 8192; i += NTHREADS) ((float*)lds)[i] = 0.f;
    const size_t ubase = (size_t)bh * CH_N;
    if (wv >= 4) {
        f32x4 rhf[2][4]; f32x4 y1v[2]; u32x4 sb[4]; f32x4 yacc;
#define SCANH_BAR() do { asm volatile("s_waitcnt lgkmcnt(0)" ::: "memory"); __builtin_amdgcn_s_barrier(); asm volatile("" ::: "memory"); } while (0)
#define SCANH_LOAD(S, cc) do { const size_t un_ = ubase + ((cc) < CH_N ? (cc) : CH_N - 1); \
        const float* rp_ = p.c_rh + un_ * 1024 + lane * 4;     \
        _Pragma("unroll") for (int kq = 0; kq < 4; ++kq) rhf[S][kq] = *(const f32x4*)(rp_ + 256 * kq); \
        y1v[S] = *(const f32x4*)(p.c_y1 + un_ * 1024 + (ib * 64 + lane) * 4); } while (0)
#define SCANH_CHUNK(S, cc, NB) do { \
        { const u32x4* ex = (const u32x4*)(exch + ((cc) & 1) * 2048) + lane; _Pragma("unroll") for (int kq = 0; kq < 4; ++kq) sb[kq] = ex[64 * kq]; } \
        if ((NB) >= 1) SCANH_BAR(); else asm volatile("s_waitcnt lgkmcnt(0)" ::: "memory"); \
        asm volatile("" : "+v"(rhf[S][0][0]), "+v"(rhf[S][0][1]), "+v"(rhf[S][0][2]), "+v"(rhf[S][0][3]), "+v"(rhf[S][1][0]), "+v"(rhf[S][1][1]), "+v"(rhf[S][1][2]), "+v"(rhf[S][1][3])); \
        asm volatile("" : "+v"(rhf[S][2][0]), "+v"(rhf[S][2][1]), "+v"(rhf[S][2][2]), "+v"(rhf[S][2][3]), "+v"(rhf[S][3][0]), "+v"(rhf[S][3][1]), "+v"(rhf[S][3][2]), "+v"(rhf[S][3][3])); \
        yacc = (f32x4){0.f, 0.f, 0.f, 0.f}; \
        _Pragma("unroll") for (int kq = 0; kq < 4; ++kq) { \
            const unsigned rx_ = cvtpk(rhf[S][kq][0], rhf[S][kq][1]), ry_ = cvtpk(rhf[S][kq][2], rhf[S][kq][3]); const u32x4 ra_ = (u32x4){rx_, ry_, rx_, ry_}; \
            yacc = __builtin_amdgcn_mfma_f32_16x16x32_bf16(__builtin_bit_cast(bf16x8, ra_), __builtin_bit_cast(bf16x8, sb[kq]), yacc, 0, 0, 0); } \
        if ((NB) >= 2) SCANH_BAR(); \
        { float* yo_ = p.sy + ((size_t)b * SEQ + (size_t)(cc) * CH_T + 4 * fq) * 256 + hd * 64 + ibase + fr; \
          _Pragma("unroll") for (int rg = 0; rg < 4; ++rg) yo_[rg * 256] = yacc[rg] + y1v[S][rg]; } \
        if ((NB) >= 3) SCANH_BAR(); \
        SCANH_LOAD(S, (cc) + 8); \
        if ((NB) >= 4) SCANH_BAR(); } while (0)
        SCANH_LOAD(0, w); SCANH_LOAD(1, w + 4);
        __syncthreads();
        for (int i = 0; i < w; ++i) SCANH_BAR();
        for (int oc = 0; oc < CH_N / 4; oc += 2) {
            SCANH_CHUNK(0, w + 4 * oc, 4);
            const int nb1 = (oc + 1 == CH_N / 4 - 1) ? 4 - w : 4;
            SCANH_CHUNK(1, w + 4 * (oc + 1), nb1);
        }
        return;
    }
    uint2 pa[8][4]; uint2 qv[8]; f32x4 gv[8]; f32x4 cur = (f32x4){0.f, 0.f, 0.f, 0.f};
#define BFLO(x) __uint_as_float((x) << 16)
#define BFHI(x) __uint_as_float((x) & 0xffff0000u)
#define SCAN_LOAD(S, cc) do { const size_t un_ = ubase + ((cc) < CH_N ? (cc) : CH_N - 1); \
        const uint2* pp_ = (const uint2*)((const bf16_t*)p.c_p + un_ * 4096 + (w * 64 + lane) * 4); \
        pa[S][0] = pp_[0]; pa[S][1] = pp_[256]; pa[S][2] = pp_[512]; pa[S][3] = pp_[768]; \
        qv[S] = *(const uint2*)((const bf16_t*)p.c_q + un_ * 4096 + ((ib * 4 + w) * 64 + lane) * 4); \
        gv[S] = *(const f32x4*)(p.c_g + un_ * 64 + 16 * w + 4 * fq); } while (0)
#define SCAN_STEP(S, SP, cc) do { const int bufo = ((cc) & 1) * 2048; \
        u32x4 ex4[4]; { const u32x4* ex = (const u32x4*)(exch + bufo) + lane; _Pragma("unroll") for (int kq = 0; kq < 4; ++kq) ex4[kq] = ex[64 * kq]; } \
        SCAN_LOAD(SP, (cc) + 7);     \
          \
        f32x4 acc0 = (f32x4){BFLO(qv[S].x), BFHI(qv[S].x), BFLO(qv[S].y), BFHI(qv[S].y)} + gv[S] * cur, acc1 = (f32x4){0.f, 0.f, 0.f, 0.f}; \
        _Pragma("unroll") for (int kq = 0; kq < 4; kq += 2) { \
            const u32x4 a0_ = (u32x4){pa[S][kq].x, pa[S][kq].y, pa[S][kq].x, pa[S][kq].y}, a1_ = (u32x4){pa[S][kq + 1].x, pa[S][kq + 1].y, pa[S][kq + 1].x, pa[S][kq + 1].y}; \
            acc0 = __builtin_amdgcn_mfma_f32_16x16x32_bf16(__builtin_bit_cast(bf16x8, a0_), __builtin_bit_cast(bf16x8, ex4[kq]), acc0, 0, 0, 0); \
            acc1 = __builtin_amdgcn_mfma_f32_16x16x32_bf16(__builtin_bit_cast(bf16x8, a1_), __builtin_bit_cast(bf16x8, ex4[kq + 1]), acc1, 0, 0, 0); } \
        const f32x4 nw_ = acc0 + acc1; cur = nw_; \
        { const unsigned h01 = cvtpk(nw_[0], nw_[1]), h23 = cvtpk(nw_[2], nw_[3]); \
          const unsigned l01 = cvtpk(nw_[0] - BFLO(h01), nw_[1] - BFHI(h01)), l23 = cvtpk(nw_[2] - BFLO(h23), nw_[3] - BFHI(h23)); \
          ((u32x4*)(exch + (2048 - bufo)))[w * 64 + lane] = (u32x4){h01, h23, l01, l23}; }     \
        asm volatile("s_waitcnt lgkmcnt(0)" ::: "memory"); __builtin_amdgcn_s_barrier(); asm volatile("" ::: "memory"); } while (0)
    SCAN_LOAD(0, 0); SCAN_LOAD(1, 1); SCAN_LOAD(2, 2); SCAN_LOAD(3, 3); SCAN_LOAD(4, 4); SCAN_LOAD(5, 5); SCAN_LOAD(6, 6); SCAN_LOAD(7, 7);
    __syncthreads();
    for (int c = 0; c < CH_N; c += 8) { SCAN_STEP(0, 7, c); SCAN_STEP(1, 0, c + 1); SCAN_STEP(2, 1, c + 2); SCAN_STEP(3, 2, c + 3); SCAN_STEP(4, 3, c + 4); SCAN_STEP(5, 4, c + 5); SCAN_STEP(6, 5, c + 6); SCAN_STEP(7, 6, c + 7); }
}

__device__ __forceinline__ void ph_mla_up(const Params& pkv, KPtr kp_in, int wbase_in, int l, char* lds) {
    PH_HEAD
    const int nq = (NT / 128) * 3, nkv = (NT / 128) * 4;
    const float SC = 0.10206207261596575f * 1.4426950408889634f;
    float* rsl = (float*)(lds + 40960);
    const int tid = TID;
    for (int u = BID; u < nq + nkv; u += gridDim.x) {
        const bool isq = u < nq;
        const int mt = isq ? u / 3 : (u - nq) / 4, t0 = mt * 128;
        const bf16_t* pbuf_ = p.pbuf; const float* tabm_ = p.tab_mla; bf16_t* mk_ = p.mk;
        auto pre = [=]() mutable {
            const int row = tid >> 2, part = tid & 3, ncol = isq ? 256 : 128, per = ncol / 4;
            const bf16_t* src = pbuf_ + (size_t)(t0 + row) * NINP + (isq ? PC_MQ : PC_MKV) + part * per;
            float ss = 0.f;
            u32x4 wq_[8];
#pragma unroll
            for (int q = 0; q < 8; ++q) wq_[q] = (q * 8 < per) ? *(const u32x4*)(src + q * 8) : (u32x4){0u, 0u, 0u, 0u};
#pragma unroll
            for (int q = 0; q < 8; ++q)
#pragma unroll
                for (int k = 0; k < 4; ++k) { const float a = __uint_as_float(wq_[q][k] << 16), b = __uint_as_float(wq_[q][k] & 0xffff0000u); ss += a * a + b * b; }
            ss += dpp_f<0xB1>(ss); ss += dpp_f<0x4E>(ss);
            __syncthreads();
            if (part == 0) rsl[row] = rsqrtf(ss / (float)ncol + 1e-6f);
            if (!isq && (u - nq) % 4 == 0) {
                float kc_[4], ks_[4], kx1_[4], kx2_[4];
#pragma unroll
                for (int q = 0; q < 4; ++q) {
                    const int e = tid + q * NTHREADS, rr = e >> 4, i = e & 15, t = t0 + rr, pos = t % SEQ;
                    const bf16_t* pr = pbuf_ + (size_t)t * NINP + PC_MKR;
                    kc_[q] = tabm_[(pos * 16 + i) * 2]; ks_[q] = tabm_[(pos * 16 + i) * 2 + 1]; kx1_[q] = bf2f(pr[i]); kx2_[q] = bf2f(pr[16 + i]);
                }
#pragma unroll
                for (int q = 0; q < 4; ++q) {
                    const int e = tid + q * NTHREADS, rr = e >> 4, i = e & 15, t = t0 + rr;
                    const bf16_t k1 = f2bf(kx1_[q] * kc_[q] - kx2_[q] * ks_[q]), k2 = f2bf(kx1_[q] * ks_[q] + kx2_[q] * kc_[q]);
#pragma unroll
                    for (int hd = 0; hd < 4; ++hd) { mk_[((size_t)t * 4 + hd) * 96 + 64 + i] = k1; mk_[((size_t)t * 4 + hd) * 96 + 80 + i] = k2; }
                }
            }
            __syncthreads();
        };
        if (isq) {
            const int nt = u % 3;
            bf16_t* mq = p.mq + (size_t)mt * 128 * 384 + nt * 128; const float* tab = p.tab_mla;
            gemm_tile128(p.pbuf + (size_t)mt * 128 * NINP + PC_MQ, NINP, nullptr, 128, p.wq_t + ((size_t)l * 384 + nt * 128) * 256, 256, 256, lds, TID, pre,
                         [=](int r, int c, f32x4 v0, f32x4 v1, u32x4 t0_, u32x4 t1_) mutable {
                             const float sc = rsl[r] * SC; v0 = v0 * sc; v1 = v1 * sc;
                             const int col = nt * 128 + c;
                             if ((col % 96) >= 64) {
                                 const f32x4 cs0 = __builtin_bit_cast(f32x4, t0_), cs1 = __builtin_bit_cast(f32x4, t1_);
                                 const f32x4 a = v0, b = v1;
                                 v0[0] = a[0] * cs0[0] - b[0] * cs0[1]; v1[0] = a[0] * cs0[1] + b[0] * cs0[0];
                                 v0[1] = a[1] * cs0[2] - b[1] * cs0[3]; v1[1] = a[1] * cs0[3] + b[1] * cs0[2];
                                 v0[2] = a[2] * cs1[0] - b[2] * cs1[1]; v1[2] = a[2] * cs1[1] + b[2] * cs1[0];
                                 v0[3] = a[3] * cs1[2] - b[3] * cs1[3]; v1[3] = a[3] * cs1[3] + b[3] * cs1[2];
                             }
                             uint2 o0, o1; o0.x = cvtpk(v0[0], v0[1]); o0.y = cvtpk(v0[2], v0[3]); o1.x = cvtpk(v1[0], v1[1]); o1.y = cvtpk(v1[2], v1[3]);
                             *(uint2*)(mq + (size_t)r * 384 + c) = o0; *(uint2*)(mq + (size_t)r * 384 + c + 16) = o1; },
                         [=](int r, int c, int which) {
                             const int col = nt * 128 + c;
                             if ((col % 96) >= 64) { const int i0 = (col % 96) - 64, pos = (t0 + r) % SEQ; return *(const u32x4*)(tab + (pos * 16 + i0) * 2 + 4 * which); }
                             return (u32x4){0u, 0u, 0u, 0u}; });
        } else {
            const int hd = (u - nq) % 4;
            bf16_t* mk = p.mk + ((size_t)mt * 128 * 4 + hd) * 96; bf16_t* mv = p.mv + ((size_t)mt * 128 * 4 + hd) * 64;
            gemm_tile128(p.pbuf + (size_t)mt * 128 * NINP + PC_MKV, NINP, nullptr, 128, p.wkv_t + ((size_t)l * 512 + hd * 128) * 128, 128, 128, lds, TID, pre,
                         [=](int r, int c, f32x4 v0, f32x4 v1, u32x4, u32x4) mutable {
                             const float sc = rsl[r]; v0 = v0 * sc; v1 = v1 * sc;
                             uint2 o0, o1; o0.x = cvtpk(v0[0], v0[1]); o0.y = cvtpk(v0[2], v0[3]); o1.x = cvtpk(v1[0], v1[1]); o1.y = cvtpk(v1[2], v1[3]);
                             if (c < 64) { *(uint2*)(mk + (size_t)r * 384 + c) = o0; *(uint2*)(mk + (size_t)r * 384 + c + 16) = o1; }
                             else { *(uint2*)(mv + (size_t)r * 256 + (c - 64)) = o0; *(uint2*)(mv + (size_t)r * 256 + (c - 64) + 16) = o1; } },
                         [](int, int, int) { return (u32x4){0u, 0u, 0u, 0u}; });
        }
    }
}


__device__ __forceinline__ void ph_mla_attn(const Params& pkv, KPtr kp_in, int wbase_in, int l, char* lds) {
    PH_HEAD
    constexpr int KSTR = 104, VSTR = 68;
    bf16_t* Ks = (bf16_t*)lds;
    bf16_t* Vt = Ks + 64 * KSTR;
    const int tid = TID, lane = tid & 63, wv = tid >> 6, r = lane & 31, h = lane >> 5;
    int* wq = p.wq + l * 16;
    volatile int* wslot = (volatile int*)(lds + 24576);
    for (;;) {
        __syncthreads();
        if (tid == 0) *wslot = atomicAdd(wq, 1);
        __syncthreads();
        const int it = __builtin_amdgcn_readfirstlane(*wslot);
        if (it >= 16 * 32) break;
        const int bh = it & 15, qb = 31 - (it >> 4);
        const int b = bh >> 2, hd = bh & 3, q0 = qb * 256;
        const int qmin = q0 + 32 * wv, qmax = qmin + 31, myq = qmin + r;
        bf16x8 qf[6];
        {
            const bf16_t* qrow = p.mq + ((size_t)(b * SEQ + myq) * 4 + hd) * 96 + 8 * h;
#pragma unroll
            for (int s = 0; s < 6; ++s) qf[s] = *(const bf16x8*)(qrow + 16 * s);
        }
        f32x16 o0, o1;
#pragma unroll
        for (int i = 0; i < 16; ++i) { o0[i] = 0.f; o1[i] = 0.f; }
        float m = -1e30f, lsum = 0.f;
        const int nkt = (q0 + 256) / 64;
        const int kk0 = tid / 12, kc0 = tid % 12, kk1 = (tid + 512) / 12, kc1 = (tid + 512) % 12;
        const int vk = tid & 63, vc = tid >> 6;
        const bf16_t* kbase = p.mk + ((size_t)b * SEQ * 4 + hd) * 96;
        const bf16_t* vbase = p.mv + ((size_t)b * SEQ * 4 + hd) * 64;
        u32x4 rk0, rk1, rv;
        rk0 = *(const u32x4*)(kbase + (size_t)kk0 * 384 + kc0 * 8);
        rk1 = (tid < 256) ? *(const u32x4*)(kbase + (size_t)kk1 * 384 + kc1 * 8) : (u32x4){0u, 0u, 0u, 0u};
        rv = *(const u32x4*)(vbase + (size_t)vk * 256 + vc * 8);
        for (int kt = 0; kt < nkt; ++kt) {
            __syncthreads();
            *(u32x4*)(Ks + kk0 * KSTR + kc0 * 8) = rk0;
            if (tid < 256) *(u32x4*)(Ks + kk1 * KSTR + kc1 * 8) = rk1;
            {
                const unsigned w0 = rv[0], w1 = rv[1], w2 = rv[2], w3 = rv[3];
                bf16_t* vd = Vt + (vc * 8) * VSTR + vk;
                vd[0] = (bf16_t)(w0 & 0xffff); vd[VSTR] = (bf16_t)(w0 >> 16); vd[2 * VSTR] = (bf16_t)(w1 & 0xffff); vd[3 * VSTR] = (bf16_t)(w1 >> 16);
                vd[4 * VSTR] = (bf16_t)(w2 & 0xffff); vd[5 * VSTR] = (bf16_t)(w2 >> 16); vd[6 * VSTR] = (bf16_t)(w3 & 0xffff); vd[7 * VSTR] = (bf16_t)(w3 >> 16);
            }
            __syncthreads();
            if (kt + 1 < nkt) {
                const size_t ko = (size_t)(kt + 1) * 64;
                rk0 = *(const u32x4*)(kbase + (ko + kk0) * 384 + kc0 * 8);
                if (tid < 256) rk1 = *(const u32x4*)(kbase + (ko + kk1) * 384 + kc1 * 8);
                rv = *(const u32x4*)(vbase + (ko + vk) * 256 + vc * 8);
            }
            const int kb = kt * 64;
            if (kb <= qmax) {
                const bool need1 = (kb + 32 <= qmax);
                f32x16 s0, s1;
#pragma unroll
                for (int i = 0; i < 16; ++i) { s0[i] = 0.f; s1[i] = -1e30f; }
#pragma unroll
                for (int s = 0; s < 6; ++s) { const bf16x8 kf = *(const bf16x8*)(Ks + r * KSTR + 16 * s + 8 * h); s0 = __builtin_amdgcn_mfma_f32_32x32x16_bf16(kf, qf[s], s0, 0, 0, 0); }
                if (need1) {
#pragma unroll
                    for (int i = 0; i < 16; ++i) s1[i] = 0.f;
#pragma unroll
                    for (int s = 0; s < 6; ++s) { const bf16x8 kf = *(const bf16x8*)(Ks + (32 + r) * KSTR + 16 * s + 8 * h); s1 = __builtin_amdgcn_mfma_f32_32x32x16_bf16(kf, qf[s], s1, 0, 0, 0); }
                }
                if (kb + 63 > qmin) {
#pragma unroll
                    for (int i = 0; i < 16; ++i) {
                        const int key = kb + (i & 3) + 8 * (i >> 2) + 4 * h;
                        if (key > myq) s0[i] = -1e30f;
                        if (key + 32 > myq) s1[i] = -1e30f;
                    }
                }
                float mx = s0[0];
#pragma unroll
                for (int i = 1; i < 16; ++i) mx = fmaxf(mx, s0[i]);
#pragma unroll
                for (int i = 0; i < 16; ++i) mx = fmaxf(mx, s1[i]);
                mx = xhalf_max(mx);
                const float mn = fmaxf(m, mx), alpha = __builtin_amdgcn_exp2f(m - mn);
                m = mn;
                float ps = 0.f;
#pragma unroll
                for (int i = 0; i < 16; ++i) { s0[i] = __builtin_amdgcn_exp2f(s0[i] - mn); ps += s0[i]; }
                if (need1) {
#pragma unroll
                    for (int i = 0; i < 16; ++i) { s1[i] = __builtin_amdgcn_exp2f(s1[i] - mn); ps += s1[i]; }
                }
                lsum = lsum * alpha + ps;
                if (!__all(alpha == 1.0f)) {
#pragma unroll
                    for (int i = 0; i < 16; ++i) { o0[i] *= alpha; o1[i] *= alpha; }
                }
#pragma unroll
                for (int s = 0; s < 2; ++s) {
                    u32x4 pw; pw[0] = cvtpk(s0[8 * s], s0[8 * s + 1]); pw[1] = cvtpk(s0[8 * s + 2], s0[8 * s + 3]); pw[2] = cvtpk(s0[8 * s + 4], s0[8 * s + 5]); pw[3] = cvtpk(s0[8 * s + 6], s0[8 * s + 7]);
                    const bf16x8 pf = __builtin_bit_cast(bf16x8, pw);
                    const bf16_t* va = Vt + r * VSTR + 16 * s + 4 * h;
                    const s16x4 a0 = *(const s16x4*)(va), a1 = *(const s16x4*)(va + 8), b0 = *(const s16x4*)(va + 32 * VSTR), b1 = *(const s16x4*)(va + 32 * VSTR + 8);
                    o0 = __builtin_amdgcn_mfma_f32_32x32x16_bf16(__builtin_shufflevector(a0, a1, 0, 1, 2, 3, 4, 5, 6, 7), pf, o0, 0, 0, 0);
                    o1 = __builtin_amdgcn_mfma_f32_32x32x16_bf16(__builtin_shufflevector(b0, b1, 0, 1, 2, 3, 4, 5, 6, 7), pf, o1, 0, 0, 0);
                }
                if (need1) {
#pragma unroll
                    for (int s = 0; s < 2; ++s) {
                        u32x4 pw; pw[0] = cvtpk(s1[8 * s], s1[8 * s + 1]); pw[1] = cvtpk(s1[8 * s + 2], s1[8 * s + 3]); pw[2] = cvtpk(s1[8 * s + 4], s1[8 * s + 5]); pw[3] = cvtpk(s1[8 * s + 6], s1[8 * s + 7]);
                        const bf16x8 pf = __builtin_bit_cast(bf16x8, pw);
                        const bf16_t* va = Vt + r * VSTR + 32 + 16 * s + 4 * h;
                        const s16x4 a0 = *(const s16x4*)(va), a1 = *(const s16x4*)(va + 8), b0 = *(const s16x4*)(va + 32 * VSTR), b1 = *(const s16x4*)(va + 32 * VSTR + 8);
                        o0 = __builtin_amdgcn_mfma_f32_32x32x16_bf16(__builtin_shufflevector(a0, a1, 0, 1, 2, 3, 4, 5, 6, 7), pf, o0, 0, 0, 0);
                        o1 = __builtin_amdgcn_mfma_f32_32x32x16_bf16(__builtin_shufflevector(b0, b1, 0, 1, 2, 3, 4, 5, 6, 7), pf, o1, 0, 0, 0);
                    }
                }
            }
        }
        const float inv = 1.0f / xhalf_sum(lsum);
        bf16_t* op = (bf16_t*)p.mo + (size_t)(b * SEQ + myq) * 256 + hd * 64 + 4 * h;
#pragma unroll
        for (int g = 0; g < 4; ++g) {
            uint2 w0; w0.x = cvtpk(o0[4 * g] * inv, o0[4 * g + 1] * inv); w0.y = cvtpk(o0[4 * g + 2] * inv, o0[4 * g + 3] * inv);
            uint2 w1; w1.x = cvtpk(o1[4 * g] * inv, o1[4 * g + 1] * inv); w1.y = cvtpk(o1[4 * g + 2] * inv, o1[4 * g + 3] * inv);
            *(uint2*)(op + 8 * g) = w0; *(uint2*)(op + 32 + 8 * g) = w1;
        }
        __syncthreads();
    }
}

__device__ __forceinline__ void ph_finalize_mix(const Params& pkv, KPtr kp_in, int wbase_in, int l) {
    PH_HEAD
    const int lane = TID & 63, gw = BID * (NTHREADS / 64) + (TID >> 6), nw = gridDim.x * (NTHREADS / 64);
    const int c = lane * 4, h = lane >> 4;
    const float4 gd = *(const float4*)(p.dil_norm_g + l * 256 + c), gm = *(const float4*)(p.mla_out_norm_g + l * 256 + c);
    const float4 lg = *(const float4*)(p.rwkv_ln_g + l * 256 + c), lb = *(const float4*)(p.rwkv_ln_b + l * 256 + c), rk = *(const float4*)(p.rwkv_r_k + l * 256 + c);
    float nl0, nl1, nl2; uint2 nd0, nd1, nd2, nsg, nmo; float4 nsy, nsr, nsk, nsv;
    auto load = [&](int t) {
        nl0 = p.dlse[((size_t)0 * NT + t) * 4 + h]; nl1 = p.dlse[((size_t)1 * NT + t) * 4 + h]; nl2 = p.dlse[((size_t)2 * NT + t) * 4 + h];
        nd0 = *(const uint2*)((const bf16_t*)p.dob + ((size_t)0 * NT + t) * 256 + c); nd1 = *(const uint2*)((const bf16_t*)p.dob + ((size_t)1 * NT + t) * 256 + c); nd2 = *(const uint2*)((const bf16_t*)p.dob + ((size_t)2 * NT + t) * 256 + c);
        const size_t o4 = (size_t)t * 256 + c;
        nsy = *(const float4*)(p.sy + o4); nsr = *(const float4*)(p.sr + o4); nsk = *(const float4*)(p.sk + o4); nsv = *(const float4*)(p.sv + o4); nsg = *(const uint2*)((const bf16_t*)p.sg + o4);
        nmo = *(const uint2*)((const bf16_t*)p.mo + o4);
    };
    int t = gw;
    if (t < NT) load(t);
    for (; t < NT; t += nw) {
        const float l0 = nl0, l1 = nl1, l2 = nl2; const float4 y = nsy, r = nsr, k = nsk, vv = nsv;
#define UNPK4(u_) make_float4(__uint_as_float((u_).x << 16), __uint_as_float((u_).x & 0xffff0000u), __uint_as_float((u_).y << 16), __uint_as_float((u_).y & 0xffff0000u))
        const float4 v0 = UNPK4(nd0), v1 = UNPK4(nd1), v2 = UNPK4(nd2), g = UNPK4(nsg), mo = UNPK4(nmo);
        if (t + nw < NT) load(t + nw);
        bf16_t* outp = p.mixcat + (size_t)t * 1024;
        {
            const float lm = fmaxf(l0, fmaxf(l1, l2));
            float w0 = __builtin_amdgcn_exp2f(l0 - lm), w1 = __builtin_amdgcn_exp2f(l1 - lm), w2 = __builtin_amdgcn_exp2f(l2 - lm);
            const float wi = __builtin_amdgcn_rcpf(w0 + w1 + w2); w0 *= wi; w1 *= wi; w2 *= wi;
            float4 v; v.x = w0 * v0.x + w1 * v1.x + w2 * v2.x; v.y = w0 * v0.y + w1 * v1.y + w2 * v2.y; v.z = w0 * v0.z + w1 * v1.z + w2 * v2.z; v.w = w0 * v0.w + w1 * v1.w + w2 * v2.w;
            const float ss = wave_sum(v.x * v.x + v.y * v.y + v.z * v.z + v.w * v.w);
            const float rs = rsqrtf(ss * (1.0f / 256.0f) + 1e-6f);
            uint2 o; o.x = cvtpk(v.x * rs * gd.x, v.y * rs * gd.y); o.y = cvtpk(v.z * rs * gd.z, v.w * rs * gd.w);
            *(uint2*)(outp + 256 + c) = o;
        }
        {
            const float mean = grp16_sum(y.x + y.y + y.z + y.w) * (1.0f / 64.0f);
            const float dx = y.x - mean, dy = y.y - mean, dz = y.z - mean, dw = y.w - mean;
            const float var = grp16_sum(dx * dx + dy * dy + dz * dz + dw * dw) * (1.0f / 64.0f);
            const float rs = rsqrtf(var + 64e-5f);
            const float bonus = grp16_sum(r.x * k.x * rk.x + r.y * k.y * rk.y + r.z * k.z * rk.z + r.w * k.w * rk.w);
            uint2 o;
            o.x = cvtpk((dx * rs * lg.x + lb.x + bonus * vv.x) * g.x, (dy * rs * lg.y + lb.y + bonus * vv.y) * g.y);
            o.y = cvtpk((dz * rs * lg.z + lb.z + bonus * vv.z) * g.z, (dw * rs * lg.w + lb.w + bonus * vv.w) * g.w);
            *(uint2*)(outp + 512 + c) = o;
        }
        {
            const float ss = wave_sum(mo.x * mo.x + mo.y * mo.y + mo.z * mo.z + mo.w * mo.w);
            const float rs = rsqrtf(ss * (1.0f / 256.0f) + 1e-6f);
            uint2 o; o.x = cvtpk(mo.x * rs * gm.x, mo.y * rs * gm.y); o.y = cvtpk(mo.z * rs * gm.z, mo.w * rs * gm.w);
            *(uint2*)(outp + 768 + c) = o;
        }
    }
}

__device__ __forceinline__ void ph_outproj(const Params& pkv, KPtr kp_in, int wbase_in, int l, char* lds) {
    PH_HEAD
    const bf16_t* xin = p.xb; bf16_t* y1 = (bf16_t*)p.y1;
    const bf16_t* Bt = p.wout_t + (size_t)l * 1024 * 1024;
    const int nunits = (NT / 256) * 4;
    bool pre = false;
    XU_LOOP(NT / 256, 4) {
        const int u = XU_UNIT();
        const int mt = u >> 2, nt = u & 3, un = XU_NEXT_UNIT();
        G8Next nx; nx.valid = 0; nx.rowidx = nullptr; nx.nvalid = 256; nx.A = p.mixcat + (size_t)(un >> 2) * 256 * 1024; nx.Bt = Bt + (size_t)(un & 3) * 256 * 1024; nx.perm = 1;
        const size_t o0 = (size_t)mt * 256 * 1024 + nt * 256;
        gemm_tile256(p.mixcat + (size_t)mt * 256 * 1024, 1024, nullptr, 256, Bt + (size_t)nt * 256 * 1024, 1024, 1024, lds, wbase_in, pre, nx, true, G8Out{y1 + o0, 1024, 256, 0}, nullptr,
                     [=](int r, int c, f32x4 v0, f32x4 v1, u32x4 xr) mutable {
                         v0[0] += ALPHA * __uint_as_float(xr[0] << 16); v0[1] += ALPHA * __uint_as_float(xr[0] & 0xffff0000u); v0[2] += ALPHA * __uint_as_float(xr[1] << 16); v0[3] += ALPHA * __uint_as_float(xr[1] & 0xffff0000u);
                         v1[0] += ALPHA * __uint_as_float(xr[2] << 16); v1[1] += ALPHA * __uint_as_float(xr[2] & 0xffff0000u); v1[2] += ALPHA * __uint_as_float(xr[3] << 16); v1[3] += ALPHA * __uint_as_float(xr[3] & 0xffff0000u);
                         u32x4 o; o[0] = cvtpk(v0[0], v0[1]); o[1] = cvtpk(v0[2], v0[3]); o[2] = cvtpk(v1[0], v1[1]); o[3] = cvtpk(v1[2], v1[3]); return o; },
                     [=](int r, int c) { return *(const u32x4*)(xin + o0 + (size_t)r * 1024 + c); });
        pre = nx.valid != 0;
    }
}

__device__ __forceinline__ void ph_ln1_router(const Params& pkv, KPtr kp_in, int wbase_in, int l, char* lds) {
    PH_HEAD
    constexpr int WSTR = 2064;
    char* Whi = lds;
    char* Wlo = lds + 32 * WSTR;
    int* hist = (int*)(lds + 64 * WSTR);
    int* base = hist + 32;
    int* le = base + 32;
    float* lgt = (float*)(le + 512);
    int* lrank = (int*)(lgt + 512);
    float* cpart = (float*)(lrank + 512);
    float* cvec = cpart + 512;
    const int tid = TID, lane = tid & 63, wv = tid >> 6, fr = lane & 15, fq = lane >> 4;
    const float* g1 = p.ln1_g + l * 1024; const float* b1 = p.ln1_b + l * 1024;
    const float* rw = p.router_w + (size_t)l * 1024 * 32; const float* rb = p.router_b + l * 32;
    __syncthreads();
    {
        float cp = 0.f;
        const int e = tid & 31;
#pragma unroll 1
        for (int jb = 0; jb < 1024 * 32 / NTHREADS; jb += 16) {
            float w_[16], g_[16], b_[16];
#pragma unroll
            for (int u = 0; u < 16; ++u) { const int i = tid + (jb + u) * NTHREADS, k = i >> 5; w_[u] = rw[i]; g_[u] = g1[k]; b_[u] = b1[k]; }
#pragma unroll
            for (int u = 0; u < 16; ++u) {
                const int k = (tid + (jb + u) * NTHREADS) >> 5;
                const float wg = w_[u] * g_[u];
                cp = fmaf(b_[u], w_[u], cp);
                const unsigned h = cvtpk(wg, 0.f) & 0xffffu; const float hf = __uint_as_float(h << 16);
                const unsigned lo = cvtpk(wg - hf, 0.f) & 0xffffu;
                *(unsigned short*)(Whi + e * WSTR + k * 2) = (unsigned short)h; *(unsigned short*)(Wlo + e * WSTR + k * 2) = (unsigned short)lo;
            }
        }
        cpart[(tid >> 5) * 32 + e] = cp;
    }
    float4 gg[4], bb[4];
#pragma unroll
    for (int m = 0; m < 4; ++m) { gg[m] = *(const float4*)(g1 + m * 256 + lane * 4); bb[m] = *(const float4*)(b1 + m * 256 + lane * 4); }
    __syncthreads();
    if (tid < 32) { float c = rb[tid]; for (int j = 0; j < 16; ++j) c += cpart[j * 32 + tid]; cvec[tid] = c; }
    for (int tb = BID * 128; tb < NT; tb += gridDim.x * 128) {
        __syncthreads();
        if (tid < 32) hist[tid] = 0;
        __syncthreads();
        const bf16_t* y1b = (const bf16_t*)p.y1;
        float rs_ = 0.f, nm_ = 0.f;
        {
            uint2 yn[4];
#pragma unroll
            for (int m = 0; m < 4; ++m) yn[m] = *(const uint2*)(y1b + (size_t)(tb + wv) * 1024 + m * 256 + lane * 4);
            for (int tt = wv; tt < 128; tt += 8) {
                const int t = tb + tt;
                float4 y[4]; float s = 0.f;
#pragma unroll
                for (int m = 0; m < 4; ++m) { y[m].x = __uint_as_float(yn[m].x << 16); y[m].y = __uint_as_float(yn[m].x & 0xffff0000u); y[m].z = __uint_as_float(yn[m].y << 16); y[m].w = __uint_as_float(yn[m].y & 0xffff0000u); s += (y[m].x + y[m].y) + (y[m].z + y[m].w); }
                {
                    const int t2 = tb + ((tt + 8 < 128) ? tt + 8 : tt);
#pragma unroll
                    for (int m = 0; m < 4; ++m) yn[m] = *(const uint2*)(y1b + (size_t)t2 * 1024 + m * 256 + lane * 4);
                }
                const float mean = wave_sum(s) * (1.0f / 1024.0f);
                float q = 0.f;
#pragma unroll
                for (int m = 0; m < 4; ++m) { y[m].x -= mean; y[m].y -= mean; y[m].z -= mean; y[m].w -= mean; q += (y[m].x * y[m].x + y[m].y * y[m].y) + (y[m].z * y[m].z + y[m].w * y[m].w); }
                const float rs = rsqrtf(wave_sum(q) * (1.0f / 1024.0f) + 1e-5f);
                if (fr == ((tt - wv) >> 3)) { rs_ = rs; nm_ = -mean * rs; }
#pragma unroll
                for (int m = 0; m < 4; ++m) {
                    const int c = m * 256 + lane * 4;
                    uint2 ob; ob.x = cvtpk(y[m].x * rs * gg[m].x + bb[m].x, y[m].y * rs * gg[m].y + bb[m].y); ob.y = cvtpk(y[m].z * rs * gg[m].z + bb[m].z, y[m].w * rs * gg[m].w + bb[m].w);
                    *(uint2*)(p.x1b + (size_t)t * 1024 + c) = ob;
                }
            }
        }
        f32x4 acc0 = (f32x4){0.f, 0.f, 0.f, 0.f}, acc1 = acc0;
        {
            const bf16_t* yrow = y1b + (size_t)(tb + wv + 8 * fr) * 1024 + 8 * fq;
            const char* wh0 = Whi + fr * WSTR + fq * 16; const char* wl0 = Wlo + fr * WSTR + fq * 16;
            u32x4 ya[4], yb2[4];
#pragma unroll
            for (int j = 0; j < 4; ++j) ya[j] = *(const u32x4*)(yrow + 32 * j);
#define LN1_KSTEP(RAW, ks) do { \
            const u32x4 raw_ = (RAW); float n_[8]; \
            _Pragma("unroll") for (int q_ = 0; q_ < 4; ++q_) { n_[2 * q_] = fmaf(__uint_as_float(raw_[q_] << 16), rs_, nm_); n_[2 * q_ + 1] = fmaf(__uint_as_float(raw_[q_] & 0xffff0000u), rs_, nm_); } \
            u32x4 ah_, al_; \
            _Pragma("unroll") for (int q_ = 0; q_ < 4; ++q_) { ah_[q_] = cvtpk(n_[2 * q_], n_[2 * q_ + 1]); al_[q_] = cvtpk(n_[2 * q_] - __uint_as_float(ah_[q_] << 16), n_[2 * q_ + 1] - __uint_as_float(ah_[q_] & 0xffff0000u)); } \
            const bf16x8 fah_ = __builtin_bit_cast(bf16x8, ah_), fal_ = __builtin_bit_cast(bf16x8, al_); \
            const bf16x8 wh0_ = *(const bf16x8*)(wh0 + (ks) * 64), wh1_ = *(const bf16x8*)(wh0 + 16 * WSTR + (ks) * 64); \
            const bf16x8 wl0_ = *(const bf16x8*)(wl0 + (ks) * 64), wl1_ = *(const bf16x8*)(wl0 + 16 * WSTR + (ks) * 64); \
            acc0 = __builtin_amdgcn_mfma_f32_16x16x32_bf16(fah_, wh0_, acc0, 0, 0, 0); acc1 = __builtin_amdgcn_mfma_f32_16x16x32_bf16(fah_, wh1_, acc1, 0, 0, 0); \
            acc0 = __builtin_amdgcn_mfma_f32_16x16x32_bf16(fal_, wh0_, acc0, 0, 0, 0); acc1 = __builtin_amdgcn_mfma_f32_16x16x32_bf16(fal_, wh1_, acc1, 0, 0, 0); \
            acc0 = __builtin_amdgcn_mfma_f32_16x16x32_bf16(fah_, wl0_, acc0, 0, 0, 0); acc1 = __builtin_amdgcn_mfma_f32_16x16x32_bf16(fah_, wl1_, acc1, 0, 0, 0); } while (0)
#pragma unroll
            for (int kg = 0; kg < 8; kg += 2) {
#pragma unroll
                for (int j = 0; j < 4; ++j) yb2[j] = *(const u32x4*)(yrow + 32 * (4 * (kg + 1) + j));
#pragma unroll
                for (int j = 0; j < 4; ++j) LN1_KSTEP(ya[j], 4 * kg + j);
                if (kg + 2 < 8) {
#pragma unroll
                    for (int j = 0; j < 4; ++j) ya[j] = *(const u32x4*)(yrow + 32 * (4 * (kg + 2) + j));
                }
#pragma unroll
                for (int j = 0; j < 4; ++j) LN1_KSTEP(yb2[j], 4 * (kg + 1) + j);
            }
        }
        {
            const float c0 = cvec[fr], c1 = cvec[16 + fr];
#pragma unroll
            for (int r = 0; r < 4; ++r) {
                const int tt = wv + 8 * (4 * fq + r);
                float l0 = acc0[r] + c0, l1 = acc1[r] + c1;
                int idx[4]; float val[4];
#pragma unroll
                for (int k = 0; k < 4; ++k) {
                    float mx = fmaxf(l0, l1);
                    mx = fmaxf(mx, dpp_f<0x128>(mx)); mx = fmaxf(mx, dpp_f<0x124>(mx)); mx = fmaxf(mx, dpp_f<0x122>(mx)); mx = fmaxf(mx, dpp_f<0x121>(mx));
                    float ci = (l0 == mx) ? (float)(31 - fr) : ((l1 == mx) ? (float)(15 - fr) : -1.0f);
                    ci = fmaxf(ci, dpp_f<0x128>(ci)); ci = fmaxf(ci, dpp_f<0x124>(ci)); ci = fmaxf(ci, dpp_f<0x122>(ci)); ci = fmaxf(ci, dpp_f<0x121>(ci));
                    const int bi = 31 - (int)ci;
                    idx[k] = bi; val[k] = mx;
                    if (fr == (bi & 15)) { if (bi < 16) l0 = -3.0e38f; else l1 = -3.0e38f; }
                }
                const float e1 = __expf(val[1] - val[0]), e2 = __expf(val[2] - val[0]), e3 = __expf(val[3] - val[0]);
                const float inv = 1.0f / (1.0f + e1 + e2 + e3);
                if (fr < 4) {
                    int ee = idx[0]; float gv = inv;
                    if (fr == 1) { ee = idx[1]; gv = e1 * inv; } else if (fr == 2) { ee = idx[2]; gv = e2 * inv; } else if (fr == 3) { ee = idx[3]; gv = e3 * inv; }
                    le[tt * 4 + fr] = ee; lgt[tt * 4 + fr] = gv;
                    lrank[tt * 4 + fr] = atomicAdd(&hist[ee], 1);
                }
            }
        }
        __syncthreads();
        if (tid < 32) base[tid] = atomicAdd(&p.cnt[l * NE + tid], hist[tid]);
        __syncthreads();
        {
            const int tt = tid >> 2, t = tb + tt, e = le[tid], pos = base[e] + lrank[tid];
            p.toke[(size_t)t * 4 + (tid & 3)] = e; p.tokpos[(size_t)t * 4 + (tid & 3)] = pos;
            p.rowtok[(size_t)e * NT + pos] = t; p.rowgate[(size_t)e * NT + pos] = lgt[tid];
        }
    }
}

__device__ __forceinline__ void moe_tile_prefix(KRef p, int l, int* tb  , const int TID) {
    __syncthreads();
    if (TID == 0) { int a = 0; for (int e = 0; e < NE; ++e) { tb[e] = a; a += (p.cnt[l * NE + e] + MOE_TM - 1) / MOE_TM; } tb[NE] = a; }
    __syncthreads();
}
struct MoeUnit { int e, mt, mtg, nt, nvalid; };
__device__ __forceinline__ MoeUnit moe_decode(const int* tb, const int* cnt, int u, int ntshift) {
    MoeUnit m; m.mtg = u >> ntshift; m.nt = u & ((1 << ntshift) - 1);
    int e = 0; while (tb[e + 1] <= m.mtg) ++e;
    m.e = __builtin_amdgcn_readfirstlane(e);
    m.mt = __builtin_amdgcn_readfirstlane(m.mtg - tb[m.e]);
    const int c = __builtin_amdgcn_readfirstlane(cnt[m.e]);
    m.nvalid = min(MOE_TM, c - m.mt * MOE_TM);
    return m;
}
__device__ __forceinline__ void ph_moe_gu(const Params& pkv, KPtr kp_in, int wbase_in, int l, char* lds) {
    PH_HEAD
    int* tb = (int*)(lds + 132096);
    moe_tile_prefix(p, l, tb, TID);
    const int ntile = __builtin_amdgcn_readfirstlane(tb[NE]), nunits = ntile * 8;
    const int* cnt = p.cnt + l * NE;
    bool pre = false;
    const int xg_x = BID & 7, xg_nb = gridDim.x >> 3, xg_own = (ntile - (xg_x >> 1) + 3) >> 2;
    for (int xv = BID >> 3; xv < xg_own * 4; xv += xg_nb) {
        const int u = ((xg_x >> 1) + 4 * (xv >> 2)) * 8 + (xg_x & 1) * 4 + (xv & 3);
        const MoeUnit m = moe_decode(tb, cnt, u, 3);
        const int un = u;
        G8Next nx; nx.valid = 0; nx.A = p.x1b; nx.rowidx = nullptr; nx.Bt = nullptr; nx.nvalid = 0;
        if (nx.valid) { const MoeUnit m2 = moe_decode(tb, cnt, un, 3); nx.rowidx = p.rowtok + (size_t)m2.e * NT + m2.mt * MOE_TM; nx.nvalid = m2.nvalid; nx.Bt = p.wgu_t + (((size_t)l * NE + m2.e) * 2048 + m2.nt * 256) * 1024; } nx.perm = 1;
        const float* bias = p.b_gu + ((size_t)l * NE + m.e) * 2048 + m.nt * 256;
        bf16_t* out = p.act + (size_t)m.mtg * MOE_TM * 1024 + m.nt * 128;
        gemm_tile256(p.x1b, 1024, p.rowtok + (size_t)m.e * NT + m.mt * MOE_TM, m.nvalid, p.wgu_t + (((size_t)l * NE + m.e) * 2048 + m.nt * 256) * 1024, 1024, 1024, lds, wbase_in, pre, nx, true, G8Out{out, 1024, 128}, bias,
                     [=](int r, int c, f32x4 va, f32x4 vb, u32x4) mutable {
                         uint2 o;
#pragma unroll
                         for (int hh = 0; hh < 2; ++hh) {
                             const f32x4 v = hh ? vb : va;
                             const float g0 = fminf(v[0], 7.0f), l0 = __builtin_amdgcn_fmed3f(v[1], -7.0f, 7.0f), g1 = fminf(v[2], 7.0f), l1 = __builtin_amdgcn_fmed3f(v[3], -7.0f, 7.0f);
                             const float a0 = g0 * sigmoidf_(1.702f * g0) * (l0 + 1.0f), a1 = g1 * sigmoidf_(1.702f * g1) * (l1 + 1.0f);
                             if (hh) o.y = cvtpk(a0, a1); else o.x = cvtpk(a0, a1);
                         }
                         return (u32x4){o.x, o.y, 0u, 0u}; },
                     [](int, int) { return (u32x4){0u, 0u, 0u, 0u}; });
        pre = nx.valid != 0;
    }
}
__device__ __forceinline__ void ph_moe_dn(const Params& pkv, KPtr kp_in, int wbase_in, int l, char* lds) {
    PH_HEAD
    int* tb = (int*)(lds + 132096);
    moe_tile_prefix(p, l, tb, TID);
    const int ntile = __builtin_amdgcn_readfirstlane(tb[NE]), nunits = ntile * 4;
    const int* cnt = p.cnt + l * NE;
    bool pre = false;
    XU_LOOP(ntile, 4) {
        const int u = XU_UNIT();
        const MoeUnit m = moe_decode(tb, cnt, u, 2);
        const int un = XU_NEXT_UNIT();
        G8Next nx; nx.valid = 0; nx.A = nullptr; nx.rowidx = nullptr; nx.Bt = nullptr; nx.nvalid = 256;
        if (nx.valid) { const MoeUnit m2 = moe_decode(tb, cnt, un, 2); nx.A = p.act + (size_t)m2.mtg * MOE_TM * 1024; nx.Bt = p.wdn_t + (((size_t)l * NE + m2.e) * 1024 + m2.nt * 256) * 1024; } nx.perm = 1;
        const float* bias = p.b_dn + ((size_t)l * NE + m.e) * 1024 + m.nt * 256;
        const float* gate = p.rowgate + (size_t)m.e * NT + m.mt * MOE_TM;
        bf16_t* out = p.yb + (size_t)m.mtg * MOE_TM * 1024 + m.nt * 256;
        const int nvalid = m.nvalid;
        gemm_tile256(p.act + (size_t)m.mtg * MOE_TM * 1024, 1024, nullptr, 256, p.wdn_t + (((size_t)l * NE + m.e) * 1024 + m.nt * 256) * 1024, 1024, 1024, lds, wbase_in, pre, nx, true, G8Out{out, 1024, 256}, bias,
                     [=](int r, int c, f32x4 v0, f32x4 v1, u32x4 ga) mutable {
                         const float g = __uint_as_float(ga[0]);
                         v0 = v0 * g; v1 = v1 * g;
                         u32x4 o; o[0] = cvtpk(v0[0], v0[1]); o[1] = cvtpk(v0[2], v0[3]); o[2] = cvtpk(v1[0], v1[1]); o[3] = cvtpk(v1[2], v1[3]); return o; },
                     [=](int r, int) { const float g = (r < nvalid) ? gate[r] : 0.f; return (u32x4){__float_as_uint(g), 0u, 0u, 0u}; });
        pre = nx.valid != 0;
    }
}
__device__ __forceinline__ void ph_combine_ln2(const Params& pkv, KPtr kp_in, int wbase_in, int l, char* lds) {
    PH_HEAD
    int* tb = (int*)(lds + 132096);
    moe_tile_prefix(p, l, tb, TID);
    const int lane = TID & 63, gw = BID * (NTHREADS / 64) + (TID >> 6), nw = gridDim.x * (NTHREADS / 64);
    float4 gg[4], bb[4];
#pragma unroll
    for (int m = 0; m < 4; ++m) { gg[m] = *(const float4*)(p.ln2_g + l * 1024 + m * 256 + lane * 4); bb[m] = *(const float4*)(p.ln2_b + l * 1024 + m * 256 + lane * 4); }
    const bool last = (l == DEPTH - 1);
    uint2 ny[4]; uint2 nb[4][4]; int4 ne, npz;
    auto load_idx = [&](int t) { ne = *(const int4*)(p.toke + (size_t)t * 4); npz = *(const int4*)(p.tokpos + (size_t)t * 4); };
    auto load_rows = [&](int t) {
        const size_t r0 = (size_t)tb[ne.x] * MOE_TM + npz.x, r1 = (size_t)tb[ne.y] * MOE_TM + npz.y, r2 = (size_t)tb[ne.z] * MOE_TM + npz.z, r3 = (size_t)tb[ne.w] * MOE_TM + npz.w;
#pragma unroll
        for (int m = 0; m < 4; ++m) {
            const int c = m * 256 + lane * 4;
            ny[m] = *(const uint2*)(p.x1b + (size_t)t * 1024 + c);
            nb[m][0] = *(const uint2*)(p.yb + r0 * 1024 + c); nb[m][1] = *(const uint2*)(p.yb + r1 * 1024 + c); nb[m][2] = *(const uint2*)(p.yb + r2 * 1024 + c); nb[m][3] = *(const uint2*)(p.yb + r3 * 1024 + c);
        }
    };
    int t = gw;
    if (t < NT) { load_idx(t); load_rows(t); if (t + nw < NT) load_idx(t + nw); }
    for (; t < NT; t += nw) {
        float4 y[4]; float s = 0.f;
#pragma unroll
        for (int m = 0; m < 4; ++m) {
            float4 v;
            v.x = ALPHA * __uint_as_float(ny[m].x << 16); v.y = ALPHA * __uint_as_float(ny[m].x & 0xffff0000u); v.z = ALPHA * __uint_as_float(ny[m].y << 16); v.w = ALPHA * __uint_as_float(ny[m].y & 0xffff0000u);
#pragma unroll
            for (int k = 0; k < 4; ++k) { const uint2 w = nb[m][k]; v.x += __uint_as_float(w.x << 16); v.y += __uint_as_float(w.x & 0xffff0000u); v.z += __uint_as_float(w.y << 16); v.w += __uint_as_float(w.y & 0xffff0000u); }
            y[m] = v; s += (v.x + v.y) + (v.z + v.w);
        }
        if (t + nw < NT) { load_rows(t + nw); if (t + 2 * nw < NT) load_idx(t + 2 * nw); }
        const float mean = wave_sum(s) * (1.0f / 1024.0f);
        float q = 0.f;
#pragma unroll
        for (int m = 0; m < 4; ++m) { y[m].x -= mean; y[m].y -= mean; y[m].z -= mean; y[m].w -= mean; q += (y[m].x * y[m].x + y[m].y * y[m].y) + (y[m].z * y[m].z + y[m].w * y[m].w); }
        const float rs = rsqrtf(wave_sum(q) * (1.0f / 1024.0f) + 1e-5f);
#pragma unroll
        for (int m = 0; m < 4; ++m) {
            const int c = m * 256 + lane * 4;
            float4 xv; xv.x = y[m].x * rs * gg[m].x + bb[m].x; xv.y = y[m].y * rs * gg[m].y + bb[m].y; xv.z = y[m].z * rs * gg[m].z + bb[m].z; xv.w = y[m].w * rs * gg[m].w + bb[m].w;
            if (last) *(float4*)(p.out + (size_t)t * 1024 + c) = xv;
            else { uint2 ob; ob.x = cvtpk(xv.x, xv.y); ob.y = cvtpk(xv.z, xv.w); *(uint2*)(p.xb + (size_t)t * 1024 + c) = ob; }
        }
    }
}

constexpr int PH_PRO = 0, PH_INPROJ = 1, PH_PREP = 2, PH_RETKV = 3, PH_RETSCAN = 4, PH_RETOUT = 5, PH_DIL = 6, PH_RWKVPREP = 7, PH_RWKVSCAN = 8, PH_MLAUP = 9,
              PH_MLAATTN = 10, PH_FINAL = 11, PH_OUTPROJ = 12, PH_LN1 = 13, PH_GU = 14, PH_DN = 15, PH_LN2 = 16;

__device__ __forceinline__ void grid_sync(KPtr kp_in, int wbase_in, char* lds) {
    KPtr kp_ = kp_launder(kp_in);
    XcdBarrier b; b.bar = kp_->bar; b.x = xb_xcc_id(); b.st = (volatile LAS unsigned*)(lds + LDS_BYTES - 16);
    xcd_barrier(b, opq_tid(wbase_in));
}
#ifndef PROBE_ID
#define PROBE_ID -1
#endif
#define RUN(ID, call) do { int reps_ = 1; if (PROBE_ID == (ID)) { reps_ = 2; asm volatile("" : "+s"(reps_)); } for (int r_ = 0; r_ < reps_; ++r_) { call; } } while (0)
__global__ void __launch_bounds__(NTHREADS, 2) mega_fused(Params pk) {
    extern __shared__ __attribute__((aligned(16))) char lds[];
    KPtr kp = (KPtr)__builtin_amdgcn_kernarg_segment_ptr();
    const int wbase = __builtin_amdgcn_readfirstlane(threadIdx.x) & ~63;
    volatile LAS unsigned* xbw = (volatile LAS unsigned*)(lds + LDS_BYTES - 16);
    if (threadIdx.x == 0) { xbw[0] = 0u; xbw[1] = 0u; xbw[2] = 0u; xbw[3] = 0u; }
    __syncthreads();
    (void)xcd_barrier_post(pk.bar, xbw);
    RUN(0, ph_prologue(pk, kp, wbase, lds));
    grid_sync(kp, wbase, lds);
    for (int l = 0; l < DEPTH; ++l) {
        RUN(1, ph_inproj(pk, kp, wbase, l, lds));
        grid_sync(kp, wbase, lds);
        RUN(3, ph_ret_kv(pk, kp, wbase, l, lds)); RUN(4, ph_rwkv_prep(pk, kp, wbase, l, lds)); RUN(5, ph_mla_up(pk, kp, wbase, l, lds));
        grid_sync(kp, wbase, lds);
        RUN(8, ph_ret_scan(pk, kp, wbase, l)); RUN(17, ph_rwkv_chunkpre(pk, kp, wbase, l, lds));
        grid_sync(kp, wbase, lds);
        RUN(10, ph_rwkv_scan(pk, kp, wbase, l, lds)); RUN(9, ph_mla_attn(pk, kp, wbase, l, lds)); ph_dil_attn(pk, kp, wbase, l, lds); ph_ret_out(pk, kp, wbase, l, lds);
        grid_sync(kp, wbase, lds);
        RUN(12, ph_finalize_mix(pk, kp, wbase, l));
        grid_sync(kp, wbase, lds);
        RUN(13, ph_outproj(pk, kp, wbase, l, lds));
        grid_sync(kp, wbase, lds);
        ph_ln1_router(pk, kp, wbase, l, lds);
        grid_sync(kp, wbase, lds);
        RUN(14, ph_moe_gu(pk, kp, wbase, l, lds));
        grid_sync(kp, wbase, lds);
        RUN(15, ph_moe_dn(pk, kp, wbase, l, lds));
        grid_sync(kp, wbase, lds);
        RUN(16, ph_combine_ln2(pk, kp, wbase, l, lds));
        grid_sync(kp, wbase, lds);
    }
}
struct Carver { char* base; size_t off; template <class T> T* take(size_t n) { T* r = (T*)(base + off); off += ((n * sizeof(T) + 255) / 256) * 256; return r; } };

extern "C" void kernel_launch(void* const* d_in, const int* in_sizes, int n_in, void* d_out, int out_size, void* d_ws, size_t ws_size, hipStream_t stream) {
    Params p; memset(&p, 0, sizeof(p));
    const float** ip = (const float**)&p;
    for (int i = 0; i < 35; ++i) ip[i] = (const float*)d_in[i];
    p.out = (float*)d_out;
    Carver c{(char*)d_ws, 0};
    p.bar = c.take<unsigned>(4096); p.cnt = c.take<int>(DEPTH * NE); p.wq = c.take<int>(DEPTH * 16);
    p.tab_ret = c.take<float>((size_t)SEQ * 32); p.tab_dil = c.take<float>((size_t)SEQ * 16); p.tab_mla = c.take<float>((size_t)SEQ * 32);
    p.win_t = c.take<bf16_t>((size_t)DEPTH * NINP * 1024); p.wout_t = c.take<bf16_t>((size_t)DEPTH * 1024 * 1024);
    p.wgu_t = c.take<bf16_t>((size_t)DEPTH * NE * 2048 * 1024); p.wdn_t = c.take<bf16_t>((size_t)DEPTH * NE * 1024 * 1024);
    p.wq_t = c.take<bf16_t>((size_t)DEPTH * 384 * 256); p.wkv_t = c.take<bf16_t>((size_t)DEPTH * 512 * 128);
    p.wupt = c.take<bf16_t>((size_t)DEPTH * 256 * 64); p.aupt = c.take<bf16_t>((size_t)DEPTH * 256 * 64); p.gupt = c.take<bf16_t>((size_t)DEPTH * 256 * 128); p.vupt = c.take<bf16_t>((size_t)DEPTH * 256 * 32);
    p.xf = c.take<float>((size_t)NT * DM); p.xb = c.take<bf16_t>((size_t)NT * DM); p.pbuf = c.take<bf16_t>((size_t)NT * NINP);
    p.mixcat = c.take<bf16_t>((size_t)NT * DM); p.y1 = c.take<float>((size_t)NT * DM); p.x1b = c.take<bf16_t>((size_t)NT * DM);
    p.rq = c.take<float>((size_t)NT * 128); p.rk = c.take<float>((size_t)NT * 128);
    p.rkv = c.take<float>((size_t)NBATCH * NCH * 4 * 32 * 64); p.rstate = c.take<float>((size_t)NBATCH * NCH * 4 * 32 * 64);
    p.dq = c.take<float>((size_t)NT * 256); p.dk = c.take<float>((size_t)NT * 256); p.dob = c.take<float>((size_t)3 * NT * 256); p.dlse = c.take<float>((size_t)3 * NT * 4);
    p.sr = c.take<float>((size_t)NT * 256); p.sw = c.take<float>((size_t)NT * 256); p.sk = c.take<float>((size_t)NT * 256); p.sv = c.take<float>((size_t)NT * 256);
    p.sa = c.take<float>((size_t)NT * 256); p.sb = c.take<float>((size_t)NT * 256); p.sg = c.take<float>((size_t)NT * 256); p.sy = c.take<float>((size_t)NT * 256);
    p.vfirst = c.take<float>((size_t)NT * 256);
    p.c_p = c.take<float>((size_t)16 * (SEQ / 16) * 4096); p.c_q = c.take<float>((size_t)16 * (SEQ / 16) * 4096); p.c_rh = c.take<float>((size_t)16 * (SEQ / 16) * 1024); p.c_y1 = c.take<float>((size_t)16 * (SEQ / 16) * 1024); p.c_g = c.take<float>((size_t)16 * (SEQ / 16) * 64);
    p.rsq = c.take<float>(NT); p.rskv = c.take<float>(NT); p.kpe = c.take<float>((size_t)NT * 32);
    p.qu = c.take<float>((size_t)NT * 384); p.kvu = c.take<float>((size_t)NT * 512); p.mo = c.take<float>((size_t)NT * 256);
    p.mq = c.take<bf16_t>((size_t)NT * 384); p.mk = c.take<bf16_t>((size_t)NT * 384); p.mv = c.take<bf16_t>((size_t)NT * 256);
    p.rowtok = c.take<int>((size_t)NE * NT); p.toke = c.take<int>((size_t)NT * 4); p.tokpos = c.take<int>((size_t)NT * 4); p.rowgate = c.take<float>((size_t)NE * NT);
    p.act = c.take<bf16_t>((size_t)MOE_MAXROWS * 1024); p.yb = c.take<bf16_t>((size_t)MOE_MAXROWS * 1024);
    if (c.off > ws_size) { fprintf(stderr, "workspace too small: need %zu have %zu\n", c.off, ws_size); return; }

    static int grid = 0;
    if (!grid) {
        (void)hipFuncSetAttribute((const void*)mega_fused, hipFuncAttributeMaxDynamicSharedMemorySize, LDS_BYTES);
        int dev = 0, cus = 0, per_cu = 0;
        (void)hipGetDevice(&dev);
        (void)hipDeviceGetAttribute(&cus, hipDeviceAttributeMultiprocessorCount, dev);
        (void)hipOccupancyMaxActiveBlocksPerMultiprocessor(&per_cu, mega_fused, NTHREADS, LDS_BYTES);
        if (cus <= 0) cus = 256;
        grid = cus * (per_cu < 1 ? 1 : 1);
    }
    (void)hipMemsetAsync(p.bar, 0, XCD_BAR_WORDS * sizeof(unsigned), stream);
    hipLaunchKernelGGL(mega_fused, dim3(grid), dim3(NTHREADS), LDS_BYTES, stream, p);
}
```
